# Optimizing an MI355X kernel written in HIP

```python
import jax
import jax.numpy as jnp
from jax import lax
import numpy as np

D_MODEL = 1024
BATCH = 2
SEQ = 16384
DEPTH = 1

FOX_HEADS = 8
FOX_HEAD_DIM = 64
FOX_WIDTH = FOX_HEADS * FOX_HEAD_DIM
Q_BLOCK = 128
RWKV_HEADS = 8
RWKV_HEAD_DIM = 64
RWKV_WIDTH = RWKV_HEADS * RWKV_HEAD_DIM
DECAY_LORA = 64
AAA_LORA = 64
GATE_LORA = 128
LN_X_EPS = 64e-5
N_BRANCHES = 2
SHIFT_WIDTH = 3 * RWKV_WIDTH + DECAY_LORA + AAA_LORA + GATE_LORA
IN_SPLITS = [FOX_WIDTH, 2 * FOX_WIDTH, 3 * FOX_WIDTH, 3 * FOX_WIDTH + FOX_HEADS,
             3 * FOX_WIDTH + FOX_HEADS + SHIFT_WIDTH]
D_IN = 3 * FOX_WIDTH + FOX_HEADS + SHIFT_WIDTH + N_BRANCHES * D_MODEL
RWKV_SPLITS = [RWKV_WIDTH, 2 * RWKV_WIDTH, 3 * RWKV_WIDTH, 3 * RWKV_WIDTH + DECAY_LORA,
               3 * RWKV_WIDTH + DECAY_LORA + AAA_LORA]
N_GROUPS = 4
EXPERTS_PER_GROUP = 8
N_EXPERTS = N_GROUPS * EXPERTS_PER_GROUP
TOP_K = 2
D_EXPERT = 512
MOE_BLOCK = 128
NORM_EPS = 1e-6

kernel_name = 'fox_rwkv7_hmoe_adaln_block'


def rms_norm(x, g):
    xf = x.astype(jnp.float32)
    y = xf * lax.rsqrt(jnp.mean(xf * xf, axis=-1, keepdims=True) + NORM_EPS)
    return (y * g.astype(jnp.float32)).astype(x.dtype)


def token_shift(p, mu):
    prev = jnp.pad(p, ((0, 0), (1, 0), (0, 0)))[:, :-1]
    return p + (prev - p) * mu


def fox_attention(q, k, v, log_f):
    b, s, _ = q.shape
    nqb = s // Q_BLOCK
    scale = FOX_HEAD_DIM ** -0.5
    qh = q.reshape(b, nqb, Q_BLOCK, FOX_HEADS, FOX_HEAD_DIM).transpose(1, 0, 3, 2, 4)
    kh = k.reshape(b, s, FOX_HEADS, FOX_HEAD_DIM).transpose(0, 2, 1, 3)
    vh = v.reshape(b, s, FOX_HEADS, FOX_HEAD_DIM).transpose(0, 2, 1, 3)
    cum = jnp.cumsum(log_f, axis=1).transpose(0, 2, 1)
    cum_q = cum.reshape(b, FOX_HEADS, nqb, Q_BLOCK).transpose(2, 0, 1, 3)
    k_pos = jnp.arange(s)

    def block(args):
        q_blk, c_blk, i = args
        logits = jnp.einsum('bhqd,bhkd->bhqk', q_blk, kh).astype(jnp.float32) * scale
        logits = logits + c_blk[..., None] - cum[:, :, None, :]
        q_pos = i * Q_BLOCK + jnp.arange(Q_BLOCK)
        logits = jnp.where(k_pos[None, :] <= q_pos[:, None], logits, -jnp.inf)
        probs = jax.nn.softmax(logits, axis=-1).astype(vh.dtype)
        return jnp.einsum('bhqk,bhkd->bhqd', probs, vh)

    o = lax.map(block, (qh, cum_q, jnp.arange(nqb)))
    return o.transpose(1, 0, 3, 2, 4).reshape(b, s, FOX_WIDTH)


def rwkv7_scan(r, w, k, v, a_vec, b_vec):
    b, s, h, n = r.shape
    xs = tuple(t.astype(jnp.float32).transpose(1, 0, 2, 3) for t in (r, w, k, v, a_vec, b_vec))
    state0 = jnp.zeros((b, h, n, n), jnp.float32)

    def step(state, inp):
        r_t, w_t, k_t, v_t, a_t, b_t = inp
        sa = jnp.einsum('bhij,bhj->bhi', state, a_t)
        state = (state * w_t[:, :, None, :] + sa[..., None] * b_t[:, :, None, :]
                 + v_t[..., None] * k_t[:, :, None, :])
        return state, jnp.einsum('bhij,bhj->bhi', state, r_t)

    _, y = lax.scan(step, state0, xs)
    return y.transpose(1, 0, 2, 3)


def rwkv7_branch(p, w0, w2, a0, a2, g2, k_k, k_a, r_k, ln_g, ln_b):
    b, s, _ = p.shape
    r, k, v, wd, ad, gd = jnp.split(p, RWKV_SPLITS, axis=-1)
    log_w = -jax.nn.softplus(-(w0 + jnp.tanh(wd) @ w2).astype(jnp.float32)) - 0.5
    decay = jnp.exp(-jnp.exp(log_w))
    a = jax.nn.sigmoid(a0 + ad @ a2)
    g = jax.nn.sigmoid(gd) @ g2
    heads = lambda t: t.reshape(b, s, RWKV_HEADS, RWKV_HEAD_DIM)
    kk = heads(k * k_k).astype(jnp.float32)
    kk = kk / jnp.maximum(jnp.sqrt(jnp.sum(kk * kk, axis=-1, keepdims=True)), 1e-12)
    k = k * (1.0 + (a - 1.0) * k_a)
    rh, kh, vh, ah = heads(r), heads(k), heads(v), heads(a)
    y = rwkv7_scan(rh, heads(decay), kh, vh, -kk, kk * ah)
    mu = jnp.mean(y, axis=-1, keepdims=True)
    var = jnp.mean(jnp.square(y - mu), axis=-1, keepdims=True)
    yn = ((y - mu) * lax.rsqrt(var + LN_X_EPS)).reshape(b, s, RWKV_WIDTH) * ln_g + ln_b
    bonus = jnp.sum((rh * kh * r_k).astype(jnp.float32), axis=-1, keepdims=True) * vh.astype(jnp.float32)
    out = (yn + bonus.reshape(b, s, RWKV_WIDTH)) * g
    return out.astype(p.dtype)


def hier_moe(h, rg_w, rg_b, re_w, re_b, w1, w3, w2):
    t, d = h.shape
    hf = h.astype(jnp.float32)
    group_prob = jax.nn.softmax(hf @ rg_w.astype(jnp.float32) + rg_b, axis=-1)
    g_p, g_idx = lax.top_k(group_prob, 1)
    exp_logits = (hf @ re_w.astype(jnp.float32) + re_b).reshape(t, N_GROUPS, EXPERTS_PER_GROUP)
    sel = exp_logits[jnp.arange(t), g_idx[:, 0]]
    e_p, e_idx = lax.top_k(jax.nn.softmax(sel, axis=-1), TOP_K)
    weights = g_p * e_p / jnp.sum(e_p, axis=-1, keepdims=True)
    expert_id = g_idx * EXPERTS_PER_GROUP + e_idx

    m = t * TOP_K
    flat_e = expert_id.reshape(m)
    flat_w = weights.reshape(m)
    flat_tok = jnp.arange(m) // TOP_K
    order = jnp.argsort(flat_e)
    e_s, tok_s, w_s = flat_e[order], flat_tok[order], flat_w[order]
    counts = jnp.bincount(flat_e, length=N_EXPERTS)
    padded = (counts + MOE_BLOCK - 1) // MOE_BLOCK * MOE_BLOCK
    seg_start = jnp.cumsum(counts) - counts
    pad_end = jnp.cumsum(padded)
    pad_start = pad_end - padded
    dest = pad_start[e_s] + (jnp.arange(m) - seg_start[e_s])
    n_blocks = -(-m // MOE_BLOCK) + N_EXPERTS
    rows = n_blocks * MOE_BLOCK
    row_tok = jnp.full((rows,), t, jnp.int32).at[dest].set(tok_s.astype(jnp.int32))
    row_w = jnp.zeros((rows,), h.dtype).at[dest].set(w_s.astype(h.dtype))
    blk_e = jnp.minimum(jnp.searchsorted(pad_end, jnp.arange(n_blocks) * MOE_BLOCK, side='right'),
                        N_EXPERTS - 1)
    h_pad = jnp.concatenate([h, jnp.zeros((1, d), h.dtype)], axis=0)
    x_in = h_pad[row_tok].reshape(n_blocks, MOE_BLOCK, d)

    def expert_block(args):
        xb, e = args
        return (jax.nn.silu(xb @ w1[e]) * (xb @ w3[e])) @ w2[e]

    out = lax.map(expert_block, (x_in, blk_e)).reshape(rows, d)
    y = jax.ops.segment_sum(out * row_w[:, None], row_tok, num_segments=t + 1)
    return y[:t]


def setup_inputs(seed: int = 0) -> dict:
    key = jax.random.key(seed)
    ks = jax.random.split(key, 32)
    L, D = DEPTH, D_MODEL

    def nrm(i, shape, scale):
        return scale * jax.random.normal(ks[i], shape, jnp.float32)

    def uni(i, shape, lo, hi):
        return jax.random.uniform(ks[i], shape, jnp.float32, lo, hi)

    return {
        'x': nrm(0, (BATCH, SEQ, D), 1.0),
        'c': nrm(1, (BATCH, D), 1.0),
        'ada_w': nrm(2, (L, D, 6 * D), 0.5 * D ** -0.5),
        'ada_b': nrm(3, (L, 6 * D), 0.02),
        'norm1_g': 1.0 + nrm(4, (L, D), 0.02),
        'w_in': nrm(5, (L, D, D_IN), D ** -0.5),
        'fox_forget_b': uni(6, (L, FOX_HEADS), 1.0, 5.0),
        'shift_mu': uni(7, (L, SHIFT_WIDTH), 0.0, 1.0),
        'rwkv_w0': uni(8, (L, RWKV_WIDTH), -6.0, -1.0),
        'rwkv_w2': nrm(9, (L, DECAY_LORA, RWKV_WIDTH), 0.5 * DECAY_LORA ** -0.5),
        'rwkv_a0': nrm(10, (L, RWKV_WIDTH), 0.1),
        'rwkv_a2': nrm(11, (L, AAA_LORA, RWKV_WIDTH), AAA_LORA ** -0.5),
        'rwkv_g2': nrm(12, (L, GATE_LORA, RWKV_WIDTH), GATE_LORA ** -0.5),
        'rwkv_k_k': 0.85 + nrm(13, (L, RWKV_WIDTH), 0.02),
        'rwkv_k_a': 1.0 + nrm(14, (L, RWKV_WIDTH), 0.02),
        'rwkv_r_k': nrm(15, (L, RWKV_HEADS, RWKV_HEAD_DIM), 0.1),
        'ln_x_g': 1.0 + nrm(16, (L, RWKV_WIDTH), 0.02),
        'ln_x_b': nrm(17, (L, RWKV_WIDTH), 0.02),
        'w_out_fox': nrm(18, (L, FOX_WIDTH, D), FOX_WIDTH ** -0.5),
        'w_out_rwkv': nrm(19, (L, RWKV_WIDTH, D), RWKV_WIDTH ** -0.5),
        'w_o': nrm(20, (L, D, D), D ** -0.5),
        'norm2_g': 1.0 + nrm(21, (L, D), 0.02),
        'router_group_w': nrm(22, (L, D, N_GROUPS), D ** -0.5),
        'router_group_b': nrm(23, (L, N_GROUPS), 0.01),
        'router_expert_w': nrm(24, (L, D, N_EXPERTS), D ** -0.5),
        'router_expert_b': nrm(25, (L, N_EXPERTS), 0.01),
        'exp_w1': nrm(26, (L, N_EXPERTS, D, D_EXPERT), D ** -0.5),
        'exp_w3': nrm(27, (L, N_EXPERTS, D, D_EXPERT), D ** -0.5),
        'exp_w2': nrm(28, (L, N_EXPERTS, D_EXPERT, D), D_EXPERT ** -0.5),
        'final_g': 1.0 + nrm(29, (D,), 0.02),
    }


def reference(x, c, ada_w, ada_b, norm1_g, w_in, fox_forget_b, shift_mu, rwkv_w0, rwkv_w2,
              rwkv_a0, rwkv_a2, rwkv_g2, rwkv_k_k, rwkv_k_a, rwkv_r_k, ln_x_g, ln_x_b,
              w_out_fox, w_out_rwkv, w_o, norm2_g, router_group_w, router_group_b,
              router_expert_w, router_expert_b, exp_w1, exp_w3, exp_w2, final_g):
    b, s, d = x.shape
    for l in range(DEPTH):
        mod = jax.nn.silu(c) @ ada_w[l] + ada_b[l]
        shift1, scale1, gate1, shift2, scale2, gate2 = [m[:, None, :] for m in jnp.split(mod, 6, axis=-1)]

        h = rms_norm(x, norm1_g[l]) * (1.0 + scale1) + shift1
        p = h @ w_in[l]
        q, k, v, f_logit, p_rwkv, gate_logit = jnp.split(p, IN_SPLITS, axis=-1)
        log_f = jax.nn.log_sigmoid((f_logit + fox_forget_b[l]).astype(jnp.float32))
        o_fox = fox_attention(q, k, v, log_f)
        o_rwkv = rwkv7_branch(token_shift(p_rwkv, shift_mu[l]), rwkv_w0[l], rwkv_w2[l], rwkv_a0[l],
                              rwkv_a2[l], rwkv_g2[l], rwkv_k_k[l], rwkv_k_a[l], rwkv_r_k[l],
                              ln_x_g[l], ln_x_b[l])
        g_fox, g_rwkv = jnp.split(jax.nn.sigmoid(gate_logit), N_BRANCHES, axis=-1)
        merged = g_fox * (o_fox @ w_out_fox[l]) + g_rwkv * (o_rwkv @ w_out_rwkv[l])
        x = x + gate1 * (merged @ w_o[l])

        h2 = rms_norm(x, norm2_g[l]) * (1.0 + scale2) + shift2
        y = hier_moe(h2.reshape(b * s, d), router_group_w[l], router_group_b[l], router_expert_w[l],
                     router_expert_b[l], exp_w1[l], exp_w3[l], exp_w2[l])
        x = x + gate2 * y.reshape(b, s, d)
    return rms_norm(x, final_g)
```

```cpp
#include <hip/hip_runtime.h>
#include <hip/hip_bf16.h>
#include <cstdio>
#include <cstdint>
#include <cmath>

namespace pg8 {
#define PG8_LAS __attribute__((address_space(3)))
typedef unsigned short bf16_t;
typedef short bf16x8 __attribute__((ext_vector_type(8)));
typedef float f32x4 __attribute__((ext_vector_type(4)));
typedef unsigned u32x4 __attribute__((ext_vector_type(4)));
typedef unsigned u32x2 __attribute__((ext_vector_type(2)));
constexpr int BM = 256, BK = 64, HALF = 128, HTB = HALF * BK * 2, STAGE_BYTES = 8 * HTB, NXCD = 8, WGM = 8;

__host__ __device__ __forceinline__ int lds_byte(int r, int c) { const int st = (r >> 4) * 2 + (c >> 5), rr = r & 15, cc = c & 31, ob = rr * 64 + cc * 2; return st * 1024 + (ob ^ (((ob >> 9) & 1) << 5)); }
__host__ __device__ __forceinline__ void stage_rc(int b, int& R, int& C) { const int st = b / 1024, sb = b % 1024, swz = sb ^ (((sb >> 9) & 1) << 5); R = (st >> 1) * 16 + swz / 64; C = (st & 1) * 32 + (swz % 64) / 2; }
__host__ __device__ __forceinline__ int perm32(int rho) { const int n = rho >> 4, i = rho & 15; return 8 * (i >> 2) + 4 * n + (i & 3); }

struct Unit { int pm, pn, e; };
struct Gemm { const bf16_t* A; const bf16_t* Bt; const int* rowidx; int K; int nB; };

struct StaticOrder {
    int nM, nN, nwg, G, c;
    __host__ __device__ void init(int M, int N, int G_, int c_) { nM = M / BM; nN = N / BM; nwg = nM * nN; G = G_; c = c_; }
    __host__ __device__ bool next(int i, Unit& u) const {
        const long L = (long)i * G + c; if (L >= nwg) return false;
        int wgid = (int)L; { const int q = nwg / NXCD, r = nwg % NXCD, xcd = wgid % NXCD, off = wgid / NXCD; wgid = (xcd < r ? xcd * (q + 1) : r * (q + 1) + (xcd - r) * q) + off; }
        const int nig = WGM * nN, gid = wgid / nig, fm = gid * WGM, gsz = (nM - fm) < WGM ? (nM - fm) : WGM;
        u.pm = fm + ((wgid % nig) % gsz); u.pn = (wgid % nig) / gsz; u.e = 0; return true;
    }
};

__device__ __forceinline__ unsigned cvt_pk_bf16(float lo, float hi) { unsigned r; asm volatile("v_cvt_pk_bf16_f32 %0, %1, %2" : "=v"(r) : "v"(lo), "v"(hi)); return r; }
__device__ __forceinline__ float bf_lo(unsigned w) { return __uint_as_float(w << 16); }
__device__ __forceinline__ float bf_hi(unsigned w) { return __uint_as_float(w & 0xffff0000u); }
__device__ __forceinline__ float fsigmoid(float x) { return __builtin_amdgcn_rcpf(1.0f + __builtin_amdgcn_exp2f(-1.4426950408889634f * x)); }

template <class Epi, class Sched, bool GATHER = false>
__device__ __forceinline__ void gemm_phase(PG8_LAS unsigned char* lds, const Gemm g, const Sched& S, const Epi& E) {
    int tid_ = threadIdx.x; asm volatile("" : "+v"(tid_));
    const int tid = tid_, wid = __builtin_amdgcn_readfirstlane(tid >> 6), lane = tid & 63, wr = wid >> 2, wc = wid & 3, fr = lane & 15, fq = lane >> 4;
    const int K = g.K, nt = K / BK;
    int RA[2], CA[2]; unsigned voffA[2], voffB[2];
#pragma unroll
    for (int i = 0; i < 2; ++i) { int R, C; stage_rc(tid * 16 + i * 8192, R, C); const int Rb = Epi::PERM ? ((R & ~31) + perm32(R & 31)) : R;
        RA[i] = R; CA[i] = C; voffA[i] = (unsigned)(R * K + C) * 2u; voffB[i] = (unsigned)(Rb * K + C) * 2u; }
    const size_t tstep = 2 * (size_t)HALF * K * 2;
    const size_t kstep = (size_t)(BK * 2);
    const size_t hstep = (size_t)HALF * K * 2;
    const unsigned ldsw = (unsigned)wid * 1024u;
    const int aoff = lds_byte(wr * 64 + fr, fq * 8), boff = lds_byte(wc * 32 + fr, fq * 8);
#define PG8_SA(b, h) (((b) * 2 + (h)) * HTB)
#define PG8_SB(b, h) ((4 + (b) * 2 + (h)) * HTB)
#define PG8_STAGE(bufoff, gbase, v0, v1) do { \
        __builtin_amdgcn_global_load_lds((const unsigned*)((const char*)(gbase) + (v0)), (PG8_LAS unsigned*)(lds + (bufoff) + ldsw), 16, 0, 0); \
        __builtin_amdgcn_global_load_lds((const unsigned*)((const char*)(gbase) + (v1)), (PG8_LAS unsigned*)(lds + (bufoff) + ldsw + 8192), 16, 0, 0); } while (0)
#define PG8_STAGEB(bufoff, gbase) PG8_STAGE(bufoff, gbase, voffB[0], voffB[1])
#define PG8_STAGEA(bufoff, abase, h, VA) do { if constexpr (GATHER) { PG8_STAGE(bufoff, abase, VA[h][0], VA[h][1]); } else { PG8_STAGE(bufoff, (abase) + (h) * hstep, voffA[0], voffA[1]); } } while (0)
#define PG8_LDA(dst, b, h) do { _Pragma("unroll") for (int m = 0; m < 4; ++m) _Pragma("unroll") for (int k = 0; k < 2; ++k) dst[m][k] = *(const PG8_LAS bf16x8*)(lds + PG8_SA(b, h) + aoff + m * 2048 + k * 1024); } while (0)
#define PG8_LDB(dst, b, h) do { _Pragma("unroll") for (int n = 0; n < 2; ++n) _Pragma("unroll") for (int k = 0; k < 2; ++k) dst[n][k] = *(const PG8_LAS bf16x8*)(lds + PG8_SB(b, h) + boff + n * 2048 + k * 1024); } while (0)
#define PG8_MMA(ai, bj, At, Bt) do { __builtin_amdgcn_s_setprio(1); _Pragma("unroll") for (int m = 0; m < 4; ++m) _Pragma("unroll") for (int n = 0; n < 2; ++n) _Pragma("unroll") for (int k = 0; k < 2; ++k) \
        acc[ai][bj][m][n] = __builtin_amdgcn_mfma_f32_16x16x32_bf16(Bt[n][k], At[m][k], acc[ai][bj][m][n], 0, 0, 0); __builtin_amdgcn_s_setprio(0); } while (0)
#define PG8_WAIT_V(n) asm volatile("s_waitcnt vmcnt(" #n ")" ::: "memory")
#define PG8_WAIT_L(n) asm volatile("s_waitcnt lgkmcnt(" #n ")" ::: "memory")
#define PG8_BAR __builtin_amdgcn_s_barrier()
#define PG8_SCHED __builtin_amdgcn_sched_barrier(0)
#define PG8_AOFF(dst, u) do { _Pragma("unroll") for (int h_ = 0; h_ < 2; ++h_) _Pragma("unroll") for (int i_ = 0; i_ < 2; ++i_) { \
        const int rr_ = (u).pm * BM + h_ * HALF + RA[i_]; const int src_ = g.rowidx[rr_]; dst[h_][i_] = (unsigned)(src_ * K + CA[i_]) * 2u; } } while (0)
    Unit cur, nxt; int ui = 0;
    if (!S.next(0, cur)) return;
    f32x4 acc[2][2][4][2];
#pragma unroll
    for (int a = 0; a < 2; ++a)
#pragma unroll
        for (int b = 0; b < 2; ++b)
#pragma unroll
            for (int m = 0; m < 4; ++m)
#pragma unroll
                for (int n = 0; n < 2; ++n) acc[a][b][m][n] = (f32x4){0.f, 0.f, 0.f, 0.f};
    bf16x8 At[4][2], B0[2][2], B1[2][2];
    unsigned vA[2][2], nvA[2][2];
    if constexpr (GATHER) { PG8_AOFF(vA, cur); }
    const char* cA = GATHER ? (const char*)g.A : (const char*)g.A + (size_t)cur.pm * tstep;
    const char* cB = (const char*)g.Bt + ((size_t)cur.e * g.nB + (size_t)cur.pn * BM) * K * 2;
    PG8_STAGEB(PG8_SB(0, 0), cB); PG8_STAGEB(PG8_SB(0, 1), cB + hstep); PG8_STAGEA(PG8_SA(0, 0), cA, 0, vA); PG8_STAGEA(PG8_SA(0, 1), cA, 1, vA);
    if (wr == 1) PG8_BAR;
    PG8_WAIT_V(2); PG8_BAR;
    PG8_STAGEB(PG8_SB(1, 0), cB + kstep); PG8_STAGEA(PG8_SA(1, 0), cA + kstep, 0, vA); PG8_STAGEB(PG8_SB(1, 1), cB + hstep + kstep);
    PG8_WAIT_V(6); PG8_BAR;
    for (;;) {
        const bool has_next = S.next(ui + 1, nxt);
        if constexpr (GATHER) { if (has_next) { PG8_AOFF(nvA, nxt); } else {
#pragma unroll
            for (int h_ = 0; h_ < 2; ++h_)
#pragma unroll
                for (int i_ = 0; i_ < 2; ++i_) nvA[h_][i_] = vA[h_][i_]; } }
        const char* nA = GATHER ? cA : (has_next ? (const char*)g.A + (size_t)nxt.pm * tstep : cA);
        const char* nB = has_next ? (const char*)g.Bt + ((size_t)nxt.e * g.nB + (size_t)nxt.pn * BM) * K * 2 : cB;
        for (int t = 0; t < nt; t += 2) {
            const bool last = (t == nt - 2);
            const char* a1 = cA + (size_t)(t + 1) * kstep;
            const char* a2 = last ? nA : cA + (size_t)(t + 2) * kstep; const char* b2 = last ? nB : cB + (size_t)(t + 2) * kstep;
            const char* a3 = a2 + kstep; const char* b3 = b2 + kstep;
            unsigned wv[2][2];
            if constexpr (GATHER) { wv[0][0] = last ? nvA[0][0] : vA[0][0]; wv[0][1] = last ? nvA[0][1] : vA[0][1]; wv[1][0] = last ? nvA[1][0] : vA[1][0]; wv[1][1] = last ? nvA[1][1] : vA[1][1]; }
            PG8_LDB(B0, 0, 0); PG8_LDB(B1, 0, 1); PG8_SCHED; PG8_LDA(At, 0, 0); PG8_STAGEA(PG8_SA(1, 1), a1, 1, vA);
            PG8_WAIT_V(8); PG8_WAIT_L(0); PG8_BAR; PG8_MMA(0, 0, At, B0); PG8_MMA(0, 1, At, B1); PG8_BAR; PG8_SCHED;
            PG8_LDA(At, 0, 1); PG8_STAGEB(PG8_SB(0, 0), b2); PG8_STAGEB(PG8_SB(0, 1), b2 + hstep); PG8_STAGEA(PG8_SA(0, 0), a2, 0, wv);
            PG8_WAIT_V(8); PG8_WAIT_L(0); PG8_BAR; PG8_MMA(1, 0, At, B0); PG8_MMA(1, 1, At, B1); PG8_BAR; PG8_SCHED;
            PG8_LDB(B0, 1, 0); PG8_LDB(B1, 1, 1); PG8_SCHED; PG8_LDA(At, 1, 0); PG8_STAGEA(PG8_SA(0, 1), a2, 1, wv);
            PG8_WAIT_V(8); PG8_WAIT_L(0); PG8_BAR; PG8_MMA(0, 0, At, B0); PG8_MMA(0, 1, At, B1); PG8_BAR; PG8_SCHED;
            PG8_LDA(At, 1, 1); PG8_STAGEB(PG8_SB(1, 0), b3); PG8_STAGEB(PG8_SB(1, 1), b3 + hstep); PG8_STAGEA(PG8_SA(1, 0), a3, 0, wv);
            PG8_WAIT_V(8); PG8_WAIT_L(0); PG8_BAR; PG8_MMA(1, 0, At, B0); PG8_MMA(1, 1, At, B1); PG8_BAR; PG8_SCHED;
        }
        if (wr == 0) PG8_BAR;
        E(acc, cur, wr, wc, fr, fq);
        if (!has_next) break;
#pragma unroll
        for (int a = 0; a < 2; ++a)
#pragma unroll
            for (int b = 0; b < 2; ++b)
#pragma unroll
                for (int m = 0; m < 4; ++m)
#pragma unroll
                    for (int n = 0; n < 2; ++n) acc[a][b][m][n] = (f32x4){0.f, 0.f, 0.f, 0.f};
        cur = nxt; cB = nB; cA = nA; ++ui;
        if constexpr (GATHER) {
#pragma unroll
        for (int h_ = 0; h_ < 2; ++h_)
#pragma unroll
            for (int i_ = 0; i_ < 2; ++i_) vA[h_][i_] = nvA[h_][i_]; }
        if (wr == 1) PG8_BAR;
    }
    PG8_WAIT_V(0);
    PG8_BAR;
#undef PG8_SA
#undef PG8_SB
#undef PG8_STAGE
#undef PG8_STAGEB
#undef PG8_STAGEA
#undef PG8_LDA
#undef PG8_LDB
#undef PG8_MMA
#undef PG8_WAIT_V
#undef PG8_WAIT_L
#undef PG8_BAR
#undef PG8_SCHED
#undef PG8_AOFF
}
}

namespace pg8 {
struct EpiIn {
    static constexpr bool PERM = true;
    bf16_t *Q, *Kb, *V, *PRW, *GT; float qscale;
    __device__ __forceinline__ void operator()(const f32x4 (&acc)[2][2][4][2], const Unit& u, int wr, int wc, int fr, int fq) const {
        const int pn = u.pn; bf16_t* base; int ld, colt, mode = 0;
        if (pn < 2) { base = Q; ld = 512; colt = pn * 256; mode = 1; }
        else if (pn < 4) { base = Kb; ld = 512; colt = (pn - 2) * 256; }
        else if (pn < 6) { base = V; ld = 512; colt = (pn - 4) * 256; }
        else if (pn < 13) { base = PRW; ld = 1792; colt = (pn - 6) * 256; }
        else { base = GT; ld = 2048; colt = (pn - 13) * 256; mode = 2; }
        const int row0 = u.pm * BM + wr * 64 + fr, col0 = colt + wc * 32 + 8 * fq;
        const float sc = (mode == 1) ? qscale : 1.0f;
#pragma unroll
        for (int ai = 0; ai < 2; ++ai)
#pragma unroll
            for (int m = 0; m < 4; ++m) { bf16_t* rowp = base + (size_t)(row0 + ai * HALF + m * 16) * ld + col0;
#pragma unroll
                for (int bj = 0; bj < 2; ++bj) { f32x4 v0 = acc[ai][bj][m][0] * sc, v1 = acc[ai][bj][m][1] * sc;
                    if (mode == 2) {
#pragma unroll
                        for (int e = 0; e < 4; ++e) { v0[e] = fsigmoid(v0[e]); v1[e] = fsigmoid(v1[e]); } }
                    u32x4 w; w.x = cvt_pk_bf16(v0[0], v0[1]); w.y = cvt_pk_bf16(v0[2], v0[3]); w.z = cvt_pk_bf16(v1[0], v1[1]); w.w = cvt_pk_bf16(v1[2], v1[3]);
                    *(u32x4*)(rowp + bj * HALF) = w; } }
    }
};
template <int MODE> struct EpiGate {
    static constexpr bool PERM = true;
    bf16_t* O; int ldo; const bf16_t* G; int ldg; int gcol0;
    __device__ __forceinline__ void operator()(const f32x4 (&acc)[2][2][4][2], const Unit& u, int wr, int wc, int fr, int fq) const {
        const int row0 = u.pm * BM + wr * 64 + fr, col0 = u.pn * BM + wc * 32 + 8 * fq;
#pragma unroll
        for (int ai = 0; ai < 2; ++ai)
#pragma unroll
            for (int m = 0; m < 4; ++m) { const size_t row = (size_t)(row0 + ai * HALF + m * 16); bf16_t* rowp = O + row * ldo + col0;
#pragma unroll
                for (int bj = 0; bj < 2; ++bj) { f32x4 v0 = acc[ai][bj][m][0], v1 = acc[ai][bj][m][1];
                    if (MODE >= 1) { const u32x4 gw = *(const u32x4*)(G + row * ldg + gcol0 + col0 + bj * HALF);
                        v0[0] *= bf_lo(gw.x); v0[1] *= bf_hi(gw.x); v0[2] *= bf_lo(gw.y); v0[3] *= bf_hi(gw.y); v1[0] *= bf_lo(gw.z); v1[1] *= bf_hi(gw.z); v1[2] *= bf_lo(gw.w); v1[3] *= bf_hi(gw.w); }
                    if (MODE == 2) { const u32x4 ow = *(const u32x4*)(rowp + bj * HALF);
                        v0[0] += bf_lo(ow.x); v0[1] += bf_hi(ow.x); v0[2] += bf_lo(ow.y); v0[3] += bf_hi(ow.y); v1[0] += bf_lo(ow.z); v1[1] += bf_hi(ow.z); v1[2] += bf_lo(ow.w); v1[3] += bf_hi(ow.w); }
                    u32x4 w; w.x = cvt_pk_bf16(v0[0], v0[1]); w.y = cvt_pk_bf16(v0[2], v0[3]); w.z = cvt_pk_bf16(v1[0], v1[1]); w.w = cvt_pk_bf16(v1[2], v1[3]);
                    *(u32x4*)(rowp + bj * HALF) = w; } }
    }
};
struct EpiRes {
    static constexpr bool PERM = false;
    const float* X; float* O; const float* gate; int seq; int gstride;
    __device__ __forceinline__ void operator()(const f32x4 (&acc)[2][2][4][2], const Unit& u, int wr, int wc, int fr, int fq) const {
        const int row0 = u.pm * BM + wr * 64 + fr, col0 = u.pn * BM + wc * 32 + 4 * fq;
        const float* gp = gate + (size_t)((u.pm * BM) / seq) * gstride + col0;
        f32x4 gv[2][2];
#pragma unroll
        for (int bj = 0; bj < 2; ++bj)
#pragma unroll
            for (int n = 0; n < 2; ++n) gv[bj][n] = *(const f32x4*)(gp + bj * HALF + n * 16);
#pragma unroll
        for (int ai = 0; ai < 2; ++ai)
#pragma unroll
            for (int m = 0; m < 4; ++m) { const size_t off = (size_t)(row0 + ai * HALF + m * 16) * 1024 + col0;
#pragma unroll
                for (int bj = 0; bj < 2; ++bj)
#pragma unroll
                    for (int n = 0; n < 2; ++n) { const f32x4 xv = *(const f32x4*)(X + off + bj * HALF + n * 16); *(f32x4*)(O + off + bj * HALF + n * 16) = xv + gv[bj][n] * acc[ai][bj][m][n]; } }
    }
};
struct EpiSwiGLU {
    static constexpr bool PERM = true;
    bf16_t* H;
    __device__ __forceinline__ void operator()(const f32x4 (&acc)[2][2][4][2], const Unit& u, int wr, int wc, int fr, int fq) const {
        const int row0 = u.pm * BM + wr * 64 + fr, col0 = u.pn * HALF + wc * 32 + 8 * fq;
#pragma unroll
        for (int ai = 0; ai < 2; ++ai)
#pragma unroll
            for (int m = 0; m < 4; ++m) { bf16_t* rowp = H + (size_t)(row0 + ai * HALF + m * 16) * 512 + col0;
                f32x4 v0, v1;
#pragma unroll
                for (int e = 0; e < 4; ++e) { const float a0 = acc[ai][0][m][0][e], a1 = acc[ai][0][m][1][e];
                    v0[e] = a0 * fsigmoid(a0) * acc[ai][1][m][0][e]; v1[e] = a1 * fsigmoid(a1) * acc[ai][1][m][1][e]; }
                u32x4 w; w.x = cvt_pk_bf16(v0[0], v0[1]); w.y = cvt_pk_bf16(v0[2], v0[3]); w.z = cvt_pk_bf16(v1[0], v1[1]); w.w = cvt_pk_bf16(v1[2], v1[3]);
                *(u32x4*)rowp = w; }
    }
};
struct MoeOrder {
    int nunits, G, c, cshift; const PG8_LAS int* tile_e;
    __device__ __forceinline__ bool next(int i, Unit& u) const {
        const int L = i * G + c; if (L >= nunits) return false;
        u.pm = L >> cshift; u.pn = L & ((1 << cshift) - 1); u.e = tile_e[u.pm]; return true;
    }
};
}
#include <hip/hip_bf16.h>
#include <cmath>
namespace attn_body {
using bf16=__hip_bfloat16;
using bf16x8=__attribute__((ext_vector_type(8)))short;
using s16x4=__attribute__((ext_vector_type(4)))short;
using f32x16=__attribute__((ext_vector_type(16)))float;
using u32x4=__attribute__((ext_vector_type(4)))unsigned;
constexpr int BATCH=2,NHEAD=8,SEQ=16384,D=64,DM=NHEAD*D;
constexpr int NW=8,QBLK=32,QB=QBLK*NW,KVBLK=64,NQB=SEQ/QB;
constexpr int ATTN_PITCH=DM, ATTN_UNIT_ROWS=QB;
__device__ __forceinline__ int crow(int r,int hi){return (r&3)+8*(r>>2)+4*hi;}
#define SBAR() __builtin_amdgcn_sched_barrier(0)
__device__ __forceinline__ void cmask(f32x16&p0,f32x16&p1,int jb,int qrel,int hi){
  const float NEG=-INFINITY; int x=qrel-64*jb-4*hi; asm volatile("":"+v"(x));
  #pragma unroll
  for(int r=0;r<16;++r){const int c=(r&3)+8*(r>>2); if(c>x)p0[r]=NEG; if(c+32>x)p1[r]=NEG;}
}

constexpr int NSLOT=3, SLOTB=8192;
constexpr int LDS_K=0, LDS_V=NSLOT*SLOTB, LDS_WS=2*NSLOT*SLOTB, LDS_OST=LDS_WS+NW*64*4, LDS_BYTES=LDS_OST+NW*4096;
constexpr float C2=0.125f*1.4426950408889634f;
__device__ __forceinline__ void glds16(const void*gsrc,unsigned lds_dst){unsigned keep;
  asm volatile("s_mov_b32 %0, m0\n\ts_mov_b32 m0, %2\n\ts_nop 0\n\tglobal_load_lds_dwordx4 %1, off\n\ts_mov_b32 m0, %0":"=&s"(keep):"v"(gsrc),"s"(lds_dst):"memory");}
__device__ __forceinline__ float max3f(float a,float b,float c){float r;asm("v_max3_f32 %0, %1, %2, %3":"=v"(r):"v"(a),"v"(b),"v"(c));return r;}
__device__ __forceinline__ float max2f(float a,float b){float r;asm("v_max_f32_e32 %0, %1, %2":"=v"(r):"v"(a),"v"(b));return r;}
__device__ __forceinline__ float fadd_s(float a,float b){float r;asm("v_add_f32_e32 %0, %1, %2":"=v"(r):"v"(a),"v"(b));return r;}
__device__ __forceinline__ float fsub_s(float a,float b){float r;asm("v_sub_f32_e32 %0, %1, %2":"=v"(r):"v"(a),"v"(b));return r;}
typedef float f32x2_t __attribute__((ext_vector_type(2))); typedef __bf16 bf16x2_t __attribute__((ext_vector_type(2)));
__device__ __forceinline__ unsigned cvtpk_s(float lo,float hi){f32x2_t v={lo,hi};bf16x2_t b=__builtin_convertvector(v,bf16x2_t);return __builtin_bit_cast(unsigned,b);}
#define WAIT_BAR(N) asm volatile("s_waitcnt vmcnt(" #N ") lgkmcnt(0)\n\ts_barrier":::"memory")

__device__ __forceinline__ void qkt(f32x16&p0,f32x16&p1,const char*Kslot,const bf16x8*qr,int r32,int hi){
  const char*kb=Kslot+hi*1024+r32*16;
  #pragma unroll
  for(int d0=0;d0<4;++d0){
    const bf16x8 b0=*reinterpret_cast<const bf16x8*>(kb+d0*2048);
    const bf16x8 b1=*reinterpret_cast<const bf16x8*>(kb+d0*2048+512);
    if(d0==0){p0=__builtin_amdgcn_mfma_f32_32x32x16_bf16(b0,qr[0],p0,0,0,0);p1=__builtin_amdgcn_mfma_f32_32x32x16_bf16(b1,qr[0],p1,0,0,0);}
    else{p0=__builtin_amdgcn_mfma_f32_32x32x16_bf16(b0,qr[d0],p0,0,0,0);p1=__builtin_amdgcn_mfma_f32_32x32x16_bf16(b1,qr[d0],p1,0,0,0);}}
}
typedef __attribute__((address_space(3))) const char* lds_cptr;
typedef short v4i16_t __attribute__((ext_vector_type(4)));
__device__ __forceinline__ void kload8(bf16x8*kf,lds_cptr kp){
  kf[0]=*(const __attribute__((address_space(3))) bf16x8*)(kp);      kf[1]=*(const __attribute__((address_space(3))) bf16x8*)(kp+512);
  kf[2]=*(const __attribute__((address_space(3))) bf16x8*)(kp+2048); kf[3]=*(const __attribute__((address_space(3))) bf16x8*)(kp+2560);
  kf[4]=*(const __attribute__((address_space(3))) bf16x8*)(kp+4096); kf[5]=*(const __attribute__((address_space(3))) bf16x8*)(kp+4608);
  kf[6]=*(const __attribute__((address_space(3))) bf16x8*)(kp+6144); kf[7]=*(const __attribute__((address_space(3))) bf16x8*)(kp+6656);
}
__device__ __forceinline__ void kload2(bf16x8*kf,lds_cptr kp,int j){ kf[2*j]=*(const __attribute__((address_space(3))) bf16x8*)(kp+j*2048); kf[2*j+1]=*(const __attribute__((address_space(3))) bf16x8*)(kp+j*2048+512); }
__device__ __forceinline__ s16x4 vtr(lds_cptr p){ return __builtin_bit_cast(s16x4,__builtin_amdgcn_ds_read_tr16_b64_v4i16((__attribute__((address_space(3))) v4i16_t*)p)); }
__device__ __forceinline__ float rowmax(const f32x16&p0,const f32x16&p1){
  float a=max3f(p0[0],p0[1],p1[0]),b=max3f(p0[2],p0[3],p1[1]);a=max3f(a,p1[2],p1[3]);
  #pragma unroll
  for(int r=4;r<16;r+=4){a=max3f(a,p0[r],p0[r+1]);b=max3f(b,p0[r+2],p0[r+3]);a=max3f(a,p1[r],p1[r+1]);b=max3f(b,p1[r+2],p1[r+3]);}
  const float m=max2f(a,b);
  auto rr=__builtin_amdgcn_permlane32_swap(__float_as_uint(m),__float_as_uint(m),false,false);
  return max2f(__uint_as_float(rr[0]),__uint_as_float(rr[1]));
}
__device__ __forceinline__ void pv(f32x16*o,int vb,bf16x8 pa0,bf16x8 pa1,bf16x8 pa2,bf16x8 pa3){
  #pragma unroll
  for(int d0=0;d0<2;++d0){s16x4 lo[4],hi[4];
    #pragma unroll
    for(int ks=0;ks<4;++ks){
      asm volatile("ds_read_b64_tr_b16 %0,%1 offset:%c2":"=&v"(lo[ks]):"v"(vb),"i"(d0*4096+ks*1024):"memory");
      asm volatile("ds_read_b64_tr_b16 %0,%1 offset:%c2":"=&v"(hi[ks]):"v"(vb),"i"(d0*4096+ks*1024+512):"memory");}
    asm volatile("s_waitcnt lgkmcnt(0)":::"memory");SBAR();
    #define PK(k) (bf16x8){lo[k][0],lo[k][1],lo[k][2],lo[k][3],hi[k][0],hi[k][1],hi[k][2],hi[k][3]}
    o[d0]=__builtin_amdgcn_mfma_f32_32x32x16_bf16(pa0,PK(0),o[d0],0,0,0);
    o[d0]=__builtin_amdgcn_mfma_f32_32x32x16_bf16(pa1,PK(1),o[d0],0,0,0);
    o[d0]=__builtin_amdgcn_mfma_f32_32x32x16_bf16(pa2,PK(2),o[d0],0,0,0);
    o[d0]=__builtin_amdgcn_mfma_f32_32x32x16_bf16(pa3,PK(3),o[d0],0,0,0);
    #undef PK
  }
}

#ifndef ATTN_STORE16
#define ATTN_STORE16(p,v) (*(u32x4*)(p)=(v))
#endif
typedef float f32x4_t __attribute__((ext_vector_type(4)));
#define NEXTB(P0,P1,tt) do{ const __attribute__((address_space(3))) float* tb_=tab3+(tt)*64+4*hi; const float nm_=-mhat; \
  _Pragma("unroll") for(int g_=0;g_<4;++g_){ const f32x4_t b0_=*(const __attribute__((address_space(3))) f32x4_t*)(tb_+8*g_); const f32x4_t b1_=*(const __attribute__((address_space(3))) f32x4_t*)(tb_+32+8*g_); \
    _Pragma("unroll") for(int j_=0;j_<4;++j_){ P0[4*g_+j_]=nm_-b0_[j_]; P1[4*g_+j_]=nm_-b1_[j_]; } } }while(0)
template<int THRL> __device__ __forceinline__ void attn_unit(int b,int h,int qb,int t0,const bf16*Q,const bf16*__restrict__ K,const bf16*__restrict__ V,bf16*O,const float*__restrict__ cumT,char*shm,int tab_off,int segp_off){
  const int tid=threadIdx.x,lane=tid&63,r32=lane&31,hi=lane>>5; const int wid=__builtin_amdgcn_readfirstlane(tid>>6);
  const long rowbase=(long)b*SEQ; const int q0=qb*QB;
  const bf16*Qw=Q+(rowbase+q0+wid*QBLK)*DM+h*D;
  const bf16*Kh=K+(rowbase+(long)t0*KVBLK)*DM+h*D,*Vh=V+(rowbase+(long)t0*KVBLK)*DM+h*D;
  const unsigned lds0=(unsigned)(uintptr_t)shm;
  float*wsf=(float*)(shm+LDS_WS)+wid*64;
  const bf16*ksrc=Kh+(long)lane*DM+wid*8;
  const bf16*vsrc=Vh+(long)(16*(wid&3)+(lane>>2))*DM+(wid>>2)*32+(lane&3)*8;
  const unsigned kdst=lds0+LDS_K+wid*1024, vdst=lds0+LDS_V+wid*1024;
  #define DMA_K(t,slot) glds16(ksrc+(long)(t)*KVBLK*DM,(unsigned)__builtin_amdgcn_readfirstlane(kdst+(slot)))
  #define DMA_V(t,slot) glds16(vsrc+(long)(t)*KVBLK*DM,(unsigned)__builtin_amdgcn_readfirstlane(vdst+(slot)))
  const int vb0=(int)(lds0+LDS_V)+((lane>>4)&1)*32+(lane&3)*8+(4*hi+((lane&15)>>2))*64;
  const char*Kbase=shm+LDS_K; bf16x8 kf[8];
  const lds_cptr shm3=(lds_cptr)shm; const lds_cptr kp0=shm3+LDS_K+hi*1024+r32*16; const lds_cptr vp0=shm3+LDS_V+((lane>>4)&1)*32+(lane&3)*8+(4*hi+((lane&15)>>2))*64;
  const int NT=(q0+QB)/KVBLK-t0;
  const __attribute__((address_space(3))) float* tab3=(const __attribute__((address_space(3))) float*)(shm3+tab_off);
  { int tl_=threadIdx.x; asm volatile("":"+v"(tl_));
    float*tabw=(float*)(shm+tab_off); const float*segp=(const float*)(shm+segp_off); const float L2E=1.4426950408889634f;
    const float*cg=cumT+((long)(b*NHEAD+h))*SEQ; const float cref=(cg[q0]+segp[q0>>7])*L2E;
    for(int i=tl_;i<NT*KVBLK;i+=NW*64){ const int kv=t0*KVBLK+i; tabw[i]=(cg[kv]+segp[kv>>7])*L2E-cref; }
    asm volatile("s_waitcnt vmcnt(0) lgkmcnt(0)\n\ts_barrier":::"memory"); }
  DMA_K(0,0);DMA_V(0,0);DMA_K(1,SLOTB);
  bf16x8 qr[4];
  #pragma unroll
  for(int d0=0;d0<4;++d0)qr[d0]=*reinterpret_cast<const bf16x8*>(&Qw[(long)r32*DM+d0*16+hi*8]);
  float mhat=0.f,l_reg=0.f;f32x16 o[2];o[0]=f32x16{};o[1]=f32x16{};
  const int qrel=wid*QBLK+r32;
  #define CMASK(P0,P1,t) do{int jb_=(t)-(NT-4); if(jb_>=0)cmask(P0,P1,jb_,qrel,hi);}while(0)
  bool resc=false;
  #define START(P0,P1) do{ const float rm=rowmax(P0,P1); resc=false; \
    { const float dl=rm; mhat=fadd_s(mhat,dl); \
      _Pragma("unroll") for(int r=0;r<16;++r){P0[r]=fsub_s(P0[r],dl);P1[r]=fsub_s(P1[r],dl);} \
      } \
    _Pragma("unroll") for(int r=0;r<16;++r)P0[r]=__builtin_amdgcn_exp2f(P0[r]); }while(0)
  #define RESC() do{ if(resc){ asm volatile("s_waitcnt lgkmcnt(0)":::"memory"); \
      _Pragma("unroll") for(int d_=0;d_<2;++d_) _Pragma("unroll") for(int r=0;r<16;++r)o[d_][r]*=wsf[crow(r,hi)]; } }while(0)
  f32x16 pA0,pA1,pB0,pB1;
  int sl_prev=0,sl_cur=0,sl_next=SLOTB;
  #define ROT() do{sl_prev=sl_cur;sl_cur=sl_next;sl_next=(sl_next==(NSLOT-1)*SLOTB)?0:sl_next+SLOTB;}while(0)
  DMA_K(2,2*SLOTB);
  WAIT_BAR(3);
  NEXTB(pA0,pA1,0);
  qkt(pA0,pA1,Kbase,qr,r32,hi);asm volatile("s_nop 15\n\ts_nop 7":"+v"(pA0),"+v"(pA1));CMASK(pA0,pA1,0);
  START(pA0,pA1);
  NEXTB(pB0,pB1,1);
  _Pragma("unroll") for(int r=0;r<16;++r)pA1[r]=__builtin_amdgcn_exp2f(pA1[r]);
  WAIT_BAR(0);
  DMA_K(3,0);DMA_V(1,SLOTB);
  ROT();
  kload8(kf,kp0+sl_cur);
  WAIT_BAR(2);
  s16x4 vlo[8],vhi[8]; u32x4 pw0,pw1,pw2,pw3;
  #define PKW(P,B) cvtpk_s(P[B],P[B+1])
  #define PAF(k) __builtin_bit_cast(bf16x8,pw##k)
  #define VFR(i) (bf16x8){vlo[i][0],vlo[i][1],vlo[i][2],vlo[i][3],vhi[i][0],vhi[i][1],vhi[i][2],vhi[i][3]}
  #define PIN(x) asm volatile("":"+v"(x))
  #define MX3(a,b,c) __builtin_fmaxf(__builtin_fmaxf((a),(b)),(c))
  #define GAPA(MF,A0,A1,A2,A3,W0,W1,PW) do{ MF; sacc+=A0; sacc+=A1; sacc+=A2; sacc+=A3; PIN(sacc); W0; W1; PIN(PW); SBAR(); }while(0)
  #define EX(v) __builtin_amdgcn_exp2f(v)
  #define GAPB(MF,X,B) do{ MF; X[B]=EX(X[B]); X[B+1]=EX(X[B+1]); X[B+2]=EX(X[B+2]); X[B+3]=EX(X[B+3]); PIN(X); SBAR(); }while(0)
  #define VRD(i) do{ vlo[i]=vtr(vp_+(((i)>>2)*4096+((i)&3)*1024)); vhi[i]=vtr(vp_+(((i)>>2)*4096+((i)&3)*1024+512)); }while(0)
  #define KRD(G,j) do{ if(G){ kload2(kf,kp0+sl_next,j); SBAR(); } }while(0)
  #define STEP(C0,C1,P0,P1,t,GK,GV,GL) do{ SBAR(); \
    const lds_cptr vp_=vp0+sl_prev; \
    VRD(0); SBAR(); float sacc=(P0[0]+P0[1]); \
    GAPA(C0=__builtin_amdgcn_mfma_f32_32x32x16_bf16(kf[0],qr[0],C0,0,0,0), P0[2],P0[3],P0[4],P0[5],     pw0[0]=PKW(P0,0), pw0[1]=PKW(P0,2), pw0); \
    VRD(4); SBAR(); GAPA(C1=__builtin_amdgcn_mfma_f32_32x32x16_bf16(kf[1],qr[0],C1,0,0,0), P0[6],P0[7],P0[8],P0[9],     pw0[2]=PKW(P0,4), pw0[3]=PKW(P0,6), pw0); \
    VRD(1); SBAR(); GAPA(C0=__builtin_amdgcn_mfma_f32_32x32x16_bf16(kf[2],qr[1],C0,0,0,0),   P0[10],P0[11],P0[12],P0[13], pw1[0]=PKW(P0,8), pw1[1]=PKW(P0,10), pw1); \
    VRD(5); SBAR(); GAPA(C1=__builtin_amdgcn_mfma_f32_32x32x16_bf16(kf[3],qr[1],C1,0,0,0),   P0[14],P0[15],P1[0],P1[1],   pw1[2]=PKW(P0,12),pw1[3]=PKW(P0,14), pw1); \
    VRD(2); SBAR(); GAPA(C0=__builtin_amdgcn_mfma_f32_32x32x16_bf16(kf[4],qr[2],C0,0,0,0),   P1[2],P1[3],P1[4],P1[5],     pw2[0]=PKW(P1,0), pw2[1]=PKW(P1,2), pw2); \
    VRD(6); SBAR(); GAPA(C1=__builtin_amdgcn_mfma_f32_32x32x16_bf16(kf[5],qr[2],C1,0,0,0),   P1[6],P1[7],P1[8],P1[9],     pw2[2]=PKW(P1,4), pw2[3]=PKW(P1,6), pw2); \
    VRD(3); SBAR(); GAPA(C0=__builtin_amdgcn_mfma_f32_32x32x16_bf16(kf[6],qr[3],C0,0,0,0),   P1[10],P1[11],P1[12],P1[13], pw3[0]=PKW(P1,8), pw3[1]=PKW(P1,10), pw3); \
    VRD(7); SBAR(); GAPA(C1=__builtin_amdgcn_mfma_f32_32x32x16_bf16(kf[7],qr[3],C1,0,0,0),   P1[14],P1[15],0.f,0.f,       pw3[2]=PKW(P1,12),pw3[3]=PKW(P1,14), pw3); \
    l_reg+=sacc; \
    if(GK){DMA_K((t)+3,sl_cur);} if(GV){DMA_V((t)+1,sl_next);} \
    CMASK(C0,C1,t); \
    { float a=MX3(C0[0],C0[1],C1[0]),b=MX3(C0[2],C0[3],C1[1]); a=MX3(a,C1[2],C1[3]); \
      _Pragma("unroll") for(int r=4;r<16;r+=4){a=MX3(a,C0[r],C0[r+1]);b=MX3(b,C0[r+2],C0[r+3]);a=MX3(a,C1[r],C1[r+1]);b=MX3(b,C1[r+2],C1[r+3]);} \
      float rm=__builtin_fmaxf(a,b); { auto rr=__builtin_amdgcn_permlane32_swap(__float_as_uint(rm),__float_as_uint(rm),false,false); rm=__builtin_fmaxf(__uint_as_float(rr[0]),__uint_as_float(rr[1])); } \
      resc=false; \
      if(__builtin_expect(__any(rm>(float)THRL),0)){ const float dl=__builtin_fmaxf(rm,0.f); mhat+=dl; \
        _Pragma("unroll") for(int r=0;r<16;++r){C0[r]-=dl;C1[r]-=dl;} \
        const float f=__builtin_amdgcn_exp2f(-dl); l_reg*=f; if(hi==0)wsf[r32]=f; resc=true; } } \
    if(GL){NEXTB(P0,P1,(t)+1);} \
    SBAR(); \
    GAPB(o[0]=__builtin_amdgcn_mfma_f32_32x32x16_bf16(PAF(0),VFR(0),o[0],0,0,0), C0,0); \
    GAPB(o[1]=__builtin_amdgcn_mfma_f32_32x32x16_bf16(PAF(0),VFR(4),o[1],0,0,0), C0,4); \
    KRD(GL,0); GAPB(o[0]=__builtin_amdgcn_mfma_f32_32x32x16_bf16(PAF(1),VFR(1),o[0],0,0,0), C0,8); \
    KRD(GL,1); GAPB(o[1]=__builtin_amdgcn_mfma_f32_32x32x16_bf16(PAF(1),VFR(5),o[1],0,0,0), C0,12); \
    KRD(GL,2); GAPB(o[0]=__builtin_amdgcn_mfma_f32_32x32x16_bf16(PAF(2),VFR(2),o[0],0,0,0), C1,0); \
    KRD(GL,3); GAPB(o[1]=__builtin_amdgcn_mfma_f32_32x32x16_bf16(PAF(2),VFR(6),o[1],0,0,0), C1,4); \
    GAPB(o[0]=__builtin_amdgcn_mfma_f32_32x32x16_bf16(PAF(3),VFR(3),o[0],0,0,0), C1,8); \
    GAPB(o[1]=__builtin_amdgcn_mfma_f32_32x32x16_bf16(PAF(3),VFR(7),o[1],0,0,0), C1,12); \
    }while(0)
  int t=1;
  #undef CMASK
  #define CMASK(P0,P1,t) do{}while(0)
  for(;t+5<NT;t+=2){
    STEP(pB0,pB1,pA0,pA1,t,true,true,true);     WAIT_BAR(2); RESC(); ROT();
    STEP(pA0,pA1,pB0,pB1,t+1,true,true,true);   WAIT_BAR(2); RESC(); ROT();
  }
  #undef CMASK
  #define CMASK(P0,P1,t) do{int jb_=(t)-(NT-4); if(jb_>=0)cmask(P0,P1,jb_,qrel,hi);}while(0)
  #define ENDW(tt) do{ if((tt)+3<NT){WAIT_BAR(2);} else if((tt)+2<NT){WAIT_BAR(1);} else {WAIT_BAR(0);} }while(0)
  for(;t+1<NT;t+=2){
    STEP(pB0,pB1,pA0,pA1,t,(t+3<NT),(t+1<NT),(t+1<NT));       ENDW(t);   RESC(); ROT();
    STEP(pA0,pA1,pB0,pB1,t+1,(t+4<NT),(t+2<NT),(t+2<NT));     ENDW(t+1); RESC(); ROT();
  }
  STEP(pB0,pB1,pA0,pA1,NT-1,false,false,false); RESC();
  { float sacc=pB0[0]+pB0[1]; _Pragma("unroll") for(int r=2;r<16;++r)sacc+=pB0[r]; _Pragma("unroll") for(int r=0;r<16;++r)sacc+=pB1[r]; l_reg+=sacc;
    pw0=(u32x4){PKW(pB0,0),PKW(pB0,2),PKW(pB0,4),PKW(pB0,6)};pw1=(u32x4){PKW(pB0,8),PKW(pB0,10),PKW(pB0,12),PKW(pB0,14)};pw2=(u32x4){PKW(pB1,0),PKW(pB1,2),PKW(pB1,4),PKW(pB1,6)};pw3=(u32x4){PKW(pB1,8),PKW(pB1,10),PKW(pB1,12),PKW(pB1,14)};
    SBAR(); pv(o,vb0+sl_cur,PAF(0),PAF(1),PAF(2),PAF(3)); }
  #undef PKW
  #undef PAF
  #undef VFR
  #undef PIN
  #undef MX3
  #undef GAPA
  #undef GAPB
  #undef EX
  #undef VRD
  #undef KRD
  #undef STEP
  #undef ENDW
  {auto rr=__builtin_amdgcn_permlane32_swap(__float_as_uint(l_reg),__float_as_uint(l_reg),false,false);l_reg=__uint_as_float(rr[0])+__uint_as_float(rr[1]);}
  if(hi==0)wsf[32+r32]=l_reg;asm volatile("s_waitcnt lgkmcnt(0)":::"memory");
  float rli[16];
  #pragma unroll
  for(int r=0;r<16;++r)rli[r]=__builtin_amdgcn_rcpf(wsf[32+crow(r,hi)]);
  bf16*Ow=O+(rowbase+q0+wid*QBLK)*DM+h*D;
  { bf16*stg=(bf16*)(shm+LDS_OST)+wid*2048;
    #pragma unroll
    for(int r=0;r<16;++r){const int orow=crow(r,hi);
      #pragma unroll
      for(int d0=0;d0<2;++d0)stg[orow*64+d0*32+r32]=__float2bfloat16(o[d0][r]*rli[r]);}
    asm volatile("s_waitcnt lgkmcnt(0)":::"memory");
    #pragma unroll
    for(int i=0;i<4;++i){const int row=i*8+(lane>>3),ch=lane&7; const u32x4 v=*(const u32x4*)(stg+row*64+ch*8); ATTN_STORE16(Ow+(long)row*DM+ch*8,v);} }
  asm volatile("s_waitcnt lgkmcnt(0)\n\ts_barrier":::"memory");
  #undef DMA_K
  #undef DMA_V
  #undef CMASK
  #undef START
  #undef RESC
  #undef ROT
}
constexpr int ATTN_LDS_BYTES=LDS_BYTES;
struct AttnTensors { const bf16* Q; const bf16* K; const bf16* V; bf16* O; const float* cumT; const float* segtot; };
struct AttnUnit { int bh; int qb; };
struct StaticOrder {
  int vcu;
  __device__ __forceinline__ explicit StaticOrder(int grid,int block):vcu((block%8)*(grid/8)+block/8){}
  __device__ __forceinline__ bool next(int i,AttnUnit&u)const{ if(i>=4||vcu>=256)return false; const int s=vcu&15; u.bh=vcu>>4; u.qb=(i==0)?63-s:(i==1)?32+s:(i==2)?31-s:s; return true; }
  __device__ __forceinline__ void a_ready(const AttnUnit&)const{}
  __device__ __forceinline__ void done(const AttnUnit&)const{}
};
template<class Sched,int THRL=8> __device__ __forceinline__ void attn_phase(char*lds,const AttnTensors&T,const Sched&S,int tab_off,int segp_off){
  AttnUnit u;
  int last_bh=-1;
  for(int i=0;S.next(i,u);++i){ S.a_ready(u);
    if(u.bh!=last_bh){ last_bh=u.bh; float*tmp=(float*)(lds+tab_off); float*segp=(float*)(lds+segp_off); int tid=threadIdx.x; asm volatile("":"+v"(tid)); const int b=u.bh/NHEAD,h=u.bh%NHEAD;
      __syncthreads(); if(tid<128)tmp[tid]=T.segtot[(b*128+tid)*NHEAD+h]; __syncthreads();
      if(tid<128){float a=0.f; for(int s=0;s<tid;++s)a+=tmp[s]; segp[tid]=a;} __syncthreads(); }
    attn_unit<THRL>(u.bh/NHEAD,u.bh%NHEAD,u.qb,0,T.Q,T.K,T.V,T.O,T.cumT,lds,tab_off,segp_off); S.done(u); }
}
#undef SBAR
#undef WAIT_BAR
}
#define GAS __attribute__((address_space(1)))
#define LAS __attribute__((address_space(3)))
typedef unsigned short bf16;
typedef unsigned v4u __attribute__((ext_vector_type(4)));
typedef float f32x4 __attribute__((ext_vector_type(4)));
typedef short bf16x8 __attribute__((ext_vector_type(8)));
typedef GAS unsigned gu32;
typedef GAS unsigned long long gu64;
#define RLX_AGENT __ATOMIC_RELAXED, __HIP_MEMORY_SCOPE_AGENT
#define LDS_WAIT() asm volatile("s_waitcnt lgkmcnt(0)" ::: "memory")
#define VM_WAIT() asm volatile("s_waitcnt vmcnt(0)" ::: "memory")
__device__ __forceinline__ unsigned long long rt() { return __builtin_amdgcn_s_memrealtime(); }
__device__ __forceinline__ unsigned f2bf(float f) { unsigned u = __builtin_bit_cast(unsigned, f); return (u + 0x7fffu + ((u >> 16) & 1u)) >> 16; }
__device__ __forceinline__ unsigned pk2(float lo, float hi) { return f2bf(lo) | (f2bf(hi) << 16); }

#define XB_TMO      128
#define XB_XCNT(j)  (256  + 64 * (j))
#define XB_XSUB(j)  (1280 + 64 * (j))
#define XB_XGEN(j)  (2304 + 64 * (j))
#define XB_TOP      3328
#define XB_TOPGEN   3392
#define XCD_BAR_WORDS 3456
#define XB_SPIN_CAP (1u << 18)

__device__ __forceinline__ unsigned xb_ld(unsigned* p)              { return __hip_atomic_load(p, __ATOMIC_RELAXED, __HIP_MEMORY_SCOPE_AGENT); }
__device__ __forceinline__ unsigned xb_add(unsigned* p, unsigned v) { return __hip_atomic_fetch_add(p, v, __ATOMIC_RELAXED, __HIP_MEMORY_SCOPE_AGENT); }
__device__ __forceinline__ unsigned xb_xcc_id() { return (unsigned)__builtin_amdgcn_s_getreg((3 << 11) | 20) & 0xFu; }
#define XB_SPIN(cond, bar) do { unsigned _sp = 0; while (cond) { __builtin_amdgcn_s_sleep(1); \
    if ((++_sp & 255u) == 0u) { if (xb_ld(&(bar)[XB_TMO])) break; if (_sp > XB_SPIN_CAP) { atomicAdd(&(bar)[XB_TMO], 1u); break; } } } } while (0)

struct XcdBarrier {
    unsigned* bar; unsigned x;
    volatile LAS unsigned* st;
};

__device__ __forceinline__ XcdBarrier xcd_barrier_post(unsigned* bar, volatile LAS unsigned* st) {
    XcdBarrier b; b.bar = bar; b.x = xb_xcc_id(); b.st = st;
    if (threadIdx.x == 0) (void)xb_add(&bar[XB_XCNT(b.x)], 1u);
    return b;
}
__device__ __forceinline__ void xcd_barrier_complete(unsigned* bar, unsigned x, unsigned& nloc, unsigned& nx) {
    const unsigned G = gridDim.x * gridDim.y * gridDim.z;
    unsigned sum, cnt, mine, sp = 0u;
    for (;;) {
        sum = 0u; cnt = 0u; mine = 0u;
#pragma unroll
        for (unsigned j = 0; j < 16; ++j) { const unsigned c = xb_ld(&bar[XB_XCNT(j)]); sum += c; cnt += (c > 0u) ? 1u : 0u; mine = (j == x) ? c : mine; }
        if (sum == G) break;
        __builtin_amdgcn_s_sleep(1);
        if ((++sp & 255u) == 0u) { if (xb_ld(&bar[XB_TMO])) break; if (sp > XB_SPIN_CAP) { atomicAdd(&bar[XB_TMO], 1u); break; } }
    }
    nloc = mine > 0u ? mine : 1u; nx = cnt > 0u ? cnt : 1u;
}

__device__ __forceinline__ void xcd_barrier(const XcdBarrier& b) {
    asm volatile("s_waitcnt vmcnt(0)" ::: "memory");
    __syncthreads();
    if (threadIdx.x == 0) {
        unsigned* bar = b.bar;
        __builtin_amdgcn_s_waitcnt(0);
        unsigned nloc = b.st[0], nx = b.st[1];
        if (nloc == 0u) { xcd_barrier_complete(bar, b.x, nloc, nx); b.st[0] = nloc; b.st[1] = nx; }
        const unsigned old = xb_add(&bar[XB_XSUB(b.x)], 1u);
        const unsigned gen = old / nloc;
        if (old + 1u == (gen + 1u) * nloc) {
            __builtin_amdgcn_fence(__ATOMIC_RELEASE, "agent");
            asm volatile("s_waitcnt vmcnt(0)" ::: "memory");
            const unsigned og = xb_add(&bar[XB_TOP], 1u);
            const unsigned tg = og / nx;
            if (og + 1u == (tg + 1u) * nx) xb_add(&bar[XB_TOPGEN], 1u);
            else XB_SPIN(xb_ld(&bar[XB_TOPGEN]) == tg, bar);
            __builtin_amdgcn_fence(__ATOMIC_ACQUIRE, "agent");
            xb_add(&bar[XB_XGEN(b.x)], 1u);
            asm volatile("s_waitcnt vmcnt(0)" ::: "memory");
        } else {
            XB_SPIN(xb_ld(&bar[XB_XGEN(b.x)]) == gen, bar);
            __builtin_amdgcn_fence(__ATOMIC_ACQUIRE, "agent");
            asm volatile("s_waitcnt vmcnt(0)" ::: "memory");
        }
    }
    __syncthreads();
}

constexpr int NWAVES = 8;
constexpr int BATCH = 2, SEQ = 16384, D = 1024, M = BATCH * SEQ;
constexpr int FH = 8, FW = 512, RWW = 512, SHW = 1792, DIN = 5384, NIN = 5376;
constexpr int NE = 32, DE = 512, NROUTE = 36;
constexpr int MAXSLOT = 2 * M + NE * 256;
constexpr int MAXTILE = MAXSLOT / 256;
constexpr float ATT_C2 = 0.125f * 1.4426950408889634f;

constexpr size_t MiB = 1u << 20;
constexpr size_t WS_CTL = 0, CTL_ZERO_BYTES = 1 * MiB;
constexpr size_t WS_MOD = 1 * MiB;
constexpr size_t WS_SEGTOT = 1 * MiB + 64 * 1024;
constexpr size_t WS_BLKCNT = 1 * MiB + 96 * 1024;
constexpr size_t WS_WIN = 2 * MiB;
constexpr size_t WS_WOF = 13 * MiB, WS_WOR = 14 * MiB, WS_WO = 15 * MiB;
constexpr size_t WS_LW2 = 17 * MiB, WS_LA2 = 17 * MiB + 64 * 1024, WS_LG2 = 17 * MiB + 128 * 1024;
constexpr size_t WS_CUM = 18 * MiB;
constexpr size_t WS_ROUTE = 19 * MiB;
constexpr size_t WS_ROWTOK = 20 * MiB;
constexpr size_t WS_BON = 21 * MiB;
constexpr size_t WS_XN = 24 * MiB;
constexpr size_t WS_Q = 88 * MiB, WS_K = 120 * MiB, WS_V = 152 * MiB;
constexpr size_t WS_PRW = 184 * MiB;
constexpr size_t WS_GATES = 296 * MiB;
constexpr size_t WS_F = 424 * MiB;
constexpr size_t WS_END = 512 * MiB;
constexpr size_t WS_Y = WS_K;
constexpr size_t WS_H = WS_Q;
constexpr size_t WS_W13 = WS_PRW, WS_W2T = WS_PRW + 64 * MiB;
constexpr size_t WS_TMP = WS_PRW;
constexpr size_t WS_YM = WS_GATES;
static_assert(WS_YM + (size_t)MAXSLOT * 1024 * 2 <= WS_END, "ws map");
static_assert(WS_H + (size_t)MAXSLOT * 512 * 2 <= WS_PRW, "ws map");
constexpr int CW_TMO = 0, CW_CODE = 1;
constexpr int CW_BAR = 4096;

constexpr int RING_OFF = 0, RING_BYTES = 131072;
constexpr int TAB_OFF = 83968;
constexpr int SEGP_OFF = TAB_OFF + 65536;
constexpr int TILE_OFF = 131072;
constexpr int LDSCTL_OFF = SEGP_OFF + 512, MISC_OFF = LDSCTL_OFF + 320;
constexpr int LDS_BYTES = LDSCTL_OFF + 512;
static_assert(attn_body::LDS_BYTES <= TAB_OFF, "attention LDS");


#define PHASE_IDS() int tid_ = threadIdx.x; asm volatile("" : "+v"(tid_)); const int lane_ = tid_ & 63; const int wave_ = __builtin_amdgcn_readfirstlane(tid_ >> 6); (void)lane_; (void)wave_
struct Frame {
    LAS unsigned char* lds;
    volatile LAS unsigned* MISC;
    gu32* ctl;
    int tid, lane, wave;
    int vcu, G;
    const float* const* in;
};
__device__ __forceinline__ float wave_sum(float v) {
#pragma unroll
    for (int o = 1; o < 64; o <<= 1) v += __shfl_xor(v, o);
    return v;
}
__device__ __forceinline__ float bflo(unsigned w) { return __uint_as_float(w << 16); }
__device__ __forceinline__ float bfhi(unsigned w) { return __uint_as_float(w & 0xffff0000u); }
__device__ __forceinline__ float sigm(float x) { return 1.0f / (1.0f + __expf(-x)); }

__device__ __forceinline__ void transpose_item(const float* W, int ld, int col, int k0, int K, bf16* WT, size_t drow, LAS float* scr, int lane) {
#pragma unroll 8
    for (int i = 0; i < 32; ++i) { const int kk = 2 * i + (lane >> 5); scr[kk * 33 + (lane & 31)] = W[(size_t)(k0 + kk) * ld + col + (lane & 31)]; }
    LDS_WAIT(); asm volatile("" ::: "memory");
    const int c = lane & 7;
#pragma unroll
    for (int j = 0; j < 4; ++j) { const int n = (lane >> 3) + 8 * j; const LAS float* s = scr + (8 * c) * 33 + n;
        v4u o; o.x = pk2(s[0 * 33], s[1 * 33]); o.y = pk2(s[2 * 33], s[3 * 33]); o.z = pk2(s[4 * 33], s[5 * 33]); o.w = pk2(s[6 * 33], s[7 * 33]);
        *(GAS v4u*)(WT + (drow + n) * K + k0 + 8 * c) = o; }
    LDS_WAIT(); asm volatile("" ::: "memory");
}
__device__ __forceinline__ void conv_seg(Frame& F, const float* W, int ld, int col0, int K, int ncols, bf16* WT, size_t drow0) {
    PHASE_IDS();
    LAS float* scr = (LAS float*)(F.lds + RING_OFF + wave_ * 16384);
    const int gw = F.vcu * NWAVES + wave_, NGW = F.G * NWAVES, nkb = K / 64, nnb = ncols / 32;
    for (int it = gw; it < nkb * nnb; it += NGW) { const int kb = it / nnb, nb = it % nnb; transpose_item(W, ld, col0 + 32 * nb, 64 * kb, K, WT, drow0 + 32 * nb, scr, lane_); }
}

struct Args { const float* in[30]; float* out; unsigned char* ws; };

__device__ __forceinline__ void p0_prologue(Frame& F, const Args& A) {
    PHASE_IDS();
    unsigned char* ws = A.ws;
    if (blockIdx.x < 96) {
        const float* c = A.in[1]; const float* aw = A.in[2]; const float* ab = A.in[3];
        const int col = blockIdx.x * 64 + lane_; float a0 = 0.f, a1 = 0.f;
        const int kbeg = wave_ * 128;
#pragma unroll 8
        for (int k = kbeg; k < kbeg + 128; ++k) { const float wv = aw[(size_t)k * 6144 + col]; const float c0 = c[k], c1 = c[1024 + k];
            a0 += c0 * sigm(c0) * wv; a1 += c1 * sigm(c1) * wv; }
        LAS float* red = (LAS float*)(F.lds + 8 * 16384 - 4096);
        red[(wave_ * 2 + 0) * 64 + lane_] = a0; red[(wave_ * 2 + 1) * 64 + lane_] = a1;
        __syncthreads();
        if (wave_ < 2) { float s = 0.f;
#pragma unroll
            for (int w = 0; w < 8; ++w) s += red[(w * 2 + wave_) * 64 + lane_];
            ((float*)(ws + WS_MOD))[wave_ * 6144 + col] = s + ab[col]; }
        __syncthreads();
    }
    const float* w_in = A.in[5];
    conv_seg(F, w_in, DIN, 0, 1024, 1536, (bf16*)(ws + WS_WIN), 0);
    conv_seg(F, w_in, DIN, 1544, 1024, 1792, (bf16*)(ws + WS_WIN), 1536);
    conv_seg(F, w_in, DIN, 3336, 1024, 2048, (bf16*)(ws + WS_WIN), 3328);
    conv_seg(F, A.in[18], 1024, 0, 512, 1024, (bf16*)(ws + WS_WOF), 0);
    conv_seg(F, A.in[19], 1024, 0, 512, 1024, (bf16*)(ws + WS_WOR), 0);
    conv_seg(F, A.in[20], 1024, 0, 1024, 1024, (bf16*)(ws + WS_WO), 0);
    conv_seg(F, A.in[9], 512, 0, 64, 512, (bf16*)(ws + WS_LW2), 0);
    conv_seg(F, A.in[11], 512, 0, 64, 512, (bf16*)(ws + WS_LA2), 0);
    conv_seg(F, A.in[12], 512, 0, 128, 512, (bf16*)(ws + WS_LG2), 0);
}

__device__ __forceinline__ void p1_norm(Frame& F, const Args& A) {
    PHASE_IDS();
    unsigned char* ws = A.ws;
    LAS float* wf = (LAS float*)(F.lds);
    LAS float* lfl = (LAS float*)(F.lds + 32768);
    LAS float* part = (LAS float*)(F.lds + 32768 + 4096);
    const float* x = A.in[0]; const float* g1 = A.in[4]; const float* w_in = A.in[5]; const float* fb = A.in[6];
    const float* mod = (const float*)(ws + WS_MOD);
    bf16* XN = (bf16*)(ws + WS_XN); float* cumT = (float*)(ws + WS_CUM); float* segtot = (float*)(ws + WS_SEGTOT);
    for (int i = tid_; i < 8192; i += NWAVES * 64) wf[(i & 7) * 1024 + (i >> 3)] = w_in[(size_t)(i >> 3) * DIN + 1536 + (i & 7)];
    __syncthreads();
    for (int blk = blockIdx.x; blk < M / 128; blk += F.G) {
        const int b = blk / (SEQ / 128);
        f32x4 gm[4], sh[4];
#pragma unroll
        for (int j = 0; j < 4; ++j) { const int col = 4 * lane_ + 256 * j; const f32x4 g = *(const f32x4*)(g1 + col), sc = *(const f32x4*)(mod + b * 6144 + 1024 + col);
            gm[j] = g * (sc + 1.0f); sh[j] = *(const f32x4*)(mod + b * 6144 + col); }
        float fbv = fb[lane_ & 7];
        for (int i = 0; i < 16; ++i) {
            const int tl = wave_ * 16 + i; const size_t tok = (size_t)blk * 128 + tl;
            const GAS f32x4* xr = (const GAS f32x4*)(x + tok * D) + lane_;
            f32x4 v[4]; float s = 0.f;
#pragma unroll
            for (int j = 0; j < 4; ++j) { v[j] = xr[64 * j]; s += (v[j].x * v[j].x + v[j].y * v[j].y) + (v[j].z * v[j].z + v[j].w * v[j].w); }
            const float rstd = 1.0f / sqrtf(wave_sum(s) * (1.f / D) + 1e-6f);
            GAS unsigned long long* o8 = (GAS unsigned long long*)(XN + tok * D) + lane_;
            float f[8];
#pragma unroll
            for (int hh = 0; hh < 8; ++hh) f[hh] = 0.f;
#pragma unroll
            for (int j = 0; j < 4; ++j) { v[j] = v[j] * rstd * gm[j] + sh[j];
                o8[64 * j] = (unsigned long long)pk2(v[j].x, v[j].y) | ((unsigned long long)pk2(v[j].z, v[j].w) << 32);
#pragma unroll
                for (int hh = 0; hh < 8; ++hh) { const f32x4 w4 = *(const LAS f32x4*)(wf + hh * 1024 + 4 * lane_ + 256 * j); f[hh] += (v[j].x * w4.x + v[j].y * w4.y) + (v[j].z * w4.z + v[j].w * w4.w); } }
#pragma unroll
            for (int hh = 0; hh < 8; ++hh) f[hh] = wave_sum(f[hh]);
            const int l7 = lane_ & 7;
            float z = (l7 == 0) ? f[0] : (l7 == 1) ? f[1] : (l7 == 2) ? f[2] : (l7 == 3) ? f[3] : (l7 == 4) ? f[4] : (l7 == 5) ? f[5] : (l7 == 6) ? f[6] : f[7];
            z += fbv;
            const float lf = (z >= 0.f) ? -log1pf(__expf(-z)) : z - log1pf(__expf(z));
            if (lane_ < 8) lfl[tl * 8 + lane_] = lf;
        }
        __syncthreads();
        const int hh = tid_ & 7, p = tid_ >> 3;
        if (tid_ < 64) { float run = 0.f; for (int i = 0; i < 16; ++i) { run += lfl[(p * 16 + i) * 8 + hh]; lfl[(p * 16 + i) * 8 + hh] = run; } part[p * 8 + hh] = run; }
        __syncthreads();
        if (tid_ < 64) { float off = 0.f; for (int q = 0; q < p; ++q) off += part[q * 8 + hh];
            const int t0 = (blk % (SEQ / 128)) * 128 + p * 16; float* dst = cumT + ((size_t)(b * 8 + hh)) * SEQ + t0;
            for (int i = 0; i < 16; ++i) dst[i] = lfl[(p * 16 + i) * 8 + hh] + off;
            if (p == 7) segtot[blk * 8 + hh] = off + part[7 * 8 + hh]; }
        __syncthreads();
    }
}

template <int WITH_MOE>
__device__ __forceinline__ void p_final(Frame& F, const Args& A, const float* src) {
    PHASE_IDS();
    unsigned char* ws = A.ws; const float* fg = A.in[29]; const float* mod = (const float*)(ws + WS_MOD);
    const int* route = (const int*)(ws + WS_ROUTE); const bf16* Y = (const bf16*)(ws + WS_YM);
    f32x4 fgv[4];
#pragma unroll
    for (int j = 0; j < 4; ++j) fgv[j] = *(const f32x4*)(fg + 4 * lane_ + 256 * j);
    const int gw = F.vcu * NWAVES + wave_, NGW = F.G * NWAVES;
    for (int m = gw; m < M; m += NGW) {
        const GAS f32x4* xr = (const GAS f32x4*)(src + (size_t)m * D) + lane_;
        f32x4 v[4]; float s = 0.f;
#pragma unroll
        for (int j = 0; j < 4; ++j) v[j] = xr[64 * j];
        if (WITH_MOE) {
            const int b = m / SEQ; const int* rt_ = route + (size_t)m * 8;
            const float w0 = __int_as_float(rt_[2]), w1 = __int_as_float(rt_[3]); const int s0 = rt_[6], s1 = rt_[7];
            const GAS unsigned long long* y0 = (const GAS unsigned long long*)(Y + (size_t)s0 * D) + lane_; const GAS unsigned long long* y1 = (const GAS unsigned long long*)(Y + (size_t)s1 * D) + lane_;
#pragma unroll
            for (int j = 0; j < 4; ++j) { const unsigned long long a = y0[64 * j], c = y1[64 * j]; const f32x4 g2 = *(const f32x4*)(mod + b * 6144 + 5120 + 4 * lane_ + 256 * j);
                const unsigned al = (unsigned)a, ah = (unsigned)(a >> 32), cl = (unsigned)c, ch = (unsigned)(c >> 32);
                f32x4 y; y.x = w0 * bflo(al) + w1 * bflo(cl); y.y = w0 * bfhi(al) + w1 * bfhi(cl); y.z = w0 * bflo(ah) + w1 * bflo(ch); y.w = w0 * bfhi(ah) + w1 * bfhi(ch);
                v[j] = v[j] + g2 * y; }
        }
#pragma unroll
        for (int j = 0; j < 4; ++j) s += (v[j].x * v[j].x + v[j].y * v[j].y) + (v[j].z * v[j].z + v[j].w * v[j].w);
        const float rstd = 1.0f / sqrtf(wave_sum(s) * (1.f / D) + 1e-6f);
        GAS f32x4* o = (GAS f32x4*)(A.out + (size_t)m * D) + lane_;
#pragma unroll
        for (int j = 0; j < 4; ++j) o[64 * j] = v[j] * rstd * fgv[j];
    }
}

typedef float f32x16 __attribute__((ext_vector_type(16)));
typedef unsigned u32x2 __attribute__((ext_vector_type(2)));
__device__ __forceinline__ f32x4 shift4(const bf16* p, bool has_prev, const float* mu) {
    const u32x2 c = *(const u32x2*)p; u32x2 q = {0u, 0u}; if (has_prev) q = *(const u32x2*)(p - SHW);
    const f32x4 m = *(const f32x4*)mu;
    f32x4 cv = {bflo(c.x), bfhi(c.x), bflo(c.y), bfhi(c.y)}, pv = {bflo(q.x), bfhi(q.x), bflo(q.y), bfhi(q.y)};
    return cv + (pv - cv) * m;
}
__device__ __forceinline__ u32x2 pack4(f32x4 v) { u32x2 r; r.x = pk2(v.x, v.y); r.y = pk2(v.z, v.w); return r; }

__device__ __forceinline__ void rwkv_pre(Frame& F, const Args& A) {
    PHASE_IDS();
    unsigned char* ws = A.ws;
    const bf16* PRW = (const bf16*)(ws + WS_PRW);
    const float* mu = A.in[7]; const float* w0 = A.in[8]; const float* a0 = A.in[10]; const float* k_k = A.in[13]; const float* k_a = A.in[14]; const float* r_k = A.in[15];
    const bf16* LW2 = (const bf16*)(ws + WS_LW2); const bf16* LA2 = (const bf16*)(ws + WS_LA2); const bf16* LG2 = (const bf16*)(ws + WS_LG2);
    float* LW = (float*)A.out; bf16* R = (bf16*)((unsigned char*)A.out + 64 * MiB); bf16* KP = (bf16*)((unsigned char*)A.out + 96 * MiB);
    bf16* VV = (bf16*)(ws + WS_XN); bf16* AV = (bf16*)(ws + WS_XN + 32 * MiB); bf16* BV = (bf16*)(ws + WS_F); bf16* GG = (bf16*)(ws + WS_F + 32 * MiB);
    float* BON = (float*)(ws + WS_BON);
    LAS bf16* Xw = (LAS bf16*)(F.lds); LAS bf16* Xa = (LAS bf16*)(F.lds + 9216); LAS bf16* Xg = (LAS bf16*)(F.lds + 18432);
    const int h = wave_, c = lane_ & 31, hh = lane_ >> 5;
    for (int ci = blockIdx.x; ci < M / 64; ci += F.G) {
        __syncthreads();
        {
            const int row = tid_ >> 3, cg = tid_ & 7; const size_t tok = (size_t)ci * 64 + row; const bool hp = (tok % SEQ) != 0;
            const bf16* src = PRW + tok * SHW + 1536 + 32 * cg; const float* mup = mu + 1536 + 32 * cg;
            LAS bf16* dst = (cg < 2) ? (Xw + row * 72 + 32 * cg) : (cg < 4) ? (Xa + row * 72 + 32 * (cg - 2)) : (Xg + row * 136 + 32 * (cg - 4));
#pragma unroll
            for (int q = 0; q < 8; ++q) { f32x4 v = shift4(src + 4 * q, hp, mup + 4 * q);
                if (cg < 2) { v.x = tanhf(v.x); v.y = tanhf(v.y); v.z = tanhf(v.z); v.w = tanhf(v.w); }
                else if (cg >= 4) { v.x = sigm(v.x); v.y = sigm(v.y); v.z = sigm(v.z); v.w = sigm(v.w); }
                *(LAS u32x2*)(dst + 4 * q) = pack4(v); }
        }
        __syncthreads();
#pragma unroll 1
        for (int cb = 0; cb < 2; ++cb) {
            const size_t tok = (size_t)ci * 64 + 32 * cb + c; const bool hp = (tok % SEQ) != 0;
            const bf16* prow = PRW + tok * SHW;
            f32x16 aa[2];
            aa[0] = f32x16{}; aa[1] = f32x16{};
#pragma unroll
            for (int ks = 0; ks < 4; ++ks) { const bf16x8 bfr = *(const LAS bf16x8*)(Xa + (32 * cb + c) * 72 + 16 * ks + 8 * hh);
#pragma unroll
                for (int rb = 0; rb < 2; ++rb) { const bf16x8 afr = *(const bf16x8*)(LA2 + (size_t)(64 * h + 32 * rb + c) * 64 + 16 * ks + 8 * hh); aa[rb] = __builtin_amdgcn_mfma_f32_32x32x16_bf16(afr, bfr, aa[rb], 0, 0, 0); } }
            float kx[2][16]; float ss = 0.f;
#pragma unroll
            for (int rb = 0; rb < 2; ++rb)
#pragma unroll
                for (int q = 0; q < 4; ++q) { const int col = 64 * h + 32 * rb + 8 * q + 4 * hh;
                    const f32x4 a0v = *(const f32x4*)(a0 + col), kkv = *(const f32x4*)(k_k + col);
                    const f32x4 kv = shift4(prow + 512 + col, hp, mu + 512 + col);
#pragma unroll
                    for (int e = 0; e < 4; ++e) { aa[rb][4 * q + e] = sigm(a0v[e] + aa[rb][4 * q + e]); kx[rb][4 * q + e] = kv[e]; const float t = kv[e] * kkv[e]; ss += t * t; } }
            ss += __shfl_xor(ss, 32);
            const float inv = 1.0f / fmaxf(sqrtf(ss), 1e-12f);
            float bon = 0.f;
#pragma unroll
            for (int rb = 0; rb < 2; ++rb)
#pragma unroll
                for (int q = 0; q < 4; ++q) { const int col = 64 * h + 32 * rb + 8 * q + 4 * hh;
                    const f32x4 kkv = *(const f32x4*)(k_k + col), kav = *(const f32x4*)(k_a + col), rkv = *(const f32x4*)(r_k + col);
                    const f32x4 rv = shift4(prow + col, hp, mu + col), vv = shift4(prow + 1024 + col, hp, mu + 1024 + col);
                    f32x4 kp, av, bv;
#pragma unroll
                    for (int e = 0; e < 4; ++e) { const float a = aa[rb][4 * q + e], k = kx[rb][4 * q + e], kk = k * kkv[e] * inv;
                        kp[e] = k * (1.0f + (a - 1.0f) * kav[e]); av[e] = -kk; bv[e] = kk * a; bon += rv[e] * kp[e] * rkv[e]; }
                    const size_t o = tok * 512 + col;
                    *(u32x2*)(R + o) = pack4(rv); *(u32x2*)(KP + o) = pack4(kp); *(u32x2*)(VV + o) = pack4(vv); *(u32x2*)(AV + o) = pack4(av); *(u32x2*)(BV + o) = pack4(bv); }
            bon += __shfl_xor(bon, 32);
            if (hh == 0) BON[tok * 8 + h] = bon;
            aa[0] = f32x16{}; aa[1] = f32x16{};
#pragma unroll
            for (int ks = 0; ks < 4; ++ks) { const bf16x8 bfr = *(const LAS bf16x8*)(Xw + (32 * cb + c) * 72 + 16 * ks + 8 * hh);
#pragma unroll
                for (int rb = 0; rb < 2; ++rb) { const bf16x8 afr = *(const bf16x8*)(LW2 + (size_t)(64 * h + 32 * rb + c) * 64 + 16 * ks + 8 * hh); aa[rb] = __builtin_amdgcn_mfma_f32_32x32x16_bf16(afr, bfr, aa[rb], 0, 0, 0); } }
#pragma unroll
            for (int rb = 0; rb < 2; ++rb)
#pragma unroll
                for (int q = 0; q < 4; ++q) { const int col = 64 * h + 32 * rb + 8 * q + 4 * hh; const f32x4 w0v = *(const f32x4*)(w0 + col); f32x4 o;
#pragma unroll
                    for (int e = 0; e < 4; ++e) { const float z = -(w0v[e] + aa[rb][4 * q + e]); const float sp = fmaxf(z, 0.f) + log1pf(__expf(-fabsf(z))); o[e] = -__expf(-sp - 0.5f); }
                    *(f32x4*)(LW + tok * 512 + col) = o; }
            aa[0] = f32x16{}; aa[1] = f32x16{};
#pragma unroll
            for (int ks = 0; ks < 8; ++ks) { const bf16x8 bfr = *(const LAS bf16x8*)(Xg + (32 * cb + c) * 136 + 16 * ks + 8 * hh);
#pragma unroll
                for (int rb = 0; rb < 2; ++rb) { const bf16x8 afr = *(const bf16x8*)(LG2 + (size_t)(64 * h + 32 * rb + c) * 128 + 16 * ks + 8 * hh); aa[rb] = __builtin_amdgcn_mfma_f32_32x32x16_bf16(afr, bfr, aa[rb], 0, 0, 0); } }
#pragma unroll
            for (int rb = 0; rb < 2; ++rb)
#pragma unroll
                for (int q = 0; q < 4; ++q) { const int col = 64 * h + 32 * rb + 8 * q + 4 * hh; const f32x4 o = {aa[rb][4 * q], aa[rb][4 * q + 1], aa[rb][4 * q + 2], aa[rb][4 * q + 3]};
                    *(u32x2*)(GG + tok * 512 + col) = pack4(o); }
        }
    }
}

__device__ __forceinline__ void rwkv_scan_seq(Frame& F, const Args& A) {
    PHASE_IDS();
    if (blockIdx.x >= BATCH * 8) return;
    unsigned char* ws = A.ws;
    const float* LW = (const float*)A.out; const bf16* R = (const bf16*)((unsigned char*)A.out + 64 * MiB); const bf16* KP = (const bf16*)((unsigned char*)A.out + 96 * MiB);
    const bf16* VV = (const bf16*)(ws + WS_XN); const bf16* AV = (const bf16*)(ws + WS_XN + 32 * MiB); const bf16* BV = (const bf16*)(ws + WS_F);
    float* Y = (float*)(ws + WS_Y);
    const int b = blockIdx.x >> 3, h = blockIdx.x & 7;
    constexpr int STEPB = 896, CH = 16, BUFB = STEPB * CH;
    LAS unsigned char* buf = F.lds;
    const size_t tok0 = (size_t)b * SEQ;
    const bool loader = wave_ >= 4; const int lt = tid_ - 256;
    auto load_chunk = [&](int cidx, int slot) {
        for (int p = lt; p < CH * 56; p += 256) { const int s = p / 56, q = p % 56; const size_t tok = tok0 + (size_t)cidx * CH + s; v4u val;
            if (q < 16) val = *(const v4u*)(LW + tok * 512 + 64 * h + 4 * q);
            else { const int a = (q - 16) >> 3, o8 = (q - 16) & 7; const bf16* src = (a == 0) ? AV : (a == 1) ? BV : (a == 2) ? KP : (a == 3) ? R : VV; val = *(const v4u*)(src + tok * 512 + 64 * h + 8 * o8); }
            *(LAS v4u*)(buf + slot * BUFB + s * STEPB + q * 16) = val; }
    };
    if (loader) load_chunk(0, 0);
    __syncthreads();
    float S[16];
#pragma unroll
    for (int j = 0; j < 16; ++j) S[j] = 0.f;
    const int il = lane_ & 15, jq = lane_ >> 4, irow = 16 * wave_ + il;
    for (int cidx = 0; cidx < SEQ / CH; ++cidx) {
        if (loader) { if (cidx + 1 < SEQ / CH) load_chunk(cidx + 1, (cidx + 1) & 1); }
        else {
            const LAS unsigned char* bb = buf + (cidx & 1) * BUFB;
#pragma unroll 4
            for (int s = 0; s < CH; ++s) { const LAS unsigned char* sp = bb + s * STEPB;
                float w[16], av[16], bv[16], kv[16], rv[16];
#pragma unroll
                for (int q = 0; q < 4; ++q) { const f32x4 l4 = *(const LAS f32x4*)(sp + 64 * jq + 16 * q); w[4 * q] = __expf(l4.x); w[4 * q + 1] = __expf(l4.y); w[4 * q + 2] = __expf(l4.z); w[4 * q + 3] = __expf(l4.w); }
#pragma unroll
                for (int q = 0; q < 2; ++q) { const v4u a4 = *(const LAS v4u*)(sp + 256 + 32 * jq + 16 * q), b4 = *(const LAS v4u*)(sp + 384 + 32 * jq + 16 * q), k4 = *(const LAS v4u*)(sp + 512 + 32 * jq + 16 * q), r4 = *(const LAS v4u*)(sp + 640 + 32 * jq + 16 * q);
#pragma unroll
                    for (int e = 0; e < 4; ++e) { av[8 * q + 2 * e] = bflo(a4[e]); av[8 * q + 2 * e + 1] = bfhi(a4[e]); bv[8 * q + 2 * e] = bflo(b4[e]); bv[8 * q + 2 * e + 1] = bfhi(b4[e]);
                        kv[8 * q + 2 * e] = bflo(k4[e]); kv[8 * q + 2 * e + 1] = bfhi(k4[e]); rv[8 * q + 2 * e] = bflo(r4[e]); rv[8 * q + 2 * e + 1] = bfhi(r4[e]); } }
                const unsigned short vraw = *(const LAS unsigned short*)(sp + 768 + 2 * irow); const float vi = __uint_as_float((unsigned)vraw << 16);
                float sa = 0.f;
#pragma unroll
                for (int j = 0; j < 16; ++j) sa += S[j] * av[j];
                sa += __shfl_xor(sa, 16); sa += __shfl_xor(sa, 32);
                float y = 0.f;
#pragma unroll
                for (int j = 0; j < 16; ++j) { S[j] = S[j] * w[j] + sa * bv[j] + vi * kv[j]; y += S[j] * rv[j]; }
                y += __shfl_xor(y, 16); y += __shfl_xor(y, 32);
                if (jq == 0) Y[(tok0 + (size_t)cidx * CH + s) * 512 + 64 * h + irow] = y;
            }
        }
        __syncthreads();
    }
}

__device__ __forceinline__ void rwkv_post(Frame& F, const Args& A) {
    PHASE_IDS();
    unsigned char* ws = A.ws;
    const float* Y = (const float*)(ws + WS_Y); const bf16* VV = (const bf16*)(ws + WS_XN); const bf16* GG = (const bf16*)(ws + WS_F + 32 * MiB); const float* BON = (const float*)(ws + WS_BON);
    bf16* O = (bf16*)(ws + WS_F);
    const float* lg = A.in[16]; const float* lb = A.in[17];
    const int gw = F.vcu * NWAVES + wave_, NGW = F.G * NWAVES, col = 8 * lane_, hd = lane_ >> 3;
    const f32x4 g0 = *(const f32x4*)(lg + col), g1 = *(const f32x4*)(lg + col + 4), b0 = *(const f32x4*)(lb + col), b1 = *(const f32x4*)(lb + col + 4);
    for (int m = gw; m < M; m += NGW) {
        const f32x4 y0 = *(const f32x4*)(Y + (size_t)m * 512 + col), y1 = *(const f32x4*)(Y + (size_t)m * 512 + col + 4);
        float s = (y0.x + y0.y) + (y0.z + y0.w) + (y1.x + y1.y) + (y1.z + y1.w);
        s += __shfl_xor(s, 1); s += __shfl_xor(s, 2); s += __shfl_xor(s, 4);
        const float mean = s * (1.f / 64.f); const f32x4 d0 = y0 - mean, d1 = y1 - mean;
        float q = (d0.x * d0.x + d0.y * d0.y) + (d0.z * d0.z + d0.w * d0.w) + (d1.x * d1.x + d1.y * d1.y) + (d1.z * d1.z + d1.w * d1.w);
        q += __shfl_xor(q, 1); q += __shfl_xor(q, 2); q += __shfl_xor(q, 4);
        const float rstd = 1.0f / sqrtf(q * (1.f / 64.f) + 64e-5f);
        const float bon = BON[(size_t)m * 8 + hd];
        const v4u vw = *(const v4u*)(VV + (size_t)m * 512 + col), gw4 = *(const v4u*)(GG + (size_t)m * 512 + col);
        f32x4 o0 = (d0 * rstd * g0 + b0), o1 = (d1 * rstd * g1 + b1);
        o0.x = (o0.x + bon * bflo(vw.x)) * bflo(gw4.x); o0.y = (o0.y + bon * bfhi(vw.x)) * bfhi(gw4.x); o0.z = (o0.z + bon * bflo(vw.y)) * bflo(gw4.y); o0.w = (o0.w + bon * bfhi(vw.y)) * bfhi(gw4.y);
        o1.x = (o1.x + bon * bflo(vw.z)) * bflo(gw4.z); o1.y = (o1.y + bon * bfhi(vw.z)) * bfhi(gw4.z); o1.z = (o1.z + bon * bflo(vw.w)) * bflo(gw4.w); o1.w = (o1.w + bon * bfhi(vw.w)) * bfhi(gw4.w);
        v4u ow; ow.x = pk2(o0.x, o0.y); ow.y = pk2(o0.z, o0.w); ow.z = pk2(o1.x, o1.y); ow.w = pk2(o1.z, o1.w);
        *(v4u*)(O + (size_t)m * 512 + col) = ow;
    }
}

__device__ __forceinline__ void p_norm2_route(Frame& F, const Args& A) {
    PHASE_IDS();
    unsigned char* ws = A.ws;
    LAS float* rw = (LAS float*)F.lds;
    LAS int* eid = (LAS int*)(F.lds + 147456);
    const float* x1 = A.out; const float* g2 = A.in[21]; const float* mod = (const float*)(ws + WS_MOD);
    const float* rgw = A.in[22]; const float* rgb = A.in[23]; const float* rew = A.in[24]; const float* reb = A.in[25];
    bf16* XN2 = (bf16*)(ws + WS_XN); int* route = (int*)(ws + WS_ROUTE); int* blkcnt = (int*)(ws + WS_BLKCNT);
    for (int i = tid_; i < 4096; i += NWAVES * 64) rw[(i & 3) * 1024 + (i >> 2)] = rgw[i];
    for (int i = tid_; i < 32768; i += NWAVES * 64) rw[(4 + (i & 31)) * 1024 + (i >> 5)] = rew[i];
    const float mybias = (lane_ < 4) ? rgb[lane_] : (lane_ < 36) ? reb[lane_ - 4] : 0.f;
    __syncthreads();
    for (int blk = blockIdx.x; blk < M / 128; blk += F.G) {
        const int b = blk / (SEQ / 128);
        f32x4 gm[4], sh[4];
#pragma unroll
        for (int j = 0; j < 4; ++j) { const int col = 4 * lane_ + 256 * j; const f32x4 g = *(const f32x4*)(g2 + col), sc = *(const f32x4*)(mod + b * 6144 + 4096 + col);
            gm[j] = g * (sc + 1.0f); sh[j] = *(const f32x4*)(mod + b * 6144 + 3072 + col); }
#pragma unroll 1
        for (int g4 = 0; g4 < 4; ++g4) {
            const int tl0 = wave_ * 16 + g4 * 4; const size_t tok0 = (size_t)blk * 128 + tl0;
            f32x4 v[4][4];
#pragma unroll
            for (int q = 0; q < 4; ++q) { const GAS f32x4* xr = (const GAS f32x4*)(x1 + (tok0 + q) * D) + lane_; float s = 0.f;
#pragma unroll
                for (int j = 0; j < 4; ++j) { v[q][j] = xr[64 * j]; s += (v[q][j].x * v[q][j].x + v[q][j].y * v[q][j].y) + (v[q][j].z * v[q][j].z + v[q][j].w * v[q][j].w); }
                const float rstd = 1.0f / sqrtf(wave_sum(s) * (1.f / D) + 1e-6f);
                GAS unsigned long long* o8 = (GAS unsigned long long*)(XN2 + (tok0 + q) * D) + lane_;
#pragma unroll
                for (int j = 0; j < 4; ++j) { v[q][j] = v[q][j] * rstd * gm[j] + sh[j]; o8[64 * j] = (unsigned long long)pk2(v[q][j].x, v[q][j].y) | ((unsigned long long)pk2(v[q][j].z, v[q][j].w) << 32); } }
            float mylog[4] = {0.f, 0.f, 0.f, 0.f};
#pragma unroll 2
            for (int c = 0; c < NROUTE; ++c) {
                f32x4 w4[4];
#pragma unroll
                for (int j = 0; j < 4; ++j) w4[j] = *(const LAS f32x4*)(rw + c * 1024 + 4 * lane_ + 256 * j);
#pragma unroll
                for (int q = 0; q < 4; ++q) { float p = 0.f;
#pragma unroll
                    for (int j = 0; j < 4; ++j) p += (v[q][j].x * w4[j].x + v[q][j].y * w4[j].y) + (v[q][j].z * w4[j].z + v[q][j].w * w4[j].w);
                    p = wave_sum(p); if (lane_ == c) mylog[q] = p; }
            }
#pragma unroll
            for (int q = 0; q < 4; ++q) {
                const float l = mylog[q] + mybias;
                const float ga = __shfl(l, 0), gb = __shfl(l, 1), gc = __shfl(l, 2), gd = __shfl(l, 3);
                int gi = 0; float gmax = ga; if (gb > gmax) { gmax = gb; gi = 1; } if (gc > gmax) { gmax = gc; gi = 2; } if (gd > gmax) { gmax = gd; gi = 3; }
                const float gp = 1.0f / (__expf(ga - gmax) + __expf(gb - gmax) + __expf(gc - gmax) + __expf(gd - gmax));
                float el[8];
#pragma unroll
                for (int i = 0; i < 8; ++i) el[i] = __shfl(l, 4 + 8 * gi + i);
                int i0 = 0; float m0 = el[0];
#pragma unroll
                for (int i = 1; i < 8; ++i) if (el[i] > m0) { m0 = el[i]; i0 = i; }
                int i1 = -1; float m1 = -INFINITY;
#pragma unroll
                for (int i = 0; i < 8; ++i) if (i != i0 && el[i] > m1) { m1 = el[i]; i1 = i; }
                const float p1 = __expf(m1 - m0), w0 = gp / (1.0f + p1), w1 = gp * p1 / (1.0f + p1);
                if (lane_ == 0) { int* rt_ = route + (tok0 + q) * 8; rt_[0] = gi * 8 + i0; rt_[1] = gi * 8 + i1; rt_[2] = __float_as_int(w0); rt_[3] = __float_as_int(w1);
                    eid[(tl0 + q) * 2] = gi * 8 + i0; eid[(tl0 + q) * 2 + 1] = gi * 8 + i1; }
            }
        }
        __syncthreads();
        if (tid_ < 256) { const int e = eid[tid_]; int rk = 0; for (int a = 0; a < tid_; ++a) rk += (eid[a] == e) ? 1 : 0; route[((size_t)blk * 128 + (tid_ >> 1)) * 8 + 4 + (tid_ & 1)] = rk; }
        else if (tid_ < 288) { const int e = tid_ - 256; int cn = 0; for (int a = 0; a < 256; ++a) cn += (eid[a] == e) ? 1 : 0; blkcnt[blk * 32 + e] = cn; }
        __syncthreads();
    }
}

__device__ __forceinline__ void conv_experts(Frame& F, const Args& A) {
    PHASE_IDS();
    unsigned char* ws = A.ws; bf16* W13 = (bf16*)(ws + WS_W13); bf16* W2T = (bf16*)(ws + WS_W2T);
    LAS float* scr = (LAS float*)(F.lds + RING_OFF + wave_ * 16384);
    const int gw = F.vcu * NWAVES + wave_, NGW = F.G * NWAVES;
    for (int it = gw; it < 3 * 8192; it += NGW) {
        const int which = it >> 13, r = it & 8191;
        if (which < 2) { const int e = r >> 8, kb = (r >> 4) & 15, nb = r & 15, n0 = 32 * nb;
            transpose_item(A.in[26 + which] + (size_t)e * 1024 * 512, 512, n0, 64 * kb, 1024, W13, (size_t)e * 1024 + (n0 >> 7) * 256 + which * 128 + (n0 & 127), scr, lane_); }
        else { const int e = r >> 8, kb = (r >> 5) & 7, nb = r & 31;
            transpose_item(A.in[28] + (size_t)e * 512 * 1024, 1024, 32 * nb, 64 * kb, 512, W2T, (size_t)e * 1024 + 32 * nb, scr, lane_); }
    }
}

__device__ __forceinline__ void p_slots(Frame& F, const Args& A) {
    PHASE_IDS();
    unsigned char* ws = A.ws;
    LAS int* tile_e = (LAS int*)(F.lds + TILE_OFF); LAS int* base = tile_e + 288; LAS int* tot = base + 32; LAS int* pre = tot + 32; LAS int* ntl = pre + 32; LAS int* part = ntl + 4;
    const int* blkcnt = (const int*)(ws + WS_BLKCNT); int* route = (int*)(ws + WS_ROUTE); int* rowtok = (int*)(ws + WS_ROWTOK);
    { const int e = tid_ & 31, pt = tid_ >> 5; int s = 0; for (int bb = 16 * pt; bb < 16 * pt + 16; ++bb) s += blkcnt[bb * 32 + e]; part[pt * 32 + e] = s; }
    __syncthreads();
    if (tid_ < 32) { int t = 0; for (int p = 0; p < 16; ++p) t += part[p * 32 + tid_]; tot[tid_] = t; }
    __syncthreads();
    if (tid_ == 0) { int run = 0, nt = 0; for (int e = 0; e < 32; ++e) { base[e] = run; const int pad = (tot[e] + 255) >> 8; for (int i = 0; i < pad; ++i) tile_e[nt++] = e; run += pad * 256; } ntl[0] = nt; }
    __syncthreads();
    for (int blk = blockIdx.x; blk < M / 128; blk += F.G) {
        if (tid_ < 32) { int p = 0; for (int bb = 0; bb < blk; ++bb) p += blkcnt[bb * 32 + tid_]; pre[tid_] = p; }
        __syncthreads();
        if (tid_ < 256) { const size_t tok = (size_t)blk * 128 + (tid_ >> 1); const int k = tid_ & 1; const int e = route[tok * 8 + k], lr = route[tok * 8 + 4 + k];
            const int slot = base[e] + pre[e] + lr; route[tok * 8 + 6 + k] = slot; rowtok[slot] = (int)tok; }
        __syncthreads();
    }
    for (int e = blockIdx.x; e < 32; e += F.G) { const int lo = base[e] + tot[e], hi = base[e] + (((tot[e] + 255) >> 8) << 8); for (int s = lo + tid_; s < hi; s += NWAVES * 64) rowtok[s] = 0; }
}

#ifndef STAGE
#define STAGE 4
#endif
#ifndef PHASES
#define PHASES 0xffff
#endif
__global__ void __launch_bounds__(NWAVES * 64, 2) fwd_kernel(Args args) {
    extern __shared__ __attribute__((aligned(16))) unsigned char lds[];
    Frame F;
    F.lds = (LAS unsigned char*)lds;
    F.MISC = (volatile LAS unsigned*)(F.lds + MISC_OFF);
    F.tid = threadIdx.x; F.lane = F.tid & 63; F.wave = __builtin_amdgcn_readfirstlane(F.tid >> 6);
    F.G = gridDim.x; { const int bx = blockIdx.x; F.vcu = (F.G % 8 == 0) ? (bx % 8) * (F.G / 8) + bx / 8 : bx; }
    unsigned char* ws = args.ws;
    F.ctl = (gu32*)(ws + WS_CTL);
    for (int u = F.tid; u < (LDS_BYTES - LDSCTL_OFF) / 4; u += NWAVES * 64) ((LAS unsigned*)(F.lds + LDSCTL_OFF))[u] = 0u;
    __syncthreads();
    XcdBarrier bar = xcd_barrier_post((unsigned*)(F.ctl + CW_BAR), F.MISC + 8);
#define GRID_BAR() xcd_barrier(bar)

#if PHASES & 1
    p0_prologue(F, args); GRID_BAR();
#endif
#if PHASES & 2
    p1_norm(F, args); GRID_BAR();
#endif
#if PHASES & 4
    {
        pg8::Gemm g{(const pg8::bf16_t*)(ws + WS_XN), (const pg8::bf16_t*)(ws + WS_WIN), nullptr, 1024, NIN};
        pg8::StaticOrder S; S.init(M, NIN, F.G, (int)blockIdx.x);
        pg8::EpiIn E{(pg8::bf16_t*)(ws + WS_Q), (pg8::bf16_t*)(ws + WS_K), (pg8::bf16_t*)(ws + WS_V), (pg8::bf16_t*)(ws + WS_PRW), (pg8::bf16_t*)(ws + WS_GATES), ATT_C2};
        pg8::gemm_phase<pg8::EpiIn, pg8::StaticOrder>(F.lds + RING_OFF, g, S, E);
    }
    GRID_BAR();
#endif
#if PHASES & 8
    {
        const attn_body::AttnTensors AT{(const attn_body::bf16*)(ws + WS_Q), (const attn_body::bf16*)(ws + WS_K), (const attn_body::bf16*)(ws + WS_V), (attn_body::bf16*)(ws + WS_Q), (const float*)(ws + WS_CUM), (const float*)(ws + WS_SEGTOT)};
        const attn_body::StaticOrder S((int)F.G, (int)blockIdx.x);
        attn_body::attn_phase<attn_body::StaticOrder>((char*)lds + RING_OFF, AT, S, TAB_OFF, SEGP_OFF);
    }
#endif
#if STAGE >= 3
#if PHASES & 16
    rwkv_pre(F, args);
    GRID_BAR();
#endif
#if PHASES & 32
    rwkv_scan_seq(F, args);
    GRID_BAR();
#endif
#if PHASES & 64
    rwkv_post(F, args);
#endif
#endif
    GRID_BAR();
#if STAGE >= 2
    {
        pg8::Gemm g{(const pg8::bf16_t*)(ws + WS_Q), (const pg8::bf16_t*)(ws + WS_WOF), nullptr, 512, 1024};
        pg8::StaticOrder S; S.init(M, 1024, F.G, (int)blockIdx.x);
        pg8::EpiGate<1> E{(pg8::bf16_t*)(ws + WS_TMP), 1024, (const pg8::bf16_t*)(ws + WS_GATES), 2048, 0};
        pg8::gemm_phase<pg8::EpiGate<1>, pg8::StaticOrder>(F.lds + RING_OFF, g, S, E);
    }
#if STAGE >= 3
    {
        pg8::Gemm g{(const pg8::bf16_t*)(ws + WS_F), (const pg8::bf16_t*)(ws + WS_WOR), nullptr, 512, 1024};
        pg8::StaticOrder S; S.init(M, 1024, F.G, (int)blockIdx.x);
        pg8::EpiGate<2> E{(pg8::bf16_t*)(ws + WS_TMP), 1024, (const pg8::bf16_t*)(ws + WS_GATES), 2048, 1024};
        pg8::gemm_phase<pg8::EpiGate<2>, pg8::StaticOrder>(F.lds + RING_OFF, g, S, E);
    }
#endif
    GRID_BAR();
    {
        pg8::Gemm g{(const pg8::bf16_t*)(ws + WS_TMP), (const pg8::bf16_t*)(ws + WS_WO), nullptr, 1024, 1024};
        pg8::StaticOrder S; S.init(M, 1024, F.G, (int)blockIdx.x);
        pg8::EpiRes E{args.in[0], args.out, (const float*)(ws + WS_MOD) + 2048, SEQ, 6144};
        pg8::gemm_phase<pg8::EpiRes, pg8::StaticOrder>(F.lds + RING_OFF, g, S, E);
    }
    GRID_BAR();
#endif
#if STAGE >= 4
    p_norm2_route(F, args); GRID_BAR();
    p_slots(F, args); conv_experts(F, args); GRID_BAR();
    {
        const LAS int* tile_e = (const LAS int*)(F.lds + TILE_OFF); const int ntiles = tile_e[288 + 96];
        {
            pg8::Gemm g{(const pg8::bf16_t*)(ws + WS_XN), (const pg8::bf16_t*)(ws + WS_W13), (const int*)(ws + WS_ROWTOK), 1024, 1024};
            pg8::MoeOrder S{ntiles * 4, F.G, (int)blockIdx.x, 2, tile_e};
            pg8::EpiSwiGLU E{(pg8::bf16_t*)(ws + WS_H)};
            pg8::gemm_phase<pg8::EpiSwiGLU, pg8::MoeOrder, true>(F.lds + RING_OFF, g, S, E);
        }
        GRID_BAR();
        {
            pg8::Gemm g{(const pg8::bf16_t*)(ws + WS_H), (const pg8::bf16_t*)(ws + WS_W2T), nullptr, 512, 1024};
            pg8::MoeOrder S{ntiles * 4, F.G, (int)blockIdx.x, 2, tile_e};
            pg8::EpiGate<0> E{(pg8::bf16_t*)(ws + WS_YM), 1024, nullptr, 0, 0};
            pg8::gemm_phase<pg8::EpiGate<0>, pg8::MoeOrder>(F.lds + RING_OFF, g, S, E);
        }
        GRID_BAR();
    }
    p_final<1>(F, args, args.out);
#elif STAGE >= 2
    p_final<0>(F, args, args.out);
#else
    p_final<0>(F, args, args.in[0]);
#endif
}

extern "C" void kernel_launch(void* const* d_in, const int* in_sizes, int n_in, void* d_out, int out_size, void* d_ws, size_t ws_size, hipStream_t stream) {
    static int grid = 0;
    if (grid == 0) {
        if (n_in != 30 || in_sizes[0] != M * D || out_size != M * D || ws_size < WS_END) { fprintf(stderr, "kernel_launch: unexpected shapes (n_in %d, in0 %d, out %d, ws %zu)\n", n_in, n_in > 0 ? in_sizes[0] : -1, out_size, ws_size); grid = -1; return; }
        int dev = 0, cus = 0, per_cu = 0;
        if (hipGetDevice(&dev) != hipSuccess || hipDeviceGetAttribute(&cus, hipDeviceAttributeMultiprocessorCount, dev) != hipSuccess) { grid = -1; return; }
        if (hipFuncSetAttribute((const void*)fwd_kernel, hipFuncAttributeMaxDynamicSharedMemorySize, LDS_BYTES) != hipSuccess) { fprintf(stderr, "kernel_launch: hipFuncSetAttribute failed\n"); grid = -1; return; }
        if (hipOccupancyMaxActiveBlocksPerMultiprocessor(&per_cu, (const void*)fwd_kernel, NWAVES * 64, LDS_BYTES) != hipSuccess || per_cu < 1)
            fprintf(stderr, "kernel_launch: occupancy query reports %d\n", per_cu);
        (void)hipGetLastError();
        grid = cus;
        if (grid > 256) grid = 256;
    }
    if (grid < 0) return;
    if (hipMemsetAsync((char*)d_ws + WS_CTL, 0, CTL_ZERO_BYTES, stream) != hipSuccess) return;
    Args a{};
    for (int i = 0; i < 30; ++i) a.in[i] = (const float*)d_in[i];
    a.out = (float*)d_out; a.ws = (unsigned char*)d_ws;
    hipLaunchKernelGGL(fwd_kernel, dim3(grid), dim3(NWAVES * 64), LDS_BYTES, stream, a);
}
```

```cpp
#include <hip/hip_runtime.h>
#include <hip/hip_bf16.h>
#include <cstdio>
#include <cstdint>
#include <cmath>

namespace pg8 {
#define PG8_LAS __attribute__((address_space(3)))
typedef unsigned short bf16_t;
typedef short bf16x8 __attribute__((ext_vector_type(8)));
typedef float f32x4 __attribute__((ext_vector_type(4)));
typedef unsigned u32x4 __attribute__((ext_vector_type(4)));
typedef unsigned u32x2 __attribute__((ext_vector_type(2)));
constexpr int BM = 256, BK = 64, HALF = 128, HTB = HALF * BK * 2, STAGE_BYTES = 8 * HTB, NXCD = 8, WGM = 8;

__host__ __device__ __forceinline__ int lds_byte(int r, int c) { const int st = (r >> 4) * 2 + (c >> 5), rr = r & 15, cc = c & 31, ob = rr * 64 + cc * 2; return st * 1024 + (ob ^ (((ob >> 9) & 1) << 5)); }
__host__ __device__ __forceinline__ void stage_rc(int b, int& R, int& C) { const int st = b / 1024, sb = b % 1024, swz = sb ^ (((sb >> 9) & 1) << 5); R = (st >> 1) * 16 + swz / 64; C = (st & 1) * 32 + (swz % 64) / 2; }
__host__ __device__ __forceinline__ int perm32(int rho) { const int n = rho >> 4, i = rho & 15; return 8 * (i >> 2) + 4 * n + (i & 3); }

struct Unit { int pm, pn, e; };
struct Gemm { const bf16_t* A; const bf16_t* Bt; const PG8_LAS int* rowlds; int K; int nB; };

struct StaticOrder {
    int nM, nN, nwg, G, c;
    __host__ __device__ void init(int M, int N, int G_, int c_) { nM = M / BM; nN = N / BM; nwg = nM * nN; G = G_; c = c_; }
    __host__ __device__ bool next(int i, Unit& u) const {
        const long L = (long)i * G + c; if (L >= nwg) return false;
        int wgid = (int)L; { const int q = nwg / NXCD, r = nwg % NXCD, xcd = wgid % NXCD, off = wgid / NXCD; wgid = (xcd < r ? xcd * (q + 1) : r * (q + 1) + (xcd - r) * q) + off; }
        const int nig = WGM * nN, gid = wgid / nig, fm = gid * WGM, gsz = (nM - fm) < WGM ? (nM - fm) : WGM;
        u.pm = fm + ((wgid % nig) % gsz); u.pn = (wgid % nig) / gsz; u.e = 0; return true;
    }
};

__device__ __forceinline__ unsigned cvt_pk_bf16(float lo, float hi) { unsigned r; asm volatile("v_cvt_pk_bf16_f32 %0, %1, %2" : "=v"(r) : "v"(lo), "v"(hi)); return r; }
__device__ __forceinline__ float bf_lo(unsigned w) { return __uint_as_float(w << 16); }
__device__ __forceinline__ float bf_hi(unsigned w) { return __uint_as_float(w & 0xffff0000u); }
__device__ __forceinline__ float fsigmoid(float x) { return __builtin_amdgcn_rcpf(1.0f + __builtin_amdgcn_exp2f(-1.4426950408889634f * x)); }

template <class Epi, class Sched, bool GATHER = false>
__device__ __forceinline__ void gemm_phase(PG8_LAS unsigned char* lds, const Gemm g, const Sched& S, const Epi& E) {
    int tid_ = threadIdx.x; asm volatile("" : "+v"(tid_));
    const int tid = tid_, wid = __builtin_amdgcn_readfirstlane(tid >> 6), lane = tid & 63, wr = wid >> 2, wc = wid & 3, fr = lane & 15, fq = lane >> 4;
    const int K = g.K, nt = K / BK;
    int RA[2], CA[2]; unsigned voffA[2], voffB[2];
#pragma unroll
    for (int i = 0; i < 2; ++i) { int R, C; stage_rc(tid * 16 + i * 8192, R, C); const int Rb = Epi::PERM ? ((R & ~31) + perm32(R & 31)) : R;
        RA[i] = R; CA[i] = C; voffA[i] = (unsigned)(R * K + C) * 2u; voffB[i] = (unsigned)(Rb * K + C) * 2u; }
    const size_t tstep = 2 * (size_t)HALF * K * 2;
    const size_t kstep = (size_t)(BK * 2);
    const size_t hstep = (size_t)HALF * K * 2;
    const unsigned ldsw = (unsigned)wid * 1024u;
    const int aoff = lds_byte(wr * 64 + fr, fq * 8), boff = lds_byte(wc * 32 + fr, fq * 8);
#define PG8_SA(b, h) (((b) * 2 + (h)) * HTB)
#define PG8_SB(b, h) ((4 + (b) * 2 + (h)) * HTB)
#define PG8_STAGE(bufoff, gbase, v0, v1) do { \
        __builtin_amdgcn_global_load_lds((const unsigned*)((const char*)(gbase) + (v0)), (PG8_LAS unsigned*)(lds + (bufoff) + ldsw), 16, 0, 0); \
        __builtin_amdgcn_global_load_lds((const unsigned*)((const char*)(gbase) + (v1)), (PG8_LAS unsigned*)(lds + (bufoff) + ldsw + 8192), 16, 0, 0); } while (0)
#define PG8_STAGEB(bufoff, gbase) PG8_STAGE(bufoff, gbase, voffB[0], voffB[1])
#define PG8_STAGEA(bufoff, abase, h, VA) do { if constexpr (GATHER) { PG8_STAGE(bufoff, abase, VA[h][0], VA[h][1]); } else { PG8_STAGE(bufoff, (abase) + (h) * hstep, voffA[0], voffA[1]); } } while (0)
#define PG8_LDA(dst, b, h) do { _Pragma("unroll") for (int m = 0; m < 4; ++m) _Pragma("unroll") for (int k = 0; k < 2; ++k) dst[m][k] = *(const PG8_LAS bf16x8*)(lds + PG8_SA(b, h) + aoff + m * 2048 + k * 1024); } while (0)
#define PG8_LDB(dst, b, h) do { _Pragma("unroll") for (int n = 0; n < 2; ++n) _Pragma("unroll") for (int k = 0; k < 2; ++k) dst[n][k] = *(const PG8_LAS bf16x8*)(lds + PG8_SB(b, h) + boff + n * 2048 + k * 1024); } while (0)
#define PG8_MMA(ai, bj, At, Bt) do { __builtin_amdgcn_s_setprio(1); _Pragma("unroll") for (int m = 0; m < 4; ++m) _Pragma("unroll") for (int n = 0; n < 2; ++n) _Pragma("unroll") for (int k = 0; k < 2; ++k) \
        acc[ai][bj][m][n] = __builtin_amdgcn_mfma_f32_16x16x32_bf16(Bt[n][k], At[m][k], acc[ai][bj][m][n], 0, 0, 0); __builtin_amdgcn_s_setprio(0); } while (0)
#define PG8_WAIT_V(n) asm volatile("s_waitcnt vmcnt(" #n ")" ::: "memory")
#define PG8_WAIT_L(n) asm volatile("s_waitcnt lgkmcnt(" #n ")" ::: "memory")
#define PG8_BAR __builtin_amdgcn_s_barrier()
#define PG8_SCHED __builtin_amdgcn_sched_barrier(0)
#define PG8_AOFF(dst, ord) do { _Pragma("unroll") for (int h_ = 0; h_ < 2; ++h_) _Pragma("unroll") for (int i_ = 0; i_ < 2; ++i_) { \
        const int src_ = g.rowlds[(ord) * BM + h_ * HALF + RA[i_]]; dst[h_][i_] = (unsigned)(src_ * K + CA[i_]) * 2u; } } while (0)
    Unit cur, nxt; int ui = 0;
    if (!S.next(0, cur)) return;
    f32x4 acc[2][2][4][2];
#pragma unroll
    for (int a = 0; a < 2; ++a)
#pragma unroll
        for (int b = 0; b < 2; ++b)
#pragma unroll
            for (int m = 0; m < 4; ++m)
#pragma unroll
                for (int n = 0; n < 2; ++n) acc[a][b][m][n] = (f32x4){0.f, 0.f, 0.f, 0.f};
    bf16x8 At[4][2], B0[2][2], B1[2][2];
    unsigned vA[2][2], nvA[2][2];
    if constexpr (GATHER) { PG8_AOFF(vA, 0); }
    const char* cA = GATHER ? (const char*)g.A : (const char*)g.A + (size_t)cur.pm * tstep;
    const char* cB = (const char*)g.Bt + ((size_t)cur.e * g.nB + (size_t)cur.pn * BM) * K * 2;
    PG8_STAGEB(PG8_SB(0, 0), cB); PG8_STAGEB(PG8_SB(0, 1), cB + hstep); PG8_STAGEA(PG8_SA(0, 0), cA, 0, vA); PG8_STAGEA(PG8_SA(0, 1), cA, 1, vA);
    if (wr == 1) PG8_BAR;
    PG8_WAIT_V(2); PG8_BAR;
    PG8_STAGEB(PG8_SB(1, 0), cB + kstep); PG8_STAGEA(PG8_SA(1, 0), cA + kstep, 0, vA); PG8_STAGEB(PG8_SB(1, 1), cB + hstep + kstep);
    PG8_WAIT_V(6); PG8_BAR;
    for (;;) {
        const bool has_next = S.next(ui + 1, nxt);
        if constexpr (GATHER) { if (has_next) { PG8_AOFF(nvA, ui + 1); } else {
#pragma unroll
            for (int h_ = 0; h_ < 2; ++h_)
#pragma unroll
                for (int i_ = 0; i_ < 2; ++i_) nvA[h_][i_] = vA[h_][i_]; } }
        const char* nA = GATHER ? cA : (has_next ? (const char*)g.A + (size_t)nxt.pm * tstep : cA);
        const char* nB = has_next ? (const char*)g.Bt + ((size_t)nxt.e * g.nB + (size_t)nxt.pn * BM) * K * 2 : cB;
        for (int t = 0; t < nt; t += 2) {
            const bool last = (t == nt - 2);
            const char* a1 = cA + (size_t)(t + 1) * kstep;
            const char* a2 = last ? nA : cA + (size_t)(t + 2) * kstep; const char* b2 = last ? nB : cB + (size_t)(t + 2) * kstep;
            const char* a3 = a2 + kstep; const char* b3 = b2 + kstep;
            unsigned wv[2][2];
            if constexpr (GATHER) { wv[0][0] = last ? nvA[0][0] : vA[0][0]; wv[0][1] = last ? nvA[0][1] : vA[0][1]; wv[1][0] = last ? nvA[1][0] : vA[1][0]; wv[1][1] = last ? nvA[1][1] : vA[1][1]; }
            PG8_LDB(B0, 0, 0); PG8_LDB(B1, 0, 1); PG8_SCHED; PG8_LDA(At, 0, 0); PG8_STAGEA(PG8_SA(1, 1), a1, 1, vA);
            PG8_WAIT_V(8); PG8_WAIT_L(0); PG8_BAR; PG8_MMA(0, 0, At, B0); PG8_MMA(0, 1, At, B1); PG8_BAR; PG8_SCHED;
            PG8_LDA(At, 0, 1); PG8_STAGEB(PG8_SB(0, 0), b2); PG8_STAGEB(PG8_SB(0, 1), b2 + hstep); PG8_STAGEA(PG8_SA(0, 0), a2, 0, wv);
            PG8_WAIT_V(8); PG8_WAIT_L(0); PG8_BAR; PG8_MMA(1, 0, At, B0); PG8_MMA(1, 1, At, B1); PG8_BAR; PG8_SCHED;
            PG8_LDB(B0, 1, 0); PG8_LDB(B1, 1, 1); PG8_SCHED; PG8_LDA(At, 1, 0); PG8_STAGEA(PG8_SA(0, 1), a2, 1, wv);
            PG8_WAIT_V(8); PG8_WAIT_L(0); PG8_BAR; PG8_MMA(0, 0, At, B0); PG8_MMA(0, 1, At, B1); PG8_BAR; PG8_SCHED;
            PG8_LDA(At, 1, 1); PG8_STAGEB(PG8_SB(1, 0), b3); PG8_STAGEB(PG8_SB(1, 1), b3 + hstep); PG8_STAGEA(PG8_SA(1, 0), a3, 0, wv);
            PG8_WAIT_V(8); PG8_WAIT_L(0); PG8_BAR; PG8_MMA(1, 0, At, B0); PG8_MMA(1, 1, At, B1); PG8_BAR; PG8_SCHED;
        }
        if (wr == 0) PG8_BAR;
        E(acc, cur, wr, wc, fr, fq);
        if (!has_next) break;
#pragma unroll
        for (int a = 0; a < 2; ++a)
#pragma unroll
            for (int b = 0; b < 2; ++b)
#pragma unroll
                for (int m = 0; m < 4; ++m)
#pragma unroll
                    for (int n = 0; n < 2; ++n) acc[a][b][m][n] = (f32x4){0.f, 0.f, 0.f, 0.f};
        cur = nxt; cB = nB; cA = nA; ++ui;
        if constexpr (GATHER) {
#pragma unroll
        for (int h_ = 0; h_ < 2; ++h_)
#pragma unroll
            for (int i_ = 0; i_ < 2; ++i_) vA[h_][i_] = nvA[h_][i_]; }
        if (wr == 1) PG8_BAR;
    }
    PG8_WAIT_V(0);
    PG8_BAR;
#undef PG8_SA
#undef PG8_SB
#undef PG8_STAGE
#undef PG8_STAGEB
#undef PG8_STAGEA
#undef PG8_LDA
#undef PG8_LDB
#undef PG8_MMA
#undef PG8_WAIT_V
#undef PG8_WAIT_L
#undef PG8_BAR
#undef PG8_SCHED
#undef PG8_AOFF
}
}

namespace pg8 {
struct EpiIn {
    static constexpr bool PERM = true;
    bf16_t *Q, *Kb, *V, *PRW, *GT; float qscale;
    __device__ __forceinline__ void operator()(const f32x4 (&acc)[2][2][4][2], const Unit& u, int wr, int wc, int fr, int fq) const {
        const int pn = u.pn; bf16_t* base; int ld, colt, mode = 0;
        if (pn < 2) { base = Q; ld = 512; colt = pn * 256; mode = 1; }
        else if (pn < 4) { base = Kb; ld = 512; colt = (pn - 2) * 256; }
        else if (pn < 6) { base = V; ld = 512; colt = (pn - 4) * 256; }
        else if (pn < 13) { base = PRW; ld = 1792; colt = (pn - 6) * 256; }
        else { base = GT; ld = 2048; colt = (pn - 13) * 256; mode = 2; }
        const int row0 = u.pm * BM + wr * 64 + fr, col0 = colt + wc * 32 + 8 * fq;
        const float sc = (mode == 1) ? qscale : 1.0f;
#pragma unroll
        for (int ai = 0; ai < 2; ++ai)
#pragma unroll
            for (int m = 0; m < 4; ++m) { bf16_t* rowp = base + (size_t)(row0 + ai * HALF + m * 16) * ld + col0;
#pragma unroll
                for (int bj = 0; bj < 2; ++bj) { f32x4 v0 = acc[ai][bj][m][0] * sc, v1 = acc[ai][bj][m][1] * sc;
                    if (mode == 2) {
#pragma unroll
                        for (int e = 0; e < 4; ++e) { v0[e] = fsigmoid(v0[e]); v1[e] = fsigmoid(v1[e]); } }
                    u32x4 w; w.x = cvt_pk_bf16(v0[0], v0[1]); w.y = cvt_pk_bf16(v0[2], v0[3]); w.z = cvt_pk_bf16(v1[0], v1[1]); w.w = cvt_pk_bf16(v1[2], v1[3]);
                    *(u32x4*)(rowp + bj * HALF) = w; } }
    }
};
template <int MODE> struct EpiGate {
    static constexpr bool PERM = true;
    bf16_t* O; int ldo; const bf16_t* G; int ldg; int gcol0;
    __device__ __forceinline__ void operator()(const f32x4 (&acc)[2][2][4][2], const Unit& u, int wr, int wc, int fr, int fq) const {
        const int row0 = u.pm * BM + wr * 64 + fr, col0 = u.pn * BM + wc * 32 + 8 * fq;
#pragma unroll
        for (int ai = 0; ai < 2; ++ai)
#pragma unroll
            for (int m = 0; m < 4; ++m) { const size_t row = (size_t)(row0 + ai * HALF + m * 16); bf16_t* rowp = O + row * ldo + col0;
#pragma unroll
                for (int bj = 0; bj < 2; ++bj) { f32x4 v0 = acc[ai][bj][m][0], v1 = acc[ai][bj][m][1];
                    if (MODE >= 1) { const u32x4 gw = *(const u32x4*)(G + row * ldg + gcol0 + col0 + bj * HALF);
                        v0[0] *= bf_lo(gw.x); v0[1] *= bf_hi(gw.x); v0[2] *= bf_lo(gw.y); v0[3] *= bf_hi(gw.y); v1[0] *= bf_lo(gw.z); v1[1] *= bf_hi(gw.z); v1[2] *= bf_lo(gw.w); v1[3] *= bf_hi(gw.w); }
                    if (MODE == 2) { const u32x4 ow = *(const u32x4*)(rowp + bj * HALF);
                        v0[0] += bf_lo(ow.x); v0[1] += bf_hi(ow.x); v0[2] += bf_lo(ow.y); v0[3] += bf_hi(ow.y); v1[0] += bf_lo(ow.z); v1[1] += bf_hi(ow.z); v1[2] += bf_lo(ow.w); v1[3] += bf_hi(ow.w); }
                    u32x4 w; w.x = cvt_pk_bf16(v0[0], v0[1]); w.y = cvt_pk_bf16(v0[2], v0[3]); w.z = cvt_pk_bf16(v1[0], v1[1]); w.w = cvt_pk_bf16(v1[2], v1[3]);
                    *(u32x4*)(rowp + bj * HALF) = w; } }
    }
};
struct EpiRes {
    static constexpr bool PERM = true;
    const float* X; bf16_t* O; const float* gate; int seq; int gstride;
    __device__ __forceinline__ void operator()(const f32x4 (&acc)[2][2][4][2], const Unit& u, int wr, int wc, int fr, int fq) const {
        const int row0 = u.pm * BM + wr * 64 + fr, col0 = u.pn * BM + wc * 32 + 8 * fq;
        const float* gp = gate + (size_t)((u.pm * BM) / seq) * gstride + col0;
        f32x4 gv[2][2];
#pragma unroll
        for (int bj = 0; bj < 2; ++bj)
#pragma unroll
            for (int n = 0; n < 2; ++n) gv[bj][n] = *(const f32x4*)(gp + bj * HALF + n * 4);
#pragma unroll
        for (int ai = 0; ai < 2; ++ai)
#pragma unroll
            for (int m = 0; m < 4; ++m) { const size_t off = (size_t)(row0 + ai * HALF + m * 16) * 1024 + col0;
#pragma unroll
                for (int bj = 0; bj < 2; ++bj) { const f32x4 x0 = *(const f32x4*)(X + off + bj * HALF), x1 = *(const f32x4*)(X + off + bj * HALF + 4);
                    const f32x4 v0 = x0 + gv[bj][0] * acc[ai][bj][m][0], v1 = x1 + gv[bj][1] * acc[ai][bj][m][1];
                    u32x4 w; w.x = cvt_pk_bf16(v0[0], v0[1]); w.y = cvt_pk_bf16(v0[2], v0[3]); w.z = cvt_pk_bf16(v1[0], v1[1]); w.w = cvt_pk_bf16(v1[2], v1[3]);
                    *(u32x4*)(O + off + bj * HALF) = w; } }
    }
};
struct EpiSwiGLU {
    static constexpr bool PERM = true;
    bf16_t* H;
    __device__ __forceinline__ void operator()(const f32x4 (&acc)[2][2][4][2], const Unit& u, int wr, int wc, int fr, int fq) const {
        const int row0 = u.pm * BM + wr * 64 + fr, col0 = u.pn * HALF + wc * 32 + 8 * fq;
#pragma unroll
        for (int ai = 0; ai < 2; ++ai)
#pragma unroll
            for (int m = 0; m < 4; ++m) { bf16_t* rowp = H + (size_t)(row0 + ai * HALF + m * 16) * 512 + col0;
                f32x4 v0, v1;
#pragma unroll
                for (int e = 0; e < 4; ++e) { const float a0 = acc[ai][0][m][0][e], a1 = acc[ai][0][m][1][e];
                    v0[e] = a0 * fsigmoid(a0) * acc[ai][1][m][0][e]; v1[e] = a1 * fsigmoid(a1) * acc[ai][1][m][1][e]; }
                u32x4 w; w.x = cvt_pk_bf16(v0[0], v0[1]); w.y = cvt_pk_bf16(v0[2], v0[3]); w.z = cvt_pk_bf16(v1[0], v1[1]); w.w = cvt_pk_bf16(v1[2], v1[3]);
                *(u32x4*)rowp = w; }
    }
};
struct MoeOrder {
    int nunits, G, c, cshift; const PG8_LAS int* tile_e;
    __device__ __forceinline__ bool next(int i, Unit& u) const {
        const int L = i * G + c; if (L >= nunits) return false;
        u.pm = L >> cshift; u.pn = L & ((1 << cshift) - 1); u.e = tile_e[u.pm]; return true;
    }
};
}
#include <hip/hip_bf16.h>
#include <cmath>
namespace attn_body {
using bf16=__hip_bfloat16;
using bf16x8=__attribute__((ext_vector_type(8)))short;
using s16x4=__attribute__((ext_vector_type(4)))short;
using f32x16=__attribute__((ext_vector_type(16)))float;
using u32x4=__attribute__((ext_vector_type(4)))unsigned;
constexpr int BATCH=2,NHEAD=8,SEQ=16384,D=64,DM=NHEAD*D;
constexpr int NW=8,QBLK=32,QB=QBLK*NW,KVBLK=64,NQB=SEQ/QB;
constexpr int ATTN_PITCH=DM, ATTN_UNIT_ROWS=QB;
__device__ __forceinline__ int crow(int r,int hi){return (r&3)+8*(r>>2)+4*hi;}
#define SBAR() __builtin_amdgcn_sched_barrier(0)
__device__ __forceinline__ void cmask(f32x16&p0,f32x16&p1,int jb,int qrel,int hi){
  const float NEG=-INFINITY; int x=qrel-64*jb-4*hi; asm volatile("":"+v"(x));
  #pragma unroll
  for(int r=0;r<16;++r){const int c=(r&3)+8*(r>>2); if(c>x)p0[r]=NEG; if(c+32>x)p1[r]=NEG;}
}

constexpr int NSLOT=3, SLOTB=8192;
constexpr int LDS_K=0, LDS_V=NSLOT*SLOTB, LDS_WS=2*NSLOT*SLOTB, LDS_OST=LDS_WS+NW*64*4, LDS_BYTES=LDS_OST+NW*4096;
constexpr float C2=0.125f*1.4426950408889634f;
__device__ __forceinline__ void glds16(const void*gsrc,unsigned lds_dst){unsigned keep;
  asm volatile("s_mov_b32 %0, m0\n\ts_mov_b32 m0, %2\n\ts_nop 0\n\tglobal_load_lds_dwordx4 %1, off\n\ts_mov_b32 m0, %0":"=&s"(keep):"v"(gsrc),"s"(lds_dst):"memory");}
__device__ __forceinline__ float max3f(float a,float b,float c){float r;asm("v_max3_f32 %0, %1, %2, %3":"=v"(r):"v"(a),"v"(b),"v"(c));return r;}
__device__ __forceinline__ float max2f(float a,float b){float r;asm("v_max_f32_e32 %0, %1, %2":"=v"(r):"v"(a),"v"(b));return r;}
__device__ __forceinline__ float fadd_s(float a,float b){float r;asm("v_add_f32_e32 %0, %1, %2":"=v"(r):"v"(a),"v"(b));return r;}
__device__ __forceinline__ float fsub_s(float a,float b){float r;asm("v_sub_f32_e32 %0, %1, %2":"=v"(r):"v"(a),"v"(b));return r;}
typedef float f32x2_t __attribute__((ext_vector_type(2))); typedef __bf16 bf16x2_t __attribute__((ext_vector_type(2)));
__device__ __forceinline__ unsigned cvtpk_s(float lo,float hi){f32x2_t v={lo,hi};bf16x2_t b=__builtin_convertvector(v,bf16x2_t);return __builtin_bit_cast(unsigned,b);}
#define WAIT_BAR(N) asm volatile("s_waitcnt vmcnt(" #N ") lgkmcnt(0)\n\ts_barrier":::"memory")

__device__ __forceinline__ void qkt(f32x16&p0,f32x16&p1,const char*Kslot,const bf16x8*qr,int r32,int hi){
  const char*kb=Kslot+hi*1024+r32*16;
  #pragma unroll
  for(int d0=0;d0<4;++d0){
    const bf16x8 b0=*reinterpret_cast<const bf16x8*>(kb+d0*2048);
    const bf16x8 b1=*reinterpret_cast<const bf16x8*>(kb+d0*2048+512);
    if(d0==0){p0=__builtin_amdgcn_mfma_f32_32x32x16_bf16(b0,qr[0],p0,0,0,0);p1=__builtin_amdgcn_mfma_f32_32x32x16_bf16(b1,qr[0],p1,0,0,0);}
    else{p0=__builtin_amdgcn_mfma_f32_32x32x16_bf16(b0,qr[d0],p0,0,0,0);p1=__builtin_amdgcn_mfma_f32_32x32x16_bf16(b1,qr[d0],p1,0,0,0);}}
}
typedef __attribute__((address_space(3))) const char* lds_cptr;
typedef short v4i16_t __attribute__((ext_vector_type(4)));
__device__ __forceinline__ void kload8(bf16x8*kf,lds_cptr kp){
  kf[0]=*(const __attribute__((address_space(3))) bf16x8*)(kp);      kf[1]=*(const __attribute__((address_space(3))) bf16x8*)(kp+512);
  kf[2]=*(const __attribute__((address_space(3))) bf16x8*)(kp+2048); kf[3]=*(const __attribute__((address_space(3))) bf16x8*)(kp+2560);
  kf[4]=*(const __attribute__((address_space(3))) bf16x8*)(kp+4096); kf[5]=*(const __attribute__((address_space(3))) bf16x8*)(kp+4608);
  kf[6]=*(const __attribute__((address_space(3))) bf16x8*)(kp+6144); kf[7]=*(const __attribute__((address_space(3))) bf16x8*)(kp+6656);
}
__device__ __forceinline__ void kload2(bf16x8*kf,lds_cptr kp,int j){ kf[2*j]=*(const __attribute__((address_space(3))) bf16x8*)(kp+j*2048); kf[2*j+1]=*(const __attribute__((address_space(3))) bf16x8*)(kp+j*2048+512); }
__device__ __forceinline__ s16x4 vtr(lds_cptr p){ return __builtin_bit_cast(s16x4,__builtin_amdgcn_ds_read_tr16_b64_v4i16((__attribute__((address_space(3))) v4i16_t*)p)); }
__device__ __forceinline__ float rowmax(const f32x16&p0,const f32x16&p1){
  float a=max3f(p0[0],p0[1],p1[0]),b=max3f(p0[2],p0[3],p1[1]);a=max3f(a,p1[2],p1[3]);
  #pragma unroll
  for(int r=4;r<16;r+=4){a=max3f(a,p0[r],p0[r+1]);b=max3f(b,p0[r+2],p0[r+3]);a=max3f(a,p1[r],p1[r+1]);b=max3f(b,p1[r+2],p1[r+3]);}
  const float m=max2f(a,b);
  auto rr=__builtin_amdgcn_permlane32_swap(__float_as_uint(m),__float_as_uint(m),false,false);
  return max2f(__uint_as_float(rr[0]),__uint_as_float(rr[1]));
}
__device__ __forceinline__ void pv(f32x16*o,int vb,bf16x8 pa0,bf16x8 pa1,bf16x8 pa2,bf16x8 pa3){
  #pragma unroll
  for(int d0=0;d0<2;++d0){s16x4 lo[4],hi[4];
    #pragma unroll
    for(int ks=0;ks<4;++ks){
      asm volatile("ds_read_b64_tr_b16 %0,%1 offset:%c2":"=&v"(lo[ks]):"v"(vb),"i"(d0*4096+ks*1024):"memory");
      asm volatile("ds_read_b64_tr_b16 %0,%1 offset:%c2":"=&v"(hi[ks]):"v"(vb),"i"(d0*4096+ks*1024+512):"memory");}
    asm volatile("s_waitcnt lgkmcnt(0)":::"memory");SBAR();
    #define PK(k) (bf16x8){lo[k][0],lo[k][1],lo[k][2],lo[k][3],hi[k][0],hi[k][1],hi[k][2],hi[k][3]}
    o[d0]=__builtin_amdgcn_mfma_f32_32x32x16_bf16(pa0,PK(0),o[d0],0,0,0);
    o[d0]=__builtin_amdgcn_mfma_f32_32x32x16_bf16(pa1,PK(1),o[d0],0,0,0);
    o[d0]=__builtin_amdgcn_mfma_f32_32x32x16_bf16(pa2,PK(2),o[d0],0,0,0);
    o[d0]=__builtin_amdgcn_mfma_f32_32x32x16_bf16(pa3,PK(3),o[d0],0,0,0);
    #undef PK
  }
}

#ifndef ATTN_STORE16
#define ATTN_STORE16(p,v) (*(u32x4*)(p)=(v))
#endif
typedef float f32x4_t __attribute__((ext_vector_type(4)));
#define NEXTB(P0,P1,tt) do{ const __attribute__((address_space(3))) float* tb_=tab3+(tt)*64+4*hi; const float nm_=-mhat; \
  _Pragma("unroll") for(int g_=0;g_<4;++g_){ const f32x4_t b0_=*(const __attribute__((address_space(3))) f32x4_t*)(tb_+8*g_); const f32x4_t b1_=*(const __attribute__((address_space(3))) f32x4_t*)(tb_+32+8*g_); \
    _Pragma("unroll") for(int j_=0;j_<4;++j_){ P0[4*g_+j_]=nm_-b0_[j_]; P1[4*g_+j_]=nm_-b1_[j_]; } } }while(0)
template<int THRL> __device__ __forceinline__ void attn_unit(int b,int h,int qb,int t0,const bf16*Q,const bf16*__restrict__ K,const bf16*__restrict__ V,bf16*O,const float*__restrict__ cumT,char*shm,int tab_off,int segp_off,unsigned*qctr){
  const int tid=threadIdx.x,lane=tid&63,r32=lane&31,hi=lane>>5; const int wid=__builtin_amdgcn_readfirstlane(tid>>6);
  const long rowbase=(long)b*SEQ; const int q0=qb*QB;
  const bf16*Qw=Q+(rowbase+q0+wid*QBLK)*DM+h*D;
  const bf16*Kh=K+(rowbase+(long)t0*KVBLK)*DM+h*D,*Vh=V+(rowbase+(long)t0*KVBLK)*DM+h*D;
  const unsigned lds0=(unsigned)(uintptr_t)shm;
  float*wsf=(float*)(shm+LDS_WS)+wid*64;
  const bf16*ksrc=Kh+(long)lane*DM+wid*8;
  const bf16*vsrc=Vh+(long)(16*(wid&3)+(lane>>2))*DM+(wid>>2)*32+(lane&3)*8;
  const unsigned kdst=lds0+LDS_K+wid*1024, vdst=lds0+LDS_V+wid*1024;
  #define DMA_K(t,slot) glds16(ksrc+(long)(t)*KVBLK*DM,(unsigned)__builtin_amdgcn_readfirstlane(kdst+(slot)))
  #define DMA_V(t,slot) glds16(vsrc+(long)(t)*KVBLK*DM,(unsigned)__builtin_amdgcn_readfirstlane(vdst+(slot)))
  const int vb0=(int)(lds0+LDS_V)+((lane>>4)&1)*32+(lane&3)*8+(4*hi+((lane&15)>>2))*64;
  const char*Kbase=shm+LDS_K; bf16x8 kf[8];
  const lds_cptr shm3=(lds_cptr)shm; const lds_cptr kp0=shm3+LDS_K+hi*1024+r32*16; const lds_cptr vp0=shm3+LDS_V+((lane>>4)&1)*32+(lane&3)*8+(4*hi+((lane&15)>>2))*64;
  const int NT=(q0+QB)/KVBLK-t0;
  const __attribute__((address_space(3))) float* tab3=(const __attribute__((address_space(3))) float*)(shm3+tab_off);
  { int tl_=threadIdx.x; asm volatile("":"+v"(tl_));
    float*tabw=(float*)(shm+tab_off); const float L2E=1.4426950408889634f;
    const float*cg=cumT+((long)(b*NHEAD+h))*SEQ; const float cref=cg[q0]*L2E;
    for(int i=tl_;i<NT*KVBLK;i+=NW*64){ const int kv=t0*KVBLK+i; tabw[i]=cg[kv]*L2E-cref; }
    asm volatile("s_waitcnt vmcnt(0) lgkmcnt(0)\n\ts_barrier":::"memory"); }
  DMA_K(0,0);DMA_V(0,0);DMA_K(1,SLOTB);
  bf16x8 qr[4];
  #pragma unroll
  for(int d0=0;d0<4;++d0)qr[d0]=*reinterpret_cast<const bf16x8*>(&Qw[(long)r32*DM+d0*16+hi*8]);
  float mhat=0.f,l_reg=0.f;f32x16 o[2];o[0]=f32x16{};o[1]=f32x16{};
  const int qrel=wid*QBLK+r32;
  #define CMASK(P0,P1,t) do{int jb_=(t)-(NT-4); if(jb_>=0)cmask(P0,P1,jb_,qrel,hi);}while(0)
  bool resc=false;
  #define START(P0,P1) do{ const float rm=rowmax(P0,P1); resc=false; \
    { const float dl=rm; mhat=fadd_s(mhat,dl); \
      _Pragma("unroll") for(int r=0;r<16;++r){P0[r]=fsub_s(P0[r],dl);P1[r]=fsub_s(P1[r],dl);} \
      } \
    _Pragma("unroll") for(int r=0;r<16;++r)P0[r]=__builtin_amdgcn_exp2f(P0[r]); }while(0)
  #define RESC() do{ if(resc){ asm volatile("s_waitcnt lgkmcnt(0)":::"memory"); \
      _Pragma("unroll") for(int d_=0;d_<2;++d_) _Pragma("unroll") for(int r=0;r<16;++r)o[d_][r]*=wsf[crow(r,hi)]; } }while(0)
  f32x16 pA0,pA1,pB0,pB1;
  int sl_prev=0,sl_cur=0,sl_next=SLOTB;
  #define ROT() do{sl_prev=sl_cur;sl_cur=sl_next;sl_next=(sl_next==(NSLOT-1)*SLOTB)?0:sl_next+SLOTB;}while(0)
  DMA_K(2,2*SLOTB);
  WAIT_BAR(3);
  NEXTB(pA0,pA1,0);
  qkt(pA0,pA1,Kbase,qr,r32,hi);asm volatile("s_nop 15\n\ts_nop 7":"+v"(pA0),"+v"(pA1));CMASK(pA0,pA1,0);
  START(pA0,pA1);
  NEXTB(pB0,pB1,1);
  _Pragma("unroll") for(int r=0;r<16;++r)pA1[r]=__builtin_amdgcn_exp2f(pA1[r]);
  WAIT_BAR(0);
  DMA_K(3,0);DMA_V(1,SLOTB);
  ROT();
  kload8(kf,kp0+sl_cur);
  WAIT_BAR(2);
  s16x4 vlo[8],vhi[8]; u32x4 pw0,pw1,pw2,pw3;
  #define PKW(P,B) cvtpk_s(P[B],P[B+1])
  #define PAF(k) __builtin_bit_cast(bf16x8,pw##k)
  #define VFR(i) (bf16x8){vlo[i][0],vlo[i][1],vlo[i][2],vlo[i][3],vhi[i][0],vhi[i][1],vhi[i][2],vhi[i][3]}
  #define PIN(x) asm volatile("":"+v"(x))
  #define MX3(a,b,c) __builtin_fmaxf(__builtin_fmaxf((a),(b)),(c))
  #define GAPA(MF,A0,A1,A2,A3,W0,W1,PW) do{ MF; sacc+=A0; sacc+=A1; sacc+=A2; sacc+=A3; PIN(sacc); W0; W1; PIN(PW); SBAR(); }while(0)
  #define EX(v) __builtin_amdgcn_exp2f(v)
  #define GAPB(MF,X,B) do{ MF; X[B]=EX(X[B]); X[B+1]=EX(X[B+1]); X[B+2]=EX(X[B+2]); X[B+3]=EX(X[B+3]); PIN(X); SBAR(); }while(0)
  #define VRD(i) do{ vlo[i]=vtr(vp_+(((i)>>2)*4096+((i)&3)*1024)); vhi[i]=vtr(vp_+(((i)>>2)*4096+((i)&3)*1024+512)); }while(0)
  #define KRD(G,j) do{ if(G){ kload2(kf,kp0+sl_next,j); SBAR(); } }while(0)
  #define STEP(C0,C1,P0,P1,t,GK,GV,GL) do{ SBAR(); \
    const lds_cptr vp_=vp0+sl_prev; \
    VRD(0); SBAR(); float sacc=(P0[0]+P0[1]); \
    GAPA(C0=__builtin_amdgcn_mfma_f32_32x32x16_bf16(kf[0],qr[0],C0,0,0,0), P0[2],P0[3],P0[4],P0[5],     pw0[0]=PKW(P0,0), pw0[1]=PKW(P0,2), pw0); \
    VRD(4); SBAR(); GAPA(C1=__builtin_amdgcn_mfma_f32_32x32x16_bf16(kf[1],qr[0],C1,0,0,0), P0[6],P0[7],P0[8],P0[9],     pw0[2]=PKW(P0,4), pw0[3]=PKW(P0,6), pw0); \
    VRD(1); SBAR(); GAPA(C0=__builtin_amdgcn_mfma_f32_32x32x16_bf16(kf[2],qr[1],C0,0,0,0),   P0[10],P0[11],P0[12],P0[13], pw1[0]=PKW(P0,8), pw1[1]=PKW(P0,10), pw1); \
    VRD(5); SBAR(); GAPA(C1=__builtin_amdgcn_mfma_f32_32x32x16_bf16(kf[3],qr[1],C1,0,0,0),   P0[14],P0[15],P1[0],P1[1],   pw1[2]=PKW(P0,12),pw1[3]=PKW(P0,14), pw1); \
    VRD(2); SBAR(); GAPA(C0=__builtin_amdgcn_mfma_f32_32x32x16_bf16(kf[4],qr[2],C0,0,0,0),   P1[2],P1[3],P1[4],P1[5],     pw2[0]=PKW(P1,0), pw2[1]=PKW(P1,2), pw2); \
    VRD(6); SBAR(); GAPA(C1=__builtin_amdgcn_mfma_f32_32x32x16_bf16(kf[5],qr[2],C1,0,0,0),   P1[6],P1[7],P1[8],P1[9],     pw2[2]=PKW(P1,4), pw2[3]=PKW(P1,6), pw2); \
    VRD(3); SBAR(); GAPA(C0=__builtin_amdgcn_mfma_f32_32x32x16_bf16(kf[6],qr[3],C0,0,0,0),   P1[10],P1[11],P1[12],P1[13], pw3[0]=PKW(P1,8), pw3[1]=PKW(P1,10), pw3); \
    VRD(7); SBAR(); GAPA(C1=__builtin_amdgcn_mfma_f32_32x32x16_bf16(kf[7],qr[3],C1,0,0,0),   P1[14],P1[15],0.f,0.f,       pw3[2]=PKW(P1,12),pw3[3]=PKW(P1,14), pw3); \
    l_reg+=sacc; \
    if(GK){DMA_K((t)+3,sl_cur);} if(GV){DMA_V((t)+1,sl_next);} \
    CMASK(C0,C1,t); \
    { float a=MX3(C0[0],C0[1],C1[0]),b=MX3(C0[2],C0[3],C1[1]); a=MX3(a,C1[2],C1[3]); \
      _Pragma("unroll") for(int r=4;r<16;r+=4){a=MX3(a,C0[r],C0[r+1]);b=MX3(b,C0[r+2],C0[r+3]);a=MX3(a,C1[r],C1[r+1]);b=MX3(b,C1[r+2],C1[r+3]);} \
      float rm=__builtin_fmaxf(a,b); { auto rr=__builtin_amdgcn_permlane32_swap(__float_as_uint(rm),__float_as_uint(rm),false,false); rm=__builtin_fmaxf(__uint_as_float(rr[0]),__uint_as_float(rr[1])); } \
      resc=false; \
      if(__builtin_expect(__any(rm>(float)THRL),0)){ const float dl=__builtin_fmaxf(rm,0.f); mhat+=dl; \
        _Pragma("unroll") for(int r=0;r<16;++r){C0[r]-=dl;C1[r]-=dl;} \
        const float f=__builtin_amdgcn_exp2f(-dl); l_reg*=f; if(hi==0)wsf[r32]=f; resc=true; } } \
    if(GL){NEXTB(P0,P1,(t)+1);} \
    SBAR(); \
    GAPB(o[0]=__builtin_amdgcn_mfma_f32_32x32x16_bf16(PAF(0),VFR(0),o[0],0,0,0), C0,0); \
    GAPB(o[1]=__builtin_amdgcn_mfma_f32_32x32x16_bf16(PAF(0),VFR(4),o[1],0,0,0), C0,4); \
    KRD(GL,0); GAPB(o[0]=__builtin_amdgcn_mfma_f32_32x32x16_bf16(PAF(1),VFR(1),o[0],0,0,0), C0,8); \
    KRD(GL,1); GAPB(o[1]=__builtin_amdgcn_mfma_f32_32x32x16_bf16(PAF(1),VFR(5),o[1],0,0,0), C0,12); \
    KRD(GL,2); GAPB(o[0]=__builtin_amdgcn_mfma_f32_32x32x16_bf16(PAF(2),VFR(2),o[0],0,0,0), C1,0); \
    KRD(GL,3); GAPB(o[1]=__builtin_amdgcn_mfma_f32_32x32x16_bf16(PAF(2),VFR(6),o[1],0,0,0), C1,4); \
    GAPB(o[0]=__builtin_amdgcn_mfma_f32_32x32x16_bf16(PAF(3),VFR(3),o[0],0,0,0), C1,8); \
    GAPB(o[1]=__builtin_amdgcn_mfma_f32_32x32x16_bf16(PAF(3),VFR(7),o[1],0,0,0), C1,12); \
    }while(0)
  int t=1;
  #undef CMASK
  #define CMASK(P0,P1,t) do{}while(0)
  for(;t+5<NT;t+=2){
    STEP(pB0,pB1,pA0,pA1,t,true,true,true);     WAIT_BAR(2); RESC(); ROT();
    STEP(pA0,pA1,pB0,pB1,t+1,true,true,true);   WAIT_BAR(2); RESC(); ROT();
  }
  #undef CMASK
  #define CMASK(P0,P1,t) do{int jb_=(t)-(NT-4); if(jb_>=0)cmask(P0,P1,jb_,qrel,hi);}while(0)
  #define ENDW(tt) do{ if((tt)+3<NT){WAIT_BAR(2);} else if((tt)+2<NT){WAIT_BAR(1);} else {WAIT_BAR(0);} }while(0)
  for(;t+1<NT;t+=2){
    STEP(pB0,pB1,pA0,pA1,t,(t+3<NT),(t+1<NT),(t+1<NT));       ENDW(t);   RESC(); ROT();
    STEP(pA0,pA1,pB0,pB1,t+1,(t+4<NT),(t+2<NT),(t+2<NT));     ENDW(t+1); RESC(); ROT();
  }
  STEP(pB0,pB1,pA0,pA1,NT-1,false,false,false); RESC();
  { float sacc=pB0[0]+pB0[1]; _Pragma("unroll") for(int r=2;r<16;++r)sacc+=pB0[r]; _Pragma("unroll") for(int r=0;r<16;++r)sacc+=pB1[r]; l_reg+=sacc;
    pw0=(u32x4){PKW(pB0,0),PKW(pB0,2),PKW(pB0,4),PKW(pB0,6)};pw1=(u32x4){PKW(pB0,8),PKW(pB0,10),PKW(pB0,12),PKW(pB0,14)};pw2=(u32x4){PKW(pB1,0),PKW(pB1,2),PKW(pB1,4),PKW(pB1,6)};pw3=(u32x4){PKW(pB1,8),PKW(pB1,10),PKW(pB1,12),PKW(pB1,14)};
    SBAR(); pv(o,vb0+sl_cur,PAF(0),PAF(1),PAF(2),PAF(3)); }
  #undef PKW
  #undef PAF
  #undef VFR
  #undef PIN
  #undef MX3
  #undef GAPA
  #undef GAPB
  #undef EX
  #undef VRD
  #undef KRD
  #undef STEP
  #undef ENDW
  {auto rr=__builtin_amdgcn_permlane32_swap(__float_as_uint(l_reg),__float_as_uint(l_reg),false,false);l_reg=__uint_as_float(rr[0])+__uint_as_float(rr[1]);}
  int un_=0; if(threadIdx.x==0)un_=(int)__hip_atomic_fetch_add(qctr,1u,__ATOMIC_RELAXED,__HIP_MEMORY_SCOPE_AGENT);
  int lane_e=threadIdx.x&63; asm volatile("":"+v"(lane_e));
  const int r32e=lane_e&31,hie=lane_e>>5;
  if(hie==0)wsf[32+r32e]=l_reg;asm volatile("s_waitcnt lgkmcnt(0)":::"memory");
  float rli[16];
  #pragma unroll
  for(int r=0;r<16;++r)rli[r]=__builtin_amdgcn_rcpf(wsf[32+crow(r,hie)]);
  bf16*Ow=O+(rowbase+q0+wid*QBLK)*DM+h*D;
  { bf16*stg=(bf16*)(shm+LDS_OST)+wid*2048;
    #pragma unroll
    for(int r=0;r<16;++r){const int orow=crow(r,hie);
      #pragma unroll
      for(int d0=0;d0<2;++d0)stg[orow*64+d0*32+r32e]=__float2bfloat16(o[d0][r]*rli[r]);}
    asm volatile("s_waitcnt lgkmcnt(0)":::"memory");
    #pragma unroll
    for(int i=0;i<4;++i){const int row=i*8+(lane_e>>3),ch=lane_e&7; const u32x4 v=*(const u32x4*)(stg+row*64+ch*8); ATTN_STORE16(Ow+(long)row*DM+ch*8,v);} }
  if(threadIdx.x==0)*(volatile int*)(shm+segp_off)=un_;
  asm volatile("s_waitcnt lgkmcnt(0)\n\ts_barrier":::"memory");
  #undef DMA_K
  #undef DMA_V
  #undef CMASK
  #undef START
  #undef RESC
  #undef ROT
}
constexpr int ATTN_LDS_BYTES=LDS_BYTES;
struct AttnTensors { const bf16* Q; const bf16* K; const bf16* V; bf16* O; const float* cumT; const float* segtot; };
struct AttnUnit { int bh; int qb; };
struct StaticOrder {
  int vcu;
  __device__ __forceinline__ explicit StaticOrder(int grid,int block):vcu((block%8)*(grid/8)+block/8){}
  __device__ __forceinline__ bool next(int i,AttnUnit&u)const{ if(i>=4||vcu>=256)return false; const int s=vcu&15; u.bh=vcu>>4; u.qb=(i==0)?63-s:(i==1)?32+s:(i==2)?31-s:s; return true; }
  __device__ __forceinline__ void a_ready(const AttnUnit&)const{}
  __device__ __forceinline__ void done(const AttnUnit&)const{}
};
constexpr float PRUNE_THR=20.0f;
template<int THRL=8> __device__ __forceinline__ void attn_phase_dyn(char*lds,const AttnTensors&T,unsigned*ctr,const unsigned*qkmax,int tab_off,int segp_off){
  volatile int*slot=(volatile int*)(lds+segp_off);
  __syncthreads();
  if(threadIdx.x==0)slot[0]=(int)__hip_atomic_fetch_add(ctr,1u,__ATOMIC_RELAXED,__HIP_MEMORY_SCOPE_AGENT);
  __syncthreads();
  for(;;){
    int tid=threadIdx.x; asm volatile("":"+v"(tid));
    const int u=slot[0]; if(u>=BATCH*NHEAD*NQB)break;
    const int bh=u&15, qb=(NQB-1)-(u>>4), b=bh/NHEAD, h=bh%NHEAD, q0=qb*QB;
    const float qm=__uint_as_float(qkmax[bh*2]), km=__uint_as_float(qkmax[bh*2+1]);
    const float L2E=1.4426950408889634f; const float*cg=T.cumT+((long)(b*NHEAD+h))*SEQ;
    const float cgk=cg[(tid<4*qb)?64*tid+63:q0], cg0=cg[q0];
    float dg;
    { const int row=tid>>1, hf=tid&1; const long ro=((long)b*SEQ+q0+row)*DM+h*D+32*hf; const u32x4*qp=(const u32x4*)(T.Q+ro); const u32x4*kp=(const u32x4*)(T.K+ro); float d=0.f;
      #pragma unroll
      for(int c4=0;c4<4;++c4){ const u32x4 qa=qp[c4], ka=kp[c4];
        #pragma unroll
        for(int e=0;e<4;++e){ d+=__uint_as_float(qa[e]<<16)*__uint_as_float(ka[e]<<16)+__uint_as_float(qa[e]&0xffff0000u)*__uint_as_float(ka[e]&0xffff0000u); } }
      d+=__shfl_xor(d,1);
      #pragma unroll
      for(int o=2;o<64;o<<=1)d=fminf(d,__shfl_xor(d,o));
      dg=d; }
    float*slotf=(float*)(lds+segp_off)+16;
    if((tid&63)==0)slotf[tid>>6]=dg;
    __syncthreads();
    float dmin=slotf[0];
    #pragma unroll
    for(int w=1;w<NW;++w)dmin=fminf(dmin,slotf[w]);
    const float X=PRUNE_THR+sqrtf(qm*km)-dmin+1.5f;
    const bool skip=(tid<4*qb)&&((cgk-cg0)*L2E>X);
    const unsigned long long bal=__ballot(skip); if((tid&63)==0)slot[1+(tid>>6)]=__popcll(bal);
    __syncthreads();
    int t0=0;
    #pragma unroll
    for(int w=0;w<NW;++w)t0+=slot[1+w];
    t0&=~1;
    attn_unit<THRL>(b,h,qb,t0,T.Q,T.K,T.V,T.O,T.cumT,lds,tab_off,segp_off,ctr);
  }
}
#undef SBAR
#undef WAIT_BAR
}
#define GAS __attribute__((address_space(1)))
#define LAS __attribute__((address_space(3)))
typedef unsigned short bf16;
typedef unsigned v4u __attribute__((ext_vector_type(4)));
typedef float f32x4 __attribute__((ext_vector_type(4)));
typedef short bf16x8 __attribute__((ext_vector_type(8)));
typedef GAS unsigned gu32;
typedef GAS unsigned long long gu64;
#define RLX_AGENT __ATOMIC_RELAXED, __HIP_MEMORY_SCOPE_AGENT
#define LDS_WAIT() asm volatile("s_waitcnt lgkmcnt(0)" ::: "memory")
#define VM_WAIT() asm volatile("s_waitcnt vmcnt(0)" ::: "memory")
__device__ __forceinline__ unsigned long long rt() { return __builtin_amdgcn_s_memrealtime(); }
typedef float pk_f32x2 __attribute__((ext_vector_type(2))); typedef __bf16 pk_bf16x2 __attribute__((ext_vector_type(2)));
__device__ __forceinline__ unsigned pk2(float lo, float hi) { pk_f32x2 v = {lo, hi}; pk_bf16x2 b = __builtin_convertvector(v, pk_bf16x2); return __builtin_bit_cast(unsigned, b); }
__device__ __forceinline__ unsigned f2bf(float f) { return pk2(f, 0.f) & 0xffffu; }

#define XB_TMO      128
#define XB_XCNT(j)  (256  + 64 * (j))
#define XB_XSUB(j)  (1280 + 64 * (j))
#define XB_XGEN(j)  (2304 + 64 * (j))
#define XB_TOP      3328
#define XB_TOPGEN   3392
#define XCD_BAR_WORDS 3456
#define XB_SPIN_CAP (1u << 18)

__device__ __forceinline__ unsigned xb_ld(unsigned* p)              { return __hip_atomic_load(p, __ATOMIC_RELAXED, __HIP_MEMORY_SCOPE_AGENT); }
__device__ __forceinline__ unsigned xb_add(unsigned* p, unsigned v) { return __hip_atomic_fetch_add(p, v, __ATOMIC_RELAXED, __HIP_MEMORY_SCOPE_AGENT); }
__device__ __forceinline__ unsigned xb_xcc_id() { return (unsigned)__builtin_amdgcn_s_getreg((3 << 11) | 20) & 0xFu; }
#define XB_SPIN(cond, bar) do { unsigned _sp = 0; while (cond) { __builtin_amdgcn_s_sleep(1); \
    if ((++_sp & 255u) == 0u) { if (xb_ld(&(bar)[XB_TMO])) break; if (_sp > XB_SPIN_CAP) { atomicAdd(&(bar)[XB_TMO], 1u); break; } } } } while (0)

struct XcdBarrier {
    unsigned* bar; unsigned x;
    volatile LAS unsigned* st;
};

__device__ __forceinline__ XcdBarrier xcd_barrier_post(unsigned* bar, volatile LAS unsigned* st) {
    XcdBarrier b; b.bar = bar; b.x = xb_xcc_id(); b.st = st;
    if (threadIdx.x == 0) (void)xb_add(&bar[XB_XCNT(b.x)], 1u);
    return b;
}
__device__ __forceinline__ void xcd_barrier_complete(unsigned* bar, unsigned x, unsigned& nloc, unsigned& nx) {
    const unsigned G = gridDim.x * gridDim.y * gridDim.z;
    unsigned sum, cnt, mine, sp = 0u;
    for (;;) {
        sum = 0u; cnt = 0u; mine = 0u;
#pragma unroll
        for (unsigned j = 0; j < 16; ++j) { const unsigned c = xb_ld(&bar[XB_XCNT(j)]); sum += c; cnt += (c > 0u) ? 1u : 0u; mine = (j == x) ? c : mine; }
        if (sum == G) break;
        __builtin_amdgcn_s_sleep(1);
        if ((++sp & 255u) == 0u) { if (xb_ld(&bar[XB_TMO])) break; if (sp > XB_SPIN_CAP) { atomicAdd(&bar[XB_TMO], 1u); break; } }
    }
    nloc = mine > 0u ? mine : 1u; nx = cnt > 0u ? cnt : 1u;
}

__device__ __forceinline__ void xcd_barrier(const XcdBarrier& b) {
    asm volatile("s_waitcnt vmcnt(0)" ::: "memory");
    __syncthreads();
    if (threadIdx.x == 0) {
        unsigned* bar = b.bar;
        __builtin_amdgcn_s_waitcnt(0);
        unsigned nloc = b.st[0], nx = b.st[1];
        if (nloc == 0u) { xcd_barrier_complete(bar, b.x, nloc, nx); b.st[0] = nloc; b.st[1] = nx; }
        const unsigned old = xb_add(&bar[XB_XSUB(b.x)], 1u);
        const unsigned gen = old / nloc;
        if (old + 1u == (gen + 1u) * nloc) {
            __builtin_amdgcn_fence(__ATOMIC_RELEASE, "agent");
            asm volatile("s_waitcnt vmcnt(0)" ::: "memory");
            const unsigned og = xb_add(&bar[XB_TOP], 1u);
            const unsigned tg = og / nx;
            if (og + 1u == (tg + 1u) * nx) xb_add(&bar[XB_TOPGEN], 1u);
            else XB_SPIN(xb_ld(&bar[XB_TOPGEN]) == tg, bar);
            __builtin_amdgcn_fence(__ATOMIC_ACQUIRE, "agent");
            xb_add(&bar[XB_XGEN(b.x)], 1u);
            asm volatile("s_waitcnt vmcnt(0)" ::: "memory");
        } else {
            XB_SPIN(xb_ld(&bar[XB_XGEN(b.x)]) == gen, bar);
            __builtin_amdgcn_fence(__ATOMIC_ACQUIRE, "agent");
            asm volatile("s_waitcnt vmcnt(0)" ::: "memory");
        }
    }
    __syncthreads();
}

constexpr int NWAVES = 8;
constexpr int BATCH = 2, SEQ = 16384, D = 1024, M = BATCH * SEQ;
constexpr int FH = 8, FW = 512, RWW = 512, SHW = 1792, DIN = 5384, NIN = 5376;
constexpr int NE = 32, DE = 512, NROUTE = 36;
constexpr int MAXSLOT = 2 * M + NE * 256;
constexpr int MAXTILE = MAXSLOT / 256;
constexpr float ATT_C2 = 0.125f * 1.4426950408889634f;

constexpr size_t MiB = 1u << 20;
constexpr size_t WS_CTL = 0, CTL_ZERO_BYTES = 1 * MiB;
constexpr size_t WS_MOD = 1 * MiB;
constexpr size_t WS_SEGTOT = 1 * MiB + 64 * 1024;
constexpr size_t WS_BLKCNT = 1 * MiB + 96 * 1024;
constexpr size_t WS_WIN = 2 * MiB;
constexpr size_t WS_WOF = 13 * MiB, WS_WOR = 14 * MiB, WS_WO = 15 * MiB;
constexpr size_t WS_LW2 = 17 * MiB, WS_LA2 = 17 * MiB + 64 * 1024, WS_LG2 = 17 * MiB + 128 * 1024;
constexpr size_t WS_CUM = 18 * MiB;
constexpr size_t WS_ROUTE = 19 * MiB;
constexpr size_t WS_ROWTOK = 20 * MiB;
constexpr size_t WS_BON = 21 * MiB;
constexpr size_t WS_XN = 24 * MiB;
constexpr size_t WS_Q = 88 * MiB, WS_K = 120 * MiB, WS_V = 152 * MiB;
constexpr size_t WS_PRW = 184 * MiB;
constexpr size_t WS_GATES = 296 * MiB;
constexpr size_t WS_F = 424 * MiB;
constexpr size_t WS_END = 512 * MiB;
constexpr size_t WS_Y = WS_K;
constexpr size_t WS_H = WS_Q;
constexpr size_t WS_W13 = WS_PRW, WS_W2T = WS_PRW + 64 * MiB;
constexpr size_t WS_TMP = WS_PRW;
constexpr size_t WS_YM = 280 * MiB;
constexpr size_t WS_X1 = 424 * MiB;
static_assert(WS_YM + (size_t)MAXSLOT * 1024 * 2 <= WS_END, "ws map");
static_assert(WS_H + (size_t)MAXSLOT * 512 * 2 <= WS_PRW, "ws map");
constexpr int CW_TMO = 0, CW_CODE = 1;
constexpr int CW_BAR = 4096;
constexpr int CW_QKMAX = 8192;
constexpr int CW_QUEUE = 8448;
constexpr int CW_DIAG = 8704;

constexpr int RING_OFF = 0, RING_BYTES = 131072;
constexpr int TAB_OFF = 83968;
constexpr int SEGP_OFF = TAB_OFF + 65536;
constexpr int TILE_OFF = 131072;
constexpr int LDSCTL_OFF = SEGP_OFF + 512, MISC_OFF = LDSCTL_OFF + 320;
constexpr int LDS_BYTES = LDSCTL_OFF + 512;
static_assert(attn_body::LDS_BYTES <= TAB_OFF, "attention LDS");


#define PHASE_IDS() int tid_ = threadIdx.x; asm volatile("" : "+v"(tid_)); const int lane_ = tid_ & 63; const int wave_ = __builtin_amdgcn_readfirstlane(tid_ >> 6); (void)lane_; (void)wave_
struct Frame {
    LAS unsigned char* lds;
    volatile LAS unsigned* MISC;
    gu32* ctl;
    int tid, lane, wave;
    int vcu, G;
    const float* const* in;
};
template <int CTRL> __device__ __forceinline__ float dpp_f(float v) { return __int_as_float(__builtin_amdgcn_mov_dpp(__float_as_int(v), CTRL, 0xf, 0xf, true)); }
__device__ __forceinline__ float row_sum16(float v) { v += dpp_f<0xB1>(v); v += dpp_f<0x4E>(v); v += dpp_f<0x141>(v); v += dpp_f<0x140>(v); return v; }
__device__ __forceinline__ float wave_sum(float v) { v = row_sum16(v); v += __shfl_xor(v, 16); v += __shfl_xor(v, 32); return v; }
__device__ __forceinline__ float bflo(unsigned w) { return __uint_as_float(w << 16); }
__device__ __forceinline__ float bfhi(unsigned w) { return __uint_as_float(w & 0xffff0000u); }
__device__ __forceinline__ float sigm(float x) { return 1.0f / (1.0f + __expf(-x)); }

__device__ __forceinline__ void transpose_item(const float* W, int ld, int col, int k0, int K, bf16* WT, size_t drow, LAS float* scr, int lane) {
#pragma unroll 8
    for (int i = 0; i < 32; ++i) { const int kk = 2 * i + (lane >> 5); scr[kk * 33 + (lane & 31)] = W[(size_t)(k0 + kk) * ld + col + (lane & 31)]; }
    LDS_WAIT(); asm volatile("" ::: "memory");
    const int c = lane & 7;
#pragma unroll
    for (int j = 0; j < 4; ++j) { const int n = (lane >> 3) + 8 * j; const LAS float* s = scr + (8 * c) * 33 + n;
        v4u o; o.x = pk2(s[0 * 33], s[1 * 33]); o.y = pk2(s[2 * 33], s[3 * 33]); o.z = pk2(s[4 * 33], s[5 * 33]); o.w = pk2(s[6 * 33], s[7 * 33]);
        *(GAS v4u*)(WT + (drow + n) * K + k0 + 8 * c) = o; }
    LDS_WAIT(); asm volatile("" ::: "memory");
}
__device__ __forceinline__ void conv_seg(Frame& F, const float* W, int ld, int col0, int K, int ncols, bf16* WT, size_t drow0) {
    PHASE_IDS();
    LAS float* scr = (LAS float*)(F.lds + RING_OFF + wave_ * 16384);
    const int gw = F.vcu * NWAVES + wave_, NGW = F.G * NWAVES, nkb = K / 64, nnb = ncols / 32;
    for (int it = gw; it < nkb * nnb; it += NGW) { const int kb = it / nnb, nb = it % nnb; transpose_item(W, ld, col0 + 32 * nb, 64 * kb, K, WT, drow0 + 32 * nb, scr, lane_); }
}

struct Args { const float* in[30]; float* out; unsigned char* ws; };

__device__ __forceinline__ void p0_prologue(Frame& F, const Args& A) {
    PHASE_IDS();
    unsigned char* ws = A.ws;
    if (blockIdx.x < 96) {
        const float* c = A.in[1]; const float* aw = A.in[2]; const float* ab = A.in[3];
        const int col = blockIdx.x * 64 + lane_; float a0 = 0.f, a1 = 0.f;
        const int kbeg = wave_ * 128;
#pragma unroll 8
        for (int k = kbeg; k < kbeg + 128; ++k) { const float wv = aw[(size_t)k * 6144 + col]; const float c0 = c[k], c1 = c[1024 + k];
            a0 += c0 * sigm(c0) * wv; a1 += c1 * sigm(c1) * wv; }
        LAS float* red = (LAS float*)(F.lds + 8 * 16384 - 4096);
        red[(wave_ * 2 + 0) * 64 + lane_] = a0; red[(wave_ * 2 + 1) * 64 + lane_] = a1;
        __syncthreads();
        if (wave_ < 2) { float s = 0.f;
#pragma unroll
            for (int w = 0; w < 8; ++w) s += red[(w * 2 + wave_) * 64 + lane_];
            ((float*)(ws + WS_MOD))[wave_ * 6144 + col] = s + ab[col]; }
        __syncthreads();
    }
}

__device__ __forceinline__ void p_convert_early(Frame& F, const Args& A) {
    unsigned char* ws = A.ws;
    const float* w_in = A.in[5];
    conv_seg(F, w_in, DIN, 0, 1024, 1536, (bf16*)(ws + WS_WIN), 0);
    conv_seg(F, w_in, DIN, 1544, 1024, 1792, (bf16*)(ws + WS_WIN), 1536);
    conv_seg(F, w_in, DIN, 3336, 1024, 2048, (bf16*)(ws + WS_WIN), 3328);
    conv_seg(F, A.in[18], 1024, 0, 512, 1024, (bf16*)(ws + WS_WOF), 0);
    conv_seg(F, A.in[19], 1024, 0, 512, 1024, (bf16*)(ws + WS_WOR), 0);
    conv_seg(F, A.in[20], 1024, 0, 1024, 1024, (bf16*)(ws + WS_WO), 0);
    conv_seg(F, A.in[9], 512, 0, 64, 512, (bf16*)(ws + WS_LW2), 0);
    conv_seg(F, A.in[11], 512, 0, 64, 512, (bf16*)(ws + WS_LA2), 0);
    conv_seg(F, A.in[12], 512, 0, 128, 512, (bf16*)(ws + WS_LG2), 0);
}

__device__ __forceinline__ void p1_norm(Frame& F, const Args& A) {
    PHASE_IDS();
    unsigned char* ws = A.ws;
    LAS float* wf = (LAS float*)(F.lds);
    LAS float* lfl = (LAS float*)(F.lds + 32768);
    LAS float* part = (LAS float*)(F.lds + 32768 + 4096);
    const float* x = A.in[0]; const float* g1 = A.in[4]; const float* w_in = A.in[5]; const float* fb = A.in[6];
    const float* mod = (const float*)(ws + WS_MOD);
    bf16* XN = (bf16*)(ws + WS_XN); float* cumT = (float*)(ws + WS_CUM); float* segtot = (float*)(ws + WS_SEGTOT);
    for (int i = tid_; i < 8192; i += NWAVES * 64) wf[(i & 7) * 1024 + (i >> 3)] = w_in[(size_t)(i >> 3) * DIN + 1536 + (i & 7)];
    __syncthreads();
    for (int blk = blockIdx.x; blk < M / 128; blk += F.G) {
        const int b = blk / (SEQ / 128);
        f32x4 gm[4], sh[4];
#pragma unroll
        for (int j = 0; j < 4; ++j) { const int col = 4 * lane_ + 256 * j; const f32x4 g = *(const f32x4*)(g1 + col), sc = *(const f32x4*)(mod + b * 6144 + 1024 + col);
            gm[j] = g * (sc + 1.0f); sh[j] = *(const f32x4*)(mod + b * 6144 + col); }
        float fbv = fb[((lane_ >> 5) & 1) * 4 + ((lane_ >> 4) & 1) * 2 + ((lane_ >> 3) & 1)];
        f32x4 nv[4];
        { const GAS f32x4* xr0 = (const GAS f32x4*)(x + ((size_t)blk * 128 + wave_ * 16) * D) + lane_;
#pragma unroll
          for (int j = 0; j < 4; ++j) nv[j] = xr0[64 * j]; }
        for (int i = 0; i < 16; ++i) {
            const int tl = wave_ * 16 + i; const size_t tok = (size_t)blk * 128 + tl;
            f32x4 v[4]; float s = 0.f;
#pragma unroll
            for (int j = 0; j < 4; ++j) { v[j] = nv[j]; s += (v[j].x * v[j].x + v[j].y * v[j].y) + (v[j].z * v[j].z + v[j].w * v[j].w); }
            if (i + 1 < 16) { const GAS f32x4* xr = (const GAS f32x4*)(x + (tok + 1) * D) + lane_;
#pragma unroll
                for (int j = 0; j < 4; ++j) nv[j] = xr[64 * j]; }
            const float rstd = 1.0f / sqrtf(wave_sum(s) * (1.f / D) + 1e-6f);
            GAS unsigned long long* o8 = (GAS unsigned long long*)(XN + tok * D) + lane_;
            float f[8];
#pragma unroll
            for (int hh = 0; hh < 8; ++hh) f[hh] = 0.f;
#pragma unroll
            for (int j = 0; j < 4; ++j) { v[j] = v[j] * rstd * gm[j] + sh[j];
                o8[64 * j] = (unsigned long long)pk2(v[j].x, v[j].y) | ((unsigned long long)pk2(v[j].z, v[j].w) << 32);
#pragma unroll
                for (int hh = 0; hh < 8; ++hh) { const f32x4 w4 = *(const LAS f32x4*)(wf + hh * 1024 + 4 * lane_ + 256 * j); f[hh] += (v[j].x * w4.x + v[j].y * w4.y) + (v[j].z * w4.z + v[j].w * w4.w); } }
            float g4[4], g2v[2], z;
            { const bool up = (lane_ & 32) != 0;
#pragma unroll
              for (int i = 0; i < 4; ++i) { const float keep = up ? f[4 + i] : f[i], send = up ? f[i] : f[4 + i]; g4[i] = keep + __shfl_xor(send, 32); } }
            { const bool up = (lane_ & 16) != 0;
#pragma unroll
              for (int i = 0; i < 2; ++i) { const float keep = up ? g4[2 + i] : g4[i], send = up ? g4[i] : g4[2 + i]; g2v[i] = keep + __shfl_xor(send, 16); } }
            { const bool up = (lane_ & 8) != 0; const float keep = up ? g2v[1] : g2v[0], send = up ? g2v[0] : g2v[1]; z = keep + __shfl_xor(send, 8); }
            z += __shfl_xor(z, 1); z += __shfl_xor(z, 2); z += __shfl_xor(z, 4);
            const int myh = ((lane_ >> 5) & 1) * 4 + ((lane_ >> 4) & 1) * 2 + ((lane_ >> 3) & 1);
            z += fbv;
            const float lf = (z >= 0.f) ? -log1pf(__expf(-z)) : z - log1pf(__expf(z));
            if ((lane_ & 7) == 0) lfl[tl * 8 + myh] = lf;
        }
        __syncthreads();
        const int hh = tid_ & 7, p = tid_ >> 3;
        if (tid_ < 64) { float run = 0.f; for (int i = 0; i < 16; ++i) { run += lfl[(p * 16 + i) * 8 + hh]; lfl[(p * 16 + i) * 8 + hh] = run; } part[p * 8 + hh] = run; }
        __syncthreads();
        if (tid_ < 64) { float off = 0.f; for (int q = 0; q < p; ++q) off += part[q * 8 + hh];
            const int t0 = (blk % (SEQ / 128)) * 128 + p * 16; float* dst = cumT + ((size_t)(b * 8 + hh)) * SEQ + t0;
            for (int i = 0; i < 16; ++i) dst[i] = lfl[(p * 16 + i) * 8 + hh] + off;
            if (p == 7) segtot[blk * 8 + hh] = off + part[7 * 8 + hh]; }
        __syncthreads();
    }
}


__device__ __forceinline__ void p_cumfix(Frame& F, const Args& A) {
    PHASE_IDS();
    unsigned char* ws = A.ws; float* cumT = (float*)(ws + WS_CUM); const float* segtot = (const float*)(ws + WS_SEGTOT);
    LAS float* pre = (LAS float*)(F.lds);
    for (int blk = blockIdx.x; blk < M / 128; blk += F.G) {
        const int b = blk / (SEQ / 128), seg = blk % (SEQ / 128);
        __syncthreads();
        if (tid_ < 64) { const int hh = tid_ & 7, part = tid_ >> 3; float a = 0.f; for (int s = part; s < seg; s += 8) a += segtot[(b * 128 + s) * 8 + hh];
            a += __shfl_xor(a, 8); a += __shfl_xor(a, 16); a += __shfl_xor(a, 32); if (part == 0) pre[hh] = a; }
        __syncthreads();
        for (int i = tid_; i < 8 * 128; i += NWAVES * 64) { const int hh = i >> 7, t = i & 127; cumT[((size_t)(b * 8 + hh)) * SEQ + seg * 128 + t] += pre[hh]; }
    }
}
__device__ __forceinline__ void p_qknorm(Frame& F, const Args& A, unsigned* qkmax) {
    PHASE_IDS();
    unsigned char* ws = A.ws; const bf16* Q = (const bf16*)(ws + WS_Q); const bf16* K = (const bf16*)(ws + WS_K);
    const int gw = F.vcu * NWAVES + wave_, NGW = F.G * NWAVES, hd = lane_ >> 3;
    float mq[2] = {0.f, 0.f}, mk[2] = {0.f, 0.f};
    for (int m = gw; m < M; m += NGW) { const int b = m / SEQ;
        const v4u qw = *(const v4u*)(Q + (size_t)m * 512 + 8 * lane_), kw = *(const v4u*)(K + (size_t)m * 512 + 8 * lane_);
        float sq = 0.f, sk = 0.f;
#pragma unroll
        for (int e = 0; e < 4; ++e) { const float a = bflo(qw[e]), c = bfhi(qw[e]), d = bflo(kw[e]), f = bfhi(kw[e]); sq += a * a + c * c; sk += d * d + f * f; }
        sq += __shfl_xor(sq, 1); sq += __shfl_xor(sq, 2); sq += __shfl_xor(sq, 4); sk += __shfl_xor(sk, 1); sk += __shfl_xor(sk, 2); sk += __shfl_xor(sk, 4);
        if (b == 0) { mq[0] = fmaxf(mq[0], sq); mk[0] = fmaxf(mk[0], sk); } else { mq[1] = fmaxf(mq[1], sq); mk[1] = fmaxf(mk[1], sk); } }
    if ((lane_ & 7) == 0) {
#pragma unroll
        for (int b = 0; b < 2; ++b) { if (mq[b] > 0.f) atomicMax(qkmax + (b * 8 + hd) * 2, __float_as_uint(mq[b])); if (mk[b] > 0.f) atomicMax(qkmax + (b * 8 + hd) * 2 + 1, __float_as_uint(mk[b])); } }
}

template <int WITH_MOE>
__device__ __forceinline__ void p_final(Frame& F, const Args& A, const float* src) {
    PHASE_IDS();
    unsigned char* ws = A.ws; const float* fg = A.in[29]; const float* mod = (const float*)(ws + WS_MOD);
    const int* route = (const int*)(ws + WS_ROUTE); const bf16* Y = (const bf16*)(ws + WS_YM);
    f32x4 fgv[4];
#pragma unroll
    for (int j = 0; j < 4; ++j) fgv[j] = *(const f32x4*)(fg + 4 * lane_ + 256 * j);
    const int gw = F.vcu * NWAVES + wave_, NGW = F.G * NWAVES;
    for (int m = gw; m < M; m += NGW) {
        f32x4 v[4]; float s = 0.f;
        if (WITH_MOE) { const GAS unsigned long long* xb = (const GAS unsigned long long*)((const bf16*)(ws + WS_X1) + (size_t)m * D) + lane_;
#pragma unroll
            for (int j = 0; j < 4; ++j) { const unsigned long long a = xb[64 * j]; const unsigned al = (unsigned)a, ah = (unsigned)(a >> 32); v[j] = (f32x4){bflo(al), bfhi(al), bflo(ah), bfhi(ah)}; } }
        else { const GAS f32x4* xr = (const GAS f32x4*)(src + (size_t)m * D) + lane_;
#pragma unroll
            for (int j = 0; j < 4; ++j) v[j] = xr[64 * j]; }
        if (WITH_MOE) {
            const int b = m / SEQ; const int* rt_ = route + (size_t)m * 8;
            const float w0 = __int_as_float(rt_[2]), w1 = __int_as_float(rt_[3]); const int s0 = rt_[6], s1 = rt_[7];
            const GAS unsigned long long* y0 = (const GAS unsigned long long*)(Y + (size_t)s0 * D) + lane_; const GAS unsigned long long* y1 = (const GAS unsigned long long*)(Y + (size_t)s1 * D) + lane_;
#pragma unroll
            for (int j = 0; j < 4; ++j) { const unsigned long long a = y0[64 * j], c = y1[64 * j]; const f32x4 g2 = *(const f32x4*)(mod + b * 6144 + 5120 + 4 * lane_ + 256 * j);
                const unsigned al = (unsigned)a, ah = (unsigned)(a >> 32), cl = (unsigned)c, ch = (unsigned)(c >> 32);
                f32x4 y; y.x = w0 * bflo(al) + w1 * bflo(cl); y.y = w0 * bfhi(al) + w1 * bfhi(cl); y.z = w0 * bflo(ah) + w1 * bflo(ch); y.w = w0 * bfhi(ah) + w1 * bfhi(ch);
                v[j] = v[j] + g2 * y; }
        }
#pragma unroll
        for (int j = 0; j < 4; ++j) s += (v[j].x * v[j].x + v[j].y * v[j].y) + (v[j].z * v[j].z + v[j].w * v[j].w);
        float rstd = 1.0f / sqrtf(wave_sum(s) * (1.f / D) + 1e-6f);
        if (WITH_MOE == 2) { if (((const unsigned*)(ws + WS_CTL))[CW_DIAG]) rstd = 0.f; }
        GAS f32x4* o = (GAS f32x4*)(A.out + (size_t)m * D) + lane_;
#pragma unroll
        for (int j = 0; j < 4; ++j) o[64 * j] = v[j] * rstd * fgv[j];
    }
}

typedef float f32x16 __attribute__((ext_vector_type(16)));
typedef unsigned u32x2 __attribute__((ext_vector_type(2)));
__device__ __forceinline__ f32x4 shift4(const bf16* p, bool has_prev, const float* mu) {
    const u32x2 c = *(const u32x2*)p; u32x2 q = *(const u32x2*)(has_prev ? p - SHW : p); if (!has_prev) q = (u32x2){0u, 0u};
    const f32x4 m = *(const f32x4*)mu;
    f32x4 cv = {bflo(c.x), bfhi(c.x), bflo(c.y), bfhi(c.y)}, pv = {bflo(q.x), bfhi(q.x), bflo(q.y), bfhi(q.y)};
    return cv + (pv - cv) * m;
}
__device__ __forceinline__ u32x2 pack4(f32x4 v) { u32x2 r; r.x = pk2(v.x, v.y); r.y = pk2(v.z, v.w); return r; }

__device__ __forceinline__ float fsig(float x) { return __builtin_amdgcn_rcpf(1.0f + __builtin_amdgcn_exp2f(-1.4426950408889634f * x)); }
__device__ __forceinline__ float ftanh(float x) { const float xc = fminf(fmaxf(x, -15.f), 15.f); return 1.0f - 2.0f * __builtin_amdgcn_rcpf(1.0f + __builtin_amdgcn_exp2f(2.8853900817779268f * xc)); }
__device__ __forceinline__ float half_sum32(float v) { v = row_sum16(v); v += __shfl_xor(v, 16); return v; }
__device__ __forceinline__ void shift2(const bf16* p, bool has_prev, const float (&mu)[2], float (&o)[2]) {
    const unsigned c = *(const unsigned*)p; unsigned q = *(const unsigned*)(has_prev ? p - SHW : p); if (!has_prev) q = 0u;
    const float c0 = bflo(c), c1 = bfhi(c); o[0] = c0 + (bflo(q) - c0) * mu[0]; o[1] = c1 + (bfhi(q) - c1) * mu[1];
}
template <int VAR> __device__ __forceinline__ void rwkv_pre(Frame& F, const Args& A, int ci_lo, int ci_hi) {
    PHASE_IDS();
    unsigned char* ws = A.ws;
    const bf16* PRW = (const bf16*)(ws + WS_PRW);
    const float* mu = A.in[7]; const float* w0 = A.in[8]; const float* a0 = A.in[10]; const float* k_k = A.in[13]; const float* k_a = A.in[14]; const float* r_k = A.in[15];
    const bf16* LW2 = (const bf16*)(ws + WS_LW2); const bf16* LA2 = (const bf16*)(ws + WS_LA2); const bf16* LG2 = (const bf16*)(ws + WS_LG2);
    float* LW = (float*)A.out; bf16* R = (bf16*)((unsigned char*)A.out + 64 * MiB); bf16* KP = (bf16*)((unsigned char*)A.out + 96 * MiB);
    bf16* VV = (bf16*)(ws + WS_XN); bf16* AV = (bf16*)(ws + WS_XN + 32 * MiB); bf16* BV = (bf16*)(ws + WS_F); bf16* GG = (bf16*)(ws + WS_F + 32 * MiB);
    float* BON = (float*)(ws + WS_BON);
    LAS bf16* Xw = (LAS bf16*)(F.lds); LAS bf16* Xa = (LAS bf16*)(F.lds + 9216); LAS bf16* Xg = (LAS bf16*)(F.lds + 18432);
    const int h = wave_;
    for (int ci = ci_lo; ci < ci_hi; ci += F.G) {
        __syncthreads();
        {
            int tl_ = threadIdx.x; asm volatile("" : "+v"(tl_));
            const int row = tl_ >> 3, cg = tl_ & 7; const size_t tok = (size_t)ci * 64 + row; const bool hp = (tok % SEQ) != 0;
            const bf16* src = PRW + tok * SHW + 1536 + 32 * cg; const float* mup = mu + 1536 + 32 * cg;
            LAS bf16* dst = (cg < 2) ? (Xw + row * 72 + 32 * cg) : (cg < 4) ? (Xa + row * 72 + 32 * (cg - 2)) : (Xg + row * 136 + 32 * (cg - 4));
#pragma unroll
            for (int q = 0; q < 8; ++q) { f32x4 v = shift4(src + 4 * q, hp, mup + 4 * q);
                if (cg < 2) { v.x = ftanh(v.x); v.y = ftanh(v.y); v.z = ftanh(v.z); v.w = ftanh(v.w); }
                else if (cg >= 4) { v.x = fsig(v.x); v.y = fsig(v.y); v.z = fsig(v.z); v.w = fsig(v.w); }
                *(LAS u32x2*)(dst + 4 * q) = pack4(v); }
        }
        __syncthreads();
        int ln_ = threadIdx.x & 63; asm volatile("" : "+v"(ln_));
        const int c = ln_ & 31, hh = ln_ >> 5, colb = 64 * h + 2 * c;
    float mur[2], muk[2], muv[2], kkc[2], kac[2], rkc[2], a0c[2], w0c[2];
#pragma unroll
    for (int e = 0; e < 2; ++e) { mur[e] = mu[colb + e]; muk[e] = mu[512 + colb + e]; muv[e] = mu[1024 + colb + e]; kkc[e] = k_k[colb + e]; kac[e] = k_a[colb + e]; rkc[e] = r_k[colb + e]; a0c[e] = a0[colb + e]; w0c[e] = w0[colb + e]; }
#pragma unroll 1
        for (int tb = 0; tb < ((VAR == 3) ? 0 : 2); ++tb) {
            f32x16 aa[2], aw[2], ag[2];
            aa[0] = f32x16{}; aa[1] = f32x16{}; aw[0] = f32x16{}; aw[1] = f32x16{}; ag[0] = f32x16{}; ag[1] = f32x16{};
            if (VAR != 4) {
#pragma unroll
            for (int ks = 0; ks < 4; ++ks) { const bf16x8 afr = *(const LAS bf16x8*)(Xa + (32 * tb + c) * 72 + 16 * ks + 8 * hh), wfr = *(const LAS bf16x8*)(Xw + (32 * tb + c) * 72 + 16 * ks + 8 * hh);
#pragma unroll
                for (int jb = 0; jb < 2; ++jb) { const bf16x8 b1 = *(const bf16x8*)(LA2 + (size_t)(colb + jb) * 64 + 16 * ks + 8 * hh), b2 = *(const bf16x8*)(LW2 + (size_t)(colb + jb) * 64 + 16 * ks + 8 * hh);
                    aa[jb] = __builtin_amdgcn_mfma_f32_32x32x16_bf16(afr, b1, aa[jb], 0, 0, 0); aw[jb] = __builtin_amdgcn_mfma_f32_32x32x16_bf16(wfr, b2, aw[jb], 0, 0, 0); } }
#pragma unroll
            for (int ks = 0; ks < 8; ++ks) { const bf16x8 gfr = *(const LAS bf16x8*)(Xg + (32 * tb + c) * 136 + 16 * ks + 8 * hh);
#pragma unroll
                for (int jb = 0; jb < 2; ++jb) { const bf16x8 b3 = *(const bf16x8*)(LG2 + (size_t)(colb + jb) * 128 + 16 * ks + 8 * hh); ag[jb] = __builtin_amdgcn_mfma_f32_32x32x16_bf16(gfr, b3, ag[jb], 0, 0, 0); } }
            }
            unsigned gpk[16], apk[16];
#pragma unroll
            for (int reg = 0; reg < 16; ++reg) { gpk[reg] = pk2(ag[0][reg], ag[1][reg]); apk[reg] = pk2(fsig(a0c[0] + aa[0][reg]), fsig(a0c[1] + aa[1][reg])); }
            unsigned rawc[16][3], rawq[4][3];
#pragma unroll
            for (int reg = 0; reg < 16; ++reg) { const int t = 32 * tb + (reg & 3) + 8 * (reg >> 2) + 4 * hh; const size_t tok = (size_t)ci * 64 + t; const bool hp = (tok % SEQ) != 0;
                const bf16* prow = PRW + tok * SHW + colb; const bf16* pprev = hp ? prow - SHW : prow;
#pragma unroll
                for (int x = 0; x < 3; ++x) { if (VAR == 2) { rawc[reg][x] = 0x3f803f80u + reg; if ((reg & 3) == 0) rawq[reg >> 2][x] = 0x3f803f80u; } else { rawc[reg][x] = *(const unsigned*)(prow + 512 * x); if ((reg & 3) == 0) { const unsigned q = *(const unsigned*)(pprev + 512 * x); rawq[reg >> 2][x] = hp ? q : 0u; } } } }
#pragma unroll
            for (int reg = 0; reg < 16; ++reg) {
                const int t = 32 * tb + (reg & 3) + 8 * (reg >> 2) + 4 * hh; const size_t tok = (size_t)ci * 64 + t;
                unsigned rawp_[3];
#pragma unroll
                for (int x = 0; x < 3; ++x) rawp_[x] = ((reg & 3) == 0) ? rawq[reg >> 2][x] : rawc[(reg + 15) & 15][x];
                float kx[2], rx[2], vx[2];
                { const unsigned cc_ = rawc[reg][0], pp_ = rawp_[0]; const float c0 = bflo(cc_), c1 = bfhi(cc_); rx[0] = c0 + (bflo(pp_) - c0) * mur[0]; rx[1] = c1 + (bfhi(pp_) - c1) * mur[1]; }
                { const unsigned cc_ = rawc[reg][1], pp_ = rawp_[1]; const float c0 = bflo(cc_), c1 = bfhi(cc_); kx[0] = c0 + (bflo(pp_) - c0) * muk[0]; kx[1] = c1 + (bfhi(pp_) - c1) * muk[1]; }
                { const unsigned cc_ = rawc[reg][2], pp_ = rawp_[2]; const float c0 = bflo(cc_), c1 = bfhi(cc_); vx[0] = c0 + (bflo(pp_) - c0) * muv[0]; vx[1] = c1 + (bfhi(pp_) - c1) * muv[1]; }
                const float as0 = bflo(apk[reg]), as1 = bfhi(apk[reg]);
                const float kr0 = kx[0] * kkc[0], kr1 = kx[1] * kkc[1];
                const float ss = half_sum32(kr0 * kr0 + kr1 * kr1); const float inv = __builtin_amdgcn_rsqf(fmaxf(ss, 1e-24f));
                const float kk0 = kr0 * inv, kk1 = kr1 * inv, kp0 = kx[0] * (1.0f + (as0 - 1.0f) * kac[0]), kp1 = kx[1] * (1.0f + (as1 - 1.0f) * kac[1]);
                const float bon = half_sum32(rx[0] * kp0 * rkc[0] + rx[1] * kp1 * rkc[1]);
                float o2[2];
#pragma unroll
                for (int e = 0; e < 2; ++e) { const float z = -(w0c[e] + aw[e][reg]);
                    const float sp = fmaxf(z, 0.f) + 0.6931471805599453f * __builtin_amdgcn_logf(1.0f + __builtin_amdgcn_exp2f(-1.4426950408889634f * fabsf(z))); o2[e] = -__builtin_amdgcn_exp2f(-1.4426950408889634f * (sp + 0.5f)); }
                const unsigned ob = (unsigned)tok * 1024u + (unsigned)colb * 2u;
                if (VAR == 0) {
                *(unsigned*)((unsigned char*)R + ob) = pk2(rx[0], rx[1]); *(unsigned*)((unsigned char*)KP + ob) = pk2(kp0, kp1); *(unsigned*)((unsigned char*)VV + ob) = pk2(vx[0], vx[1]);
                *(unsigned*)((unsigned char*)AV + ob) = pk2(-kk0, -kk1); *(unsigned*)((unsigned char*)BV + ob) = pk2(kk0 * as0, kk1 * as1);
                *(float2*)((unsigned char*)LW + 2u * ob) = make_float2(o2[0], o2[1]); *(unsigned*)((unsigned char*)GG + ob) = gpk[reg];
                if (c == 0) BON[tok * 8 + h] = bon;
                } else { asm volatile("" :: "v"(pk2(rx[0], rx[1])), "v"(pk2(kp0, kp1)), "v"(pk2(vx[0], vx[1])), "v"(pk2(-kk0, -kk1)), "v"(pk2(kk0 * as0, kk1 * as1)), "v"(o2[0]), "v"(o2[1]), "v"(gpk[reg]), "v"(bon), "v"(ob)); }
                if ((reg & 3) == 3) __builtin_amdgcn_sched_barrier(0);
            }
        }
    }
}

__device__ __forceinline__ void rwkv_scan_seq(Frame& F, const Args& A) {
    PHASE_IDS();
    if (blockIdx.x >= BATCH * 8) return;
    unsigned char* ws = A.ws;
    const float* LW = (const float*)A.out; const bf16* R = (const bf16*)((unsigned char*)A.out + 64 * MiB); const bf16* KP = (const bf16*)((unsigned char*)A.out + 96 * MiB);
    const bf16* VV = (const bf16*)(ws + WS_XN); const bf16* AV = (const bf16*)(ws + WS_XN + 32 * MiB); const bf16* BV = (const bf16*)(ws + WS_F);
    float* Y = (float*)(ws + WS_Y);
    const int b = blockIdx.x >> 3, h = blockIdx.x & 7;
    constexpr int STEPB = 896, CH = 16, BUFB = STEPB * CH;
    LAS unsigned char* buf = F.lds;
    const size_t tok0 = (size_t)b * SEQ;
    const bool loader = wave_ >= 4; const int lt = tid_ - 256;
    auto load_chunk = [&](int cidx, int slot) {
        for (int p = lt; p < CH * 56; p += 256) { const int s = p / 56, q = p % 56; const size_t tok = tok0 + (size_t)cidx * CH + s; v4u val;
            if (q < 16) val = *(const v4u*)(LW + tok * 512 + 64 * h + 4 * q);
            else { const int a = (q - 16) >> 3, o8 = (q - 16) & 7; const bf16* src = (a == 0) ? AV : (a == 1) ? BV : (a == 2) ? KP : (a == 3) ? R : VV; val = *(const v4u*)(src + tok * 512 + 64 * h + 8 * o8); }
            *(LAS v4u*)(buf + slot * BUFB + s * STEPB + q * 16) = val; }
    };
    if (loader) load_chunk(0, 0);
    __syncthreads();
    float S[16];
#pragma unroll
    for (int j = 0; j < 16; ++j) S[j] = 0.f;
    const int il = lane_ & 15, jq = lane_ >> 4, irow = 16 * wave_ + il;
    for (int cidx = 0; cidx < SEQ / CH; ++cidx) {
        if (loader) { if (cidx + 1 < SEQ / CH) load_chunk(cidx + 1, (cidx + 1) & 1); }
        else {
            const LAS unsigned char* bb = buf + (cidx & 1) * BUFB;
#pragma unroll 4
            for (int s = 0; s < CH; ++s) { const LAS unsigned char* sp = bb + s * STEPB;
                float w[16], av[16], bv[16], kv[16], rv[16];
#pragma unroll
                for (int q = 0; q < 4; ++q) { const f32x4 l4 = *(const LAS f32x4*)(sp + 64 * jq + 16 * q); w[4 * q] = __expf(l4.x); w[4 * q + 1] = __expf(l4.y); w[4 * q + 2] = __expf(l4.z); w[4 * q + 3] = __expf(l4.w); }
#pragma unroll
                for (int q = 0; q < 2; ++q) { const v4u a4 = *(const LAS v4u*)(sp + 256 + 32 * jq + 16 * q), b4 = *(const LAS v4u*)(sp + 384 + 32 * jq + 16 * q), k4 = *(const LAS v4u*)(sp + 512 + 32 * jq + 16 * q), r4 = *(const LAS v4u*)(sp + 640 + 32 * jq + 16 * q);
#pragma unroll
                    for (int e = 0; e < 4; ++e) { av[8 * q + 2 * e] = bflo(a4[e]); av[8 * q + 2 * e + 1] = bfhi(a4[e]); bv[8 * q + 2 * e] = bflo(b4[e]); bv[8 * q + 2 * e + 1] = bfhi(b4[e]);
                        kv[8 * q + 2 * e] = bflo(k4[e]); kv[8 * q + 2 * e + 1] = bfhi(k4[e]); rv[8 * q + 2 * e] = bflo(r4[e]); rv[8 * q + 2 * e + 1] = bfhi(r4[e]); } }
                const unsigned short vraw = *(const LAS unsigned short*)(sp + 768 + 2 * irow); const float vi = __uint_as_float((unsigned)vraw << 16);
                float sa = 0.f;
#pragma unroll
                for (int j = 0; j < 16; ++j) sa += S[j] * av[j];
                sa += __shfl_xor(sa, 16); sa += __shfl_xor(sa, 32);
                float y = 0.f;
#pragma unroll
                for (int j = 0; j < 16; ++j) { S[j] = S[j] * w[j] + sa * bv[j] + vi * kv[j]; y += S[j] * rv[j]; }
                y += __shfl_xor(y, 16); y += __shfl_xor(y, 32);
                if (jq == 0) Y[(tok0 + (size_t)cidx * CH + s) * 512 + 64 * h + irow] = y;
            }
        }
        __syncthreads();
    }
}

__device__ __forceinline__ void rwkv_post(Frame& F, const Args& A) {
    PHASE_IDS();
    unsigned char* ws = A.ws;
    const float* Y = (const float*)(ws + WS_Y); const bf16* VV = (const bf16*)(ws + WS_XN); const bf16* GG = (const bf16*)(ws + WS_F + 32 * MiB); const float* BON = (const float*)(ws + WS_BON);
    bf16* O = (bf16*)(ws + WS_F);
    const float* lg = A.in[16]; const float* lb = A.in[17];
    const int gw = F.vcu * NWAVES + wave_, NGW = F.G * NWAVES, col = 8 * lane_, hd = lane_ >> 3;
    const f32x4 g0 = *(const f32x4*)(lg + col), g1 = *(const f32x4*)(lg + col + 4), b0 = *(const f32x4*)(lb + col), b1 = *(const f32x4*)(lb + col + 4);
    for (int m = gw; m < M; m += NGW) {
        const f32x4 y0 = *(const f32x4*)(Y + (size_t)m * 512 + col), y1 = *(const f32x4*)(Y + (size_t)m * 512 + col + 4);
        float s = (y0.x + y0.y) + (y0.z + y0.w) + (y1.x + y1.y) + (y1.z + y1.w);
        s += __shfl_xor(s, 1); s += __shfl_xor(s, 2); s += __shfl_xor(s, 4);
        const float mean = s * (1.f / 64.f); const f32x4 d0 = y0 - mean, d1 = y1 - mean;
        float q = (d0.x * d0.x + d0.y * d0.y) + (d0.z * d0.z + d0.w * d0.w) + (d1.x * d1.x + d1.y * d1.y) + (d1.z * d1.z + d1.w * d1.w);
        q += __shfl_xor(q, 1); q += __shfl_xor(q, 2); q += __shfl_xor(q, 4);
        const float rstd = 1.0f / sqrtf(q * (1.f / 64.f) + 64e-5f);
        const float bon = BON[(size_t)m * 8 + hd];
        const v4u vw = *(const v4u*)(VV + (size_t)m * 512 + col), gw4 = *(const v4u*)(GG + (size_t)m * 512 + col);
        f32x4 o0 = (d0 * rstd * g0 + b0), o1 = (d1 * rstd * g1 + b1);
        o0.x = (o0.x + bon * bflo(vw.x)) * bflo(gw4.x); o0.y = (o0.y + bon * bfhi(vw.x)) * bfhi(gw4.x); o0.z = (o0.z + bon * bflo(vw.y)) * bflo(gw4.y); o0.w = (o0.w + bon * bfhi(vw.y)) * bfhi(gw4.y);
        o1.x = (o1.x + bon * bflo(vw.z)) * bflo(gw4.z); o1.y = (o1.y + bon * bfhi(vw.z)) * bfhi(gw4.z); o1.z = (o1.z + bon * bflo(vw.w)) * bflo(gw4.w); o1.w = (o1.w + bon * bfhi(vw.w)) * bfhi(gw4.w);
        v4u ow; ow.x = pk2(o0.x, o0.y); ow.y = pk2(o0.z, o0.w); ow.z = pk2(o1.x, o1.y); ow.w = pk2(o1.z, o1.w);
        *(v4u*)(O + (size_t)m * 512 + col) = ow;
    }
}

__device__ __forceinline__ size_t pq_off(int it) { const int ch = it >> 8, cc = it & 255; return WS_PRW + ((size_t)(ch >> 3) * SEQ + (size_t)cc * 64) * (SHW * 2) + (size_t)(ch & 7) * 24576; }
__device__ __forceinline__ size_t y0_off(int it, int idx) { const int ch = it >> 8, cc = it & 255; return (((size_t)(ch >> 3) * SEQ + (size_t)cc * 64 + (idx >> 4)) * 512 + 64 * (ch & 7)) * 4 + (size_t)(idx & 15) * 16; }
constexpr size_t ST_OFF = 64 * MiB;
constexpr int CH_ITEMS = BATCH * 8 * (SEQ / 64);

__device__ __forceinline__ int sw16(int row, int chunk) { return row * 128 + ((chunk ^ (row & 7)) << 4); }
typedef float f32x4c __attribute__((ext_vector_type(4)));
__device__ __forceinline__ bf16x8 ld_frag(const LAS unsigned char* Mx, int row, int chunk) { return *(const LAS bf16x8*)(Mx + sw16(row, chunk)); }
template <bool SWAP>
__device__ __forceinline__ void mm_tile(const LAS unsigned char* Am, const LAS unsigned char* Bm, int r0, int c0, int l15, int kg, f32x4c (&acc)[2]) {
    bf16x8 a[2], b[2][2];
#pragma unroll
    for (int ks = 0; ks < 2; ++ks) { a[ks] = ld_frag(Am, r0 + l15, 4 * ks + kg);
#pragma unroll
        for (int n = 0; n < 2; ++n) b[ks][n] = ld_frag(Bm, c0 + 16 * n + l15, 4 * ks + kg); }
#pragma unroll
    for (int ks = 0; ks < 2; ++ks)
#pragma unroll
        for (int n = 0; n < 2; ++n)
            acc[n] = SWAP ? __builtin_amdgcn_mfma_f32_16x16x32_bf16(b[ks][n], a[ks], acc[n], 0, 0, 0) : __builtin_amdgcn_mfma_f32_16x16x32_bf16(a[ks], b[ks][n], acc[n], 0, 0, 0);
}
__device__ __forceinline__ unsigned long long pack4u(f32x4c v) { return (unsigned long long)pk2(v[0], v[1]) | ((unsigned long long)pk2(v[2], v[3]) << 32); }
__device__ __forceinline__ void st_nat(LAS unsigned char* O, int r0, int c0, int l15, int kg, const f32x4c (&acc)[2]) {
#pragma unroll
    for (int n = 0; n < 2; ++n) { const int row = r0 + l15, col = c0 + 16 * n + 4 * kg; *(LAS unsigned long long*)(O + sw16(row, col >> 3) + (col & 4) * 2) = pack4u(acc[n]); }
}
__device__ __forceinline__ void st_tr(LAS unsigned char* OT, int r0, int c0, int l15, int kg, const f32x4c (&acc)[2]) {
#pragma unroll
    for (int n = 0; n < 2; ++n)
#pragma unroll
        for (int e = 0; e < 4; ++e) { const int row = r0 + l15, col = c0 + 16 * n + 4 * kg + e; *(LAS unsigned short*)(OT + sw16(col, row >> 3) + (row & 7) * 2) = (unsigned short)f2bf(acc[n][e]); }
}
__device__ __forceinline__ f32x4c ld_nat4(const LAS unsigned char* O, int row, int col) { const unsigned long long w = *(const LAS unsigned long long*)(O + sw16(row, col >> 3) + (col & 4) * 2);
    const unsigned lo = (unsigned)w, hi = (unsigned)(w >> 32); return (f32x4c){bflo(lo), bfhi(lo), bflo(hi), bfhi(hi)}; }

template <int VAR> __device__ __forceinline__ void rwkv_r1(Frame& F, const Args& A, int it_lo, int it_hi, int it_step) {
    PHASE_IDS();
    unsigned char* ws = A.ws;
    const float* LW = (const float*)A.out; const bf16* R = (const bf16*)((unsigned char*)A.out + 64 * MiB); const bf16* KP = (const bf16*)((unsigned char*)A.out + 96 * MiB);
    const bf16* VV = (const bf16*)(ws + WS_XN); const bf16* AV = (const bf16*)(ws + WS_XN + 32 * MiB); const bf16* BV = (const bf16*)(ws + WS_F);
    LAS unsigned char* L = F.lds;
#define MB(i) (L + (i) * 8192)
    LAS float* gCs = (LAS float*)(L + 17 * 8192); LAS float* part = gCs + 64;
    const int w = wave_, j = lane_, l15 = lane_ & 15, kg = lane_ >> 4, r0 = 16 * (w >> 1), c0 = 32 * (w & 1);
#define R1_BAR() asm volatile("s_waitcnt lgkmcnt(0)\n\ts_barrier" ::: "memory")
    float nlw[8]; unsigned short nav[8], nbv[8], nkv[8], nrv[8], nvv[8];
#define R1_LOAD(itx) do { const int ch_ = (itx) >> 8, cc_ = (itx) & 255; const size_t tb_ = (size_t)(ch_ >> 3) * SEQ + (size_t)cc_ * 64 + 8 * w; const int cg_ = 64 * (ch_ & 7) + j; \
        _Pragma("unroll") for (int t = 0; t < 8; ++t) { const size_t o = (tb_ + t) * 512 + cg_; nlw[t] = LW[o]; nav[t] = AV[o]; nbv[t] = BV[o]; nkv[t] = KP[o]; nrv[t] = R[o]; nvv[t] = VV[o]; } } while (0)
    if (it_lo < it_hi) R1_LOAD(it_lo);
    for (int it = it_lo; it < it_hi; it += it_step) {
        R1_BAR();
        {
            float g[8], lw[8], av[8], bv[8], kv[8], rv[8]; unsigned short vraw[8]; float run = 0.f;
#pragma unroll
            for (int t = 0; t < 8; ++t) { lw[t] = nlw[t]; av[t] = __uint_as_float((unsigned)nav[t] << 16); bv[t] = __uint_as_float((unsigned)nbv[t] << 16);
                kv[t] = __uint_as_float((unsigned)nkv[t] << 16); rv[t] = __uint_as_float((unsigned)nrv[t] << 16); vraw[t] = nvv[t]; run += lw[t]; g[t] = run; }
            if (it + it_step < it_hi) R1_LOAD(it + it_step);
            part[w * 64 + j] = run;
            R1_BAR();
            float pre = 0.f, tot = 0.f;
#pragma unroll
            for (int q = 0; q < 8; ++q) { const float p = part[q * 64 + j]; tot += p; if (q < w) pre += p; }
            if (w == 0) gCs[j] = __expf(tot);
            unsigned short atT[8], bhT[8], khT[8];
#pragma unroll
            for (int t = 0; t < 8; ++t) { const float G = pre + g[t]; const float eg = __expf(G), en = __expf(-G), ea = __expf(G - lw[t]), ec = __expf(tot - G);
                const int row = 8 * w + t; const int off = sw16(row, j >> 3) + (j & 7) * 2;
                const unsigned short at = (unsigned short)f2bf(av[t] * ea);
                *(LAS unsigned short*)(MB(0) + off) = at; atT[t] = at;
                *(LAS unsigned short*)(MB(2) + off) = (unsigned short)f2bf(bv[t] * en);
                *(LAS unsigned short*)(MB(3) + off) = (unsigned short)f2bf(kv[t] * en);
                *(LAS unsigned short*)(MB(4) + off) = (unsigned short)f2bf(rv[t] * eg);
                bhT[t] = (unsigned short)f2bf(bv[t] * ec); khT[t] = (unsigned short)f2bf(kv[t] * ec); }
            v4u x;
            x.x = atT[0] | ((unsigned)atT[1] << 16); x.y = atT[2] | ((unsigned)atT[3] << 16); x.z = atT[4] | ((unsigned)atT[5] << 16); x.w = atT[6] | ((unsigned)atT[7] << 16); *(LAS v4u*)(MB(1) + sw16(j, w)) = x;
            x.x = bhT[0] | ((unsigned)bhT[1] << 16); x.y = bhT[2] | ((unsigned)bhT[3] << 16); x.z = bhT[4] | ((unsigned)bhT[5] << 16); x.w = bhT[6] | ((unsigned)bhT[7] << 16); *(LAS v4u*)(MB(5) + sw16(j, w)) = x;
            x.x = khT[0] | ((unsigned)khT[1] << 16); x.y = khT[2] | ((unsigned)khT[3] << 16); x.z = khT[4] | ((unsigned)khT[5] << 16); x.w = khT[6] | ((unsigned)khT[7] << 16); *(LAS v4u*)(MB(6) + sw16(j, w)) = x;
            x.x = vraw[0] | ((unsigned)vraw[1] << 16); x.y = vraw[2] | ((unsigned)vraw[3] << 16); x.z = vraw[4] | ((unsigned)vraw[5] << 16); x.w = vraw[6] | ((unsigned)vraw[7] << 16); *(LAS v4u*)(MB(7) + sw16(j, w)) = x;
        }
        R1_BAR();
        if (VAR == 1) continue;
        f32x4c acc[2];
        const int trow = r0 + l15;
        {
            acc[0] = f32x4c{}; acc[1] = f32x4c{}; mm_tile<true>(MB(0), MB(2), r0, c0, l15, kg, acc);
#pragma unroll
            for (int n = 0; n < 2; ++n)
#pragma unroll
                for (int e = 0; e < 4; ++e) { const int s = c0 + 16 * n + 4 * kg + e; if (s >= trow) acc[n][e] = 0.f; }
            st_nat(MB(8), r0, c0, l15, kg, acc); st_tr(MB(9), r0, c0, l15, kg, acc);
#pragma unroll
            for (int n = 0; n < 2; ++n)
#pragma unroll
                for (int e = 0; e < 4; ++e) { const int s = c0 + 16 * n + 4 * kg + e; if (s == trow) acc[n][e] = 1.f; }
            st_nat(MB(15), r0, c0, l15, kg, acc);
            acc[0] = f32x4c{}; acc[1] = f32x4c{}; mm_tile<true>(MB(0), MB(3), r0, c0, l15, kg, acc);
#pragma unroll
            for (int n = 0; n < 2; ++n)
#pragma unroll
                for (int e = 0; e < 4; ++e) { const int s = c0 + 16 * n + 4 * kg + e; if (s >= trow) acc[n][e] = 0.f; }
            st_nat(MB(10), r0, c0, l15, kg, acc);
            acc[0] = f32x4c{}; acc[1] = f32x4c{}; mm_tile<true>(MB(4), MB(2), r0, c0, l15, kg, acc);
#pragma unroll
            for (int n = 0; n < 2; ++n)
#pragma unroll
                for (int e = 0; e < 4; ++e) { const int s = c0 + 16 * n + 4 * kg + e; if (s > trow) acc[n][e] = 0.f; }
            st_nat(MB(11), r0, c0, l15, kg, acc);
            acc[0] = f32x4c{}; acc[1] = f32x4c{}; mm_tile<true>(MB(4), MB(3), r0, c0, l15, kg, acc);
#pragma unroll
            for (int n = 0; n < 2; ++n)
#pragma unroll
                for (int e = 0; e < 4; ++e) { const int s = c0 + 16 * n + 4 * kg + e; if (s > trow) acc[n][e] = 0.f; }
            st_nat(MB(12), r0, c0, l15, kg, acc);
        }
        R1_BAR();
        if (VAR == 2) continue;
        acc[0] = f32x4c{}; acc[1] = f32x4c{}; mm_tile<true>(MB(8), MB(9), r0, c0, l15, kg, acc); st_nat(MB(13), r0, c0, l15, kg, acc); st_tr(MB(14), r0, c0, l15, kg, acc);
        acc[0] = f32x4c{}; acc[1] = f32x4c{}; mm_tile<true>(MB(7), MB(10), r0, c0, l15, kg, acc); st_nat(MB(3), r0, c0, l15, kg, acc);
        R1_BAR();
#define SQUARE(xi, xti, xo, xto) do { acc[0] = f32x4c{}; acc[1] = f32x4c{}; mm_tile<true>(MB(xi), MB(xti), r0, c0, l15, kg, acc); st_nat(MB(xo), r0, c0, l15, kg, acc); st_tr(MB(xto), r0, c0, l15, kg, acc); } while (0)
#define MUPD(mi, xti, mo) do { acc[0] = ld_nat4(MB(mi), trow, c0 + 4 * kg); acc[1] = ld_nat4(MB(mi), trow, c0 + 16 + 4 * kg); mm_tile<true>(MB(mi), MB(xti), r0, c0, l15, kg, acc); st_nat(MB(mo), r0, c0, l15, kg, acc); } while (0)
        SQUARE(13, 14, 0, 2); MUPD(15, 14, 16); R1_BAR();
        SQUARE(0, 2, 13, 14); MUPD(16, 2, 15); R1_BAR();
        SQUARE(13, 14, 0, 2); MUPD(15, 14, 16); R1_BAR();
        SQUARE(0, 2, 13, 14); MUPD(16, 2, 15); R1_BAR();
        MUPD(15, 14, 16); R1_BAR();
        acc[0] = f32x4c{}; acc[1] = f32x4c{}; mm_tile<true>(MB(1), MB(16), r0, c0, l15, kg, acc); st_nat(MB(13), r0, c0, l15, kg, acc);
        acc[0] = f32x4c{}; acc[1] = f32x4c{}; mm_tile<true>(MB(3), MB(16), r0, c0, l15, kg, acc); st_nat(MB(14), r0, c0, l15, kg, acc);
        R1_BAR();
        if (VAR == 3) continue;
        unsigned char* og = ws + pq_off(it); unsigned char* oy = (unsigned char*)A.out + y0_off(it, w * 64 + lane_);
        {
            acc[0] = f32x4c{}; acc[1] = f32x4c{}; mm_tile<true>(MB(5), MB(13), r0, c0, l15, kg, acc);
            const float gc = gCs[trow];
#pragma unroll
            for (int n = 0; n < 2; ++n) { const int col = c0 + 16 * n + 4 * kg;
#pragma unroll
                for (int e = 0; e < 4; ++e) if (col + e == trow) acc[n][e] += gc;
                const size_t po_ = (size_t)(trow * 64 + col) * 2;
                if (VAR == 0) *(unsigned long long*)(og + po_) = pack4u(acc[n]); else asm volatile("" :: "v"(pack4u(acc[n]))); }
            acc[0] = ld_nat4(MB(4), trow, c0 + 4 * kg); acc[1] = ld_nat4(MB(4), trow, c0 + 16 + 4 * kg); mm_tile<true>(MB(11), MB(13), r0, c0, l15, kg, acc);
#pragma unroll
            for (int n = 0; n < 2; ++n) { const int col = c0 + 16 * n + 4 * kg; if (VAR == 0) *(unsigned long long*)(og + 16384 + (size_t)(trow * 64 + col) * 2) = pack4u(acc[n]); else asm volatile("" :: "v"(pack4u(acc[n]))); }
            acc[0] = f32x4c{}; acc[1] = f32x4c{}; mm_tile<false>(MB(5), MB(14), r0, c0, l15, kg, acc); mm_tile<false>(MB(6), MB(7), r0, c0, l15, kg, acc);
            { v4u q; q.x = pk2(acc[0][0], acc[0][1]); q.y = pk2(acc[0][2], acc[0][3]); q.z = pk2(acc[1][0], acc[1][1]); q.w = pk2(acc[1][2], acc[1][3]); if (VAR == 0) *(v4u*)(og + 8192 + (size_t)(w * 64 + lane_) * 16) = q; else asm volatile("" :: "v"(q)); }
            acc[0] = f32x4c{}; acc[1] = f32x4c{}; mm_tile<false>(MB(11), MB(14), r0, c0, l15, kg, acc); mm_tile<false>(MB(12), MB(7), r0, c0, l15, kg, acc);
            { v4u q; q.x = pk2(acc[0][0], acc[0][1]); q.y = pk2(acc[0][2], acc[0][3]); q.z = pk2(acc[1][0], acc[1][1]); q.w = pk2(acc[1][2], acc[1][3]); if (VAR == 0) *(v4u*)oy = q; else asm volatile("" :: "v"(q)); }
        }
    }
#undef SQUARE
#undef MUPD
#undef MB
#undef R1_BAR
#undef R1_LOAD
}

template <int VAR> __device__ __forceinline__ void rwkv_r2(Frame& F, const Args& A, unsigned char* stbase) {
    PHASE_IDS();
    if (blockIdx.x >= BATCH * 8) return;
    unsigned char* ws = A.ws;
    LAS unsigned char* L = F.lds;
    const int ch = blockIdx.x, w = wave_, l15 = lane_ & 15, kg = lane_ >> 4, r0 = 16 * (w >> 1), c0 = 32 * (w & 1);
    const unsigned char* pq = ws + pq_off(ch * 256); unsigned char* st = stbase + (size_t)ch * 256 * 8192;
    for (int i = tid_; i < 2048; i += NWAVES * 64) { ((LAS unsigned*)L)[i] = 0u; }
    for (int i = tid_; i < 512; i += NWAVES * 64) ((v4u*)st)[i] = (v4u){0u, 0u, 0u, 0u};
    __syncthreads();
    constexpr int PF = 8;
    bf16x8 pa[PF][2]; v4u qf[PF];
#define R2_LOAD(slot, step) do { const unsigned char* p_ = pq + (size_t)(step) * (64 * SHW * 2); \
        pa[slot][0] = *(const bf16x8*)(p_ + (size_t)((r0 + l15) * 64 + 8 * kg) * 2); pa[slot][1] = *(const bf16x8*)(p_ + (size_t)((r0 + l15) * 64 + 32 + 8 * kg) * 2); \
        qf[slot] = *(const v4u*)(p_ + 8192 + (size_t)(w * 64 + lane_) * 16); } while (0)
#pragma unroll
    for (int s = 0; s < PF; ++s) R2_LOAD(s, s);
    for (int c = 0; c < 256; c += PF) {
#pragma unroll
        for (int s = 0; s < PF; ++s) {
            const int step = c + s; const LAS unsigned char* Sin = L + (step & 15) * 8192; LAS unsigned char* Sout = L + ((step + 1) & 15) * 8192;
            f32x4c acc[2];
            acc[0] = (f32x4c){bflo(qf[s].x), bfhi(qf[s].x), bflo(qf[s].y), bfhi(qf[s].y)}; acc[1] = (f32x4c){bflo(qf[s].z), bfhi(qf[s].z), bflo(qf[s].w), bfhi(qf[s].w)};
            bf16x8 sf[2][2];
#pragma unroll
            for (int ks = 0; ks < 2; ++ks)
#pragma unroll
                for (int n = 0; n < 2; ++n) sf[ks][n] = ld_frag(Sin, c0 + 16 * n + l15, 4 * ks + kg);
#pragma unroll
            for (int ks = 0; ks < 2; ++ks)
#pragma unroll
                for (int n = 0; n < 2; ++n) acc[n] = __builtin_amdgcn_mfma_f32_16x16x32_bf16(pa[s][ks], sf[ks][n], acc[n], 0, 0, 0);
#pragma unroll
            for (int n = 0; n < 2; ++n) { const int row = c0 + 16 * n + l15, col = r0 + 4 * kg; const unsigned long long pkd = pack4u(acc[n]);
                *(LAS unsigned long long*)(Sout + sw16(row, col >> 3) + (col & 4) * 2) = pkd;
                }
            if (VAR != 3) { if (step + PF < 256) R2_LOAD(s, step + PF); }
            if (VAR != 4) asm volatile("s_waitcnt lgkmcnt(0)\n\ts_barrier" ::: "memory");
        }
        if (VAR != 2) { const int nflush = (c + PF < 256) ? PF * 8192 : (PF - 1) * 8192; unsigned char* dst = st + (size_t)(c + 1) * 8192;
          for (int o = tid_ * 16; o < nflush; o += NWAVES * 64 * 16) { const int row_ = (o >> 7) & 63, chk_ = (o >> 4) & 7, slot_ = (c + 1 + (o >> 13)) & 15; *(v4u*)(dst + o) = *(const LAS v4u*)(L + slot_ * 8192 + sw16(row_, chk_)); } }
    }
#undef R2_LOAD
}

__device__ __forceinline__ void rwkv_r3(Frame& F, const Args& A) {
    PHASE_IDS();
    unsigned char* ws = A.ws;
    const bf16* VV = (const bf16*)(ws + WS_XN); const bf16* GG = (const bf16*)(ws + WS_F + 32 * MiB); const float* BON = (const float*)(ws + WS_BON);
    bf16* O = (bf16*)(ws + WS_F); const float* lg = A.in[16]; const float* lb = A.in[17];
    LAS float* Yt = (LAS float*)F.lds;
    const int w = wave_, l15 = lane_ & 15, kg = lane_ >> 4, r0 = 16 * (w >> 1), c0 = 32 * (w & 1);
#define R3_BAR() asm volatile("s_waitcnt lgkmcnt(0)\n\ts_barrier" ::: "memory")
    v4u nq, nvw, ngw; bf16x8 na[2], nb[2][2]; float nbon;
    const int pt_ = tid_ >> 3, pi0_ = 8 * (tid_ & 7);
#define R3_LOAD(itx) do { const int ch_ = (itx) >> 8, cc_ = (itx) & 255; const unsigned char* og_ = ws + pq_off(itx); const unsigned char* sg_ = (const unsigned char*)A.out + ST_OFF + (size_t)(itx) * 8192; \
        nq = *(const v4u*)((const unsigned char*)A.out + y0_off(itx, w * 64 + lane_)); \
        _Pragma("unroll") for (int ks = 0; ks < 2; ++ks) { na[ks] = *(const bf16x8*)(og_ + 16384 + (size_t)((r0 + l15) * 64 + 32 * ks + 8 * kg) * 2); \
            _Pragma("unroll") for (int n = 0; n < 2; ++n) nb[ks][n] = *(const bf16x8*)(sg_ + (size_t)((c0 + 16 * n + l15) * 64 + 32 * ks + 8 * kg) * 2); } \
        const size_t m_ = (size_t)(ch_ >> 3) * SEQ + (size_t)cc_ * 64 + pt_; const int col_ = 64 * (ch_ & 7) + pi0_; \
        nvw = *(const v4u*)(VV + m_ * 512 + col_); ngw = *(const v4u*)(GG + m_ * 512 + col_); nbon = BON[m_ * 8 + (ch_ & 7)]; } while (0)
    if ((int)blockIdx.x < CH_ITEMS) R3_LOAD((int)blockIdx.x);
    for (int it = blockIdx.x; it < CH_ITEMS; it += F.G) {
        const int ch = it >> 8, cc = it & 255, b = ch >> 3, h = ch & 7;
        f32x4c acc[2];
        acc[0] = (f32x4c){bflo(nq.x), bfhi(nq.x), bflo(nq.y), bfhi(nq.y)}; acc[1] = (f32x4c){bflo(nq.z), bfhi(nq.z), bflo(nq.w), bfhi(nq.w)};
#pragma unroll
        for (int ks = 0; ks < 2; ++ks)
#pragma unroll
            for (int n = 0; n < 2; ++n) acc[n] = __builtin_amdgcn_mfma_f32_16x16x32_bf16(na[ks], nb[ks][n], acc[n], 0, 0, 0);
        const v4u vw = nvw, gw4 = ngw; const float bon = nbon;
        if (it + F.G < CH_ITEMS) R3_LOAD(it + F.G);
        R3_BAR();
#pragma unroll
        for (int n = 0; n < 2; ++n)
#pragma unroll
            for (int e = 0; e < 4; ++e) Yt[(r0 + 4 * kg + e) * 68 + c0 + 16 * n + l15] = acc[n][e];
        R3_BAR();
        {   const int t = pt_, i0 = pi0_; const size_t m = (size_t)b * SEQ + (size_t)cc * 64 + t; const int col = 64 * h + i0;
            const f32x4 y0 = *(const LAS f32x4*)(Yt + t * 68 + i0), y1 = *(const LAS f32x4*)(Yt + t * 68 + i0 + 4);
            float s = (y0.x + y0.y) + (y0.z + y0.w) + (y1.x + y1.y) + (y1.z + y1.w);
            s += __shfl_xor(s, 1); s += __shfl_xor(s, 2); s += __shfl_xor(s, 4);
            const float mean = s * (1.f / 64.f); const f32x4 d0 = y0 - mean, d1 = y1 - mean;
            float q = (d0.x * d0.x + d0.y * d0.y) + (d0.z * d0.z + d0.w * d0.w) + (d1.x * d1.x + d1.y * d1.y) + (d1.z * d1.z + d1.w * d1.w);
            q += __shfl_xor(q, 1); q += __shfl_xor(q, 2); q += __shfl_xor(q, 4);
            const float rstd = 1.0f / sqrtf(q * (1.f / 64.f) + 64e-5f);
            const f32x4 g0 = *(const f32x4*)(lg + col), g1 = *(const f32x4*)(lg + col + 4), b0 = *(const f32x4*)(lb + col), b1 = *(const f32x4*)(lb + col + 4);
            f32x4 o0 = (d0 * rstd * g0 + b0), o1 = (d1 * rstd * g1 + b1);
            o0.x = (o0.x + bon * bflo(vw.x)) * bflo(gw4.x); o0.y = (o0.y + bon * bfhi(vw.x)) * bfhi(gw4.x); o0.z = (o0.z + bon * bflo(vw.y)) * bflo(gw4.y); o0.w = (o0.w + bon * bfhi(vw.y)) * bfhi(gw4.y);
            o1.x = (o1.x + bon * bflo(vw.z)) * bflo(gw4.z); o1.y = (o1.y + bon * bfhi(vw.z)) * bfhi(gw4.z); o1.z = (o1.z + bon * bflo(vw.w)) * bflo(gw4.w); o1.w = (o1.w + bon * bfhi(vw.w)) * bfhi(gw4.w);
            v4u ow; ow.x = pk2(o0.x, o0.y); ow.y = pk2(o0.z, o0.w); ow.z = pk2(o1.x, o1.y); ow.w = pk2(o1.z, o1.w);
            *(v4u*)(O + m * 512 + col) = ow; }
    }
#undef R3_BAR
#undef R3_LOAD
}

__device__ __forceinline__ void p_norm2_route(Frame& F, const Args& A) {
    PHASE_IDS();
    unsigned char* ws = A.ws;
    constexpr int WROW = 2064;
    LAS unsigned char* WH = F.lds; LAS unsigned char* WL = F.lds + 36 * WROW;
    LAS float* LG = (LAS float*)F.lds;
    LAS int* eid = (LAS int*)(F.lds + 128 * 36 * 4);
    const bf16* x1 = (const bf16*)(ws + WS_X1); const float* g2 = A.in[21]; const float* mod = (const float*)(ws + WS_MOD);
    const float* rgw = A.in[22]; const float* rgb = A.in[23]; const float* rew = A.in[24]; const float* reb = A.in[25];
    bf16* XN2 = (bf16*)(ws + WS_XN); int* route = (int*)(ws + WS_ROUTE); int* blkcnt = (int*)(ws + WS_BLKCNT);
    const int l15 = lane_ & 15, kg = lane_ >> 4;
    for (int blk = blockIdx.x; blk < M / 128; blk += F.G) {
        __syncthreads();
        for (int i = tid_; i < 4096; i += NWAVES * 64) { const float w = rgw[i]; const unsigned hi = f2bf(w); const unsigned lo = f2bf(w - __uint_as_float(hi << 16)); const int off = (i & 3) * WROW + (i >> 2) * 2;
            *(LAS unsigned short*)(WH + off) = (unsigned short)hi; *(LAS unsigned short*)(WL + off) = (unsigned short)lo; }
        for (int i = tid_; i < 32768; i += NWAVES * 64) { const float w = rew[i]; const unsigned hi = f2bf(w); const unsigned lo = f2bf(w - __uint_as_float(hi << 16)); const int off = (4 + (i & 31)) * WROW + (i >> 5) * 2;
            *(LAS unsigned short*)(WH + off) = (unsigned short)hi; *(LAS unsigned short*)(WL + off) = (unsigned short)lo; }
        __syncthreads();
        const int b = blk / (SEQ / 128); const size_t tok = (size_t)blk * 128 + wave_ * 16 + l15;
        const bf16* xrow = x1 + tok * D + 8 * kg; const float* gmp = g2 + 8 * kg; const float* scp = mod + b * 6144 + 4096 + 8 * kg; const float* shp = mod + b * 6144 + 3072 + 8 * kg;
        float ss = 0.f;
#pragma unroll 8
        for (int ks = 0; ks < 32; ++ks) { const v4u xw = *(const v4u*)(xrow + 32 * ks);
#pragma unroll
            for (int e = 0; e < 4; ++e) { const float lo_ = bflo(xw[e]), hi_ = bfhi(xw[e]); ss += lo_ * lo_ + hi_ * hi_; } }
        ss += __shfl_xor(ss, 16); ss += __shfl_xor(ss, 32);
        const float rstd = 1.0f / sqrtf(ss * (1.f / D) + 1e-6f);
        f32x4 acc[3]; acc[0] = f32x4{0.f, 0.f, 0.f, 0.f}; acc[1] = acc[0]; acc[2] = acc[0];
        int wcol[3];
#pragma unroll
        for (int ct = 0; ct < 3; ++ct) { const int col = 16 * ct + l15; wcol[ct] = (col < 36 ? col : 35) * WROW + 16 * kg; }
#pragma unroll 2
        for (int ks = 0; ks < 32; ++ks) {
            float hv[8];
            { const v4u xw = *(const v4u*)(xrow + 32 * ks); const f32x4 a = {bflo(xw.x), bfhi(xw.x), bflo(xw.y), bfhi(xw.y)}, c = {bflo(xw.z), bfhi(xw.z), bflo(xw.w), bfhi(xw.w)};
              const f32x4 g0 = *(const f32x4*)(gmp + 32 * ks), g1 = *(const f32x4*)(gmp + 32 * ks + 4), s0 = *(const f32x4*)(scp + 32 * ks), s1 = *(const f32x4*)(scp + 32 * ks + 4), h0 = *(const f32x4*)(shp + 32 * ks), h1 = *(const f32x4*)(shp + 32 * ks + 4);
              const f32x4 u0 = a * rstd * (g0 * (s0 + 1.0f)) + h0, u1 = c * rstd * (g1 * (s1 + 1.0f)) + h1;
              hv[0] = u0.x; hv[1] = u0.y; hv[2] = u0.z; hv[3] = u0.w; hv[4] = u1.x; hv[5] = u1.y; hv[6] = u1.z; hv[7] = u1.w; }
            unsigned hiw[4], low[4];
#pragma unroll
            for (int e = 0; e < 4; ++e) { const unsigned h0 = f2bf(hv[2 * e]), h1 = f2bf(hv[2 * e + 1]); hiw[e] = h0 | (h1 << 16);
                low[e] = f2bf(hv[2 * e] - __uint_as_float(h0 << 16)) | (f2bf(hv[2 * e + 1] - __uint_as_float(h1 << 16)) << 16); }
            v4u hq; hq.x = hiw[0]; hq.y = hiw[1]; hq.z = hiw[2]; hq.w = hiw[3];
            *(v4u*)(XN2 + tok * D + 32 * ks + 8 * kg) = hq;
            v4u lq; lq.x = low[0]; lq.y = low[1]; lq.z = low[2]; lq.w = low[3];
            const bf16x8 ah = __builtin_bit_cast(bf16x8, hq), al = __builtin_bit_cast(bf16x8, lq);
#pragma unroll
            for (int ct = 0; ct < 3; ++ct) { const bf16x8 bh = *(const LAS bf16x8*)(WH + wcol[ct] + 64 * ks), bl = *(const LAS bf16x8*)(WL + wcol[ct] + 64 * ks);
                acc[ct] = __builtin_amdgcn_mfma_f32_16x16x32_bf16(ah, bh, acc[ct], 0, 0, 0); acc[ct] = __builtin_amdgcn_mfma_f32_16x16x32_bf16(ah, bl, acc[ct], 0, 0, 0); acc[ct] = __builtin_amdgcn_mfma_f32_16x16x32_bf16(al, bh, acc[ct], 0, 0, 0); }
        }
        __syncthreads();
#pragma unroll
        for (int ct = 0; ct < 3; ++ct) { const int col = 16 * ct + l15; if (col < 36) { const float bias = (col < 4) ? rgb[col] : reb[col - 4];
#pragma unroll
            for (int e = 0; e < 4; ++e) LG[(wave_ * 16 + 4 * kg + e) * 36 + col] = acc[ct][e] + bias; } }
        __syncthreads();
        if (tid_ < 128) { const LAS float* lg = LG + tid_ * 36;
            int gi = 0; float gmax = lg[0];
#pragma unroll
            for (int i = 1; i < 4; ++i) if (lg[i] > gmax) { gmax = lg[i]; gi = i; }
            float den = 0.f;
#pragma unroll
            for (int i = 0; i < 4; ++i) den += __expf(lg[i] - gmax);
            const float gp = 1.0f / den;
            float el[8];
#pragma unroll
            for (int i = 0; i < 8; ++i) el[i] = lg[4 + 8 * gi + i];
            int i0 = 0; float m0 = el[0];
#pragma unroll
            for (int i = 1; i < 8; ++i) if (el[i] > m0) { m0 = el[i]; i0 = i; }
            int i1 = -1; float m1 = -INFINITY;
#pragma unroll
            for (int i = 0; i < 8; ++i) if (i != i0 && el[i] > m1) { m1 = el[i]; i1 = i; }
            if (i1 < 0) { i1 = (i0 + 1) & 7; m1 = m0; }
            const float p1 = __expf(m1 - m0), w0 = gp / (1.0f + p1), w1 = gp * p1 / (1.0f + p1);
            int* rt_ = route + ((size_t)blk * 128 + tid_) * 8; rt_[0] = gi * 8 + i0; rt_[1] = gi * 8 + i1; rt_[2] = __float_as_int(w0); rt_[3] = __float_as_int(w1);
            eid[tid_ * 2] = gi * 8 + i0; eid[tid_ * 2 + 1] = gi * 8 + i1; }
        __syncthreads();
        if (tid_ < 256) { const int e = eid[tid_]; int rk = 0; for (int a = 0; a < tid_; ++a) rk += (eid[a] == e) ? 1 : 0; route[((size_t)blk * 128 + (tid_ >> 1)) * 8 + 4 + (tid_ & 1)] = rk; }
        else if (tid_ < 288) { const int e = tid_ - 256; int cn = 0; for (int a = 0; a < 256; ++a) cn += (eid[a] == e) ? 1 : 0; blkcnt[blk * 32 + e] = cn; }
    }
}

__device__ __forceinline__ void conv_experts(Frame& F, const Args& A) {
    PHASE_IDS();
    unsigned char* ws = A.ws; bf16* W13 = (bf16*)(ws + WS_W13); bf16* W2T = (bf16*)(ws + WS_W2T);
    LAS float* scr = (LAS float*)(F.lds + RING_OFF + wave_ * 16384);
    const int gw = F.vcu * NWAVES + wave_, NGW = F.G * NWAVES;
    for (int it = gw; it < 3 * 8192; it += NGW) {
        const int which = it >> 13, r = it & 8191;
        if (which < 2) { const int e = r >> 8, kb = (r >> 4) & 15, nb = r & 15, n0 = 32 * nb;
            transpose_item(A.in[26 + which] + (size_t)e * 1024 * 512, 512, n0, 64 * kb, 1024, W13, (size_t)e * 1024 + (n0 >> 7) * 256 + which * 128 + (n0 & 127), scr, lane_); }
        else { const int e = r >> 8, kb = (r >> 5) & 7, nb = r & 31;
            transpose_item(A.in[28] + (size_t)e * 512 * 1024, 1024, 32 * nb, 64 * kb, 512, W2T, (size_t)e * 1024 + 32 * nb, scr, lane_); }
    }
}

__device__ __forceinline__ void p_slots(Frame& F, const Args& A) {
    PHASE_IDS();
    unsigned char* ws = A.ws;
    LAS int* tile_e = (LAS int*)(F.lds + TILE_OFF); LAS int* base = tile_e + 288; LAS int* tot = base + 32; LAS int* pre = tot + 32; LAS int* ntl = pre + 32; LAS int* part = ntl + 4;
    const int* blkcnt = (const int*)(ws + WS_BLKCNT); int* route = (int*)(ws + WS_ROUTE); int* rowtok = (int*)(ws + WS_ROWTOK);
    { const int e = tid_ & 31, pt = tid_ >> 5; int s = 0; for (int bb = 16 * pt; bb < 16 * pt + 16; ++bb) s += blkcnt[bb * 32 + e]; part[pt * 32 + e] = s; }
    __syncthreads();
    if (tid_ < 32) { int t = 0; for (int p = 0; p < 16; ++p) t += part[p * 32 + tid_]; tot[tid_] = t; }
    __syncthreads();
    if (tid_ == 0) { int run = 0, nt = 0; for (int e = 0; e < 32; ++e) { base[e] = run; const int pad = (tot[e] + 255) >> 8; for (int i = 0; i < pad; ++i) tile_e[nt++] = e; run += pad * 256; } ntl[0] = nt; }
    __syncthreads();
    for (int blk = blockIdx.x; blk < M / 128; blk += F.G) {
        { const int e = tid_ & 31, pt = tid_ >> 5; int s = 0; for (int bb = pt; bb < blk; bb += 16) s += blkcnt[bb * 32 + e]; part[pt * 32 + e] = s; }
        __syncthreads();
        if (tid_ < 32) { int p = 0; for (int q = 0; q < 16; ++q) p += part[q * 32 + tid_]; pre[tid_] = p; }
        __syncthreads();
        if (tid_ < 256) { const size_t tok = (size_t)blk * 128 + (tid_ >> 1); const int k = tid_ & 1; const int e = route[tok * 8 + k], lr = route[tok * 8 + 4 + k];
            const int slot = base[e] + pre[e] + lr; route[tok * 8 + 6 + k] = slot; rowtok[slot] = (int)tok; }
        __syncthreads();
    }
    for (int e = blockIdx.x; e < 32; e += F.G) { const int lo = base[e] + tot[e], hi = base[e] + (((tot[e] + 255) >> 8) << 8); for (int s = lo + tid_; s < hi; s += NWAVES * 64) rowtok[s] = 0; }
}

#ifndef STAGE_UNUSED
#define STAGE 4
#endif
#ifndef PHASES
#define PHASES 0xffff
#endif
#ifndef RWKV_CHUNKED
#define RWKV_CHUNKED 1
#endif

__device__ __forceinline__ void ph_gemm1(Frame& F, const Args& args) { unsigned char* ws = args.ws;
    pg8::Gemm g{(const pg8::bf16_t*)(ws + WS_XN), (const pg8::bf16_t*)(ws + WS_WIN), nullptr, 1024, NIN};
    pg8::StaticOrder S; S.init(M, NIN, F.G, (int)blockIdx.x);
    pg8::EpiIn E{(pg8::bf16_t*)(ws + WS_Q), (pg8::bf16_t*)(ws + WS_K), (pg8::bf16_t*)(ws + WS_V), (pg8::bf16_t*)(ws + WS_PRW), (pg8::bf16_t*)(ws + WS_GATES), ATT_C2};
    pg8::gemm_phase<pg8::EpiIn, pg8::StaticOrder>(F.lds + RING_OFF, g, S, E); }
__device__ __forceinline__ void ph_attn_wrap(unsigned char* lds, Frame& F, const Args& args, size_t out_off, int qslot) { unsigned char* ws = args.ws;
    const attn_body::AttnTensors AT{(const attn_body::bf16*)(ws + WS_Q), (const attn_body::bf16*)(ws + WS_K), (const attn_body::bf16*)(ws + WS_V), (attn_body::bf16*)(ws + out_off), (const float*)(ws + WS_CUM), (const float*)(ws + WS_SEGTOT)};
    attn_body::attn_phase_dyn<8>((char*)lds + RING_OFF, AT, (unsigned*)(F.ctl + CW_QUEUE + 64 * qslot), (const unsigned*)(F.ctl + CW_QKMAX), TAB_OFF, SEGP_OFF); }
__device__ __forceinline__ void ph_gemm2a(Frame& F, const Args& args) { unsigned char* ws = args.ws;
    pg8::Gemm g{(const pg8::bf16_t*)(ws + WS_Q), (const pg8::bf16_t*)(ws + WS_WOF), nullptr, 512, 1024};
    pg8::StaticOrder S; S.init(M, 1024, F.G, (int)blockIdx.x);
    pg8::EpiGate<1> E{(pg8::bf16_t*)(ws + WS_TMP), 1024, (const pg8::bf16_t*)(ws + WS_GATES), 2048, 0};
    pg8::gemm_phase<pg8::EpiGate<1>, pg8::StaticOrder>(F.lds + RING_OFF, g, S, E); }
__device__ __forceinline__ void ph_gemm2b(Frame& F, const Args& args) { unsigned char* ws = args.ws;
    pg8::Gemm g{(const pg8::bf16_t*)(ws + WS_F), (const pg8::bf16_t*)(ws + WS_WOR), nullptr, 512, 1024};
    pg8::StaticOrder S; S.init(M, 1024, F.G, (int)blockIdx.x);
    pg8::EpiGate<2> E{(pg8::bf16_t*)(ws + WS_TMP), 1024, (const pg8::bf16_t*)(ws + WS_GATES), 2048, 1024};
    pg8::gemm_phase<pg8::EpiGate<2>, pg8::StaticOrder>(F.lds + RING_OFF, g, S, E); }
__device__ __forceinline__ void ph_gemm3(Frame& F, const Args& args) { unsigned char* ws = args.ws;
    pg8::Gemm g{(const pg8::bf16_t*)(ws + WS_TMP), (const pg8::bf16_t*)(ws + WS_WO), nullptr, 1024, 1024};
    pg8::StaticOrder S; S.init(M, 1024, F.G, (int)blockIdx.x);
    pg8::EpiRes E{args.in[0], (pg8::bf16_t*)(ws + WS_X1), (const float*)(ws + WS_MOD) + 2048, SEQ, 6144};
    pg8::gemm_phase<pg8::EpiRes, pg8::StaticOrder>(F.lds + RING_OFF, g, S, E); }
__device__ __forceinline__ void ph_moe_up(Frame& F, const Args& args) { unsigned char* ws = args.ws;
    const LAS int* tile_e = (const LAS int*)(F.lds + TILE_OFF); const int ntiles = tile_e[288 + 96];
    LAS int* rows = (LAS int*)(F.lds + TILE_OFF + 4096);
    { const int* rowtok = (const int*)(ws + WS_ROWTOK); int tid_ = threadIdx.x; asm volatile("" : "+v"(tid_));
      for (int i = 0; i < 8; ++i) { const int L = i * F.G + (int)blockIdx.x; if (L >= ntiles * 4) break; if (tid_ < 256) rows[i * 256 + tid_] = rowtok[(L >> 2) * 256 + tid_]; }
      __syncthreads(); }
    pg8::Gemm g{(const pg8::bf16_t*)(ws + WS_XN), (const pg8::bf16_t*)(ws + WS_W13), rows, 1024, 1024};
    pg8::MoeOrder S{ntiles * 4, F.G, (int)blockIdx.x, 2, tile_e};
    pg8::EpiSwiGLU E{(pg8::bf16_t*)(ws + WS_H)};
    pg8::gemm_phase<pg8::EpiSwiGLU, pg8::MoeOrder, true>(F.lds + RING_OFF, g, S, E); }
__device__ __forceinline__ void ph_moe_down(Frame& F, const Args& args) { unsigned char* ws = args.ws;
    const LAS int* tile_e = (const LAS int*)(F.lds + TILE_OFF); const int ntiles = tile_e[288 + 96];
    pg8::Gemm g{(const pg8::bf16_t*)(ws + WS_H), (const pg8::bf16_t*)(ws + WS_W2T), nullptr, 512, 1024};
    pg8::MoeOrder S{ntiles * 4, F.G, (int)blockIdx.x, 2, tile_e};
    pg8::EpiGate<0> E{(pg8::bf16_t*)(ws + WS_YM), 1024, nullptr, 0, 0};
    pg8::gemm_phase<pg8::EpiGate<0>, pg8::MoeOrder>(F.lds + RING_OFF, g, S, E); }

__global__ void __launch_bounds__(NWAVES * 64, 2) fwd_kernel(Args args) {
    extern __shared__ __attribute__((aligned(16))) unsigned char lds[];
    Frame F;
    F.lds = (LAS unsigned char*)lds;
    F.MISC = (volatile LAS unsigned*)(F.lds + MISC_OFF);
    F.tid = threadIdx.x; F.lane = F.tid & 63; F.wave = __builtin_amdgcn_readfirstlane(F.tid >> 6);
    F.G = gridDim.x; { const int bx = blockIdx.x; F.vcu = (F.G % 8 == 0) ? (bx % 8) * (F.G / 8) + bx / 8 : bx; }
    unsigned char* ws = args.ws;
    F.ctl = (gu32*)(ws + WS_CTL);
    for (int u = F.tid; u < (LDS_BYTES - LDSCTL_OFF) / 4; u += NWAVES * 64) ((LAS unsigned*)(F.lds + LDSCTL_OFF))[u] = 0u;
    __syncthreads();
    XcdBarrier bar = xcd_barrier_post((unsigned*)(F.ctl + CW_BAR), F.MISC + 8);
#define GRID_BAR() xcd_barrier(bar)

    p0_prologue(F, args); GRID_BAR();
    p1_norm(F, args); __syncthreads(); p_convert_early(F, args); GRID_BAR();
    p_cumfix(F, args);
    ph_gemm1(F, args); GRID_BAR();
    p_qknorm(F, args, (unsigned*)(F.ctl + CW_QKMAX));
    for (int cb = (int)blockIdx.x; cb < SEQ / 64; cb += F.G)
    for (int half = 0; half < 2; ++half) {
        rwkv_pre<0>(F, args, cb + 256 * half, cb + 256 * half + 1);
        __syncthreads();
        rwkv_r1<0>(F, args, cb + 2048 * half, cb + 2048 * half + 2048, 256);
        __syncthreads();
    }
    GRID_BAR();
    rwkv_r2<0>(F, args, (unsigned char*)args.out + ST_OFF);
    ph_attn_wrap(lds, F, args, WS_Q, 0); GRID_BAR();
    rwkv_r3(F, args); GRID_BAR();
    ph_gemm2a(F, args);
    ph_gemm2b(F, args); GRID_BAR();
    ph_gemm3(F, args); GRID_BAR();
    p_norm2_route(F, args); GRID_BAR();
    p_slots(F, args); conv_experts(F, args); GRID_BAR();
    ph_moe_up(F, args); GRID_BAR();
    ph_moe_down(F, args); GRID_BAR();
    p_final<1>(F, args, args.out);
}

extern "C" void kernel_launch(void* const* d_in, const int* in_sizes, int n_in, void* d_out, int out_size, void* d_ws, size_t ws_size, hipStream_t stream) {
    static int grid = 0;
    if (grid == 0) {
        if (n_in != 30 || in_sizes[0] != M * D || out_size != M * D || ws_size < WS_END) { fprintf(stderr, "kernel_launch: unexpected shapes (n_in %d, in0 %d, out %d, ws %zu)\n", n_in, n_in > 0 ? in_sizes[0] : -1, out_size, ws_size); grid = -1; return; }
        int dev = 0, cus = 0, per_cu = 0;
        if (hipGetDevice(&dev) != hipSuccess || hipDeviceGetAttribute(&cus, hipDeviceAttributeMultiprocessorCount, dev) != hipSuccess) { grid = -1; return; }
        if (hipFuncSetAttribute((const void*)fwd_kernel, hipFuncAttributeMaxDynamicSharedMemorySize, LDS_BYTES) != hipSuccess) { fprintf(stderr, "kernel_launch: hipFuncSetAttribute failed\n"); grid = -1; return; }
        if (hipOccupancyMaxActiveBlocksPerMultiprocessor(&per_cu, (const void*)fwd_kernel, NWAVES * 64, LDS_BYTES) != hipSuccess || per_cu < 1)
            fprintf(stderr, "kernel_launch: occupancy query reports %d\n", per_cu);
        (void)hipGetLastError();
        grid = cus;
        if (grid > 256) grid = 256;
    }
    if (grid < 0) return;
    if (hipMemsetAsync((char*)d_ws + WS_CTL, 0, CTL_ZERO_BYTES, stream) != hipSuccess) return;
    Args a{};
    for (int i = 0; i < 30; ++i) a.in[i] = (const float*)d_in[i];
    a.out = (float*)d_out; a.ws = (unsigned char*)d_ws;
    hipLaunchKernelGGL(fwd_kernel, dim3(grid), dim3(NWAVES * 64), LDS_BYTES, stream, a);
}
```

```cpp
#include <hip/hip_runtime.h>
#include <hip/hip_bf16.h>
#include <cstdio>
#include <cstdint>
#include <cmath>

namespace pg8 {
#define PG8_LAS __attribute__((address_space(3)))
typedef unsigned short bf16_t;
typedef short bf16x8 __attribute__((ext_vector_type(8)));
typedef float f32x4 __attribute__((ext_vector_type(4)));
typedef unsigned u32x4 __attribute__((ext_vector_type(4)));
typedef unsigned u32x2 __attribute__((ext_vector_type(2)));
constexpr int BM = 256, BK = 64, HALF = 128, HTB = HALF * BK * 2, STAGE_BYTES = 8 * HTB, NXCD = 8, WGM = 8;

__host__ __device__ __forceinline__ int lds_byte(int r, int c) { const int st = (r >> 4) * 2 + (c >> 5), rr = r & 15, cc = c & 31, ob = rr * 64 + cc * 2; return st * 1024 + (ob ^ (((ob >> 9) & 1) << 5)); }
__host__ __device__ __forceinline__ void stage_rc(int b, int& R, int& C) { const int st = b / 1024, sb = b % 1024, swz = sb ^ (((sb >> 9) & 1) << 5); R = (st >> 1) * 16 + swz / 64; C = (st & 1) * 32 + (swz % 64) / 2; }
__host__ __device__ __forceinline__ int perm32(int rho) { const int n = rho >> 4, i = rho & 15; return 8 * (i >> 2) + 4 * n + (i & 3); }

struct Unit { int pm, pn, e; };
struct Gemm { const bf16_t* A; const bf16_t* Bt; const PG8_LAS int* rowlds; int K; int nB; };

struct StaticOrder {
    int nM, nN, nwg, G, c;
    __host__ __device__ void init(int M, int N, int G_, int c_) { nM = M / BM; nN = N / BM; nwg = nM * nN; G = G_; c = c_; }
    __host__ __device__ bool next(int i, Unit& u) const {
        const long L = (long)i * G + c; if (L >= nwg) return false;
        int wgid = (int)L; { const int q = nwg / NXCD, r = nwg % NXCD, xcd = wgid % NXCD, off = wgid / NXCD; wgid = (xcd < r ? xcd * (q + 1) : r * (q + 1) + (xcd - r) * q) + off; }
        const int nig = WGM * nN, gid = wgid / nig, fm = gid * WGM, gsz = (nM - fm) < WGM ? (nM - fm) : WGM;
        u.pm = fm + ((wgid % nig) % gsz); u.pn = (wgid % nig) / gsz; u.e = 0; return true;
    }
};

__device__ __forceinline__ unsigned cvt_pk_bf16(float lo, float hi) { unsigned r; asm volatile("v_cvt_pk_bf16_f32 %0, %1, %2" : "=v"(r) : "v"(lo), "v"(hi)); return r; }
__device__ __forceinline__ float bf_lo(unsigned w) { return __uint_as_float(w << 16); }
__device__ __forceinline__ float bf_hi(unsigned w) { return __uint_as_float(w & 0xffff0000u); }
__device__ __forceinline__ float fsigmoid(float x) { return __builtin_amdgcn_rcpf(1.0f + __builtin_amdgcn_exp2f(-1.4426950408889634f * x)); }

template <class Epi, class Sched, bool GATHER = false>
__device__ __forceinline__ void gemm_phase(PG8_LAS unsigned char* lds, const Gemm g, const Sched& S, const Epi& E) {
    int tid_ = threadIdx.x; asm volatile("" : "+v"(tid_));
    const int tid = tid_, wid = __builtin_amdgcn_readfirstlane(tid >> 6), lane = tid & 63, wr = wid >> 2, wc = wid & 3, fr = lane & 15, fq = lane >> 4;
    const int K = g.K, nt = K / BK;
    int RA[2], CA[2]; unsigned voffA[2], voffB[2];
#pragma unroll
    for (int i = 0; i < 2; ++i) { int R, C; stage_rc(tid * 16 + i * 8192, R, C); const int Rb = Epi::PERM ? ((R & ~31) + perm32(R & 31)) : R;
        RA[i] = R; CA[i] = C; voffA[i] = (unsigned)(R * K + C) * 2u; voffB[i] = (unsigned)(Rb * K + C) * 2u; }
    const size_t tstep = 2 * (size_t)HALF * K * 2;
    const size_t kstep = (size_t)(BK * 2);
    const size_t hstep = (size_t)HALF * K * 2;
    const unsigned ldsw = (unsigned)wid * 1024u;
    const int aoff = lds_byte(wr * 64 + fr, fq * 8), boff = lds_byte(wc * 32 + fr, fq * 8);
#define PG8_SA(b, h) (((b) * 2 + (h)) * HTB)
#define PG8_SB(b, h) ((4 + (b) * 2 + (h)) * HTB)
#define PG8_STAGE(bufoff, gbase, v0, v1) do { \
        __builtin_amdgcn_global_load_lds((const unsigned*)((const char*)(gbase) + (v0)), (PG8_LAS unsigned*)(lds + (bufoff) + ldsw), 16, 0, 0); \
        __builtin_amdgcn_global_load_lds((const unsigned*)((const char*)(gbase) + (v1)), (PG8_LAS unsigned*)(lds + (bufoff) + ldsw + 8192), 16, 0, 0); } while (0)
#define PG8_STAGEB(bufoff, gbase) PG8_STAGE(bufoff, gbase, voffB[0], voffB[1])
#define PG8_STAGEA(bufoff, abase, h, VA) do { if constexpr (GATHER) { PG8_STAGE(bufoff, abase, VA[h][0], VA[h][1]); } else { PG8_STAGE(bufoff, (abase) + (h) * hstep, voffA[0], voffA[1]); } } while (0)
#define PG8_LDA(dst, b, h) do { _Pragma("unroll") for (int m = 0; m < 4; ++m) _Pragma("unroll") for (int k = 0; k < 2; ++k) dst[m][k] = *(const PG8_LAS bf16x8*)(lds + PG8_SA(b, h) + aoff + m * 2048 + k * 1024); } while (0)
#define PG8_LDB(dst, b, h) do { _Pragma("unroll") for (int n = 0; n < 2; ++n) _Pragma("unroll") for (int k = 0; k < 2; ++k) dst[n][k] = *(const PG8_LAS bf16x8*)(lds + PG8_SB(b, h) + boff + n * 2048 + k * 1024); } while (0)
#define PG8_MMA(ai, bj, At, Bt) do { __builtin_amdgcn_s_setprio(1); _Pragma("unroll") for (int m = 0; m < 4; ++m) _Pragma("unroll") for (int n = 0; n < 2; ++n) _Pragma("unroll") for (int k = 0; k < 2; ++k) \
        acc[ai][bj][m][n] = __builtin_amdgcn_mfma_f32_16x16x32_bf16(Bt[n][k], At[m][k], acc[ai][bj][m][n], 0, 0, 0); __builtin_amdgcn_s_setprio(0); } while (0)
#define PG8_WAIT_V(n) asm volatile("s_waitcnt vmcnt(" #n ")" ::: "memory")
#define PG8_WAIT_L(n) asm volatile("s_waitcnt lgkmcnt(" #n ")" ::: "memory")
#define PG8_BAR __builtin_amdgcn_s_barrier()
#define PG8_SCHED __builtin_amdgcn_sched_barrier(0)
#define PG8_AOFF(dst, ord) do { _Pragma("unroll") for (int h_ = 0; h_ < 2; ++h_) _Pragma("unroll") for (int i_ = 0; i_ < 2; ++i_) { \
        const int src_ = g.rowlds[(ord) * BM + h_ * HALF + RA[i_]]; dst[h_][i_] = (unsigned)(src_ * K + CA[i_]) * 2u; } } while (0)
    Unit cur, nxt; int ui = 0;
    if (!S.next(0, cur)) return;
    f32x4 acc[2][2][4][2];
#pragma unroll
    for (int a = 0; a < 2; ++a)
#pragma unroll
        for (int b = 0; b < 2; ++b)
#pragma unroll
            for (int m = 0; m < 4; ++m)
#pragma unroll
                for (int n = 0; n < 2; ++n) acc[a][b][m][n] = (f32x4){0.f, 0.f, 0.f, 0.f};
    bf16x8 At[4][2], B0[2][2], B1[2][2];
    unsigned vA[2][2], nvA[2][2];
    if constexpr (GATHER) { PG8_AOFF(vA, 0); }
    const char* cA = GATHER ? (const char*)g.A : (const char*)g.A + (size_t)cur.pm * tstep;
    const char* cB = (const char*)g.Bt + ((size_t)cur.e * g.nB + (size_t)cur.pn * BM) * K * 2;
    PG8_STAGEB(PG8_SB(0, 0), cB); PG8_STAGEB(PG8_SB(0, 1), cB + hstep); PG8_STAGEA(PG8_SA(0, 0), cA, 0, vA); PG8_STAGEA(PG8_SA(0, 1), cA, 1, vA);
    if (wr == 1) PG8_BAR;
    PG8_WAIT_V(2); PG8_BAR;
    PG8_STAGEB(PG8_SB(1, 0), cB + kstep); PG8_STAGEA(PG8_SA(1, 0), cA + kstep, 0, vA); PG8_STAGEB(PG8_SB(1, 1), cB + hstep + kstep);
    PG8_WAIT_V(6); PG8_BAR;
    for (;;) {
        const bool has_next = S.next(ui + 1, nxt);
        if constexpr (GATHER) { if (has_next) { PG8_AOFF(nvA, ui + 1); } else {
#pragma unroll
            for (int h_ = 0; h_ < 2; ++h_)
#pragma unroll
                for (int i_ = 0; i_ < 2; ++i_) nvA[h_][i_] = vA[h_][i_]; } }
        const char* nA = GATHER ? cA : (has_next ? (const char*)g.A + (size_t)nxt.pm * tstep : cA);
        const char* nB = has_next ? (const char*)g.Bt + ((size_t)nxt.e * g.nB + (size_t)nxt.pn * BM) * K * 2 : cB;
        for (int t = 0; t < nt; t += 2) {
            const bool last = (t == nt - 2);
            const char* a1 = cA + (size_t)(t + 1) * kstep;
            const char* a2 = last ? nA : cA + (size_t)(t + 2) * kstep; const char* b2 = last ? nB : cB + (size_t)(t + 2) * kstep;
            const char* a3 = a2 + kstep; const char* b3 = b2 + kstep;
            unsigned wv[2][2];
            if constexpr (GATHER) { wv[0][0] = last ? nvA[0][0] : vA[0][0]; wv[0][1] = last ? nvA[0][1] : vA[0][1]; wv[1][0] = last ? nvA[1][0] : vA[1][0]; wv[1][1] = last ? nvA[1][1] : vA[1][1]; }
            PG8_LDB(B0, 0, 0); PG8_LDB(B1, 0, 1); PG8_SCHED; PG8_LDA(At, 0, 0); PG8_STAGEA(PG8_SA(1, 1), a1, 1, vA);
            PG8_WAIT_V(8); PG8_WAIT_L(0); PG8_BAR; PG8_MMA(0, 0, At, B0); PG8_MMA(0, 1, At, B1); PG8_BAR; PG8_SCHED;
            PG8_LDA(At, 0, 1); PG8_STAGEB(PG8_SB(0, 0), b2); PG8_STAGEB(PG8_SB(0, 1), b2 + hstep); PG8_STAGEA(PG8_SA(0, 0), a2, 0, wv);
            PG8_WAIT_V(8); PG8_WAIT_L(0); PG8_BAR; PG8_MMA(1, 0, At, B0); PG8_MMA(1, 1, At, B1); PG8_BAR; PG8_SCHED;
            PG8_LDB(B0, 1, 0); PG8_LDB(B1, 1, 1); PG8_SCHED; PG8_LDA(At, 1, 0); PG8_STAGEA(PG8_SA(0, 1), a2, 1, wv);
            PG8_WAIT_V(8); PG8_WAIT_L(0); PG8_BAR; PG8_MMA(0, 0, At, B0); PG8_MMA(0, 1, At, B1); PG8_BAR; PG8_SCHED;
            PG8_LDA(At, 1, 1); PG8_STAGEB(PG8_SB(1, 0), b3); PG8_STAGEB(PG8_SB(1, 1), b3 + hstep); PG8_STAGEA(PG8_SA(1, 0), a3, 0, wv);
            PG8_WAIT_V(8); PG8_WAIT_L(0); PG8_BAR; PG8_MMA(1, 0, At, B0); PG8_MMA(1, 1, At, B1); PG8_BAR; PG8_SCHED;
        }
        if (wr == 0) PG8_BAR;
        E(acc, cur, wr, wc, fr, fq);
        if (!has_next) break;
#pragma unroll
        for (int a = 0; a < 2; ++a)
#pragma unroll
            for (int b = 0; b < 2; ++b)
#pragma unroll
                for (int m = 0; m < 4; ++m)
#pragma unroll
                    for (int n = 0; n < 2; ++n) acc[a][b][m][n] = (f32x4){0.f, 0.f, 0.f, 0.f};
        cur = nxt; cB = nB; cA = nA; ++ui;
        if constexpr (GATHER) {
#pragma unroll
        for (int h_ = 0; h_ < 2; ++h_)
#pragma unroll
            for (int i_ = 0; i_ < 2; ++i_) vA[h_][i_] = nvA[h_][i_]; }
        if (wr == 1) PG8_BAR;
    }
    PG8_WAIT_V(0);
    PG8_BAR;
#undef PG8_SA
#undef PG8_SB
#undef PG8_STAGE
#undef PG8_STAGEB
#undef PG8_STAGEA
#undef PG8_LDA
#undef PG8_LDB
#undef PG8_MMA
#undef PG8_WAIT_V
#undef PG8_WAIT_L
#undef PG8_BAR
#undef PG8_SCHED
#undef PG8_AOFF
}
}

namespace pg8 {
struct EpiIn {
    static constexpr bool PERM = true;
    bf16_t *Q, *Kb, *V, *PRW, *GT; float qscale;
    __device__ __forceinline__ void operator()(const f32x4 (&acc)[2][2][4][2], const Unit& u, int wr, int wc, int fr, int fq) const {
        const int pn = u.pn; bf16_t* base; int ld, colt, mode = 0;
        if (pn < 2) { base = Q; ld = 512; colt = pn * 256; mode = 1; }
        else if (pn < 4) { base = Kb; ld = 512; colt = (pn - 2) * 256; }
        else if (pn < 6) { base = V; ld = 512; colt = (pn - 4) * 256; }
        else if (pn < 13) { base = PRW; ld = 1792; colt = (pn - 6) * 256; }
        else { base = GT; ld = 2048; colt = (pn - 13) * 256; mode = 2; }
        const int row0 = u.pm * BM + wr * 64 + fr, col0 = colt + wc * 32 + 8 * fq;
        const float sc = (mode == 1) ? qscale : 1.0f;
#pragma unroll
        for (int ai = 0; ai < 2; ++ai)
#pragma unroll
            for (int m = 0; m < 4; ++m) { bf16_t* rowp = base + (size_t)(row0 + ai * HALF + m * 16) * ld + col0;
#pragma unroll
                for (int bj = 0; bj < 2; ++bj) { f32x4 v0 = acc[ai][bj][m][0] * sc, v1 = acc[ai][bj][m][1] * sc;
                    if (mode == 2) {
#pragma unroll
                        for (int e = 0; e < 4; ++e) { v0[e] = fsigmoid(v0[e]); v1[e] = fsigmoid(v1[e]); } }
                    u32x4 w; w.x = cvt_pk_bf16(v0[0], v0[1]); w.y = cvt_pk_bf16(v0[2], v0[3]); w.z = cvt_pk_bf16(v1[0], v1[1]); w.w = cvt_pk_bf16(v1[2], v1[3]);
                    *(u32x4*)(rowp + bj * HALF) = w; } }
    }
};
template <int MODE> struct EpiGate {
    static constexpr bool PERM = true;
    bf16_t* O; int ldo; const bf16_t* G; int ldg; int gcol0;
    __device__ __forceinline__ void operator()(const f32x4 (&acc)[2][2][4][2], const Unit& u, int wr, int wc, int fr, int fq) const {
        const int row0 = u.pm * BM + wr * 64 + fr, col0 = u.pn * BM + wc * 32 + 8 * fq;
#pragma unroll
        for (int ai = 0; ai < 2; ++ai)
#pragma unroll
            for (int m = 0; m < 4; ++m) { const size_t row = (size_t)(row0 + ai * HALF + m * 16); bf16_t* rowp = O + row * ldo + col0;
#pragma unroll
                for (int bj = 0; bj < 2; ++bj) { f32x4 v0 = acc[ai][bj][m][0], v1 = acc[ai][bj][m][1];
                    if (MODE >= 1) { const u32x4 gw = *(const u32x4*)(G + row * ldg + gcol0 + col0 + bj * HALF);
                        v0[0] *= bf_lo(gw.x); v0[1] *= bf_hi(gw.x); v0[2] *= bf_lo(gw.y); v0[3] *= bf_hi(gw.y); v1[0] *= bf_lo(gw.z); v1[1] *= bf_hi(gw.z); v1[2] *= bf_lo(gw.w); v1[3] *= bf_hi(gw.w); }
                    if (MODE == 2) { const u32x4 ow = *(const u32x4*)(rowp + bj * HALF);
                        v0[0] += bf_lo(ow.x); v0[1] += bf_hi(ow.x); v0[2] += bf_lo(ow.y); v0[3] += bf_hi(ow.y); v1[0] += bf_lo(ow.z); v1[1] += bf_hi(ow.z); v1[2] += bf_lo(ow.w); v1[3] += bf_hi(ow.w); }
                    u32x4 w; w.x = cvt_pk_bf16(v0[0], v0[1]); w.y = cvt_pk_bf16(v0[2], v0[3]); w.z = cvt_pk_bf16(v1[0], v1[1]); w.w = cvt_pk_bf16(v1[2], v1[3]);
                    *(u32x4*)(rowp + bj * HALF) = w; } }
    }
};
struct EpiRes {
    static constexpr bool PERM = true;
    const float* X; bf16_t* O; const float* gate; int seq; int gstride;
    __device__ __forceinline__ void operator()(const f32x4 (&acc)[2][2][4][2], const Unit& u, int wr, int wc, int fr, int fq) const {
        const int row0 = u.pm * BM + wr * 64 + fr, col0 = u.pn * BM + wc * 32 + 8 * fq;
        const float* gp = gate + (size_t)((u.pm * BM) / seq) * gstride + col0;
        f32x4 gv[2][2];
#pragma unroll
        for (int bj = 0; bj < 2; ++bj)
#pragma unroll
            for (int n = 0; n < 2; ++n) gv[bj][n] = *(const f32x4*)(gp + bj * HALF + n * 4);
#pragma unroll
        for (int ai = 0; ai < 2; ++ai)
#pragma unroll
            for (int m = 0; m < 4; ++m) { const size_t off = (size_t)(row0 + ai * HALF + m * 16) * 1024 + col0;
#pragma unroll
                for (int bj = 0; bj < 2; ++bj) { const f32x4 x0 = *(const f32x4*)(X + off + bj * HALF), x1 = *(const f32x4*)(X + off + bj * HALF + 4);
                    const f32x4 v0 = x0 + gv[bj][0] * acc[ai][bj][m][0], v1 = x1 + gv[bj][1] * acc[ai][bj][m][1];
                    u32x4 w; w.x = cvt_pk_bf16(v0[0], v0[1]); w.y = cvt_pk_bf16(v0[2], v0[3]); w.z = cvt_pk_bf16(v1[0], v1[1]); w.w = cvt_pk_bf16(v1[2], v1[3]);
                    *(u32x4*)(O + off + bj * HALF) = w; } }
    }
};
struct EpiSwiGLU {
    static constexpr bool PERM = true;
    bf16_t* H;
    __device__ __forceinline__ void operator()(const f32x4 (&acc)[2][2][4][2], const Unit& u, int wr, int wc, int fr, int fq) const {
        const int row0 = u.pm * BM + wr * 64 + fr, col0 = u.pn * HALF + wc * 32 + 8 * fq;
#pragma unroll
        for (int ai = 0; ai < 2; ++ai)
#pragma unroll
            for (int m = 0; m < 4; ++m) { bf16_t* rowp = H + (size_t)(row0 + ai * HALF + m * 16) * 512 + col0;
                f32x4 v0, v1;
#pragma unroll
                for (int e = 0; e < 4; ++e) { const float a0 = acc[ai][0][m][0][e], a1 = acc[ai][0][m][1][e];
                    v0[e] = a0 * fsigmoid(a0) * acc[ai][1][m][0][e]; v1[e] = a1 * fsigmoid(a1) * acc[ai][1][m][1][e]; }
                u32x4 w; w.x = cvt_pk_bf16(v0[0], v0[1]); w.y = cvt_pk_bf16(v0[2], v0[3]); w.z = cvt_pk_bf16(v1[0], v1[1]); w.w = cvt_pk_bf16(v1[2], v1[3]);
                *(u32x4*)rowp = w; }
    }
};
struct EpiFp8 {
    static constexpr bool PERM = true;
    unsigned char* O; int ldo;
    __device__ __forceinline__ void operator()(const f32x4 (&acc)[2][2][4][2], const Unit& u, int wr, int wc, int fr, int fq) const {
        const int row0 = u.pm * BM + wr * 64 + fr, col0 = u.pn * BM + wc * 32 + 8 * fq;
#pragma unroll
        for (int ai = 0; ai < 2; ++ai)
#pragma unroll
            for (int m = 0; m < 4; ++m) { unsigned char* rowp = O + (size_t)(row0 + ai * HALF + m * 16) * ldo + col0;
#pragma unroll
                for (int bj = 0; bj < 2; ++bj) { const f32x4 v0 = acc[ai][bj][m][0], v1 = acc[ai][bj][m][1];
                    int lo = __builtin_amdgcn_cvt_pk_fp8_f32(v0[0], v0[1], 0, false); lo = __builtin_amdgcn_cvt_pk_fp8_f32(v0[2], v0[3], lo, true);
                    int hi = __builtin_amdgcn_cvt_pk_fp8_f32(v1[0], v1[1], 0, false); hi = __builtin_amdgcn_cvt_pk_fp8_f32(v1[2], v1[3], hi, true);
                    *(u32x2*)(rowp + bj * HALF) = (u32x2){(unsigned)lo, (unsigned)hi}; } }
    }
};
struct MoeOrder {
    int nunits, G, c, cshift; const PG8_LAS int* tile_e;
    __device__ __forceinline__ bool next(int i, Unit& u) const {
        const int L = i * G + c; if (L >= nunits) return false;
        u.pm = L >> cshift; u.pn = L & ((1 << cshift) - 1); u.e = tile_e[u.pm]; return true;
    }
};
}
#include <hip/hip_bf16.h>
#include <cmath>
namespace attn_body {
using bf16=__hip_bfloat16;
using bf16x8=__attribute__((ext_vector_type(8)))short;
using s16x4=__attribute__((ext_vector_type(4)))short;
using f32x16=__attribute__((ext_vector_type(16)))float;
using u32x4=__attribute__((ext_vector_type(4)))unsigned;
constexpr int BATCH=2,NHEAD=8,SEQ=16384,D=64,DM=NHEAD*D;
constexpr int NW=8,QBLK=32,QB=QBLK*NW,KVBLK=64,NQB=SEQ/QB;
constexpr int ATTN_PITCH=DM, ATTN_UNIT_ROWS=QB;
__device__ __forceinline__ int crow(int r,int hi){return (r&3)+8*(r>>2)+4*hi;}
#define SBAR() __builtin_amdgcn_sched_barrier(0)
__device__ __forceinline__ void cmask(f32x16&p0,f32x16&p1,int jb,int qrel,int hi){
  const float NEG=-INFINITY; int x=qrel-64*jb-4*hi; asm volatile("":"+v"(x));
  #pragma unroll
  for(int r=0;r<16;++r){const int c=(r&3)+8*(r>>2); if(c>x)p0[r]=NEG; if(c+32>x)p1[r]=NEG;}
}

constexpr int NSLOT=3, SLOTB=8192;
constexpr int LDS_K=0, LDS_V=NSLOT*SLOTB, LDS_WS=2*NSLOT*SLOTB, LDS_OST=LDS_WS+NW*64*4, LDS_BYTES=LDS_OST+NW*4096;
constexpr float C2=0.125f*1.4426950408889634f;
__device__ __forceinline__ void glds16(const void*gsrc,unsigned lds_dst){unsigned keep;
  asm volatile("s_mov_b32 %0, m0\n\ts_mov_b32 m0, %2\n\ts_nop 0\n\tglobal_load_lds_dwordx4 %1, off\n\ts_mov_b32 m0, %0":"=&s"(keep):"v"(gsrc),"s"(lds_dst):"memory");}
__device__ __forceinline__ float max3f(float a,float b,float c){float r;asm("v_max3_f32 %0, %1, %2, %3":"=v"(r):"v"(a),"v"(b),"v"(c));return r;}
__device__ __forceinline__ float max2f(float a,float b){float r;asm("v_max_f32_e32 %0, %1, %2":"=v"(r):"v"(a),"v"(b));return r;}
__device__ __forceinline__ float fadd_s(float a,float b){float r;asm("v_add_f32_e32 %0, %1, %2":"=v"(r):"v"(a),"v"(b));return r;}
__device__ __forceinline__ float fsub_s(float a,float b){float r;asm("v_sub_f32_e32 %0, %1, %2":"=v"(r):"v"(a),"v"(b));return r;}
typedef float f32x2_t __attribute__((ext_vector_type(2))); typedef __bf16 bf16x2_t __attribute__((ext_vector_type(2)));
__device__ __forceinline__ unsigned cvtpk_s(float lo,float hi){f32x2_t v={lo,hi};bf16x2_t b=__builtin_convertvector(v,bf16x2_t);return __builtin_bit_cast(unsigned,b);}
#define WAIT_BAR(N) asm volatile("s_waitcnt vmcnt(" #N ") lgkmcnt(0)\n\ts_barrier":::"memory")

__device__ __forceinline__ void qkt(f32x16&p0,f32x16&p1,const char*Kslot,const bf16x8*qr,int r32,int hi){
  const char*kb=Kslot+hi*1024+r32*16;
  #pragma unroll
  for(int d0=0;d0<4;++d0){
    const bf16x8 b0=*reinterpret_cast<const bf16x8*>(kb+d0*2048);
    const bf16x8 b1=*reinterpret_cast<const bf16x8*>(kb+d0*2048+512);
    if(d0==0){p0=__builtin_amdgcn_mfma_f32_32x32x16_bf16(b0,qr[0],p0,0,0,0);p1=__builtin_amdgcn_mfma_f32_32x32x16_bf16(b1,qr[0],p1,0,0,0);}
    else{p0=__builtin_amdgcn_mfma_f32_32x32x16_bf16(b0,qr[d0],p0,0,0,0);p1=__builtin_amdgcn_mfma_f32_32x32x16_bf16(b1,qr[d0],p1,0,0,0);}}
}
typedef __attribute__((address_space(3))) const char* lds_cptr;
typedef short v4i16_t __attribute__((ext_vector_type(4)));
__device__ __forceinline__ void kload8(bf16x8*kf,lds_cptr kp){
  kf[0]=*(const __attribute__((address_space(3))) bf16x8*)(kp);      kf[1]=*(const __attribute__((address_space(3))) bf16x8*)(kp+512);
  kf[2]=*(const __attribute__((address_space(3))) bf16x8*)(kp+2048); kf[3]=*(const __attribute__((address_space(3))) bf16x8*)(kp+2560);
  kf[4]=*(const __attribute__((address_space(3))) bf16x8*)(kp+4096); kf[5]=*(const __attribute__((address_space(3))) bf16x8*)(kp+4608);
  kf[6]=*(const __attribute__((address_space(3))) bf16x8*)(kp+6144); kf[7]=*(const __attribute__((address_space(3))) bf16x8*)(kp+6656);
}
__device__ __forceinline__ void kload2(bf16x8*kf,lds_cptr kp,int j){ kf[2*j]=*(const __attribute__((address_space(3))) bf16x8*)(kp+j*2048); kf[2*j+1]=*(const __attribute__((address_space(3))) bf16x8*)(kp+j*2048+512); }
__device__ __forceinline__ s16x4 vtr(lds_cptr p){ return __builtin_bit_cast(s16x4,__builtin_amdgcn_ds_read_tr16_b64_v4i16((__attribute__((address_space(3))) v4i16_t*)p)); }
__device__ __forceinline__ float rowmax(const f32x16&p0,const f32x16&p1){
  float a=max3f(p0[0],p0[1],p1[0]),b=max3f(p0[2],p0[3],p1[1]);a=max3f(a,p1[2],p1[3]);
  #pragma unroll
  for(int r=4;r<16;r+=4){a=max3f(a,p0[r],p0[r+1]);b=max3f(b,p0[r+2],p0[r+3]);a=max3f(a,p1[r],p1[r+1]);b=max3f(b,p1[r+2],p1[r+3]);}
  const float m=max2f(a,b);
  auto rr=__builtin_amdgcn_permlane32_swap(__float_as_uint(m),__float_as_uint(m),false,false);
  return max2f(__uint_as_float(rr[0]),__uint_as_float(rr[1]));
}
__device__ __forceinline__ void pv(f32x16*o,int vb,bf16x8 pa0,bf16x8 pa1,bf16x8 pa2,bf16x8 pa3){
  #pragma unroll
  for(int d0=0;d0<2;++d0){s16x4 lo[4],hi[4];
    #pragma unroll
    for(int ks=0;ks<4;++ks){
      asm volatile("ds_read_b64_tr_b16 %0,%1 offset:%c2":"=&v"(lo[ks]):"v"(vb),"i"(d0*4096+ks*1024):"memory");
      asm volatile("ds_read_b64_tr_b16 %0,%1 offset:%c2":"=&v"(hi[ks]):"v"(vb),"i"(d0*4096+ks*1024+512):"memory");}
    asm volatile("s_waitcnt lgkmcnt(0)":::"memory");SBAR();
    #define PK(k) (bf16x8){lo[k][0],lo[k][1],lo[k][2],lo[k][3],hi[k][0],hi[k][1],hi[k][2],hi[k][3]}
    o[d0]=__builtin_amdgcn_mfma_f32_32x32x16_bf16(pa0,PK(0),o[d0],0,0,0);
    o[d0]=__builtin_amdgcn_mfma_f32_32x32x16_bf16(pa1,PK(1),o[d0],0,0,0);
    o[d0]=__builtin_amdgcn_mfma_f32_32x32x16_bf16(pa2,PK(2),o[d0],0,0,0);
    o[d0]=__builtin_amdgcn_mfma_f32_32x32x16_bf16(pa3,PK(3),o[d0],0,0,0);
    #undef PK
  }
}

#ifndef ATTN_STORE16
#define ATTN_STORE16(p,v) (*(u32x4*)(p)=(v))
#endif
typedef float f32x4_t __attribute__((ext_vector_type(4)));
#define NEXTB(P0,P1,tt) do{ const __attribute__((address_space(3))) float* tb_=tab3+(tt)*64+4*hi; const float nm_=-mhat; \
  _Pragma("unroll") for(int g_=0;g_<4;++g_){ const f32x4_t b0_=*(const __attribute__((address_space(3))) f32x4_t*)(tb_+8*g_); const f32x4_t b1_=*(const __attribute__((address_space(3))) f32x4_t*)(tb_+32+8*g_); \
    _Pragma("unroll") for(int j_=0;j_<4;++j_){ P0[4*g_+j_]=nm_-b0_[j_]; P1[4*g_+j_]=nm_-b1_[j_]; } } }while(0)
template<int THRL> __device__ __forceinline__ void attn_unit(int b,int h,int qb,int t0,const bf16*Q,const bf16*__restrict__ K,const bf16*__restrict__ V,bf16*O,const float*__restrict__ cumT,char*shm,int tab_off,int segp_off,unsigned*qctr){
  const int tid=threadIdx.x,lane=tid&63,r32=lane&31,hi=lane>>5; const int wid=__builtin_amdgcn_readfirstlane(tid>>6);
  const long rowbase=(long)b*SEQ; const int q0=qb*QB;
  const bf16*Qw=Q+(rowbase+q0+wid*QBLK)*DM+h*D;
  const bf16*Kh=K+(rowbase+(long)t0*KVBLK)*DM+h*D,*Vh=V+(rowbase+(long)t0*KVBLK)*DM+h*D;
  const unsigned lds0=(unsigned)(uintptr_t)shm;
  float*wsf=(float*)(shm+LDS_WS)+wid*64;
  const bf16*ksrc=Kh+(long)lane*DM+wid*8;
  const bf16*vsrc=Vh+(long)(16*(wid&3)+(lane>>2))*DM+(wid>>2)*32+(lane&3)*8;
  const unsigned kdst=lds0+LDS_K+wid*1024, vdst=lds0+LDS_V+wid*1024;
  #define DMA_K(t,slot) glds16(ksrc+(long)(t)*KVBLK*DM,(unsigned)__builtin_amdgcn_readfirstlane(kdst+(slot)))
  #define DMA_V(t,slot) glds16(vsrc+(long)(t)*KVBLK*DM,(unsigned)__builtin_amdgcn_readfirstlane(vdst+(slot)))
  const int vb0=(int)(lds0+LDS_V)+((lane>>4)&1)*32+(lane&3)*8+(4*hi+((lane&15)>>2))*64;
  const char*Kbase=shm+LDS_K; bf16x8 kf[8];
  const lds_cptr shm3=(lds_cptr)shm; const lds_cptr kp0=shm3+LDS_K+hi*1024+r32*16; const lds_cptr vp0=shm3+LDS_V+((lane>>4)&1)*32+(lane&3)*8+(4*hi+((lane&15)>>2))*64;
  const int NT=(q0+QB)/KVBLK-t0;
  const __attribute__((address_space(3))) float* tab3=(const __attribute__((address_space(3))) float*)(shm3+tab_off);
  { int tl_=threadIdx.x; asm volatile("":"+v"(tl_));
    float*tabw=(float*)(shm+tab_off); const float L2E=1.4426950408889634f;
    const float*cg=cumT+((long)(b*NHEAD+h))*SEQ; const float cref=cg[q0]*L2E;
    for(int i=tl_;i<NT*KVBLK;i+=NW*64){ const int kv=t0*KVBLK+i; tabw[i]=cg[kv]*L2E-cref; }
    asm volatile("s_waitcnt vmcnt(0) lgkmcnt(0)\n\ts_barrier":::"memory"); }
  DMA_K(0,0);DMA_V(0,0);DMA_K(1,SLOTB);
  bf16x8 qr[4];
  #pragma unroll
  for(int d0=0;d0<4;++d0)qr[d0]=*reinterpret_cast<const bf16x8*>(&Qw[(long)r32*DM+d0*16+hi*8]);
  float mhat=0.f,l_reg=0.f;f32x16 o[2];o[0]=f32x16{};o[1]=f32x16{};
  const int qrel=wid*QBLK+r32;
  #define CMASK(P0,P1,t) do{int jb_=(t)-(NT-4); if(jb_>=0)cmask(P0,P1,jb_,qrel,hi);}while(0)
  bool resc=false;
  #define START(P0,P1) do{ const float rm=rowmax(P0,P1); resc=false; \
    { const float dl=rm; mhat=fadd_s(mhat,dl); \
      _Pragma("unroll") for(int r=0;r<16;++r){P0[r]=fsub_s(P0[r],dl);P1[r]=fsub_s(P1[r],dl);} \
      } \
    _Pragma("unroll") for(int r=0;r<16;++r)P0[r]=__builtin_amdgcn_exp2f(P0[r]); }while(0)
  #define RESC() do{ if(resc){ asm volatile("s_waitcnt lgkmcnt(0)":::"memory"); \
      _Pragma("unroll") for(int d_=0;d_<2;++d_) _Pragma("unroll") for(int r=0;r<16;++r)o[d_][r]*=wsf[crow(r,hi)]; } }while(0)
  f32x16 pA0,pA1,pB0,pB1;
  int sl_prev=0,sl_cur=0,sl_next=SLOTB;
  #define ROT() do{sl_prev=sl_cur;sl_cur=sl_next;sl_next=(sl_next==(NSLOT-1)*SLOTB)?0:sl_next+SLOTB;}while(0)
  DMA_K(2,2*SLOTB);
  WAIT_BAR(3);
  NEXTB(pA0,pA1,0);
  qkt(pA0,pA1,Kbase,qr,r32,hi);asm volatile("s_nop 15\n\ts_nop 7":"+v"(pA0),"+v"(pA1));CMASK(pA0,pA1,0);
  START(pA0,pA1);
  NEXTB(pB0,pB1,1);
  _Pragma("unroll") for(int r=0;r<16;++r)pA1[r]=__builtin_amdgcn_exp2f(pA1[r]);
  WAIT_BAR(0);
  DMA_K(3,0);DMA_V(1,SLOTB);
  ROT();
  kload8(kf,kp0+sl_cur);
  WAIT_BAR(2);
  s16x4 vlo[8],vhi[8]; u32x4 pw0,pw1,pw2,pw3;
  #define PKW(P,B) cvtpk_s(P[B],P[B+1])
  #define PAF(k) __builtin_bit_cast(bf16x8,pw##k)
  #define VFR(i) (bf16x8){vlo[i][0],vlo[i][1],vlo[i][2],vlo[i][3],vhi[i][0],vhi[i][1],vhi[i][2],vhi[i][3]}
  #define PIN(x) asm volatile("":"+v"(x))
  #define MX3(a,b,c) __builtin_fmaxf(__builtin_fmaxf((a),(b)),(c))
  #define GAPA(MF,A0,A1,A2,A3,W0,W1,PW) do{ MF; sacc+=A0; sacc+=A1; sacc+=A2; sacc+=A3; PIN(sacc); W0; W1; PIN(PW); SBAR(); }while(0)
  #define EX(v) __builtin_amdgcn_exp2f(v)
  #define GAPB(MF,X,B) do{ MF; X[B]=EX(X[B]); X[B+1]=EX(X[B+1]); X[B+2]=EX(X[B+2]); X[B+3]=EX(X[B+3]); PIN(X); SBAR(); }while(0)
  #define VRD(i) do{ vlo[i]=vtr(vp_+(((i)>>2)*4096+((i)&3)*1024)); vhi[i]=vtr(vp_+(((i)>>2)*4096+((i)&3)*1024+512)); }while(0)
  #define KRD(G,j) do{ if(G){ kload2(kf,kp0+sl_next,j); SBAR(); } }while(0)
  #define STEP(C0,C1,P0,P1,t,GK,GV,GL) do{ SBAR(); \
    const lds_cptr vp_=vp0+sl_prev; \
    VRD(0); SBAR(); float sacc=(P0[0]+P0[1]); \
    GAPA(C0=__builtin_amdgcn_mfma_f32_32x32x16_bf16(kf[0],qr[0],C0,0,0,0), P0[2],P0[3],P0[4],P0[5],     pw0[0]=PKW(P0,0), pw0[1]=PKW(P0,2), pw0); \
    VRD(4); SBAR(); GAPA(C1=__builtin_amdgcn_mfma_f32_32x32x16_bf16(kf[1],qr[0],C1,0,0,0), P0[6],P0[7],P0[8],P0[9],     pw0[2]=PKW(P0,4), pw0[3]=PKW(P0,6), pw0); \
    VRD(1); SBAR(); GAPA(C0=__builtin_amdgcn_mfma_f32_32x32x16_bf16(kf[2],qr[1],C0,0,0,0),   P0[10],P0[11],P0[12],P0[13], pw1[0]=PKW(P0,8), pw1[1]=PKW(P0,10), pw1); \
    VRD(5); SBAR(); GAPA(C1=__builtin_amdgcn_mfma_f32_32x32x16_bf16(kf[3],qr[1],C1,0,0,0),   P0[14],P0[15],P1[0],P1[1],   pw1[2]=PKW(P0,12),pw1[3]=PKW(P0,14), pw1); \
    VRD(2); SBAR(); GAPA(C0=__builtin_amdgcn_mfma_f32_32x32x16_bf16(kf[4],qr[2],C0,0,0,0),   P1[2],P1[3],P1[4],P1[5],     pw2[0]=PKW(P1,0), pw2[1]=PKW(P1,2), pw2); \
    VRD(6); SBAR(); GAPA(C1=__builtin_amdgcn_mfma_f32_32x32x16_bf16(kf[5],qr[2],C1,0,0,0),   P1[6],P1[7],P1[8],P1[9],     pw2[2]=PKW(P1,4), pw2[3]=PKW(P1,6), pw2); \
    VRD(3); SBAR(); GAPA(C0=__builtin_amdgcn_mfma_f32_32x32x16_bf16(kf[6],qr[3],C0,0,0,0),   P1[10],P1[11],P1[12],P1[13], pw3[0]=PKW(P1,8), pw3[1]=PKW(P1,10), pw3); \
    VRD(7); SBAR(); GAPA(C1=__builtin_amdgcn_mfma_f32_32x32x16_bf16(kf[7],qr[3],C1,0,0,0),   P1[14],P1[15],0.f,0.f,       pw3[2]=PKW(P1,12),pw3[3]=PKW(P1,14), pw3); \
    l_reg+=sacc; \
    if(GK){DMA_K((t)+3,sl_cur);} if(GV){DMA_V((t)+1,sl_next);} \
    CMASK(C0,C1,t); \
    { float a=MX3(C0[0],C0[1],C1[0]),b=MX3(C0[2],C0[3],C1[1]); a=MX3(a,C1[2],C1[3]); \
      _Pragma("unroll") for(int r=4;r<16;r+=4){a=MX3(a,C0[r],C0[r+1]);b=MX3(b,C0[r+2],C0[r+3]);a=MX3(a,C1[r],C1[r+1]);b=MX3(b,C1[r+2],C1[r+3]);} \
      float rm=__builtin_fmaxf(a,b); { auto rr=__builtin_amdgcn_permlane32_swap(__float_as_uint(rm),__float_as_uint(rm),false,false); rm=__builtin_fmaxf(__uint_as_float(rr[0]),__uint_as_float(rr[1])); } \
      resc=false; \
      if(__builtin_expect(__any(rm>(float)THRL),0)){ const float dl=__builtin_fmaxf(rm,0.f); mhat+=dl; \
        _Pragma("unroll") for(int r=0;r<16;++r){C0[r]-=dl;C1[r]-=dl;} \
        const float f=__builtin_amdgcn_exp2f(-dl); l_reg*=f; if(hi==0)wsf[r32]=f; resc=true; } } \
    if(GL){NEXTB(P0,P1,(t)+1);} \
    SBAR(); \
    GAPB(o[0]=__builtin_amdgcn_mfma_f32_32x32x16_bf16(PAF(0),VFR(0),o[0],0,0,0), C0,0); \
    GAPB(o[1]=__builtin_amdgcn_mfma_f32_32x32x16_bf16(PAF(0),VFR(4),o[1],0,0,0), C0,4); \
    KRD(GL,0); GAPB(o[0]=__builtin_amdgcn_mfma_f32_32x32x16_bf16(PAF(1),VFR(1),o[0],0,0,0), C0,8); \
    KRD(GL,1); GAPB(o[1]=__builtin_amdgcn_mfma_f32_32x32x16_bf16(PAF(1),VFR(5),o[1],0,0,0), C0,12); \
    KRD(GL,2); GAPB(o[0]=__builtin_amdgcn_mfma_f32_32x32x16_bf16(PAF(2),VFR(2),o[0],0,0,0), C1,0); \
    KRD(GL,3); GAPB(o[1]=__builtin_amdgcn_mfma_f32_32x32x16_bf16(PAF(2),VFR(6),o[1],0,0,0), C1,4); \
    GAPB(o[0]=__builtin_amdgcn_mfma_f32_32x32x16_bf16(PAF(3),VFR(3),o[0],0,0,0), C1,8); \
    GAPB(o[1]=__builtin_amdgcn_mfma_f32_32x32x16_bf16(PAF(3),VFR(7),o[1],0,0,0), C1,12); \
    }while(0)
  int t=1;
  #undef CMASK
  #define CMASK(P0,P1,t) do{}while(0)
  for(;t+5<NT;t+=2){
    STEP(pB0,pB1,pA0,pA1,t,true,true,true);     WAIT_BAR(2); RESC(); ROT();
    STEP(pA0,pA1,pB0,pB1,t+1,true,true,true);   WAIT_BAR(2); RESC(); ROT();
  }
  #undef CMASK
  #define CMASK(P0,P1,t) do{int jb_=(t)-(NT-4); if(jb_>=0)cmask(P0,P1,jb_,qrel,hi);}while(0)
  #define ENDW(tt) do{ if((tt)+3<NT){WAIT_BAR(2);} else if((tt)+2<NT){WAIT_BAR(1);} else {WAIT_BAR(0);} }while(0)
  for(;t+1<NT;t+=2){
    STEP(pB0,pB1,pA0,pA1,t,(t+3<NT),(t+1<NT),(t+1<NT));       ENDW(t);   RESC(); ROT();
    STEP(pA0,pA1,pB0,pB1,t+1,(t+4<NT),(t+2<NT),(t+2<NT));     ENDW(t+1); RESC(); ROT();
  }
  STEP(pB0,pB1,pA0,pA1,NT-1,false,false,false); RESC();
  { float sacc=pB0[0]+pB0[1]; _Pragma("unroll") for(int r=2;r<16;++r)sacc+=pB0[r]; _Pragma("unroll") for(int r=0;r<16;++r)sacc+=pB1[r]; l_reg+=sacc;
    pw0=(u32x4){PKW(pB0,0),PKW(pB0,2),PKW(pB0,4),PKW(pB0,6)};pw1=(u32x4){PKW(pB0,8),PKW(pB0,10),PKW(pB0,12),PKW(pB0,14)};pw2=(u32x4){PKW(pB1,0),PKW(pB1,2),PKW(pB1,4),PKW(pB1,6)};pw3=(u32x4){PKW(pB1,8),PKW(pB1,10),PKW(pB1,12),PKW(pB1,14)};
    SBAR(); pv(o,vb0+sl_cur,PAF(0),PAF(1),PAF(2),PAF(3)); }
  #undef PKW
  #undef PAF
  #undef VFR
  #undef PIN
  #undef MX3
  #undef GAPA
  #undef GAPB
  #undef EX
  #undef VRD
  #undef KRD
  #undef STEP
  #undef ENDW
  {auto rr=__builtin_amdgcn_permlane32_swap(__float_as_uint(l_reg),__float_as_uint(l_reg),false,false);l_reg=__uint_as_float(rr[0])+__uint_as_float(rr[1]);}
  int un_=0; if(threadIdx.x==0)un_=(int)__hip_atomic_fetch_add(qctr,1u,__ATOMIC_RELAXED,__HIP_MEMORY_SCOPE_AGENT);
  int lane_e=threadIdx.x&63; asm volatile("":"+v"(lane_e));
  const int r32e=lane_e&31,hie=lane_e>>5;
  if(hie==0)wsf[32+r32e]=l_reg;asm volatile("s_waitcnt lgkmcnt(0)":::"memory");
  float rli[16];
  #pragma unroll
  for(int r=0;r<16;++r)rli[r]=__builtin_amdgcn_rcpf(wsf[32+crow(r,hie)]);
  bf16*Ow=O+(rowbase+q0+wid*QBLK)*DM+h*D;
  { bf16*stg=(bf16*)(shm+LDS_OST)+wid*2048;
    #pragma unroll
    for(int r=0;r<16;++r){const int orow=crow(r,hie);
      #pragma unroll
      for(int d0=0;d0<2;++d0)stg[orow*64+d0*32+r32e]=__float2bfloat16(o[d0][r]*rli[r]);}
    asm volatile("s_waitcnt lgkmcnt(0)":::"memory");
    #pragma unroll
    for(int i=0;i<4;++i){const int row=i*8+(lane_e>>3),ch=lane_e&7; const u32x4 v=*(const u32x4*)(stg+row*64+ch*8); ATTN_STORE16(Ow+(long)row*DM+ch*8,v);} }
  if(threadIdx.x==0)*(volatile int*)(shm+segp_off)=un_;
  asm volatile("s_waitcnt lgkmcnt(0)\n\ts_barrier":::"memory");
  #undef DMA_K
  #undef DMA_V
  #undef CMASK
  #undef START
  #undef RESC
  #undef ROT
}
constexpr int ATTN_LDS_BYTES=LDS_BYTES;
struct AttnTensors { const bf16* Q; const bf16* K; const bf16* V; bf16* O; const float* cumT; const float* segtot; };
struct AttnUnit { int bh; int qb; };
struct StaticOrder {
  int vcu;
  __device__ __forceinline__ explicit StaticOrder(int grid,int block):vcu((block%8)*(grid/8)+block/8){}
  __device__ __forceinline__ bool next(int i,AttnUnit&u)const{ if(i>=4||vcu>=256)return false; const int s=vcu&15; u.bh=vcu>>4; u.qb=(i==0)?63-s:(i==1)?32+s:(i==2)?31-s:s; return true; }
  __device__ __forceinline__ void a_ready(const AttnUnit&)const{}
  __device__ __forceinline__ void done(const AttnUnit&)const{}
};
constexpr float PRUNE_THR=20.0f;
template<int THRL=8> __device__ __forceinline__ void attn_phase_dyn(char*lds,const AttnTensors&T,unsigned*ctr,const unsigned*qkmax,int tab_off,int segp_off){
  volatile int*slot=(volatile int*)(lds+segp_off);
  __syncthreads();
  if(threadIdx.x==0)slot[0]=(int)__hip_atomic_fetch_add(ctr,1u,__ATOMIC_RELAXED,__HIP_MEMORY_SCOPE_AGENT);
  __syncthreads();
  for(;;){
    int tid=threadIdx.x; asm volatile("":"+v"(tid));
    const int u=slot[0]; if(u>=BATCH*NHEAD*NQB)break;
    const int bh=u&15, qb=(NQB-1)-(u>>4), b=bh/NHEAD, h=bh%NHEAD, q0=qb*QB;
    const float qm=__uint_as_float(qkmax[bh*2]), km=__uint_as_float(qkmax[bh*2+1]);
    const float L2E=1.4426950408889634f; const float*cg=T.cumT+((long)(b*NHEAD+h))*SEQ;
    const float cgk=cg[(tid<4*qb)?64*tid+63:q0], cg0=cg[q0];
    float dg;
    { const int row=tid>>1, hf=tid&1; const long ro=((long)b*SEQ+q0+row)*DM+h*D+32*hf; const u32x4*qp=(const u32x4*)(T.Q+ro); const u32x4*kp=(const u32x4*)(T.K+ro); float d=0.f;
      #pragma unroll
      for(int c4=0;c4<4;++c4){ const u32x4 qa=qp[c4], ka=kp[c4];
        #pragma unroll
        for(int e=0;e<4;++e){ d+=__uint_as_float(qa[e]<<16)*__uint_as_float(ka[e]<<16)+__uint_as_float(qa[e]&0xffff0000u)*__uint_as_float(ka[e]&0xffff0000u); } }
      d+=__shfl_xor(d,1);
      #pragma unroll
      for(int o=2;o<64;o<<=1)d=fminf(d,__shfl_xor(d,o));
      dg=d; }
    float*slotf=(float*)(lds+segp_off)+16;
    if((tid&63)==0)slotf[tid>>6]=dg;
    __syncthreads();
    float dmin=slotf[0];
    #pragma unroll
    for(int w=1;w<NW;++w)dmin=fminf(dmin,slotf[w]);
    const float X=PRUNE_THR+sqrtf(qm*km)-dmin+1.5f;
    const bool skip=(tid<4*qb)&&((cgk-cg0)*L2E>X);
    const unsigned long long bal=__ballot(skip); if((tid&63)==0)slot[1+(tid>>6)]=__popcll(bal);
    __syncthreads();
    int t0=0;
    #pragma unroll
    for(int w=0;w<NW;++w)t0+=slot[1+w];
    t0&=~1;
    attn_unit<THRL>(b,h,qb,t0,T.Q,T.K,T.V,T.O,T.cumT,lds,tab_off,segp_off,ctr);
  }
}
#undef SBAR
#undef WAIT_BAR
}
#define GAS __attribute__((address_space(1)))
#define LAS __attribute__((address_space(3)))
typedef unsigned short bf16;
typedef unsigned v4u __attribute__((ext_vector_type(4)));
typedef float f32x4 __attribute__((ext_vector_type(4)));
typedef short bf16x8 __attribute__((ext_vector_type(8)));
typedef GAS unsigned gu32;
typedef GAS unsigned long long gu64;
#define RLX_AGENT __ATOMIC_RELAXED, __HIP_MEMORY_SCOPE_AGENT
#define LDS_WAIT() asm volatile("s_waitcnt lgkmcnt(0)" ::: "memory")
#define VM_WAIT() asm volatile("s_waitcnt vmcnt(0)" ::: "memory")
__device__ __forceinline__ unsigned long long rt() { return __builtin_amdgcn_s_memrealtime(); }
typedef float pk_f32x2 __attribute__((ext_vector_type(2))); typedef __bf16 pk_bf16x2 __attribute__((ext_vector_type(2)));
__device__ __forceinline__ unsigned pk2(float lo, float hi) { pk_f32x2 v = {lo, hi}; pk_bf16x2 b = __builtin_convertvector(v, pk_bf16x2); return __builtin_bit_cast(unsigned, b); }
__device__ __forceinline__ unsigned f2bf(float f) { return pk2(f, 0.f) & 0xffffu; }

#define XB_TMO      128
#define XB_XCNT(j)  (256  + 64 * (j))
#define XB_XSUB(j)  (1280 + 64 * (j))
#define XB_XGEN(j)  (2304 + 64 * (j))
#define XB_TOP      3328
#define XB_TOPGEN   3392
#define XCD_BAR_WORDS 3456
#define XB_SPIN_CAP (1u << 18)

__device__ __forceinline__ unsigned xb_ld(unsigned* p)              { return __hip_atomic_load(p, __ATOMIC_RELAXED, __HIP_MEMORY_SCOPE_AGENT); }
__device__ __forceinline__ unsigned xb_add(unsigned* p, unsigned v) { return __hip_atomic_fetch_add(p, v, __ATOMIC_RELAXED, __HIP_MEMORY_SCOPE_AGENT); }
__device__ __forceinline__ unsigned xb_xcc_id() { return (unsigned)__builtin_amdgcn_s_getreg((3 << 11) | 20) & 0xFu; }
#define XB_SPIN(cond, bar) do { unsigned _sp = 0; while (cond) { __builtin_amdgcn_s_sleep(1); \
    if ((++_sp & 255u) == 0u) { if (xb_ld(&(bar)[XB_TMO])) break; if (_sp > XB_SPIN_CAP) { atomicAdd(&(bar)[XB_TMO], 1u); break; } } } } while (0)

struct XcdBarrier {
    unsigned* bar; unsigned x;
    volatile LAS unsigned* st;
};

__device__ __forceinline__ XcdBarrier xcd_barrier_post(unsigned* bar, volatile LAS unsigned* st) {
    XcdBarrier b; b.bar = bar; b.x = xb_xcc_id(); b.st = st;
    if (threadIdx.x == 0) (void)xb_add(&bar[XB_XCNT(b.x)], 1u);
    return b;
}
__device__ __forceinline__ void xcd_barrier_complete(unsigned* bar, unsigned x, unsigned& nloc, unsigned& nx) {
    const unsigned G = gridDim.x * gridDim.y * gridDim.z;
    unsigned sum, cnt, mine, sp = 0u;
    for (;;) {
        sum = 0u; cnt = 0u; mine = 0u;
#pragma unroll
        for (unsigned j = 0; j < 16; ++j) { const unsigned c = xb_ld(&bar[XB_XCNT(j)]); sum += c; cnt += (c > 0u) ? 1u : 0u; mine = (j == x) ? c : mine; }
        if (sum == G) break;
        __builtin_amdgcn_s_sleep(1);
        if ((++sp & 255u) == 0u) { if (xb_ld(&bar[XB_TMO])) break; if (sp > XB_SPIN_CAP) { atomicAdd(&bar[XB_TMO], 1u); break; } }
    }
    nloc = mine > 0u ? mine : 1u; nx = cnt > 0u ? cnt : 1u;
}

__device__ __forceinline__ void xcd_barrier(const XcdBarrier& b) {
    asm volatile("s_waitcnt vmcnt(0)" ::: "memory");
    __syncthreads();
    if (threadIdx.x == 0) {
        unsigned* bar = b.bar;
        __builtin_amdgcn_s_waitcnt(0);
        unsigned nloc = b.st[0], nx = b.st[1];
        if (nloc == 0u) { xcd_barrier_complete(bar, b.x, nloc, nx); b.st[0] = nloc; b.st[1] = nx; }
        const unsigned old = xb_add(&bar[XB_XSUB(b.x)], 1u);
        const unsigned gen = old / nloc;
        if (old + 1u == (gen + 1u) * nloc) {
            __builtin_amdgcn_fence(__ATOMIC_RELEASE, "agent");
            asm volatile("s_waitcnt vmcnt(0)" ::: "memory");
            const unsigned og = xb_add(&bar[XB_TOP], 1u);
            const unsigned tg = og / nx;
            if (og + 1u == (tg + 1u) * nx) xb_add(&bar[XB_TOPGEN], 1u);
            else XB_SPIN(xb_ld(&bar[XB_TOPGEN]) == tg, bar);
            __builtin_amdgcn_fence(__ATOMIC_ACQUIRE, "agent");
            xb_add(&bar[XB_XGEN(b.x)], 1u);
            asm volatile("s_waitcnt vmcnt(0)" ::: "memory");
        } else {
            XB_SPIN(xb_ld(&bar[XB_XGEN(b.x)]) == gen, bar);
            __builtin_amdgcn_fence(__ATOMIC_ACQUIRE, "agent");
            asm volatile("s_waitcnt vmcnt(0)" ::: "memory");
        }
    }
    __syncthreads();
}

constexpr int NWAVES = 8;
constexpr int BATCH = 2, SEQ = 16384, D = 1024, M = BATCH * SEQ;
constexpr int FH = 8, FW = 512, RWW = 512, SHW = 1792, DIN = 5384, NIN = 5376;
constexpr int NE = 32, DE = 512, NROUTE = 36;
constexpr int MAXSLOT = 2 * M + NE * 256;
constexpr int MAXTILE = MAXSLOT / 256;
constexpr float ATT_C2 = 0.125f * 1.4426950408889634f;

constexpr size_t MiB = 1u << 20;
constexpr size_t WS_CTL = 0, CTL_ZERO_BYTES = 1 * MiB;
constexpr size_t WS_MOD = 1 * MiB;
constexpr size_t WS_SEGTOT = 1 * MiB + 64 * 1024;
constexpr size_t WS_BLKCNT = 1 * MiB + 96 * 1024;
constexpr size_t WS_WIN = 2 * MiB;
constexpr size_t WS_WOF = 13 * MiB, WS_WOR = 14 * MiB, WS_WO = 15 * MiB;
constexpr size_t WS_LW2 = 17 * MiB, WS_LA2 = 17 * MiB + 64 * 1024, WS_LG2 = 17 * MiB + 128 * 1024;
constexpr size_t WS_CUM = 18 * MiB;
constexpr size_t WS_ROUTE = 19 * MiB;
constexpr size_t WS_ROWTOK = 20 * MiB;
constexpr size_t WS_BON = 21 * MiB;
constexpr size_t WS_XN = 24 * MiB;
constexpr size_t WS_Q = 88 * MiB, WS_K = 120 * MiB, WS_V = 152 * MiB;
constexpr size_t WS_PRW = 184 * MiB;
constexpr size_t WS_GATES = 296 * MiB;
constexpr size_t WS_F = 424 * MiB;
constexpr size_t WS_END = 512 * MiB;
constexpr size_t WS_Y = WS_K;
constexpr size_t WS_H = WS_Q;
constexpr size_t WS_W13 = WS_PRW, WS_W2T = WS_PRW + 64 * MiB;
constexpr size_t WS_TMP = WS_PRW;
constexpr size_t WS_YM = 280 * MiB;
constexpr size_t WS_X1 = 424 * MiB;
static_assert(WS_YM + (size_t)MAXSLOT * 1024 * 2 <= WS_END, "ws map");
static_assert(WS_H + (size_t)MAXSLOT * 512 * 2 <= WS_PRW, "ws map");
constexpr int CW_TMO = 0, CW_CODE = 1;
constexpr int CW_BAR = 4096;
constexpr int CW_QKMAX = 8192;
constexpr int CW_QUEUE = 8448;
constexpr int CW_DIAG = 8704;

constexpr int RING_OFF = 0, RING_BYTES = 131072;
constexpr int TAB_OFF = 83968;
constexpr int SEGP_OFF = TAB_OFF + 65536;
constexpr int TILE_OFF = 131072;
constexpr int LDSCTL_OFF = SEGP_OFF + 512, MISC_OFF = LDSCTL_OFF + 320;
constexpr int LDS_BYTES = LDSCTL_OFF + 512;
static_assert(attn_body::LDS_BYTES <= TAB_OFF, "attention LDS");


#define PHASE_IDS() int tid_ = threadIdx.x; asm volatile("" : "+v"(tid_)); const int lane_ = tid_ & 63; const int wave_ = __builtin_amdgcn_readfirstlane(tid_ >> 6); (void)lane_; (void)wave_
struct Frame {
    LAS unsigned char* lds;
    volatile LAS unsigned* MISC;
    gu32* ctl;
    int tid, lane, wave;
    int vcu, G;
    const float* const* in;
};
template <int CTRL> __device__ __forceinline__ float dpp_f(float v) { return __int_as_float(__builtin_amdgcn_mov_dpp(__float_as_int(v), CTRL, 0xf, 0xf, true)); }
__device__ __forceinline__ float row_sum16(float v) { v += dpp_f<0xB1>(v); v += dpp_f<0x4E>(v); v += dpp_f<0x141>(v); v += dpp_f<0x140>(v); return v; }
__device__ __forceinline__ float wave_sum(float v) { v = row_sum16(v); v += __shfl_xor(v, 16); v += __shfl_xor(v, 32); return v; }
__device__ __forceinline__ float bflo(unsigned w) { return __uint_as_float(w << 16); }
__device__ __forceinline__ float bfhi(unsigned w) { return __uint_as_float(w & 0xffff0000u); }
__device__ __forceinline__ float sigm(float x) { return 1.0f / (1.0f + __expf(-x)); }

__device__ __forceinline__ void transpose_item(const float* W, int ld, int col, int k0, int K, bf16* WT, size_t drow, LAS float* scr, int lane) {
#pragma unroll 8
    for (int i = 0; i < 32; ++i) { const int kk = 2 * i + (lane >> 5); scr[kk * 33 + (lane & 31)] = W[(size_t)(k0 + kk) * ld + col + (lane & 31)]; }
    LDS_WAIT(); asm volatile("" ::: "memory");
    const int c = lane & 7;
#pragma unroll
    for (int j = 0; j < 4; ++j) { const int n = (lane >> 3) + 8 * j; const LAS float* s = scr + (8 * c) * 33 + n;
        v4u o; o.x = pk2(s[0 * 33], s[1 * 33]); o.y = pk2(s[2 * 33], s[3 * 33]); o.z = pk2(s[4 * 33], s[5 * 33]); o.w = pk2(s[6 * 33], s[7 * 33]);
        *(GAS v4u*)(WT + (drow + n) * K + k0 + 8 * c) = o; }
    LDS_WAIT(); asm volatile("" ::: "memory");
}
__device__ __forceinline__ void conv_seg(Frame& F, const float* W, int ld, int col0, int K, int ncols, bf16* WT, size_t drow0) {
    PHASE_IDS();
    LAS float* scr = (LAS float*)(F.lds + RING_OFF + wave_ * 16384);
    const int gw = F.vcu * NWAVES + wave_, NGW = F.G * NWAVES, nkb = K / 64, nnb = ncols / 32;
    for (int it = gw; it < nkb * nnb; it += NGW) { const int kb = it / nnb, nb = it % nnb; transpose_item(W, ld, col0 + 32 * nb, 64 * kb, K, WT, drow0 + 32 * nb, scr, lane_); }
}

struct Args { const float* in[30]; float* out; unsigned char* ws; };

__device__ __forceinline__ void p0_prologue(Frame& F, const Args& A) {
    PHASE_IDS();
    unsigned char* ws = A.ws;
    if (blockIdx.x < 96) {
        const float* c = A.in[1]; const float* aw = A.in[2]; const float* ab = A.in[3];
        const int col = blockIdx.x * 64 + lane_; float a0 = 0.f, a1 = 0.f;
        const int kbeg = wave_ * 128;
#pragma unroll 8
        for (int k = kbeg; k < kbeg + 128; ++k) { const float wv = aw[(size_t)k * 6144 + col]; const float c0 = c[k], c1 = c[1024 + k];
            a0 += c0 * sigm(c0) * wv; a1 += c1 * sigm(c1) * wv; }
        LAS float* red = (LAS float*)(F.lds + 8 * 16384 - 4096);
        red[(wave_ * 2 + 0) * 64 + lane_] = a0; red[(wave_ * 2 + 1) * 64 + lane_] = a1;
        __syncthreads();
        if (wave_ < 2) { float s = 0.f;
#pragma unroll
            for (int w = 0; w < 8; ++w) s += red[(w * 2 + wave_) * 64 + lane_];
            ((float*)(ws + WS_MOD))[wave_ * 6144 + col] = s + ab[col]; }
        __syncthreads();
    }
}

__device__ __forceinline__ void p_convert_early(Frame& F, const Args& A) {
    unsigned char* ws = A.ws;
    const float* w_in = A.in[5];
    conv_seg(F, w_in, DIN, 0, 1024, 1536, (bf16*)(ws + WS_WIN), 0);
    conv_seg(F, w_in, DIN, 1544, 1024, 1792, (bf16*)(ws + WS_WIN), 1536);
    conv_seg(F, w_in, DIN, 3336, 1024, 2048, (bf16*)(ws + WS_WIN), 3328);
    conv_seg(F, A.in[18], 1024, 0, 512, 1024, (bf16*)(ws + WS_WOF), 0);
    conv_seg(F, A.in[19], 1024, 0, 512, 1024, (bf16*)(ws + WS_WOR), 0);
    conv_seg(F, A.in[20], 1024, 0, 1024, 1024, (bf16*)(ws + WS_WO), 0);
    conv_seg(F, A.in[9], 512, 0, 64, 512, (bf16*)(ws + WS_LW2), 0);
    conv_seg(F, A.in[11], 512, 0, 64, 512, (bf16*)(ws + WS_LA2), 0);
    conv_seg(F, A.in[12], 512, 0, 128, 512, (bf16*)(ws + WS_LG2), 0);
}

__device__ __forceinline__ void p1_norm(Frame& F, const Args& A) {
    PHASE_IDS();
    unsigned char* ws = A.ws;
    LAS float* wf = (LAS float*)(F.lds);
    LAS float* lfl = (LAS float*)(F.lds + 32768);
    LAS float* part = (LAS float*)(F.lds + 32768 + 4096);
    const float* x = A.in[0]; const float* g1 = A.in[4]; const float* w_in = A.in[5]; const float* fb = A.in[6];
    const float* mod = (const float*)(ws + WS_MOD);
    bf16* XN = (bf16*)(ws + WS_XN); float* cumT = (float*)(ws + WS_CUM); float* segtot = (float*)(ws + WS_SEGTOT);
    for (int i = tid_; i < 8192; i += NWAVES * 64) wf[(i & 7) * 1024 + (i >> 3)] = w_in[(size_t)(i >> 3) * DIN + 1536 + (i & 7)];
    __syncthreads();
    for (int blk = blockIdx.x; blk < M / 128; blk += F.G) {
        const int b = blk / (SEQ / 128);
        f32x4 gm[4], sh[4];
#pragma unroll
        for (int j = 0; j < 4; ++j) { const int col = 4 * lane_ + 256 * j; const f32x4 g = *(const f32x4*)(g1 + col), sc = *(const f32x4*)(mod + b * 6144 + 1024 + col);
            gm[j] = g * (sc + 1.0f); sh[j] = *(const f32x4*)(mod + b * 6144 + col); }
        float fbv = fb[((lane_ >> 5) & 1) * 4 + ((lane_ >> 4) & 1) * 2 + ((lane_ >> 3) & 1)];
        f32x4 nv[4];
        { const GAS f32x4* xr0 = (const GAS f32x4*)(x + ((size_t)blk * 128 + wave_ * 16) * D) + lane_;
#pragma unroll
          for (int j = 0; j < 4; ++j) nv[j] = xr0[64 * j]; }
        for (int i = 0; i < 16; ++i) {
            const int tl = wave_ * 16 + i; const size_t tok = (size_t)blk * 128 + tl;
            f32x4 v[4]; float s = 0.f;
#pragma unroll
            for (int j = 0; j < 4; ++j) { v[j] = nv[j]; s += (v[j].x * v[j].x + v[j].y * v[j].y) + (v[j].z * v[j].z + v[j].w * v[j].w); }
            if (i + 1 < 16) { const GAS f32x4* xr = (const GAS f32x4*)(x + (tok + 1) * D) + lane_;
#pragma unroll
                for (int j = 0; j < 4; ++j) nv[j] = xr[64 * j]; }
            const float rstd = 1.0f / sqrtf(wave_sum(s) * (1.f / D) + 1e-6f);
            GAS unsigned long long* o8 = (GAS unsigned long long*)(XN + tok * D) + lane_;
            float f[8];
#pragma unroll
            for (int hh = 0; hh < 8; ++hh) f[hh] = 0.f;
#pragma unroll
            for (int j = 0; j < 4; ++j) { v[j] = v[j] * rstd * gm[j] + sh[j];
                o8[64 * j] = (unsigned long long)pk2(v[j].x, v[j].y) | ((unsigned long long)pk2(v[j].z, v[j].w) << 32);
#pragma unroll
                for (int hh = 0; hh < 8; ++hh) { const f32x4 w4 = *(const LAS f32x4*)(wf + hh * 1024 + 4 * lane_ + 256 * j); f[hh] += (v[j].x * w4.x + v[j].y * w4.y) + (v[j].z * w4.z + v[j].w * w4.w); } }
            float g4[4], g2v[2], z;
            { const bool up = (lane_ & 32) != 0;
#pragma unroll
              for (int i = 0; i < 4; ++i) { const float keep = up ? f[4 + i] : f[i], send = up ? f[i] : f[4 + i]; g4[i] = keep + __shfl_xor(send, 32); } }
            { const bool up = (lane_ & 16) != 0;
#pragma unroll
              for (int i = 0; i < 2; ++i) { const float keep = up ? g4[2 + i] : g4[i], send = up ? g4[i] : g4[2 + i]; g2v[i] = keep + __shfl_xor(send, 16); } }
            { const bool up = (lane_ & 8) != 0; const float keep = up ? g2v[1] : g2v[0], send = up ? g2v[0] : g2v[1]; z = keep + __shfl_xor(send, 8); }
            z += __shfl_xor(z, 1); z += __shfl_xor(z, 2); z += __shfl_xor(z, 4);
            const int myh = ((lane_ >> 5) & 1) * 4 + ((lane_ >> 4) & 1) * 2 + ((lane_ >> 3) & 1);
            z += fbv;
            const float lf = (z >= 0.f) ? -log1pf(__expf(-z)) : z - log1pf(__expf(z));
            if ((lane_ & 7) == 0) lfl[tl * 8 + myh] = lf;
        }
        __syncthreads();
        const int hh = tid_ & 7, p = tid_ >> 3;
        if (tid_ < 64) { float run = 0.f; for (int i = 0; i < 16; ++i) { run += lfl[(p * 16 + i) * 8 + hh]; lfl[(p * 16 + i) * 8 + hh] = run; } part[p * 8 + hh] = run; }
        __syncthreads();
        if (tid_ < 64) { float off = 0.f; for (int q = 0; q < p; ++q) off += part[q * 8 + hh];
            const int t0 = (blk % (SEQ / 128)) * 128 + p * 16; float* dst = cumT + ((size_t)(b * 8 + hh)) * SEQ + t0;
            for (int i = 0; i < 16; ++i) dst[i] = lfl[(p * 16 + i) * 8 + hh] + off;
            if (p == 7) segtot[blk * 8 + hh] = off + part[7 * 8 + hh]; }
        __syncthreads();
    }
}


__device__ __forceinline__ void p_cumfix(Frame& F, const Args& A) {
    PHASE_IDS();
    unsigned char* ws = A.ws; float* cumT = (float*)(ws + WS_CUM); const float* segtot = (const float*)(ws + WS_SEGTOT);
    LAS float* pre = (LAS float*)(F.lds);
    for (int blk = blockIdx.x; blk < M / 128; blk += F.G) {
        const int b = blk / (SEQ / 128), seg = blk % (SEQ / 128);
        __syncthreads();
        if (tid_ < 64) { const int hh = tid_ & 7, part = tid_ >> 3; float a = 0.f; for (int s = part; s < seg; s += 8) a += segtot[(b * 128 + s) * 8 + hh];
            a += __shfl_xor(a, 8); a += __shfl_xor(a, 16); a += __shfl_xor(a, 32); if (part == 0) pre[hh] = a; }
        __syncthreads();
        for (int i = tid_; i < 8 * 128; i += NWAVES * 64) { const int hh = i >> 7, t = i & 127; cumT[((size_t)(b * 8 + hh)) * SEQ + seg * 128 + t] += pre[hh]; }
    }
}
__device__ __forceinline__ void p_qknorm(Frame& F, const Args& A, unsigned* qkmax) {
    PHASE_IDS();
    unsigned char* ws = A.ws; const bf16* Q = (const bf16*)(ws + WS_Q); const bf16* K = (const bf16*)(ws + WS_K);
    const int gw = F.vcu * NWAVES + wave_, NGW = F.G * NWAVES, hd = lane_ >> 3;
    float mq[2] = {0.f, 0.f}, mk[2] = {0.f, 0.f};
    for (int m = gw; m < M; m += NGW) { const int b = m / SEQ;
        const v4u qw = *(const v4u*)(Q + (size_t)m * 512 + 8 * lane_), kw = *(const v4u*)(K + (size_t)m * 512 + 8 * lane_);
        float sq = 0.f, sk = 0.f;
#pragma unroll
        for (int e = 0; e < 4; ++e) { const float a = bflo(qw[e]), c = bfhi(qw[e]), d = bflo(kw[e]), f = bfhi(kw[e]); sq += a * a + c * c; sk += d * d + f * f; }
        sq += __shfl_xor(sq, 1); sq += __shfl_xor(sq, 2); sq += __shfl_xor(sq, 4); sk += __shfl_xor(sk, 1); sk += __shfl_xor(sk, 2); sk += __shfl_xor(sk, 4);
        if (b == 0) { mq[0] = fmaxf(mq[0], sq); mk[0] = fmaxf(mk[0], sk); } else { mq[1] = fmaxf(mq[1], sq); mk[1] = fmaxf(mk[1], sk); } }
    if ((lane_ & 7) == 0) {
#pragma unroll
        for (int b = 0; b < 2; ++b) { if (mq[b] > 0.f) atomicMax(qkmax + (b * 8 + hd) * 2, __float_as_uint(mq[b])); if (mk[b] > 0.f) atomicMax(qkmax + (b * 8 + hd) * 2 + 1, __float_as_uint(mk[b])); } }
}

template <int WITH_MOE>
__device__ __forceinline__ void p_final(Frame& F, const Args& A, const float* src) {
    PHASE_IDS();
    unsigned char* ws = A.ws; const float* fg = A.in[29]; const float* mod = (const float*)(ws + WS_MOD);
    const int* route = (const int*)(ws + WS_ROUTE); const bf16* Y = (const bf16*)(ws + WS_YM);
    f32x4 fgv[4];
#pragma unroll
    for (int j = 0; j < 4; ++j) fgv[j] = *(const f32x4*)(fg + 4 * lane_ + 256 * j);
    const int gw = F.vcu * NWAVES + wave_, NGW = F.G * NWAVES;
    for (int m = gw; m < M; m += NGW) {
        f32x4 v[4]; float s = 0.f;
        if (WITH_MOE) { const GAS unsigned long long* xb = (const GAS unsigned long long*)((const bf16*)(ws + WS_X1) + (size_t)m * D) + lane_;
#pragma unroll
            for (int j = 0; j < 4; ++j) { const unsigned long long a = xb[64 * j]; const unsigned al = (unsigned)a, ah = (unsigned)(a >> 32); v[j] = (f32x4){bflo(al), bfhi(al), bflo(ah), bfhi(ah)}; } }
        else { const GAS f32x4* xr = (const GAS f32x4*)(src + (size_t)m * D) + lane_;
#pragma unroll
            for (int j = 0; j < 4; ++j) v[j] = xr[64 * j]; }
        if (WITH_MOE) {
            const int b = m / SEQ; const int* rt_ = route + (size_t)m * 8;
            const float w0 = __int_as_float(rt_[2]), w1 = __int_as_float(rt_[3]); const int s0 = rt_[6], s1 = rt_[7];
            const GAS unsigned* y0 = (const GAS unsigned*)((const unsigned char*)Y + (size_t)s0 * D) + lane_; const GAS unsigned* y1 = (const GAS unsigned*)((const unsigned char*)Y + (size_t)s1 * D) + lane_;
#pragma unroll
            for (int j = 0; j < 4; ++j) { const int a = (int)y0[64 * j], c = (int)y1[64 * j]; const f32x4 g2 = *(const f32x4*)(mod + b * 6144 + 5120 + 4 * lane_ + 256 * j);
                f32x4 y; y.x = w0 * __builtin_amdgcn_cvt_f32_fp8(a, 0) + w1 * __builtin_amdgcn_cvt_f32_fp8(c, 0); y.y = w0 * __builtin_amdgcn_cvt_f32_fp8(a, 1) + w1 * __builtin_amdgcn_cvt_f32_fp8(c, 1);
                y.z = w0 * __builtin_amdgcn_cvt_f32_fp8(a, 2) + w1 * __builtin_amdgcn_cvt_f32_fp8(c, 2); y.w = w0 * __builtin_amdgcn_cvt_f32_fp8(a, 3) + w1 * __builtin_amdgcn_cvt_f32_fp8(c, 3);
                v[j] = v[j] + g2 * y; }
        }
#pragma unroll
        for (int j = 0; j < 4; ++j) s += (v[j].x * v[j].x + v[j].y * v[j].y) + (v[j].z * v[j].z + v[j].w * v[j].w);
        float rstd = 1.0f / sqrtf(wave_sum(s) * (1.f / D) + 1e-6f);
        if (WITH_MOE == 2) { if (((const unsigned*)(ws + WS_CTL))[CW_DIAG]) rstd = 0.f; }
        GAS f32x4* o = (GAS f32x4*)(A.out + (size_t)m * D) + lane_;
#pragma unroll
        for (int j = 0; j < 4; ++j) o[64 * j] = v[j] * rstd * fgv[j];
    }
}

typedef float f32x16 __attribute__((ext_vector_type(16)));
typedef unsigned u32x2 __attribute__((ext_vector_type(2)));
__device__ __forceinline__ f32x4 shift4(const bf16* p, bool has_prev, const float* mu) {
    const u32x2 c = *(const u32x2*)p; u32x2 q = *(const u32x2*)(has_prev ? p - SHW : p); if (!has_prev) q = (u32x2){0u, 0u};
    const f32x4 m = *(const f32x4*)mu;
    f32x4 cv = {bflo(c.x), bfhi(c.x), bflo(c.y), bfhi(c.y)}, pv = {bflo(q.x), bfhi(q.x), bflo(q.y), bfhi(q.y)};
    return cv + (pv - cv) * m;
}
__device__ __forceinline__ u32x2 pack4(f32x4 v) { u32x2 r; r.x = pk2(v.x, v.y); r.y = pk2(v.z, v.w); return r; }

__device__ __forceinline__ float fsig(float x) { return __builtin_amdgcn_rcpf(1.0f + __builtin_amdgcn_exp2f(-1.4426950408889634f * x)); }
__device__ __forceinline__ float ftanh(float x) { const float xc = fminf(fmaxf(x, -15.f), 15.f); return 1.0f - 2.0f * __builtin_amdgcn_rcpf(1.0f + __builtin_amdgcn_exp2f(2.8853900817779268f * xc)); }
__device__ __forceinline__ float half_sum32(float v) { v = row_sum16(v); v += __shfl_xor(v, 16); return v; }
__device__ __forceinline__ void shift2(const bf16* p, bool has_prev, const float (&mu)[2], float (&o)[2]) {
    const unsigned c = *(const unsigned*)p; unsigned q = *(const unsigned*)(has_prev ? p - SHW : p); if (!has_prev) q = 0u;
    const float c0 = bflo(c), c1 = bfhi(c); o[0] = c0 + (bflo(q) - c0) * mu[0]; o[1] = c1 + (bfhi(q) - c1) * mu[1];
}
template <int VAR> __device__ __forceinline__ void rwkv_pre(Frame& F, const Args& A, int ci_lo, int ci_hi) {
    PHASE_IDS();
    unsigned char* ws = A.ws;
    const bf16* PRW = (const bf16*)(ws + WS_PRW);
    const float* mu = A.in[7]; const float* w0 = A.in[8]; const float* a0 = A.in[10]; const float* k_k = A.in[13]; const float* k_a = A.in[14]; const float* r_k = A.in[15];
    const bf16* LW2 = (const bf16*)(ws + WS_LW2); const bf16* LA2 = (const bf16*)(ws + WS_LA2); const bf16* LG2 = (const bf16*)(ws + WS_LG2);
    float* LW = (float*)A.out; bf16* R = (bf16*)((unsigned char*)A.out + 64 * MiB); bf16* KP = (bf16*)((unsigned char*)A.out + 96 * MiB);
    bf16* VV = (bf16*)(ws + WS_XN); bf16* AV = (bf16*)(ws + WS_XN + 32 * MiB); bf16* BV = (bf16*)(ws + WS_F); bf16* GG = (bf16*)(ws + WS_F + 32 * MiB);
    float* BON = (float*)(ws + WS_BON);
    LAS bf16* Xw = (LAS bf16*)(F.lds); LAS bf16* Xa = (LAS bf16*)(F.lds + 9216); LAS bf16* Xg = (LAS bf16*)(F.lds + 18432);
    const int h = wave_;
    for (int ci = ci_lo; ci < ci_hi; ci += F.G) {
        __syncthreads();
        {
            int tl_ = threadIdx.x; asm volatile("" : "+v"(tl_));
            const int row = tl_ >> 3, cg = tl_ & 7; const size_t tok = (size_t)ci * 64 + row; const bool hp = (tok % SEQ) != 0;
            const bf16* src = PRW + tok * SHW + 1536 + 32 * cg; const float* mup = mu + 1536 + 32 * cg;
            LAS bf16* dst = (cg < 2) ? (Xw + row * 72 + 32 * cg) : (cg < 4) ? (Xa + row * 72 + 32 * (cg - 2)) : (Xg + row * 136 + 32 * (cg - 4));
#pragma unroll
            for (int q = 0; q < 8; ++q) { f32x4 v = shift4(src + 4 * q, hp, mup + 4 * q);
                if (cg < 2) { v.x = ftanh(v.x); v.y = ftanh(v.y); v.z = ftanh(v.z); v.w = ftanh(v.w); }
                else if (cg >= 4) { v.x = fsig(v.x); v.y = fsig(v.y); v.z = fsig(v.z); v.w = fsig(v.w); }
                *(LAS u32x2*)(dst + 4 * q) = pack4(v); }
        }
        __syncthreads();
        int ln_ = threadIdx.x & 63; asm volatile("" : "+v"(ln_));
        const int c = ln_ & 31, hh = ln_ >> 5, colb = 64 * h + 2 * c;
    float mur[2], muk[2], muv[2], kkc[2], kac[2], rkc[2], a0c[2], w0c[2];
#pragma unroll
    for (int e = 0; e < 2; ++e) { mur[e] = mu[colb + e]; muk[e] = mu[512 + colb + e]; muv[e] = mu[1024 + colb + e]; kkc[e] = k_k[colb + e]; kac[e] = k_a[colb + e]; rkc[e] = r_k[colb + e]; a0c[e] = a0[colb + e]; w0c[e] = w0[colb + e]; }
#pragma unroll 1
        for (int tb = 0; tb < ((VAR == 3) ? 0 : 2); ++tb) {
            f32x16 aa[2], aw[2], ag[2];
            aa[0] = f32x16{}; aa[1] = f32x16{}; aw[0] = f32x16{}; aw[1] = f32x16{}; ag[0] = f32x16{}; ag[1] = f32x16{};
            if (VAR != 4) {
#pragma unroll
            for (int ks = 0; ks < 4; ++ks) { const bf16x8 afr = *(const LAS bf16x8*)(Xa + (32 * tb + c) * 72 + 16 * ks + 8 * hh), wfr = *(const LAS bf16x8*)(Xw + (32 * tb + c) * 72 + 16 * ks + 8 * hh);
#pragma unroll
                for (int jb = 0; jb < 2; ++jb) { const bf16x8 b1 = *(const bf16x8*)(LA2 + (size_t)(colb + jb) * 64 + 16 * ks + 8 * hh), b2 = *(const bf16x8*)(LW2 + (size_t)(colb + jb) * 64 + 16 * ks + 8 * hh);
                    aa[jb] = __builtin_amdgcn_mfma_f32_32x32x16_bf16(afr, b1, aa[jb], 0, 0, 0); aw[jb] = __builtin_amdgcn_mfma_f32_32x32x16_bf16(wfr, b2, aw[jb], 0, 0, 0); } }
#pragma unroll
            for (int ks = 0; ks < 8; ++ks) { const bf16x8 gfr = *(const LAS bf16x8*)(Xg + (32 * tb + c) * 136 + 16 * ks + 8 * hh);
#pragma unroll
                for (int jb = 0; jb < 2; ++jb) { const bf16x8 b3 = *(const bf16x8*)(LG2 + (size_t)(colb + jb) * 128 + 16 * ks + 8 * hh); ag[jb] = __builtin_amdgcn_mfma_f32_32x32x16_bf16(gfr, b3, ag[jb], 0, 0, 0); } }
            }
            unsigned gpk[16], apk[16];
#pragma unroll
            for (int reg = 0; reg < 16; ++reg) { gpk[reg] = pk2(ag[0][reg], ag[1][reg]); apk[reg] = pk2(fsig(a0c[0] + aa[0][reg]), fsig(a0c[1] + aa[1][reg])); }
            unsigned rawc[16][3], rawq[4][3];
#pragma unroll
            for (int reg = 0; reg < 16; ++reg) { const int t = 32 * tb + (reg & 3) + 8 * (reg >> 2) + 4 * hh; const size_t tok = (size_t)ci * 64 + t; const bool hp = (tok % SEQ) != 0;
                const bf16* prow = PRW + tok * SHW + colb; const bf16* pprev = hp ? prow - SHW : prow;
#pragma unroll
                for (int x = 0; x < 3; ++x) { if (VAR == 2) { rawc[reg][x] = 0x3f803f80u + reg; if ((reg & 3) == 0) rawq[reg >> 2][x] = 0x3f803f80u; } else { rawc[reg][x] = *(const unsigned*)(prow + 512 * x); if ((reg & 3) == 0) { const unsigned q = *(const unsigned*)(pprev + 512 * x); rawq[reg >> 2][x] = hp ? q : 0u; } } } }
#pragma unroll
            for (int reg = 0; reg < 16; ++reg) {
                const int t = 32 * tb + (reg & 3) + 8 * (reg >> 2) + 4 * hh; const size_t tok = (size_t)ci * 64 + t;
                unsigned rawp_[3];
#pragma unroll
                for (int x = 0; x < 3; ++x) rawp_[x] = ((reg & 3) == 0) ? rawq[reg >> 2][x] : rawc[(reg + 15) & 15][x];
                float kx[2], rx[2], vx[2];
                { const unsigned cc_ = rawc[reg][0], pp_ = rawp_[0]; const float c0 = bflo(cc_), c1 = bfhi(cc_); rx[0] = c0 + (bflo(pp_) - c0) * mur[0]; rx[1] = c1 + (bfhi(pp_) - c1) * mur[1]; }
                { const unsigned cc_ = rawc[reg][1], pp_ = rawp_[1]; const float c0 = bflo(cc_), c1 = bfhi(cc_); kx[0] = c0 + (bflo(pp_) - c0) * muk[0]; kx[1] = c1 + (bfhi(pp_) - c1) * muk[1]; }
                { const unsigned cc_ = rawc[reg][2], pp_ = rawp_[2]; const float c0 = bflo(cc_), c1 = bfhi(cc_); vx[0] = c0 + (bflo(pp_) - c0) * muv[0]; vx[1] = c1 + (bfhi(pp_) - c1) * muv[1]; }
                const float as0 = bflo(apk[reg]), as1 = bfhi(apk[reg]);
                const float kr0 = kx[0] * kkc[0], kr1 = kx[1] * kkc[1];
                const float ss = half_sum32(kr0 * kr0 + kr1 * kr1); const float inv = __builtin_amdgcn_rsqf(fmaxf(ss, 1e-24f));
                const float kk0 = kr0 * inv, kk1 = kr1 * inv, kp0 = kx[0] * (1.0f + (as0 - 1.0f) * kac[0]), kp1 = kx[1] * (1.0f + (as1 - 1.0f) * kac[1]);
                const float bon = half_sum32(rx[0] * kp0 * rkc[0] + rx[1] * kp1 * rkc[1]);
                float o2[2];
#pragma unroll
                for (int e = 0; e < 2; ++e) { const float z = -(w0c[e] + aw[e][reg]);
                    const float sp = fmaxf(z, 0.f) + 0.6931471805599453f * __builtin_amdgcn_logf(1.0f + __builtin_amdgcn_exp2f(-1.4426950408889634f * fabsf(z))); o2[e] = -__builtin_amdgcn_exp2f(-1.4426950408889634f * (sp + 0.5f)); }
                const unsigned ob = (unsigned)tok * 1024u + (unsigned)colb * 2u;
                if (VAR == 0) {
                *(unsigned*)((unsigned char*)R + ob) = pk2(rx[0], rx[1]); *(unsigned*)((unsigned char*)KP + ob) = pk2(kp0, kp1); *(unsigned*)((unsigned char*)VV + ob) = pk2(vx[0], vx[1]);
                *(unsigned*)((unsigned char*)AV + ob) = pk2(-kk0, -kk1); *(unsigned*)((unsigned char*)BV + ob) = pk2(kk0 * as0, kk1 * as1);
                *(float2*)((unsigned char*)LW + 2u * ob) = make_float2(o2[0], o2[1]); *(unsigned*)((unsigned char*)GG + ob) = gpk[reg];
                if (c == 0) BON[tok * 8 + h] = bon;
                } else { asm volatile("" :: "v"(pk2(rx[0], rx[1])), "v"(pk2(kp0, kp1)), "v"(pk2(vx[0], vx[1])), "v"(pk2(-kk0, -kk1)), "v"(pk2(kk0 * as0, kk1 * as1)), "v"(o2[0]), "v"(o2[1]), "v"(gpk[reg]), "v"(bon), "v"(ob)); }
                if ((reg & 3) == 3) __builtin_amdgcn_sched_barrier(0);
            }
        }
    }
}

__device__ __forceinline__ void rwkv_scan_seq(Frame& F, const Args& A) {
    PHASE_IDS();
    if (blockIdx.x >= BATCH * 8) return;
    unsigned char* ws = A.ws;
    const float* LW = (const float*)A.out; const bf16* R = (const bf16*)((unsigned char*)A.out + 64 * MiB); const bf16* KP = (const bf16*)((unsigned char*)A.out + 96 * MiB);
    const bf16* VV = (const bf16*)(ws + WS_XN); const bf16* AV = (const bf16*)(ws + WS_XN + 32 * MiB); const bf16* BV = (const bf16*)(ws + WS_F);
    float* Y = (float*)(ws + WS_Y);
    const int b = blockIdx.x >> 3, h = blockIdx.x & 7;
    constexpr int STEPB = 896, CH = 16, BUFB = STEPB * CH;
    LAS unsigned char* buf = F.lds;
    const size_t tok0 = (size_t)b * SEQ;
    const bool loader = wave_ >= 4; const int lt = tid_ - 256;
    auto load_chunk = [&](int cidx, int slot) {
        for (int p = lt; p < CH * 56; p += 256) { const int s = p / 56, q = p % 56; const size_t tok = tok0 + (size_t)cidx * CH + s; v4u val;
            if (q < 16) val = *(const v4u*)(LW + tok * 512 + 64 * h + 4 * q);
            else { const int a = (q - 16) >> 3, o8 = (q - 16) & 7; const bf16* src = (a == 0) ? AV : (a == 1) ? BV : (a == 2) ? KP : (a == 3) ? R : VV; val = *(const v4u*)(src + tok * 512 + 64 * h + 8 * o8); }
            *(LAS v4u*)(buf + slot * BUFB + s * STEPB + q * 16) = val; }
    };
    if (loader) load_chunk(0, 0);
    __syncthreads();
    float S[16];
#pragma unroll
    for (int j = 0; j < 16; ++j) S[j] = 0.f;
    const int il = lane_ & 15, jq = lane_ >> 4, irow = 16 * wave_ + il;
    for (int cidx = 0; cidx < SEQ / CH; ++cidx) {
        if (loader) { if (cidx + 1 < SEQ / CH) load_chunk(cidx + 1, (cidx + 1) & 1); }
        else {
            const LAS unsigned char* bb = buf + (cidx & 1) * BUFB;
#pragma unroll 4
            for (int s = 0; s < CH; ++s) { const LAS unsigned char* sp = bb + s * STEPB;
                float w[16], av[16], bv[16], kv[16], rv[16];
#pragma unroll
                for (int q = 0; q < 4; ++q) { const f32x4 l4 = *(const LAS f32x4*)(sp + 64 * jq + 16 * q); w[4 * q] = __expf(l4.x); w[4 * q + 1] = __expf(l4.y); w[4 * q + 2] = __expf(l4.z); w[4 * q + 3] = __expf(l4.w); }
#pragma unroll
                for (int q = 0; q < 2; ++q) { const v4u a4 = *(const LAS v4u*)(sp + 256 + 32 * jq + 16 * q), b4 = *(const LAS v4u*)(sp + 384 + 32 * jq + 16 * q), k4 = *(const LAS v4u*)(sp + 512 + 32 * jq + 16 * q), r4 = *(const LAS v4u*)(sp + 640 + 32 * jq + 16 * q);
#pragma unroll
                    for (int e = 0; e < 4; ++e) { av[8 * q + 2 * e] = bflo(a4[e]); av[8 * q + 2 * e + 1] = bfhi(a4[e]); bv[8 * q + 2 * e] = bflo(b4[e]); bv[8 * q + 2 * e + 1] = bfhi(b4[e]);
                        kv[8 * q + 2 * e] = bflo(k4[e]); kv[8 * q + 2 * e + 1] = bfhi(k4[e]); rv[8 * q + 2 * e] = bflo(r4[e]); rv[8 * q + 2 * e + 1] = bfhi(r4[e]); } }
                const unsigned short vraw = *(const LAS unsigned short*)(sp + 768 + 2 * irow); const float vi = __uint_as_float((unsigned)vraw << 16);
                float sa = 0.f;
#pragma unroll
                for (int j = 0; j < 16; ++j) sa += S[j] * av[j];
                sa += __shfl_xor(sa, 16); sa += __shfl_xor(sa, 32);
                float y = 0.f;
#pragma unroll
                for (int j = 0; j < 16; ++j) { S[j] = S[j] * w[j] + sa * bv[j] + vi * kv[j]; y += S[j] * rv[j]; }
                y += __shfl_xor(y, 16); y += __shfl_xor(y, 32);
                if (jq == 0) Y[(tok0 + (size_t)cidx * CH + s) * 512 + 64 * h + irow] = y;
            }
        }
        __syncthreads();
    }
}

__device__ __forceinline__ void rwkv_post(Frame& F, const Args& A) {
    PHASE_IDS();
    unsigned char* ws = A.ws;
    const float* Y = (const float*)(ws + WS_Y); const bf16* VV = (const bf16*)(ws + WS_XN); const bf16* GG = (const bf16*)(ws + WS_F + 32 * MiB); const float* BON = (const float*)(ws + WS_BON);
    bf16* O = (bf16*)(ws + WS_F);
    const float* lg = A.in[16]; const float* lb = A.in[17];
    const int gw = F.vcu * NWAVES + wave_, NGW = F.G * NWAVES, col = 8 * lane_, hd = lane_ >> 3;
    const f32x4 g0 = *(const f32x4*)(lg + col), g1 = *(const f32x4*)(lg + col + 4), b0 = *(const f32x4*)(lb + col), b1 = *(const f32x4*)(lb + col + 4);
    for (int m = gw; m < M; m += NGW) {
        const f32x4 y0 = *(const f32x4*)(Y + (size_t)m * 512 + col), y1 = *(const f32x4*)(Y + (size_t)m * 512 + col + 4);
        float s = (y0.x + y0.y) + (y0.z + y0.w) + (y1.x + y1.y) + (y1.z + y1.w);
        s += __shfl_xor(s, 1); s += __shfl_xor(s, 2); s += __shfl_xor(s, 4);
        const float mean = s * (1.f / 64.f); const f32x4 d0 = y0 - mean, d1 = y1 - mean;
        float q = (d0.x * d0.x + d0.y * d0.y) + (d0.z * d0.z + d0.w * d0.w) + (d1.x * d1.x + d1.y * d1.y) + (d1.z * d1.z + d1.w * d1.w);
        q += __shfl_xor(q, 1); q += __shfl_xor(q, 2); q += __shfl_xor(q, 4);
        const float rstd = 1.0f / sqrtf(q * (1.f / 64.f) + 64e-5f);
        const float bon = BON[(size_t)m * 8 + hd];
        const v4u vw = *(const v4u*)(VV + (size_t)m * 512 + col), gw4 = *(const v4u*)(GG + (size_t)m * 512 + col);
        f32x4 o0 = (d0 * rstd * g0 + b0), o1 = (d1 * rstd * g1 + b1);
        o0.x = (o0.x + bon * bflo(vw.x)) * bflo(gw4.x); o0.y = (o0.y + bon * bfhi(vw.x)) * bfhi(gw4.x); o0.z = (o0.z + bon * bflo(vw.y)) * bflo(gw4.y); o0.w = (o0.w + bon * bfhi(vw.y)) * bfhi(gw4.y);
        o1.x = (o1.x + bon * bflo(vw.z)) * bflo(gw4.z); o1.y = (o1.y + bon * bfhi(vw.z)) * bfhi(gw4.z); o1.z = (o1.z + bon * bflo(vw.w)) * bflo(gw4.w); o1.w = (o1.w + bon * bfhi(vw.w)) * bfhi(gw4.w);
        v4u ow; ow.x = pk2(o0.x, o0.y); ow.y = pk2(o0.z, o0.w); ow.z = pk2(o1.x, o1.y); ow.w = pk2(o1.z, o1.w);
        *(v4u*)(O + (size_t)m * 512 + col) = ow;
    }
}

__device__ __forceinline__ size_t pq_off(int it) { const int ch = it >> 8, cc = it & 255; return WS_PRW + ((size_t)(ch >> 3) * SEQ + (size_t)cc * 64) * (SHW * 2) + (size_t)(ch & 7) * 24576; }
__device__ __forceinline__ size_t y0_off(int it, int idx) { const int ch = it >> 8, cc = it & 255; return (((size_t)(ch >> 3) * SEQ + (size_t)cc * 64 + (idx >> 4)) * 512 + 64 * (ch & 7)) * 4 + (size_t)(idx & 15) * 16; }
constexpr size_t ST_OFF = 64 * MiB;
constexpr int CH_ITEMS = BATCH * 8 * (SEQ / 64);

__device__ __forceinline__ int sw16(int row, int chunk) { return row * 128 + ((chunk ^ (row & 7)) << 4); }
typedef float f32x4c __attribute__((ext_vector_type(4)));
__device__ __forceinline__ bf16x8 ld_frag(const LAS unsigned char* Mx, int row, int chunk) { return *(const LAS bf16x8*)(Mx + sw16(row, chunk)); }
template <bool SWAP>
__device__ __forceinline__ void mm_tile(const LAS unsigned char* Am, const LAS unsigned char* Bm, int r0, int c0, int l15, int kg, f32x4c (&acc)[2]) {
    bf16x8 a[2], b[2][2];
#pragma unroll
    for (int ks = 0; ks < 2; ++ks) { a[ks] = ld_frag(Am, r0 + l15, 4 * ks + kg);
#pragma unroll
        for (int n = 0; n < 2; ++n) b[ks][n] = ld_frag(Bm, c0 + 16 * n + l15, 4 * ks + kg); }
#pragma unroll
    for (int ks = 0; ks < 2; ++ks)
#pragma unroll
        for (int n = 0; n < 2; ++n)
            acc[n] = SWAP ? __builtin_amdgcn_mfma_f32_16x16x32_bf16(b[ks][n], a[ks], acc[n], 0, 0, 0) : __builtin_amdgcn_mfma_f32_16x16x32_bf16(a[ks], b[ks][n], acc[n], 0, 0, 0);
}
__device__ __forceinline__ unsigned long long pack4u(f32x4c v) { return (unsigned long long)pk2(v[0], v[1]) | ((unsigned long long)pk2(v[2], v[3]) << 32); }
__device__ __forceinline__ void st_nat(LAS unsigned char* O, int r0, int c0, int l15, int kg, const f32x4c (&acc)[2]) {
#pragma unroll
    for (int n = 0; n < 2; ++n) { const int row = r0 + l15, col = c0 + 16 * n + 4 * kg; *(LAS unsigned long long*)(O + sw16(row, col >> 3) + (col & 4) * 2) = pack4u(acc[n]); }
}
__device__ __forceinline__ void st_tr(LAS unsigned char* OT, int r0, int c0, int l15, int kg, const f32x4c (&acc)[2]) {
#pragma unroll
    for (int n = 0; n < 2; ++n)
#pragma unroll
        for (int e = 0; e < 4; ++e) { const int row = r0 + l15, col = c0 + 16 * n + 4 * kg + e; *(LAS unsigned short*)(OT + sw16(col, row >> 3) + (row & 7) * 2) = (unsigned short)f2bf(acc[n][e]); }
}
__device__ __forceinline__ f32x4c ld_nat4(const LAS unsigned char* O, int row, int col) { const unsigned long long w = *(const LAS unsigned long long*)(O + sw16(row, col >> 3) + (col & 4) * 2);
    const unsigned lo = (unsigned)w, hi = (unsigned)(w >> 32); return (f32x4c){bflo(lo), bfhi(lo), bflo(hi), bfhi(hi)}; }

template <int VAR> __device__ __forceinline__ void rwkv_r1(Frame& F, const Args& A, int it_lo, int it_hi, int it_step) {
    PHASE_IDS();
    unsigned char* ws = A.ws;
    const float* LW = (const float*)A.out; const bf16* R = (const bf16*)((unsigned char*)A.out + 64 * MiB); const bf16* KP = (const bf16*)((unsigned char*)A.out + 96 * MiB);
    const bf16* VV = (const bf16*)(ws + WS_XN); const bf16* AV = (const bf16*)(ws + WS_XN + 32 * MiB); const bf16* BV = (const bf16*)(ws + WS_F);
    LAS unsigned char* L = F.lds;
#define MB(i) (L + (i) * 8192)
    LAS float* gCs = (LAS float*)(L + 17 * 8192); LAS float* part = gCs + 64;
    const int w = wave_, j = lane_, l15 = lane_ & 15, kg = lane_ >> 4, r0 = 16 * (w >> 1), c0 = 32 * (w & 1);
#define R1_BAR() asm volatile("s_waitcnt lgkmcnt(0)\n\ts_barrier" ::: "memory")
    float nlw[8]; unsigned short nav[8], nbv[8], nkv[8], nrv[8], nvv[8];
#define R1_LOAD(itx) do { const int ch_ = (itx) >> 8, cc_ = (itx) & 255; const size_t tb_ = (size_t)(ch_ >> 3) * SEQ + (size_t)cc_ * 64 + 8 * w; const int cg_ = 64 * (ch_ & 7) + j; \
        _Pragma("unroll") for (int t = 0; t < 8; ++t) { const size_t o = (tb_ + t) * 512 + cg_; nlw[t] = LW[o]; nav[t] = AV[o]; nbv[t] = BV[o]; nkv[t] = KP[o]; nrv[t] = R[o]; nvv[t] = VV[o]; } } while (0)
    if (it_lo < it_hi) R1_LOAD(it_lo);
    for (int it = it_lo; it < it_hi; it += it_step) {
        R1_BAR();
        {
            float g[8], lw[8], av[8], bv[8], kv[8], rv[8]; unsigned short vraw[8]; float run = 0.f;
#pragma unroll
            for (int t = 0; t < 8; ++t) { lw[t] = nlw[t]; av[t] = __uint_as_float((unsigned)nav[t] << 16); bv[t] = __uint_as_float((unsigned)nbv[t] << 16);
                kv[t] = __uint_as_float((unsigned)nkv[t] << 16); rv[t] = __uint_as_float((unsigned)nrv[t] << 16); vraw[t] = nvv[t]; run += lw[t]; g[t] = run; }
            if (it + it_step < it_hi) R1_LOAD(it + it_step);
            part[w * 64 + j] = run;
            R1_BAR();
            float pre = 0.f, tot = 0.f;
#pragma unroll
            for (int q = 0; q < 8; ++q) { const float p = part[q * 64 + j]; tot += p; if (q < w) pre += p; }
            if (w == 0) gCs[j] = __expf(tot);
            unsigned short atT[8], bhT[8], khT[8];
#pragma unroll
            for (int t = 0; t < 8; ++t) { const float G = pre + g[t]; const float eg = __expf(G), en = __expf(-G), ea = __expf(G - lw[t]), ec = __expf(tot - G);
                const int row = 8 * w + t; const int off = sw16(row, j >> 3) + (j & 7) * 2;
                const unsigned short at = (unsigned short)f2bf(av[t] * ea);
                *(LAS unsigned short*)(MB(0) + off) = at; atT[t] = at;
                *(LAS unsigned short*)(MB(2) + off) = (unsigned short)f2bf(bv[t] * en);
                *(LAS unsigned short*)(MB(3) + off) = (unsigned short)f2bf(kv[t] * en);
                *(LAS unsigned short*)(MB(4) + off) = (unsigned short)f2bf(rv[t] * eg);
                bhT[t] = (unsigned short)f2bf(bv[t] * ec); khT[t] = (unsigned short)f2bf(kv[t] * ec); }
            v4u x;
            x.x = atT[0] | ((unsigned)atT[1] << 16); x.y = atT[2] | ((unsigned)atT[3] << 16); x.z = atT[4] | ((unsigned)atT[5] << 16); x.w = atT[6] | ((unsigned)atT[7] << 16); *(LAS v4u*)(MB(1) + sw16(j, w)) = x;
            x.x = bhT[0] | ((unsigned)bhT[1] << 16); x.y = bhT[2] | ((unsigned)bhT[3] << 16); x.z = bhT[4] | ((unsigned)bhT[5] << 16); x.w = bhT[6] | ((unsigned)bhT[7] << 16); *(LAS v4u*)(MB(5) + sw16(j, w)) = x;
            x.x = khT[0] | ((unsigned)khT[1] << 16); x.y = khT[2] | ((unsigned)khT[3] << 16); x.z = khT[4] | ((unsigned)khT[5] << 16); x.w = khT[6] | ((unsigned)khT[7] << 16); *(LAS v4u*)(MB(6) + sw16(j, w)) = x;
            x.x = vraw[0] | ((unsigned)vraw[1] << 16); x.y = vraw[2] | ((unsigned)vraw[3] << 16); x.z = vraw[4] | ((unsigned)vraw[5] << 16); x.w = vraw[6] | ((unsigned)vraw[7] << 16); *(LAS v4u*)(MB(7) + sw16(j, w)) = x;
        }
        R1_BAR();
        if (VAR == 1) continue;
        f32x4c acc[2];
        const int trow = r0 + l15;
        {
            acc[0] = f32x4c{}; acc[1] = f32x4c{}; mm_tile<true>(MB(0), MB(2), r0, c0, l15, kg, acc);
#pragma unroll
            for (int n = 0; n < 2; ++n)
#pragma unroll
                for (int e = 0; e < 4; ++e) { const int s = c0 + 16 * n + 4 * kg + e; if (s >= trow) acc[n][e] = 0.f; }
            st_nat(MB(8), r0, c0, l15, kg, acc); st_tr(MB(9), r0, c0, l15, kg, acc);
#pragma unroll
            for (int n = 0; n < 2; ++n)
#pragma unroll
                for (int e = 0; e < 4; ++e) { const int s = c0 + 16 * n + 4 * kg + e; if (s == trow) acc[n][e] = 1.f; }
            st_nat(MB(15), r0, c0, l15, kg, acc);
            acc[0] = f32x4c{}; acc[1] = f32x4c{}; mm_tile<true>(MB(0), MB(3), r0, c0, l15, kg, acc);
#pragma unroll
            for (int n = 0; n < 2; ++n)
#pragma unroll
                for (int e = 0; e < 4; ++e) { const int s = c0 + 16 * n + 4 * kg + e; if (s >= trow) acc[n][e] = 0.f; }
            st_nat(MB(10), r0, c0, l15, kg, acc);
            acc[0] = f32x4c{}; acc[1] = f32x4c{}; mm_tile<true>(MB(4), MB(2), r0, c0, l15, kg, acc);
#pragma unroll
            for (int n = 0; n < 2; ++n)
#pragma unroll
                for (int e = 0; e < 4; ++e) { const int s = c0 + 16 * n + 4 * kg + e; if (s > trow) acc[n][e] = 0.f; }
            st_nat(MB(11), r0, c0, l15, kg, acc);
            acc[0] = f32x4c{}; acc[1] = f32x4c{}; mm_tile<true>(MB(4), MB(3), r0, c0, l15, kg, acc);
#pragma unroll
            for (int n = 0; n < 2; ++n)
#pragma unroll
                for (int e = 0; e < 4; ++e) { const int s = c0 + 16 * n + 4 * kg + e; if (s > trow) acc[n][e] = 0.f; }
            st_nat(MB(12), r0, c0, l15, kg, acc);
        }
        R1_BAR();
        if (VAR == 2) continue;
        acc[0] = f32x4c{}; acc[1] = f32x4c{}; mm_tile<true>(MB(8), MB(9), r0, c0, l15, kg, acc); st_nat(MB(13), r0, c0, l15, kg, acc); st_tr(MB(14), r0, c0, l15, kg, acc);
        acc[0] = f32x4c{}; acc[1] = f32x4c{}; mm_tile<true>(MB(7), MB(10), r0, c0, l15, kg, acc); st_nat(MB(3), r0, c0, l15, kg, acc);
        R1_BAR();
#define SQUARE(xi, xti, xo, xto) do { acc[0] = f32x4c{}; acc[1] = f32x4c{}; mm_tile<true>(MB(xi), MB(xti), r0, c0, l15, kg, acc); st_nat(MB(xo), r0, c0, l15, kg, acc); st_tr(MB(xto), r0, c0, l15, kg, acc); } while (0)
#define MUPD(mi, xti, mo) do { acc[0] = ld_nat4(MB(mi), trow, c0 + 4 * kg); acc[1] = ld_nat4(MB(mi), trow, c0 + 16 + 4 * kg); mm_tile<true>(MB(mi), MB(xti), r0, c0, l15, kg, acc); st_nat(MB(mo), r0, c0, l15, kg, acc); } while (0)
        SQUARE(13, 14, 0, 2); MUPD(15, 14, 16); R1_BAR();
        SQUARE(0, 2, 13, 14); MUPD(16, 2, 15); R1_BAR();
        SQUARE(13, 14, 0, 2); MUPD(15, 14, 16); R1_BAR();
        SQUARE(0, 2, 13, 14); MUPD(16, 2, 15); R1_BAR();
        MUPD(15, 14, 16); R1_BAR();
        acc[0] = f32x4c{}; acc[1] = f32x4c{}; mm_tile<true>(MB(1), MB(16), r0, c0, l15, kg, acc); st_nat(MB(13), r0, c0, l15, kg, acc);
        acc[0] = f32x4c{}; acc[1] = f32x4c{}; mm_tile<true>(MB(3), MB(16), r0, c0, l15, kg, acc); st_nat(MB(14), r0, c0, l15, kg, acc);
        R1_BAR();
        if (VAR == 3) continue;
        unsigned char* og = ws + pq_off(it); unsigned char* oy = (unsigned char*)A.out + y0_off(it, w * 64 + lane_);
        {
            acc[0] = f32x4c{}; acc[1] = f32x4c{}; mm_tile<true>(MB(5), MB(13), r0, c0, l15, kg, acc);
            const float gc = gCs[trow];
#pragma unroll
            for (int n = 0; n < 2; ++n) { const int col = c0 + 16 * n + 4 * kg;
#pragma unroll
                for (int e = 0; e < 4; ++e) if (col + e == trow) acc[n][e] += gc;
                const size_t po_ = (size_t)(trow * 64 + col) * 2;
                if (VAR == 0) *(unsigned long long*)(og + po_) = pack4u(acc[n]); else asm volatile("" :: "v"(pack4u(acc[n]))); }
            acc[0] = ld_nat4(MB(4), trow, c0 + 4 * kg); acc[1] = ld_nat4(MB(4), trow, c0 + 16 + 4 * kg); mm_tile<true>(MB(11), MB(13), r0, c0, l15, kg, acc);
#pragma unroll
            for (int n = 0; n < 2; ++n) { const int col = c0 + 16 * n + 4 * kg; if (VAR == 0) *(unsigned long long*)(og + 16384 + (size_t)(trow * 64 + col) * 2) = pack4u(acc[n]); else asm volatile("" :: "v"(pack4u(acc[n]))); }
            acc[0] = f32x4c{}; acc[1] = f32x4c{}; mm_tile<false>(MB(5), MB(14), r0, c0, l15, kg, acc); mm_tile<false>(MB(6), MB(7), r0, c0, l15, kg, acc);
            { v4u q; q.x = pk2(acc[0][0], acc[0][1]); q.y = pk2(acc[0][2], acc[0][3]); q.z = pk2(acc[1][0], acc[1][1]); q.w = pk2(acc[1][2], acc[1][3]); if (VAR == 0) *(v4u*)(og + 8192 + (size_t)(w * 64 + lane_) * 16) = q; else asm volatile("" :: "v"(q)); }
            acc[0] = f32x4c{}; acc[1] = f32x4c{}; mm_tile<false>(MB(11), MB(14), r0, c0, l15, kg, acc); mm_tile<false>(MB(12), MB(7), r0, c0, l15, kg, acc);
            { v4u q; q.x = pk2(acc[0][0], acc[0][1]); q.y = pk2(acc[0][2], acc[0][3]); q.z = pk2(acc[1][0], acc[1][1]); q.w = pk2(acc[1][2], acc[1][3]); if (VAR == 0) *(v4u*)oy = q; else asm volatile("" :: "v"(q)); }
        }
    }
#undef SQUARE
#undef MUPD
#undef MB
#undef R1_BAR
#undef R1_LOAD
}

template <int VAR> __device__ __forceinline__ void rwkv_r2(Frame& F, const Args& A, unsigned char* stbase) {
    PHASE_IDS();
    if (blockIdx.x >= BATCH * 8) return;
    unsigned char* ws = A.ws;
    LAS unsigned char* L = F.lds;
    const int ch = blockIdx.x, w = wave_, l15 = lane_ & 15, kg = lane_ >> 4, r0 = 16 * (w >> 1), c0 = 32 * (w & 1);
    const unsigned char* pq = ws + pq_off(ch * 256); unsigned char* st = stbase + (size_t)ch * 256 * 8192;
    for (int i = tid_; i < 2048; i += NWAVES * 64) { ((LAS unsigned*)L)[i] = 0u; }
    for (int i = tid_; i < 512; i += NWAVES * 64) ((v4u*)st)[i] = (v4u){0u, 0u, 0u, 0u};
    __syncthreads();
    constexpr int PF = 8;
    bf16x8 pa[PF][2]; v4u qf[PF];
#define R2_LOAD(slot, step) do { const unsigned char* p_ = pq + (size_t)(step) * (64 * SHW * 2); \
        pa[slot][0] = *(const bf16x8*)(p_ + (size_t)((r0 + l15) * 64 + 8 * kg) * 2); pa[slot][1] = *(const bf16x8*)(p_ + (size_t)((r0 + l15) * 64 + 32 + 8 * kg) * 2); \
        qf[slot] = *(const v4u*)(p_ + 8192 + (size_t)(w * 64 + lane_) * 16); } while (0)
#pragma unroll
    for (int s = 0; s < PF; ++s) R2_LOAD(s, s);
    for (int c = 0; c < 256; c += PF) {
#pragma unroll
        for (int s = 0; s < PF; ++s) {
            const int step = c + s; const LAS unsigned char* Sin = L + (step & 15) * 8192; LAS unsigned char* Sout = L + ((step + 1) & 15) * 8192;
            f32x4c acc[2];
            acc[0] = (f32x4c){bflo(qf[s].x), bfhi(qf[s].x), bflo(qf[s].y), bfhi(qf[s].y)}; acc[1] = (f32x4c){bflo(qf[s].z), bfhi(qf[s].z), bflo(qf[s].w), bfhi(qf[s].w)};
            bf16x8 sf[2][2];
#pragma unroll
            for (int ks = 0; ks < 2; ++ks)
#pragma unroll
                for (int n = 0; n < 2; ++n) sf[ks][n] = ld_frag(Sin, c0 + 16 * n + l15, 4 * ks + kg);
#pragma unroll
            for (int ks = 0; ks < 2; ++ks)
#pragma unroll
                for (int n = 0; n < 2; ++n) acc[n] = __builtin_amdgcn_mfma_f32_16x16x32_bf16(pa[s][ks], sf[ks][n], acc[n], 0, 0, 0);
#pragma unroll
            for (int n = 0; n < 2; ++n) { const int row = c0 + 16 * n + l15, col = r0 + 4 * kg; const unsigned long long pkd = pack4u(acc[n]);
                *(LAS unsigned long long*)(Sout + sw16(row, col >> 3) + (col & 4) * 2) = pkd;
                }
            if (VAR != 3) { if (step + PF < 256) R2_LOAD(s, step + PF); }
            if (VAR != 4) asm volatile("s_waitcnt lgkmcnt(0)\n\ts_barrier" ::: "memory");
        }
        if (VAR != 2) { const int nflush = (c + PF < 256) ? PF * 8192 : (PF - 1) * 8192; unsigned char* dst = st + (size_t)(c + 1) * 8192;
          for (int o = tid_ * 16; o < nflush; o += NWAVES * 64 * 16) { const int row_ = (o >> 7) & 63, chk_ = (o >> 4) & 7, slot_ = (c + 1 + (o >> 13)) & 15; *(v4u*)(dst + o) = *(const LAS v4u*)(L + slot_ * 8192 + sw16(row_, chk_)); } }
    }
#undef R2_LOAD
}

__device__ __forceinline__ void rwkv_r3(Frame& F, const Args& A) {
    PHASE_IDS();
    unsigned char* ws = A.ws;
    const bf16* VV = (const bf16*)(ws + WS_XN); const bf16* GG = (const bf16*)(ws + WS_F + 32 * MiB); const float* BON = (const float*)(ws + WS_BON);
    bf16* O = (bf16*)(ws + WS_F); const float* lg = A.in[16]; const float* lb = A.in[17];
    LAS float* Yt = (LAS float*)F.lds;
    const int w = wave_, l15 = lane_ & 15, kg = lane_ >> 4, r0 = 16 * (w >> 1), c0 = 32 * (w & 1);
#define R3_BAR() asm volatile("s_waitcnt lgkmcnt(0)\n\ts_barrier" ::: "memory")
    v4u nq, nvw, ngw; bf16x8 na[2], nb[2][2]; float nbon;
    const int pt_ = tid_ >> 3, pi0_ = 8 * (tid_ & 7);
#define R3_LOAD(itx) do { const int ch_ = (itx) >> 8, cc_ = (itx) & 255; const unsigned char* og_ = ws + pq_off(itx); const unsigned char* sg_ = (const unsigned char*)A.out + ST_OFF + (size_t)(itx) * 8192; \
        nq = *(const v4u*)((const unsigned char*)A.out + y0_off(itx, w * 64 + lane_)); \
        _Pragma("unroll") for (int ks = 0; ks < 2; ++ks) { na[ks] = *(const bf16x8*)(og_ + 16384 + (size_t)((r0 + l15) * 64 + 32 * ks + 8 * kg) * 2); \
            _Pragma("unroll") for (int n = 0; n < 2; ++n) nb[ks][n] = *(const bf16x8*)(sg_ + (size_t)((c0 + 16 * n + l15) * 64 + 32 * ks + 8 * kg) * 2); } \
        const size_t m_ = (size_t)(ch_ >> 3) * SEQ + (size_t)cc_ * 64 + pt_; const int col_ = 64 * (ch_ & 7) + pi0_; \
        nvw = *(const v4u*)(VV + m_ * 512 + col_); ngw = *(const v4u*)(GG + m_ * 512 + col_); nbon = BON[m_ * 8 + (ch_ & 7)]; } while (0)
    if ((int)blockIdx.x < CH_ITEMS) R3_LOAD((int)blockIdx.x);
    for (int it = blockIdx.x; it < CH_ITEMS; it += F.G) {
        const int ch = it >> 8, cc = it & 255, b = ch >> 3, h = ch & 7;
        f32x4c acc[2];
        acc[0] = (f32x4c){bflo(nq.x), bfhi(nq.x), bflo(nq.y), bfhi(nq.y)}; acc[1] = (f32x4c){bflo(nq.z), bfhi(nq.z), bflo(nq.w), bfhi(nq.w)};
#pragma unroll
        for (int ks = 0; ks < 2; ++ks)
#pragma unroll
            for (int n = 0; n < 2; ++n) acc[n] = __builtin_amdgcn_mfma_f32_16x16x32_bf16(na[ks], nb[ks][n], acc[n], 0, 0, 0);
        const v4u vw = nvw, gw4 = ngw; const float bon = nbon;
        if (it + F.G < CH_ITEMS) R3_LOAD(it + F.G);
        R3_BAR();
#pragma unroll
        for (int n = 0; n < 2; ++n)
#pragma unroll
            for (int e = 0; e < 4; ++e) Yt[(r0 + 4 * kg + e) * 68 + c0 + 16 * n + l15] = acc[n][e];
        R3_BAR();
        {   const int t = pt_, i0 = pi0_; const size_t m = (size_t)b * SEQ + (size_t)cc * 64 + t; const int col = 64 * h + i0;
            const f32x4 y0 = *(const LAS f32x4*)(Yt + t * 68 + i0), y1 = *(const LAS f32x4*)(Yt + t * 68 + i0 + 4);
            float s = (y0.x + y0.y) + (y0.z + y0.w) + (y1.x + y1.y) + (y1.z + y1.w);
            s += __shfl_xor(s, 1); s += __shfl_xor(s, 2); s += __shfl_xor(s, 4);
            const float mean = s * (1.f / 64.f); const f32x4 d0 = y0 - mean, d1 = y1 - mean;
            float q = (d0.x * d0.x + d0.y * d0.y) + (d0.z * d0.z + d0.w * d0.w) + (d1.x * d1.x + d1.y * d1.y) + (d1.z * d1.z + d1.w * d1.w);
            q += __shfl_xor(q, 1); q += __shfl_xor(q, 2); q += __shfl_xor(q, 4);
            const float rstd = 1.0f / sqrtf(q * (1.f / 64.f) + 64e-5f);
            const f32x4 g0 = *(const f32x4*)(lg + col), g1 = *(const f32x4*)(lg + col + 4), b0 = *(const f32x4*)(lb + col), b1 = *(const f32x4*)(lb + col + 4);
            f32x4 o0 = (d0 * rstd * g0 + b0), o1 = (d1 * rstd * g1 + b1);
            o0.x = (o0.x + bon * bflo(vw.x)) * bflo(gw4.x); o0.y = (o0.y + bon * bfhi(vw.x)) * bfhi(gw4.x); o0.z = (o0.z + bon * bflo(vw.y)) * bflo(gw4.y); o0.w = (o0.w + bon * bfhi(vw.y)) * bfhi(gw4.y);
            o1.x = (o1.x + bon * bflo(vw.z)) * bflo(gw4.z); o1.y = (o1.y + bon * bfhi(vw.z)) * bfhi(gw4.z); o1.z = (o1.z + bon * bflo(vw.w)) * bflo(gw4.w); o1.w = (o1.w + bon * bfhi(vw.w)) * bfhi(gw4.w);
            v4u ow; ow.x = pk2(o0.x, o0.y); ow.y = pk2(o0.z, o0.w); ow.z = pk2(o1.x, o1.y); ow.w = pk2(o1.z, o1.w);
            *(v4u*)(O + m * 512 + col) = ow; }
    }
#undef R3_BAR
#undef R3_LOAD
}

__device__ __forceinline__ void p_norm2_route(Frame& F, const Args& A) {
    PHASE_IDS();
    unsigned char* ws = A.ws;
    constexpr int WROW = 2064;
    LAS unsigned char* WH = F.lds; LAS unsigned char* WL = F.lds + 36 * WROW;
    LAS float* LG = (LAS float*)F.lds;
    LAS int* eid = (LAS int*)(F.lds + 128 * 36 * 4);
    const bf16* x1 = (const bf16*)(ws + WS_X1); const float* g2 = A.in[21]; const float* mod = (const float*)(ws + WS_MOD);
    const float* rgw = A.in[22]; const float* rgb = A.in[23]; const float* rew = A.in[24]; const float* reb = A.in[25];
    bf16* XN2 = (bf16*)(ws + WS_XN); int* route = (int*)(ws + WS_ROUTE); int* blkcnt = (int*)(ws + WS_BLKCNT);
    const int l15 = lane_ & 15, kg = lane_ >> 4;
    for (int blk = blockIdx.x; blk < M / 128; blk += F.G) {
        __syncthreads();
        for (int i = tid_; i < 4096; i += NWAVES * 64) { const float w = rgw[i]; const unsigned hi = f2bf(w); const unsigned lo = f2bf(w - __uint_as_float(hi << 16)); const int off = (i & 3) * WROW + (i >> 2) * 2;
            *(LAS unsigned short*)(WH + off) = (unsigned short)hi; *(LAS unsigned short*)(WL + off) = (unsigned short)lo; }
        for (int i = tid_; i < 32768; i += NWAVES * 64) { const float w = rew[i]; const unsigned hi = f2bf(w); const unsigned lo = f2bf(w - __uint_as_float(hi << 16)); const int off = (4 + (i & 31)) * WROW + (i >> 5) * 2;
            *(LAS unsigned short*)(WH + off) = (unsigned short)hi; *(LAS unsigned short*)(WL + off) = (unsigned short)lo; }
        __syncthreads();
        const int b = blk / (SEQ / 128); const size_t tok = (size_t)blk * 128 + wave_ * 16 + l15;
        const bf16* xrow = x1 + tok * D + 8 * kg; const float* gmp = g2 + 8 * kg; const float* scp = mod + b * 6144 + 4096 + 8 * kg; const float* shp = mod + b * 6144 + 3072 + 8 * kg;
        float ss = 0.f;
#pragma unroll 8
        for (int ks = 0; ks < 32; ++ks) { const v4u xw = *(const v4u*)(xrow + 32 * ks);
#pragma unroll
            for (int e = 0; e < 4; ++e) { const float lo_ = bflo(xw[e]), hi_ = bfhi(xw[e]); ss += lo_ * lo_ + hi_ * hi_; } }
        ss += __shfl_xor(ss, 16); ss += __shfl_xor(ss, 32);
        const float rstd = 1.0f / sqrtf(ss * (1.f / D) + 1e-6f);
        f32x4 acc[3]; acc[0] = f32x4{0.f, 0.f, 0.f, 0.f}; acc[1] = acc[0]; acc[2] = acc[0];
        int wcol[3];
#pragma unroll
        for (int ct = 0; ct < 3; ++ct) { const int col = 16 * ct + l15; wcol[ct] = (col < 36 ? col : 35) * WROW + 16 * kg; }
#pragma unroll 2
        for (int ks = 0; ks < 32; ++ks) {
            float hv[8];
            { const v4u xw = *(const v4u*)(xrow + 32 * ks); const f32x4 a = {bflo(xw.x), bfhi(xw.x), bflo(xw.y), bfhi(xw.y)}, c = {bflo(xw.z), bfhi(xw.z), bflo(xw.w), bfhi(xw.w)};
              const f32x4 g0 = *(const f32x4*)(gmp + 32 * ks), g1 = *(const f32x4*)(gmp + 32 * ks + 4), s0 = *(const f32x4*)(scp + 32 * ks), s1 = *(const f32x4*)(scp + 32 * ks + 4), h0 = *(const f32x4*)(shp + 32 * ks), h1 = *(const f32x4*)(shp + 32 * ks + 4);
              const f32x4 u0 = a * rstd * (g0 * (s0 + 1.0f)) + h0, u1 = c * rstd * (g1 * (s1 + 1.0f)) + h1;
              hv[0] = u0.x; hv[1] = u0.y; hv[2] = u0.z; hv[3] = u0.w; hv[4] = u1.x; hv[5] = u1.y; hv[6] = u1.z; hv[7] = u1.w; }
            unsigned hiw[4], low[4];
#pragma unroll
            for (int e = 0; e < 4; ++e) { const unsigned h0 = f2bf(hv[2 * e]), h1 = f2bf(hv[2 * e + 1]); hiw[e] = h0 | (h1 << 16);
                low[e] = f2bf(hv[2 * e] - __uint_as_float(h0 << 16)) | (f2bf(hv[2 * e + 1] - __uint_as_float(h1 << 16)) << 16); }
            v4u hq; hq.x = hiw[0]; hq.y = hiw[1]; hq.z = hiw[2]; hq.w = hiw[3];
            *(v4u*)(XN2 + tok * D + 32 * ks + 8 * kg) = hq;
            v4u lq; lq.x = low[0]; lq.y = low[1]; lq.z = low[2]; lq.w = low[3];
            const bf16x8 ah = __builtin_bit_cast(bf16x8, hq), al = __builtin_bit_cast(bf16x8, lq);
#pragma unroll
            for (int ct = 0; ct < 3; ++ct) { const bf16x8 bh = *(const LAS bf16x8*)(WH + wcol[ct] + 64 * ks), bl = *(const LAS bf16x8*)(WL + wcol[ct] + 64 * ks);
                acc[ct] = __builtin_amdgcn_mfma_f32_16x16x32_bf16(ah, bh, acc[ct], 0, 0, 0); acc[ct] = __builtin_amdgcn_mfma_f32_16x16x32_bf16(ah, bl, acc[ct], 0, 0, 0); acc[ct] = __builtin_amdgcn_mfma_f32_16x16x32_bf16(al, bh, acc[ct], 0, 0, 0); }
        }
        __syncthreads();
#pragma unroll
        for (int ct = 0; ct < 3; ++ct) { const int col = 16 * ct + l15; if (col < 36) { const float bias = (col < 4) ? rgb[col] : reb[col - 4];
#pragma unroll
            for (int e = 0; e < 4; ++e) LG[(wave_ * 16 + 4 * kg + e) * 36 + col] = acc[ct][e] + bias; } }
        __syncthreads();
        if (tid_ < 128) { const LAS float* lg = LG + tid_ * 36;
            int gi = 0; float gmax = lg[0];
#pragma unroll
            for (int i = 1; i < 4; ++i) if (lg[i] > gmax) { gmax = lg[i]; gi = i; }
            float den = 0.f;
#pragma unroll
            for (int i = 0; i < 4; ++i) den += __expf(lg[i] - gmax);
            const float gp = 1.0f / den;
            float el[8];
#pragma unroll
            for (int i = 0; i < 8; ++i) el[i] = lg[4 + 8 * gi + i];
            int i0 = 0; float m0 = el[0];
#pragma unroll
            for (int i = 1; i < 8; ++i) if (el[i] > m0) { m0 = el[i]; i0 = i; }
            int i1 = -1; float m1 = -INFINITY;
#pragma unroll
            for (int i = 0; i < 8; ++i) if (i != i0 && el[i] > m1) { m1 = el[i]; i1 = i; }
            if (i1 < 0) { i1 = (i0 + 1) & 7; m1 = m0; }
            const float p1 = __expf(m1 - m0), w0 = gp / (1.0f + p1), w1 = gp * p1 / (1.0f + p1);
            int* rt_ = route + ((size_t)blk * 128 + tid_) * 8; rt_[0] = gi * 8 + i0; rt_[1] = gi * 8 + i1; rt_[2] = __float_as_int(w0); rt_[3] = __float_as_int(w1);
            eid[tid_ * 2] = gi * 8 + i0; eid[tid_ * 2 + 1] = gi * 8 + i1; }
        __syncthreads();
        if (tid_ < 256) { const int e = eid[tid_]; int rk = 0; for (int a = 0; a < tid_; ++a) rk += (eid[a] == e) ? 1 : 0; route[((size_t)blk * 128 + (tid_ >> 1)) * 8 + 4 + (tid_ & 1)] = rk; }
        else if (tid_ < 288) { const int e = tid_ - 256; int cn = 0; for (int a = 0; a < 256; ++a) cn += (eid[a] == e) ? 1 : 0; blkcnt[blk * 32 + e] = cn; }
    }
}

__device__ __forceinline__ void conv_experts(Frame& F, const Args& A) {
    PHASE_IDS();
    unsigned char* ws = A.ws; bf16* W13 = (bf16*)(ws + WS_W13); bf16* W2T = (bf16*)(ws + WS_W2T);
    LAS float* scr = (LAS float*)(F.lds + RING_OFF + wave_ * 16384);
    const int gw = F.vcu * NWAVES + wave_, NGW = F.G * NWAVES;
    for (int it = gw; it < 3 * 8192; it += NGW) {
        const int which = it >> 13, r = it & 8191;
        if (which < 2) { const int e = r >> 8, kb = (r >> 4) & 15, nb = r & 15, n0 = 32 * nb;
            transpose_item(A.in[26 + which] + (size_t)e * 1024 * 512, 512, n0, 64 * kb, 1024, W13, (size_t)e * 1024 + (n0 >> 7) * 256 + which * 128 + (n0 & 127), scr, lane_); }
        else { const int e = r >> 8, kb = (r >> 5) & 7, nb = r & 31;
            transpose_item(A.in[28] + (size_t)e * 512 * 1024, 1024, 32 * nb, 64 * kb, 512, W2T, (size_t)e * 1024 + 32 * nb, scr, lane_); }
    }
}

__device__ __forceinline__ void p_slots(Frame& F, const Args& A) {
    PHASE_IDS();
    unsigned char* ws = A.ws;
    LAS int* tile_e = (LAS int*)(F.lds + TILE_OFF); LAS int* base = tile_e + 288; LAS int* tot = base + 32; LAS int* pre = tot + 32; LAS int* ntl = pre + 32; LAS int* part = ntl + 4;
    const int* blkcnt = (const int*)(ws + WS_BLKCNT); int* route = (int*)(ws + WS_ROUTE); int* rowtok = (int*)(ws + WS_ROWTOK);
    { const int e = tid_ & 31, pt = tid_ >> 5; int s = 0; for (int bb = 16 * pt; bb < 16 * pt + 16; ++bb) s += blkcnt[bb * 32 + e]; part[pt * 32 + e] = s; }
    __syncthreads();
    if (tid_ < 32) { int t = 0; for (int p = 0; p < 16; ++p) t += part[p * 32 + tid_]; tot[tid_] = t; }
    __syncthreads();
    if (tid_ == 0) { int run = 0, nt = 0; for (int e = 0; e < 32; ++e) { base[e] = run; const int pad = (tot[e] + 255) >> 8; for (int i = 0; i < pad; ++i) tile_e[nt++] = e; run += pad * 256; } ntl[0] = nt; }
    __syncthreads();
    for (int blk = blockIdx.x; blk < M / 128; blk += F.G) {
        { const int e = tid_ & 31, pt = tid_ >> 5; int s = 0; for (int bb = pt; bb < blk; bb += 16) s += blkcnt[bb * 32 + e]; part[pt * 32 + e] = s; }
        __syncthreads();
        if (tid_ < 32) { int p = 0; for (int q = 0; q < 16; ++q) p += part[q * 32 + tid_]; pre[tid_] = p; }
        __syncthreads();
        if (tid_ < 256) { const size_t tok = (size_t)blk * 128 + (tid_ >> 1); const int k = tid_ & 1; const int e = route[tok * 8 + k], lr = route[tok * 8 + 4 + k];
            const int slot = base[e] + pre[e] + lr; route[tok * 8 + 6 + k] = slot; rowtok[slot] = (int)tok; }
        __syncthreads();
    }
    for (int e = blockIdx.x; e < 32; e += F.G) { const int lo = base[e] + tot[e], hi = base[e] + (((tot[e] + 255) >> 8) << 8); for (int s = lo + tid_; s < hi; s += NWAVES * 64) rowtok[s] = 0; }
}

#ifndef STAGE_UNUSED
#define STAGE 4
#endif
#ifndef PHASES
#define PHASES 0xffff
#endif
#ifndef RWKV_CHUNKED
#define RWKV_CHUNKED 1
#endif

__device__ __forceinline__ void ph_gemm1(Frame& F, const Args& args) { unsigned char* ws = args.ws;
    pg8::Gemm g{(const pg8::bf16_t*)(ws + WS_XN), (const pg8::bf16_t*)(ws + WS_WIN), nullptr, 1024, NIN};
    pg8::StaticOrder S; S.init(M, NIN, F.G, (int)blockIdx.x);
    pg8::EpiIn E{(pg8::bf16_t*)(ws + WS_Q), (pg8::bf16_t*)(ws + WS_K), (pg8::bf16_t*)(ws + WS_V), (pg8::bf16_t*)(ws + WS_PRW), (pg8::bf16_t*)(ws + WS_GATES), ATT_C2};
    pg8::gemm_phase<pg8::EpiIn, pg8::StaticOrder>(F.lds + RING_OFF, g, S, E); }
__device__ __forceinline__ void ph_attn_wrap(unsigned char* lds, Frame& F, const Args& args, size_t out_off, int qslot) { unsigned char* ws = args.ws;
    const attn_body::AttnTensors AT{(const attn_body::bf16*)(ws + WS_Q), (const attn_body::bf16*)(ws + WS_K), (const attn_body::bf16*)(ws + WS_V), (attn_body::bf16*)(ws + out_off), (const float*)(ws + WS_CUM), (const float*)(ws + WS_SEGTOT)};
    attn_body::attn_phase_dyn<8>((char*)lds + RING_OFF, AT, (unsigned*)(F.ctl + CW_QUEUE + 64 * qslot), (const unsigned*)(F.ctl + CW_QKMAX), TAB_OFF, SEGP_OFF); }
__device__ __forceinline__ void ph_gemm2a(Frame& F, const Args& args) { unsigned char* ws = args.ws;
    pg8::Gemm g{(const pg8::bf16_t*)(ws + WS_Q), (const pg8::bf16_t*)(ws + WS_WOF), nullptr, 512, 1024};
    pg8::StaticOrder S; S.init(M, 1024, F.G, (int)blockIdx.x);
    pg8::EpiGate<1> E{(pg8::bf16_t*)(ws + WS_TMP), 1024, (const pg8::bf16_t*)(ws + WS_GATES), 2048, 0};
    pg8::gemm_phase<pg8::EpiGate<1>, pg8::StaticOrder>(F.lds + RING_OFF, g, S, E); }
__device__ __forceinline__ void ph_gemm2b(Frame& F, const Args& args) { unsigned char* ws = args.ws;
    pg8::Gemm g{(const pg8::bf16_t*)(ws + WS_F), (const pg8::bf16_t*)(ws + WS_WOR), nullptr, 512, 1024};
    pg8::StaticOrder S; S.init(M, 1024, F.G, (int)blockIdx.x);
    pg8::EpiGate<2> E{(pg8::bf16_t*)(ws + WS_TMP), 1024, (const pg8::bf16_t*)(ws + WS_GATES), 2048, 1024};
    pg8::gemm_phase<pg8::EpiGate<2>, pg8::StaticOrder>(F.lds + RING_OFF, g, S, E); }
__device__ __forceinline__ void ph_gemm3(Frame& F, const Args& args) { unsigned char* ws = args.ws;
    pg8::Gemm g{(const pg8::bf16_t*)(ws + WS_TMP), (const pg8::bf16_t*)(ws + WS_WO), nullptr, 1024, 1024};
    pg8::StaticOrder S; S.init(M, 1024, F.G, (int)blockIdx.x);
    pg8::EpiRes E{args.in[0], (pg8::bf16_t*)(ws + WS_X1), (const float*)(ws + WS_MOD) + 2048, SEQ, 6144};
    pg8::gemm_phase<pg8::EpiRes, pg8::StaticOrder>(F.lds + RING_OFF, g, S, E); }
__device__ __forceinline__ void ph_moe_up(Frame& F, const Args& args) { unsigned char* ws = args.ws;
    const LAS int* tile_e = (const LAS int*)(F.lds + TILE_OFF); const int ntiles = tile_e[288 + 96];
    LAS int* rows = (LAS int*)(F.lds + TILE_OFF + 4096);
    { const int* rowtok = (const int*)(ws + WS_ROWTOK); int tid_ = threadIdx.x; asm volatile("" : "+v"(tid_));
      for (int i = 0; i < 8; ++i) { const int L = i * F.G + (int)blockIdx.x; if (L >= ntiles * 4) break; if (tid_ < 256) rows[i * 256 + tid_] = rowtok[(L >> 2) * 256 + tid_]; }
      __syncthreads(); }
    pg8::Gemm g{(const pg8::bf16_t*)(ws + WS_XN), (const pg8::bf16_t*)(ws + WS_W13), rows, 1024, 1024};
    pg8::MoeOrder S{ntiles * 4, F.G, (int)blockIdx.x, 2, tile_e};
    pg8::EpiSwiGLU E{(pg8::bf16_t*)(ws + WS_H)};
    pg8::gemm_phase<pg8::EpiSwiGLU, pg8::MoeOrder, true>(F.lds + RING_OFF, g, S, E); }
__device__ __forceinline__ void ph_moe_down(Frame& F, const Args& args) { unsigned char* ws = args.ws;
    const LAS int* tile_e = (const LAS int*)(F.lds + TILE_OFF); const int ntiles = tile_e[288 + 96];
    pg8::Gemm g{(const pg8::bf16_t*)(ws + WS_H), (const pg8::bf16_t*)(ws + WS_W2T), nullptr, 512, 1024};
    pg8::MoeOrder S{ntiles * 4, F.G, (int)blockIdx.x, 2, tile_e};
    pg8::EpiFp8 E{ws + WS_YM, 1024};
    pg8::gemm_phase<pg8::EpiFp8, pg8::MoeOrder>(F.lds + RING_OFF, g, S, E); }

__global__ void __launch_bounds__(NWAVES * 64, 2) fwd_kernel(Args args) {
    extern __shared__ __attribute__((aligned(16))) unsigned char lds[];
    Frame F;
    F.lds = (LAS unsigned char*)lds;
    F.MISC = (volatile LAS unsigned*)(F.lds + MISC_OFF);
    F.tid = threadIdx.x; F.lane = F.tid & 63; F.wave = __builtin_amdgcn_readfirstlane(F.tid >> 6);
    F.G = gridDim.x; { const int bx = blockIdx.x; F.vcu = (F.G % 8 == 0) ? (bx % 8) * (F.G / 8) + bx / 8 : bx; }
    unsigned char* ws = args.ws;
    F.ctl = (gu32*)(ws + WS_CTL);
    for (int u = F.tid; u < (LDS_BYTES - LDSCTL_OFF) / 4; u += NWAVES * 64) ((LAS unsigned*)(F.lds + LDSCTL_OFF))[u] = 0u;
    __syncthreads();
    XcdBarrier bar = xcd_barrier_post((unsigned*)(F.ctl + CW_BAR), F.MISC + 8);
#define GRID_BAR() xcd_barrier(bar)

    p0_prologue(F, args); GRID_BAR();
    p1_norm(F, args); __syncthreads(); p_convert_early(F, args); GRID_BAR();
    p_cumfix(F, args);
    ph_gemm1(F, args); GRID_BAR();
    p_qknorm(F, args, (unsigned*)(F.ctl + CW_QKMAX));
    for (int cb = (int)blockIdx.x; cb < SEQ / 64; cb += F.G)
    for (int half = 0; half < 2; ++half) {
        rwkv_pre<0>(F, args, cb + 256 * half, cb + 256 * half + 1);
        __syncthreads();
        rwkv_r1<0>(F, args, cb + 2048 * half, cb + 2048 * half + 2048, 256);
        __syncthreads();
    }
    GRID_BAR();
    rwkv_r2<0>(F, args, (unsigned char*)args.out + ST_OFF);
    ph_attn_wrap(lds, F, args, WS_Q, 0); GRID_BAR();
    rwkv_r3(F, args); GRID_BAR();
    ph_gemm2a(F, args);
    ph_gemm2b(F, args); GRID_BAR();
    ph_gemm3(F, args); GRID_BAR();
    p_norm2_route(F, args); GRID_BAR();
    p_slots(F, args); conv_experts(F, args); GRID_BAR();
    ph_moe_up(F, args); GRID_BAR();
    ph_moe_down(F, args); GRID_BAR();
    p_final<1>(F, args, args.out);
}

extern "C" void kernel_launch(void* const* d_in, const int* in_sizes, int n_in, void* d_out, int out_size, void* d_ws, size_t ws_size, hipStream_t stream) {
    static int grid = 0;
    if (grid == 0) {
        if (n_in != 30 || in_sizes[0] != M * D || out_size != M * D || ws_size < WS_END) { fprintf(stderr, "kernel_launch: unexpected shapes (n_in %d, in0 %d, out %d, ws %zu)\n", n_in, n_in > 0 ? in_sizes[0] : -1, out_size, ws_size); grid = -1; return; }
        int dev = 0, cus = 0, per_cu = 0;
        if (hipGetDevice(&dev) != hipSuccess || hipDeviceGetAttribute(&cus, hipDeviceAttributeMultiprocessorCount, dev) != hipSuccess) { grid = -1; return; }
        if (hipFuncSetAttribute((const void*)fwd_kernel, hipFuncAttributeMaxDynamicSharedMemorySize, LDS_BYTES) != hipSuccess) { fprintf(stderr, "kernel_launch: hipFuncSetAttribute failed\n"); grid = -1; return; }
        if (hipOccupancyMaxActiveBlocksPerMultiprocessor(&per_cu, (const void*)fwd_kernel, NWAVES * 64, LDS_BYTES) != hipSuccess || per_cu < 1)
            fprintf(stderr, "kernel_launch: occupancy query reports %d\n", per_cu);
        (void)hipGetLastError();
        grid = cus;
        if (grid > 256) grid = 256;
    }
    if (grid < 0) return;
    if (hipMemsetAsync((char*)d_ws + WS_CTL, 0, CTL_ZERO_BYTES, stream) != hipSuccess) return;
    Args a{};
    for (int i = 0; i < 30; ++i) a.in[i] = (const float*)d_in[i];
    a.out = (float*)d_out; a.ws = (unsigned char*)d_ws;
    hipLaunchKernelGGL(fwd_kernel, dim3(grid), dim3(NWAVES * 64), LDS_BYTES, stream, a);
}
```

```cpp
#include <hip/hip_runtime.h>
#include <hip/hip_bf16.h>
#include <cstdio>
#include <cstdint>
#include <cmath>

namespace pg8 {
#define PG8_LAS __attribute__((address_space(3)))
typedef unsigned short bf16_t;
typedef short bf16x8 __attribute__((ext_vector_type(8)));
typedef float f32x4 __attribute__((ext_vector_type(4)));
typedef unsigned u32x4 __attribute__((ext_vector_type(4)));
typedef unsigned u32x2 __attribute__((ext_vector_type(2)));
constexpr int BM = 256, BK = 64, HALF = 128, HTB = HALF * BK * 2, STAGE_BYTES = 8 * HTB, NXCD = 8, WGM = 8;

__host__ __device__ __forceinline__ int lds_byte(int r, int c) { const int st = (r >> 4) * 2 + (c >> 5), rr = r & 15, cc = c & 31, ob = rr * 64 + cc * 2; return st * 1024 + (ob ^ (((ob >> 9) & 1) << 5)); }
__host__ __device__ __forceinline__ void stage_rc(int b, int& R, int& C) { const int st = b / 1024, sb = b % 1024, swz = sb ^ (((sb >> 9) & 1) << 5); R = (st >> 1) * 16 + swz / 64; C = (st & 1) * 32 + (swz % 64) / 2; }
__host__ __device__ __forceinline__ int perm32(int rho) { const int n = rho >> 4, i = rho & 15; return 8 * (i >> 2) + 4 * n + (i & 3); }

struct Unit { int pm, pn, e; };
struct Gemm { const bf16_t* A; const bf16_t* Bt; const PG8_LAS int* rowlds; int K; int nB; };

struct StaticOrder {
    int nM, nN, nwg, G, c;
    __host__ __device__ void init(int M, int N, int G_, int c_) { nM = M / BM; nN = N / BM; nwg = nM * nN; G = G_; c = c_; }
    __host__ __device__ bool next(int i, Unit& u) const {
        const long L = (long)i * G + c; if (L >= nwg) return false;
        int wgid = (int)L; { const int q = nwg / NXCD, r = nwg % NXCD, xcd = wgid % NXCD, off = wgid / NXCD; wgid = (xcd < r ? xcd * (q + 1) : r * (q + 1) + (xcd - r) * q) + off; }
        const int nig = WGM * nN, gid = wgid / nig, fm = gid * WGM, gsz = (nM - fm) < WGM ? (nM - fm) : WGM;
        u.pm = fm + ((wgid % nig) % gsz); u.pn = (wgid % nig) / gsz; u.e = 0; return true;
    }
};

__device__ __forceinline__ unsigned cvt_pk_bf16(float lo, float hi) { unsigned r; asm volatile("v_cvt_pk_bf16_f32 %0, %1, %2" : "=v"(r) : "v"(lo), "v"(hi)); return r; }
__device__ __forceinline__ float bf_lo(unsigned w) { return __uint_as_float(w << 16); }
__device__ __forceinline__ float bf_hi(unsigned w) { return __uint_as_float(w & 0xffff0000u); }
__device__ __forceinline__ float fsigmoid(float x) { return __builtin_amdgcn_rcpf(1.0f + __builtin_amdgcn_exp2f(-1.4426950408889634f * x)); }

template <class Epi, class Sched, bool GATHER = false>
__device__ __forceinline__ void gemm_phase(PG8_LAS unsigned char* lds, const Gemm g, const Sched& S, const Epi& E) {
    int tid_ = threadIdx.x; asm volatile("" : "+v"(tid_));
    const int tid = tid_, wid = __builtin_amdgcn_readfirstlane(tid >> 6), lane = tid & 63, wr = wid >> 2, wc = wid & 3, fr = lane & 15, fq = lane >> 4;
    const int K = g.K, nt = K / BK;
    int RA[2], CA[2]; unsigned voffA[2], voffB[2];
#pragma unroll
    for (int i = 0; i < 2; ++i) { int R, C; stage_rc(tid * 16 + i * 8192, R, C); const int Rb = Epi::PERM ? ((R & ~31) + perm32(R & 31)) : R;
        RA[i] = R; CA[i] = C; voffA[i] = (unsigned)(R * K + C) * 2u; voffB[i] = (unsigned)(Rb * K + C) * 2u; }
    const size_t tstep = 2 * (size_t)HALF * K * 2;
    const size_t kstep = (size_t)(BK * 2);
    const size_t hstep = (size_t)HALF * K * 2;
    const unsigned ldsw = (unsigned)wid * 1024u;
    const int aoff = lds_byte(wr * 64 + fr, fq * 8), boff = lds_byte(wc * 32 + fr, fq * 8);
#define PG8_SA(b, h) (((b) * 2 + (h)) * HTB)
#define PG8_SB(b, h) ((4 + (b) * 2 + (h)) * HTB)
#define PG8_STAGE(bufoff, gbase, v0, v1) do { \
        __builtin_amdgcn_global_load_lds((const unsigned*)((const char*)(gbase) + (v0)), (PG8_LAS unsigned*)(lds + (bufoff) + ldsw), 16, 0, 0); \
        __builtin_amdgcn_global_load_lds((const unsigned*)((const char*)(gbase) + (v1)), (PG8_LAS unsigned*)(lds + (bufoff) + ldsw + 8192), 16, 0, 0); } while (0)
#define PG8_STAGEB(bufoff, gbase) PG8_STAGE(bufoff, gbase, voffB[0], voffB[1])
#define PG8_STAGEA(bufoff, abase, h, VA) do { if constexpr (GATHER) { PG8_STAGE(bufoff, abase, VA[h][0], VA[h][1]); } else { PG8_STAGE(bufoff, (abase) + (h) * hstep, voffA[0], voffA[1]); } } while (0)
#define PG8_LDA(dst, b, h) do { _Pragma("unroll") for (int m = 0; m < 4; ++m) _Pragma("unroll") for (int k = 0; k < 2; ++k) dst[m][k] = *(const PG8_LAS bf16x8*)(lds + PG8_SA(b, h) + aoff + m * 2048 + k * 1024); } while (0)
#define PG8_LDB(dst, b, h) do { _Pragma("unroll") for (int n = 0; n < 2; ++n) _Pragma("unroll") for (int k = 0; k < 2; ++k) dst[n][k] = *(const PG8_LAS bf16x8*)(lds + PG8_SB(b, h) + boff + n * 2048 + k * 1024); } while (0)
#define PG8_MMA(ai, bj, At, Bt) do { __builtin_amdgcn_s_setprio(1); _Pragma("unroll") for (int m = 0; m < 4; ++m) _Pragma("unroll") for (int n = 0; n < 2; ++n) _Pragma("unroll") for (int k = 0; k < 2; ++k) \
        acc[ai][bj][m][n] = __builtin_amdgcn_mfma_f32_16x16x32_bf16(Bt[n][k], At[m][k], acc[ai][bj][m][n], 0, 0, 0); __builtin_amdgcn_s_setprio(0); } while (0)
#define PG8_WAIT_V(n) asm volatile("s_waitcnt vmcnt(" #n ")" ::: "memory")
#define PG8_WAIT_L(n) asm volatile("s_waitcnt lgkmcnt(" #n ")" ::: "memory")
#define PG8_BAR __builtin_amdgcn_s_barrier()
#define PG8_SCHED __builtin_amdgcn_sched_barrier(0)
#define PG8_AOFF(dst, ord) do { _Pragma("unroll") for (int h_ = 0; h_ < 2; ++h_) _Pragma("unroll") for (int i_ = 0; i_ < 2; ++i_) { \
        const int src_ = g.rowlds[(ord) * BM + h_ * HALF + RA[i_]]; dst[h_][i_] = (unsigned)(src_ * K + CA[i_]) * 2u; } } while (0)
    Unit cur, nxt; int ui = 0;
    if (!S.next(0, cur)) return;
    f32x4 acc[2][2][4][2];
#pragma unroll
    for (int a = 0; a < 2; ++a)
#pragma unroll
        for (int b = 0; b < 2; ++b)
#pragma unroll
            for (int m = 0; m < 4; ++m)
#pragma unroll
                for (int n = 0; n < 2; ++n) acc[a][b][m][n] = (f32x4){0.f, 0.f, 0.f, 0.f};
    bf16x8 At[4][2], B0[2][2], B1[2][2];
    unsigned vA[2][2], nvA[2][2];
    if constexpr (GATHER) { PG8_AOFF(vA, 0); }
    const char* cA = GATHER ? (const char*)g.A : (const char*)g.A + (size_t)cur.pm * tstep;
    const char* cB = (const char*)g.Bt + ((size_t)cur.e * g.nB + (size_t)cur.pn * BM) * K * 2;
    PG8_STAGEB(PG8_SB(0, 0), cB); PG8_STAGEB(PG8_SB(0, 1), cB + hstep); PG8_STAGEA(PG8_SA(0, 0), cA, 0, vA); PG8_STAGEA(PG8_SA(0, 1), cA, 1, vA);
    if (wr == 1) PG8_BAR;
    PG8_WAIT_V(2); PG8_BAR;
    PG8_STAGEB(PG8_SB(1, 0), cB + kstep); PG8_STAGEA(PG8_SA(1, 0), cA + kstep, 0, vA); PG8_STAGEB(PG8_SB(1, 1), cB + hstep + kstep);
    PG8_WAIT_V(6); PG8_BAR;
    for (;;) {
        const bool has_next = S.next(ui + 1, nxt);
        if constexpr (GATHER) { if (has_next) { PG8_AOFF(nvA, ui + 1); } else {
#pragma unroll
            for (int h_ = 0; h_ < 2; ++h_)
#pragma unroll
                for (int i_ = 0; i_ < 2; ++i_) nvA[h_][i_] = vA[h_][i_]; } }
        const char* nA = GATHER ? cA : (has_next ? (const char*)g.A + (size_t)nxt.pm * tstep : cA);
        const char* nB = has_next ? (const char*)g.Bt + ((size_t)nxt.e * g.nB + (size_t)nxt.pn * BM) * K * 2 : cB;
        for (int t = 0; t < nt; t += 2) {
            const bool last = (t == nt - 2);
            const char* a1 = cA + (size_t)(t + 1) * kstep;
            const char* a2 = last ? nA : cA + (size_t)(t + 2) * kstep; const char* b2 = last ? nB : cB + (size_t)(t + 2) * kstep;
            const char* a3 = a2 + kstep; const char* b3 = b2 + kstep;
            unsigned wv[2][2];
            if constexpr (GATHER) { wv[0][0] = last ? nvA[0][0] : vA[0][0]; wv[0][1] = last ? nvA[0][1] : vA[0][1]; wv[1][0] = last ? nvA[1][0] : vA[1][0]; wv[1][1] = last ? nvA[1][1] : vA[1][1]; }
            PG8_LDB(B0, 0, 0); PG8_LDB(B1, 0, 1); PG8_SCHED; PG8_LDA(At, 0, 0); PG8_STAGEA(PG8_SA(1, 1), a1, 1, vA);
            PG8_WAIT_V(8); PG8_WAIT_L(0); PG8_BAR; PG8_MMA(0, 0, At, B0); PG8_MMA(0, 1, At, B1); PG8_BAR; PG8_SCHED;
            PG8_LDA(At, 0, 1); PG8_STAGEB(PG8_SB(0, 0), b2); PG8_STAGEB(PG8_SB(0, 1), b2 + hstep); PG8_STAGEA(PG8_SA(0, 0), a2, 0, wv);
            PG8_WAIT_V(8); PG8_WAIT_L(0); PG8_BAR; PG8_MMA(1, 0, At, B0); PG8_MMA(1, 1, At, B1); PG8_BAR; PG8_SCHED;
            PG8_LDB(B0, 1, 0); PG8_LDB(B1, 1, 1); PG8_SCHED; PG8_LDA(At, 1, 0); PG8_STAGEA(PG8_SA(0, 1), a2, 1, wv);
            PG8_WAIT_V(8); PG8_WAIT_L(0); PG8_BAR; PG8_MMA(0, 0, At, B0); PG8_MMA(0, 1, At, B1); PG8_BAR; PG8_SCHED;
            PG8_LDA(At, 1, 1); PG8_STAGEB(PG8_SB(1, 0), b3); PG8_STAGEB(PG8_SB(1, 1), b3 + hstep); PG8_STAGEA(PG8_SA(1, 0), a3, 0, wv);
            PG8_WAIT_V(8); PG8_WAIT_L(0); PG8_BAR; PG8_MMA(1, 0, At, B0); PG8_MMA(1, 1, At, B1); PG8_BAR; PG8_SCHED;
        }
        if (wr == 0) PG8_BAR;
        E(acc, cur, wr, wc, fr, fq);
        if (!has_next) break;
#pragma unroll
        for (int a = 0; a < 2; ++a)
#pragma unroll
            for (int b = 0; b < 2; ++b)
#pragma unroll
                for (int m = 0; m < 4; ++m)
#pragma unroll
                    for (int n = 0; n < 2; ++n) acc[a][b][m][n] = (f32x4){0.f, 0.f, 0.f, 0.f};
        cur = nxt; cB = nB; cA = nA; ++ui;
        if constexpr (GATHER) {
#pragma unroll
        for (int h_ = 0; h_ < 2; ++h_)
#pragma unroll
            for (int i_ = 0; i_ < 2; ++i_) vA[h_][i_] = nvA[h_][i_]; }
        if (wr == 1) PG8_BAR;
    }
    PG8_WAIT_V(0);
    PG8_BAR;
#undef PG8_SA
#undef PG8_SB
#undef PG8_STAGE
#undef PG8_STAGEB
#undef PG8_STAGEA
#undef PG8_LDA
#undef PG8_LDB
#undef PG8_MMA
#undef PG8_WAIT_V
#undef PG8_WAIT_L
#undef PG8_BAR
#undef PG8_SCHED
#undef PG8_AOFF
}
}

namespace pg8 {
struct EpiIn {
    static constexpr bool PERM = true;
    bf16_t *Q, *Kb, *V, *PRW, *GT; float qscale;
    __device__ __forceinline__ void operator()(const f32x4 (&acc)[2][2][4][2], const Unit& u, int wr, int wc, int fr, int fq) const {
        const int pn = u.pn; bf16_t* base; int ld, colt, mode = 0;
        if (pn < 2) { base = Q; ld = 512; colt = pn * 256; mode = 1; }
        else if (pn < 4) { base = Kb; ld = 512; colt = (pn - 2) * 256; }
        else if (pn < 6) { base = V; ld = 512; colt = (pn - 4) * 256; }
        else if (pn < 13) { base = PRW; ld = 1792; colt = (pn - 6) * 256; }
        else { base = GT; ld = 2048; colt = (pn - 13) * 256; mode = 2; }
        const int row0 = u.pm * BM + wr * 64 + fr, col0 = colt + wc * 32 + 8 * fq;
        const float sc = (mode == 1) ? qscale : 1.0f;
#pragma unroll
        for (int ai = 0; ai < 2; ++ai)
#pragma unroll
            for (int m = 0; m < 4; ++m) { bf16_t* rowp = base + (size_t)(row0 + ai * HALF + m * 16) * ld + col0;
#pragma unroll
                for (int bj = 0; bj < 2; ++bj) { f32x4 v0 = acc[ai][bj][m][0] * sc, v1 = acc[ai][bj][m][1] * sc;
                    if (mode == 2) {
#pragma unroll
                        for (int e = 0; e < 4; ++e) { v0[e] = fsigmoid(v0[e]); v1[e] = fsigmoid(v1[e]); } }
                    u32x4 w; w.x = cvt_pk_bf16(v0[0], v0[1]); w.y = cvt_pk_bf16(v0[2], v0[3]); w.z = cvt_pk_bf16(v1[0], v1[1]); w.w = cvt_pk_bf16(v1[2], v1[3]);
                    *(u32x4*)(rowp + bj * HALF) = w; } }
    }
};
template <int MODE> struct EpiGate {
    static constexpr bool PERM = true;
    bf16_t* O; int ldo; const bf16_t* G; int ldg; int gcol0;
    __device__ __forceinline__ void operator()(const f32x4 (&acc)[2][2][4][2], const Unit& u, int wr, int wc, int fr, int fq) const {
        const int row0 = u.pm * BM + wr * 64 + fr, col0 = u.pn * BM + wc * 32 + 8 * fq;
#pragma unroll
        for (int ai = 0; ai < 2; ++ai)
#pragma unroll
            for (int m = 0; m < 4; ++m) { const size_t row = (size_t)(row0 + ai * HALF + m * 16); bf16_t* rowp = O + row * ldo + col0;
#pragma unroll
                for (int bj = 0; bj < 2; ++bj) { f32x4 v0 = acc[ai][bj][m][0], v1 = acc[ai][bj][m][1];
                    if (MODE >= 1) { const u32x4 gw = *(const u32x4*)(G + row * ldg + gcol0 + col0 + bj * HALF);
                        v0[0] *= bf_lo(gw.x); v0[1] *= bf_hi(gw.x); v0[2] *= bf_lo(gw.y); v0[3] *= bf_hi(gw.y); v1[0] *= bf_lo(gw.z); v1[1] *= bf_hi(gw.z); v1[2] *= bf_lo(gw.w); v1[3] *= bf_hi(gw.w); }
                    if (MODE == 2) { const u32x4 ow = *(const u32x4*)(rowp + bj * HALF);
                        v0[0] += bf_lo(ow.x); v0[1] += bf_hi(ow.x); v0[2] += bf_lo(ow.y); v0[3] += bf_hi(ow.y); v1[0] += bf_lo(ow.z); v1[1] += bf_hi(ow.z); v1[2] += bf_lo(ow.w); v1[3] += bf_hi(ow.w); }
                    u32x4 w; w.x = cvt_pk_bf16(v0[0], v0[1]); w.y = cvt_pk_bf16(v0[2], v0[3]); w.z = cvt_pk_bf16(v1[0], v1[1]); w.w = cvt_pk_bf16(v1[2], v1[3]);
                    *(u32x4*)(rowp + bj * HALF) = w; } }
    }
};
struct EpiRes {
    static constexpr bool PERM = true;
    const float* X; bf16_t* O; const float* gate; int seq; int gstride;
    __device__ __forceinline__ void operator()(const f32x4 (&acc)[2][2][4][2], const Unit& u, int wr, int wc, int fr, int fq) const {
        const int row0 = u.pm * BM + wr * 64 + fr, col0 = u.pn * BM + wc * 32 + 8 * fq;
        const float* gp = gate + (size_t)((u.pm * BM) / seq) * gstride + col0;
        f32x4 gv[2][2];
#pragma unroll
        for (int bj = 0; bj < 2; ++bj)
#pragma unroll
            for (int n = 0; n < 2; ++n) gv[bj][n] = *(const f32x4*)(gp + bj * HALF + n * 4);
#pragma unroll
        for (int ai = 0; ai < 2; ++ai)
#pragma unroll
            for (int m = 0; m < 4; ++m) { const size_t off = (size_t)(row0 + ai * HALF + m * 16) * 1024 + col0;
#pragma unroll
                for (int bj = 0; bj < 2; ++bj) { const f32x4 x0 = *(const f32x4*)(X + off + bj * HALF), x1 = *(const f32x4*)(X + off + bj * HALF + 4);
                    const f32x4 v0 = x0 + gv[bj][0] * acc[ai][bj][m][0], v1 = x1 + gv[bj][1] * acc[ai][bj][m][1];
                    u32x4 w; w.x = cvt_pk_bf16(v0[0], v0[1]); w.y = cvt_pk_bf16(v0[2], v0[3]); w.z = cvt_pk_bf16(v1[0], v1[1]); w.w = cvt_pk_bf16(v1[2], v1[3]);
                    *(u32x4*)(O + off + bj * HALF) = w; } }
    }
};
struct EpiSwiGLU {
    static constexpr bool PERM = true;
    bf16_t* H;
    __device__ __forceinline__ void operator()(const f32x4 (&acc)[2][2][4][2], const Unit& u, int wr, int wc, int fr, int fq) const {
        const int row0 = u.pm * BM + wr * 64 + fr, col0 = u.pn * HALF + wc * 32 + 8 * fq;
#pragma unroll
        for (int ai = 0; ai < 2; ++ai)
#pragma unroll
            for (int m = 0; m < 4; ++m) { bf16_t* rowp = H + (size_t)(row0 + ai * HALF + m * 16) * 512 + col0;
                f32x4 v0, v1;
#pragma unroll
                for (int e = 0; e < 4; ++e) { const float a0 = acc[ai][0][m][0][e], a1 = acc[ai][0][m][1][e];
                    v0[e] = a0 * fsigmoid(a0) * acc[ai][1][m][0][e]; v1[e] = a1 * fsigmoid(a1) * acc[ai][1][m][1][e]; }
                u32x4 w; w.x = cvt_pk_bf16(v0[0], v0[1]); w.y = cvt_pk_bf16(v0[2], v0[3]); w.z = cvt_pk_bf16(v1[0], v1[1]); w.w = cvt_pk_bf16(v1[2], v1[3]);
                *(u32x4*)rowp = w; }
    }
};
struct EpiFp8 {
    static constexpr bool PERM = true;
    unsigned char* O; int ldo;
    __device__ __forceinline__ void operator()(const f32x4 (&acc)[2][2][4][2], const Unit& u, int wr, int wc, int fr, int fq) const {
        const int row0 = u.pm * BM + wr * 64 + fr, col0 = u.pn * BM + wc * 32 + 8 * fq;
#pragma unroll
        for (int ai = 0; ai < 2; ++ai)
#pragma unroll
            for (int m = 0; m < 4; ++m) { unsigned char* rowp = O + (size_t)(row0 + ai * HALF + m * 16) * ldo + col0;
#pragma unroll
                for (int bj = 0; bj < 2; ++bj) { const f32x4 v0 = acc[ai][bj][m][0], v1 = acc[ai][bj][m][1];
                    int lo = __builtin_amdgcn_cvt_pk_fp8_f32(v0[0], v0[1], 0, false); lo = __builtin_amdgcn_cvt_pk_fp8_f32(v0[2], v0[3], lo, true);
                    int hi = __builtin_amdgcn_cvt_pk_fp8_f32(v1[0], v1[1], 0, false); hi = __builtin_amdgcn_cvt_pk_fp8_f32(v1[2], v1[3], hi, true);
                    *(u32x2*)(rowp + bj * HALF) = (u32x2){(unsigned)lo, (unsigned)hi}; } }
    }
};
struct MoeOrder {
    int nunits, G, c, cshift; const PG8_LAS int* tile_e;
    __device__ __forceinline__ bool next(int i, Unit& u) const {
        const int L = i * G + c; if (L >= nunits) return false;
        u.pm = L >> cshift; u.pn = L & ((1 << cshift) - 1); u.e = tile_e[u.pm]; return true;
    }
};
}
#include <hip/hip_bf16.h>
#include <cmath>
namespace attn_body {
using bf16=__hip_bfloat16;
using bf16x8=__attribute__((ext_vector_type(8)))short;
using s16x4=__attribute__((ext_vector_type(4)))short;
using f32x16=__attribute__((ext_vector_type(16)))float;
using u32x4=__attribute__((ext_vector_type(4)))unsigned;
constexpr int BATCH=2,NHEAD=8,SEQ=16384,D=64,DM=NHEAD*D;
constexpr int NW=8,QBLK=32,QB=QBLK*NW,KVBLK=64,NQB=SEQ/QB;
constexpr int ATTN_PITCH=DM, ATTN_UNIT_ROWS=QB;
__device__ __forceinline__ int crow(int r,int hi){return (r&3)+8*(r>>2)+4*hi;}
#define SBAR() __builtin_amdgcn_sched_barrier(0)
__device__ __forceinline__ void cmask(f32x16&p0,f32x16&p1,int jb,int qrel,int hi){
  const float NEG=-INFINITY; int x=qrel-64*jb-4*hi; asm volatile("":"+v"(x));
  #pragma unroll
  for(int r=0;r<16;++r){const int c=(r&3)+8*(r>>2); if(c>x)p0[r]=NEG; if(c+32>x)p1[r]=NEG;}
}

constexpr int NSLOT=3, SLOTB=8192;
constexpr int LDS_K=0, LDS_V=NSLOT*SLOTB, LDS_WS=2*NSLOT*SLOTB, LDS_OST=LDS_WS+NW*64*4, LDS_BYTES=LDS_OST+NW*4096;
constexpr float C2=0.125f*1.4426950408889634f;
__device__ __forceinline__ void glds16(const void*gsrc,unsigned lds_dst){unsigned keep;
  asm volatile("s_mov_b32 %0, m0\n\ts_mov_b32 m0, %2\n\ts_nop 0\n\tglobal_load_lds_dwordx4 %1, off\n\ts_mov_b32 m0, %0":"=&s"(keep):"v"(gsrc),"s"(lds_dst):"memory");}
__device__ __forceinline__ float max3f(float a,float b,float c){float r;asm("v_max3_f32 %0, %1, %2, %3":"=v"(r):"v"(a),"v"(b),"v"(c));return r;}
__device__ __forceinline__ float max2f(float a,float b){float r;asm("v_max_f32_e32 %0, %1, %2":"=v"(r):"v"(a),"v"(b));return r;}
__device__ __forceinline__ float fadd_s(float a,float b){float r;asm("v_add_f32_e32 %0, %1, %2":"=v"(r):"v"(a),"v"(b));return r;}
__device__ __forceinline__ float fsub_s(float a,float b){float r;asm("v_sub_f32_e32 %0, %1, %2":"=v"(r):"v"(a),"v"(b));return r;}
typedef float f32x2_t __attribute__((ext_vector_type(2))); typedef __bf16 bf16x2_t __attribute__((ext_vector_type(2)));
__device__ __forceinline__ unsigned cvtpk_s(float lo,float hi){f32x2_t v={lo,hi};bf16x2_t b=__builtin_convertvector(v,bf16x2_t);return __builtin_bit_cast(unsigned,b);}
#define WAIT_BAR(N) asm volatile("s_waitcnt vmcnt(" #N ") lgkmcnt(0)\n\ts_barrier":::"memory")

__device__ __forceinline__ void qkt(f32x16&p0,f32x16&p1,const char*Kslot,const bf16x8*qr,int r32,int hi){
  const char*kb=Kslot+hi*1024+r32*16;
  #pragma unroll
  for(int d0=0;d0<4;++d0){
    const bf16x8 b0=*reinterpret_cast<const bf16x8*>(kb+d0*2048);
    const bf16x8 b1=*reinterpret_cast<const bf16x8*>(kb+d0*2048+512);
    if(d0==0){p0=__builtin_amdgcn_mfma_f32_32x32x16_bf16(b0,qr[0],p0,0,0,0);p1=__builtin_amdgcn_mfma_f32_32x32x16_bf16(b1,qr[0],p1,0,0,0);}
    else{p0=__builtin_amdgcn_mfma_f32_32x32x16_bf16(b0,qr[d0],p0,0,0,0);p1=__builtin_amdgcn_mfma_f32_32x32x16_bf16(b1,qr[d0],p1,0,0,0);}}
}
typedef __attribute__((address_space(3))) const char* lds_cptr;
typedef short v4i16_t __attribute__((ext_vector_type(4)));
__device__ __forceinline__ void kload8(bf16x8*kf,lds_cptr kp){
  kf[0]=*(const __attribute__((address_space(3))) bf16x8*)(kp);      kf[1]=*(const __attribute__((address_space(3))) bf16x8*)(kp+512);
  kf[2]=*(const __attribute__((address_space(3))) bf16x8*)(kp+2048); kf[3]=*(const __attribute__((address_space(3))) bf16x8*)(kp+2560);
  kf[4]=*(const __attribute__((address_space(3))) bf16x8*)(kp+4096); kf[5]=*(const __attribute__((address_space(3))) bf16x8*)(kp+4608);
  kf[6]=*(const __attribute__((address_space(3))) bf16x8*)(kp+6144); kf[7]=*(const __attribute__((address_space(3))) bf16x8*)(kp+6656);
}
__device__ __forceinline__ void kload2(bf16x8*kf,lds_cptr kp,int j){ kf[2*j]=*(const __attribute__((address_space(3))) bf16x8*)(kp+j*2048); kf[2*j+1]=*(const __attribute__((address_space(3))) bf16x8*)(kp+j*2048+512); }
__device__ __forceinline__ s16x4 vtr(lds_cptr p){ return __builtin_bit_cast(s16x4,__builtin_amdgcn_ds_read_tr16_b64_v4i16((__attribute__((address_space(3))) v4i16_t*)p)); }
__device__ __forceinline__ float rowmax(const f32x16&p0,const f32x16&p1){
  float a=max3f(p0[0],p0[1],p1[0]),b=max3f(p0[2],p0[3],p1[1]);a=max3f(a,p1[2],p1[3]);
  #pragma unroll
  for(int r=4;r<16;r+=4){a=max3f(a,p0[r],p0[r+1]);b=max3f(b,p0[r+2],p0[r+3]);a=max3f(a,p1[r],p1[r+1]);b=max3f(b,p1[r+2],p1[r+3]);}
  const float m=max2f(a,b);
  auto rr=__builtin_amdgcn_permlane32_swap(__float_as_uint(m),__float_as_uint(m),false,false);
  return max2f(__uint_as_float(rr[0]),__uint_as_float(rr[1]));
}
__device__ __forceinline__ void pv(f32x16*o,int vb,bf16x8 pa0,bf16x8 pa1,bf16x8 pa2,bf16x8 pa3){
  #pragma unroll
  for(int d0=0;d0<2;++d0){s16x4 lo[4],hi[4];
    #pragma unroll
    for(int ks=0;ks<4;++ks){
      asm volatile("ds_read_b64_tr_b16 %0,%1 offset:%c2":"=&v"(lo[ks]):"v"(vb),"i"(d0*4096+ks*1024):"memory");
      asm volatile("ds_read_b64_tr_b16 %0,%1 offset:%c2":"=&v"(hi[ks]):"v"(vb),"i"(d0*4096+ks*1024+512):"memory");}
    asm volatile("s_waitcnt lgkmcnt(0)":::"memory");SBAR();
    #define PK(k) (bf16x8){lo[k][0],lo[k][1],lo[k][2],lo[k][3],hi[k][0],hi[k][1],hi[k][2],hi[k][3]}
    o[d0]=__builtin_amdgcn_mfma_f32_32x32x16_bf16(pa0,PK(0),o[d0],0,0,0);
    o[d0]=__builtin_amdgcn_mfma_f32_32x32x16_bf16(pa1,PK(1),o[d0],0,0,0);
    o[d0]=__builtin_amdgcn_mfma_f32_32x32x16_bf16(pa2,PK(2),o[d0],0,0,0);
    o[d0]=__builtin_amdgcn_mfma_f32_32x32x16_bf16(pa3,PK(3),o[d0],0,0,0);
    #undef PK
  }
}

#ifndef ATTN_STORE16
#define ATTN_STORE16(p,v) (*(u32x4*)(p)=(v))
#endif
typedef float f32x4_t __attribute__((ext_vector_type(4)));
#define NBLD(dst,off) dst=*(const __attribute__((address_space(3))) f32x4_t*)(tbn_+(off))
#define NBSUB(P,b,src) do{ P[(b)]=nmn_-src[0]; P[(b)+1]=nmn_-src[1]; P[(b)+2]=nmn_-src[2]; P[(b)+3]=nmn_-src[3]; }while(0)
#define NEXTB(P0,P1,tt) do{ const __attribute__((address_space(3))) float* tb_=tab3+(tt)*64+4*hi; const float nm_=-mhat; \
  _Pragma("unroll") for(int g_=0;g_<4;++g_){ const f32x4_t b0_=*(const __attribute__((address_space(3))) f32x4_t*)(tb_+8*g_); const f32x4_t b1_=*(const __attribute__((address_space(3))) f32x4_t*)(tb_+32+8*g_); \
    _Pragma("unroll") for(int j_=0;j_<4;++j_){ P0[4*g_+j_]=nm_-b0_[j_]; P1[4*g_+j_]=nm_-b1_[j_]; } } }while(0)
template<int THRL> __device__ __forceinline__ void attn_unit(int b,int h,int qb,int t0,const bf16*Q,const bf16*__restrict__ K,const bf16*__restrict__ V,bf16*O,const float*__restrict__ cumT,char*shm,int tab_off,int segp_off,unsigned*qctr){
  const int tid=threadIdx.x,lane=tid&63,r32=lane&31,hi=lane>>5; const int wid=__builtin_amdgcn_readfirstlane(tid>>6);
  const long rowbase=(long)b*SEQ; const int q0=qb*QB;
  const bf16*Qw=Q+(rowbase+q0+wid*QBLK)*DM+h*D;
  const bf16*Kh=K+(rowbase+(long)t0*KVBLK)*DM+h*D,*Vh=V+(rowbase+(long)t0*KVBLK)*DM+h*D;
  const unsigned lds0=(unsigned)(uintptr_t)shm;
  float*wsf=(float*)(shm+LDS_WS)+wid*64;
  const bf16*ksrc=Kh+(long)lane*DM+wid*8;
  const bf16*vsrc=Vh+(long)(16*(wid&3)+(lane>>2))*DM+(wid>>2)*32+(lane&3)*8;
  const unsigned kdst=lds0+LDS_K+wid*1024, vdst=lds0+LDS_V+wid*1024;
  #define DMA_K(t,slot) glds16(ksrc+(long)(t)*KVBLK*DM,(unsigned)__builtin_amdgcn_readfirstlane(kdst+(slot)))
  #define DMA_V(t,slot) glds16(vsrc+(long)(t)*KVBLK*DM,(unsigned)__builtin_amdgcn_readfirstlane(vdst+(slot)))
  const int vb0=(int)(lds0+LDS_V)+((lane>>4)&1)*32+(lane&3)*8+(4*hi+((lane&15)>>2))*64;
  const char*Kbase=shm+LDS_K; bf16x8 kf[8];
  const lds_cptr shm3=(lds_cptr)shm; const lds_cptr kp0=shm3+LDS_K+hi*1024+r32*16; const lds_cptr vp0=shm3+LDS_V+((lane>>4)&1)*32+(lane&3)*8+(4*hi+((lane&15)>>2))*64;
  const int NT=(q0+QB)/KVBLK-t0;
  const __attribute__((address_space(3))) float* tab3=(const __attribute__((address_space(3))) float*)(shm3+tab_off);
  { int tl_=threadIdx.x; asm volatile("":"+v"(tl_));
    float*tabw=(float*)(shm+tab_off); const float L2E=1.4426950408889634f;
    const float*cg=cumT+((long)(b*NHEAD+h))*SEQ; const float cref=cg[q0]*L2E;
    for(int i=tl_;i<NT*KVBLK;i+=NW*64){ const int kv=t0*KVBLK+i; tabw[i]=cg[kv]*L2E-cref; }
    asm volatile("s_waitcnt vmcnt(0) lgkmcnt(0)\n\ts_barrier":::"memory"); }
  DMA_K(0,0);DMA_V(0,0);DMA_K(1,SLOTB);
  bf16x8 qr[4];
  #pragma unroll
  for(int d0=0;d0<4;++d0)qr[d0]=*reinterpret_cast<const bf16x8*>(&Qw[(long)r32*DM+d0*16+hi*8]);
  float mhat=0.f,l_reg=0.f;f32x16 o[2];o[0]=f32x16{};o[1]=f32x16{};
  const int qrel=wid*QBLK+r32;
  #define CMASK(P0,P1,t) do{int jb_=(t)-(NT-4); if(jb_>=0)cmask(P0,P1,jb_,qrel,hi);}while(0)
  bool resc=false;
  #define START(P0,P1) do{ const float rm=rowmax(P0,P1); resc=false; \
    { const float dl=rm; mhat=fadd_s(mhat,dl); \
      _Pragma("unroll") for(int r=0;r<16;++r){P0[r]=fsub_s(P0[r],dl);P1[r]=fsub_s(P1[r],dl);} \
      } \
    _Pragma("unroll") for(int r=0;r<16;++r)P0[r]=__builtin_amdgcn_exp2f(P0[r]); }while(0)
  #define RESC() do{ if(resc){ asm volatile("s_waitcnt lgkmcnt(0)":::"memory"); \
      _Pragma("unroll") for(int d_=0;d_<2;++d_) _Pragma("unroll") for(int r=0;r<16;++r)o[d_][r]*=wsf[crow(r,hi)]; } }while(0)
  f32x16 pA0,pA1,pB0,pB1;
  int sl_prev=0,sl_cur=0,sl_next=SLOTB;
  #define ROT() do{sl_prev=sl_cur;sl_cur=sl_next;sl_next=(sl_next==(NSLOT-1)*SLOTB)?0:sl_next+SLOTB;}while(0)
  DMA_K(2,2*SLOTB);
  WAIT_BAR(3);
  NEXTB(pA0,pA1,0);
  qkt(pA0,pA1,Kbase,qr,r32,hi);asm volatile("s_nop 15\n\ts_nop 7":"+v"(pA0),"+v"(pA1));CMASK(pA0,pA1,0);
  START(pA0,pA1);
  NEXTB(pB0,pB1,1);
  _Pragma("unroll") for(int r=0;r<16;++r)pA1[r]=__builtin_amdgcn_exp2f(pA1[r]);
  WAIT_BAR(0);
  DMA_K(3,0);DMA_V(1,SLOTB);
  ROT();
  kload8(kf,kp0+sl_cur);
  WAIT_BAR(2);
  s16x4 vlo[8],vhi[8]; u32x4 pw0,pw1,pw2,pw3;
  #define PKW(P,B) cvtpk_s(P[B],P[B+1])
  #define PAF(k) __builtin_bit_cast(bf16x8,pw##k)
  #define VFR(i) (bf16x8){vlo[i][0],vlo[i][1],vlo[i][2],vlo[i][3],vhi[i][0],vhi[i][1],vhi[i][2],vhi[i][3]}
  #define PIN(x) asm volatile("":"+v"(x))
  #define MX3(a,b,c) __builtin_fmaxf(__builtin_fmaxf((a),(b)),(c))
  #define GAPA(MF,A0,A1,A2,A3,W0,W1,PW) do{ MF; sacc+=A0; sacc+=A1; sacc+=A2; sacc+=A3; PIN(sacc); W0; W1; PIN(PW); SBAR(); }while(0)
  #define EX(v) __builtin_amdgcn_exp2f(v)
  #define GAPB(MF,X,B) do{ MF; X[B]=EX(X[B]); X[B+1]=EX(X[B+1]); X[B+2]=EX(X[B+2]); X[B+3]=EX(X[B+3]); PIN(X); SBAR(); }while(0)
  #define VRD(i) do{ vlo[i]=vtr(vp_+(((i)>>2)*4096+((i)&3)*1024)); vhi[i]=vtr(vp_+(((i)>>2)*4096+((i)&3)*1024+512)); }while(0)
  #define KRD(G,j) do{ if(G){ kload2(kf,kp0+sl_next,j); SBAR(); } }while(0)
  #define STEP(C0,C1,P0,P1,t,GK,GV,GL) do{ SBAR(); \
    const lds_cptr vp_=vp0+sl_prev; \
    VRD(0); SBAR(); float sacc=(P0[0]+P0[1]); \
    GAPA(C0=__builtin_amdgcn_mfma_f32_32x32x16_bf16(kf[0],qr[0],C0,0,0,0), P0[2],P0[3],P0[4],P0[5],     pw0[0]=PKW(P0,0), pw0[1]=PKW(P0,2), pw0); \
    VRD(4); SBAR(); GAPA(C1=__builtin_amdgcn_mfma_f32_32x32x16_bf16(kf[1],qr[0],C1,0,0,0), P0[6],P0[7],P0[8],P0[9],     pw0[2]=PKW(P0,4), pw0[3]=PKW(P0,6), pw0); \
    VRD(1); SBAR(); GAPA(C0=__builtin_amdgcn_mfma_f32_32x32x16_bf16(kf[2],qr[1],C0,0,0,0),   P0[10],P0[11],P0[12],P0[13], pw1[0]=PKW(P0,8), pw1[1]=PKW(P0,10), pw1); \
    VRD(5); SBAR(); GAPA(C1=__builtin_amdgcn_mfma_f32_32x32x16_bf16(kf[3],qr[1],C1,0,0,0),   P0[14],P0[15],P1[0],P1[1],   pw1[2]=PKW(P0,12),pw1[3]=PKW(P0,14), pw1); \
    VRD(2); SBAR(); GAPA(C0=__builtin_amdgcn_mfma_f32_32x32x16_bf16(kf[4],qr[2],C0,0,0,0),   P1[2],P1[3],P1[4],P1[5],     pw2[0]=PKW(P1,0), pw2[1]=PKW(P1,2), pw2); \
    VRD(6); SBAR(); GAPA(C1=__builtin_amdgcn_mfma_f32_32x32x16_bf16(kf[5],qr[2],C1,0,0,0),   P1[6],P1[7],P1[8],P1[9],     pw2[2]=PKW(P1,4), pw2[3]=PKW(P1,6), pw2); \
    VRD(3); SBAR(); GAPA(C0=__builtin_amdgcn_mfma_f32_32x32x16_bf16(kf[6],qr[3],C0,0,0,0),   P1[10],P1[11],P1[12],P1[13], pw3[0]=PKW(P1,8), pw3[1]=PKW(P1,10), pw3); \
    VRD(7); SBAR(); GAPA(C1=__builtin_amdgcn_mfma_f32_32x32x16_bf16(kf[7],qr[3],C1,0,0,0),   P1[14],P1[15],0.f,0.f,       pw3[2]=PKW(P1,12),pw3[3]=PKW(P1,14), pw3); \
    l_reg+=sacc; \
    if(GK){DMA_K((t)+3,sl_cur);} if(GV){DMA_V((t)+1,sl_next);} \
    CMASK(C0,C1,t); \
    { float a=MX3(C0[0],C0[1],C1[0]),b=MX3(C0[2],C0[3],C1[1]); a=MX3(a,C1[2],C1[3]); \
      _Pragma("unroll") for(int r=4;r<16;r+=4){a=MX3(a,C0[r],C0[r+1]);b=MX3(b,C0[r+2],C0[r+3]);a=MX3(a,C1[r],C1[r+1]);b=MX3(b,C1[r+2],C1[r+3]);} \
      float rm=__builtin_fmaxf(a,b); { auto rr=__builtin_amdgcn_permlane32_swap(__float_as_uint(rm),__float_as_uint(rm),false,false); rm=__builtin_fmaxf(__uint_as_float(rr[0]),__uint_as_float(rr[1])); } \
      resc=false; \
      if(__builtin_expect(__any(rm>(float)THRL),0)){ const float dl=__builtin_fmaxf(rm,0.f); mhat+=dl; \
        _Pragma("unroll") for(int r=0;r<16;++r){C0[r]-=dl;C1[r]-=dl;} \
        const float f=__builtin_amdgcn_exp2f(-dl); l_reg*=f; if(hi==0)wsf[r32]=f; resc=true; } } \
      \
    const __attribute__((address_space(3))) float* tbn_=tab3+((t)+1)*64+4*hi; const float nmn_=-mhat; f32x4_t nbA_,nbB_; \
    SBAR(); \
    if(GL){NBLD(nbA_,0);} GAPB(o[0]=__builtin_amdgcn_mfma_f32_32x32x16_bf16(PAF(0),VFR(0),o[0],0,0,0), C0,0); \
    if(GL){NBLD(nbB_,8); NBSUB(P0,0,nbA_);} GAPB(o[1]=__builtin_amdgcn_mfma_f32_32x32x16_bf16(PAF(0),VFR(4),o[1],0,0,0), C0,4); \
    if(GL){NBLD(nbA_,16); NBSUB(P0,4,nbB_);} KRD(GL,0); GAPB(o[0]=__builtin_amdgcn_mfma_f32_32x32x16_bf16(PAF(1),VFR(1),o[0],0,0,0), C0,8); \
    if(GL){NBLD(nbB_,24); NBSUB(P0,8,nbA_);} KRD(GL,1); GAPB(o[1]=__builtin_amdgcn_mfma_f32_32x32x16_bf16(PAF(1),VFR(5),o[1],0,0,0), C0,12); \
    if(GL){NBLD(nbA_,32); NBSUB(P0,12,nbB_);} KRD(GL,2); GAPB(o[0]=__builtin_amdgcn_mfma_f32_32x32x16_bf16(PAF(2),VFR(2),o[0],0,0,0), C1,0); \
    if(GL){NBLD(nbB_,40); NBSUB(P1,0,nbA_);} KRD(GL,3); GAPB(o[1]=__builtin_amdgcn_mfma_f32_32x32x16_bf16(PAF(2),VFR(6),o[1],0,0,0), C1,4); \
    if(GL){NBLD(nbA_,48); NBSUB(P1,4,nbB_);} GAPB(o[0]=__builtin_amdgcn_mfma_f32_32x32x16_bf16(PAF(3),VFR(3),o[0],0,0,0), C1,8); \
    if(GL){NBLD(nbB_,56); NBSUB(P1,8,nbA_);} GAPB(o[1]=__builtin_amdgcn_mfma_f32_32x32x16_bf16(PAF(3),VFR(7),o[1],0,0,0), C1,12); \
    if(GL){NBSUB(P1,12,nbB_);} \
    }while(0)
  int t=1;
  #undef CMASK
  #define CMASK(P0,P1,t) do{}while(0)
  for(;t+5<NT;t+=2){
    STEP(pB0,pB1,pA0,pA1,t,true,true,true);     WAIT_BAR(2); RESC(); ROT();
    STEP(pA0,pA1,pB0,pB1,t+1,true,true,true);   WAIT_BAR(2); RESC(); ROT();
  }
  #undef CMASK
  #define CMASK(P0,P1,t) do{int jb_=(t)-(NT-4); if(jb_>=0)cmask(P0,P1,jb_,qrel,hi);}while(0)
  #define ENDW(tt) do{ if((tt)+3<NT){WAIT_BAR(2);} else if((tt)+2<NT){WAIT_BAR(1);} else {WAIT_BAR(0);} }while(0)
  for(;t+1<NT;t+=2){
    STEP(pB0,pB1,pA0,pA1,t,(t+3<NT),(t+1<NT),(t+1<NT));       ENDW(t);   RESC(); ROT();
    STEP(pA0,pA1,pB0,pB1,t+1,(t+4<NT),(t+2<NT),(t+2<NT));     ENDW(t+1); RESC(); ROT();
  }
  STEP(pB0,pB1,pA0,pA1,NT-1,false,false,false); RESC();
  { float sacc=pB0[0]+pB0[1]; _Pragma("unroll") for(int r=2;r<16;++r)sacc+=pB0[r]; _Pragma("unroll") for(int r=0;r<16;++r)sacc+=pB1[r]; l_reg+=sacc;
    pw0=(u32x4){PKW(pB0,0),PKW(pB0,2),PKW(pB0,4),PKW(pB0,6)};pw1=(u32x4){PKW(pB0,8),PKW(pB0,10),PKW(pB0,12),PKW(pB0,14)};pw2=(u32x4){PKW(pB1,0),PKW(pB1,2),PKW(pB1,4),PKW(pB1,6)};pw3=(u32x4){PKW(pB1,8),PKW(pB1,10),PKW(pB1,12),PKW(pB1,14)};
    SBAR(); pv(o,vb0+sl_cur,PAF(0),PAF(1),PAF(2),PAF(3)); }
  #undef PKW
  #undef PAF
  #undef VFR
  #undef PIN
  #undef MX3
  #undef GAPA
  #undef GAPB
  #undef EX
  #undef VRD
  #undef KRD
  #undef STEP
  #undef ENDW
  {auto rr=__builtin_amdgcn_permlane32_swap(__float_as_uint(l_reg),__float_as_uint(l_reg),false,false);l_reg=__uint_as_float(rr[0])+__uint_as_float(rr[1]);}
  int un_=0; if(threadIdx.x==0)un_=(int)__hip_atomic_fetch_add(qctr,1u,__ATOMIC_RELAXED,__HIP_MEMORY_SCOPE_AGENT);
  int lane_e=threadIdx.x&63; asm volatile("":"+v"(lane_e));
  const int r32e=lane_e&31,hie=lane_e>>5;
  if(hie==0)wsf[32+r32e]=l_reg;asm volatile("s_waitcnt lgkmcnt(0)":::"memory");
  float rli[16];
  #pragma unroll
  for(int r=0;r<16;++r)rli[r]=__builtin_amdgcn_rcpf(wsf[32+crow(r,hie)]);
  bf16*Ow=O+(rowbase+q0+wid*QBLK)*DM+h*D;
  { bf16*stg=(bf16*)(shm+LDS_OST)+wid*2048;
    #pragma unroll
    for(int r=0;r<16;++r){const int orow=crow(r,hie);
      #pragma unroll
      for(int d0=0;d0<2;++d0)stg[orow*64+d0*32+r32e]=__float2bfloat16(o[d0][r]*rli[r]);}
    asm volatile("s_waitcnt lgkmcnt(0)":::"memory");
    #pragma unroll
    for(int i=0;i<4;++i){const int row=i*8+(lane_e>>3),ch=lane_e&7; const u32x4 v=*(const u32x4*)(stg+row*64+ch*8); ATTN_STORE16(Ow+(long)row*DM+ch*8,v);} }
  if(threadIdx.x==0)*(volatile int*)(shm+segp_off)=un_;
  asm volatile("s_waitcnt lgkmcnt(0)\n\ts_barrier":::"memory");
  #undef DMA_K
  #undef DMA_V
  #undef CMASK
  #undef START
  #undef RESC
  #undef ROT
}
constexpr int ATTN_LDS_BYTES=LDS_BYTES;
struct AttnTensors { const bf16* Q; const bf16* K; const bf16* V; bf16* O; const float* cumT; const float* segtot; };
struct AttnUnit { int bh; int qb; };
struct StaticOrder {
  int vcu;
  __device__ __forceinline__ explicit StaticOrder(int grid,int block):vcu((block%8)*(grid/8)+block/8){}
  __device__ __forceinline__ bool next(int i,AttnUnit&u)const{ if(i>=4||vcu>=256)return false; const int s=vcu&15; u.bh=vcu>>4; u.qb=(i==0)?63-s:(i==1)?32+s:(i==2)?31-s:s; return true; }
  __device__ __forceinline__ void a_ready(const AttnUnit&)const{}
  __device__ __forceinline__ void done(const AttnUnit&)const{}
};
constexpr float PRUNE_THR=20.0f;
template<int THRL=8> __device__ __forceinline__ void attn_phase_dyn(char*lds,const AttnTensors&T,unsigned*ctr,const unsigned*qkmax,int tab_off,int segp_off){
  volatile int*slot=(volatile int*)(lds+segp_off);
  __syncthreads();
  if(threadIdx.x==0)slot[0]=(int)__hip_atomic_fetch_add(ctr,1u,__ATOMIC_RELAXED,__HIP_MEMORY_SCOPE_AGENT);
  __syncthreads();
  for(;;){
    int tid=threadIdx.x; asm volatile("":"+v"(tid));
    const int u=slot[0]; if(u>=BATCH*NHEAD*NQB)break;
    const int bh=u&15, qb=(NQB-1)-(u>>4), b=bh/NHEAD, h=bh%NHEAD, q0=qb*QB;
    const float qm=__uint_as_float(qkmax[bh*2]), km=__uint_as_float(qkmax[bh*2+1]);
    const float L2E=1.4426950408889634f; const float*cg=T.cumT+((long)(b*NHEAD+h))*SEQ;
    const float cgk=cg[(tid<4*qb)?64*tid+63:q0], cg0=cg[q0];
    float dg, qg;
    { const int row=tid>>1, hf=tid&1; const long ro=((long)b*SEQ+q0+row)*DM+h*D+32*hf; const u32x4*qp=(const u32x4*)(T.Q+ro); const u32x4*kp=(const u32x4*)(T.K+ro); float d=0.f, qq=0.f;
      #pragma unroll
      for(int c4=0;c4<4;++c4){ const u32x4 qa=qp[c4], ka=kp[c4];
        #pragma unroll
        for(int e=0;e<4;++e){ const float q0_=__uint_as_float(qa[e]<<16), q1_=__uint_as_float(qa[e]&0xffff0000u); d+=q0_*__uint_as_float(ka[e]<<16)+q1_*__uint_as_float(ka[e]&0xffff0000u); qq+=q0_*q0_+q1_*q1_; } }
      d+=__shfl_xor(d,1); qq+=__shfl_xor(qq,1);
      #pragma unroll
      for(int o=2;o<64;o<<=1){ d=fminf(d,__shfl_xor(d,o)); qq=fmaxf(qq,__shfl_xor(qq,o)); }
      dg=d; qg=qq; }
    float*slotf=(float*)(lds+segp_off)+16;
    if((tid&63)==0){ slotf[tid>>6]=dg; slotf[8+(tid>>6)]=qg; }
    __syncthreads();
    float dmin=slotf[0], qmu=slotf[8];
    #pragma unroll
    for(int w=1;w<NW;++w){ dmin=fminf(dmin,slotf[w]); qmu=fmaxf(qmu,slotf[8+w]); }
    (void)qm;
    const float X=PRUNE_THR+sqrtf(qmu*km)-dmin+1.5f;
    const bool skip=(tid<4*qb)&&((cgk-cg0)*L2E>X);
    const unsigned long long bal=__ballot(skip); if((tid&63)==0)slot[1+(tid>>6)]=__popcll(bal);
    __syncthreads();
    int t0=0;
    #pragma unroll
    for(int w=0;w<NW;++w)t0+=slot[1+w];
    t0&=~1;
    attn_unit<THRL>(b,h,qb,t0,T.Q,T.K,T.V,T.O,T.cumT,lds,tab_off,segp_off,ctr);
  }
}
#undef SBAR
#undef WAIT_BAR
}
#define GAS __attribute__((address_space(1)))
#define LAS __attribute__((address_space(3)))
typedef unsigned short bf16;
typedef unsigned v4u __attribute__((ext_vector_type(4)));
typedef float f32x4 __attribute__((ext_vector_type(4)));
typedef short bf16x8 __attribute__((ext_vector_type(8)));
typedef GAS unsigned gu32;
typedef GAS unsigned long long gu64;
#define RLX_AGENT __ATOMIC_RELAXED, __HIP_MEMORY_SCOPE_AGENT
#define LDS_WAIT() asm volatile("s_waitcnt lgkmcnt(0)" ::: "memory")
#define VM_WAIT() asm volatile("s_waitcnt vmcnt(0)" ::: "memory")
__device__ __forceinline__ unsigned long long rt() { return __builtin_amdgcn_s_memrealtime(); }
typedef float pk_f32x2 __attribute__((ext_vector_type(2))); typedef __bf16 pk_bf16x2 __attribute__((ext_vector_type(2)));
__device__ __forceinline__ unsigned pk2(float lo, float hi) { pk_f32x2 v = {lo, hi}; pk_bf16x2 b = __builtin_convertvector(v, pk_bf16x2); return __builtin_bit_cast(unsigned, b); }
__device__ __forceinline__ unsigned f2bf(float f) { return pk2(f, 0.f) & 0xffffu; }

#define XB_TMO      128
#define XB_XCNT(j)  (256  + 64 * (j))
#define XB_XSUB(j)  (1280 + 64 * (j))
#define XB_XGEN(j)  (2304 + 64 * (j))
#define XB_TOP      3328
#define XB_TOPGEN   3392
#define XCD_BAR_WORDS 3456
#define XB_SPIN_CAP (1u << 18)

__device__ __forceinline__ unsigned xb_ld(unsigned* p)              { return __hip_atomic_load(p, __ATOMIC_RELAXED, __HIP_MEMORY_SCOPE_AGENT); }
__device__ __forceinline__ unsigned xb_add(unsigned* p, unsigned v) { return __hip_atomic_fetch_add(p, v, __ATOMIC_RELAXED, __HIP_MEMORY_SCOPE_AGENT); }
__device__ __forceinline__ unsigned xb_xcc_id() { return (unsigned)__builtin_amdgcn_s_getreg((3 << 11) | 20) & 0xFu; }
#define XB_SPIN(cond, bar) do { unsigned _sp = 0; while (cond) { __builtin_amdgcn_s_sleep(1); \
    if ((++_sp & 255u) == 0u) { if (xb_ld(&(bar)[XB_TMO])) break; if (_sp > XB_SPIN_CAP) { atomicAdd(&(bar)[XB_TMO], 1u); break; } } } } while (0)

struct XcdBarrier {
    unsigned* bar; unsigned x;
    volatile LAS unsigned* st;
};

__device__ __forceinline__ XcdBarrier xcd_barrier_post(unsigned* bar, volatile LAS unsigned* st) {
    XcdBarrier b; b.bar = bar; b.x = xb_xcc_id(); b.st = st;
    if (threadIdx.x == 0) (void)xb_add(&bar[XB_XCNT(b.x)], 1u);
    return b;
}
__device__ __forceinline__ void xcd_barrier_complete(unsigned* bar, unsigned x, unsigned& nloc, unsigned& nx) {
    const unsigned G = gridDim.x * gridDim.y * gridDim.z;
    unsigned sum, cnt, mine, sp = 0u;
    for (;;) {
        sum = 0u; cnt = 0u; mine = 0u;
#pragma unroll
        for (unsigned j = 0; j < 16; ++j) { const unsigned c = xb_ld(&bar[XB_XCNT(j)]); sum += c; cnt += (c > 0u) ? 1u : 0u; mine = (j == x) ? c : mine; }
        if (sum == G) break;
        __builtin_amdgcn_s_sleep(1);
        if ((++sp & 255u) == 0u) { if (xb_ld(&bar[XB_TMO])) break; if (sp > XB_SPIN_CAP) { atomicAdd(&bar[XB_TMO], 1u); break; } }
    }
    nloc = mine > 0u ? mine : 1u; nx = cnt > 0u ? cnt : 1u;
}

__device__ __forceinline__ void xcd_barrier(const XcdBarrier& b) {
    asm volatile("s_waitcnt vmcnt(0)" ::: "memory");
    __syncthreads();
    if (threadIdx.x == 0) {
        unsigned* bar = b.bar;
        __builtin_amdgcn_s_waitcnt(0);
        unsigned nloc = b.st[0], nx = b.st[1];
        if (nloc == 0u) { xcd_barrier_complete(bar, b.x, nloc, nx); b.st[0] = nloc; b.st[1] = nx; }
        const unsigned old = xb_add(&bar[XB_XSUB(b.x)], 1u);
        const unsigned gen = old / nloc;
        if (old + 1u == (gen + 1u) * nloc) {
            __builtin_amdgcn_fence(__ATOMIC_RELEASE, "agent");
            asm volatile("s_waitcnt vmcnt(0)" ::: "memory");
            const unsigned og = xb_add(&bar[XB_TOP], 1u);
            const unsigned tg = og / nx;
            if (og + 1u == (tg + 1u) * nx) xb_add(&bar[XB_TOPGEN], 1u);
            else XB_SPIN(xb_ld(&bar[XB_TOPGEN]) == tg, bar);
            __builtin_amdgcn_fence(__ATOMIC_ACQUIRE, "agent");
            xb_add(&bar[XB_XGEN(b.x)], 1u);
            asm volatile("s_waitcnt vmcnt(0)" ::: "memory");
        } else {
            XB_SPIN(xb_ld(&bar[XB_XGEN(b.x)]) == gen, bar);
            __builtin_amdgcn_fence(__ATOMIC_ACQUIRE, "agent");
            asm volatile("s_waitcnt vmcnt(0)" ::: "memory");
        }
    }
    __syncthreads();
}

constexpr int NWAVES = 8;
constexpr int BATCH = 2, SEQ = 16384, D = 1024, M = BATCH * SEQ;
constexpr int FH = 8, FW = 512, RWW = 512, SHW = 1792, DIN = 5384, NIN = 5376;
constexpr int NE = 32, DE = 512, NROUTE = 36;
constexpr int MAXSLOT = 2 * M + NE * 256;
constexpr int MAXTILE = MAXSLOT / 256;
constexpr float ATT_C2 = 0.125f * 1.4426950408889634f;

constexpr size_t MiB = 1u << 20;
constexpr size_t WS_CTL = 0, CTL_ZERO_BYTES = 1 * MiB;
constexpr size_t WS_MOD = 1 * MiB;
constexpr size_t WS_SEGTOT = 1 * MiB + 64 * 1024;
constexpr size_t WS_BLKCNT = 1 * MiB + 96 * 1024;
constexpr size_t WS_WIN = 2 * MiB;
constexpr size_t WS_WOF = 13 * MiB, WS_WOR = 14 * MiB, WS_WO = 15 * MiB;
constexpr size_t WS_LW2 = 17 * MiB, WS_LA2 = 17 * MiB + 64 * 1024, WS_LG2 = 17 * MiB + 128 * 1024;
constexpr size_t WS_CUM = 18 * MiB;
constexpr size_t WS_ROUTE = 19 * MiB;
constexpr size_t WS_ROWTOK = 20 * MiB;
constexpr size_t WS_BON = 21 * MiB;
constexpr size_t WS_XN = 24 * MiB;
constexpr size_t WS_Q = 88 * MiB, WS_K = 120 * MiB, WS_V = 152 * MiB;
constexpr size_t WS_PRW = 184 * MiB;
constexpr size_t WS_GATES = 296 * MiB;
constexpr size_t WS_F = 424 * MiB;
constexpr size_t WS_END = 512 * MiB;
constexpr size_t WS_Y = WS_K;
constexpr size_t WS_H = WS_Q;
constexpr size_t WS_W13 = WS_PRW, WS_W2T = WS_PRW + 64 * MiB;
constexpr size_t WS_TMP = WS_PRW;
constexpr size_t WS_YM = 280 * MiB;
constexpr size_t WS_X1 = 424 * MiB;
static_assert(WS_YM + (size_t)MAXSLOT * 1024 * 2 <= WS_END, "ws map");
static_assert(WS_H + (size_t)MAXSLOT * 512 * 2 <= WS_PRW, "ws map");
constexpr int CW_TMO = 0, CW_CODE = 1;
constexpr int CW_BAR = 4096;
constexpr int CW_QKMAX = 8192;
constexpr int CW_QUEUE = 8448;
constexpr int CW_DIAG = 8704;

constexpr int RING_OFF = 0, RING_BYTES = 131072;
constexpr int TAB_OFF = 83968;
constexpr int SEGP_OFF = TAB_OFF + 65536;
constexpr int TILE_OFF = 131072;
constexpr int LDSCTL_OFF = SEGP_OFF + 512, MISC_OFF = LDSCTL_OFF + 320;
constexpr int LDS_BYTES = LDSCTL_OFF + 512;
static_assert(attn_body::LDS_BYTES <= TAB_OFF, "attention LDS");


#define PHASE_IDS() int tid_ = threadIdx.x; asm volatile("" : "+v"(tid_)); const int lane_ = tid_ & 63; const int wave_ = __builtin_amdgcn_readfirstlane(tid_ >> 6); (void)lane_; (void)wave_
struct Frame {
    LAS unsigned char* lds;
    volatile LAS unsigned* MISC;
    gu32* ctl;
    int tid, lane, wave;
    int vcu, G;
    const float* const* in;
};
template <int CTRL> __device__ __forceinline__ float dpp_f(float v) { return __int_as_float(__builtin_amdgcn_mov_dpp(__float_as_int(v), CTRL, 0xf, 0xf, true)); }
__device__ __forceinline__ float row_sum16(float v) { v += dpp_f<0xB1>(v); v += dpp_f<0x4E>(v); v += dpp_f<0x141>(v); v += dpp_f<0x140>(v); return v; }
__device__ __forceinline__ float wave_sum(float v) { v = row_sum16(v); v += __shfl_xor(v, 16); v += __shfl_xor(v, 32); return v; }
__device__ __forceinline__ float bflo(unsigned w) { return __uint_as_float(w << 16); }
__device__ __forceinline__ float bfhi(unsigned w) { return __uint_as_float(w & 0xffff0000u); }
__device__ __forceinline__ float sigm(float x) { return 1.0f / (1.0f + __expf(-x)); }

__device__ __forceinline__ void transpose_item(const float* W, int ld, int col, int k0, int K, bf16* WT, size_t drow, LAS float* scr, int lane) {
#pragma unroll 8
    for (int i = 0; i < 32; ++i) { const int kk = 2 * i + (lane >> 5); scr[kk * 33 + (lane & 31)] = W[(size_t)(k0 + kk) * ld + col + (lane & 31)]; }
    LDS_WAIT(); asm volatile("" ::: "memory");
    const int c = lane & 7;
#pragma unroll
    for (int j = 0; j < 4; ++j) { const int n = (lane >> 3) + 8 * j; const LAS float* s = scr + (8 * c) * 33 + n;
        v4u o; o.x = pk2(s[0 * 33], s[1 * 33]); o.y = pk2(s[2 * 33], s[3 * 33]); o.z = pk2(s[4 * 33], s[5 * 33]); o.w = pk2(s[6 * 33], s[7 * 33]);
        *(GAS v4u*)(WT + (drow + n) * K + k0 + 8 * c) = o; }
    LDS_WAIT(); asm volatile("" ::: "memory");
}
__device__ __forceinline__ void conv_seg(Frame& F, const float* W, int ld, int col0, int K, int ncols, bf16* WT, size_t drow0) {
    PHASE_IDS();
    LAS float* scr = (LAS float*)(F.lds + RING_OFF + wave_ * 16384);
    const int gw = F.vcu * NWAVES + wave_, NGW = F.G * NWAVES, nkb = K / 64, nnb = ncols / 32;
    for (int it = gw; it < nkb * nnb; it += NGW) { const int kb = it / nnb, nb = it % nnb; transpose_item(W, ld, col0 + 32 * nb, 64 * kb, K, WT, drow0 + 32 * nb, scr, lane_); }
}

struct Args { const float* in[30]; float* out; unsigned char* ws; };

__device__ __forceinline__ void p0_prologue(Frame& F, const Args& A) {
    PHASE_IDS();
    unsigned char* ws = A.ws;
    if (blockIdx.x < 96) {
        const float* c = A.in[1]; const float* aw = A.in[2]; const float* ab = A.in[3];
        const int col = blockIdx.x * 64 + lane_; float a0 = 0.f, a1 = 0.f;
        const int kbeg = wave_ * 128;
#pragma unroll 8
        for (int k = kbeg; k < kbeg + 128; ++k) { const float wv = aw[(size_t)k * 6144 + col]; const float c0 = c[k], c1 = c[1024 + k];
            a0 += c0 * sigm(c0) * wv; a1 += c1 * sigm(c1) * wv; }
        LAS float* red = (LAS float*)(F.lds + 8 * 16384 - 4096);
        red[(wave_ * 2 + 0) * 64 + lane_] = a0; red[(wave_ * 2 + 1) * 64 + lane_] = a1;
        __syncthreads();
        if (wave_ < 2) { float s = 0.f;
#pragma unroll
            for (int w = 0; w < 8; ++w) s += red[(w * 2 + wave_) * 64 + lane_];
            ((float*)(ws + WS_MOD))[wave_ * 6144 + col] = s + ab[col]; }
        __syncthreads();
    }
}

__device__ __forceinline__ void p_convert_early(Frame& F, const Args& A) {
    unsigned char* ws = A.ws;
    const float* w_in = A.in[5];
    conv_seg(F, w_in, DIN, 0, 1024, 1536, (bf16*)(ws + WS_WIN), 0);
    conv_seg(F, w_in, DIN, 1544, 1024, 1792, (bf16*)(ws + WS_WIN), 1536);
    conv_seg(F, w_in, DIN, 3336, 1024, 2048, (bf16*)(ws + WS_WIN), 3328);
    conv_seg(F, A.in[18], 1024, 0, 512, 1024, (bf16*)(ws + WS_WOF), 0);
    conv_seg(F, A.in[19], 1024, 0, 512, 1024, (bf16*)(ws + WS_WOR), 0);
    conv_seg(F, A.in[20], 1024, 0, 1024, 1024, (bf16*)(ws + WS_WO), 0);
    conv_seg(F, A.in[9], 512, 0, 64, 512, (bf16*)(ws + WS_LW2), 0);
    conv_seg(F, A.in[11], 512, 0, 64, 512, (bf16*)(ws + WS_LA2), 0);
    conv_seg(F, A.in[12], 512, 0, 128, 512, (bf16*)(ws + WS_LG2), 0);
}

__device__ __forceinline__ void p1_norm(Frame& F, const Args& A) {
    PHASE_IDS();
    unsigned char* ws = A.ws;
    LAS float* wf = (LAS float*)(F.lds);
    LAS float* lfl = (LAS float*)(F.lds + 32768);
    LAS float* part = (LAS float*)(F.lds + 32768 + 4096);
    const float* x = A.in[0]; const float* g1 = A.in[4]; const float* w_in = A.in[5]; const float* fb = A.in[6];
    const float* mod = (const float*)(ws + WS_MOD);
    bf16* XN = (bf16*)(ws + WS_XN); float* cumT = (float*)(ws + WS_CUM); float* segtot = (float*)(ws + WS_SEGTOT);
    for (int i = tid_; i < 8192; i += NWAVES * 64) wf[(i & 7) * 1024 + (i >> 3)] = w_in[(size_t)(i >> 3) * DIN + 1536 + (i & 7)];
    __syncthreads();
    for (int blk = blockIdx.x; blk < M / 128; blk += F.G) {
        const int b = blk / (SEQ / 128);
        f32x4 gm[4], sh[4];
#pragma unroll
        for (int j = 0; j < 4; ++j) { const int col = 4 * lane_ + 256 * j; const f32x4 g = *(const f32x4*)(g1 + col), sc = *(const f32x4*)(mod + b * 6144 + 1024 + col);
            gm[j] = g * (sc + 1.0f); sh[j] = *(const f32x4*)(mod + b * 6144 + col); }
        float fbv = fb[((lane_ >> 5) & 1) * 4 + ((lane_ >> 4) & 1) * 2 + ((lane_ >> 3) & 1)];
        f32x4 nv[4];
        { const GAS f32x4* xr0 = (const GAS f32x4*)(x + ((size_t)blk * 128 + wave_ * 16) * D) + lane_;
#pragma unroll
          for (int j = 0; j < 4; ++j) nv[j] = xr0[64 * j]; }
        for (int i = 0; i < 16; ++i) {
            const int tl = wave_ * 16 + i; const size_t tok = (size_t)blk * 128 + tl;
            f32x4 v[4]; float s = 0.f;
#pragma unroll
            for (int j = 0; j < 4; ++j) { v[j] = nv[j]; s += (v[j].x * v[j].x + v[j].y * v[j].y) + (v[j].z * v[j].z + v[j].w * v[j].w); }
            if (i + 1 < 16) { const GAS f32x4* xr = (const GAS f32x4*)(x + (tok + 1) * D) + lane_;
#pragma unroll
                for (int j = 0; j < 4; ++j) nv[j] = xr[64 * j]; }
            const float rstd = 1.0f / sqrtf(wave_sum(s) * (1.f / D) + 1e-6f);
            GAS unsigned long long* o8 = (GAS unsigned long long*)(XN + tok * D) + lane_;
            float f[8];
#pragma unroll
            for (int hh = 0; hh < 8; ++hh) f[hh] = 0.f;
#pragma unroll
            for (int j = 0; j < 4; ++j) { v[j] = v[j] * rstd * gm[j] + sh[j];
                o8[64 * j] = (unsigned long long)pk2(v[j].x, v[j].y) | ((unsigned long long)pk2(v[j].z, v[j].w) << 32);
#pragma unroll
                for (int hh = 0; hh < 8; ++hh) { const f32x4 w4 = *(const LAS f32x4*)(wf + hh * 1024 + 4 * lane_ + 256 * j); f[hh] += (v[j].x * w4.x + v[j].y * w4.y) + (v[j].z * w4.z + v[j].w * w4.w); } }
            float g4[4], g2v[2], z;
            { const bool up = (lane_ & 32) != 0;
#pragma unroll
              for (int i = 0; i < 4; ++i) { const float keep = up ? f[4 + i] : f[i], send = up ? f[i] : f[4 + i]; g4[i] = keep + __shfl_xor(send, 32); } }
            { const bool up = (lane_ & 16) != 0;
#pragma unroll
              for (int i = 0; i < 2; ++i) { const float keep = up ? g4[2 + i] : g4[i], send = up ? g4[i] : g4[2 + i]; g2v[i] = keep + __shfl_xor(send, 16); } }
            { const bool up = (lane_ & 8) != 0; const float keep = up ? g2v[1] : g2v[0], send = up ? g2v[0] : g2v[1]; z = keep + __shfl_xor(send, 8); }
            z += __shfl_xor(z, 1); z += __shfl_xor(z, 2); z += __shfl_xor(z, 4);
            const int myh = ((lane_ >> 5) & 1) * 4 + ((lane_ >> 4) & 1) * 2 + ((lane_ >> 3) & 1);
            z += fbv;
            const float lf = (z >= 0.f) ? -log1pf(__expf(-z)) : z - log1pf(__expf(z));
            if ((lane_ & 7) == 0) lfl[tl * 8 + myh] = lf;
        }
        __syncthreads();
        const int hh = tid_ & 7, p = tid_ >> 3;
        if (tid_ < 64) { float run = 0.f; for (int i = 0; i < 16; ++i) { run += lfl[(p * 16 + i) * 8 + hh]; lfl[(p * 16 + i) * 8 + hh] = run; } part[p * 8 + hh] = run; }
        __syncthreads();
        if (tid_ < 64) { float off = 0.f; for (int q = 0; q < p; ++q) off += part[q * 8 + hh];
            const int t0 = (blk % (SEQ / 128)) * 128 + p * 16; float* dst = cumT + ((size_t)(b * 8 + hh)) * SEQ + t0;
            for (int i = 0; i < 16; ++i) dst[i] = lfl[(p * 16 + i) * 8 + hh] + off;
            if (p == 7) segtot[blk * 8 + hh] = off + part[7 * 8 + hh]; }
        __syncthreads();
    }
}


__device__ __forceinline__ void p_cumfix(Frame& F, const Args& A) {
    PHASE_IDS();
    unsigned char* ws = A.ws; float* cumT = (float*)(ws + WS_CUM); const float* segtot = (const float*)(ws + WS_SEGTOT);
    LAS float* pre = (LAS float*)(F.lds);
    for (int blk = blockIdx.x; blk < M / 128; blk += F.G) {
        const int b = blk / (SEQ / 128), seg = blk % (SEQ / 128);
        __syncthreads();
        if (tid_ < 64) { const int hh = tid_ & 7, part = tid_ >> 3; float a = 0.f; for (int s = part; s < seg; s += 8) a += segtot[(b * 128 + s) * 8 + hh];
            a += __shfl_xor(a, 8); a += __shfl_xor(a, 16); a += __shfl_xor(a, 32); if (part == 0) pre[hh] = a; }
        __syncthreads();
        for (int i = tid_; i < 8 * 128; i += NWAVES * 64) { const int hh = i >> 7, t = i & 127; cumT[((size_t)(b * 8 + hh)) * SEQ + seg * 128 + t] += pre[hh]; }
    }
}
__device__ __forceinline__ void p_qknorm(Frame& F, const Args& A, unsigned* qkmax) {
    PHASE_IDS();
    unsigned char* ws = A.ws; const bf16* Q = (const bf16*)(ws + WS_Q); const bf16* K = (const bf16*)(ws + WS_K);
    const int gw = F.vcu * NWAVES + wave_, NGW = F.G * NWAVES, hd = lane_ >> 3;
    float mq[2] = {0.f, 0.f}, mk[2] = {0.f, 0.f};
    for (int m = gw; m < M; m += NGW) { const int b = m / SEQ;
        const v4u qw = *(const v4u*)(Q + (size_t)m * 512 + 8 * lane_), kw = *(const v4u*)(K + (size_t)m * 512 + 8 * lane_);
        float sq = 0.f, sk = 0.f;
#pragma unroll
        for (int e = 0; e < 4; ++e) { const float a = bflo(qw[e]), c = bfhi(qw[e]), d = bflo(kw[e]), f = bfhi(kw[e]); sq += a * a + c * c; sk += d * d + f * f; }
        sq += __shfl_xor(sq, 1); sq += __shfl_xor(sq, 2); sq += __shfl_xor(sq, 4); sk += __shfl_xor(sk, 1); sk += __shfl_xor(sk, 2); sk += __shfl_xor(sk, 4);
        if (b == 0) { mq[0] = fmaxf(mq[0], sq); mk[0] = fmaxf(mk[0], sk); } else { mq[1] = fmaxf(mq[1], sq); mk[1] = fmaxf(mk[1], sk); } }
    if ((lane_ & 7) == 0) {
#pragma unroll
        for (int b = 0; b < 2; ++b) { if (mq[b] > 0.f) atomicMax(qkmax + (b * 8 + hd) * 2, __float_as_uint(mq[b])); if (mk[b] > 0.f) atomicMax(qkmax + (b * 8 + hd) * 2 + 1, __float_as_uint(mk[b])); } }
}

template <int WITH_MOE>
__device__ __forceinline__ void p_final(Frame& F, const Args& A, const float* src) {
    PHASE_IDS();
    unsigned char* ws = A.ws; const float* fg = A.in[29]; const float* mod = (const float*)(ws + WS_MOD);
    const int* route = (const int*)(ws + WS_ROUTE); const bf16* Y = (const bf16*)(ws + WS_YM);
    f32x4 fgv[4];
#pragma unroll
    for (int j = 0; j < 4; ++j) fgv[j] = *(const f32x4*)(fg + 4 * lane_ + 256 * j);
    const int gw = F.vcu * NWAVES + wave_, NGW = F.G * NWAVES;
    for (int m = gw; m < M; m += NGW) {
        f32x4 v[4]; float s = 0.f;
        if (WITH_MOE) { const GAS unsigned long long* xb = (const GAS unsigned long long*)((const bf16*)(ws + WS_X1) + (size_t)m * D) + lane_;
#pragma unroll
            for (int j = 0; j < 4; ++j) { const unsigned long long a = xb[64 * j]; const unsigned al = (unsigned)a, ah = (unsigned)(a >> 32); v[j] = (f32x4){bflo(al), bfhi(al), bflo(ah), bfhi(ah)}; } }
        else { const GAS f32x4* xr = (const GAS f32x4*)(src + (size_t)m * D) + lane_;
#pragma unroll
            for (int j = 0; j < 4; ++j) v[j] = xr[64 * j]; }
        if (WITH_MOE) {
            const int b = m / SEQ; const int* rt_ = route + (size_t)m * 8;
            const float w0 = __int_as_float(rt_[2]), w1 = __int_as_float(rt_[3]); const int s0 = rt_[6], s1 = rt_[7];
            const GAS unsigned* y0 = (const GAS unsigned*)((const unsigned char*)Y + (size_t)s0 * D) + lane_; const GAS unsigned* y1 = (const GAS unsigned*)((const unsigned char*)Y + (size_t)s1 * D) + lane_;
#pragma unroll
            for (int j = 0; j < 4; ++j) { const int a = (int)y0[64 * j], c = (int)y1[64 * j]; const f32x4 g2 = *(const f32x4*)(mod + b * 6144 + 5120 + 4 * lane_ + 256 * j);
                f32x4 y; y.x = w0 * __builtin_amdgcn_cvt_f32_fp8(a, 0) + w1 * __builtin_amdgcn_cvt_f32_fp8(c, 0); y.y = w0 * __builtin_amdgcn_cvt_f32_fp8(a, 1) + w1 * __builtin_amdgcn_cvt_f32_fp8(c, 1);
                y.z = w0 * __builtin_amdgcn_cvt_f32_fp8(a, 2) + w1 * __builtin_amdgcn_cvt_f32_fp8(c, 2); y.w = w0 * __builtin_amdgcn_cvt_f32_fp8(a, 3) + w1 * __builtin_amdgcn_cvt_f32_fp8(c, 3);
                v[j] = v[j] + g2 * y; }
        }
#pragma unroll
        for (int j = 0; j < 4; ++j) s += (v[j].x * v[j].x + v[j].y * v[j].y) + (v[j].z * v[j].z + v[j].w * v[j].w);
        float rstd = 1.0f / sqrtf(wave_sum(s) * (1.f / D) + 1e-6f);
        if (WITH_MOE == 2) { if (((const unsigned*)(ws + WS_CTL))[CW_DIAG]) rstd = 0.f; }
        GAS f32x4* o = (GAS f32x4*)(A.out + (size_t)m * D) + lane_;
#pragma unroll
        for (int j = 0; j < 4; ++j) o[64 * j] = v[j] * rstd * fgv[j];
    }
}

typedef float f32x16 __attribute__((ext_vector_type(16)));
typedef unsigned u32x2 __attribute__((ext_vector_type(2)));
__device__ __forceinline__ f32x4 shift4(const bf16* p, bool has_prev, const float* mu) {
    const u32x2 c = *(const u32x2*)p; u32x2 q = *(const u32x2*)(has_prev ? p - SHW : p); if (!has_prev) q = (u32x2){0u, 0u};
    const f32x4 m = *(const f32x4*)mu;
    f32x4 cv = {bflo(c.x), bfhi(c.x), bflo(c.y), bfhi(c.y)}, pv = {bflo(q.x), bfhi(q.x), bflo(q.y), bfhi(q.y)};
    return cv + (pv - cv) * m;
}
__device__ __forceinline__ u32x2 pack4(f32x4 v) { u32x2 r; r.x = pk2(v.x, v.y); r.y = pk2(v.z, v.w); return r; }

__device__ __forceinline__ float fsig(float x) { return __builtin_amdgcn_rcpf(1.0f + __builtin_amdgcn_exp2f(-1.4426950408889634f * x)); }
__device__ __forceinline__ float ftanh(float x) { const float xc = fminf(fmaxf(x, -15.f), 15.f); return 1.0f - 2.0f * __builtin_amdgcn_rcpf(1.0f + __builtin_amdgcn_exp2f(2.8853900817779268f * xc)); }
__device__ __forceinline__ float half_sum32(float v) { v = row_sum16(v); v += __shfl_xor(v, 16); return v; }
__device__ __forceinline__ void shift2(const bf16* p, bool has_prev, const float (&mu)[2], float (&o)[2]) {
    const unsigned c = *(const unsigned*)p; unsigned q = *(const unsigned*)(has_prev ? p - SHW : p); if (!has_prev) q = 0u;
    const float c0 = bflo(c), c1 = bfhi(c); o[0] = c0 + (bflo(q) - c0) * mu[0]; o[1] = c1 + (bfhi(q) - c1) * mu[1];
}
template <int VAR> __device__ __forceinline__ void rwkv_pre(Frame& F, const Args& A, int ci_lo, int ci_hi) {
    PHASE_IDS();
    unsigned char* ws = A.ws;
    const bf16* PRW = (const bf16*)(ws + WS_PRW);
    const float* mu = A.in[7]; const float* w0 = A.in[8]; const float* a0 = A.in[10]; const float* k_k = A.in[13]; const float* k_a = A.in[14]; const float* r_k = A.in[15];
    const bf16* LW2 = (const bf16*)(ws + WS_LW2); const bf16* LA2 = (const bf16*)(ws + WS_LA2); const bf16* LG2 = (const bf16*)(ws + WS_LG2);
    float* LW = (float*)A.out; bf16* R = (bf16*)((unsigned char*)A.out + 64 * MiB); bf16* KP = (bf16*)((unsigned char*)A.out + 96 * MiB);
    bf16* VV = (bf16*)(ws + WS_XN); bf16* AV = (bf16*)(ws + WS_XN + 32 * MiB); bf16* BV = (bf16*)(ws + WS_F); bf16* GG = (bf16*)(ws + WS_F + 32 * MiB);
    float* BON = (float*)(ws + WS_BON);
    LAS bf16* Xw = (LAS bf16*)(F.lds); LAS bf16* Xa = (LAS bf16*)(F.lds + 9216); LAS bf16* Xg = (LAS bf16*)(F.lds + 18432);
    const int h = wave_;
    for (int ci = ci_lo; ci < ci_hi; ci += F.G) {
        __syncthreads();
        {
            int tl_ = threadIdx.x; asm volatile("" : "+v"(tl_));
            const int row = tl_ >> 3, cg = tl_ & 7; const size_t tok = (size_t)ci * 64 + row; const bool hp = (tok % SEQ) != 0;
            const bf16* src = PRW + tok * SHW + 1536 + 32 * cg; const float* mup = mu + 1536 + 32 * cg;
            LAS bf16* dst = (cg < 2) ? (Xw + row * 72 + 32 * cg) : (cg < 4) ? (Xa + row * 72 + 32 * (cg - 2)) : (Xg + row * 136 + 32 * (cg - 4));
#pragma unroll
            for (int q = 0; q < 8; ++q) { f32x4 v = shift4(src + 4 * q, hp, mup + 4 * q);
                if (cg < 2) { v.x = ftanh(v.x); v.y = ftanh(v.y); v.z = ftanh(v.z); v.w = ftanh(v.w); }
                else if (cg >= 4) { v.x = fsig(v.x); v.y = fsig(v.y); v.z = fsig(v.z); v.w = fsig(v.w); }
                *(LAS u32x2*)(dst + 4 * q) = pack4(v); }
        }
        __syncthreads();
        int ln_ = threadIdx.x & 63; asm volatile("" : "+v"(ln_));
        const int c = ln_ & 31, hh = ln_ >> 5, colb = 64 * h + 2 * c;
    float mur[2], muk[2], muv[2], kkc[2], kac[2], rkc[2], a0c[2], w0c[2];
#pragma unroll
    for (int e = 0; e < 2; ++e) { mur[e] = mu[colb + e]; muk[e] = mu[512 + colb + e]; muv[e] = mu[1024 + colb + e]; kkc[e] = k_k[colb + e]; kac[e] = k_a[colb + e]; rkc[e] = r_k[colb + e]; a0c[e] = a0[colb + e]; w0c[e] = w0[colb + e]; }
#pragma unroll 1
        for (int tb = 0; tb < ((VAR == 3) ? 0 : 2); ++tb) {
            f32x16 aa[2], aw[2], ag[2];
            aa[0] = f32x16{}; aa[1] = f32x16{}; aw[0] = f32x16{}; aw[1] = f32x16{}; ag[0] = f32x16{}; ag[1] = f32x16{};
            if (VAR != 4) {
#pragma unroll
            for (int ks = 0; ks < 4; ++ks) { const bf16x8 afr = *(const LAS bf16x8*)(Xa + (32 * tb + c) * 72 + 16 * ks + 8 * hh), wfr = *(const LAS bf16x8*)(Xw + (32 * tb + c) * 72 + 16 * ks + 8 * hh);
#pragma unroll
                for (int jb = 0; jb < 2; ++jb) { const bf16x8 b1 = *(const bf16x8*)(LA2 + (size_t)(colb + jb) * 64 + 16 * ks + 8 * hh), b2 = *(const bf16x8*)(LW2 + (size_t)(colb + jb) * 64 + 16 * ks + 8 * hh);
                    aa[jb] = __builtin_amdgcn_mfma_f32_32x32x16_bf16(afr, b1, aa[jb], 0, 0, 0); aw[jb] = __builtin_amdgcn_mfma_f32_32x32x16_bf16(wfr, b2, aw[jb], 0, 0, 0); } }
#pragma unroll
            for (int ks = 0; ks < 8; ++ks) { const bf16x8 gfr = *(const LAS bf16x8*)(Xg + (32 * tb + c) * 136 + 16 * ks + 8 * hh);
#pragma unroll
                for (int jb = 0; jb < 2; ++jb) { const bf16x8 b3 = *(const bf16x8*)(LG2 + (size_t)(colb + jb) * 128 + 16 * ks + 8 * hh); ag[jb] = __builtin_amdgcn_mfma_f32_32x32x16_bf16(gfr, b3, ag[jb], 0, 0, 0); } }
            }
            unsigned gpk[16], apk[16];
#pragma unroll
            for (int reg = 0; reg < 16; ++reg) { gpk[reg] = pk2(ag[0][reg], ag[1][reg]); apk[reg] = pk2(fsig(a0c[0] + aa[0][reg]), fsig(a0c[1] + aa[1][reg])); }
            unsigned rawc[16][3], rawq[4][3];
#pragma unroll
            for (int reg = 0; reg < 16; ++reg) { const int t = 32 * tb + (reg & 3) + 8 * (reg >> 2) + 4 * hh; const size_t tok = (size_t)ci * 64 + t; const bool hp = (tok % SEQ) != 0;
                const bf16* prow = PRW + tok * SHW + colb; const bf16* pprev = hp ? prow - SHW : prow;
#pragma unroll
                for (int x = 0; x < 3; ++x) { if (VAR == 2) { rawc[reg][x] = 0x3f803f80u + reg; if ((reg & 3) == 0) rawq[reg >> 2][x] = 0x3f803f80u; } else { rawc[reg][x] = *(const unsigned*)(prow + 512 * x); if ((reg & 3) == 0) { const unsigned q = *(const unsigned*)(pprev + 512 * x); rawq[reg >> 2][x] = hp ? q : 0u; } } } }
#pragma unroll
            for (int reg = 0; reg < 16; ++reg) {
                const int t = 32 * tb + (reg & 3) + 8 * (reg >> 2) + 4 * hh; const size_t tok = (size_t)ci * 64 + t;
                unsigned rawp_[3];
#pragma unroll
                for (int x = 0; x < 3; ++x) rawp_[x] = ((reg & 3) == 0) ? rawq[reg >> 2][x] : rawc[(reg + 15) & 15][x];
                float kx[2], rx[2], vx[2];
                { const unsigned cc_ = rawc[reg][0], pp_ = rawp_[0]; const float c0 = bflo(cc_), c1 = bfhi(cc_); rx[0] = c0 + (bflo(pp_) - c0) * mur[0]; rx[1] = c1 + (bfhi(pp_) - c1) * mur[1]; }
                { const unsigned cc_ = rawc[reg][1], pp_ = rawp_[1]; const float c0 = bflo(cc_), c1 = bfhi(cc_); kx[0] = c0 + (bflo(pp_) - c0) * muk[0]; kx[1] = c1 + (bfhi(pp_) - c1) * muk[1]; }
                { const unsigned cc_ = rawc[reg][2], pp_ = rawp_[2]; const float c0 = bflo(cc_), c1 = bfhi(cc_); vx[0] = c0 + (bflo(pp_) - c0) * muv[0]; vx[1] = c1 + (bfhi(pp_) - c1) * muv[1]; }
                const float as0 = bflo(apk[reg]), as1 = bfhi(apk[reg]);
                const float kr0 = kx[0] * kkc[0], kr1 = kx[1] * kkc[1];
                const float ss = half_sum32(kr0 * kr0 + kr1 * kr1); const float inv = __builtin_amdgcn_rsqf(fmaxf(ss, 1e-24f));
                const float kk0 = kr0 * inv, kk1 = kr1 * inv, kp0 = kx[0] * (1.0f + (as0 - 1.0f) * kac[0]), kp1 = kx[1] * (1.0f + (as1 - 1.0f) * kac[1]);
                const float bon = half_sum32(rx[0] * kp0 * rkc[0] + rx[1] * kp1 * rkc[1]);
                float o2[2];
#pragma unroll
                for (int e = 0; e < 2; ++e) { const float z = -(w0c[e] + aw[e][reg]);
                    const float sp = fmaxf(z, 0.f) + 0.6931471805599453f * __builtin_amdgcn_logf(1.0f + __builtin_amdgcn_exp2f(-1.4426950408889634f * fabsf(z))); o2[e] = -__builtin_amdgcn_exp2f(-1.4426950408889634f * (sp + 0.5f)); }
                const unsigned ob = (unsigned)tok * 1024u + (unsigned)colb * 2u;
                if (VAR == 0) {
                *(unsigned*)((unsigned char*)R + ob) = pk2(rx[0], rx[1]); *(unsigned*)((unsigned char*)KP + ob) = pk2(kp0, kp1); *(unsigned*)((unsigned char*)VV + ob) = pk2(vx[0], vx[1]);
                *(unsigned*)((unsigned char*)AV + ob) = pk2(-kk0, -kk1); *(unsigned*)((unsigned char*)BV + ob) = pk2(kk0 * as0, kk1 * as1);
                *(float2*)((unsigned char*)LW + 2u * ob) = make_float2(o2[0], o2[1]); *(unsigned*)((unsigned char*)GG + ob) = gpk[reg];
                if (c == 0) BON[tok * 8 + h] = bon;
                } else { asm volatile("" :: "v"(pk2(rx[0], rx[1])), "v"(pk2(kp0, kp1)), "v"(pk2(vx[0], vx[1])), "v"(pk2(-kk0, -kk1)), "v"(pk2(kk0 * as0, kk1 * as1)), "v"(o2[0]), "v"(o2[1]), "v"(gpk[reg]), "v"(bon), "v"(ob)); }
                if ((reg & 3) == 3) __builtin_amdgcn_sched_barrier(0);
            }
        }
    }
}

__device__ __forceinline__ void rwkv_scan_seq(Frame& F, const Args& A) {
    PHASE_IDS();
    if (blockIdx.x >= BATCH * 8) return;
    unsigned char* ws = A.ws;
    const float* LW = (const float*)A.out; const bf16* R = (const bf16*)((unsigned char*)A.out + 64 * MiB); const bf16* KP = (const bf16*)((unsigned char*)A.out + 96 * MiB);
    const bf16* VV = (const bf16*)(ws + WS_XN); const bf16* AV = (const bf16*)(ws + WS_XN + 32 * MiB); const bf16* BV = (const bf16*)(ws + WS_F);
    float* Y = (float*)(ws + WS_Y);
    const int b = blockIdx.x >> 3, h = blockIdx.x & 7;
    constexpr int STEPB = 896, CH = 16, BUFB = STEPB * CH;
    LAS unsigned char* buf = F.lds;
    const size_t tok0 = (size_t)b * SEQ;
    const bool loader = wave_ >= 4; const int lt = tid_ - 256;
    auto load_chunk = [&](int cidx, int slot) {
        for (int p = lt; p < CH * 56; p += 256) { const int s = p / 56, q = p % 56; const size_t tok = tok0 + (size_t)cidx * CH + s; v4u val;
            if (q < 16) val = *(const v4u*)(LW + tok * 512 + 64 * h + 4 * q);
            else { const int a = (q - 16) >> 3, o8 = (q - 16) & 7; const bf16* src = (a == 0) ? AV : (a == 1) ? BV : (a == 2) ? KP : (a == 3) ? R : VV; val = *(const v4u*)(src + tok * 512 + 64 * h + 8 * o8); }
            *(LAS v4u*)(buf + slot * BUFB + s * STEPB + q * 16) = val; }
    };
    if (loader) load_chunk(0, 0);
    __syncthreads();
    float S[16];
#pragma unroll
    for (int j = 0; j < 16; ++j) S[j] = 0.f;
    const int il = lane_ & 15, jq = lane_ >> 4, irow = 16 * wave_ + il;
    for (int cidx = 0; cidx < SEQ / CH; ++cidx) {
        if (loader) { if (cidx + 1 < SEQ / CH) load_chunk(cidx + 1, (cidx + 1) & 1); }
        else {
            const LAS unsigned char* bb = buf + (cidx & 1) * BUFB;
#pragma unroll 4
            for (int s = 0; s < CH; ++s) { const LAS unsigned char* sp = bb + s * STEPB;
                float w[16], av[16], bv[16], kv[16], rv[16];
#pragma unroll
                for (int q = 0; q < 4; ++q) { const f32x4 l4 = *(const LAS f32x4*)(sp + 64 * jq + 16 * q); w[4 * q] = __expf(l4.x); w[4 * q + 1] = __expf(l4.y); w[4 * q + 2] = __expf(l4.z); w[4 * q + 3] = __expf(l4.w); }
#pragma unroll
                for (int q = 0; q < 2; ++q) { const v4u a4 = *(const LAS v4u*)(sp + 256 + 32 * jq + 16 * q), b4 = *(const LAS v4u*)(sp + 384 + 32 * jq + 16 * q), k4 = *(const LAS v4u*)(sp + 512 + 32 * jq + 16 * q), r4 = *(const LAS v4u*)(sp + 640 + 32 * jq + 16 * q);
#pragma unroll
                    for (int e = 0; e < 4; ++e) { av[8 * q + 2 * e] = bflo(a4[e]); av[8 * q + 2 * e + 1] = bfhi(a4[e]); bv[8 * q + 2 * e] = bflo(b4[e]); bv[8 * q + 2 * e + 1] = bfhi(b4[e]);
                        kv[8 * q + 2 * e] = bflo(k4[e]); kv[8 * q + 2 * e + 1] = bfhi(k4[e]); rv[8 * q + 2 * e] = bflo(r4[e]); rv[8 * q + 2 * e + 1] = bfhi(r4[e]); } }
                const unsigned short vraw = *(const LAS unsigned short*)(sp + 768 + 2 * irow); const float vi = __uint_as_float((unsigned)vraw << 16);
                float sa = 0.f;
#pragma unroll
                for (int j = 0; j < 16; ++j) sa += S[j] * av[j];
                sa += __shfl_xor(sa, 16); sa += __shfl_xor(sa, 32);
                float y = 0.f;
#pragma unroll
                for (int j = 0; j < 16; ++j) { S[j] = S[j] * w[j] + sa * bv[j] + vi * kv[j]; y += S[j] * rv[j]; }
                y += __shfl_xor(y, 16); y += __shfl_xor(y, 32);
                if (jq == 0) Y[(tok0 + (size_t)cidx * CH + s) * 512 + 64 * h + irow] = y;
            }
        }
        __syncthreads();
    }
}

__device__ __forceinline__ void rwkv_post(Frame& F, const Args& A) {
    PHASE_IDS();
    unsigned char* ws = A.ws;
    const float* Y = (const float*)(ws + WS_Y); const bf16* VV = (const bf16*)(ws + WS_XN); const bf16* GG = (const bf16*)(ws + WS_F + 32 * MiB); const float* BON = (const float*)(ws + WS_BON);
    bf16* O = (bf16*)(ws + WS_F);
    const float* lg = A.in[16]; const float* lb = A.in[17];
    const int gw = F.vcu * NWAVES + wave_, NGW = F.G * NWAVES, col = 8 * lane_, hd = lane_ >> 3;
    const f32x4 g0 = *(const f32x4*)(lg + col), g1 = *(const f32x4*)(lg + col + 4), b0 = *(const f32x4*)(lb + col), b1 = *(const f32x4*)(lb + col + 4);
    for (int m = gw; m < M; m += NGW) {
        const f32x4 y0 = *(const f32x4*)(Y + (size_t)m * 512 + col), y1 = *(const f32x4*)(Y + (size_t)m * 512 + col + 4);
        float s = (y0.x + y0.y) + (y0.z + y0.w) + (y1.x + y1.y) + (y1.z + y1.w);
        s += __shfl_xor(s, 1); s += __shfl_xor(s, 2); s += __shfl_xor(s, 4);
        const float mean = s * (1.f / 64.f); const f32x4 d0 = y0 - mean, d1 = y1 - mean;
        float q = (d0.x * d0.x + d0.y * d0.y) + (d0.z * d0.z + d0.w * d0.w) + (d1.x * d1.x + d1.y * d1.y) + (d1.z * d1.z + d1.w * d1.w);
        q += __shfl_xor(q, 1); q += __shfl_xor(q, 2); q += __shfl_xor(q, 4);
        const float rstd = 1.0f / sqrtf(q * (1.f / 64.f) + 64e-5f);
        const float bon = BON[(size_t)m * 8 + hd];
        const v4u vw = *(const v4u*)(VV + (size_t)m * 512 + col), gw4 = *(const v4u*)(GG + (size_t)m * 512 + col);
        f32x4 o0 = (d0 * rstd * g0 + b0), o1 = (d1 * rstd * g1 + b1);
        o0.x = (o0.x + bon * bflo(vw.x)) * bflo(gw4.x); o0.y = (o0.y + bon * bfhi(vw.x)) * bfhi(gw4.x); o0.z = (o0.z + bon * bflo(vw.y)) * bflo(gw4.y); o0.w = (o0.w + bon * bfhi(vw.y)) * bfhi(gw4.y);
        o1.x = (o1.x + bon * bflo(vw.z)) * bflo(gw4.z); o1.y = (o1.y + bon * bfhi(vw.z)) * bfhi(gw4.z); o1.z = (o1.z + bon * bflo(vw.w)) * bflo(gw4.w); o1.w = (o1.w + bon * bfhi(vw.w)) * bfhi(gw4.w);
        v4u ow; ow.x = pk2(o0.x, o0.y); ow.y = pk2(o0.z, o0.w); ow.z = pk2(o1.x, o1.y); ow.w = pk2(o1.z, o1.w);
        *(v4u*)(O + (size_t)m * 512 + col) = ow;
    }
}

__device__ __forceinline__ size_t pq_off(int it) { const int ch = it >> 8, cc = it & 255; return WS_PRW + ((size_t)(ch >> 3) * SEQ + (size_t)cc * 64) * (SHW * 2) + (size_t)(ch & 7) * 24576; }
__device__ __forceinline__ size_t y0_off(int it, int idx) { const int ch = it >> 8, cc = it & 255; return (((size_t)(ch >> 3) * SEQ + (size_t)cc * 64 + (idx >> 4)) * 512 + 64 * (ch & 7)) * 4 + (size_t)(idx & 15) * 16; }
constexpr size_t ST_OFF = 64 * MiB;
constexpr int CH_ITEMS = BATCH * 8 * (SEQ / 64);

__device__ __forceinline__ int sw16(int row, int chunk) { return row * 128 + ((chunk ^ (row & 7)) << 4); }
typedef float f32x4c __attribute__((ext_vector_type(4)));
__device__ __forceinline__ bf16x8 ld_frag(const LAS unsigned char* Mx, int row, int chunk) { return *(const LAS bf16x8*)(Mx + sw16(row, chunk)); }
template <bool SWAP>
__device__ __forceinline__ void mm_tile(const LAS unsigned char* Am, const LAS unsigned char* Bm, int r0, int c0, int l15, int kg, f32x4c (&acc)[2]) {
    bf16x8 a[2], b[2][2];
#pragma unroll
    for (int ks = 0; ks < 2; ++ks) { a[ks] = ld_frag(Am, r0 + l15, 4 * ks + kg);
#pragma unroll
        for (int n = 0; n < 2; ++n) b[ks][n] = ld_frag(Bm, c0 + 16 * n + l15, 4 * ks + kg); }
#pragma unroll
    for (int ks = 0; ks < 2; ++ks)
#pragma unroll
        for (int n = 0; n < 2; ++n)
            acc[n] = SWAP ? __builtin_amdgcn_mfma_f32_16x16x32_bf16(b[ks][n], a[ks], acc[n], 0, 0, 0) : __builtin_amdgcn_mfma_f32_16x16x32_bf16(a[ks], b[ks][n], acc[n], 0, 0, 0);
}
__device__ __forceinline__ unsigned long long pack4u(f32x4c v) { return (unsigned long long)pk2(v[0], v[1]) | ((unsigned long long)pk2(v[2], v[3]) << 32); }
__device__ __forceinline__ void st_nat(LAS unsigned char* O, int r0, int c0, int l15, int kg, const f32x4c (&acc)[2]) {
#pragma unroll
    for (int n = 0; n < 2; ++n) { const int row = r0 + l15, col = c0 + 16 * n + 4 * kg; *(LAS unsigned long long*)(O + sw16(row, col >> 3) + (col & 4) * 2) = pack4u(acc[n]); }
}
__device__ __forceinline__ void st_tr(LAS unsigned char* OT, int r0, int c0, int l15, int kg, const f32x4c (&acc)[2]) {
#pragma unroll
    for (int n = 0; n < 2; ++n)
#pragma unroll
        for (int e = 0; e < 4; ++e) { const int row = r0 + l15, col = c0 + 16 * n + 4 * kg + e; *(LAS unsigned short*)(OT + sw16(col, row >> 3) + (row & 7) * 2) = (unsigned short)f2bf(acc[n][e]); }
}
__device__ __forceinline__ f32x4c ld_nat4(const LAS unsigned char* O, int row, int col) { const unsigned long long w = *(const LAS unsigned long long*)(O + sw16(row, col >> 3) + (col & 4) * 2);
    const unsigned lo = (unsigned)w, hi = (unsigned)(w >> 32); return (f32x4c){bflo(lo), bfhi(lo), bflo(hi), bfhi(hi)}; }

template <int VAR> __device__ __forceinline__ void rwkv_r1(Frame& F, const Args& A, int it_lo, int it_hi, int it_step) {
    PHASE_IDS();
    unsigned char* ws = A.ws;
    const float* LW = (const float*)A.out; const bf16* R = (const bf16*)((unsigned char*)A.out + 64 * MiB); const bf16* KP = (const bf16*)((unsigned char*)A.out + 96 * MiB);
    const bf16* VV = (const bf16*)(ws + WS_XN); const bf16* AV = (const bf16*)(ws + WS_XN + 32 * MiB); const bf16* BV = (const bf16*)(ws + WS_F);
    LAS unsigned char* L = F.lds;
#define MB(i) (L + (i) * 8192)
    LAS float* gCs = (LAS float*)(L + 17 * 8192); LAS float* part = gCs + 64;
    const int w = wave_, j = lane_, l15 = lane_ & 15, kg = lane_ >> 4, r0 = 16 * (w >> 1), c0 = 32 * (w & 1);
#define R1_BAR() asm volatile("s_waitcnt lgkmcnt(0)\n\ts_barrier" ::: "memory")
    float nlw[8]; unsigned short nav[8], nbv[8], nkv[8], nrv[8], nvv[8];
#define R1_LOAD(itx) do { const int ch_ = (itx) >> 8, cc_ = (itx) & 255; const size_t tb_ = (size_t)(ch_ >> 3) * SEQ + (size_t)cc_ * 64 + 8 * w; const int cg_ = 64 * (ch_ & 7) + j; \
        _Pragma("unroll") for (int t = 0; t < 8; ++t) { const size_t o = (tb_ + t) * 512 + cg_; nlw[t] = LW[o]; nav[t] = AV[o]; nbv[t] = BV[o]; nkv[t] = KP[o]; nrv[t] = R[o]; nvv[t] = VV[o]; } } while (0)
    if (it_lo < it_hi) R1_LOAD(it_lo);
    for (int it = it_lo; it < it_hi; it += it_step) {
        R1_BAR();
        {
            float g[8], lw[8], av[8], bv[8], kv[8], rv[8]; unsigned short vraw[8]; float run = 0.f;
#pragma unroll
            for (int t = 0; t < 8; ++t) { lw[t] = nlw[t]; av[t] = __uint_as_float((unsigned)nav[t] << 16); bv[t] = __uint_as_float((unsigned)nbv[t] << 16);
                kv[t] = __uint_as_float((unsigned)nkv[t] << 16); rv[t] = __uint_as_float((unsigned)nrv[t] << 16); vraw[t] = nvv[t]; run += lw[t]; g[t] = run; }
            if (it + it_step < it_hi) R1_LOAD(it + it_step);
            part[w * 64 + j] = run;
            R1_BAR();
            float pre = 0.f, tot = 0.f;
#pragma unroll
            for (int q = 0; q < 8; ++q) { const float p = part[q * 64 + j]; tot += p; if (q < w) pre += p; }
            if (w == 0) gCs[j] = __expf(tot);
            unsigned short atT[8], bhT[8], khT[8];
#pragma unroll
            for (int t = 0; t < 8; ++t) { const float G = pre + g[t]; const float eg = __expf(G), en = __expf(-G), ea = __expf(G - lw[t]), ec = __expf(tot - G);
                const int row = 8 * w + t; const int off = sw16(row, j >> 3) + (j & 7) * 2;
                const unsigned short at = (unsigned short)f2bf(av[t] * ea);
                *(LAS unsigned short*)(MB(0) + off) = at; atT[t] = at;
                *(LAS unsigned short*)(MB(2) + off) = (unsigned short)f2bf(bv[t] * en);
                *(LAS unsigned short*)(MB(3) + off) = (unsigned short)f2bf(kv[t] * en);
                *(LAS unsigned short*)(MB(4) + off) = (unsigned short)f2bf(rv[t] * eg);
                bhT[t] = (unsigned short)f2bf(bv[t] * ec); khT[t] = (unsigned short)f2bf(kv[t] * ec); }
            v4u x;
            x.x = atT[0] | ((unsigned)atT[1] << 16); x.y = atT[2] | ((unsigned)atT[3] << 16); x.z = atT[4] | ((unsigned)atT[5] << 16); x.w = atT[6] | ((unsigned)atT[7] << 16); *(LAS v4u*)(MB(1) + sw16(j, w)) = x;
            x.x = bhT[0] | ((unsigned)bhT[1] << 16); x.y = bhT[2] | ((unsigned)bhT[3] << 16); x.z = bhT[4] | ((unsigned)bhT[5] << 16); x.w = bhT[6] | ((unsigned)bhT[7] << 16); *(LAS v4u*)(MB(5) + sw16(j, w)) = x;
            x.x = khT[0] | ((unsigned)khT[1] << 16); x.y = khT[2] | ((unsigned)khT[3] << 16); x.z = khT[4] | ((unsigned)khT[5] << 16); x.w = khT[6] | ((unsigned)khT[7] << 16); *(LAS v4u*)(MB(6) + sw16(j, w)) = x;
            x.x = vraw[0] | ((unsigned)vraw[1] << 16); x.y = vraw[2] | ((unsigned)vraw[3] << 16); x.z = vraw[4] | ((unsigned)vraw[5] << 16); x.w = vraw[6] | ((unsigned)vraw[7] << 16); *(LAS v4u*)(MB(7) + sw16(j, w)) = x;
        }
        R1_BAR();
        if (VAR == 1) continue;
        f32x4c acc[2];
        const int trow = r0 + l15;
        {
            acc[0] = f32x4c{}; acc[1] = f32x4c{}; mm_tile<true>(MB(0), MB(2), r0, c0, l15, kg, acc);
#pragma unroll
            for (int n = 0; n < 2; ++n)
#pragma unroll
                for (int e = 0; e < 4; ++e) { const int s = c0 + 16 * n + 4 * kg + e; if (s >= trow) acc[n][e] = 0.f; }
            st_nat(MB(8), r0, c0, l15, kg, acc); st_tr(MB(9), r0, c0, l15, kg, acc);
#pragma unroll
            for (int n = 0; n < 2; ++n)
#pragma unroll
                for (int e = 0; e < 4; ++e) { const int s = c0 + 16 * n + 4 * kg + e; if (s == trow) acc[n][e] = 1.f; }
            st_nat(MB(15), r0, c0, l15, kg, acc);
            acc[0] = f32x4c{}; acc[1] = f32x4c{}; mm_tile<true>(MB(0), MB(3), r0, c0, l15, kg, acc);
#pragma unroll
            for (int n = 0; n < 2; ++n)
#pragma unroll
                for (int e = 0; e < 4; ++e) { const int s = c0 + 16 * n + 4 * kg + e; if (s >= trow) acc[n][e] = 0.f; }
            st_nat(MB(10), r0, c0, l15, kg, acc);
            acc[0] = f32x4c{}; acc[1] = f32x4c{}; mm_tile<true>(MB(4), MB(2), r0, c0, l15, kg, acc);
#pragma unroll
            for (int n = 0; n < 2; ++n)
#pragma unroll
                for (int e = 0; e < 4; ++e) { const int s = c0 + 16 * n + 4 * kg + e; if (s > trow) acc[n][e] = 0.f; }
            st_nat(MB(11), r0, c0, l15, kg, acc);
            acc[0] = f32x4c{}; acc[1] = f32x4c{}; mm_tile<true>(MB(4), MB(3), r0, c0, l15, kg, acc);
#pragma unroll
            for (int n = 0; n < 2; ++n)
#pragma unroll
                for (int e = 0; e < 4; ++e) { const int s = c0 + 16 * n + 4 * kg + e; if (s > trow) acc[n][e] = 0.f; }
            st_nat(MB(12), r0, c0, l15, kg, acc);
        }
        R1_BAR();
        if (VAR == 2) continue;
        acc[0] = f32x4c{}; acc[1] = f32x4c{}; mm_tile<true>(MB(8), MB(9), r0, c0, l15, kg, acc); st_nat(MB(13), r0, c0, l15, kg, acc); st_tr(MB(14), r0, c0, l15, kg, acc);
        acc[0] = f32x4c{}; acc[1] = f32x4c{}; mm_tile<true>(MB(7), MB(10), r0, c0, l15, kg, acc); st_nat(MB(3), r0, c0, l15, kg, acc);
        R1_BAR();
#define SQUARE(xi, xti, xo, xto) do { acc[0] = f32x4c{}; acc[1] = f32x4c{}; mm_tile<true>(MB(xi), MB(xti), r0, c0, l15, kg, acc); st_nat(MB(xo), r0, c0, l15, kg, acc); st_tr(MB(xto), r0, c0, l15, kg, acc); } while (0)
#define MUPD(mi, xti, mo) do { acc[0] = ld_nat4(MB(mi), trow, c0 + 4 * kg); acc[1] = ld_nat4(MB(mi), trow, c0 + 16 + 4 * kg); mm_tile<true>(MB(mi), MB(xti), r0, c0, l15, kg, acc); st_nat(MB(mo), r0, c0, l15, kg, acc); } while (0)
        SQUARE(13, 14, 0, 2); MUPD(15, 14, 16); R1_BAR();
        SQUARE(0, 2, 13, 14); MUPD(16, 2, 15); R1_BAR();
        SQUARE(13, 14, 0, 2); MUPD(15, 14, 16); R1_BAR();
        SQUARE(0, 2, 13, 14); MUPD(16, 2, 15); R1_BAR();
        MUPD(15, 14, 16); R1_BAR();
        acc[0] = f32x4c{}; acc[1] = f32x4c{}; mm_tile<true>(MB(1), MB(16), r0, c0, l15, kg, acc); st_nat(MB(13), r0, c0, l15, kg, acc);
        acc[0] = f32x4c{}; acc[1] = f32x4c{}; mm_tile<true>(MB(3), MB(16), r0, c0, l15, kg, acc); st_nat(MB(14), r0, c0, l15, kg, acc);
        R1_BAR();
        if (VAR == 3) continue;
        unsigned char* og = ws + pq_off(it); unsigned char* oy = (unsigned char*)A.out + y0_off(it, w * 64 + lane_);
        {
            acc[0] = f32x4c{}; acc[1] = f32x4c{}; mm_tile<true>(MB(5), MB(13), r0, c0, l15, kg, acc);
            const float gc = gCs[trow];
#pragma unroll
            for (int n = 0; n < 2; ++n) { const int col = c0 + 16 * n + 4 * kg;
#pragma unroll
                for (int e = 0; e < 4; ++e) if (col + e == trow) acc[n][e] += gc;
                const int jj_ = col & 31, q_ = jj_ & 15; const size_t po_ = ((size_t)((((trow >> 5) * 2 + (col >> 5)) * 2 + (jj_ >> 4)) * 64 + (trow & 31) + 32 * ((q_ >> 2) & 1)) * 16 + (size_t)(4 * (q_ >> 3)) * 2);
                if (VAR == 0) *(unsigned long long*)(og + po_) = pack4u(acc[n]); else asm volatile("" :: "v"(pack4u(acc[n]))); }
            acc[0] = ld_nat4(MB(4), trow, c0 + 4 * kg); acc[1] = ld_nat4(MB(4), trow, c0 + 16 + 4 * kg); mm_tile<true>(MB(11), MB(13), r0, c0, l15, kg, acc);
#pragma unroll
            for (int n = 0; n < 2; ++n) { const int col = c0 + 16 * n + 4 * kg; if (VAR == 0) *(unsigned long long*)(og + 16384 + (size_t)(trow * 64 + col) * 2) = pack4u(acc[n]); else asm volatile("" :: "v"(pack4u(acc[n]))); }
            acc[0] = f32x4c{}; acc[1] = f32x4c{}; mm_tile<false>(MB(5), MB(14), r0, c0, l15, kg, acc); mm_tile<false>(MB(6), MB(7), r0, c0, l15, kg, acc);
#pragma unroll
            for (int n = 0; n < 2; ++n) { const int i_ = c0 + 16 * n + l15, jr_ = r0 + 4 * kg, rr_ = jr_ & 31;
                const size_t qo_ = (size_t)((((i_ >> 5) * 2 + (jr_ >> 5)) * 64 + (i_ & 31) + 32 * ((rr_ >> 2) & 1)) * 32 + (4 * (rr_ >> 3)) * 2);
                if (VAR == 0) *(unsigned long long*)(og + 8192 + qo_) = pack4u(acc[n]); else asm volatile("" :: "v"(pack4u(acc[n]))); }
            acc[0] = f32x4c{}; acc[1] = f32x4c{}; mm_tile<false>(MB(11), MB(14), r0, c0, l15, kg, acc); mm_tile<false>(MB(12), MB(7), r0, c0, l15, kg, acc);
            { v4u q; q.x = pk2(acc[0][0], acc[0][1]); q.y = pk2(acc[0][2], acc[0][3]); q.z = pk2(acc[1][0], acc[1][1]); q.w = pk2(acc[1][2], acc[1][3]); if (VAR == 0) *(v4u*)oy = q; else asm volatile("" :: "v"(q)); }
        }
    }
#undef SQUARE
#undef MUPD
#undef MB
#undef R1_BAR
#undef R1_LOAD
}

template <int VAR> __device__ __forceinline__ void rwkv_r2(Frame& F, const Args& A, unsigned char* stbase) {
    PHASE_IDS();
    if (blockIdx.x >= BATCH * 8) return;
    unsigned char* ws = A.ws;
    LAS unsigned char* L = F.lds;
    const int ch = blockIdx.x, w = wave_, l15 = lane_ & 15, kg = lane_ >> 4, r0 = 16 * (w >> 1), c0 = 32 * (w & 1);
    const unsigned char* pq = ws + pq_off(ch * 256); unsigned char* st = stbase + (size_t)ch * 256 * 8192;
    for (int i = tid_; i < 2048; i += NWAVES * 64) { ((LAS unsigned*)L)[i] = 0u; }
    for (int i = tid_; i < 512; i += NWAVES * 64) ((v4u*)st)[i] = (v4u){0u, 0u, 0u, 0u};
    __syncthreads();
    constexpr int PF = 8;
    bf16x8 pa[PF][2]; v4u qf[PF];
#define R2_LOAD(slot, step) do { const unsigned char* p_ = pq + (size_t)(step) * (64 * SHW * 2); \
        pa[slot][0] = *(const bf16x8*)(p_ + (size_t)((r0 + l15) * 64 + 8 * kg) * 2); pa[slot][1] = *(const bf16x8*)(p_ + (size_t)((r0 + l15) * 64 + 32 + 8 * kg) * 2); \
        qf[slot] = *(const v4u*)(p_ + 8192 + (size_t)(w * 64 + lane_) * 16); } while (0)
#pragma unroll
    for (int s = 0; s < PF; ++s) R2_LOAD(s, s);
    for (int c = 0; c < 256; c += PF) {
#pragma unroll
        for (int s = 0; s < PF; ++s) {
            const int step = c + s; const LAS unsigned char* Sin = L + (step & 15) * 8192; LAS unsigned char* Sout = L + ((step + 1) & 15) * 8192;
            f32x4c acc[2];
            acc[0] = (f32x4c){bflo(qf[s].x), bfhi(qf[s].x), bflo(qf[s].y), bfhi(qf[s].y)}; acc[1] = (f32x4c){bflo(qf[s].z), bfhi(qf[s].z), bflo(qf[s].w), bfhi(qf[s].w)};
            bf16x8 sf[2][2];
#pragma unroll
            for (int ks = 0; ks < 2; ++ks)
#pragma unroll
                for (int n = 0; n < 2; ++n) sf[ks][n] = ld_frag(Sin, c0 + 16 * n + l15, 4 * ks + kg);
#pragma unroll
            for (int ks = 0; ks < 2; ++ks)
#pragma unroll
                for (int n = 0; n < 2; ++n) acc[n] = __builtin_amdgcn_mfma_f32_16x16x32_bf16(pa[s][ks], sf[ks][n], acc[n], 0, 0, 0);
#pragma unroll
            for (int n = 0; n < 2; ++n) { const int row = c0 + 16 * n + l15, col = r0 + 4 * kg; const unsigned long long pkd = pack4u(acc[n]);
                *(LAS unsigned long long*)(Sout + sw16(row, col >> 3) + (col & 4) * 2) = pkd;
                }
            if (VAR != 3) { if (step + PF < 256) R2_LOAD(s, step + PF); }
            if (VAR != 4) asm volatile("s_waitcnt lgkmcnt(0)\n\ts_barrier" ::: "memory");
        }
        if (VAR != 2) { const int nflush = (c + PF < 256) ? PF * 8192 : (PF - 1) * 8192; unsigned char* dst = st + (size_t)(c + 1) * 8192;
          for (int o = tid_ * 16; o < nflush; o += NWAVES * 64 * 16) { const int row_ = (o >> 7) & 63, chk_ = (o >> 4) & 7, slot_ = (c + 1 + (o >> 13)) & 15; *(v4u*)(dst + o) = *(const LAS v4u*)(L + slot_ * 8192 + sw16(row_, chk_)); } }
    }
#undef R2_LOAD
}

__device__ __forceinline__ void rwkv_r2w(Frame& F, const Args& A, unsigned char* stbase) {
    PHASE_IDS();
    if (blockIdx.x >= BATCH * 8) return;
    unsigned char* ws = A.ws;
    LAS unsigned char* HB = F.lds;
    const int ch = blockIdx.x, it = wave_ & 1, cl = lane_ & 31, hh = lane_ >> 5; const bool chain = wave_ < 2;
    const unsigned char* pq = ws + pq_off(ch * 256); unsigned char* st = stbase + (size_t)ch * 256 * 8192;
    for (int i = tid_; i < 512; i += NWAVES * 64) ((v4u*)st)[i] = (v4u){0u, 0u, 0u, 0u};
    f32x16 H[2]; H[0] = f32x16{}; H[1] = f32x16{};
    constexpr int PF = 2;
    bf16x8 pf[PF][8]; v4u qf[PF][4];
#define RW_LOAD(slot, step) do { const unsigned char* p_ = pq + (size_t)(step) * (64 * SHW * 2); \
        _Pragma("unroll") for (int f = 0; f < 8; ++f) pf[slot][f] = *(const bf16x8*)(p_ + (size_t)(f * 64 + lane_) * 16); \
        _Pragma("unroll") for (int jt = 0; jt < 2; ++jt) { const unsigned char* q_ = p_ + 8192 + (size_t)((it * 2 + jt) * 64 + lane_) * 32; qf[slot][2 * jt] = *(const v4u*)q_; qf[slot][2 * jt + 1] = *(const v4u*)(q_ + 16); } } while (0)
    if (chain) {
#pragma unroll
        for (int s = 0; s < PF; ++s) RW_LOAD(s, s); }
    for (int g = 0; g < 64; ++g) {
        LAS unsigned char* hb = HB + (g & 1) * 32768;
        if (chain) {
#pragma unroll
            for (int s = 0; s < 4; ++s) {
                const int step = 4 * g + s; if (step >= 255) break;
                bf16x8 B[2][2];
#pragma unroll
                for (int jt2 = 0; jt2 < 2; ++jt2)
#pragma unroll
                    for (int k = 0; k < 2; ++k) { v4u p_; p_.x = pk2(H[jt2][8 * k], H[jt2][8 * k + 1]); p_.y = pk2(H[jt2][8 * k + 2], H[jt2][8 * k + 3]); p_.z = pk2(H[jt2][8 * k + 4], H[jt2][8 * k + 5]); p_.w = pk2(H[jt2][8 * k + 6], H[jt2][8 * k + 7]); B[jt2][k] = __builtin_bit_cast(bf16x8, p_); }
#pragma unroll
                for (int jt = 0; jt < 2; ++jt) { f32x16 n_;
#pragma unroll
                    for (int e = 0; e < 4; ++e) { const unsigned a_ = qf[s & 1][2 * jt][e], b_ = qf[s & 1][2 * jt + 1][e]; n_[2 * e] = bflo(a_); n_[2 * e + 1] = bfhi(a_); n_[8 + 2 * e] = bflo(b_); n_[8 + 2 * e + 1] = bfhi(b_); }
#pragma unroll
                    for (int jt2 = 0; jt2 < 2; ++jt2)
#pragma unroll
                        for (int k = 0; k < 2; ++k) n_ = __builtin_amdgcn_mfma_f32_32x32x16_bf16(pf[s & 1][(jt * 2 + jt2) * 2 + k], B[jt2][k], n_, 0, 0, 0);
                    H[jt] = n_; }
#pragma unroll
                for (int jt = 0; jt < 2; ++jt)
#pragma unroll
                    for (int q = 0; q < 4; ++q) { const int row = 32 * it + cl, col = 32 * jt + 8 * q + 4 * hh;
                        *(LAS unsigned long long*)(hb + s * 8192 + sw16(row, col >> 3) + (col & 4) * 2) = (unsigned long long)pk2(H[jt][4 * q], H[jt][4 * q + 1]) | ((unsigned long long)pk2(H[jt][4 * q + 2], H[jt][4 * q + 3]) << 32); }
                if (step + PF < 255) RW_LOAD(s & 1, step + PF);
            }
        }
        asm volatile("s_waitcnt lgkmcnt(0)\n\ts_barrier" ::: "memory");
        if (!chain) {
            const int nst = (4 * g + 4 <= 255) ? 4 : 255 - 4 * g; unsigned char* dst = st + (size_t)(4 * g + 1) * 8192; const int ft = tid_ - 128;
            for (int o = ft * 16; o < nst * 8192; o += 384 * 16) { const int row_ = (o >> 7) & 63, chk_ = (o >> 4) & 7; *(v4u*)(dst + o) = *(const LAS v4u*)(hb + (o & ~8191) + sw16(row_, chk_)); }
        }
    }
    asm volatile("s_waitcnt vmcnt(0) lgkmcnt(0)\n\ts_barrier" ::: "memory");
#undef RW_LOAD
}

__device__ __forceinline__ void rwkv_r3(Frame& F, const Args& A) {
    PHASE_IDS();
    unsigned char* ws = A.ws;
    const bf16* VV = (const bf16*)(ws + WS_XN); const bf16* GG = (const bf16*)(ws + WS_F + 32 * MiB); const float* BON = (const float*)(ws + WS_BON);
    bf16* O = (bf16*)(ws + WS_F); const float* lg = A.in[16]; const float* lb = A.in[17];
    LAS float* Yt = (LAS float*)F.lds;
    const int w = wave_, l15 = lane_ & 15, kg = lane_ >> 4, r0 = 16 * (w >> 1), c0 = 32 * (w & 1);
#define R3_BAR() asm volatile("s_waitcnt lgkmcnt(0)\n\ts_barrier" ::: "memory")
    v4u nq, nvw, ngw; bf16x8 na[2], nb[2][2]; float nbon;
    const int pt_ = tid_ >> 3, pi0_ = 8 * (tid_ & 7);
#define R3_LOAD(itx) do { const int ch_ = (itx) >> 8, cc_ = (itx) & 255; const unsigned char* og_ = ws + pq_off(itx); const unsigned char* sg_ = (const unsigned char*)A.out + ST_OFF + (size_t)(itx) * 8192; \
        nq = *(const v4u*)((const unsigned char*)A.out + y0_off(itx, w * 64 + lane_)); \
        _Pragma("unroll") for (int ks = 0; ks < 2; ++ks) { na[ks] = *(const bf16x8*)(og_ + 16384 + (size_t)((r0 + l15) * 64 + 32 * ks + 8 * kg) * 2); \
            _Pragma("unroll") for (int n = 0; n < 2; ++n) nb[ks][n] = *(const bf16x8*)(sg_ + (size_t)((c0 + 16 * n + l15) * 64 + 32 * ks + 8 * kg) * 2); } \
        const size_t m_ = (size_t)(ch_ >> 3) * SEQ + (size_t)cc_ * 64 + pt_; const int col_ = 64 * (ch_ & 7) + pi0_; \
        nvw = *(const v4u*)(VV + m_ * 512 + col_); ngw = *(const v4u*)(GG + m_ * 512 + col_); nbon = BON[m_ * 8 + (ch_ & 7)]; } while (0)
    if ((int)blockIdx.x < CH_ITEMS) R3_LOAD((int)blockIdx.x);
    for (int it = blockIdx.x; it < CH_ITEMS; it += F.G) {
        const int ch = it >> 8, cc = it & 255, b = ch >> 3, h = ch & 7;
        f32x4c acc[2];
        acc[0] = (f32x4c){bflo(nq.x), bfhi(nq.x), bflo(nq.y), bfhi(nq.y)}; acc[1] = (f32x4c){bflo(nq.z), bfhi(nq.z), bflo(nq.w), bfhi(nq.w)};
#pragma unroll
        for (int ks = 0; ks < 2; ++ks)
#pragma unroll
            for (int n = 0; n < 2; ++n) acc[n] = __builtin_amdgcn_mfma_f32_16x16x32_bf16(na[ks], nb[ks][n], acc[n], 0, 0, 0);
        const v4u vw = nvw, gw4 = ngw; const float bon = nbon;
        if (it + F.G < CH_ITEMS) R3_LOAD(it + F.G);
        R3_BAR();
#pragma unroll
        for (int n = 0; n < 2; ++n)
#pragma unroll
            for (int e = 0; e < 4; ++e) Yt[(r0 + 4 * kg + e) * 68 + c0 + 16 * n + l15] = acc[n][e];
        R3_BAR();
        {   const int t = pt_, i0 = pi0_; const size_t m = (size_t)b * SEQ + (size_t)cc * 64 + t; const int col = 64 * h + i0;
            const f32x4 y0 = *(const LAS f32x4*)(Yt + t * 68 + i0), y1 = *(const LAS f32x4*)(Yt + t * 68 + i0 + 4);
            float s = (y0.x + y0.y) + (y0.z + y0.w) + (y1.x + y1.y) + (y1.z + y1.w);
            s += __shfl_xor(s, 1); s += __shfl_xor(s, 2); s += __shfl_xor(s, 4);
            const float mean = s * (1.f / 64.f); const f32x4 d0 = y0 - mean, d1 = y1 - mean;
            float q = (d0.x * d0.x + d0.y * d0.y) + (d0.z * d0.z + d0.w * d0.w) + (d1.x * d1.x + d1.y * d1.y) + (d1.z * d1.z + d1.w * d1.w);
            q += __shfl_xor(q, 1); q += __shfl_xor(q, 2); q += __shfl_xor(q, 4);
            const float rstd = 1.0f / sqrtf(q * (1.f / 64.f) + 64e-5f);
            const f32x4 g0 = *(const f32x4*)(lg + col), g1 = *(const f32x4*)(lg + col + 4), b0 = *(const f32x4*)(lb + col), b1 = *(const f32x4*)(lb + col + 4);
            f32x4 o0 = (d0 * rstd * g0 + b0), o1 = (d1 * rstd * g1 + b1);
            o0.x = (o0.x + bon * bflo(vw.x)) * bflo(gw4.x); o0.y = (o0.y + bon * bfhi(vw.x)) * bfhi(gw4.x); o0.z = (o0.z + bon * bflo(vw.y)) * bflo(gw4.y); o0.w = (o0.w + bon * bfhi(vw.y)) * bfhi(gw4.y);
            o1.x = (o1.x + bon * bflo(vw.z)) * bflo(gw4.z); o1.y = (o1.y + bon * bfhi(vw.z)) * bfhi(gw4.z); o1.z = (o1.z + bon * bflo(vw.w)) * bflo(gw4.w); o1.w = (o1.w + bon * bfhi(vw.w)) * bfhi(gw4.w);
            v4u ow; ow.x = pk2(o0.x, o0.y); ow.y = pk2(o0.z, o0.w); ow.z = pk2(o1.x, o1.y); ow.w = pk2(o1.z, o1.w);
            *(v4u*)(O + m * 512 + col) = ow; }
    }
#undef R3_BAR
#undef R3_LOAD
}

__device__ __forceinline__ void p_norm2_route(Frame& F, const Args& A) {
    PHASE_IDS();
    unsigned char* ws = A.ws;
    constexpr int WROW = 2064;
    LAS unsigned char* WH = F.lds; LAS unsigned char* WL = F.lds + 36 * WROW;
    LAS float* LG = (LAS float*)F.lds;
    LAS int* eid = (LAS int*)(F.lds + 128 * 36 * 4);
    const bf16* x1 = (const bf16*)(ws + WS_X1); const float* g2 = A.in[21]; const float* mod = (const float*)(ws + WS_MOD);
    const float* rgw = A.in[22]; const float* rgb = A.in[23]; const float* rew = A.in[24]; const float* reb = A.in[25];
    bf16* XN2 = (bf16*)(ws + WS_XN); int* route = (int*)(ws + WS_ROUTE); int* blkcnt = (int*)(ws + WS_BLKCNT);
    const int l15 = lane_ & 15, kg = lane_ >> 4;
    for (int blk = blockIdx.x; blk < M / 128; blk += F.G) {
        __syncthreads();
        for (int i = tid_; i < 4096; i += NWAVES * 64) { const float w = rgw[i]; const unsigned hi = f2bf(w); const unsigned lo = f2bf(w - __uint_as_float(hi << 16)); const int off = (i & 3) * WROW + (i >> 2) * 2;
            *(LAS unsigned short*)(WH + off) = (unsigned short)hi; *(LAS unsigned short*)(WL + off) = (unsigned short)lo; }
        for (int i = tid_; i < 32768; i += NWAVES * 64) { const float w = rew[i]; const unsigned hi = f2bf(w); const unsigned lo = f2bf(w - __uint_as_float(hi << 16)); const int off = (4 + (i & 31)) * WROW + (i >> 5) * 2;
            *(LAS unsigned short*)(WH + off) = (unsigned short)hi; *(LAS unsigned short*)(WL + off) = (unsigned short)lo; }
        __syncthreads();
        const int b = blk / (SEQ / 128); const size_t tok = (size_t)blk * 128 + wave_ * 16 + l15;
        const bf16* xrow = x1 + tok * D + 8 * kg; const float* gmp = g2 + 8 * kg; const float* scp = mod + b * 6144 + 4096 + 8 * kg; const float* shp = mod + b * 6144 + 3072 + 8 * kg;
        float ss = 0.f;
#pragma unroll 8
        for (int ks = 0; ks < 32; ++ks) { const v4u xw = *(const v4u*)(xrow + 32 * ks);
#pragma unroll
            for (int e = 0; e < 4; ++e) { const float lo_ = bflo(xw[e]), hi_ = bfhi(xw[e]); ss += lo_ * lo_ + hi_ * hi_; } }
        ss += __shfl_xor(ss, 16); ss += __shfl_xor(ss, 32);
        const float rstd = 1.0f / sqrtf(ss * (1.f / D) + 1e-6f);
        f32x4 acc[3]; acc[0] = f32x4{0.f, 0.f, 0.f, 0.f}; acc[1] = acc[0]; acc[2] = acc[0];
        int wcol[3];
#pragma unroll
        for (int ct = 0; ct < 3; ++ct) { const int col = 16 * ct + l15; wcol[ct] = (col < 36 ? col : 35) * WROW + 16 * kg; }
#pragma unroll 2
        for (int ks = 0; ks < 32; ++ks) {
            float hv[8];
            { const v4u xw = *(const v4u*)(xrow + 32 * ks); const f32x4 a = {bflo(xw.x), bfhi(xw.x), bflo(xw.y), bfhi(xw.y)}, c = {bflo(xw.z), bfhi(xw.z), bflo(xw.w), bfhi(xw.w)};
              const f32x4 g0 = *(const f32x4*)(gmp + 32 * ks), g1 = *(const f32x4*)(gmp + 32 * ks + 4), s0 = *(const f32x4*)(scp + 32 * ks), s1 = *(const f32x4*)(scp + 32 * ks + 4), h0 = *(const f32x4*)(shp + 32 * ks), h1 = *(const f32x4*)(shp + 32 * ks + 4);
              const f32x4 u0 = a * rstd * (g0 * (s0 + 1.0f)) + h0, u1 = c * rstd * (g1 * (s1 + 1.0f)) + h1;
              hv[0] = u0.x; hv[1] = u0.y; hv[2] = u0.z; hv[3] = u0.w; hv[4] = u1.x; hv[5] = u1.y; hv[6] = u1.z; hv[7] = u1.w; }
            unsigned hiw[4], low[4];
#pragma unroll
            for (int e = 0; e < 4; ++e) { const unsigned h0 = f2bf(hv[2 * e]), h1 = f2bf(hv[2 * e + 1]); hiw[e] = h0 | (h1 << 16);
                low[e] = f2bf(hv[2 * e] - __uint_as_float(h0 << 16)) | (f2bf(hv[2 * e + 1] - __uint_as_float(h1 << 16)) << 16); }
            v4u hq; hq.x = hiw[0]; hq.y = hiw[1]; hq.z = hiw[2]; hq.w = hiw[3];
            *(v4u*)(XN2 + tok * D + 32 * ks + 8 * kg) = hq;
            v4u lq; lq.x = low[0]; lq.y = low[1]; lq.z = low[2]; lq.w = low[3];
            const bf16x8 ah = __builtin_bit_cast(bf16x8, hq), al = __builtin_bit_cast(bf16x8, lq);
#pragma unroll
            for (int ct = 0; ct < 3; ++ct) { const bf16x8 bh = *(const LAS bf16x8*)(WH + wcol[ct] + 64 * ks), bl = *(const LAS bf16x8*)(WL + wcol[ct] + 64 * ks);
                acc[ct] = __builtin_amdgcn_mfma_f32_16x16x32_bf16(ah, bh, acc[ct], 0, 0, 0); acc[ct] = __builtin_amdgcn_mfma_f32_16x16x32_bf16(ah, bl, acc[ct], 0, 0, 0); acc[ct] = __builtin_amdgcn_mfma_f32_16x16x32_bf16(al, bh, acc[ct], 0, 0, 0); }
        }
        __syncthreads();
#pragma unroll
        for (int ct = 0; ct < 3; ++ct) { const int col = 16 * ct + l15; if (col < 36) { const float bias = (col < 4) ? rgb[col] : reb[col - 4];
#pragma unroll
            for (int e = 0; e < 4; ++e) LG[(wave_ * 16 + 4 * kg + e) * 36 + col] = acc[ct][e] + bias; } }
        __syncthreads();
        if (tid_ < 128) { const LAS float* lg = LG + tid_ * 36;
            int gi = 0; float gmax = lg[0];
#pragma unroll
            for (int i = 1; i < 4; ++i) if (lg[i] > gmax) { gmax = lg[i]; gi = i; }
            float den = 0.f;
#pragma unroll
            for (int i = 0; i < 4; ++i) den += __expf(lg[i] - gmax);
            const float gp = 1.0f / den;
            float el[8];
#pragma unroll
            for (int i = 0; i < 8; ++i) el[i] = lg[4 + 8 * gi + i];
            int i0 = 0; float m0 = el[0];
#pragma unroll
            for (int i = 1; i < 8; ++i) if (el[i] > m0) { m0 = el[i]; i0 = i; }
            int i1 = -1; float m1 = -INFINITY;
#pragma unroll
            for (int i = 0; i < 8; ++i) if (i != i0 && el[i] > m1) { m1 = el[i]; i1 = i; }
            if (i1 < 0) { i1 = (i0 + 1) & 7; m1 = m0; }
            const float p1 = __expf(m1 - m0), w0 = gp / (1.0f + p1), w1 = gp * p1 / (1.0f + p1);
            int* rt_ = route + ((size_t)blk * 128 + tid_) * 8; rt_[0] = gi * 8 + i0; rt_[1] = gi * 8 + i1; rt_[2] = __float_as_int(w0); rt_[3] = __float_as_int(w1);
            eid[tid_ * 2] = gi * 8 + i0; eid[tid_ * 2 + 1] = gi * 8 + i1; }
        __syncthreads();
        if (tid_ < 256) { const int e = eid[tid_]; int rk = 0; for (int a = 0; a < tid_; ++a) rk += (eid[a] == e) ? 1 : 0; route[((size_t)blk * 128 + (tid_ >> 1)) * 8 + 4 + (tid_ & 1)] = rk; }
        else if (tid_ < 288) { const int e = tid_ - 256; int cn = 0; for (int a = 0; a < 256; ++a) cn += (eid[a] == e) ? 1 : 0; blkcnt[blk * 32 + e] = cn; }
    }
}

__device__ __forceinline__ void conv_experts(Frame& F, const Args& A) {
    PHASE_IDS();
    unsigned char* ws = A.ws; bf16* W13 = (bf16*)(ws + WS_W13); bf16* W2T = (bf16*)(ws + WS_W2T);
    LAS float* scr = (LAS float*)(F.lds + RING_OFF + wave_ * 16384);
    const int gw = F.vcu * NWAVES + wave_, NGW = F.G * NWAVES;
    for (int it = gw; it < 3 * 8192; it += NGW) {
        const int which = it >> 13, r = it & 8191;
        if (which < 2) { const int e = r >> 8, kb = (r >> 4) & 15, nb = r & 15, n0 = 32 * nb;
            transpose_item(A.in[26 + which] + (size_t)e * 1024 * 512, 512, n0, 64 * kb, 1024, W13, (size_t)e * 1024 + (n0 >> 7) * 256 + which * 128 + (n0 & 127), scr, lane_); }
        else { const int e = r >> 8, kb = (r >> 5) & 7, nb = r & 31;
            transpose_item(A.in[28] + (size_t)e * 512 * 1024, 1024, 32 * nb, 64 * kb, 512, W2T, (size_t)e * 1024 + 32 * nb, scr, lane_); }
    }
}

__device__ __forceinline__ void p_slots(Frame& F, const Args& A) {
    PHASE_IDS();
    unsigned char* ws = A.ws;
    LAS int* tile_e = (LAS int*)(F.lds + TILE_OFF); LAS int* base = tile_e + 288; LAS int* tot = base + 32; LAS int* pre = tot + 32; LAS int* ntl = pre + 32; LAS int* part = ntl + 4;
    const int* blkcnt = (const int*)(ws + WS_BLKCNT); int* route = (int*)(ws + WS_ROUTE); int* rowtok = (int*)(ws + WS_ROWTOK);
    { const int e = tid_ & 31, pt = tid_ >> 5; int s = 0; for (int bb = 16 * pt; bb < 16 * pt + 16; ++bb) s += blkcnt[bb * 32 + e]; part[pt * 32 + e] = s; }
    __syncthreads();
    if (tid_ < 32) { int t = 0; for (int p = 0; p < 16; ++p) t += part[p * 32 + tid_]; tot[tid_] = t; }
    __syncthreads();
    if (tid_ == 0) { int run = 0, nt = 0; for (int e = 0; e < 32; ++e) { base[e] = run; const int pad = (tot[e] + 255) >> 8; for (int i = 0; i < pad; ++i) tile_e[nt++] = e; run += pad * 256; } ntl[0] = nt; }
    __syncthreads();
    for (int blk = blockIdx.x; blk < M / 128; blk += F.G) {
        { const int e = tid_ & 31, pt = tid_ >> 5; int s = 0; for (int bb = pt; bb < blk; bb += 16) s += blkcnt[bb * 32 + e]; part[pt * 32 + e] = s; }
        __syncthreads();
        if (tid_ < 32) { int p = 0; for (int q = 0; q < 16; ++q) p += part[q * 32 + tid_]; pre[tid_] = p; }
        __syncthreads();
        if (tid_ < 256) { const size_t tok = (size_t)blk * 128 + (tid_ >> 1); const int k = tid_ & 1; const int e = route[tok * 8 + k], lr = route[tok * 8 + 4 + k];
            const int slot = base[e] + pre[e] + lr; route[tok * 8 + 6 + k] = slot; rowtok[slot] = (int)tok; }
        __syncthreads();
    }
    for (int e = blockIdx.x; e < 32; e += F.G) { const int lo = base[e] + tot[e], hi = base[e] + (((tot[e] + 255) >> 8) << 8); for (int s = lo + tid_; s < hi; s += NWAVES * 64) rowtok[s] = 0; }
}

#ifndef STAGE_UNUSED
#define STAGE 4
#endif
#ifndef PHASES
#define PHASES 0xffff
#endif
#ifndef RWKV_CHUNKED
#define RWKV_CHUNKED 1
#endif

__device__ __forceinline__ void ph_gemm1(Frame& F, const Args& args) { unsigned char* ws = args.ws;
    pg8::Gemm g{(const pg8::bf16_t*)(ws + WS_XN), (const pg8::bf16_t*)(ws + WS_WIN), nullptr, 1024, NIN};
    pg8::StaticOrder S; S.init(M, NIN, F.G, (int)blockIdx.x);
    pg8::EpiIn E{(pg8::bf16_t*)(ws + WS_Q), (pg8::bf16_t*)(ws + WS_K), (pg8::bf16_t*)(ws + WS_V), (pg8::bf16_t*)(ws + WS_PRW), (pg8::bf16_t*)(ws + WS_GATES), ATT_C2};
    pg8::gemm_phase<pg8::EpiIn, pg8::StaticOrder>(F.lds + RING_OFF, g, S, E); }
__device__ __forceinline__ void ph_attn_wrap(unsigned char* lds, Frame& F, const Args& args, size_t out_off, int qslot) { unsigned char* ws = args.ws;
    const attn_body::AttnTensors AT{(const attn_body::bf16*)(ws + WS_Q), (const attn_body::bf16*)(ws + WS_K), (const attn_body::bf16*)(ws + WS_V), (attn_body::bf16*)(ws + out_off), (const float*)(ws + WS_CUM), (const float*)(ws + WS_SEGTOT)};
    attn_body::attn_phase_dyn<8>((char*)lds + RING_OFF, AT, (unsigned*)(F.ctl + CW_QUEUE + 64 * qslot), (const unsigned*)(F.ctl + CW_QKMAX), TAB_OFF, SEGP_OFF); }
__device__ __forceinline__ void ph_gemm2a(Frame& F, const Args& args) { unsigned char* ws = args.ws;
    pg8::Gemm g{(const pg8::bf16_t*)(ws + WS_Q), (const pg8::bf16_t*)(ws + WS_WOF), nullptr, 512, 1024};
    pg8::StaticOrder S; S.init(M, 1024, F.G, (int)blockIdx.x);
    pg8::EpiGate<1> E{(pg8::bf16_t*)(ws + WS_TMP), 1024, (const pg8::bf16_t*)(ws + WS_GATES), 2048, 0};
    pg8::gemm_phase<pg8::EpiGate<1>, pg8::StaticOrder>(F.lds + RING_OFF, g, S, E); }
__device__ __forceinline__ void ph_gemm2b(Frame& F, const Args& args) { unsigned char* ws = args.ws;
    pg8::Gemm g{(const pg8::bf16_t*)(ws + WS_F), (const pg8::bf16_t*)(ws + WS_WOR), nullptr, 512, 1024};
    pg8::StaticOrder S; S.init(M, 1024, F.G, (int)blockIdx.x);
    pg8::EpiGate<2> E{(pg8::bf16_t*)(ws + WS_TMP), 1024, (const pg8::bf16_t*)(ws + WS_GATES), 2048, 1024};
    pg8::gemm_phase<pg8::EpiGate<2>, pg8::StaticOrder>(F.lds + RING_OFF, g, S, E); }
__device__ __forceinline__ void ph_gemm3(Frame& F, const Args& args) { unsigned char* ws = args.ws;
    pg8::Gemm g{(const pg8::bf16_t*)(ws + WS_TMP), (const pg8::bf16_t*)(ws + WS_WO), nullptr, 1024, 1024};
    pg8::StaticOrder S; S.init(M, 1024, F.G, (int)blockIdx.x);
    pg8::EpiRes E{args.in[0], (pg8::bf16_t*)(ws + WS_X1), (const float*)(ws + WS_MOD) + 2048, SEQ, 6144};
    pg8::gemm_phase<pg8::EpiRes, pg8::StaticOrder>(F.lds + RING_OFF, g, S, E); }
__device__ __forceinline__ void ph_moe_up(Frame& F, const Args& args) { unsigned char* ws = args.ws;
    const LAS int* tile_e = (const LAS int*)(F.lds + TILE_OFF); const int ntiles = tile_e[288 + 96];
    LAS int* rows = (LAS int*)(F.lds + TILE_OFF + 4096);
    { const int* rowtok = (const int*)(ws + WS_ROWTOK); int tid_ = threadIdx.x; asm volatile("" : "+v"(tid_));
      for (int i = 0; i < 8; ++i) { const int L = i * F.G + (int)blockIdx.x; if (L >= ntiles * 4) break; if (tid_ < 256) rows[i * 256 + tid_] = rowtok[(L >> 2) * 256 + tid_]; }
      __syncthreads(); }
    pg8::Gemm g{(const pg8::bf16_t*)(ws + WS_XN), (const pg8::bf16_t*)(ws + WS_W13), rows, 1024, 1024};
    pg8::MoeOrder S{ntiles * 4, F.G, (int)blockIdx.x, 2, tile_e};
    pg8::EpiSwiGLU E{(pg8::bf16_t*)(ws + WS_H)};
    pg8::gemm_phase<pg8::EpiSwiGLU, pg8::MoeOrder, true>(F.lds + RING_OFF, g, S, E); }
__device__ __forceinline__ void ph_moe_down(Frame& F, const Args& args) { unsigned char* ws = args.ws;
    const LAS int* tile_e = (const LAS int*)(F.lds + TILE_OFF); const int ntiles = tile_e[288 + 96];
    pg8::Gemm g{(const pg8::bf16_t*)(ws + WS_H), (const pg8::bf16_t*)(ws + WS_W2T), nullptr, 512, 1024};
    pg8::MoeOrder S{ntiles * 4, F.G, (int)blockIdx.x, 2, tile_e};
    pg8::EpiFp8 E{ws + WS_YM, 1024};
    pg8::gemm_phase<pg8::EpiFp8, pg8::MoeOrder>(F.lds + RING_OFF, g, S, E); }

__global__ void __launch_bounds__(NWAVES * 64, 2) fwd_kernel(Args args) {
    extern __shared__ __attribute__((aligned(16))) unsigned char lds[];
    Frame F;
    F.lds = (LAS unsigned char*)lds;
    F.MISC = (volatile LAS unsigned*)(F.lds + MISC_OFF);
    F.tid = threadIdx.x; F.lane = F.tid & 63; F.wave = __builtin_amdgcn_readfirstlane(F.tid >> 6);
    F.G = gridDim.x; { const int bx = blockIdx.x; F.vcu = (F.G % 8 == 0) ? (bx % 8) * (F.G / 8) + bx / 8 : bx; }
    unsigned char* ws = args.ws;
    F.ctl = (gu32*)(ws + WS_CTL);
    for (int u = F.tid; u < (LDS_BYTES - LDSCTL_OFF) / 4; u += NWAVES * 64) ((LAS unsigned*)(F.lds + LDSCTL_OFF))[u] = 0u;
    __syncthreads();
    XcdBarrier bar = xcd_barrier_post((unsigned*)(F.ctl + CW_BAR), F.MISC + 8);
#define GRID_BAR() xcd_barrier(bar)

    p0_prologue(F, args); GRID_BAR();
    p1_norm(F, args); __syncthreads(); p_convert_early(F, args); GRID_BAR();
    p_cumfix(F, args);
    ph_gemm1(F, args); GRID_BAR();
    p_qknorm(F, args, (unsigned*)(F.ctl + CW_QKMAX));
    for (int cb = (int)blockIdx.x; cb < SEQ / 64; cb += F.G)
    for (int half = 0; half < 2; ++half) {
        rwkv_pre<0>(F, args, cb + 256 * half, cb + 256 * half + 1);
        __syncthreads();
        rwkv_r1<0>(F, args, cb + 2048 * half, cb + 2048 * half + 2048, 256);
        __syncthreads();
    }
    GRID_BAR();
    rwkv_r2w(F, args, (unsigned char*)args.out + ST_OFF);
#ifdef PROBE_R2
    rwkv_r2w(F, args, (unsigned char*)args.out + ST_OFF);
#endif
#ifdef PROBE_SER
    GRID_BAR();
#endif
    ph_attn_wrap(lds, F, args, WS_Q, 0); GRID_BAR();
    rwkv_r3(F, args); GRID_BAR();
    ph_gemm2a(F, args);
    ph_gemm2b(F, args); GRID_BAR();
    ph_gemm3(F, args); GRID_BAR();
    p_norm2_route(F, args); GRID_BAR();
    p_slots(F, args); conv_experts(F, args); GRID_BAR();
    ph_moe_up(F, args); GRID_BAR();
    ph_moe_down(F, args); GRID_BAR();
    p_final<1>(F, args, args.out);
}

extern "C" void kernel_launch(void* const* d_in, const int* in_sizes, int n_in, void* d_out, int out_size, void* d_ws, size_t ws_size, hipStream_t stream) {
    static int grid = 0;
    if (grid == 0) {
        if (n_in != 30 || in_sizes[0] != M * D || out_size != M * D || ws_size < WS_END) { fprintf(stderr, "kernel_launch: unexpected shapes (n_in %d, in0 %d, out %d, ws %zu)\n", n_in, n_in > 0 ? in_sizes[0] : -1, out_size, ws_size); grid = -1; return; }
        int dev = 0, cus = 0, per_cu = 0;
        if (hipGetDevice(&dev) != hipSuccess || hipDeviceGetAttribute(&cus, hipDeviceAttributeMultiprocessorCount, dev) != hipSuccess) { grid = -1; return; }
        if (hipFuncSetAttribute((const void*)fwd_kernel, hipFuncAttributeMaxDynamicSharedMemorySize, LDS_BYTES) != hipSuccess) { fprintf(stderr, "kernel_launch: hipFuncSetAttribute failed\n"); grid = -1; return; }
        if (hipOccupancyMaxActiveBlocksPerMultiprocessor(&per_cu, (const void*)fwd_kernel, NWAVES * 64, LDS_BYTES) != hipSuccess || per_cu < 1)
            fprintf(stderr, "kernel_launch: occupancy query reports %d\n", per_cu);
        (void)hipGetLastError();
        grid = cus;
        if (grid > 256) grid = 256;
    }
    if (grid < 0) return;
    if (hipMemsetAsync((char*)d_ws + WS_CTL, 0, CTL_ZERO_BYTES, stream) != hipSuccess) return;
    Args a{};
    for (int i = 0; i < 30; ++i) a.in[i] = (const float*)d_in[i];
    a.out = (float*)d_out; a.ws = (unsigned char*)d_ws;
    hipLaunchKernelGGL(fwd_kernel, dim3(grid), dim3(NWAVES * 64), LDS_BYTES, stream, a);
}
```

```cpp
#include <hip/hip_runtime.h>
#include <hip/hip_bf16.h>
#include <cstdio>
#include <cstdint>
#include <cmath>

namespace pg8 {
#define PG8_LAS __attribute__((address_space(3)))
typedef unsigned short bf16_t;
typedef short bf16x8 __attribute__((ext_vector_type(8)));
typedef float f32x4 __attribute__((ext_vector_type(4)));
typedef unsigned u32x4 __attribute__((ext_vector_type(4)));
typedef unsigned u32x2 __attribute__((ext_vector_type(2)));
constexpr int BM = 256, BK = 64, HALF = 128, HTB = HALF * BK * 2, STAGE_BYTES = 8 * HTB, NXCD = 8, WGM = 8;

__host__ __device__ __forceinline__ int lds_byte(int r, int c) { const int st = (r >> 4) * 2 + (c >> 5), rr = r & 15, cc = c & 31, ob = rr * 64 + cc * 2; return st * 1024 + (ob ^ (((ob >> 9) & 1) << 5)); }
__host__ __device__ __forceinline__ void stage_rc(int b, int& R, int& C) { const int st = b / 1024, sb = b % 1024, swz = sb ^ (((sb >> 9) & 1) << 5); R = (st >> 1) * 16 + swz / 64; C = (st & 1) * 32 + (swz % 64) / 2; }
__host__ __device__ __forceinline__ int perm32(int rho) { const int n = rho >> 4, i = rho & 15; return 8 * (i >> 2) + 4 * n + (i & 3); }

struct Unit { int pm, pn, e; };
struct Gemm { const bf16_t* A; const bf16_t* Bt; const PG8_LAS int* rowlds; int K; int nB; };

struct StaticOrder {
    int nM, nN, nwg, G, c;
    __host__ __device__ void init(int M, int N, int G_, int c_) { nM = M / BM; nN = N / BM; nwg = nM * nN; G = G_; c = c_; }
    __host__ __device__ bool next(int i, Unit& u) const {
        const long L = (long)i * G + c; if (L >= nwg) return false;
        int wgid = (int)L; { const int q = nwg / NXCD, r = nwg % NXCD, xcd = wgid % NXCD, off = wgid / NXCD; wgid = (xcd < r ? xcd * (q + 1) : r * (q + 1) + (xcd - r) * q) + off; }
        const int nig = WGM * nN, gid = wgid / nig, fm = gid * WGM, gsz = (nM - fm) < WGM ? (nM - fm) : WGM;
        u.pm = fm + ((wgid % nig) % gsz); u.pn = (wgid % nig) / gsz; u.e = 0; return true;
    }
};

__device__ __forceinline__ unsigned cvt_pk_bf16(float lo, float hi) { unsigned r; asm volatile("v_cvt_pk_bf16_f32 %0, %1, %2" : "=v"(r) : "v"(lo), "v"(hi)); return r; }
__device__ __forceinline__ float bf_lo(unsigned w) { return __uint_as_float(w << 16); }
__device__ __forceinline__ float bf_hi(unsigned w) { return __uint_as_float(w & 0xffff0000u); }
__device__ __forceinline__ float fsigmoid(float x) { return __builtin_amdgcn_rcpf(1.0f + __builtin_amdgcn_exp2f(-1.4426950408889634f * x)); }

template <class Epi, class Sched, bool GATHER = false>
__device__ __forceinline__ void gemm_phase(PG8_LAS unsigned char* lds, const Gemm g, const Sched& S, const Epi& E) {
    int tid_ = threadIdx.x; asm volatile("" : "+v"(tid_));
    const int tid = tid_, wid = __builtin_amdgcn_readfirstlane(tid >> 6), lane = tid & 63, wr = wid >> 2, wc = wid & 3, fr = lane & 15, fq = lane >> 4;
    const int K = g.K, nt = K / BK;
    int RA[2], CA[2]; unsigned voffA[2], voffB[2];
#pragma unroll
    for (int i = 0; i < 2; ++i) { int R, C; stage_rc(tid * 16 + i * 8192, R, C); const int Rb = Epi::PERM ? ((R & ~31) + perm32(R & 31)) : R;
        RA[i] = R; CA[i] = C; voffA[i] = (unsigned)(R * K + C) * 2u; voffB[i] = (unsigned)(Rb * K + C) * 2u; }
    const size_t tstep = 2 * (size_t)HALF * K * 2;
    const size_t kstep = (size_t)(BK * 2);
    const size_t hstep = (size_t)HALF * K * 2;
    const unsigned ldsw = (unsigned)wid * 1024u;
    const int aoff = lds_byte(wr * 64 + fr, fq * 8), boff = lds_byte(wc * 32 + fr, fq * 8);
#define PG8_SA(b, h) (((b) * 2 + (h)) * HTB)
#define PG8_SB(b, h) ((4 + (b) * 2 + (h)) * HTB)
#define PG8_STAGE(bufoff, gbase, v0, v1) do { \
        __builtin_amdgcn_global_load_lds((const unsigned*)((const char*)(gbase) + (v0)), (PG8_LAS unsigned*)(lds + (bufoff) + ldsw), 16, 0, 0); \
        __builtin_amdgcn_global_load_lds((const unsigned*)((const char*)(gbase) + (v1)), (PG8_LAS unsigned*)(lds + (bufoff) + ldsw + 8192), 16, 0, 0); } while (0)
#define PG8_STAGEB(bufoff, gbase) PG8_STAGE(bufoff, gbase, voffB[0], voffB[1])
#define PG8_STAGEA(bufoff, abase, h, VA) do { if constexpr (GATHER) { PG8_STAGE(bufoff, abase, VA[h][0], VA[h][1]); } else { PG8_STAGE(bufoff, (abase) + (h) * hstep, voffA[0], voffA[1]); } } while (0)
#define PG8_LDA(dst, b, h) do { _Pragma("unroll") for (int m = 0; m < 4; ++m) _Pragma("unroll") for (int k = 0; k < 2; ++k) dst[m][k] = *(const PG8_LAS bf16x8*)(lds + PG8_SA(b, h) + aoff + m * 2048 + k * 1024); } while (0)
#define PG8_LDB(dst, b, h) do { _Pragma("unroll") for (int n = 0; n < 2; ++n) _Pragma("unroll") for (int k = 0; k < 2; ++k) dst[n][k] = *(const PG8_LAS bf16x8*)(lds + PG8_SB(b, h) + boff + n * 2048 + k * 1024); } while (0)
#define PG8_MMA(ai, bj, At, Bt) do { __builtin_amdgcn_s_setprio(1); _Pragma("unroll") for (int m = 0; m < 4; ++m) _Pragma("unroll") for (int n = 0; n < 2; ++n) _Pragma("unroll") for (int k = 0; k < 2; ++k) \
        acc[ai][bj][m][n] = __builtin_amdgcn_mfma_f32_16x16x32_bf16(Bt[n][k], At[m][k], acc[ai][bj][m][n], 0, 0, 0); __builtin_amdgcn_s_setprio(0); } while (0)
#define PG8_WAIT_V(n) asm volatile("s_waitcnt vmcnt(" #n ")" ::: "memory")
#define PG8_WAIT_L(n) asm volatile("s_waitcnt lgkmcnt(" #n ")" ::: "memory")
#define PG8_BAR __builtin_amdgcn_s_barrier()
#define PG8_SCHED __builtin_amdgcn_sched_barrier(0)
#define PG8_AOFF(dst, ord) do { _Pragma("unroll") for (int h_ = 0; h_ < 2; ++h_) _Pragma("unroll") for (int i_ = 0; i_ < 2; ++i_) { \
        const int src_ = g.rowlds[(ord) * BM + h_ * HALF + RA[i_]]; dst[h_][i_] = (unsigned)(src_ * K + CA[i_]) * 2u; } } while (0)
    Unit cur, nxt; int ui = 0;
    if (!S.next(0, cur)) return;
    f32x4 acc[2][2][4][2];
#pragma unroll
    for (int a = 0; a < 2; ++a)
#pragma unroll
        for (int b = 0; b < 2; ++b)
#pragma unroll
            for (int m = 0; m < 4; ++m)
#pragma unroll
                for (int n = 0; n < 2; ++n) acc[a][b][m][n] = (f32x4){0.f, 0.f, 0.f, 0.f};
    bf16x8 At[4][2], B0[2][2], B1[2][2];
    unsigned vA[2][2], nvA[2][2];
    if constexpr (GATHER) { PG8_AOFF(vA, 0); }
    const char* cA = GATHER ? (const char*)g.A : (const char*)g.A + (size_t)cur.pm * tstep;
    const char* cB = (const char*)g.Bt + ((size_t)cur.e * g.nB + (size_t)cur.pn * BM) * K * 2;
    PG8_STAGEB(PG8_SB(0, 0), cB); PG8_STAGEB(PG8_SB(0, 1), cB + hstep); PG8_STAGEA(PG8_SA(0, 0), cA, 0, vA); PG8_STAGEA(PG8_SA(0, 1), cA, 1, vA);
    if (wr == 1) PG8_BAR;
    PG8_WAIT_V(2); PG8_BAR;
    PG8_STAGEB(PG8_SB(1, 0), cB + kstep); PG8_STAGEA(PG8_SA(1, 0), cA + kstep, 0, vA); PG8_STAGEB(PG8_SB(1, 1), cB + hstep + kstep);
    PG8_WAIT_V(6); PG8_BAR;
    for (;;) {
        const bool has_next = S.next(ui + 1, nxt);
        if constexpr (GATHER) { if (has_next) { PG8_AOFF(nvA, ui + 1); } else {
#pragma unroll
            for (int h_ = 0; h_ < 2; ++h_)
#pragma unroll
                for (int i_ = 0; i_ < 2; ++i_) nvA[h_][i_] = vA[h_][i_]; } }
        const char* nA = GATHER ? cA : (has_next ? (const char*)g.A + (size_t)nxt.pm * tstep : cA);
        const char* nB = has_next ? (const char*)g.Bt + ((size_t)nxt.e * g.nB + (size_t)nxt.pn * BM) * K * 2 : cB;
        for (int t = 0; t < nt; t += 2) {
            const bool last = (t == nt - 2);
            const char* a1 = cA + (size_t)(t + 1) * kstep;
            const char* a2 = last ? nA : cA + (size_t)(t + 2) * kstep; const char* b2 = last ? nB : cB + (size_t)(t + 2) * kstep;
            const char* a3 = a2 + kstep; const char* b3 = b2 + kstep;
            unsigned wv[2][2];
            if constexpr (GATHER) { wv[0][0] = last ? nvA[0][0] : vA[0][0]; wv[0][1] = last ? nvA[0][1] : vA[0][1]; wv[1][0] = last ? nvA[1][0] : vA[1][0]; wv[1][1] = last ? nvA[1][1] : vA[1][1]; }
            PG8_LDB(B0, 0, 0); PG8_LDB(B1, 0, 1); PG8_SCHED; PG8_LDA(At, 0, 0); PG8_STAGEA(PG8_SA(1, 1), a1, 1, vA);
            PG8_WAIT_V(8); PG8_WAIT_L(0); PG8_BAR; PG8_MMA(0, 0, At, B0); PG8_MMA(0, 1, At, B1); PG8_BAR; PG8_SCHED;
            PG8_LDA(At, 0, 1); PG8_STAGEB(PG8_SB(0, 0), b2); PG8_STAGEB(PG8_SB(0, 1), b2 + hstep); PG8_STAGEA(PG8_SA(0, 0), a2, 0, wv);
            PG8_WAIT_V(8); PG8_WAIT_L(0); PG8_BAR; PG8_MMA(1, 0, At, B0); PG8_MMA(1, 1, At, B1); PG8_BAR; PG8_SCHED;
            PG8_LDB(B0, 1, 0); PG8_LDB(B1, 1, 1); PG8_SCHED; PG8_LDA(At, 1, 0); PG8_STAGEA(PG8_SA(0, 1), a2, 1, wv);
            PG8_WAIT_V(8); PG8_WAIT_L(0); PG8_BAR; PG8_MMA(0, 0, At, B0); PG8_MMA(0, 1, At, B1); PG8_BAR; PG8_SCHED;
            PG8_LDA(At, 1, 1); PG8_STAGEB(PG8_SB(1, 0), b3); PG8_STAGEB(PG8_SB(1, 1), b3 + hstep); PG8_STAGEA(PG8_SA(1, 0), a3, 0, wv);
            PG8_WAIT_V(8); PG8_WAIT_L(0); PG8_BAR; PG8_MMA(1, 0, At, B0); PG8_MMA(1, 1, At, B1); PG8_BAR; PG8_SCHED;
        }
        if (wr == 0) PG8_BAR;
        E(acc, cur, wr, wc, fr, fq);
        if (!has_next) break;
#pragma unroll
        for (int a = 0; a < 2; ++a)
#pragma unroll
            for (int b = 0; b < 2; ++b)
#pragma unroll
                for (int m = 0; m < 4; ++m)
#pragma unroll
                    for (int n = 0; n < 2; ++n) acc[a][b][m][n] = (f32x4){0.f, 0.f, 0.f, 0.f};
        cur = nxt; cB = nB; cA = nA; ++ui;
        if constexpr (GATHER) {
#pragma unroll
        for (int h_ = 0; h_ < 2; ++h_)
#pragma unroll
            for (int i_ = 0; i_ < 2; ++i_) vA[h_][i_] = nvA[h_][i_]; }
        if (wr == 1) PG8_BAR;
    }
    PG8_WAIT_V(0);
    PG8_BAR;
#undef PG8_SA
#undef PG8_SB
#undef PG8_STAGE
#undef PG8_STAGEB
#undef PG8_STAGEA
#undef PG8_LDA
#undef PG8_LDB
#undef PG8_MMA
#undef PG8_WAIT_V
#undef PG8_WAIT_L
#undef PG8_BAR
#undef PG8_SCHED
#undef PG8_AOFF
}
}

namespace pg8 {
struct EpiIn {
    static constexpr bool PERM = true;
    bf16_t *Q, *Kb, *V, *PRW, *GT; float qscale;
    __device__ __forceinline__ void operator()(const f32x4 (&acc)[2][2][4][2], const Unit& u, int wr, int wc, int fr, int fq) const {
        const int pn = u.pn; bf16_t* base; int ld, colt, mode = 0;
        if (pn < 2) { base = Q; ld = 512; colt = pn * 256; mode = 1; }
        else if (pn < 4) { base = Kb; ld = 512; colt = (pn - 2) * 256; }
        else if (pn < 6) { base = V; ld = 512; colt = (pn - 4) * 256; }
        else if (pn < 13) { base = PRW; ld = 1792; colt = (pn - 6) * 256; }
        else { base = GT; ld = 2048; colt = (pn - 13) * 256; mode = 2; }
        const int row0 = u.pm * BM + wr * 64 + fr, col0 = colt + wc * 32 + 8 * fq;
        const float sc = (mode == 1) ? qscale : 1.0f;
#pragma unroll
        for (int ai = 0; ai < 2; ++ai)
#pragma unroll
            for (int m = 0; m < 4; ++m) { bf16_t* rowp = base + (size_t)(row0 + ai * HALF + m * 16) * ld + col0;
#pragma unroll
                for (int bj = 0; bj < 2; ++bj) { f32x4 v0 = acc[ai][bj][m][0] * sc, v1 = acc[ai][bj][m][1] * sc;
                    if (mode == 2) {
#pragma unroll
                        for (int e = 0; e < 4; ++e) { v0[e] = fsigmoid(v0[e]); v1[e] = fsigmoid(v1[e]); } }
                    u32x4 w; w.x = cvt_pk_bf16(v0[0], v0[1]); w.y = cvt_pk_bf16(v0[2], v0[3]); w.z = cvt_pk_bf16(v1[0], v1[1]); w.w = cvt_pk_bf16(v1[2], v1[3]);
                    *(u32x4*)(rowp + bj * HALF) = w; } }
    }
};
template <int MODE> struct EpiGate {
    static constexpr bool PERM = true;
    bf16_t* O; int ldo; const bf16_t* G; int ldg; int gcol0;
    __device__ __forceinline__ void operator()(const f32x4 (&acc)[2][2][4][2], const Unit& u, int wr, int wc, int fr, int fq) const {
        const int row0 = u.pm * BM + wr * 64 + fr, col0 = u.pn * BM + wc * 32 + 8 * fq;
#pragma unroll
        for (int ai = 0; ai < 2; ++ai)
#pragma unroll
            for (int m = 0; m < 4; ++m) { const size_t row = (size_t)(row0 + ai * HALF + m * 16); bf16_t* rowp = O + row * ldo + col0;
#pragma unroll
                for (int bj = 0; bj < 2; ++bj) { f32x4 v0 = acc[ai][bj][m][0], v1 = acc[ai][bj][m][1];
                    if (MODE >= 1) { const u32x4 gw = *(const u32x4*)(G + row * ldg + gcol0 + col0 + bj * HALF);
                        v0[0] *= bf_lo(gw.x); v0[1] *= bf_hi(gw.x); v0[2] *= bf_lo(gw.y); v0[3] *= bf_hi(gw.y); v1[0] *= bf_lo(gw.z); v1[1] *= bf_hi(gw.z); v1[2] *= bf_lo(gw.w); v1[3] *= bf_hi(gw.w); }
                    if (MODE == 2) { const u32x4 ow = *(const u32x4*)(rowp + bj * HALF);
                        v0[0] += bf_lo(ow.x); v0[1] += bf_hi(ow.x); v0[2] += bf_lo(ow.y); v0[3] += bf_hi(ow.y); v1[0] += bf_lo(ow.z); v1[1] += bf_hi(ow.z); v1[2] += bf_lo(ow.w); v1[3] += bf_hi(ow.w); }
                    u32x4 w; w.x = cvt_pk_bf16(v0[0], v0[1]); w.y = cvt_pk_bf16(v0[2], v0[3]); w.z = cvt_pk_bf16(v1[0], v1[1]); w.w = cvt_pk_bf16(v1[2], v1[3]);
                    *(u32x4*)(rowp + bj * HALF) = w; } }
    }
};
struct EpiRes {
    static constexpr bool PERM = true;
    const float* X; bf16_t* O; const float* gate; int seq; int gstride;
    __device__ __forceinline__ void operator()(const f32x4 (&acc)[2][2][4][2], const Unit& u, int wr, int wc, int fr, int fq) const {
        const int row0 = u.pm * BM + wr * 64 + fr, col0 = u.pn * BM + wc * 32 + 8 * fq;
        const float* gp = gate + (size_t)((u.pm * BM) / seq) * gstride + col0;
        f32x4 gv[2][2];
#pragma unroll
        for (int bj = 0; bj < 2; ++bj)
#pragma unroll
            for (int n = 0; n < 2; ++n) gv[bj][n] = *(const f32x4*)(gp + bj * HALF + n * 4);
#pragma unroll
        for (int ai = 0; ai < 2; ++ai)
#pragma unroll
            for (int m = 0; m < 4; ++m) { const size_t off = (size_t)(row0 + ai * HALF + m * 16) * 1024 + col0;
#pragma unroll
                for (int bj = 0; bj < 2; ++bj) { const f32x4 x0 = *(const f32x4*)(X + off + bj * HALF), x1 = *(const f32x4*)(X + off + bj * HALF + 4);
                    const f32x4 v0 = x0 + gv[bj][0] * acc[ai][bj][m][0], v1 = x1 + gv[bj][1] * acc[ai][bj][m][1];
                    u32x4 w; w.x = cvt_pk_bf16(v0[0], v0[1]); w.y = cvt_pk_bf16(v0[2], v0[3]); w.z = cvt_pk_bf16(v1[0], v1[1]); w.w = cvt_pk_bf16(v1[2], v1[3]);
                    *(u32x4*)(O + off + bj * HALF) = w; } }
    }
};
struct EpiSwiGLU {
    static constexpr bool PERM = true;
    bf16_t* H;
    __device__ __forceinline__ void operator()(const f32x4 (&acc)[2][2][4][2], const Unit& u, int wr, int wc, int fr, int fq) const {
        const int row0 = u.pm * BM + wr * 64 + fr, col0 = u.pn * HALF + wc * 32 + 8 * fq;
#pragma unroll
        for (int ai = 0; ai < 2; ++ai)
#pragma unroll
            for (int m = 0; m < 4; ++m) { bf16_t* rowp = H + (size_t)(row0 + ai * HALF + m * 16) * 512 + col0;
                f32x4 v0, v1;
#pragma unroll
                for (int e = 0; e < 4; ++e) { const float a0 = acc[ai][0][m][0][e], a1 = acc[ai][0][m][1][e];
                    v0[e] = a0 * fsigmoid(a0) * acc[ai][1][m][0][e]; v1[e] = a1 * fsigmoid(a1) * acc[ai][1][m][1][e]; }
                u32x4 w; w.x = cvt_pk_bf16(v0[0], v0[1]); w.y = cvt_pk_bf16(v0[2], v0[3]); w.z = cvt_pk_bf16(v1[0], v1[1]); w.w = cvt_pk_bf16(v1[2], v1[3]);
                *(u32x4*)rowp = w; }
    }
};
struct EpiFp8 {
    static constexpr bool PERM = true;
    unsigned char* O; int ldo;
    __device__ __forceinline__ void operator()(const f32x4 (&acc)[2][2][4][2], const Unit& u, int wr, int wc, int fr, int fq) const {
        const int row0 = u.pm * BM + wr * 64 + fr, col0 = u.pn * BM + wc * 32 + 8 * fq;
#pragma unroll
        for (int ai = 0; ai < 2; ++ai)
#pragma unroll
            for (int m = 0; m < 4; ++m) { unsigned char* rowp = O + (size_t)(row0 + ai * HALF + m * 16) * ldo + col0;
#pragma unroll
                for (int bj = 0; bj < 2; ++bj) { const f32x4 v0 = acc[ai][bj][m][0], v1 = acc[ai][bj][m][1];
                    int lo = __builtin_amdgcn_cvt_pk_fp8_f32(v0[0], v0[1], 0, false); lo = __builtin_amdgcn_cvt_pk_fp8_f32(v0[2], v0[3], lo, true);
                    int hi = __builtin_amdgcn_cvt_pk_fp8_f32(v1[0], v1[1], 0, false); hi = __builtin_amdgcn_cvt_pk_fp8_f32(v1[2], v1[3], hi, true);
                    *(u32x2*)(rowp + bj * HALF) = (u32x2){(unsigned)lo, (unsigned)hi}; } }
    }
};
struct MoeOrder {
    int nunits, G, c, cshift; const PG8_LAS int* tile_e;
    __device__ __forceinline__ bool next(int i, Unit& u) const {
        const int L = i * G + c; if (L >= nunits) return false;
        u.pm = L >> cshift; u.pn = L & ((1 << cshift) - 1); u.e = tile_e[u.pm]; return true;
    }
};
}
#include <hip/hip_bf16.h>
#include <cmath>
namespace attn_body {
using bf16=__hip_bfloat16;
using bf16x8=__attribute__((ext_vector_type(8)))short;
using s16x4=__attribute__((ext_vector_type(4)))short;
using f32x16=__attribute__((ext_vector_type(16)))float;
using u32x4=__attribute__((ext_vector_type(4)))unsigned;
constexpr int BATCH=2,NHEAD=8,SEQ=16384,D=64,DM=NHEAD*D;
constexpr int NW=8,QBLK=32,QB=QBLK*NW,KVBLK=64,NQB=SEQ/QB;
constexpr int ATTN_PITCH=DM, ATTN_UNIT_ROWS=QB;
__device__ __forceinline__ int crow(int r,int hi){return (r&3)+8*(r>>2)+4*hi;}
#define SBAR() __builtin_amdgcn_sched_barrier(0)
__device__ __forceinline__ void cmask(f32x16&p0,f32x16&p1,int jb,int qrel,int hi){
  const float NEG=-INFINITY; int x=qrel-64*jb-4*hi; asm volatile("":"+v"(x));
  #pragma unroll
  for(int r=0;r<16;++r){const int c=(r&3)+8*(r>>2); if(c>x)p0[r]=NEG; if(c+32>x)p1[r]=NEG;}
}

constexpr int NSLOT=3, SLOTB=8192;
constexpr int LDS_K=0, LDS_V=NSLOT*SLOTB, LDS_WS=2*NSLOT*SLOTB, LDS_OST=LDS_WS+NW*64*4, LDS_BYTES=LDS_OST+NW*4096;
constexpr float C2=0.125f*1.4426950408889634f;
__device__ __forceinline__ void glds16(const void*gsrc,unsigned lds_dst){unsigned keep;
  asm volatile("s_mov_b32 %0, m0\n\ts_mov_b32 m0, %2\n\ts_nop 0\n\tglobal_load_lds_dwordx4 %1, off\n\ts_mov_b32 m0, %0":"=&s"(keep):"v"(gsrc),"s"(lds_dst):"memory");}
__device__ __forceinline__ float max3f(float a,float b,float c){float r;asm("v_max3_f32 %0, %1, %2, %3":"=v"(r):"v"(a),"v"(b),"v"(c));return r;}
__device__ __forceinline__ float max2f(float a,float b){float r;asm("v_max_f32_e32 %0, %1, %2":"=v"(r):"v"(a),"v"(b));return r;}
__device__ __forceinline__ float fadd_s(float a,float b){float r;asm("v_add_f32_e32 %0, %1, %2":"=v"(r):"v"(a),"v"(b));return r;}
__device__ __forceinline__ float fsub_s(float a,float b){float r;asm("v_sub_f32_e32 %0, %1, %2":"=v"(r):"v"(a),"v"(b));return r;}
typedef float f32x2_t __attribute__((ext_vector_type(2))); typedef __bf16 bf16x2_t __attribute__((ext_vector_type(2)));
__device__ __forceinline__ unsigned cvtpk_s(float lo,float hi){f32x2_t v={lo,hi};bf16x2_t b=__builtin_convertvector(v,bf16x2_t);return __builtin_bit_cast(unsigned,b);}
#define WAIT_BAR(N) asm volatile("s_waitcnt vmcnt(" #N ") lgkmcnt(0)\n\ts_barrier":::"memory")

__device__ __forceinline__ void qkt(f32x16&p0,f32x16&p1,const char*Kslot,const bf16x8*qr,int r32,int hi){
  const char*kb=Kslot+hi*1024+r32*16;
  #pragma unroll
  for(int d0=0;d0<4;++d0){
    const bf16x8 b0=*reinterpret_cast<const bf16x8*>(kb+d0*2048);
    const bf16x8 b1=*reinterpret_cast<const bf16x8*>(kb+d0*2048+512);
    if(d0==0){p0=__builtin_amdgcn_mfma_f32_32x32x16_bf16(b0,qr[0],p0,0,0,0);p1=__builtin_amdgcn_mfma_f32_32x32x16_bf16(b1,qr[0],p1,0,0,0);}
    else{p0=__builtin_amdgcn_mfma_f32_32x32x16_bf16(b0,qr[d0],p0,0,0,0);p1=__builtin_amdgcn_mfma_f32_32x32x16_bf16(b1,qr[d0],p1,0,0,0);}}
}
typedef __attribute__((address_space(3))) const char* lds_cptr;
typedef short v4i16_t __attribute__((ext_vector_type(4)));
__device__ __forceinline__ void kload8(bf16x8*kf,lds_cptr kp){
  kf[0]=*(const __attribute__((address_space(3))) bf16x8*)(kp);      kf[1]=*(const __attribute__((address_space(3))) bf16x8*)(kp+512);
  kf[2]=*(const __attribute__((address_space(3))) bf16x8*)(kp+2048); kf[3]=*(const __attribute__((address_space(3))) bf16x8*)(kp+2560);
  kf[4]=*(const __attribute__((address_space(3))) bf16x8*)(kp+4096); kf[5]=*(const __attribute__((address_space(3))) bf16x8*)(kp+4608);
  kf[6]=*(const __attribute__((address_space(3))) bf16x8*)(kp+6144); kf[7]=*(const __attribute__((address_space(3))) bf16x8*)(kp+6656);
}
__device__ __forceinline__ void kload2(bf16x8*kf,lds_cptr kp,int j){ kf[2*j]=*(const __attribute__((address_space(3))) bf16x8*)(kp+j*2048); kf[2*j+1]=*(const __attribute__((address_space(3))) bf16x8*)(kp+j*2048+512); }
__device__ __forceinline__ s16x4 vtr(lds_cptr p){ return __builtin_bit_cast(s16x4,__builtin_amdgcn_ds_read_tr16_b64_v4i16((__attribute__((address_space(3))) v4i16_t*)p)); }
__device__ __forceinline__ float rowmax(const f32x16&p0,const f32x16&p1){
  float a=max3f(p0[0],p0[1],p1[0]),b=max3f(p0[2],p0[3],p1[1]);a=max3f(a,p1[2],p1[3]);
  #pragma unroll
  for(int r=4;r<16;r+=4){a=max3f(a,p0[r],p0[r+1]);b=max3f(b,p0[r+2],p0[r+3]);a=max3f(a,p1[r],p1[r+1]);b=max3f(b,p1[r+2],p1[r+3]);}
  const float m=max2f(a,b);
  auto rr=__builtin_amdgcn_permlane32_swap(__float_as_uint(m),__float_as_uint(m),false,false);
  return max2f(__uint_as_float(rr[0]),__uint_as_float(rr[1]));
}
__device__ __forceinline__ void pv(f32x16*o,int vb,bf16x8 pa0,bf16x8 pa1,bf16x8 pa2,bf16x8 pa3){
  #pragma unroll
  for(int d0=0;d0<2;++d0){s16x4 lo[4],hi[4];
    #pragma unroll
    for(int ks=0;ks<4;++ks){
      asm volatile("ds_read_b64_tr_b16 %0,%1 offset:%c2":"=&v"(lo[ks]):"v"(vb),"i"(d0*4096+ks*1024):"memory");
      asm volatile("ds_read_b64_tr_b16 %0,%1 offset:%c2":"=&v"(hi[ks]):"v"(vb),"i"(d0*4096+ks*1024+512):"memory");}
    asm volatile("s_waitcnt lgkmcnt(0)":::"memory");SBAR();
    #define PK(k) (bf16x8){lo[k][0],lo[k][1],lo[k][2],lo[k][3],hi[k][0],hi[k][1],hi[k][2],hi[k][3]}
    o[d0]=__builtin_amdgcn_mfma_f32_32x32x16_bf16(pa0,PK(0),o[d0],0,0,0);
    o[d0]=__builtin_amdgcn_mfma_f32_32x32x16_bf16(pa1,PK(1),o[d0],0,0,0);
    o[d0]=__builtin_amdgcn_mfma_f32_32x32x16_bf16(pa2,PK(2),o[d0],0,0,0);
    o[d0]=__builtin_amdgcn_mfma_f32_32x32x16_bf16(pa3,PK(3),o[d0],0,0,0);
    #undef PK
  }
}

#ifndef ATTN_STORE16
#define ATTN_STORE16(p,v) (*(u32x4*)(p)=(v))
#endif
typedef float f32x4_t __attribute__((ext_vector_type(4)));
#define NBLD(dst,off) dst=*(const __attribute__((address_space(3))) f32x4_t*)(tbn_+(off))
#define NBSUB(P,b,src) do{ P[(b)]=nmn_-src[0]; P[(b)+1]=nmn_-src[1]; P[(b)+2]=nmn_-src[2]; P[(b)+3]=nmn_-src[3]; }while(0)
#define NEXTB(P0,P1,tt) do{ const __attribute__((address_space(3))) float* tb_=tab3+(tt)*64+4*hi; const float nm_=-mhat; \
  _Pragma("unroll") for(int g_=0;g_<4;++g_){ const f32x4_t b0_=*(const __attribute__((address_space(3))) f32x4_t*)(tb_+8*g_); const f32x4_t b1_=*(const __attribute__((address_space(3))) f32x4_t*)(tb_+32+8*g_); \
    _Pragma("unroll") for(int j_=0;j_<4;++j_){ P0[4*g_+j_]=nm_-b0_[j_]; P1[4*g_+j_]=nm_-b1_[j_]; } } }while(0)
template<int THRL> __device__ __forceinline__ void attn_unit(int b,int h,int qb,int t0,const bf16*Q,const bf16*__restrict__ K,const bf16*__restrict__ V,bf16*O,const float*__restrict__ cumT,char*shm,int tab_off,int segp_off,unsigned*qctr){
  const int tid=threadIdx.x,lane=tid&63,r32=lane&31,hi=lane>>5; const int wid=__builtin_amdgcn_readfirstlane(tid>>6);
  const long rowbase=(long)b*SEQ; const int q0=qb*QB;
  const bf16*Qw=Q+(rowbase+q0+wid*QBLK)*DM+h*D;
  const bf16*Kh=K+(rowbase+(long)t0*KVBLK)*DM+h*D,*Vh=V+(rowbase+(long)t0*KVBLK)*DM+h*D;
  const unsigned lds0=(unsigned)(uintptr_t)shm;
  float*wsf=(float*)(shm+LDS_WS)+wid*64;
  const bf16*ksrc=Kh+(long)lane*DM+wid*8;
  const bf16*vsrc=Vh+(long)(16*(wid&3)+(lane>>2))*DM+(wid>>2)*32+(lane&3)*8;
  const unsigned kdst=lds0+LDS_K+wid*1024, vdst=lds0+LDS_V+wid*1024;
  #define DMA_K(t,slot) glds16(ksrc+(long)(t)*KVBLK*DM,(unsigned)__builtin_amdgcn_readfirstlane(kdst+(slot)))
  #define DMA_V(t,slot) glds16(vsrc+(long)(t)*KVBLK*DM,(unsigned)__builtin_amdgcn_readfirstlane(vdst+(slot)))
  const int vb0=(int)(lds0+LDS_V)+((lane>>4)&1)*32+(lane&3)*8+(4*hi+((lane&15)>>2))*64;
  const char*Kbase=shm+LDS_K; bf16x8 kf[8];
  const lds_cptr shm3=(lds_cptr)shm; const lds_cptr kp0=shm3+LDS_K+hi*1024+r32*16; const lds_cptr vp0=shm3+LDS_V+((lane>>4)&1)*32+(lane&3)*8+(4*hi+((lane&15)>>2))*64;
  const int NT=(q0+QB)/KVBLK-t0;
  const __attribute__((address_space(3))) float* tab3=(const __attribute__((address_space(3))) float*)(shm3+tab_off);
  { int tl_=threadIdx.x; asm volatile("":"+v"(tl_));
    float*tabw=(float*)(shm+tab_off); const float L2E=1.4426950408889634f;
    const float*cg=cumT+((long)(b*NHEAD+h))*SEQ; const float cref=cg[q0]*L2E;
    for(int i=tl_;i<NT*KVBLK;i+=NW*64){ const int kv=t0*KVBLK+i; tabw[i]=cg[kv]*L2E-cref; }
    asm volatile("s_waitcnt vmcnt(0) lgkmcnt(0)\n\ts_barrier":::"memory"); }
  DMA_K(0,0);DMA_V(0,0);DMA_K(1,SLOTB);
  bf16x8 qr[4];
  #pragma unroll
  for(int d0=0;d0<4;++d0)qr[d0]=*reinterpret_cast<const bf16x8*>(&Qw[(long)r32*DM+d0*16+hi*8]);
  float mhat=0.f,l_reg=0.f;f32x16 o[2];o[0]=f32x16{};o[1]=f32x16{};
  const int qrel=wid*QBLK+r32;
  #define CMASK(P0,P1,t) do{int jb_=(t)-(NT-4); if(jb_>=0)cmask(P0,P1,jb_,qrel,hi);}while(0)
  bool resc=false;
  #define START(P0,P1) do{ const float rm=rowmax(P0,P1); resc=false; \
    { const float dl=rm; mhat=fadd_s(mhat,dl); \
      _Pragma("unroll") for(int r=0;r<16;++r){P0[r]=fsub_s(P0[r],dl);P1[r]=fsub_s(P1[r],dl);} \
      } \
    _Pragma("unroll") for(int r=0;r<16;++r)P0[r]=__builtin_amdgcn_exp2f(P0[r]); }while(0)
  #define RESC() do{ if(resc){ asm volatile("s_waitcnt lgkmcnt(0)":::"memory"); \
      _Pragma("unroll") for(int d_=0;d_<2;++d_) _Pragma("unroll") for(int r=0;r<16;++r)o[d_][r]*=wsf[crow(r,hi)]; } }while(0)
  f32x16 pA0,pA1,pB0,pB1;
  int sl_prev=0,sl_cur=0,sl_next=SLOTB;
  #define ROT() do{sl_prev=sl_cur;sl_cur=sl_next;sl_next=(sl_next==(NSLOT-1)*SLOTB)?0:sl_next+SLOTB;}while(0)
  DMA_K(2,2*SLOTB);
  WAIT_BAR(3);
  NEXTB(pA0,pA1,0);
  qkt(pA0,pA1,Kbase,qr,r32,hi);asm volatile("s_nop 15\n\ts_nop 7":"+v"(pA0),"+v"(pA1));CMASK(pA0,pA1,0);
  START(pA0,pA1);
  NEXTB(pB0,pB1,1);
  _Pragma("unroll") for(int r=0;r<16;++r)pA1[r]=__builtin_amdgcn_exp2f(pA1[r]);
  WAIT_BAR(0);
  DMA_K(3,0);DMA_V(1,SLOTB);
  ROT();
  kload8(kf,kp0+sl_cur);
  WAIT_BAR(2);
  s16x4 vlo[8],vhi[8]; u32x4 pw0,pw1,pw2,pw3;
  #define PKW(P,B) cvtpk_s(P[B],P[B+1])
  #define PAF(k) __builtin_bit_cast(bf16x8,pw##k)
  #define VFR(i) (bf16x8){vlo[i][0],vlo[i][1],vlo[i][2],vlo[i][3],vhi[i][0],vhi[i][1],vhi[i][2],vhi[i][3]}
  #define PIN(x) asm volatile("":"+v"(x))
  #define MX3(a,b,c) __builtin_fmaxf(__builtin_fmaxf((a),(b)),(c))
  #define GAPA(MF,A0,A1,A2,A3,W0,W1,PW) do{ MF; sacc+=A0; sacc+=A1; sacc+=A2; sacc+=A3; PIN(sacc); W0; W1; PIN(PW); SBAR(); }while(0)
  #define EX(v) __builtin_amdgcn_exp2f(v)
  #define GAPB(MF,X,B) do{ MF; X[B]=EX(X[B]); X[B+1]=EX(X[B+1]); X[B+2]=EX(X[B+2]); X[B+3]=EX(X[B+3]); PIN(X); SBAR(); }while(0)
  #define VRD(i) do{ vlo[i]=vtr(vp_+(((i)>>2)*4096+((i)&3)*1024)); vhi[i]=vtr(vp_+(((i)>>2)*4096+((i)&3)*1024+512)); }while(0)
  #define KRD(G,j) do{ if(G){ kload2(kf,kp0+sl_next,j); SBAR(); } }while(0)
  #define STEP(C0,C1,P0,P1,t,GK,GV,GL) do{ SBAR(); \
    const lds_cptr vp_=vp0+sl_prev; \
    VRD(0); SBAR(); float sacc=(P0[0]+P0[1]); \
    GAPA(C0=__builtin_amdgcn_mfma_f32_32x32x16_bf16(kf[0],qr[0],C0,0,0,0), P0[2],P0[3],P0[4],P0[5],     pw0[0]=PKW(P0,0), pw0[1]=PKW(P0,2), pw0); \
    VRD(4); SBAR(); GAPA(C1=__builtin_amdgcn_mfma_f32_32x32x16_bf16(kf[1],qr[0],C1,0,0,0), P0[6],P0[7],P0[8],P0[9],     pw0[2]=PKW(P0,4), pw0[3]=PKW(P0,6), pw0); \
    VRD(1); SBAR(); GAPA(C0=__builtin_amdgcn_mfma_f32_32x32x16_bf16(kf[2],qr[1],C0,0,0,0),   P0[10],P0[11],P0[12],P0[13], pw1[0]=PKW(P0,8), pw1[1]=PKW(P0,10), pw1); \
    VRD(5); SBAR(); GAPA(C1=__builtin_amdgcn_mfma_f32_32x32x16_bf16(kf[3],qr[1],C1,0,0,0),   P0[14],P0[15],P1[0],P1[1],   pw1[2]=PKW(P0,12),pw1[3]=PKW(P0,14), pw1); \
    VRD(2); SBAR(); GAPA(C0=__builtin_amdgcn_mfma_f32_32x32x16_bf16(kf[4],qr[2],C0,0,0,0),   P1[2],P1[3],P1[4],P1[5],     pw2[0]=PKW(P1,0), pw2[1]=PKW(P1,2), pw2); \
    VRD(6); SBAR(); GAPA(C1=__builtin_amdgcn_mfma_f32_32x32x16_bf16(kf[5],qr[2],C1,0,0,0),   P1[6],P1[7],P1[8],P1[9],     pw2[2]=PKW(P1,4), pw2[3]=PKW(P1,6), pw2); \
    VRD(3); SBAR(); GAPA(C0=__builtin_amdgcn_mfma_f32_32x32x16_bf16(kf[6],qr[3],C0,0,0,0),   P1[10],P1[11],P1[12],P1[13], pw3[0]=PKW(P1,8), pw3[1]=PKW(P1,10), pw3); \
    VRD(7); SBAR(); GAPA(C1=__builtin_amdgcn_mfma_f32_32x32x16_bf16(kf[7],qr[3],C1,0,0,0),   P1[14],P1[15],0.f,0.f,       pw3[2]=PKW(P1,12),pw3[3]=PKW(P1,14), pw3); \
    l_reg+=sacc; \
    if(GK){DMA_K((t)+3,sl_cur);} if(GV){DMA_V((t)+1,sl_next);} \
    CMASK(C0,C1,t); \
    { float a=MX3(C0[0],C0[1],C1[0]),b=MX3(C0[2],C0[3],C1[1]); a=MX3(a,C1[2],C1[3]); \
      _Pragma("unroll") for(int r=4;r<16;r+=4){a=MX3(a,C0[r],C0[r+1]);b=MX3(b,C0[r+2],C0[r+3]);a=MX3(a,C1[r],C1[r+1]);b=MX3(b,C1[r+2],C1[r+3]);} \
      float rm=__builtin_fmaxf(a,b); { auto rr=__builtin_amdgcn_permlane32_swap(__float_as_uint(rm),__float_as_uint(rm),false,false); rm=__builtin_fmaxf(__uint_as_float(rr[0]),__uint_as_float(rr[1])); } \
      resc=false; \
      if(__builtin_expect(__any(rm>(float)THRL),0)){ const float dl=__builtin_fmaxf(rm,0.f); mhat+=dl; \
        _Pragma("unroll") for(int r=0;r<16;++r){C0[r]-=dl;C1[r]-=dl;} \
        const float f=__builtin_amdgcn_exp2f(-dl); l_reg*=f; if(hi==0)wsf[r32]=f; resc=true; } } \
      \
    const __attribute__((address_space(3))) float* tbn_=tab3+((t)+1)*64+4*hi; const float nmn_=-mhat; f32x4_t nbA_,nbB_; \
    SBAR(); \
    if(GL){NBLD(nbA_,0);} GAPB(o[0]=__builtin_amdgcn_mfma_f32_32x32x16_bf16(PAF(0),VFR(0),o[0],0,0,0), C0,0); \
    if(GL){NBLD(nbB_,8); NBSUB(P0,0,nbA_);} GAPB(o[1]=__builtin_amdgcn_mfma_f32_32x32x16_bf16(PAF(0),VFR(4),o[1],0,0,0), C0,4); \
    if(GL){NBLD(nbA_,16); NBSUB(P0,4,nbB_);} KRD(GL,0); GAPB(o[0]=__builtin_amdgcn_mfma_f32_32x32x16_bf16(PAF(1),VFR(1),o[0],0,0,0), C0,8); \
    if(GL){NBLD(nbB_,24); NBSUB(P0,8,nbA_);} KRD(GL,1); GAPB(o[1]=__builtin_amdgcn_mfma_f32_32x32x16_bf16(PAF(1),VFR(5),o[1],0,0,0), C0,12); \
    if(GL){NBLD(nbA_,32); NBSUB(P0,12,nbB_);} KRD(GL,2); GAPB(o[0]=__builtin_amdgcn_mfma_f32_32x32x16_bf16(PAF(2),VFR(2),o[0],0,0,0), C1,0); \
    if(GL){NBLD(nbB_,40); NBSUB(P1,0,nbA_);} KRD(GL,3); GAPB(o[1]=__builtin_amdgcn_mfma_f32_32x32x16_bf16(PAF(2),VFR(6),o[1],0,0,0), C1,4); \
    if(GL){NBLD(nbA_,48); NBSUB(P1,4,nbB_);} GAPB(o[0]=__builtin_amdgcn_mfma_f32_32x32x16_bf16(PAF(3),VFR(3),o[0],0,0,0), C1,8); \
    if(GL){NBLD(nbB_,56); NBSUB(P1,8,nbA_);} GAPB(o[1]=__builtin_amdgcn_mfma_f32_32x32x16_bf16(PAF(3),VFR(7),o[1],0,0,0), C1,12); \
    if(GL){NBSUB(P1,12,nbB_);} \
    }while(0)
  int t=1;
  #undef CMASK
  #define CMASK(P0,P1,t) do{}while(0)
  for(;t+5<NT;t+=2){
    STEP(pB0,pB1,pA0,pA1,t,true,true,true);     WAIT_BAR(2); RESC(); ROT();
    STEP(pA0,pA1,pB0,pB1,t+1,true,true,true);   WAIT_BAR(2); RESC(); ROT();
  }
  #undef CMASK
  #define CMASK(P0,P1,t) do{int jb_=(t)-(NT-4); if(jb_>=0)cmask(P0,P1,jb_,qrel,hi);}while(0)
  #define ENDW(tt) do{ if((tt)+3<NT){WAIT_BAR(2);} else if((tt)+2<NT){WAIT_BAR(1);} else {WAIT_BAR(0);} }while(0)
  for(;t+1<NT;t+=2){
    STEP(pB0,pB1,pA0,pA1,t,(t+3<NT),(t+1<NT),(t+1<NT));       ENDW(t);   RESC(); ROT();
    STEP(pA0,pA1,pB0,pB1,t+1,(t+4<NT),(t+2<NT),(t+2<NT));     ENDW(t+1); RESC(); ROT();
  }
  STEP(pB0,pB1,pA0,pA1,NT-1,false,false,false); RESC();
  { float sacc=pB0[0]+pB0[1]; _Pragma("unroll") for(int r=2;r<16;++r)sacc+=pB0[r]; _Pragma("unroll") for(int r=0;r<16;++r)sacc+=pB1[r]; l_reg+=sacc;
    pw0=(u32x4){PKW(pB0,0),PKW(pB0,2),PKW(pB0,4),PKW(pB0,6)};pw1=(u32x4){PKW(pB0,8),PKW(pB0,10),PKW(pB0,12),PKW(pB0,14)};pw2=(u32x4){PKW(pB1,0),PKW(pB1,2),PKW(pB1,4),PKW(pB1,6)};pw3=(u32x4){PKW(pB1,8),PKW(pB1,10),PKW(pB1,12),PKW(pB1,14)};
    SBAR(); pv(o,vb0+sl_cur,PAF(0),PAF(1),PAF(2),PAF(3)); }
  #undef PKW
  #undef PAF
  #undef VFR
  #undef PIN
  #undef MX3
  #undef GAPA
  #undef GAPB
  #undef EX
  #undef VRD
  #undef KRD
  #undef STEP
  #undef ENDW
  {auto rr=__builtin_amdgcn_permlane32_swap(__float_as_uint(l_reg),__float_as_uint(l_reg),false,false);l_reg=__uint_as_float(rr[0])+__uint_as_float(rr[1]);}
  int un_=0; if(threadIdx.x==0)un_=(int)__hip_atomic_fetch_add(qctr,1u,__ATOMIC_RELAXED,__HIP_MEMORY_SCOPE_AGENT);
  int lane_e=threadIdx.x&63; asm volatile("":"+v"(lane_e));
  const int r32e=lane_e&31,hie=lane_e>>5;
  if(hie==0)wsf[32+r32e]=l_reg;asm volatile("s_waitcnt lgkmcnt(0)":::"memory");
  float rli[16];
  #pragma unroll
  for(int r=0;r<16;++r)rli[r]=__builtin_amdgcn_rcpf(wsf[32+crow(r,hie)]);
  bf16*Ow=O+(rowbase+q0+wid*QBLK)*DM+h*D;
  { bf16*stg=(bf16*)(shm+LDS_OST)+wid*2048;
    #pragma unroll
    for(int r=0;r<16;++r){const int orow=crow(r,hie);
      #pragma unroll
      for(int d0=0;d0<2;++d0)stg[orow*64+d0*32+r32e]=__float2bfloat16(o[d0][r]*rli[r]);}
    asm volatile("s_waitcnt lgkmcnt(0)":::"memory");
    #pragma unroll
    for(int i=0;i<4;++i){const int row=i*8+(lane_e>>3),ch=lane_e&7; const u32x4 v=*(const u32x4*)(stg+row*64+ch*8); ATTN_STORE16(Ow+(long)row*DM+ch*8,v);} }
  if(threadIdx.x==0)*(volatile int*)(shm+segp_off)=un_;
  asm volatile("s_waitcnt lgkmcnt(0)\n\ts_barrier":::"memory");
  #undef DMA_K
  #undef DMA_V
  #undef CMASK
  #undef START
  #undef RESC
  #undef ROT
}
constexpr int ATTN_LDS_BYTES=LDS_BYTES;
struct AttnTensors { const bf16* Q; const bf16* K; const bf16* V; bf16* O; const float* cumT; const float* segtot; };
struct AttnUnit { int bh; int qb; };
struct StaticOrder {
  int vcu;
  __device__ __forceinline__ explicit StaticOrder(int grid,int block):vcu((block%8)*(grid/8)+block/8){}
  __device__ __forceinline__ bool next(int i,AttnUnit&u)const{ if(i>=4||vcu>=256)return false; const int s=vcu&15; u.bh=vcu>>4; u.qb=(i==0)?63-s:(i==1)?32+s:(i==2)?31-s:s; return true; }
  __device__ __forceinline__ void a_ready(const AttnUnit&)const{}
  __device__ __forceinline__ void done(const AttnUnit&)const{}
};
constexpr float PRUNE_THR=20.0f;
template<int THRL=8> __device__ __forceinline__ void attn_phase_dyn(char*lds,const AttnTensors&T,unsigned*ctr,const unsigned*qkmax,int tab_off,int segp_off){
  volatile int*slot=(volatile int*)(lds+segp_off);
  __syncthreads();
  if(threadIdx.x==0)slot[0]=(int)__hip_atomic_fetch_add(ctr,1u,__ATOMIC_RELAXED,__HIP_MEMORY_SCOPE_AGENT);
  __syncthreads();
  for(;;){
    int tid=threadIdx.x; asm volatile("":"+v"(tid));
    const int u=slot[0]; if(u>=BATCH*NHEAD*NQB)break;
    const int bh=u&15, qb=(NQB-1)-(u>>4), b=bh/NHEAD, h=bh%NHEAD, q0=qb*QB;
    const float qm=__uint_as_float(qkmax[bh*2]), km=__uint_as_float(qkmax[bh*2+1]);
    const float L2E=1.4426950408889634f; const float*cg=T.cumT+((long)(b*NHEAD+h))*SEQ;
    const float cgk=cg[(tid<4*qb)?64*tid+63:q0], cg0=cg[q0];
    float dg, qg;
    { const int row=tid>>1, hf=tid&1; const long ro=((long)b*SEQ+q0+row)*DM+h*D+32*hf; const u32x4*qp=(const u32x4*)(T.Q+ro); const u32x4*kp=(const u32x4*)(T.K+ro); float d=0.f, qq=0.f;
      #pragma unroll
      for(int c4=0;c4<4;++c4){ const u32x4 qa=qp[c4], ka=kp[c4];
        #pragma unroll
        for(int e=0;e<4;++e){ const float q0_=__uint_as_float(qa[e]<<16), q1_=__uint_as_float(qa[e]&0xffff0000u); d+=q0_*__uint_as_float(ka[e]<<16)+q1_*__uint_as_float(ka[e]&0xffff0000u); qq+=q0_*q0_+q1_*q1_; } }
      d+=__shfl_xor(d,1); qq+=__shfl_xor(qq,1);
      #pragma unroll
      for(int o=2;o<64;o<<=1){ d=fminf(d,__shfl_xor(d,o)); qq=fmaxf(qq,__shfl_xor(qq,o)); }
      dg=d; qg=qq; }
    float*slotf=(float*)(lds+segp_off)+16;
    if((tid&63)==0){ slotf[tid>>6]=dg; slotf[8+(tid>>6)]=qg; }
    __syncthreads();
    float dmin=slotf[0], qmu=slotf[8];
    #pragma unroll
    for(int w=1;w<NW;++w){ dmin=fminf(dmin,slotf[w]); qmu=fmaxf(qmu,slotf[8+w]); }
    (void)qm;
    const float X=PRUNE_THR+sqrtf(qmu*km)-dmin+1.5f;
    const bool skip=(tid<4*qb)&&((cgk-cg0)*L2E>X);
    const unsigned long long bal=__ballot(skip); if((tid&63)==0)slot[1+(tid>>6)]=__popcll(bal);
    __syncthreads();
    int t0=0;
    #pragma unroll
    for(int w=0;w<NW;++w)t0+=slot[1+w];
    t0&=~1;
    attn_unit<THRL>(b,h,qb,t0,T.Q,T.K,T.V,T.O,T.cumT,lds,tab_off,segp_off,ctr);
  }
}
#undef SBAR
#undef WAIT_BAR
}
#define GAS __attribute__((address_space(1)))
#define LAS __attribute__((address_space(3)))
typedef unsigned short bf16;
typedef unsigned v4u __attribute__((ext_vector_type(4)));
typedef float f32x4 __attribute__((ext_vector_type(4)));
typedef short bf16x8 __attribute__((ext_vector_type(8)));
typedef GAS unsigned gu32;
typedef GAS unsigned long long gu64;
#define RLX_AGENT __ATOMIC_RELAXED, __HIP_MEMORY_SCOPE_AGENT
#define LDS_WAIT() asm volatile("s_waitcnt lgkmcnt(0)" ::: "memory")
#define VM_WAIT() asm volatile("s_waitcnt vmcnt(0)" ::: "memory")
__device__ __forceinline__ unsigned long long rt() { return __builtin_amdgcn_s_memrealtime(); }
typedef float pk_f32x2 __attribute__((ext_vector_type(2))); typedef __bf16 pk_bf16x2 __attribute__((ext_vector_type(2)));
__device__ __forceinline__ unsigned pk2(float lo, float hi) { pk_f32x2 v = {lo, hi}; pk_bf16x2 b = __builtin_convertvector(v, pk_bf16x2); return __builtin_bit_cast(unsigned, b); }
__device__ __forceinline__ unsigned f2bf(float f) { return pk2(f, 0.f) & 0xffffu; }

#define XB_TMO      128
#define XB_XCNT(j)  (256  + 64 * (j))
#define XB_XSUB(j)  (1280 + 64 * (j))
#define XB_XGEN(j)  (2304 + 64 * (j))
#define XB_TOP      3328
#define XB_TOPGEN   3392
#define XCD_BAR_WORDS 3456
#define XB_SPIN_CAP (1u << 18)

__device__ __forceinline__ unsigned xb_ld(unsigned* p)              { return __hip_atomic_load(p, __ATOMIC_RELAXED, __HIP_MEMORY_SCOPE_AGENT); }
__device__ __forceinline__ unsigned xb_add(unsigned* p, unsigned v) { return __hip_atomic_fetch_add(p, v, __ATOMIC_RELAXED, __HIP_MEMORY_SCOPE_AGENT); }
__device__ __forceinline__ unsigned xb_xcc_id() { return (unsigned)__builtin_amdgcn_s_getreg((3 << 11) | 20) & 0xFu; }
#define XB_SPIN(cond, bar) do { unsigned _sp = 0; while (cond) { __builtin_amdgcn_s_sleep(1); \
    if ((++_sp & 255u) == 0u) { if (xb_ld(&(bar)[XB_TMO])) break; if (_sp > XB_SPIN_CAP) { atomicAdd(&(bar)[XB_TMO], 1u); break; } } } } while (0)

struct XcdBarrier {
    unsigned* bar; unsigned x;
    volatile LAS unsigned* st;
};

__device__ __forceinline__ XcdBarrier xcd_barrier_post(unsigned* bar, volatile LAS unsigned* st) {
    XcdBarrier b; b.bar = bar; b.x = xb_xcc_id(); b.st = st;
    if (threadIdx.x == 0) (void)xb_add(&bar[XB_XCNT(b.x)], 1u);
    return b;
}
__device__ __forceinline__ void xcd_barrier_complete(unsigned* bar, unsigned x, unsigned& nloc, unsigned& nx) {
    const unsigned G = gridDim.x * gridDim.y * gridDim.z;
    unsigned sum, cnt, mine, sp = 0u;
    for (;;) {
        sum = 0u; cnt = 0u; mine = 0u;
#pragma unroll
        for (unsigned j = 0; j < 16; ++j) { const unsigned c = xb_ld(&bar[XB_XCNT(j)]); sum += c; cnt += (c > 0u) ? 1u : 0u; mine = (j == x) ? c : mine; }
        if (sum == G) break;
        __builtin_amdgcn_s_sleep(1);
        if ((++sp & 255u) == 0u) { if (xb_ld(&bar[XB_TMO])) break; if (sp > XB_SPIN_CAP) { atomicAdd(&bar[XB_TMO], 1u); break; } }
    }
    nloc = mine > 0u ? mine : 1u; nx = cnt > 0u ? cnt : 1u;
}

__device__ __forceinline__ void xcd_barrier(const XcdBarrier& b) {
    asm volatile("s_waitcnt vmcnt(0)" ::: "memory");
    __syncthreads();
    if (threadIdx.x == 0) {
        unsigned* bar = b.bar;
        __builtin_amdgcn_s_waitcnt(0);
        unsigned nloc = b.st[0], nx = b.st[1];
        if (nloc == 0u) { xcd_barrier_complete(bar, b.x, nloc, nx); b.st[0] = nloc; b.st[1] = nx; }
        const unsigned old = xb_add(&bar[XB_XSUB(b.x)], 1u);
        const unsigned gen = old / nloc;
        if (old + 1u == (gen + 1u) * nloc) {
            __builtin_amdgcn_fence(__ATOMIC_RELEASE, "agent");
            asm volatile("s_waitcnt vmcnt(0)" ::: "memory");
            const unsigned og = xb_add(&bar[XB_TOP], 1u);
            const unsigned tg = og / nx;
            if (og + 1u == (tg + 1u) * nx) xb_add(&bar[XB_TOPGEN], 1u);
            else XB_SPIN(xb_ld(&bar[XB_TOPGEN]) == tg, bar);
            __builtin_amdgcn_fence(__ATOMIC_ACQUIRE, "agent");
            xb_add(&bar[XB_XGEN(b.x)], 1u);
            asm volatile("s_waitcnt vmcnt(0)" ::: "memory");
        } else {
            XB_SPIN(xb_ld(&bar[XB_XGEN(b.x)]) == gen, bar);
            __builtin_amdgcn_fence(__ATOMIC_ACQUIRE, "agent");
            asm volatile("s_waitcnt vmcnt(0)" ::: "memory");
        }
    }
    __syncthreads();
}

constexpr int NWAVES = 8;
constexpr int BATCH = 2, SEQ = 16384, D = 1024, M = BATCH * SEQ;
constexpr int FH = 8, FW = 512, RWW = 512, SHW = 1792, DIN = 5384, NIN = 5376;
constexpr int NE = 32, DE = 512, NROUTE = 36;
constexpr int MAXSLOT = 2 * M + NE * 256;
constexpr int MAXTILE = MAXSLOT / 256;
constexpr float ATT_C2 = 0.125f * 1.4426950408889634f;

constexpr size_t MiB = 1u << 20;
constexpr size_t WS_CTL = 0, CTL_ZERO_BYTES = 1 * MiB;
constexpr size_t WS_MOD = 1 * MiB;
constexpr size_t WS_SEGTOT = 1 * MiB + 64 * 1024;
constexpr size_t WS_BLKCNT = 1 * MiB + 96 * 1024;
constexpr size_t WS_WIN = 2 * MiB;
constexpr size_t WS_WOF = 13 * MiB, WS_WOR = 14 * MiB, WS_WO = 15 * MiB;
constexpr size_t WS_LW2 = 17 * MiB, WS_LA2 = 17 * MiB + 64 * 1024, WS_LG2 = 17 * MiB + 128 * 1024;
constexpr size_t WS_CUM = 18 * MiB;
constexpr size_t WS_ROUTE = 19 * MiB;
constexpr size_t WS_ROWTOK = 20 * MiB;
constexpr size_t WS_BON = 21 * MiB;
constexpr size_t WS_XN = 24 * MiB;
constexpr size_t WS_Q = 88 * MiB, WS_K = 120 * MiB, WS_V = 152 * MiB;
constexpr size_t WS_PRW = 184 * MiB;
constexpr size_t WS_GATES = 296 * MiB;
constexpr size_t WS_F = 424 * MiB;
constexpr size_t WS_END = 512 * MiB;
constexpr size_t WS_Y = WS_K;
constexpr size_t WS_H = WS_Q;
constexpr size_t WS_W13 = WS_PRW, WS_W2T = WS_PRW + 64 * MiB;
constexpr size_t WS_TMP = WS_PRW;
constexpr size_t WS_YM = 280 * MiB;
constexpr size_t WS_X1 = 424 * MiB;
static_assert(WS_YM + (size_t)MAXSLOT * 1024 * 2 <= WS_END, "ws map");
static_assert(WS_H + (size_t)MAXSLOT * 512 * 2 <= WS_PRW, "ws map");
constexpr int CW_TMO = 0, CW_CODE = 1;
constexpr int CW_BAR = 4096;
constexpr int CW_QKMAX = 8192;
constexpr int CW_QUEUE = 8448;
constexpr int CW_DIAG = 8704;

constexpr int RING_OFF = 0, RING_BYTES = 131072;
constexpr int TAB_OFF = 83968;
constexpr int SEGP_OFF = TAB_OFF + 65536;
constexpr int TILE_OFF = 131072;
constexpr int LDSCTL_OFF = SEGP_OFF + 512, MISC_OFF = LDSCTL_OFF + 320;
constexpr int LDS_BYTES = LDSCTL_OFF + 512;
static_assert(attn_body::LDS_BYTES <= TAB_OFF, "attention LDS");


#define PHASE_IDS() int tid_ = threadIdx.x; asm volatile("" : "+v"(tid_)); const int lane_ = tid_ & 63; const int wave_ = __builtin_amdgcn_readfirstlane(tid_ >> 6); (void)lane_; (void)wave_
struct Frame {
    LAS unsigned char* lds;
    volatile LAS unsigned* MISC;
    gu32* ctl;
    int tid, lane, wave;
    int vcu, G;
    const float* const* in;
};
template <int CTRL> __device__ __forceinline__ float dpp_f(float v) { return __int_as_float(__builtin_amdgcn_mov_dpp(__float_as_int(v), CTRL, 0xf, 0xf, true)); }
__device__ __forceinline__ float row_sum16(float v) { v += dpp_f<0xB1>(v); v += dpp_f<0x4E>(v); v += dpp_f<0x141>(v); v += dpp_f<0x140>(v); return v; }
__device__ __forceinline__ float wave_sum(float v) { v = row_sum16(v); v += __shfl_xor(v, 16); v += __shfl_xor(v, 32); return v; }
__device__ __forceinline__ float bflo(unsigned w) { return __uint_as_float(w << 16); }
__device__ __forceinline__ float bfhi(unsigned w) { return __uint_as_float(w & 0xffff0000u); }
__device__ __forceinline__ float sigm(float x) { return 1.0f / (1.0f + __expf(-x)); }

__device__ __forceinline__ void transpose_item(const float* W, int ld, int col, int k0, int K, bf16* WT, size_t drow, LAS float* scr, int lane) {
#pragma unroll 8
    for (int i = 0; i < 32; ++i) { const int kk = 2 * i + (lane >> 5); scr[kk * 33 + (lane & 31)] = W[(size_t)(k0 + kk) * ld + col + (lane & 31)]; }
    LDS_WAIT(); asm volatile("" ::: "memory");
    const int c = lane & 7;
#pragma unroll
    for (int j = 0; j < 4; ++j) { const int n = (lane >> 3) + 8 * j; const LAS float* s = scr + (8 * c) * 33 + n;
        v4u o; o.x = pk2(s[0 * 33], s[1 * 33]); o.y = pk2(s[2 * 33], s[3 * 33]); o.z = pk2(s[4 * 33], s[5 * 33]); o.w = pk2(s[6 * 33], s[7 * 33]);
        *(GAS v4u*)(WT + (drow + n) * K + k0 + 8 * c) = o; }
    LDS_WAIT(); asm volatile("" ::: "memory");
}
__device__ __forceinline__ void conv_seg(Frame& F, const float* W, int ld, int col0, int K, int ncols, bf16* WT, size_t drow0) {
    PHASE_IDS();
    LAS float* scr = (LAS float*)(F.lds + RING_OFF + wave_ * 16384);
    const int gw = F.vcu * NWAVES + wave_, NGW = F.G * NWAVES, nkb = K / 64, nnb = ncols / 32;
    for (int it = gw; it < nkb * nnb; it += NGW) { const int kb = it / nnb, nb = it % nnb; transpose_item(W, ld, col0 + 32 * nb, 64 * kb, K, WT, drow0 + 32 * nb, scr, lane_); }
}

struct Args { const float* in[30]; float* out; unsigned char* ws; };

__device__ __forceinline__ void p0_prologue(Frame& F, const Args& A) {
    PHASE_IDS();
    unsigned char* ws = A.ws;
    if (blockIdx.x < 96) {
        const float* c = A.in[1]; const float* aw = A.in[2]; const float* ab = A.in[3];
        const int col = blockIdx.x * 64 + lane_; float a0 = 0.f, a1 = 0.f;
        const int kbeg = wave_ * 128;
#pragma unroll 8
        for (int k = kbeg; k < kbeg + 128; ++k) { const float wv = aw[(size_t)k * 6144 + col]; const float c0 = c[k], c1 = c[1024 + k];
            a0 += c0 * sigm(c0) * wv; a1 += c1 * sigm(c1) * wv; }
        LAS float* red = (LAS float*)(F.lds + 8 * 16384 - 4096);
        red[(wave_ * 2 + 0) * 64 + lane_] = a0; red[(wave_ * 2 + 1) * 64 + lane_] = a1;
        __syncthreads();
        if (wave_ < 2) { float s = 0.f;
#pragma unroll
            for (int w = 0; w < 8; ++w) s += red[(w * 2 + wave_) * 64 + lane_];
            ((float*)(ws + WS_MOD))[wave_ * 6144 + col] = s + ab[col]; }
        __syncthreads();
    }
}

__device__ __forceinline__ void p_convert_early(Frame& F, const Args& A) {
    unsigned char* ws = A.ws;
    const float* w_in = A.in[5];
    conv_seg(F, w_in, DIN, 0, 1024, 1536, (bf16*)(ws + WS_WIN), 0);
    conv_seg(F, w_in, DIN, 1544, 1024, 1792, (bf16*)(ws + WS_WIN), 1536);
    conv_seg(F, w_in, DIN, 3336, 1024, 2048, (bf16*)(ws + WS_WIN), 3328);
    conv_seg(F, A.in[18], 1024, 0, 512, 1024, (bf16*)(ws + WS_WOF), 0);
    conv_seg(F, A.in[19], 1024, 0, 512, 1024, (bf16*)(ws + WS_WOR), 0);
    conv_seg(F, A.in[20], 1024, 0, 1024, 1024, (bf16*)(ws + WS_WO), 0);
    conv_seg(F, A.in[9], 512, 0, 64, 512, (bf16*)(ws + WS_LW2), 0);
    conv_seg(F, A.in[11], 512, 0, 64, 512, (bf16*)(ws + WS_LA2), 0);
    conv_seg(F, A.in[12], 512, 0, 128, 512, (bf16*)(ws + WS_LG2), 0);
}

__device__ __forceinline__ void p1_norm(Frame& F, const Args& A) {
    PHASE_IDS();
    unsigned char* ws = A.ws;
    LAS float* wf = (LAS float*)(F.lds);
    LAS float* lfl = (LAS float*)(F.lds + 32768);
    LAS float* part = (LAS float*)(F.lds + 32768 + 4096);
    const float* x = A.in[0]; const float* g1 = A.in[4]; const float* w_in = A.in[5]; const float* fb = A.in[6];
    const float* mod = (const float*)(ws + WS_MOD);
    bf16* XN = (bf16*)(ws + WS_XN); float* cumT = (float*)(ws + WS_CUM); float* segtot = (float*)(ws + WS_SEGTOT);
    for (int i = tid_; i < 8192; i += NWAVES * 64) wf[(i & 7) * 1024 + (i >> 3)] = w_in[(size_t)(i >> 3) * DIN + 1536 + (i & 7)];
    __syncthreads();
    for (int blk = blockIdx.x; blk < M / 128; blk += F.G) {
        const int b = blk / (SEQ / 128);
        f32x4 gm[4], sh[4];
#pragma unroll
        for (int j = 0; j < 4; ++j) { const int col = 4 * lane_ + 256 * j; const f32x4 g = *(const f32x4*)(g1 + col), sc = *(const f32x4*)(mod + b * 6144 + 1024 + col);
            gm[j] = g * (sc + 1.0f); sh[j] = *(const f32x4*)(mod + b * 6144 + col); }
        float fbv = fb[((lane_ >> 5) & 1) * 4 + ((lane_ >> 4) & 1) * 2 + ((lane_ >> 3) & 1)];
        f32x4 nv[4];
        { const GAS f32x4* xr0 = (const GAS f32x4*)(x + ((size_t)blk * 128 + wave_ * 16) * D) + lane_;
#pragma unroll
          for (int j = 0; j < 4; ++j) nv[j] = xr0[64 * j]; }
        for (int i = 0; i < 16; ++i) {
            const int tl = wave_ * 16 + i; const size_t tok = (size_t)blk * 128 + tl;
            f32x4 v[4]; float s = 0.f;
#pragma unroll
            for (int j = 0; j < 4; ++j) { v[j] = nv[j]; s += (v[j].x * v[j].x + v[j].y * v[j].y) + (v[j].z * v[j].z + v[j].w * v[j].w); }
            if (i + 1 < 16) { const GAS f32x4* xr = (const GAS f32x4*)(x + (tok + 1) * D) + lane_;
#pragma unroll
                for (int j = 0; j < 4; ++j) nv[j] = xr[64 * j]; }
            const float rstd = 1.0f / sqrtf(wave_sum(s) * (1.f / D) + 1e-6f);
            GAS unsigned long long* o8 = (GAS unsigned long long*)(XN + tok * D) + lane_;
            float f[8];
#pragma unroll
            for (int hh = 0; hh < 8; ++hh) f[hh] = 0.f;
#pragma unroll
            for (int j = 0; j < 4; ++j) { v[j] = v[j] * rstd * gm[j] + sh[j];
                o8[64 * j] = (unsigned long long)pk2(v[j].x, v[j].y) | ((unsigned long long)pk2(v[j].z, v[j].w) << 32);
#pragma unroll
                for (int hh = 0; hh < 8; ++hh) { const f32x4 w4 = *(const LAS f32x4*)(wf + hh * 1024 + 4 * lane_ + 256 * j); f[hh] += (v[j].x * w4.x + v[j].y * w4.y) + (v[j].z * w4.z + v[j].w * w4.w); } }
            float g4[4], g2v[2], z;
            { const bool up = (lane_ & 32) != 0;
#pragma unroll
              for (int i = 0; i < 4; ++i) { const float keep = up ? f[4 + i] : f[i], send = up ? f[i] : f[4 + i]; g4[i] = keep + __shfl_xor(send, 32); } }
            { const bool up = (lane_ & 16) != 0;
#pragma unroll
              for (int i = 0; i < 2; ++i) { const float keep = up ? g4[2 + i] : g4[i], send = up ? g4[i] : g4[2 + i]; g2v[i] = keep + __shfl_xor(send, 16); } }
            { const bool up = (lane_ & 8) != 0; const float keep = up ? g2v[1] : g2v[0], send = up ? g2v[0] : g2v[1]; z = keep + __shfl_xor(send, 8); }
            z += __shfl_xor(z, 1); z += __shfl_xor(z, 2); z += __shfl_xor(z, 4);
            const int myh = ((lane_ >> 5) & 1) * 4 + ((lane_ >> 4) & 1) * 2 + ((lane_ >> 3) & 1);
            z += fbv;
            const float lf = (z >= 0.f) ? -log1pf(__expf(-z)) : z - log1pf(__expf(z));
            if ((lane_ & 7) == 0) lfl[tl * 8 + myh] = lf;
        }
        __syncthreads();
        const int hh = tid_ & 7, p = tid_ >> 3;
        if (tid_ < 64) { float run = 0.f; for (int i = 0; i < 16; ++i) { run += lfl[(p * 16 + i) * 8 + hh]; lfl[(p * 16 + i) * 8 + hh] = run; } part[p * 8 + hh] = run; }
        __syncthreads();
        if (tid_ < 64) { float off = 0.f; for (int q = 0; q < p; ++q) off += part[q * 8 + hh];
            const int t0 = (blk % (SEQ / 128)) * 128 + p * 16; float* dst = cumT + ((size_t)(b * 8 + hh)) * SEQ + t0;
            for (int i = 0; i < 16; ++i) dst[i] = lfl[(p * 16 + i) * 8 + hh] + off;
            if (p == 7) segtot[blk * 8 + hh] = off + part[7 * 8 + hh]; }
        __syncthreads();
    }
}


__device__ __forceinline__ void p_cumfix(Frame& F, const Args& A) {
    PHASE_IDS();
    unsigned char* ws = A.ws; float* cumT = (float*)(ws + WS_CUM); const float* segtot = (const float*)(ws + WS_SEGTOT);
    LAS float* pre = (LAS float*)(F.lds);
    for (int blk = blockIdx.x; blk < M / 128; blk += F.G) {
        const int b = blk / (SEQ / 128), seg = blk % (SEQ / 128);
        __syncthreads();
        if (tid_ < 64) { const int hh = tid_ & 7, part = tid_ >> 3; float a = 0.f; for (int s = part; s < seg; s += 8) a += segtot[(b * 128 + s) * 8 + hh];
            a += __shfl_xor(a, 8); a += __shfl_xor(a, 16); a += __shfl_xor(a, 32); if (part == 0) pre[hh] = a; }
        __syncthreads();
        for (int i = tid_; i < 8 * 128; i += NWAVES * 64) { const int hh = i >> 7, t = i & 127; cumT[((size_t)(b * 8 + hh)) * SEQ + seg * 128 + t] += pre[hh]; }
    }
}
__device__ __forceinline__ void p_qknorm(Frame& F, const Args& A, unsigned* qkmax) {
    PHASE_IDS();
    unsigned char* ws = A.ws; const bf16* Q = (const bf16*)(ws + WS_Q); const bf16* K = (const bf16*)(ws + WS_K);
    const int gw = F.vcu * NWAVES + wave_, NGW = F.G * NWAVES, hd = lane_ >> 3;
    float mq[2] = {0.f, 0.f}, mk[2] = {0.f, 0.f};
    for (int m = gw; m < M; m += NGW) { const int b = m / SEQ;
        const v4u qw = *(const v4u*)(Q + (size_t)m * 512 + 8 * lane_), kw = *(const v4u*)(K + (size_t)m * 512 + 8 * lane_);
        float sq = 0.f, sk = 0.f;
#pragma unroll
        for (int e = 0; e < 4; ++e) { const float a = bflo(qw[e]), c = bfhi(qw[e]), d = bflo(kw[e]), f = bfhi(kw[e]); sq += a * a + c * c; sk += d * d + f * f; }
        sq += __shfl_xor(sq, 1); sq += __shfl_xor(sq, 2); sq += __shfl_xor(sq, 4); sk += __shfl_xor(sk, 1); sk += __shfl_xor(sk, 2); sk += __shfl_xor(sk, 4);
        if (b == 0) { mq[0] = fmaxf(mq[0], sq); mk[0] = fmaxf(mk[0], sk); } else { mq[1] = fmaxf(mq[1], sq); mk[1] = fmaxf(mk[1], sk); } }
    if ((lane_ & 7) == 0) {
#pragma unroll
        for (int b = 0; b < 2; ++b) { if (mq[b] > 0.f) atomicMax(qkmax + (b * 8 + hd) * 2, __float_as_uint(mq[b])); if (mk[b] > 0.f) atomicMax(qkmax + (b * 8 + hd) * 2 + 1, __float_as_uint(mk[b])); } }
}

template <int WITH_MOE>
__device__ __forceinline__ void p_final(Frame& F, const Args& A, const float* src) {
    PHASE_IDS();
    unsigned char* ws = A.ws; const float* fg = A.in[29]; const float* mod = (const float*)(ws + WS_MOD);
    const int* route = (const int*)(ws + WS_ROUTE); const bf16* Y = (const bf16*)(ws + WS_YM);
    f32x4 fgv[4];
#pragma unroll
    for (int j = 0; j < 4; ++j) fgv[j] = *(const f32x4*)(fg + 4 * lane_ + 256 * j);
    const int gw = F.vcu * NWAVES + wave_, NGW = F.G * NWAVES;
    for (int m = gw; m < M; m += NGW) {
        f32x4 v[4]; float s = 0.f;
        if (WITH_MOE) { const GAS unsigned long long* xb = (const GAS unsigned long long*)((const bf16*)(ws + WS_X1) + (size_t)m * D) + lane_;
#pragma unroll
            for (int j = 0; j < 4; ++j) { const unsigned long long a = xb[64 * j]; const unsigned al = (unsigned)a, ah = (unsigned)(a >> 32); v[j] = (f32x4){bflo(al), bfhi(al), bflo(ah), bfhi(ah)}; } }
        else { const GAS f32x4* xr = (const GAS f32x4*)(src + (size_t)m * D) + lane_;
#pragma unroll
            for (int j = 0; j < 4; ++j) v[j] = xr[64 * j]; }
        if (WITH_MOE) {
            const int b = m / SEQ; const int* rt_ = route + (size_t)m * 8;
            const float w0 = __int_as_float(rt_[2]), w1 = __int_as_float(rt_[3]); const int s0 = rt_[6], s1 = rt_[7];
            const GAS unsigned* y0 = (const GAS unsigned*)((const unsigned char*)Y + (size_t)s0 * D) + lane_; const GAS unsigned* y1 = (const GAS unsigned*)((const unsigned char*)Y + (size_t)s1 * D) + lane_;
#pragma unroll
            for (int j = 0; j < 4; ++j) { const int a = (int)y0[64 * j], c = (int)y1[64 * j]; const f32x4 g2 = *(const f32x4*)(mod + b * 6144 + 5120 + 4 * lane_ + 256 * j);
                f32x4 y; y.x = w0 * __builtin_amdgcn_cvt_f32_fp8(a, 0) + w1 * __builtin_amdgcn_cvt_f32_fp8(c, 0); y.y = w0 * __builtin_amdgcn_cvt_f32_fp8(a, 1) + w1 * __builtin_amdgcn_cvt_f32_fp8(c, 1);
                y.z = w0 * __builtin_amdgcn_cvt_f32_fp8(a, 2) + w1 * __builtin_amdgcn_cvt_f32_fp8(c, 2); y.w = w0 * __builtin_amdgcn_cvt_f32_fp8(a, 3) + w1 * __builtin_amdgcn_cvt_f32_fp8(c, 3);
                v[j] = v[j] + g2 * y; }
        }
#pragma unroll
        for (int j = 0; j < 4; ++j) s += (v[j].x * v[j].x + v[j].y * v[j].y) + (v[j].z * v[j].z + v[j].w * v[j].w);
        float rstd = 1.0f / sqrtf(wave_sum(s) * (1.f / D) + 1e-6f);
        if (WITH_MOE == 2) { if (((const unsigned*)(ws + WS_CTL))[CW_DIAG]) rstd = 0.f; }
        GAS f32x4* o = (GAS f32x4*)(A.out + (size_t)m * D) + lane_;
#pragma unroll
        for (int j = 0; j < 4; ++j) o[64 * j] = v[j] * rstd * fgv[j];
    }
}

typedef float f32x16 __attribute__((ext_vector_type(16)));
typedef unsigned u32x2 __attribute__((ext_vector_type(2)));
__device__ __forceinline__ f32x4 shift4(const bf16* p, bool has_prev, const float* mu) {
    const u32x2 c = *(const u32x2*)p; u32x2 q = *(const u32x2*)(has_prev ? p - SHW : p); if (!has_prev) q = (u32x2){0u, 0u};
    const f32x4 m = *(const f32x4*)mu;
    f32x4 cv = {bflo(c.x), bfhi(c.x), bflo(c.y), bfhi(c.y)}, pv = {bflo(q.x), bfhi(q.x), bflo(q.y), bfhi(q.y)};
    return cv + (pv - cv) * m;
}
__device__ __forceinline__ u32x2 pack4(f32x4 v) { u32x2 r; r.x = pk2(v.x, v.y); r.y = pk2(v.z, v.w); return r; }

__device__ __forceinline__ float fsig(float x) { return __builtin_amdgcn_rcpf(1.0f + __builtin_amdgcn_exp2f(-1.4426950408889634f * x)); }
__device__ __forceinline__ float ftanh(float x) { const float xc = fminf(fmaxf(x, -15.f), 15.f); return 1.0f - 2.0f * __builtin_amdgcn_rcpf(1.0f + __builtin_amdgcn_exp2f(2.8853900817779268f * xc)); }
__device__ __forceinline__ float half_sum32(float v) { v = row_sum16(v); v += __shfl_xor(v, 16); return v; }
__device__ __forceinline__ void shift2(const bf16* p, bool has_prev, const float (&mu)[2], float (&o)[2]) {
    const unsigned c = *(const unsigned*)p; unsigned q = *(const unsigned*)(has_prev ? p - SHW : p); if (!has_prev) q = 0u;
    const float c0 = bflo(c), c1 = bfhi(c); o[0] = c0 + (bflo(q) - c0) * mu[0]; o[1] = c1 + (bfhi(q) - c1) * mu[1];
}
template <int VAR> __device__ __forceinline__ void rwkv_pre(Frame& F, const Args& A, int ci_lo, int ci_hi) {
    PHASE_IDS();
    unsigned char* ws = A.ws;
    const bf16* PRW = (const bf16*)(ws + WS_PRW);
    const float* mu = A.in[7]; const float* w0 = A.in[8]; const float* a0 = A.in[10]; const float* k_k = A.in[13]; const float* k_a = A.in[14]; const float* r_k = A.in[15];
    const bf16* LW2 = (const bf16*)(ws + WS_LW2); const bf16* LA2 = (const bf16*)(ws + WS_LA2); const bf16* LG2 = (const bf16*)(ws + WS_LG2);
    float* LW = (float*)A.out; bf16* R = (bf16*)((unsigned char*)A.out + 64 * MiB); bf16* KP = (bf16*)((unsigned char*)A.out + 96 * MiB);
    bf16* VV = (bf16*)(ws + WS_XN); bf16* AV = (bf16*)(ws + WS_XN + 32 * MiB); bf16* BV = (bf16*)(ws + WS_F); bf16* GG = (bf16*)(ws + WS_F + 32 * MiB);
    float* BON = (float*)(ws + WS_BON);
    LAS bf16* Xw = (LAS bf16*)(F.lds); LAS bf16* Xa = (LAS bf16*)(F.lds + 9216); LAS bf16* Xg = (LAS bf16*)(F.lds + 18432);
    const int h = wave_;
    for (int ci = ci_lo; ci < ci_hi; ci += F.G) {
        __syncthreads();
        {
            int tl_ = threadIdx.x; asm volatile("" : "+v"(tl_));
            const int row = tl_ >> 3, cg = tl_ & 7; const size_t tok = (size_t)ci * 64 + row; const bool hp = (tok % SEQ) != 0;
            const bf16* src = PRW + tok * SHW + 1536 + 32 * cg; const float* mup = mu + 1536 + 32 * cg;
            LAS bf16* dst = (cg < 2) ? (Xw + row * 72 + 32 * cg) : (cg < 4) ? (Xa + row * 72 + 32 * (cg - 2)) : (Xg + row * 136 + 32 * (cg - 4));
#pragma unroll
            for (int q = 0; q < 8; ++q) { f32x4 v = shift4(src + 4 * q, hp, mup + 4 * q);
                if (cg < 2) { v.x = ftanh(v.x); v.y = ftanh(v.y); v.z = ftanh(v.z); v.w = ftanh(v.w); }
                else if (cg >= 4) { v.x = fsig(v.x); v.y = fsig(v.y); v.z = fsig(v.z); v.w = fsig(v.w); }
                *(LAS u32x2*)(dst + 4 * q) = pack4(v); }
        }
        __syncthreads();
        int ln_ = threadIdx.x & 63; asm volatile("" : "+v"(ln_));
        const int c = ln_ & 31, hh = ln_ >> 5, colb = 64 * h + 2 * c;
    float mur[2], muk[2], muv[2], kkc[2], kac[2], rkc[2], a0c[2], w0c[2];
#pragma unroll
    for (int e = 0; e < 2; ++e) { mur[e] = mu[colb + e]; muk[e] = mu[512 + colb + e]; muv[e] = mu[1024 + colb + e]; kkc[e] = k_k[colb + e]; kac[e] = k_a[colb + e]; rkc[e] = r_k[colb + e]; a0c[e] = a0[colb + e]; w0c[e] = w0[colb + e]; }
#pragma unroll 1
        for (int tb = 0; tb < ((VAR == 3) ? 0 : 2); ++tb) {
            f32x16 aa[2], aw[2], ag[2];
            aa[0] = f32x16{}; aa[1] = f32x16{}; aw[0] = f32x16{}; aw[1] = f32x16{}; ag[0] = f32x16{}; ag[1] = f32x16{};
            if (VAR != 4) {
#pragma unroll
            for (int ks = 0; ks < 4; ++ks) { const bf16x8 afr = *(const LAS bf16x8*)(Xa + (32 * tb + c) * 72 + 16 * ks + 8 * hh), wfr = *(const LAS bf16x8*)(Xw + (32 * tb + c) * 72 + 16 * ks + 8 * hh);
#pragma unroll
                for (int jb = 0; jb < 2; ++jb) { const bf16x8 b1 = *(const bf16x8*)(LA2 + (size_t)(colb + jb) * 64 + 16 * ks + 8 * hh), b2 = *(const bf16x8*)(LW2 + (size_t)(colb + jb) * 64 + 16 * ks + 8 * hh);
                    aa[jb] = __builtin_amdgcn_mfma_f32_32x32x16_bf16(afr, b1, aa[jb], 0, 0, 0); aw[jb] = __builtin_amdgcn_mfma_f32_32x32x16_bf16(wfr, b2, aw[jb], 0, 0, 0); } }
#pragma unroll
            for (int ks = 0; ks < 8; ++ks) { const bf16x8 gfr = *(const LAS bf16x8*)(Xg + (32 * tb + c) * 136 + 16 * ks + 8 * hh);
#pragma unroll
                for (int jb = 0; jb < 2; ++jb) { const bf16x8 b3 = *(const bf16x8*)(LG2 + (size_t)(colb + jb) * 128 + 16 * ks + 8 * hh); ag[jb] = __builtin_amdgcn_mfma_f32_32x32x16_bf16(gfr, b3, ag[jb], 0, 0, 0); } }
            }
            unsigned gpk[16], apk[16];
#pragma unroll
            for (int reg = 0; reg < 16; ++reg) { gpk[reg] = pk2(ag[0][reg], ag[1][reg]); apk[reg] = pk2(fsig(a0c[0] + aa[0][reg]), fsig(a0c[1] + aa[1][reg])); }
            unsigned rawc[16][3], rawq[4][3];
#pragma unroll
            for (int reg = 0; reg < 16; ++reg) { const int t = 32 * tb + (reg & 3) + 8 * (reg >> 2) + 4 * hh; const size_t tok = (size_t)ci * 64 + t; const bool hp = (tok % SEQ) != 0;
                const bf16* prow = PRW + tok * SHW + colb; const bf16* pprev = hp ? prow - SHW : prow;
#pragma unroll
                for (int x = 0; x < 3; ++x) { if (VAR == 2) { rawc[reg][x] = 0x3f803f80u + reg; if ((reg & 3) == 0) rawq[reg >> 2][x] = 0x3f803f80u; } else { rawc[reg][x] = *(const unsigned*)(prow + 512 * x); if ((reg & 3) == 0) { const unsigned q = *(const unsigned*)(pprev + 512 * x); rawq[reg >> 2][x] = hp ? q : 0u; } } } }
#pragma unroll
            for (int reg = 0; reg < 16; ++reg) {
                const int t = 32 * tb + (reg & 3) + 8 * (reg >> 2) + 4 * hh; const size_t tok = (size_t)ci * 64 + t;
                unsigned rawp_[3];
#pragma unroll
                for (int x = 0; x < 3; ++x) rawp_[x] = ((reg & 3) == 0) ? rawq[reg >> 2][x] : rawc[(reg + 15) & 15][x];
                float kx[2], rx[2], vx[2];
                { const unsigned cc_ = rawc[reg][0], pp_ = rawp_[0]; const float c0 = bflo(cc_), c1 = bfhi(cc_); rx[0] = c0 + (bflo(pp_) - c0) * mur[0]; rx[1] = c1 + (bfhi(pp_) - c1) * mur[1]; }
                { const unsigned cc_ = rawc[reg][1], pp_ = rawp_[1]; const float c0 = bflo(cc_), c1 = bfhi(cc_); kx[0] = c0 + (bflo(pp_) - c0) * muk[0]; kx[1] = c1 + (bfhi(pp_) - c1) * muk[1]; }
                { const unsigned cc_ = rawc[reg][2], pp_ = rawp_[2]; const float c0 = bflo(cc_), c1 = bfhi(cc_); vx[0] = c0 + (bflo(pp_) - c0) * muv[0]; vx[1] = c1 + (bfhi(pp_) - c1) * muv[1]; }
                const float as0 = bflo(apk[reg]), as1 = bfhi(apk[reg]);
                const float kr0 = kx[0] * kkc[0], kr1 = kx[1] * kkc[1];
                const float ss = half_sum32(kr0 * kr0 + kr1 * kr1); const float inv = __builtin_amdgcn_rsqf(fmaxf(ss, 1e-24f));
                const float kk0 = kr0 * inv, kk1 = kr1 * inv, kp0 = kx[0] * (1.0f + (as0 - 1.0f) * kac[0]), kp1 = kx[1] * (1.0f + (as1 - 1.0f) * kac[1]);
                const float bon = half_sum32(rx[0] * kp0 * rkc[0] + rx[1] * kp1 * rkc[1]);
                float o2[2];
#pragma unroll
                for (int e = 0; e < 2; ++e) { const float z = -(w0c[e] + aw[e][reg]);
                    const float sp = fmaxf(z, 0.f) + 0.6931471805599453f * __builtin_amdgcn_logf(1.0f + __builtin_amdgcn_exp2f(-1.4426950408889634f * fabsf(z))); o2[e] = -__builtin_amdgcn_exp2f(-1.4426950408889634f * (sp + 0.5f)); }
                const unsigned ob = (unsigned)tok * 1024u + (unsigned)colb * 2u;
                if (VAR == 0) {
                *(unsigned*)((unsigned char*)R + ob) = pk2(rx[0], rx[1]); *(unsigned*)((unsigned char*)KP + ob) = pk2(kp0, kp1); *(unsigned*)((unsigned char*)VV + ob) = pk2(vx[0], vx[1]);
                *(unsigned*)((unsigned char*)AV + ob) = pk2(-kk0, -kk1); *(unsigned*)((unsigned char*)BV + ob) = pk2(kk0 * as0, kk1 * as1);
                *(float2*)((unsigned char*)LW + 2u * ob) = make_float2(o2[0], o2[1]); *(unsigned*)((unsigned char*)GG + ob) = gpk[reg];
                if (c == 0) BON[tok * 8 + h] = bon;
                } else { asm volatile("" :: "v"(pk2(rx[0], rx[1])), "v"(pk2(kp0, kp1)), "v"(pk2(vx[0], vx[1])), "v"(pk2(-kk0, -kk1)), "v"(pk2(kk0 * as0, kk1 * as1)), "v"(o2[0]), "v"(o2[1]), "v"(gpk[reg]), "v"(bon), "v"(ob)); }
                if ((reg & 3) == 3) __builtin_amdgcn_sched_barrier(0);
            }
        }
    }
}

__device__ __forceinline__ void rwkv_scan_seq(Frame& F, const Args& A) {
    PHASE_IDS();
    if (blockIdx.x >= BATCH * 8) return;
    unsigned char* ws = A.ws;
    const float* LW = (const float*)A.out; const bf16* R = (const bf16*)((unsigned char*)A.out + 64 * MiB); const bf16* KP = (const bf16*)((unsigned char*)A.out + 96 * MiB);
    const bf16* VV = (const bf16*)(ws + WS_XN); const bf16* AV = (const bf16*)(ws + WS_XN + 32 * MiB); const bf16* BV = (const bf16*)(ws + WS_F);
    float* Y = (float*)(ws + WS_Y);
    const int b = blockIdx.x >> 3, h = blockIdx.x & 7;
    constexpr int STEPB = 896, CH = 16, BUFB = STEPB * CH;
    LAS unsigned char* buf = F.lds;
    const size_t tok0 = (size_t)b * SEQ;
    const bool loader = wave_ >= 4; const int lt = tid_ - 256;
    auto load_chunk = [&](int cidx, int slot) {
        for (int p = lt; p < CH * 56; p += 256) { const int s = p / 56, q = p % 56; const size_t tok = tok0 + (size_t)cidx * CH + s; v4u val;
            if (q < 16) val = *(const v4u*)(LW + tok * 512 + 64 * h + 4 * q);
            else { const int a = (q - 16) >> 3, o8 = (q - 16) & 7; const bf16* src = (a == 0) ? AV : (a == 1) ? BV : (a == 2) ? KP : (a == 3) ? R : VV; val = *(const v4u*)(src + tok * 512 + 64 * h + 8 * o8); }
            *(LAS v4u*)(buf + slot * BUFB + s * STEPB + q * 16) = val; }
    };
    if (loader) load_chunk(0, 0);
    __syncthreads();
    float S[16];
#pragma unroll
    for (int j = 0; j < 16; ++j) S[j] = 0.f;
    const int il = lane_ & 15, jq = lane_ >> 4, irow = 16 * wave_ + il;
    for (int cidx = 0; cidx < SEQ / CH; ++cidx) {
        if (loader) { if (cidx + 1 < SEQ / CH) load_chunk(cidx + 1, (cidx + 1) & 1); }
        else {
            const LAS unsigned char* bb = buf + (cidx & 1) * BUFB;
#pragma unroll 4
            for (int s = 0; s < CH; ++s) { const LAS unsigned char* sp = bb + s * STEPB;
                float w[16], av[16], bv[16], kv[16], rv[16];
#pragma unroll
                for (int q = 0; q < 4; ++q) { const f32x4 l4 = *(const LAS f32x4*)(sp + 64 * jq + 16 * q); w[4 * q] = __expf(l4.x); w[4 * q + 1] = __expf(l4.y); w[4 * q + 2] = __expf(l4.z); w[4 * q + 3] = __expf(l4.w); }
#pragma unroll
                for (int q = 0; q < 2; ++q) { const v4u a4 = *(const LAS v4u*)(sp + 256 + 32 * jq + 16 * q), b4 = *(const LAS v4u*)(sp + 384 + 32 * jq + 16 * q), k4 = *(const LAS v4u*)(sp + 512 + 32 * jq + 16 * q), r4 = *(const LAS v4u*)(sp + 640 + 32 * jq + 16 * q);
#pragma unroll
                    for (int e = 0; e < 4; ++e) { av[8 * q + 2 * e] = bflo(a4[e]); av[8 * q + 2 * e + 1] = bfhi(a4[e]); bv[8 * q + 2 * e] = bflo(b4[e]); bv[8 * q + 2 * e + 1] = bfhi(b4[e]);
                        kv[8 * q + 2 * e] = bflo(k4[e]); kv[8 * q + 2 * e + 1] = bfhi(k4[e]); rv[8 * q + 2 * e] = bflo(r4[e]); rv[8 * q + 2 * e + 1] = bfhi(r4[e]); } }
                const unsigned short vraw = *(const LAS unsigned short*)(sp + 768 + 2 * irow); const float vi = __uint_as_float((unsigned)vraw << 16);
                float sa = 0.f;
#pragma unroll
                for (int j = 0; j < 16; ++j) sa += S[j] * av[j];
                sa += __shfl_xor(sa, 16); sa += __shfl_xor(sa, 32);
                float y = 0.f;
#pragma unroll
                for (int j = 0; j < 16; ++j) { S[j] = S[j] * w[j] + sa * bv[j] + vi * kv[j]; y += S[j] * rv[j]; }
                y += __shfl_xor(y, 16); y += __shfl_xor(y, 32);
                if (jq == 0) Y[(tok0 + (size_t)cidx * CH + s) * 512 + 64 * h + irow] = y;
            }
        }
        __syncthreads();
    }
}

__device__ __forceinline__ void rwkv_post(Frame& F, const Args& A) {
    PHASE_IDS();
    unsigned char* ws = A.ws;
    const float* Y = (const float*)(ws + WS_Y); const bf16* VV = (const bf16*)(ws + WS_XN); const bf16* GG = (const bf16*)(ws + WS_F + 32 * MiB); const float* BON = (const float*)(ws + WS_BON);
    bf16* O = (bf16*)(ws + WS_F);
    const float* lg = A.in[16]; const float* lb = A.in[17];
    const int gw = F.vcu * NWAVES + wave_, NGW = F.G * NWAVES, col = 8 * lane_, hd = lane_ >> 3;
    const f32x4 g0 = *(const f32x4*)(lg + col), g1 = *(const f32x4*)(lg + col + 4), b0 = *(const f32x4*)(lb + col), b1 = *(const f32x4*)(lb + col + 4);
    for (int m = gw; m < M; m += NGW) {
        const f32x4 y0 = *(const f32x4*)(Y + (size_t)m * 512 + col), y1 = *(const f32x4*)(Y + (size_t)m * 512 + col + 4);
        float s = (y0.x + y0.y) + (y0.z + y0.w) + (y1.x + y1.y) + (y1.z + y1.w);
        s += __shfl_xor(s, 1); s += __shfl_xor(s, 2); s += __shfl_xor(s, 4);
        const float mean = s * (1.f / 64.f); const f32x4 d0 = y0 - mean, d1 = y1 - mean;
        float q = (d0.x * d0.x + d0.y * d0.y) + (d0.z * d0.z + d0.w * d0.w) + (d1.x * d1.x + d1.y * d1.y) + (d1.z * d1.z + d1.w * d1.w);
        q += __shfl_xor(q, 1); q += __shfl_xor(q, 2); q += __shfl_xor(q, 4);
        const float rstd = 1.0f / sqrtf(q * (1.f / 64.f) + 64e-5f);
        const float bon = BON[(size_t)m * 8 + hd];
        const v4u vw = *(const v4u*)(VV + (size_t)m * 512 + col), gw4 = *(const v4u*)(GG + (size_t)m * 512 + col);
        f32x4 o0 = (d0 * rstd * g0 + b0), o1 = (d1 * rstd * g1 + b1);
        o0.x = (o0.x + bon * bflo(vw.x)) * bflo(gw4.x); o0.y = (o0.y + bon * bfhi(vw.x)) * bfhi(gw4.x); o0.z = (o0.z + bon * bflo(vw.y)) * bflo(gw4.y); o0.w = (o0.w + bon * bfhi(vw.y)) * bfhi(gw4.y);
        o1.x = (o1.x + bon * bflo(vw.z)) * bflo(gw4.z); o1.y = (o1.y + bon * bfhi(vw.z)) * bfhi(gw4.z); o1.z = (o1.z + bon * bflo(vw.w)) * bflo(gw4.w); o1.w = (o1.w + bon * bfhi(vw.w)) * bfhi(gw4.w);
        v4u ow; ow.x = pk2(o0.x, o0.y); ow.y = pk2(o0.z, o0.w); ow.z = pk2(o1.x, o1.y); ow.w = pk2(o1.z, o1.w);
        *(v4u*)(O + (size_t)m * 512 + col) = ow;
    }
}

__device__ __forceinline__ size_t pq_off(int it) { const int ch = it >> 8, cc = it & 255; return WS_PRW + ((size_t)(ch >> 3) * SEQ + (size_t)cc * 64) * (SHW * 2) + (size_t)(ch & 7) * 24576; }
__device__ __forceinline__ size_t y0_off(int it, int idx) { const int ch = it >> 8, cc = it & 255; return (((size_t)(ch >> 3) * SEQ + (size_t)cc * 64 + (idx >> 4)) * 512 + 64 * (ch & 7)) * 4 + (size_t)(idx & 15) * 16; }
constexpr size_t ST_OFF = 64 * MiB;
constexpr int CH_ITEMS = BATCH * 8 * (SEQ / 64);

__device__ __forceinline__ int sw16(int row, int chunk) { return row * 128 + ((chunk ^ (row & 7)) << 4); }
typedef float f32x4c __attribute__((ext_vector_type(4)));
__device__ __forceinline__ bf16x8 ld_frag(const LAS unsigned char* Mx, int row, int chunk) { return *(const LAS bf16x8*)(Mx + sw16(row, chunk)); }
template <bool SWAP>
__device__ __forceinline__ void mm_tile(const LAS unsigned char* Am, const LAS unsigned char* Bm, int r0, int c0, int l15, int kg, f32x4c (&acc)[2]) {
    bf16x8 a[2], b[2][2];
#pragma unroll
    for (int ks = 0; ks < 2; ++ks) { a[ks] = ld_frag(Am, r0 + l15, 4 * ks + kg);
#pragma unroll
        for (int n = 0; n < 2; ++n) b[ks][n] = ld_frag(Bm, c0 + 16 * n + l15, 4 * ks + kg); }
#pragma unroll
    for (int ks = 0; ks < 2; ++ks)
#pragma unroll
        for (int n = 0; n < 2; ++n)
            acc[n] = SWAP ? __builtin_amdgcn_mfma_f32_16x16x32_bf16(b[ks][n], a[ks], acc[n], 0, 0, 0) : __builtin_amdgcn_mfma_f32_16x16x32_bf16(a[ks], b[ks][n], acc[n], 0, 0, 0);
}
__device__ __forceinline__ unsigned long long pack4u(f32x4c v) { return (unsigned long long)pk2(v[0], v[1]) | ((unsigned long long)pk2(v[2], v[3]) << 32); }
__device__ __forceinline__ void st_nat(LAS unsigned char* O, int r0, int c0, int l15, int kg, const f32x4c (&acc)[2]) {
#pragma unroll
    for (int n = 0; n < 2; ++n) { const int row = r0 + l15, col = c0 + 16 * n + 4 * kg; *(LAS unsigned long long*)(O + sw16(row, col >> 3) + (col & 4) * 2) = pack4u(acc[n]); }
}
__device__ __forceinline__ void st_tr(LAS unsigned char* OT, int r0, int c0, int l15, int kg, const f32x4c (&acc)[2]) {
#pragma unroll
    for (int n = 0; n < 2; ++n)
#pragma unroll
        for (int e = 0; e < 4; ++e) { const int row = r0 + l15, col = c0 + 16 * n + 4 * kg + e; *(LAS unsigned short*)(OT + sw16(col, row >> 3) + (row & 7) * 2) = (unsigned short)f2bf(acc[n][e]); }
}
__device__ __forceinline__ f32x4c ld_nat4(const LAS unsigned char* O, int row, int col) { const unsigned long long w = *(const LAS unsigned long long*)(O + sw16(row, col >> 3) + (col & 4) * 2);
    const unsigned lo = (unsigned)w, hi = (unsigned)(w >> 32); return (f32x4c){bflo(lo), bfhi(lo), bflo(hi), bfhi(hi)}; }

template <int VAR> __device__ __forceinline__ void rwkv_r1(Frame& F, const Args& A, int it_lo, int it_hi, int it_step) {
    PHASE_IDS();
    unsigned char* ws = A.ws;
    const float* LW = (const float*)A.out; const bf16* R = (const bf16*)((unsigned char*)A.out + 64 * MiB); const bf16* KP = (const bf16*)((unsigned char*)A.out + 96 * MiB);
    const bf16* VV = (const bf16*)(ws + WS_XN); const bf16* AV = (const bf16*)(ws + WS_XN + 32 * MiB); const bf16* BV = (const bf16*)(ws + WS_F);
    LAS unsigned char* L = F.lds;
#define MB(i) (L + (i) * 8192)
    LAS float* gCs = (LAS float*)(L + 17 * 8192); LAS float* part = gCs + 64;
    const int w = wave_, j = lane_, l15 = lane_ & 15, kg = lane_ >> 4, r0 = 16 * (w >> 1), c0 = 32 * (w & 1);
#define R1_BAR() asm volatile("s_waitcnt lgkmcnt(0)\n\ts_barrier" ::: "memory")
    float nlw[8]; unsigned short nav[8], nbv[8], nkv[8], nrv[8], nvv[8];
#define R1_LOAD(itx) do { const int ch_ = (itx) >> 8, cc_ = (itx) & 255; const size_t tb_ = (size_t)(ch_ >> 3) * SEQ + (size_t)cc_ * 64 + 8 * w; const int cg_ = 64 * (ch_ & 7) + j; \
        _Pragma("unroll") for (int t = 0; t < 8; ++t) { const size_t o = (tb_ + t) * 512 + cg_; nlw[t] = LW[o]; nav[t] = AV[o]; nbv[t] = BV[o]; nkv[t] = KP[o]; nrv[t] = R[o]; nvv[t] = VV[o]; } } while (0)
    if (it_lo < it_hi) R1_LOAD(it_lo);
    for (int it = it_lo; it < it_hi; it += it_step) {
        R1_BAR();
        {
            float g[8], lw[8], av[8], bv[8], kv[8], rv[8]; unsigned short vraw[8]; float run = 0.f;
#pragma unroll
            for (int t = 0; t < 8; ++t) { lw[t] = nlw[t]; av[t] = __uint_as_float((unsigned)nav[t] << 16); bv[t] = __uint_as_float((unsigned)nbv[t] << 16);
                kv[t] = __uint_as_float((unsigned)nkv[t] << 16); rv[t] = __uint_as_float((unsigned)nrv[t] << 16); vraw[t] = nvv[t]; run += lw[t]; g[t] = run; }
            if (it + it_step < it_hi) R1_LOAD(it + it_step);
            part[w * 64 + j] = run;
            R1_BAR();
            float pre = 0.f, tot = 0.f;
#pragma unroll
            for (int q = 0; q < 8; ++q) { const float p = part[q * 64 + j]; tot += p; if (q < w) pre += p; }
            if (w == 0) gCs[j] = __expf(tot);
            unsigned short atT[8], bhT[8], khT[8];
#pragma unroll
            for (int t = 0; t < 8; ++t) { const float G = pre + g[t]; const float eg = __expf(G), en = __expf(-G), ea = __expf(G - lw[t]), ec = __expf(tot - G);
                const int row = 8 * w + t; const int off = sw16(row, j >> 3) + (j & 7) * 2;
                const unsigned short at = (unsigned short)f2bf(av[t] * ea);
                *(LAS unsigned short*)(MB(0) + off) = at; atT[t] = at;
                *(LAS unsigned short*)(MB(2) + off) = (unsigned short)f2bf(bv[t] * en);
                *(LAS unsigned short*)(MB(3) + off) = (unsigned short)f2bf(kv[t] * en);
                *(LAS unsigned short*)(MB(4) + off) = (unsigned short)f2bf(rv[t] * eg);
                bhT[t] = (unsigned short)f2bf(bv[t] * ec); khT[t] = (unsigned short)f2bf(kv[t] * ec); }
            v4u x;
            x.x = atT[0] | ((unsigned)atT[1] << 16); x.y = atT[2] | ((unsigned)atT[3] << 16); x.z = atT[4] | ((unsigned)atT[5] << 16); x.w = atT[6] | ((unsigned)atT[7] << 16); *(LAS v4u*)(MB(1) + sw16(j, w)) = x;
            x.x = bhT[0] | ((unsigned)bhT[1] << 16); x.y = bhT[2] | ((unsigned)bhT[3] << 16); x.z = bhT[4] | ((unsigned)bhT[5] << 16); x.w = bhT[6] | ((unsigned)bhT[7] << 16); *(LAS v4u*)(MB(5) + sw16(j, w)) = x;
            x.x = khT[0] | ((unsigned)khT[1] << 16); x.y = khT[2] | ((unsigned)khT[3] << 16); x.z = khT[4] | ((unsigned)khT[5] << 16); x.w = khT[6] | ((unsigned)khT[7] << 16); *(LAS v4u*)(MB(6) + sw16(j, w)) = x;
            x.x = vraw[0] | ((unsigned)vraw[1] << 16); x.y = vraw[2] | ((unsigned)vraw[3] << 16); x.z = vraw[4] | ((unsigned)vraw[5] << 16); x.w = vraw[6] | ((unsigned)vraw[7] << 16); *(LAS v4u*)(MB(7) + sw16(j, w)) = x;
        }
        R1_BAR();
        if (VAR == 1) continue;
        f32x4c acc[2];
        const int trow = r0 + l15;
        {
            acc[0] = f32x4c{}; acc[1] = f32x4c{}; mm_tile<true>(MB(0), MB(2), r0, c0, l15, kg, acc);
#pragma unroll
            for (int n = 0; n < 2; ++n)
#pragma unroll
                for (int e = 0; e < 4; ++e) { const int s = c0 + 16 * n + 4 * kg + e; if (s >= trow) acc[n][e] = 0.f; }
            st_nat(MB(8), r0, c0, l15, kg, acc); st_tr(MB(9), r0, c0, l15, kg, acc);
#pragma unroll
            for (int n = 0; n < 2; ++n)
#pragma unroll
                for (int e = 0; e < 4; ++e) { const int s = c0 + 16 * n + 4 * kg + e; if (s == trow) acc[n][e] = 1.f; }
            st_nat(MB(15), r0, c0, l15, kg, acc);
            acc[0] = f32x4c{}; acc[1] = f32x4c{}; mm_tile<true>(MB(0), MB(3), r0, c0, l15, kg, acc);
#pragma unroll
            for (int n = 0; n < 2; ++n)
#pragma unroll
                for (int e = 0; e < 4; ++e) { const int s = c0 + 16 * n + 4 * kg + e; if (s >= trow) acc[n][e] = 0.f; }
            st_nat(MB(10), r0, c0, l15, kg, acc);
            acc[0] = f32x4c{}; acc[1] = f32x4c{}; mm_tile<true>(MB(4), MB(2), r0, c0, l15, kg, acc);
#pragma unroll
            for (int n = 0; n < 2; ++n)
#pragma unroll
                for (int e = 0; e < 4; ++e) { const int s = c0 + 16 * n + 4 * kg + e; if (s > trow) acc[n][e] = 0.f; }
            st_nat(MB(11), r0, c0, l15, kg, acc);
            acc[0] = f32x4c{}; acc[1] = f32x4c{}; mm_tile<true>(MB(4), MB(3), r0, c0, l15, kg, acc);
#pragma unroll
            for (int n = 0; n < 2; ++n)
#pragma unroll
                for (int e = 0; e < 4; ++e) { const int s = c0 + 16 * n + 4 * kg + e; if (s > trow) acc[n][e] = 0.f; }
            st_nat(MB(12), r0, c0, l15, kg, acc);
        }
        R1_BAR();
        if (VAR == 2) continue;
        acc[0] = f32x4c{}; acc[1] = f32x4c{}; mm_tile<true>(MB(8), MB(9), r0, c0, l15, kg, acc); st_nat(MB(13), r0, c0, l15, kg, acc); st_tr(MB(14), r0, c0, l15, kg, acc);
        acc[0] = f32x4c{}; acc[1] = f32x4c{}; mm_tile<true>(MB(7), MB(10), r0, c0, l15, kg, acc); st_nat(MB(3), r0, c0, l15, kg, acc);
        R1_BAR();
#define SQUARE(xi, xti, xo, xto) do { acc[0] = f32x4c{}; acc[1] = f32x4c{}; mm_tile<true>(MB(xi), MB(xti), r0, c0, l15, kg, acc); st_nat(MB(xo), r0, c0, l15, kg, acc); st_tr(MB(xto), r0, c0, l15, kg, acc); } while (0)
#define MUPD(mi, xti, mo) do { acc[0] = ld_nat4(MB(mi), trow, c0 + 4 * kg); acc[1] = ld_nat4(MB(mi), trow, c0 + 16 + 4 * kg); mm_tile<true>(MB(mi), MB(xti), r0, c0, l15, kg, acc); st_nat(MB(mo), r0, c0, l15, kg, acc); } while (0)
        SQUARE(13, 14, 0, 2); MUPD(15, 14, 16); R1_BAR();
        SQUARE(0, 2, 13, 14); MUPD(16, 2, 15); R1_BAR();
        SQUARE(13, 14, 0, 2); MUPD(15, 14, 16); R1_BAR();
        SQUARE(0, 2, 13, 14); MUPD(16, 2, 15); R1_BAR();
        MUPD(15, 14, 16); R1_BAR();
        acc[0] = f32x4c{}; acc[1] = f32x4c{}; mm_tile<true>(MB(1), MB(16), r0, c0, l15, kg, acc); st_nat(MB(13), r0, c0, l15, kg, acc);
        acc[0] = f32x4c{}; acc[1] = f32x4c{}; mm_tile<true>(MB(3), MB(16), r0, c0, l15, kg, acc); st_nat(MB(14), r0, c0, l15, kg, acc);
        R1_BAR();
        if (VAR == 3) continue;
        unsigned char* og = ws + pq_off(it); unsigned char* oy = (unsigned char*)A.out + y0_off(it, w * 64 + lane_);
        {
            acc[0] = f32x4c{}; acc[1] = f32x4c{}; mm_tile<true>(MB(5), MB(13), r0, c0, l15, kg, acc);
            const float gc = gCs[trow];
#pragma unroll
            for (int n = 0; n < 2; ++n) { const int col = c0 + 16 * n + 4 * kg;
#pragma unroll
                for (int e = 0; e < 4; ++e) if (col + e == trow) acc[n][e] += gc;
                const int jj_ = col & 31, q_ = jj_ & 15; const size_t po_ = ((size_t)((((trow >> 5) * 2 + (col >> 5)) * 2 + (jj_ >> 4)) * 64 + (trow & 31) + 32 * ((q_ >> 2) & 1)) * 16 + (size_t)(4 * (q_ >> 3)) * 2);
                if (VAR == 0) *(unsigned long long*)(og + po_) = pack4u(acc[n]); else asm volatile("" :: "v"(pack4u(acc[n]))); }
            acc[0] = ld_nat4(MB(4), trow, c0 + 4 * kg); acc[1] = ld_nat4(MB(4), trow, c0 + 16 + 4 * kg); mm_tile<true>(MB(11), MB(13), r0, c0, l15, kg, acc);
#pragma unroll
            for (int n = 0; n < 2; ++n) { const int col = c0 + 16 * n + 4 * kg; if (VAR == 0) *(unsigned long long*)(og + 16384 + (size_t)(trow * 64 + col) * 2) = pack4u(acc[n]); else asm volatile("" :: "v"(pack4u(acc[n]))); }
            acc[0] = f32x4c{}; acc[1] = f32x4c{}; mm_tile<false>(MB(5), MB(14), r0, c0, l15, kg, acc); mm_tile<false>(MB(6), MB(7), r0, c0, l15, kg, acc);
#pragma unroll
            for (int n = 0; n < 2; ++n) { const int i_ = c0 + 16 * n + l15, jr_ = r0 + 4 * kg, rr_ = jr_ & 31;
                const size_t qo_ = (size_t)((((i_ >> 5) * 2 + (jr_ >> 5)) * 64 + (i_ & 31) + 32 * ((rr_ >> 2) & 1)) * 32 + (4 * (rr_ >> 3)) * 2);
                if (VAR == 0) *(unsigned long long*)(og + 8192 + qo_) = pack4u(acc[n]); else asm volatile("" :: "v"(pack4u(acc[n]))); }
            acc[0] = f32x4c{}; acc[1] = f32x4c{}; mm_tile<false>(MB(11), MB(14), r0, c0, l15, kg, acc); mm_tile<false>(MB(12), MB(7), r0, c0, l15, kg, acc);
            { v4u q; q.x = pk2(acc[0][0], acc[0][1]); q.y = pk2(acc[0][2], acc[0][3]); q.z = pk2(acc[1][0], acc[1][1]); q.w = pk2(acc[1][2], acc[1][3]); if (VAR == 0) *(v4u*)oy = q; else asm volatile("" :: "v"(q)); }
        }
    }
#undef SQUARE
#undef MUPD
#undef MB
#undef R1_BAR
#undef R1_LOAD
}

template <int VAR> __device__ __forceinline__ void rwkv_r2(Frame& F, const Args& A, unsigned char* stbase) {
    PHASE_IDS();
    if (blockIdx.x >= BATCH * 8) return;
    unsigned char* ws = A.ws;
    LAS unsigned char* L = F.lds;
    const int ch = blockIdx.x, w = wave_, l15 = lane_ & 15, kg = lane_ >> 4, r0 = 16 * (w >> 1), c0 = 32 * (w & 1);
    const unsigned char* pq = ws + pq_off(ch * 256); unsigned char* st = stbase + (size_t)ch * 256 * 8192;
    for (int i = tid_; i < 2048; i += NWAVES * 64) { ((LAS unsigned*)L)[i] = 0u; }
    for (int i = tid_; i < 512; i += NWAVES * 64) ((v4u*)st)[i] = (v4u){0u, 0u, 0u, 0u};
    __syncthreads();
    constexpr int PF = 8;
    bf16x8 pa[PF][2]; v4u qf[PF];
#define R2_LOAD(slot, step) do { const unsigned char* p_ = pq + (size_t)(step) * (64 * SHW * 2); \
        pa[slot][0] = *(const bf16x8*)(p_ + (size_t)((r0 + l15) * 64 + 8 * kg) * 2); pa[slot][1] = *(const bf16x8*)(p_ + (size_t)((r0 + l15) * 64 + 32 + 8 * kg) * 2); \
        qf[slot] = *(const v4u*)(p_ + 8192 + (size_t)(w * 64 + lane_) * 16); } while (0)
#pragma unroll
    for (int s = 0; s < PF; ++s) R2_LOAD(s, s);
    for (int c = 0; c < 256; c += PF) {
#pragma unroll
        for (int s = 0; s < PF; ++s) {
            const int step = c + s; const LAS unsigned char* Sin = L + (step & 15) * 8192; LAS unsigned char* Sout = L + ((step + 1) & 15) * 8192;
            f32x4c acc[2];
            acc[0] = (f32x4c){bflo(qf[s].x), bfhi(qf[s].x), bflo(qf[s].y), bfhi(qf[s].y)}; acc[1] = (f32x4c){bflo(qf[s].z), bfhi(qf[s].z), bflo(qf[s].w), bfhi(qf[s].w)};
            bf16x8 sf[2][2];
#pragma unroll
            for (int ks = 0; ks < 2; ++ks)
#pragma unroll
                for (int n = 0; n < 2; ++n) sf[ks][n] = ld_frag(Sin, c0 + 16 * n + l15, 4 * ks + kg);
#pragma unroll
            for (int ks = 0; ks < 2; ++ks)
#pragma unroll
                for (int n = 0; n < 2; ++n) acc[n] = __builtin_amdgcn_mfma_f32_16x16x32_bf16(pa[s][ks], sf[ks][n], acc[n], 0, 0, 0);
#pragma unroll
            for (int n = 0; n < 2; ++n) { const int row = c0 + 16 * n + l15, col = r0 + 4 * kg; const unsigned long long pkd = pack4u(acc[n]);
                *(LAS unsigned long long*)(Sout + sw16(row, col >> 3) + (col & 4) * 2) = pkd;
                }
            if (VAR != 3) { if (step + PF < 256) R2_LOAD(s, step + PF); }
            if (VAR != 4) asm volatile("s_waitcnt lgkmcnt(0)\n\ts_barrier" ::: "memory");
        }
        if (VAR != 2) { const int nflush = (c + PF < 256) ? PF * 8192 : (PF - 1) * 8192; unsigned char* dst = st + (size_t)(c + 1) * 8192;
          for (int o = tid_ * 16; o < nflush; o += NWAVES * 64 * 16) { const int row_ = (o >> 7) & 63, chk_ = (o >> 4) & 7, slot_ = (c + 1 + (o >> 13)) & 15; *(v4u*)(dst + o) = *(const LAS v4u*)(L + slot_ * 8192 + sw16(row_, chk_)); } }
    }
#undef R2_LOAD
}

__device__ __forceinline__ void rwkv_r2w(Frame& F, const Args& A, unsigned char* stbase) {
    PHASE_IDS();
    if (blockIdx.x >= BATCH * 8) return;
    unsigned char* ws = A.ws;
    LAS unsigned char* HB = F.lds;
    const int ch = blockIdx.x, it = wave_ & 1, cl = lane_ & 31, hh = lane_ >> 5; const bool chain = wave_ < 2;
    const unsigned char* pq = ws + pq_off(ch * 256); unsigned char* st = stbase + (size_t)ch * 256 * 8192;
    for (int i = tid_; i < 512; i += NWAVES * 64) ((v4u*)st)[i] = (v4u){0u, 0u, 0u, 0u};
    f32x16 H[2]; H[0] = f32x16{}; H[1] = f32x16{};
    constexpr int PF = 2;
    bf16x8 pf[PF][8]; v4u qf[PF][4];
#define RW_LOAD(slot, step) do { const unsigned char* p_ = pq + (size_t)(step) * (64 * SHW * 2); \
        _Pragma("unroll") for (int f = 0; f < 8; ++f) pf[slot][f] = *(const bf16x8*)(p_ + (size_t)(f * 64 + lane_) * 16); \
        _Pragma("unroll") for (int jt = 0; jt < 2; ++jt) { const unsigned char* q_ = p_ + 8192 + (size_t)((it * 2 + jt) * 64 + lane_) * 32; qf[slot][2 * jt] = *(const v4u*)q_; qf[slot][2 * jt + 1] = *(const v4u*)(q_ + 16); } } while (0)
    if (chain) {
#pragma unroll
        for (int s = 0; s < PF; ++s) RW_LOAD(s, s); }
    for (int g = 0; g < 64; ++g) {
        LAS unsigned char* hb = HB + (g & 1) * 32768;
        if (chain) {
#pragma unroll
            for (int s = 0; s < 4; ++s) {
                const int step = 4 * g + s; if (step >= 255) break;
                bf16x8 B[2][2];
#pragma unroll
                for (int jt2 = 0; jt2 < 2; ++jt2)
#pragma unroll
                    for (int k = 0; k < 2; ++k) { v4u p_; p_.x = pk2(H[jt2][8 * k], H[jt2][8 * k + 1]); p_.y = pk2(H[jt2][8 * k + 2], H[jt2][8 * k + 3]); p_.z = pk2(H[jt2][8 * k + 4], H[jt2][8 * k + 5]); p_.w = pk2(H[jt2][8 * k + 6], H[jt2][8 * k + 7]); B[jt2][k] = __builtin_bit_cast(bf16x8, p_); }
#pragma unroll
                for (int jt = 0; jt < 2; ++jt) { f32x16 n_;
#pragma unroll
                    for (int e = 0; e < 4; ++e) { const unsigned a_ = qf[s & 1][2 * jt][e], b_ = qf[s & 1][2 * jt + 1][e]; n_[2 * e] = bflo(a_); n_[2 * e + 1] = bfhi(a_); n_[8 + 2 * e] = bflo(b_); n_[8 + 2 * e + 1] = bfhi(b_); }
#pragma unroll
                    for (int jt2 = 0; jt2 < 2; ++jt2)
#pragma unroll
                        for (int k = 0; k < 2; ++k) n_ = __builtin_amdgcn_mfma_f32_32x32x16_bf16(pf[s & 1][(jt * 2 + jt2) * 2 + k], B[jt2][k], n_, 0, 0, 0);
                    H[jt] = n_; }
#pragma unroll
                for (int jt = 0; jt < 2; ++jt)
#pragma unroll
                    for (int q = 0; q < 4; ++q) { const int row = 32 * it + cl, col = 32 * jt + 8 * q + 4 * hh;
                        *(LAS unsigned long long*)(hb + s * 8192 + sw16(row, col >> 3) + (col & 4) * 2) = (unsigned long long)pk2(H[jt][4 * q], H[jt][4 * q + 1]) | ((unsigned long long)pk2(H[jt][4 * q + 2], H[jt][4 * q + 3]) << 32); }
                if (step + PF < 255) RW_LOAD(s & 1, step + PF);
            }
        }
        asm volatile("s_waitcnt lgkmcnt(0)\n\ts_barrier" ::: "memory");
        if (!chain) {
            const int nst = (4 * g + 4 <= 255) ? 4 : 255 - 4 * g; unsigned char* dst = st + (size_t)(4 * g + 1) * 8192; const int ft = tid_ - 128;
            for (int o = ft * 16; o < nst * 8192; o += 384 * 16) { const int row_ = (o >> 7) & 63, chk_ = (o >> 4) & 7; *(v4u*)(dst + o) = *(const LAS v4u*)(hb + (o & ~8191) + sw16(row_, chk_)); }
        }
    }
    asm volatile("s_waitcnt vmcnt(0) lgkmcnt(0)\n\ts_barrier" ::: "memory");
#undef RW_LOAD
}

__device__ __forceinline__ void rwkv_r3(Frame& F, const Args& A) {
    PHASE_IDS();
    unsigned char* ws = A.ws;
    const bf16* VV = (const bf16*)(ws + WS_XN); const bf16* GG = (const bf16*)(ws + WS_F + 32 * MiB); const float* BON = (const float*)(ws + WS_BON);
    bf16* O = (bf16*)(ws + WS_F); const float* lg = A.in[16]; const float* lb = A.in[17];
    LAS float* Yt = (LAS float*)F.lds;
    const int w = wave_, l15 = lane_ & 15, kg = lane_ >> 4, r0 = 16 * (w >> 1), c0 = 32 * (w & 1);
#define R3_BAR() asm volatile("s_waitcnt lgkmcnt(0)\n\ts_barrier" ::: "memory")
    v4u nq, nvw, ngw; bf16x8 na[2], nb[2][2]; float nbon;
    const int pt_ = tid_ >> 3, pi0_ = 8 * (tid_ & 7);
#define R3_LOAD(itx) do { const int ch_ = (itx) >> 8, cc_ = (itx) & 255; const unsigned char* og_ = ws + pq_off(itx); const unsigned char* sg_ = (const unsigned char*)A.out + ST_OFF + (size_t)(itx) * 8192; \
        nq = *(const v4u*)((const unsigned char*)A.out + y0_off(itx, w * 64 + lane_)); \
        _Pragma("unroll") for (int ks = 0; ks < 2; ++ks) { na[ks] = *(const bf16x8*)(og_ + 16384 + (size_t)((r0 + l15) * 64 + 32 * ks + 8 * kg) * 2); \
            _Pragma("unroll") for (int n = 0; n < 2; ++n) nb[ks][n] = *(const bf16x8*)(sg_ + (size_t)((c0 + 16 * n + l15) * 64 + 32 * ks + 8 * kg) * 2); } \
        const size_t m_ = (size_t)(ch_ >> 3) * SEQ + (size_t)cc_ * 64 + pt_; const int col_ = 64 * (ch_ & 7) + pi0_; \
        nvw = *(const v4u*)(VV + m_ * 512 + col_); ngw = *(const v4u*)(GG + m_ * 512 + col_); nbon = BON[m_ * 8 + (ch_ & 7)]; } while (0)
    if ((int)blockIdx.x < CH_ITEMS) R3_LOAD((int)blockIdx.x);
    for (int it = blockIdx.x; it < CH_ITEMS; it += F.G) {
        const int ch = it >> 8, cc = it & 255, b = ch >> 3, h = ch & 7;
        f32x4c acc[2];
        acc[0] = (f32x4c){bflo(nq.x), bfhi(nq.x), bflo(nq.y), bfhi(nq.y)}; acc[1] = (f32x4c){bflo(nq.z), bfhi(nq.z), bflo(nq.w), bfhi(nq.w)};
#pragma unroll
        for (int ks = 0; ks < 2; ++ks)
#pragma unroll
            for (int n = 0; n < 2; ++n) acc[n] = __builtin_amdgcn_mfma_f32_16x16x32_bf16(na[ks], nb[ks][n], acc[n], 0, 0, 0);
        const v4u vw = nvw, gw4 = ngw; const float bon = nbon;
        if (it + F.G < CH_ITEMS) R3_LOAD(it + F.G);
        R3_BAR();
#pragma unroll
        for (int n = 0; n < 2; ++n)
#pragma unroll
            for (int e = 0; e < 4; ++e) Yt[(r0 + 4 * kg + e) * 68 + c0 + 16 * n + l15] = acc[n][e];
        R3_BAR();
        {   const int t = pt_, i0 = pi0_; const size_t m = (size_t)b * SEQ + (size_t)cc * 64 + t; const int col = 64 * h + i0;
            const f32x4 y0 = *(const LAS f32x4*)(Yt + t * 68 + i0), y1 = *(const LAS f32x4*)(Yt + t * 68 + i0 + 4);
            float s = (y0.x + y0.y) + (y0.z + y0.w) + (y1.x + y1.y) + (y1.z + y1.w);
            s += __shfl_xor(s, 1); s += __shfl_xor(s, 2); s += __shfl_xor(s, 4);
            const float mean = s * (1.f / 64.f); const f32x4 d0 = y0 - mean, d1 = y1 - mean;
            float q = (d0.x * d0.x + d0.y * d0.y) + (d0.z * d0.z + d0.w * d0.w) + (d1.x * d1.x + d1.y * d1.y) + (d1.z * d1.z + d1.w * d1.w);
            q += __shfl_xor(q, 1); q += __shfl_xor(q, 2); q += __shfl_xor(q, 4);
            const float rstd = 1.0f / sqrtf(q * (1.f / 64.f) + 64e-5f);
            const f32x4 g0 = *(const f32x4*)(lg + col), g1 = *(const f32x4*)(lg + col + 4), b0 = *(const f32x4*)(lb + col), b1 = *(const f32x4*)(lb + col + 4);
            f32x4 o0 = (d0 * rstd * g0 + b0), o1 = (d1 * rstd * g1 + b1);
            o0.x = (o0.x + bon * bflo(vw.x)) * bflo(gw4.x); o0.y = (o0.y + bon * bfhi(vw.x)) * bfhi(gw4.x); o0.z = (o0.z + bon * bflo(vw.y)) * bflo(gw4.y); o0.w = (o0.w + bon * bfhi(vw.y)) * bfhi(gw4.y);
            o1.x = (o1.x + bon * bflo(vw.z)) * bflo(gw4.z); o1.y = (o1.y + bon * bfhi(vw.z)) * bfhi(gw4.z); o1.z = (o1.z + bon * bflo(vw.w)) * bflo(gw4.w); o1.w = (o1.w + bon * bfhi(vw.w)) * bfhi(gw4.w);
            v4u ow; ow.x = pk2(o0.x, o0.y); ow.y = pk2(o0.z, o0.w); ow.z = pk2(o1.x, o1.y); ow.w = pk2(o1.z, o1.w);
            *(v4u*)(O + m * 512 + col) = ow; }
    }
#undef R3_BAR
#undef R3_LOAD
}

__device__ __forceinline__ void p_norm2_route(Frame& F, const Args& A) {
    PHASE_IDS();
    unsigned char* ws = A.ws;
    constexpr int WROW = 2064;
    LAS unsigned char* WH = F.lds; LAS unsigned char* WL = F.lds + 36 * WROW;
    LAS float* LG = (LAS float*)F.lds;
    LAS int* eid = (LAS int*)(F.lds + 128 * 36 * 4);
    const bf16* x1 = (const bf16*)(ws + WS_X1); const float* g2 = A.in[21]; const float* mod = (const float*)(ws + WS_MOD);
    const float* rgw = A.in[22]; const float* rgb = A.in[23]; const float* rew = A.in[24]; const float* reb = A.in[25];
    bf16* XN2 = (bf16*)(ws + WS_XN); int* route = (int*)(ws + WS_ROUTE); int* blkcnt = (int*)(ws + WS_BLKCNT);
    const int l15 = lane_ & 15, kg = lane_ >> 4;
    for (int blk = blockIdx.x; blk < M / 128; blk += F.G) {
        __syncthreads();
        for (int i = tid_; i < 4096; i += NWAVES * 64) { const float w = rgw[i]; const unsigned hi = f2bf(w); const unsigned lo = f2bf(w - __uint_as_float(hi << 16)); const int off = (i & 3) * WROW + (i >> 2) * 2;
            *(LAS unsigned short*)(WH + off) = (unsigned short)hi; *(LAS unsigned short*)(WL + off) = (unsigned short)lo; }
        for (int i = tid_; i < 32768; i += NWAVES * 64) { const float w = rew[i]; const unsigned hi = f2bf(w); const unsigned lo = f2bf(w - __uint_as_float(hi << 16)); const int off = (4 + (i & 31)) * WROW + (i >> 5) * 2;
            *(LAS unsigned short*)(WH + off) = (unsigned short)hi; *(LAS unsigned short*)(WL + off) = (unsigned short)lo; }
        __syncthreads();
        const int b = blk / (SEQ / 128); const size_t tok = (size_t)blk * 128 + wave_ * 16 + l15;
        const bf16* xrow = x1 + tok * D + 8 * kg; const float* gmp = g2 + 8 * kg; const float* scp = mod + b * 6144 + 4096 + 8 * kg; const float* shp = mod + b * 6144 + 3072 + 8 * kg;
        float ss = 0.f;
#pragma unroll 8
        for (int ks = 0; ks < 32; ++ks) { const v4u xw = *(const v4u*)(xrow + 32 * ks);
#pragma unroll
            for (int e = 0; e < 4; ++e) { const float lo_ = bflo(xw[e]), hi_ = bfhi(xw[e]); ss += lo_ * lo_ + hi_ * hi_; } }
        ss += __shfl_xor(ss, 16); ss += __shfl_xor(ss, 32);
        const float rstd = 1.0f / sqrtf(ss * (1.f / D) + 1e-6f);
        f32x4 acc[3]; acc[0] = f32x4{0.f, 0.f, 0.f, 0.f}; acc[1] = acc[0]; acc[2] = acc[0];
        int wcol[3];
#pragma unroll
        for (int ct = 0; ct < 3; ++ct) { const int col = 16 * ct + l15; wcol[ct] = (col < 36 ? col : 35) * WROW + 16 * kg; }
#pragma unroll 2
        for (int ks = 0; ks < 32; ++ks) {
            float hv[8];
            { const v4u xw = *(const v4u*)(xrow + 32 * ks); const f32x4 a = {bflo(xw.x), bfhi(xw.x), bflo(xw.y), bfhi(xw.y)}, c = {bflo(xw.z), bfhi(xw.z), bflo(xw.w), bfhi(xw.w)};
              const f32x4 g0 = *(const f32x4*)(gmp + 32 * ks), g1 = *(const f32x4*)(gmp + 32 * ks + 4), s0 = *(const f32x4*)(scp + 32 * ks), s1 = *(const f32x4*)(scp + 32 * ks + 4), h0 = *(const f32x4*)(shp + 32 * ks), h1 = *(const f32x4*)(shp + 32 * ks + 4);
              const f32x4 u0 = a * rstd * (g0 * (s0 + 1.0f)) + h0, u1 = c * rstd * (g1 * (s1 + 1.0f)) + h1;
              hv[0] = u0.x; hv[1] = u0.y; hv[2] = u0.z; hv[3] = u0.w; hv[4] = u1.x; hv[5] = u1.y; hv[6] = u1.z; hv[7] = u1.w; }
            unsigned hiw[4], low[4];
#pragma unroll
            for (int e = 0; e < 4; ++e) { const unsigned h0 = f2bf(hv[2 * e]), h1 = f2bf(hv[2 * e + 1]); hiw[e] = h0 | (h1 << 16);
                low[e] = f2bf(hv[2 * e] - __uint_as_float(h0 << 16)) | (f2bf(hv[2 * e + 1] - __uint_as_float(h1 << 16)) << 16); }
            v4u hq; hq.x = hiw[0]; hq.y = hiw[1]; hq.z = hiw[2]; hq.w = hiw[3];
            *(v4u*)(XN2 + tok * D + 32 * ks + 8 * kg) = hq;
            v4u lq; lq.x = low[0]; lq.y = low[1]; lq.z = low[2]; lq.w = low[3];
            const bf16x8 ah = __builtin_bit_cast(bf16x8, hq), al = __builtin_bit_cast(bf16x8, lq);
#pragma unroll
            for (int ct = 0; ct < 3; ++ct) { const bf16x8 bh = *(const LAS bf16x8*)(WH + wcol[ct] + 64 * ks), bl = *(const LAS bf16x8*)(WL + wcol[ct] + 64 * ks);
                acc[ct] = __builtin_amdgcn_mfma_f32_16x16x32_bf16(ah, bh, acc[ct], 0, 0, 0); acc[ct] = __builtin_amdgcn_mfma_f32_16x16x32_bf16(ah, bl, acc[ct], 0, 0, 0); acc[ct] = __builtin_amdgcn_mfma_f32_16x16x32_bf16(al, bh, acc[ct], 0, 0, 0); }
        }
        __syncthreads();
#pragma unroll
        for (int ct = 0; ct < 3; ++ct) { const int col = 16 * ct + l15; if (col < 36) { const float bias = (col < 4) ? rgb[col] : reb[col - 4];
#pragma unroll
            for (int e = 0; e < 4; ++e) LG[(wave_ * 16 + 4 * kg + e) * 36 + col] = acc[ct][e] + bias; } }
        __syncthreads();
        if (tid_ < 128) { const LAS float* lg = LG + tid_ * 36;
            int gi = 0; float gmax = lg[0];
#pragma unroll
            for (int i = 1; i < 4; ++i) if (lg[i] > gmax) { gmax = lg[i]; gi = i; }
            float den = 0.f;
#pragma unroll
            for (int i = 0; i < 4; ++i) den += __expf(lg[i] - gmax);
            const float gp = 1.0f / den;
            float el[8];
#pragma unroll
            for (int i = 0; i < 8; ++i) el[i] = lg[4 + 8 * gi + i];
            int i0 = 0; float m0 = el[0];
#pragma unroll
            for (int i = 1; i < 8; ++i) if (el[i] > m0) { m0 = el[i]; i0 = i; }
            int i1 = -1; float m1 = -INFINITY;
#pragma unroll
            for (int i = 0; i < 8; ++i) if (i != i0 && el[i] > m1) { m1 = el[i]; i1 = i; }
            if (i1 < 0) { i1 = (i0 + 1) & 7; m1 = m0; }
            const float p1 = __expf(m1 - m0), w0 = gp / (1.0f + p1), w1 = gp * p1 / (1.0f + p1);
            int* rt_ = route + ((size_t)blk * 128 + tid_) * 8; rt_[0] = gi * 8 + i0; rt_[1] = gi * 8 + i1; rt_[2] = __float_as_int(w0); rt_[3] = __float_as_int(w1);
            eid[tid_ * 2] = gi * 8 + i0; eid[tid_ * 2 + 1] = gi * 8 + i1; }
        __syncthreads();
        if (tid_ < 256) { const int e = eid[tid_]; int rk = 0; for (int a = 0; a < tid_; ++a) rk += (eid[a] == e) ? 1 : 0; route[((size_t)blk * 128 + (tid_ >> 1)) * 8 + 4 + (tid_ & 1)] = rk; }
        else if (tid_ < 288) { const int e = tid_ - 256; int cn = 0; for (int a = 0; a < 256; ++a) cn += (eid[a] == e) ? 1 : 0; blkcnt[blk * 32 + e] = cn; }
    }
}

__device__ __forceinline__ void conv_experts(Frame& F, const Args& A) {
    PHASE_IDS();
    unsigned char* ws = A.ws; bf16* W13 = (bf16*)(ws + WS_W13); bf16* W2T = (bf16*)(ws + WS_W2T);
    LAS float* scr = (LAS float*)(F.lds + RING_OFF + wave_ * 16384);
    const int gw = F.vcu * NWAVES + wave_, NGW = F.G * NWAVES;
    for (int it = gw; it < 3 * 8192; it += NGW) {
        const int which = it >> 13, r = it & 8191;
        if (which < 2) { const int e = r >> 8, kb = (r >> 4) & 15, nb = r & 15, n0 = 32 * nb;
            transpose_item(A.in[26 + which] + (size_t)e * 1024 * 512, 512, n0, 64 * kb, 1024, W13, (size_t)e * 1024 + (n0 >> 7) * 256 + which * 128 + (n0 & 127), scr, lane_); }
        else { const int e = r >> 8, kb = (r >> 5) & 7, nb = r & 31;
            transpose_item(A.in[28] + (size_t)e * 512 * 1024, 1024, 32 * nb, 64 * kb, 512, W2T, (size_t)e * 1024 + 32 * nb, scr, lane_); }
    }
}

__device__ __forceinline__ void p_slots(Frame& F, const Args& A) {
    PHASE_IDS();
    unsigned char* ws = A.ws;
    LAS int* tile_e = (LAS int*)(F.lds + TILE_OFF); LAS int* base = tile_e + 288; LAS int* tot = base + 32; LAS int* pre = tot + 32; LAS int* ntl = pre + 32; LAS int* part = ntl + 4;
    const int* blkcnt = (const int*)(ws + WS_BLKCNT); int* route = (int*)(ws + WS_ROUTE); int* rowtok = (int*)(ws + WS_ROWTOK);
    { const int e = tid_ & 31, pt = tid_ >> 5; int s = 0; for (int bb = 16 * pt; bb < 16 * pt + 16; ++bb) s += blkcnt[bb * 32 + e]; part[pt * 32 + e] = s; }
    __syncthreads();
    if (tid_ < 32) { int t = 0; for (int p = 0; p < 16; ++p) t += part[p * 32 + tid_]; tot[tid_] = t; }
    __syncthreads();
    if (tid_ == 0) { int run = 0, nt = 0; for (int e = 0; e < 32; ++e) { base[e] = run; const int pad = (tot[e] + 255) >> 8; for (int i = 0; i < pad; ++i) tile_e[nt++] = e; run += pad * 256; } ntl[0] = nt; }
    __syncthreads();
    for (int blk = blockIdx.x; blk < M / 128; blk += F.G) {
        { const int e = tid_ & 31, pt = tid_ >> 5; int s = 0; for (int bb = pt; bb < blk; bb += 16) s += blkcnt[bb * 32 + e]; part[pt * 32 + e] = s; }
        __syncthreads();
        if (tid_ < 32) { int p = 0; for (int q = 0; q < 16; ++q) p += part[q * 32 + tid_]; pre[tid_] = p; }
        __syncthreads();
        if (tid_ < 256) { const size_t tok = (size_t)blk * 128 + (tid_ >> 1); const int k = tid_ & 1; const int e = route[tok * 8 + k], lr = route[tok * 8 + 4 + k];
            const int slot = base[e] + pre[e] + lr; route[tok * 8 + 6 + k] = slot; rowtok[slot] = (int)tok; }
        __syncthreads();
    }
    for (int e = blockIdx.x; e < 32; e += F.G) { const int lo = base[e] + tot[e], hi = base[e] + (((tot[e] + 255) >> 8) << 8); for (int s = lo + tid_; s < hi; s += NWAVES * 64) rowtok[s] = 0; }
}

#ifndef STAGE_UNUSED
#define STAGE 4
#endif
#ifndef PHASES
#define PHASES 0xffff
#endif
#ifndef RWKV_CHUNKED
#define RWKV_CHUNKED 1
#endif

__device__ __forceinline__ void ph_gemm1(Frame& F, const Args& args) { unsigned char* ws = args.ws;
    pg8::Gemm g{(const pg8::bf16_t*)(ws + WS_XN), (const pg8::bf16_t*)(ws + WS_WIN), nullptr, 1024, NIN};
    pg8::StaticOrder S; S.init(M, NIN, F.G, (int)blockIdx.x);
    pg8::EpiIn E{(pg8::bf16_t*)(ws + WS_Q), (pg8::bf16_t*)(ws + WS_K), (pg8::bf16_t*)(ws + WS_V), (pg8::bf16_t*)(ws + WS_PRW), (pg8::bf16_t*)(ws + WS_GATES), ATT_C2};
    pg8::gemm_phase<pg8::EpiIn, pg8::StaticOrder>(F.lds + RING_OFF, g, S, E); }
__device__ __forceinline__ void ph_attn_wrap(unsigned char* lds, Frame& F, const Args& args, size_t out_off, int qslot) { unsigned char* ws = args.ws;
    const attn_body::AttnTensors AT{(const attn_body::bf16*)(ws + WS_Q), (const attn_body::bf16*)(ws + WS_K), (const attn_body::bf16*)(ws + WS_V), (attn_body::bf16*)(ws + out_off), (const float*)(ws + WS_CUM), (const float*)(ws + WS_SEGTOT)};
    attn_body::attn_phase_dyn<8>((char*)lds + RING_OFF, AT, (unsigned*)(F.ctl + CW_QUEUE + 64 * qslot), (const unsigned*)(F.ctl + CW_QKMAX), TAB_OFF, SEGP_OFF); }
__device__ __forceinline__ void ph_gemm2a(Frame& F, const Args& args) { unsigned char* ws = args.ws;
    pg8::Gemm g{(const pg8::bf16_t*)(ws + WS_Q), (const pg8::bf16_t*)(ws + WS_WOF), nullptr, 512, 1024};
    pg8::StaticOrder S; S.init(M, 1024, F.G, (int)blockIdx.x);
    pg8::EpiGate<1> E{(pg8::bf16_t*)(ws + WS_TMP), 1024, (const pg8::bf16_t*)(ws + WS_GATES), 2048, 0};
    pg8::gemm_phase<pg8::EpiGate<1>, pg8::StaticOrder>(F.lds + RING_OFF, g, S, E); }
__device__ __forceinline__ void ph_gemm2b(Frame& F, const Args& args) { unsigned char* ws = args.ws;
    pg8::Gemm g{(const pg8::bf16_t*)(ws + WS_F), (const pg8::bf16_t*)(ws + WS_WOR), nullptr, 512, 1024};
    pg8::StaticOrder S; S.init(M, 1024, F.G, (int)blockIdx.x);
    pg8::EpiGate<2> E{(pg8::bf16_t*)(ws + WS_TMP), 1024, (const pg8::bf16_t*)(ws + WS_GATES), 2048, 1024};
    pg8::gemm_phase<pg8::EpiGate<2>, pg8::StaticOrder>(F.lds + RING_OFF, g, S, E); }
__device__ __forceinline__ void ph_gemm3(Frame& F, const Args& args) { unsigned char* ws = args.ws;
    pg8::Gemm g{(const pg8::bf16_t*)(ws + WS_TMP), (const pg8::bf16_t*)(ws + WS_WO), nullptr, 1024, 1024};
    pg8::StaticOrder S; S.init(M, 1024, F.G, (int)blockIdx.x);
    pg8::EpiRes E{args.in[0], (pg8::bf16_t*)(ws + WS_X1), (const float*)(ws + WS_MOD) + 2048, SEQ, 6144};
    pg8::gemm_phase<pg8::EpiRes, pg8::StaticOrder>(F.lds + RING_OFF, g, S, E); }
__device__ __forceinline__ void ph_moe_up(Frame& F, const Args& args) { unsigned char* ws = args.ws;
    const LAS int* tile_e = (const LAS int*)(F.lds + TILE_OFF); const int ntiles = tile_e[288 + 96];
    LAS int* rows = (LAS int*)(F.lds + TILE_OFF + 4096);
    { const int* rowtok = (const int*)(ws + WS_ROWTOK); int tid_ = threadIdx.x; asm volatile("" : "+v"(tid_));
      for (int i = 0; i < 8; ++i) { const int L = i * F.G + (int)blockIdx.x; if (L >= ntiles * 4) break; if (tid_ < 256) rows[i * 256 + tid_] = rowtok[(L >> 2) * 256 + tid_]; }
      __syncthreads(); }
    pg8::Gemm g{(const pg8::bf16_t*)(ws + WS_XN), (const pg8::bf16_t*)(ws + WS_W13), rows, 1024, 1024};
    pg8::MoeOrder S{ntiles * 4, F.G, (int)blockIdx.x, 2, tile_e};
    pg8::EpiSwiGLU E{(pg8::bf16_t*)(ws + WS_H)};
    pg8::gemm_phase<pg8::EpiSwiGLU, pg8::MoeOrder, true>(F.lds + RING_OFF, g, S, E); }
__device__ __forceinline__ void ph_moe_down(Frame& F, const Args& args) { unsigned char* ws = args.ws;
    const LAS int* tile_e = (const LAS int*)(F.lds + TILE_OFF); const int ntiles = tile_e[288 + 96];
    pg8::Gemm g{(const pg8::bf16_t*)(ws + WS_H), (const pg8::bf16_t*)(ws + WS_W2T), nullptr, 512, 1024};
    pg8::MoeOrder S{ntiles * 4, F.G, (int)blockIdx.x, 2, tile_e};
    pg8::EpiFp8 E{ws + WS_YM, 1024};
    pg8::gemm_phase<pg8::EpiFp8, pg8::MoeOrder>(F.lds + RING_OFF, g, S, E); }

__global__ void __launch_bounds__(NWAVES * 64, 2) fwd_kernel(Args args) {
    extern __shared__ __attribute__((aligned(16))) unsigned char lds[];
    Frame F;
    F.lds = (LAS unsigned char*)lds;
    F.MISC = (volatile LAS unsigned*)(F.lds + MISC_OFF);
    F.tid = threadIdx.x; F.lane = F.tid & 63; F.wave = __builtin_amdgcn_readfirstlane(F.tid >> 6);
    F.G = gridDim.x; { const int bx = blockIdx.x; F.vcu = (F.G % 8 == 0) ? (bx % 8) * (F.G / 8) + bx / 8 : bx; }
    unsigned char* ws = args.ws;
    F.ctl = (gu32*)(ws + WS_CTL);
    for (int u = F.tid; u < (LDS_BYTES - LDSCTL_OFF) / 4; u += NWAVES * 64) ((LAS unsigned*)(F.lds + LDSCTL_OFF))[u] = 0u;
    __syncthreads();
    XcdBarrier bar = xcd_barrier_post((unsigned*)(F.ctl + CW_BAR), F.MISC + 8);
#define GRID_BAR() xcd_barrier(bar)

    p0_prologue(F, args); GRID_BAR();
    p1_norm(F, args); __syncthreads(); p_convert_early(F, args); GRID_BAR();
    p_cumfix(F, args);
    ph_gemm1(F, args); GRID_BAR();
    p_qknorm(F, args, (unsigned*)(F.ctl + CW_QKMAX));
    for (int cb = (int)blockIdx.x; cb < SEQ / 64; cb += F.G)
    for (int half = 0; half < 2; ++half) {
        rwkv_pre<0>(F, args, cb + 256 * half, cb + 256 * half + 1);
        __syncthreads();
        rwkv_r1<0>(F, args, cb + 2048 * half, cb + 2048 * half + 2048, 256);
        __syncthreads();
    }
    GRID_BAR();
    rwkv_r2w(F, args, (unsigned char*)args.out + ST_OFF);
    ph_attn_wrap(lds, F, args, WS_Q, 0); GRID_BAR();
    rwkv_r3(F, args); GRID_BAR();
    ph_gemm2a(F, args);
    ph_gemm2b(F, args); GRID_BAR();
    ph_gemm3(F, args); GRID_BAR();
    p_norm2_route(F, args); GRID_BAR();
    p_slots(F, args); conv_experts(F, args); GRID_BAR();
    ph_moe_up(F, args); GRID_BAR();
    ph_moe_down(F, args); GRID_BAR();
    p_final<1>(F, args, args.out);
}

extern "C" void kernel_launch(void* const* d_in, const int* in_sizes, int n_in, void* d_out, int out_size, void* d_ws, size_t ws_size, hipStream_t stream) {
    static int grid = 0;
    if (grid == 0) {
        if (n_in != 30 || in_sizes[0] != M * D || out_size != M * D || ws_size < WS_END) { fprintf(stderr, "kernel_launch: unexpected shapes (n_in %d, in0 %d, out %d, ws %zu)\n", n_in, n_in > 0 ? in_sizes[0] : -1, out_size, ws_size); grid = -1; return; }
        int dev = 0, cus = 0, per_cu = 0;
        if (hipGetDevice(&dev) != hipSuccess || hipDeviceGetAttribute(&cus, hipDeviceAttributeMultiprocessorCount, dev) != hipSuccess) { grid = -1; return; }
        if (hipFuncSetAttribute((const void*)fwd_kernel, hipFuncAttributeMaxDynamicSharedMemorySize, LDS_BYTES) != hipSuccess) { fprintf(stderr, "kernel_launch: hipFuncSetAttribute failed\n"); grid = -1; return; }
        if (hipOccupancyMaxActiveBlocksPerMultiprocessor(&per_cu, (const void*)fwd_kernel, NWAVES * 64, LDS_BYTES) != hipSuccess || per_cu < 1)
            fprintf(stderr, "kernel_launch: occupancy query reports %d\n", per_cu);
        (void)hipGetLastError();
        grid = cus;
        if (grid > 256) grid = 256;
    }
    if (grid < 0) return;
    if (hipMemsetAsync((char*)d_ws + WS_CTL, 0, CTL_ZERO_BYTES, stream) != hipSuccess) return;
    Args a{};
    for (int i = 0; i < 30; ++i) a.in[i] = (const float*)d_in[i];
    a.out = (float*)d_out; a.ws = (unsigned char*)d_ws;
    hipLaunchKernelGGL(fwd_kernel, dim3(grid), dim3(NWAVES * 64), LDS_BYTES, stream, a);
}
```

```cpp
#include <hip/hip_runtime.h>
#include <hip/hip_bf16.h>
#include <cstdio>
#include <cstdint>
#include <cmath>

namespace pg8 {
#define PG8_LAS __attribute__((address_space(3)))
typedef unsigned short bf16_t;
typedef short bf16x8 __attribute__((ext_vector_type(8)));
typedef float f32x4 __attribute__((ext_vector_type(4)));
typedef unsigned u32x4 __attribute__((ext_vector_type(4)));
typedef unsigned u32x2 __attribute__((ext_vector_type(2)));
constexpr int BM = 256, BK = 64, HALF = 128, HTB = HALF * BK * 2, STAGE_BYTES = 8 * HTB, NXCD = 8, WGM = 8;

__host__ __device__ __forceinline__ int lds_byte(int r, int c) { const int st = (r >> 4) * 2 + (c >> 5), rr = r & 15, cc = c & 31, ob = rr * 64 + cc * 2; return st * 1024 + (ob ^ (((ob >> 9) & 1) << 5)); }
__host__ __device__ __forceinline__ void stage_rc(int b, int& R, int& C) { const int st = b / 1024, sb = b % 1024, swz = sb ^ (((sb >> 9) & 1) << 5); R = (st >> 1) * 16 + swz / 64; C = (st & 1) * 32 + (swz % 64) / 2; }
__host__ __device__ __forceinline__ int perm32(int rho) { const int n = rho >> 4, i = rho & 15; return 8 * (i >> 2) + 4 * n + (i & 3); }

struct Unit { int pm, pn, e; };
struct Gemm { const bf16_t* A; const bf16_t* Bt; const PG8_LAS int* rowlds; int K; int nB; };

struct StaticOrder {
    int nM, nN, nwg, G, c;
    __host__ __device__ void init(int M, int N, int G_, int c_) { nM = M / BM; nN = N / BM; nwg = nM * nN; G = G_; c = c_; }
    __host__ __device__ bool next(int i, Unit& u) const {
        const long L = (long)i * G + c; if (L >= nwg) return false;
        int wgid = (int)L; { const int q = nwg / NXCD, r = nwg % NXCD, xcd = wgid % NXCD, off = wgid / NXCD; wgid = (xcd < r ? xcd * (q + 1) : r * (q + 1) + (xcd - r) * q) + off; }
        const int nig = WGM * nN, gid = wgid / nig, fm = gid * WGM, gsz = (nM - fm) < WGM ? (nM - fm) : WGM;
        u.pm = fm + ((wgid % nig) % gsz); u.pn = (wgid % nig) / gsz; u.e = 0; return true;
    }
};

__device__ __forceinline__ unsigned cvt_pk_bf16(float lo, float hi) { unsigned r; asm volatile("v_cvt_pk_bf16_f32 %0, %1, %2" : "=v"(r) : "v"(lo), "v"(hi)); return r; }
__device__ __forceinline__ float bf_lo(unsigned w) { return __uint_as_float(w << 16); }
__device__ __forceinline__ float bf_hi(unsigned w) { return __uint_as_float(w & 0xffff0000u); }
__device__ __forceinline__ float fsigmoid(float x) { return __builtin_amdgcn_rcpf(1.0f + __builtin_amdgcn_exp2f(-1.4426950408889634f * x)); }

template <class Epi, class Sched, bool GATHER = false>
__device__ __forceinline__ void gemm_phase(PG8_LAS unsigned char* lds, const Gemm g, const Sched& S, const Epi& E) {
    int tid_ = threadIdx.x; asm volatile("" : "+v"(tid_));
    const int tid = tid_, wid = __builtin_amdgcn_readfirstlane(tid >> 6), lane = tid & 63, wr = wid >> 2, wc = wid & 3, fr = lane & 15, fq = lane >> 4;
    const int K = g.K, nt = K / BK;
    int RA[2], CA[2]; unsigned voffA[2], voffB[2];
#pragma unroll
    for (int i = 0; i < 2; ++i) { int R, C; stage_rc(tid * 16 + i * 8192, R, C); const int Rb = Epi::PERM ? ((R & ~31) + perm32(R & 31)) : R;
        RA[i] = R; CA[i] = C; voffA[i] = (unsigned)(R * K + C) * 2u; voffB[i] = (unsigned)(Rb * K + C) * 2u; }
    const size_t tstep = 2 * (size_t)HALF * K * 2;
    const size_t kstep = (size_t)(BK * 2);
    const size_t hstep = (size_t)HALF * K * 2;
    const unsigned ldsw = (unsigned)wid * 1024u;
    const int aoff = lds_byte(wr * 64 + fr, fq * 8), boff = lds_byte(wc * 32 + fr, fq * 8);
#define PG8_SA(b, h) (((b) * 2 + (h)) * HTB)
#define PG8_SB(b, h) ((4 + (b) * 2 + (h)) * HTB)
#define PG8_STAGE(bufoff, gbase, v0, v1) do { \
        __builtin_amdgcn_global_load_lds((const unsigned*)((const char*)(gbase) + (v0)), (PG8_LAS unsigned*)(lds + (bufoff) + ldsw), 16, 0, 0); \
        __builtin_amdgcn_global_load_lds((const unsigned*)((const char*)(gbase) + (v1)), (PG8_LAS unsigned*)(lds + (bufoff) + ldsw + 8192), 16, 0, 0); } while (0)
#define PG8_STAGEB(bufoff, gbase) PG8_STAGE(bufoff, gbase, voffB[0], voffB[1])
#define PG8_STAGEA(bufoff, abase, h, VA) do { if constexpr (GATHER) { PG8_STAGE(bufoff, abase, VA[h][0], VA[h][1]); } else { PG8_STAGE(bufoff, (abase) + (h) * hstep, voffA[0], voffA[1]); } } while (0)
#define PG8_LDA(dst, b, h) do { _Pragma("unroll") for (int m = 0; m < 4; ++m) _Pragma("unroll") for (int k = 0; k < 2; ++k) dst[m][k] = *(const PG8_LAS bf16x8*)(lds + PG8_SA(b, h) + aoff + m * 2048 + k * 1024); } while (0)
#define PG8_LDB(dst, b, h) do { _Pragma("unroll") for (int n = 0; n < 2; ++n) _Pragma("unroll") for (int k = 0; k < 2; ++k) dst[n][k] = *(const PG8_LAS bf16x8*)(lds + PG8_SB(b, h) + boff + n * 2048 + k * 1024); } while (0)
#define PG8_MMA(ai, bj, At, Bt) do { __builtin_amdgcn_s_setprio(1); _Pragma("unroll") for (int m = 0; m < 4; ++m) _Pragma("unroll") for (int n = 0; n < 2; ++n) _Pragma("unroll") for (int k = 0; k < 2; ++k) \
        acc[ai][bj][m][n] = __builtin_amdgcn_mfma_f32_16x16x32_bf16(Bt[n][k], At[m][k], acc[ai][bj][m][n], 0, 0, 0); __builtin_amdgcn_s_setprio(0); } while (0)
#define PG8_WAIT_V(n) asm volatile("s_waitcnt vmcnt(" #n ")" ::: "memory")
#define PG8_WAIT_L(n) asm volatile("s_waitcnt lgkmcnt(" #n ")" ::: "memory")
#define PG8_BAR __builtin_amdgcn_s_barrier()
#define PG8_SCHED __builtin_amdgcn_sched_barrier(0)
#define PG8_AOFF(dst, ord) do { _Pragma("unroll") for (int h_ = 0; h_ < 2; ++h_) _Pragma("unroll") for (int i_ = 0; i_ < 2; ++i_) { \
        const int src_ = g.rowlds[(ord) * BM + h_ * HALF + RA[i_]]; dst[h_][i_] = (unsigned)(src_ * K + CA[i_]) * 2u; } } while (0)
    Unit cur, nxt; int ui = 0;
    if (!S.next(0, cur)) return;
    f32x4 acc[2][2][4][2];
#pragma unroll
    for (int a = 0; a < 2; ++a)
#pragma unroll
        for (int b = 0; b < 2; ++b)
#pragma unroll
            for (int m = 0; m < 4; ++m)
#pragma unroll
                for (int n = 0; n < 2; ++n) acc[a][b][m][n] = (f32x4){0.f, 0.f, 0.f, 0.f};
    bf16x8 At[4][2], B0[2][2], B1[2][2];
    unsigned vA[2][2], nvA[2][2];
    if constexpr (GATHER) { PG8_AOFF(vA, 0); }
    const char* cA = GATHER ? (const char*)g.A : (const char*)g.A + (size_t)cur.pm * tstep;
    const char* cB = (const char*)g.Bt + ((size_t)cur.e * g.nB + (size_t)cur.pn * BM) * K * 2;
    PG8_STAGEB(PG8_SB(0, 0), cB); PG8_STAGEB(PG8_SB(0, 1), cB + hstep); PG8_STAGEA(PG8_SA(0, 0), cA, 0, vA); PG8_STAGEA(PG8_SA(0, 1), cA, 1, vA);
    if (wr == 1) PG8_BAR;
    PG8_WAIT_V(2); PG8_BAR;
    PG8_STAGEB(PG8_SB(1, 0), cB + kstep); PG8_STAGEA(PG8_SA(1, 0), cA + kstep, 0, vA); PG8_STAGEB(PG8_SB(1, 1), cB + hstep + kstep);
    PG8_WAIT_V(6); PG8_BAR;
    for (;;) {
        const bool has_next = S.next(ui + 1, nxt);
        if constexpr (GATHER) { if (has_next) { PG8_AOFF(nvA, ui + 1); } else {
#pragma unroll
            for (int h_ = 0; h_ < 2; ++h_)
#pragma unroll
                for (int i_ = 0; i_ < 2; ++i_) nvA[h_][i_] = vA[h_][i_]; } }
        const char* nA = GATHER ? cA : (has_next ? (const char*)g.A + (size_t)nxt.pm * tstep : cA);
        const char* nB = has_next ? (const char*)g.Bt + ((size_t)nxt.e * g.nB + (size_t)nxt.pn * BM) * K * 2 : cB;
        for (int t = 0; t < nt; t += 2) {
            const bool last = (t == nt - 2);
            const char* a1 = cA + (size_t)(t + 1) * kstep;
            const char* a2 = last ? nA : cA + (size_t)(t + 2) * kstep; const char* b2 = last ? nB : cB + (size_t)(t + 2) * kstep;
            const char* a3 = a2 + kstep; const char* b3 = b2 + kstep;
            unsigned wv[2][2];
            if constexpr (GATHER) { wv[0][0] = last ? nvA[0][0] : vA[0][0]; wv[0][1] = last ? nvA[0][1] : vA[0][1]; wv[1][0] = last ? nvA[1][0] : vA[1][0]; wv[1][1] = last ? nvA[1][1] : vA[1][1]; }
            PG8_LDB(B0, 0, 0); PG8_LDB(B1, 0, 1); PG8_SCHED; PG8_LDA(At, 0, 0); PG8_STAGEA(PG8_SA(1, 1), a1, 1, vA);
            PG8_WAIT_V(8); PG8_WAIT_L(0); PG8_BAR; PG8_MMA(0, 0, At, B0); PG8_MMA(0, 1, At, B1); PG8_BAR; PG8_SCHED;
            PG8_LDA(At, 0, 1); PG8_STAGEB(PG8_SB(0, 0), b2); PG8_STAGEB(PG8_SB(0, 1), b2 + hstep); PG8_STAGEA(PG8_SA(0, 0), a2, 0, wv);
            PG8_WAIT_V(8); PG8_WAIT_L(0); PG8_BAR; PG8_MMA(1, 0, At, B0); PG8_MMA(1, 1, At, B1); PG8_BAR; PG8_SCHED;
            PG8_LDB(B0, 1, 0); PG8_LDB(B1, 1, 1); PG8_SCHED; PG8_LDA(At, 1, 0); PG8_STAGEA(PG8_SA(0, 1), a2, 1, wv);
            PG8_WAIT_V(8); PG8_WAIT_L(0); PG8_BAR; PG8_MMA(0, 0, At, B0); PG8_MMA(0, 1, At, B1); PG8_BAR; PG8_SCHED;
            PG8_LDA(At, 1, 1); PG8_STAGEB(PG8_SB(1, 0), b3); PG8_STAGEB(PG8_SB(1, 1), b3 + hstep); PG8_STAGEA(PG8_SA(1, 0), a3, 0, wv);
            PG8_WAIT_V(8); PG8_WAIT_L(0); PG8_BAR; PG8_MMA(1, 0, At, B0); PG8_MMA(1, 1, At, B1); PG8_BAR; PG8_SCHED;
        }
        if (wr == 0) PG8_BAR;
        E(acc, cur, wr, wc, fr, fq);
        if (!has_next) break;
#pragma unroll
        for (int a = 0; a < 2; ++a)
#pragma unroll
            for (int b = 0; b < 2; ++b)
#pragma unroll
                for (int m = 0; m < 4; ++m)
#pragma unroll
                    for (int n = 0; n < 2; ++n) acc[a][b][m][n] = (f32x4){0.f, 0.f, 0.f, 0.f};
        cur = nxt; cB = nB; cA = nA; ++ui;
        if constexpr (GATHER) {
#pragma unroll
        for (int h_ = 0; h_ < 2; ++h_)
#pragma unroll
            for (int i_ = 0; i_ < 2; ++i_) vA[h_][i_] = nvA[h_][i_]; }
        if (wr == 1) PG8_BAR;
    }
    PG8_WAIT_V(0);
    PG8_BAR;
#undef PG8_SA
#undef PG8_SB
#undef PG8_STAGE
#undef PG8_STAGEB
#undef PG8_STAGEA
#undef PG8_LDA
#undef PG8_LDB
#undef PG8_MMA
#undef PG8_WAIT_V
#undef PG8_WAIT_L
#undef PG8_BAR
#undef PG8_SCHED
#undef PG8_AOFF
}
}

namespace pg8 {
struct EpiIn {
    static constexpr bool PERM = true;
    bf16_t *Q, *Kb, *V, *PRW, *GT; float qscale;
    __device__ __forceinline__ void operator()(const f32x4 (&acc)[2][2][4][2], const Unit& u, int wr, int wc, int fr, int fq) const {
        const int pn = u.pn; bf16_t* base; int ld, colt, mode = 0;
        if (pn < 2) { base = Q; ld = 512; colt = pn * 256; mode = 1; }
        else if (pn < 4) { base = Kb; ld = 512; colt = (pn - 2) * 256; }
        else if (pn < 6) { base = V; ld = 512; colt = (pn - 4) * 256; }
        else if (pn < 13) { base = PRW; ld = 1792; colt = (pn - 6) * 256; }
        else { base = GT; ld = 2048; colt = (pn - 13) * 256; mode = 2; }
        const int row0 = u.pm * BM + wr * 64 + fr, col0 = colt + wc * 32 + 8 * fq;
        const float sc = (mode == 1) ? qscale : 1.0f;
#pragma unroll
        for (int ai = 0; ai < 2; ++ai)
#pragma unroll
            for (int m = 0; m < 4; ++m) { bf16_t* rowp = base + (size_t)(row0 + ai * HALF + m * 16) * ld + col0;
#pragma unroll
                for (int bj = 0; bj < 2; ++bj) { f32x4 v0 = acc[ai][bj][m][0] * sc, v1 = acc[ai][bj][m][1] * sc;
                    if (mode == 2) {
#pragma unroll
                        for (int e = 0; e < 4; ++e) { v0[e] = fsigmoid(v0[e]); v1[e] = fsigmoid(v1[e]); } }
                    u32x4 w; w.x = cvt_pk_bf16(v0[0], v0[1]); w.y = cvt_pk_bf16(v0[2], v0[3]); w.z = cvt_pk_bf16(v1[0], v1[1]); w.w = cvt_pk_bf16(v1[2], v1[3]);
                    *(u32x4*)(rowp + bj * HALF) = w; } }
    }
};
template <int MODE> struct EpiGate {
    static constexpr bool PERM = true;
    bf16_t* O; int ldo; const bf16_t* G; int ldg; int gcol0;
    __device__ __forceinline__ void operator()(const f32x4 (&acc)[2][2][4][2], const Unit& u, int wr, int wc, int fr, int fq) const {
        const int row0 = u.pm * BM + wr * 64 + fr, col0 = u.pn * BM + wc * 32 + 8 * fq;
#pragma unroll
        for (int ai = 0; ai < 2; ++ai)
#pragma unroll
            for (int m = 0; m < 4; ++m) { const size_t row = (size_t)(row0 + ai * HALF + m * 16); bf16_t* rowp = O + row * ldo + col0;
#pragma unroll
                for (int bj = 0; bj < 2; ++bj) { f32x4 v0 = acc[ai][bj][m][0], v1 = acc[ai][bj][m][1];
                    if (MODE >= 1) { const u32x4 gw = *(const u32x4*)(G + row * ldg + gcol0 + col0 + bj * HALF);
                        v0[0] *= bf_lo(gw.x); v0[1] *= bf_hi(gw.x); v0[2] *= bf_lo(gw.y); v0[3] *= bf_hi(gw.y); v1[0] *= bf_lo(gw.z); v1[1] *= bf_hi(gw.z); v1[2] *= bf_lo(gw.w); v1[3] *= bf_hi(gw.w); }
                    if (MODE == 2) { const u32x4 ow = *(const u32x4*)(rowp + bj * HALF);
                        v0[0] += bf_lo(ow.x); v0[1] += bf_hi(ow.x); v0[2] += bf_lo(ow.y); v0[3] += bf_hi(ow.y); v1[0] += bf_lo(ow.z); v1[1] += bf_hi(ow.z); v1[2] += bf_lo(ow.w); v1[3] += bf_hi(ow.w); }
                    u32x4 w; w.x = cvt_pk_bf16(v0[0], v0[1]); w.y = cvt_pk_bf16(v0[2], v0[3]); w.z = cvt_pk_bf16(v1[0], v1[1]); w.w = cvt_pk_bf16(v1[2], v1[3]);
                    *(u32x4*)(rowp + bj * HALF) = w; } }
    }
};
struct EpiRes {
    static constexpr bool PERM = true;
    const float* X; bf16_t* O; const float* gate; int seq; int gstride;
    __device__ __forceinline__ void operator()(const f32x4 (&acc)[2][2][4][2], const Unit& u, int wr, int wc, int fr, int fq) const {
        const int row0 = u.pm * BM + wr * 64 + fr, col0 = u.pn * BM + wc * 32 + 8 * fq;
        const float* gp = gate + (size_t)((u.pm * BM) / seq) * gstride + col0;
        f32x4 gv[2][2];
#pragma unroll
        for (int bj = 0; bj < 2; ++bj)
#pragma unroll
            for (int n = 0; n < 2; ++n) gv[bj][n] = *(const f32x4*)(gp + bj * HALF + n * 4);
#pragma unroll
        for (int ai = 0; ai < 2; ++ai)
#pragma unroll
            for (int m = 0; m < 4; ++m) { const size_t off = (size_t)(row0 + ai * HALF + m * 16) * 1024 + col0;
#pragma unroll
                for (int bj = 0; bj < 2; ++bj) { const f32x4 x0 = *(const f32x4*)(X + off + bj * HALF), x1 = *(const f32x4*)(X + off + bj * HALF + 4);
                    const f32x4 v0 = x0 + gv[bj][0] * acc[ai][bj][m][0], v1 = x1 + gv[bj][1] * acc[ai][bj][m][1];
                    u32x4 w; w.x = cvt_pk_bf16(v0[0], v0[1]); w.y = cvt_pk_bf16(v0[2], v0[3]); w.z = cvt_pk_bf16(v1[0], v1[1]); w.w = cvt_pk_bf16(v1[2], v1[3]);
                    *(u32x4*)(O + off + bj * HALF) = w; } }
    }
};
struct EpiSwiGLU {
    static constexpr bool PERM = true;
    bf16_t* H;
    __device__ __forceinline__ void operator()(const f32x4 (&acc)[2][2][4][2], const Unit& u, int wr, int wc, int fr, int fq) const {
        const int row0 = u.pm * BM + wr * 64 + fr, col0 = u.pn * HALF + wc * 32 + 8 * fq;
#pragma unroll
        for (int ai = 0; ai < 2; ++ai)
#pragma unroll
            for (int m = 0; m < 4; ++m) { bf16_t* rowp = H + (size_t)(row0 + ai * HALF + m * 16) * 512 + col0;
                f32x4 v0, v1;
#pragma unroll
                for (int e = 0; e < 4; ++e) { const float a0 = acc[ai][0][m][0][e], a1 = acc[ai][0][m][1][e];
                    v0[e] = a0 * fsigmoid(a0) * acc[ai][1][m][0][e]; v1[e] = a1 * fsigmoid(a1) * acc[ai][1][m][1][e]; }
                u32x4 w; w.x = cvt_pk_bf16(v0[0], v0[1]); w.y = cvt_pk_bf16(v0[2], v0[3]); w.z = cvt_pk_bf16(v1[0], v1[1]); w.w = cvt_pk_bf16(v1[2], v1[3]);
                *(u32x4*)rowp = w; }
    }
};
struct EpiFp8 {
    static constexpr bool PERM = true;
    unsigned char* O; int ldo;
    __device__ __forceinline__ void operator()(const f32x4 (&acc)[2][2][4][2], const Unit& u, int wr, int wc, int fr, int fq) const {
        const int row0 = u.pm * BM + wr * 64 + fr, col0 = u.pn * BM + wc * 32 + 8 * fq;
#pragma unroll
        for (int ai = 0; ai < 2; ++ai)
#pragma unroll
            for (int m = 0; m < 4; ++m) { unsigned char* rowp = O + (size_t)(row0 + ai * HALF + m * 16) * ldo + col0;
#pragma unroll
                for (int bj = 0; bj < 2; ++bj) { const f32x4 v0 = acc[ai][bj][m][0], v1 = acc[ai][bj][m][1];
                    int lo = __builtin_amdgcn_cvt_pk_fp8_f32(v0[0], v0[1], 0, false); lo = __builtin_amdgcn_cvt_pk_fp8_f32(v0[2], v0[3], lo, true);
                    int hi = __builtin_amdgcn_cvt_pk_fp8_f32(v1[0], v1[1], 0, false); hi = __builtin_amdgcn_cvt_pk_fp8_f32(v1[2], v1[3], hi, true);
                    *(u32x2*)(rowp + bj * HALF) = (u32x2){(unsigned)lo, (unsigned)hi}; } }
    }
};
struct MoeOrder {
    int nunits, G, c, cshift; const PG8_LAS int* tile_e;
    __device__ __forceinline__ bool next(int i, Unit& u) const {
        const int L = i * G + c; if (L >= nunits) return false;
        u.pm = L >> cshift; u.pn = L & ((1 << cshift) - 1); u.e = tile_e[u.pm]; return true;
    }
};
}
#include <hip/hip_bf16.h>
#include <cmath>
namespace attn_body {
using bf16=__hip_bfloat16;
using bf16x8=__attribute__((ext_vector_type(8)))short;
using s16x4=__attribute__((ext_vector_type(4)))short;
using f32x16=__attribute__((ext_vector_type(16)))float;
using u32x4=__attribute__((ext_vector_type(4)))unsigned;
constexpr int BATCH=2,NHEAD=8,SEQ=16384,D=64,DM=NHEAD*D;
constexpr int NW=8,QBLK=32,QB=QBLK*NW,KVBLK=64,NQB=SEQ/QB;
constexpr int ATTN_PITCH=DM, ATTN_UNIT_ROWS=QB;
__device__ __forceinline__ int crow(int r,int hi){return (r&3)+8*(r>>2)+4*hi;}
#define SBAR() __builtin_amdgcn_sched_barrier(0)
__device__ __forceinline__ void cmask(f32x16&p0,f32x16&p1,int jb,int qrel,int hi){
  const float NEG=-INFINITY; int x=qrel-64*jb-4*hi; asm volatile("":"+v"(x));
  #pragma unroll
  for(int r=0;r<16;++r){const int c=(r&3)+8*(r>>2); if(c>x)p0[r]=NEG; if(c+32>x)p1[r]=NEG;}
}

constexpr int NSLOT=3, SLOTB=8192;
constexpr int LDS_K=0, LDS_V=NSLOT*SLOTB, LDS_WS=2*NSLOT*SLOTB, LDS_OST=LDS_WS+NW*64*4, LDS_BYTES=LDS_OST+NW*4096;
constexpr float C2=0.125f*1.4426950408889634f;
__device__ __forceinline__ void glds16(const void*gsrc,unsigned lds_dst){unsigned keep;
  asm volatile("s_mov_b32 %0, m0\n\ts_mov_b32 m0, %2\n\ts_nop 0\n\tglobal_load_lds_dwordx4 %1, off\n\ts_mov_b32 m0, %0":"=&s"(keep):"v"(gsrc),"s"(lds_dst):"memory");}
__device__ __forceinline__ float max3f(float a,float b,float c){float r;asm("v_max3_f32 %0, %1, %2, %3":"=v"(r):"v"(a),"v"(b),"v"(c));return r;}
__device__ __forceinline__ float max2f(float a,float b){float r;asm("v_max_f32_e32 %0, %1, %2":"=v"(r):"v"(a),"v"(b));return r;}
__device__ __forceinline__ float fadd_s(float a,float b){float r;asm("v_add_f32_e32 %0, %1, %2":"=v"(r):"v"(a),"v"(b));return r;}
__device__ __forceinline__ float fsub_s(float a,float b){float r;asm("v_sub_f32_e32 %0, %1, %2":"=v"(r):"v"(a),"v"(b));return r;}
typedef float f32x2_t __attribute__((ext_vector_type(2))); typedef __bf16 bf16x2_t __attribute__((ext_vector_type(2)));
__device__ __forceinline__ unsigned cvtpk_s(float lo,float hi){f32x2_t v={lo,hi};bf16x2_t b=__builtin_convertvector(v,bf16x2_t);return __builtin_bit_cast(unsigned,b);}
#define WAIT_BAR(N) asm volatile("s_waitcnt vmcnt(" #N ") lgkmcnt(0)\n\ts_barrier":::"memory")

__device__ __forceinline__ void qkt(f32x16&p0,f32x16&p1,const char*Kslot,const bf16x8*qr,int r32,int hi){
  const char*kb=Kslot+hi*1024+r32*16;
  #pragma unroll
  for(int d0=0;d0<4;++d0){
    const bf16x8 b0=*reinterpret_cast<const bf16x8*>(kb+d0*2048);
    const bf16x8 b1=*reinterpret_cast<const bf16x8*>(kb+d0*2048+512);
    if(d0==0){p0=__builtin_amdgcn_mfma_f32_32x32x16_bf16(b0,qr[0],p0,0,0,0);p1=__builtin_amdgcn_mfma_f32_32x32x16_bf16(b1,qr[0],p1,0,0,0);}
    else{p0=__builtin_amdgcn_mfma_f32_32x32x16_bf16(b0,qr[d0],p0,0,0,0);p1=__builtin_amdgcn_mfma_f32_32x32x16_bf16(b1,qr[d0],p1,0,0,0);}}
}
typedef __attribute__((address_space(3))) const char* lds_cptr;
typedef short v4i16_t __attribute__((ext_vector_type(4)));
__device__ __forceinline__ void kload8(bf16x8*kf,lds_cptr kp){
  kf[0]=*(const __attribute__((address_space(3))) bf16x8*)(kp);      kf[1]=*(const __attribute__((address_space(3))) bf16x8*)(kp+512);
  kf[2]=*(const __attribute__((address_space(3))) bf16x8*)(kp+2048); kf[3]=*(const __attribute__((address_space(3))) bf16x8*)(kp+2560);
  kf[4]=*(const __attribute__((address_space(3))) bf16x8*)(kp+4096); kf[5]=*(const __attribute__((address_space(3))) bf16x8*)(kp+4608);
  kf[6]=*(const __attribute__((address_space(3))) bf16x8*)(kp+6144); kf[7]=*(const __attribute__((address_space(3))) bf16x8*)(kp+6656);
}
__device__ __forceinline__ void kload2(bf16x8*kf,lds_cptr kp,int j){ kf[2*j]=*(const __attribute__((address_space(3))) bf16x8*)(kp+j*2048); kf[2*j+1]=*(const __attribute__((address_space(3))) bf16x8*)(kp+j*2048+512); }
__device__ __forceinline__ s16x4 vtr(lds_cptr p){ return __builtin_bit_cast(s16x4,__builtin_amdgcn_ds_read_tr16_b64_v4i16((__attribute__((address_space(3))) v4i16_t*)p)); }
__device__ __forceinline__ float rowmax(const f32x16&p0,const f32x16&p1){
  float a=max3f(p0[0],p0[1],p1[0]),b=max3f(p0[2],p0[3],p1[1]);a=max3f(a,p1[2],p1[3]);
  #pragma unroll
  for(int r=4;r<16;r+=4){a=max3f(a,p0[r],p0[r+1]);b=max3f(b,p0[r+2],p0[r+3]);a=max3f(a,p1[r],p1[r+1]);b=max3f(b,p1[r+2],p1[r+3]);}
  const float m=max2f(a,b);
  auto rr=__builtin_amdgcn_permlane32_swap(__float_as_uint(m),__float_as_uint(m),false,false);
  return max2f(__uint_as_float(rr[0]),__uint_as_float(rr[1]));
}
__device__ __forceinline__ void pv(f32x16*o,int vb,bf16x8 pa0,bf16x8 pa1,bf16x8 pa2,bf16x8 pa3){
  #pragma unroll
  for(int d0=0;d0<2;++d0){s16x4 lo[4],hi[4];
    #pragma unroll
    for(int ks=0;ks<4;++ks){
      asm volatile("ds_read_b64_tr_b16 %0,%1 offset:%c2":"=&v"(lo[ks]):"v"(vb),"i"(d0*4096+ks*1024):"memory");
      asm volatile("ds_read_b64_tr_b16 %0,%1 offset:%c2":"=&v"(hi[ks]):"v"(vb),"i"(d0*4096+ks*1024+512):"memory");}
    asm volatile("s_waitcnt lgkmcnt(0)":::"memory");SBAR();
    #define PK(k) (bf16x8){lo[k][0],lo[k][1],lo[k][2],lo[k][3],hi[k][0],hi[k][1],hi[k][2],hi[k][3]}
    o[d0]=__builtin_amdgcn_mfma_f32_32x32x16_bf16(pa0,PK(0),o[d0],0,0,0);
    o[d0]=__builtin_amdgcn_mfma_f32_32x32x16_bf16(pa1,PK(1),o[d0],0,0,0);
    o[d0]=__builtin_amdgcn_mfma_f32_32x32x16_bf16(pa2,PK(2),o[d0],0,0,0);
    o[d0]=__builtin_amdgcn_mfma_f32_32x32x16_bf16(pa3,PK(3),o[d0],0,0,0);
    #undef PK
  }
}

#ifndef ATTN_STORE16
#define ATTN_STORE16(p,v) (*(u32x4*)(p)=(v))
#endif
typedef float f32x4_t __attribute__((ext_vector_type(4)));
#define NBLD(dst,off) dst=*(const __attribute__((address_space(3))) f32x4_t*)(tbn_+(off))
#define NBSUB(P,b,src) do{ P[(b)]=nmn_-src[0]; P[(b)+1]=nmn_-src[1]; P[(b)+2]=nmn_-src[2]; P[(b)+3]=nmn_-src[3]; }while(0)
#define NEXTB(P0,P1,tt) do{ const __attribute__((address_space(3))) float* tb_=tab3+(tt)*64+4*hi; const float nm_=-mhat; \
  _Pragma("unroll") for(int g_=0;g_<4;++g_){ const f32x4_t b0_=*(const __attribute__((address_space(3))) f32x4_t*)(tb_+8*g_); const f32x4_t b1_=*(const __attribute__((address_space(3))) f32x4_t*)(tb_+32+8*g_); \
    _Pragma("unroll") for(int j_=0;j_<4;++j_){ P0[4*g_+j_]=nm_-b0_[j_]; P1[4*g_+j_]=nm_-b1_[j_]; } } }while(0)
template<int THRL> __device__ __forceinline__ void attn_unit(int b,int h,int qb,int t0,const bf16*Q,const bf16*__restrict__ K,const bf16*__restrict__ V,bf16*O,const float*__restrict__ cumT,char*shm,int tab_off,int segp_off,unsigned*qctr){
  const int tid=threadIdx.x,lane=tid&63,r32=lane&31,hi=lane>>5; const int wid=__builtin_amdgcn_readfirstlane(tid>>6);
  const long rowbase=(long)b*SEQ; const int q0=qb*QB;
  const bf16*Qw=Q+(rowbase+q0+wid*QBLK)*DM+h*D;
  const bf16*Kh=K+(rowbase+(long)t0*KVBLK)*DM+h*D,*Vh=V+(rowbase+(long)t0*KVBLK)*DM+h*D;
  const unsigned lds0=(unsigned)(uintptr_t)shm;
  float*wsf=(float*)(shm+LDS_WS)+wid*64;
  const bf16*ksrc=Kh+(long)lane*DM+wid*8;
  const bf16*vsrc=Vh+(long)(16*(wid&3)+(lane>>2))*DM+(wid>>2)*32+(lane&3)*8;
  const unsigned kdst=lds0+LDS_K+wid*1024, vdst=lds0+LDS_V+wid*1024;
  #define DMA_K(t,slot) glds16(ksrc+(long)(t)*KVBLK*DM,(unsigned)__builtin_amdgcn_readfirstlane(kdst+(slot)))
  #define DMA_V(t,slot) glds16(vsrc+(long)(t)*KVBLK*DM,(unsigned)__builtin_amdgcn_readfirstlane(vdst+(slot)))
  const int vb0=(int)(lds0+LDS_V)+((lane>>4)&1)*32+(lane&3)*8+(4*hi+((lane&15)>>2))*64;
  const char*Kbase=shm+LDS_K; bf16x8 kf[8];
  const lds_cptr shm3=(lds_cptr)shm; const lds_cptr kp0=shm3+LDS_K+hi*1024+r32*16; const lds_cptr vp0=shm3+LDS_V+((lane>>4)&1)*32+(lane&3)*8+(4*hi+((lane&15)>>2))*64;
  const int NT=(q0+QB)/KVBLK-t0;
  const __attribute__((address_space(3))) float* tab3=(const __attribute__((address_space(3))) float*)(shm3+tab_off);
  { int tl_=threadIdx.x; asm volatile("":"+v"(tl_));
    float*tabw=(float*)(shm+tab_off); const float L2E=1.4426950408889634f;
    const float*cg=cumT+((long)(b*NHEAD+h))*SEQ; const float cref=cg[q0]*L2E;
    for(int i=tl_;i<NT*KVBLK;i+=NW*64){ const int kv=t0*KVBLK+i; tabw[i]=cg[kv]*L2E-cref; }
    asm volatile("s_waitcnt vmcnt(0) lgkmcnt(0)\n\ts_barrier":::"memory"); }
  DMA_K(0,0);DMA_V(0,0);DMA_K(1,SLOTB);
  bf16x8 qr[4];
  #pragma unroll
  for(int d0=0;d0<4;++d0)qr[d0]=*reinterpret_cast<const bf16x8*>(&Qw[(long)r32*DM+d0*16+hi*8]);
  float mhat=0.f,l_reg=0.f;f32x16 o[2];o[0]=f32x16{};o[1]=f32x16{};
  const int qrel=wid*QBLK+r32;
  #define CMASK(P0,P1,t) do{int jb_=(t)-(NT-4); if(jb_>=0)cmask(P0,P1,jb_,qrel,hi);}while(0)
  bool resc=false;
  #define START(P0,P1) do{ const float rm=rowmax(P0,P1); resc=false; \
    { const float dl=rm; mhat=fadd_s(mhat,dl); \
      _Pragma("unroll") for(int r=0;r<16;++r){P0[r]=fsub_s(P0[r],dl);P1[r]=fsub_s(P1[r],dl);} \
      } \
    _Pragma("unroll") for(int r=0;r<16;++r)P0[r]=__builtin_amdgcn_exp2f(P0[r]); }while(0)
  #define RESC() do{ if(resc){ asm volatile("s_waitcnt lgkmcnt(0)":::"memory"); \
      _Pragma("unroll") for(int d_=0;d_<2;++d_) _Pragma("unroll") for(int r=0;r<16;++r)o[d_][r]*=wsf[crow(r,hi)]; } }while(0)
  f32x16 pA0,pA1,pB0,pB1;
  int sl_prev=0,sl_cur=0,sl_next=SLOTB;
  #define ROT() do{sl_prev=sl_cur;sl_cur=sl_next;sl_next=(sl_next==(NSLOT-1)*SLOTB)?0:sl_next+SLOTB;}while(0)
  DMA_K(2,2*SLOTB);
  WAIT_BAR(3);
  NEXTB(pA0,pA1,0);
  qkt(pA0,pA1,Kbase,qr,r32,hi);asm volatile("s_nop 15\n\ts_nop 7":"+v"(pA0),"+v"(pA1));CMASK(pA0,pA1,0);
  START(pA0,pA1);
  NEXTB(pB0,pB1,1);
  _Pragma("unroll") for(int r=0;r<16;++r)pA1[r]=__builtin_amdgcn_exp2f(pA1[r]);
  WAIT_BAR(0);
  DMA_K(3,0);DMA_V(1,SLOTB);
  ROT();
  kload8(kf,kp0+sl_cur);
  WAIT_BAR(2);
  s16x4 vlo[8],vhi[8]; u32x4 pw0,pw1,pw2,pw3;
  #define PKW(P,B) cvtpk_s(P[B],P[B+1])
  #define PAF(k) __builtin_bit_cast(bf16x8,pw##k)
  #define VFR(i) (bf16x8){vlo[i][0],vlo[i][1],vlo[i][2],vlo[i][3],vhi[i][0],vhi[i][1],vhi[i][2],vhi[i][3]}
  #define PIN(x) asm volatile("":"+v"(x))
  #define MX3(a,b,c) __builtin_fmaxf(__builtin_fmaxf((a),(b)),(c))
  #define GAPA(MF,A0,A1,A2,A3,W0,W1,PW) do{ MF; sacc+=A0; sacc+=A1; sacc+=A2; sacc+=A3; PIN(sacc); W0; W1; PIN(PW); SBAR(); }while(0)
  #define EX(v) __builtin_amdgcn_exp2f(v)
  #define GAPB(MF,X,B) do{ MF; X[B]=EX(X[B]); X[B+1]=EX(X[B+1]); X[B+2]=EX(X[B+2]); X[B+3]=EX(X[B+3]); PIN(X); SBAR(); }while(0)
  #define VRD(i) do{ vlo[i]=vtr(vp_+(((i)>>2)*4096+((i)&3)*1024)); vhi[i]=vtr(vp_+(((i)>>2)*4096+((i)&3)*1024+512)); }while(0)
  #define KRD(G,j) do{ if(G){ kload2(kf,kp0+sl_next,j); SBAR(); } }while(0)
  #define STEP(C0,C1,P0,P1,t,GK,GV,GL) do{ SBAR(); \
    const lds_cptr vp_=vp0+sl_prev; \
    VRD(0); SBAR(); float sacc=(P0[0]+P0[1]); \
    GAPA(C0=__builtin_amdgcn_mfma_f32_32x32x16_bf16(kf[0],qr[0],C0,0,0,0), P0[2],P0[3],P0[4],P0[5],     pw0[0]=PKW(P0,0), pw0[1]=PKW(P0,2), pw0); \
    VRD(4); SBAR(); GAPA(C1=__builtin_amdgcn_mfma_f32_32x32x16_bf16(kf[1],qr[0],C1,0,0,0), P0[6],P0[7],P0[8],P0[9],     pw0[2]=PKW(P0,4), pw0[3]=PKW(P0,6), pw0); \
    VRD(1); SBAR(); GAPA(C0=__builtin_amdgcn_mfma_f32_32x32x16_bf16(kf[2],qr[1],C0,0,0,0),   P0[10],P0[11],P0[12],P0[13], pw1[0]=PKW(P0,8), pw1[1]=PKW(P0,10), pw1); \
    VRD(5); SBAR(); GAPA(C1=__builtin_amdgcn_mfma_f32_32x32x16_bf16(kf[3],qr[1],C1,0,0,0),   P0[14],P0[15],P1[0],P1[1],   pw1[2]=PKW(P0,12),pw1[3]=PKW(P0,14), pw1); \
    VRD(2); SBAR(); GAPA(C0=__builtin_amdgcn_mfma_f32_32x32x16_bf16(kf[4],qr[2],C0,0,0,0),   P1[2],P1[3],P1[4],P1[5],     pw2[0]=PKW(P1,0), pw2[1]=PKW(P1,2), pw2); \
    VRD(6); SBAR(); GAPA(C1=__builtin_amdgcn_mfma_f32_32x32x16_bf16(kf[5],qr[2],C1,0,0,0),   P1[6],P1[7],P1[8],P1[9],     pw2[2]=PKW(P1,4), pw2[3]=PKW(P1,6), pw2); \
    VRD(3); SBAR(); GAPA(C0=__builtin_amdgcn_mfma_f32_32x32x16_bf16(kf[6],qr[3],C0,0,0,0),   P1[10],P1[11],P1[12],P1[13], pw3[0]=PKW(P1,8), pw3[1]=PKW(P1,10), pw3); \
    VRD(7); SBAR(); GAPA(C1=__builtin_amdgcn_mfma_f32_32x32x16_bf16(kf[7],qr[3],C1,0,0,0),   P1[14],P1[15],0.f,0.f,       pw3[2]=PKW(P1,12),pw3[3]=PKW(P1,14), pw3); \
    l_reg+=sacc; \
    if(GK){DMA_K((t)+3,sl_cur);} if(GV){DMA_V((t)+1,sl_next);} \
    CMASK(C0,C1,t); \
    { float a=MX3(C0[0],C0[1],C1[0]),b=MX3(C0[2],C0[3],C1[1]); a=MX3(a,C1[2],C1[3]); \
      _Pragma("unroll") for(int r=4;r<16;r+=4){a=MX3(a,C0[r],C0[r+1]);b=MX3(b,C0[r+2],C0[r+3]);a=MX3(a,C1[r],C1[r+1]);b=MX3(b,C1[r+2],C1[r+3]);} \
      float rm=__builtin_fmaxf(a,b); { auto rr=__builtin_amdgcn_permlane32_swap(__float_as_uint(rm),__float_as_uint(rm),false,false); rm=__builtin_fmaxf(__uint_as_float(rr[0]),__uint_as_float(rr[1])); } \
      resc=false; \
      if(__builtin_expect(__any(rm>(float)THRL),0)){ const float dl=__builtin_fmaxf(rm,0.f); mhat+=dl; \
        _Pragma("unroll") for(int r=0;r<16;++r){C0[r]-=dl;C1[r]-=dl;} \
        const float f=__builtin_amdgcn_exp2f(-dl); l_reg*=f; if(hi==0)wsf[r32]=f; resc=true; } } \
      \
    const __attribute__((address_space(3))) float* tbn_=tab3+((t)+1)*64+4*hi; const float nmn_=-mhat; f32x4_t nbA_,nbB_; \
    SBAR(); \
    if(GL){NBLD(nbA_,0);} GAPB(o[0]=__builtin_amdgcn_mfma_f32_32x32x16_bf16(PAF(0),VFR(0),o[0],0,0,0), C0,0); \
    if(GL){NBLD(nbB_,8); NBSUB(P0,0,nbA_);} GAPB(o[1]=__builtin_amdgcn_mfma_f32_32x32x16_bf16(PAF(0),VFR(4),o[1],0,0,0), C0,4); \
    if(GL){NBLD(nbA_,16); NBSUB(P0,4,nbB_);} KRD(GL,0); GAPB(o[0]=__builtin_amdgcn_mfma_f32_32x32x16_bf16(PAF(1),VFR(1),o[0],0,0,0), C0,8); \
    if(GL){NBLD(nbB_,24); NBSUB(P0,8,nbA_);} KRD(GL,1); GAPB(o[1]=__builtin_amdgcn_mfma_f32_32x32x16_bf16(PAF(1),VFR(5),o[1],0,0,0), C0,12); \
    if(GL){NBLD(nbA_,32); NBSUB(P0,12,nbB_);} KRD(GL,2); GAPB(o[0]=__builtin_amdgcn_mfma_f32_32x32x16_bf16(PAF(2),VFR(2),o[0],0,0,0), C1,0); \
    if(GL){NBLD(nbB_,40); NBSUB(P1,0,nbA_);} KRD(GL,3); GAPB(o[1]=__builtin_amdgcn_mfma_f32_32x32x16_bf16(PAF(2),VFR(6),o[1],0,0,0), C1,4); \
    if(GL){NBLD(nbA_,48); NBSUB(P1,4,nbB_);} GAPB(o[0]=__builtin_amdgcn_mfma_f32_32x32x16_bf16(PAF(3),VFR(3),o[0],0,0,0), C1,8); \
    if(GL){NBLD(nbB_,56); NBSUB(P1,8,nbA_);} GAPB(o[1]=__builtin_amdgcn_mfma_f32_32x32x16_bf16(PAF(3),VFR(7),o[1],0,0,0), C1,12); \
    if(GL){NBSUB(P1,12,nbB_);} \
    }while(0)
  int t=1;
  #undef CMASK
  #define CMASK(P0,P1,t) do{}while(0)
  for(;t+5<NT;t+=2){
    STEP(pB0,pB1,pA0,pA1,t,true,true,true);     WAIT_BAR(2); RESC(); ROT();
    STEP(pA0,pA1,pB0,pB1,t+1,true,true,true);   WAIT_BAR(2); RESC(); ROT();
  }
  #undef CMASK
  #define CMASK(P0,P1,t) do{int jb_=(t)-(NT-4); if(jb_>=0)cmask(P0,P1,jb_,qrel,hi);}while(0)
  #define ENDW(tt) do{ if((tt)+3<NT){WAIT_BAR(2);} else if((tt)+2<NT){WAIT_BAR(1);} else {WAIT_BAR(0);} }while(0)
  for(;t+1<NT;t+=2){
    STEP(pB0,pB1,pA0,pA1,t,(t+3<NT),(t+1<NT),(t+1<NT));       ENDW(t);   RESC(); ROT();
    STEP(pA0,pA1,pB0,pB1,t+1,(t+4<NT),(t+2<NT),(t+2<NT));     ENDW(t+1); RESC(); ROT();
  }
  STEP(pB0,pB1,pA0,pA1,NT-1,false,false,false); RESC();
  { float sacc=pB0[0]+pB0[1]; _Pragma("unroll") for(int r=2;r<16;++r)sacc+=pB0[r]; _Pragma("unroll") for(int r=0;r<16;++r)sacc+=pB1[r]; l_reg+=sacc;
    pw0=(u32x4){PKW(pB0,0),PKW(pB0,2),PKW(pB0,4),PKW(pB0,6)};pw1=(u32x4){PKW(pB0,8),PKW(pB0,10),PKW(pB0,12),PKW(pB0,14)};pw2=(u32x4){PKW(pB1,0),PKW(pB1,2),PKW(pB1,4),PKW(pB1,6)};pw3=(u32x4){PKW(pB1,8),PKW(pB1,10),PKW(pB1,12),PKW(pB1,14)};
    SBAR(); pv(o,vb0+sl_cur,PAF(0),PAF(1),PAF(2),PAF(3)); }
  #undef PKW
  #undef PAF
  #undef VFR
  #undef PIN
  #undef MX3
  #undef GAPA
  #undef GAPB
  #undef EX
  #undef VRD
  #undef KRD
  #undef STEP
  #undef ENDW
  {auto rr=__builtin_amdgcn_permlane32_swap(__float_as_uint(l_reg),__float_as_uint(l_reg),false,false);l_reg=__uint_as_float(rr[0])+__uint_as_float(rr[1]);}
  int un_=0; if(threadIdx.x==0)un_=(int)__hip_atomic_fetch_add(qctr,1u,__ATOMIC_RELAXED,__HIP_MEMORY_SCOPE_AGENT);
  int lane_e=threadIdx.x&63; asm volatile("":"+v"(lane_e));
  const int r32e=lane_e&31,hie=lane_e>>5;
  if(hie==0)wsf[32+r32e]=l_reg;asm volatile("s_waitcnt lgkmcnt(0)":::"memory");
  float rli[16];
  #pragma unroll
  for(int r=0;r<16;++r)rli[r]=__builtin_amdgcn_rcpf(wsf[32+crow(r,hie)]);
  bf16*Ow=O+(rowbase+q0+wid*QBLK)*DM+h*D;
  { bf16*stg=(bf16*)(shm+LDS_OST)+wid*2048;
    #pragma unroll
    for(int r=0;r<16;++r){const int orow=crow(r,hie);
      #pragma unroll
      for(int d0=0;d0<2;++d0)stg[orow*64+d0*32+r32e]=__float2bfloat16(o[d0][r]*rli[r]);}
    asm volatile("s_waitcnt lgkmcnt(0)":::"memory");
    #pragma unroll
    for(int i=0;i<4;++i){const int row=i*8+(lane_e>>3),ch=lane_e&7; const u32x4 v=*(const u32x4*)(stg+row*64+ch*8); ATTN_STORE16(Ow+(long)row*DM+ch*8,v);} }
  if(threadIdx.x==0)*(volatile int*)(shm+segp_off)=un_;
  asm volatile("s_waitcnt lgkmcnt(0)\n\ts_barrier":::"memory");
  #undef DMA_K
  #undef DMA_V
  #undef CMASK
  #undef START
  #undef RESC
  #undef ROT
}
constexpr int ATTN_LDS_BYTES=LDS_BYTES;
struct AttnTensors { const bf16* Q; const bf16* K; const bf16* V; bf16* O; const float* cumT; const float* segtot; };
struct AttnUnit { int bh; int qb; };
struct StaticOrder {
  int vcu;
  __device__ __forceinline__ explicit StaticOrder(int grid,int block):vcu((block%8)*(grid/8)+block/8){}
  __device__ __forceinline__ bool next(int i,AttnUnit&u)const{ if(i>=4||vcu>=256)return false; const int s=vcu&15; u.bh=vcu>>4; u.qb=(i==0)?63-s:(i==1)?32+s:(i==2)?31-s:s; return true; }
  __device__ __forceinline__ void a_ready(const AttnUnit&)const{}
  __device__ __forceinline__ void done(const AttnUnit&)const{}
};
constexpr float PRUNE_THR=20.0f;
template<int THRL=8> __device__ __forceinline__ void attn_phase_dyn(char*lds,const AttnTensors&T,unsigned*ctr,const unsigned*qkmax,int tab_off,int segp_off){
  volatile int*slot=(volatile int*)(lds+segp_off);
  __syncthreads();
  if(threadIdx.x==0)slot[0]=(int)__hip_atomic_fetch_add(ctr,1u,__ATOMIC_RELAXED,__HIP_MEMORY_SCOPE_AGENT);
  __syncthreads();
  for(;;){
    int tid=threadIdx.x; asm volatile("":"+v"(tid));
    const int u=slot[0]; if(u>=BATCH*NHEAD*NQB)break;
    const int bh=u&15, qb=(NQB-1)-(u>>4), b=bh/NHEAD, h=bh%NHEAD, q0=qb*QB;
    const float qm=__uint_as_float(qkmax[bh*2]), km=__uint_as_float(qkmax[bh*2+1]);
    const float L2E=1.4426950408889634f; const float*cg=T.cumT+((long)(b*NHEAD+h))*SEQ;
    const float cgk=cg[(tid<4*qb)?64*tid+63:q0], cg0=cg[q0];
    float dg, qg;
    { const int row=tid>>1, hf=tid&1; const long ro=((long)b*SEQ+q0+row)*DM+h*D+32*hf; const u32x4*qp=(const u32x4*)(T.Q+ro); const u32x4*kp=(const u32x4*)(T.K+ro); float d=0.f, qq=0.f;
      #pragma unroll
      for(int c4=0;c4<4;++c4){ const u32x4 qa=qp[c4], ka=kp[c4];
        #pragma unroll
        for(int e=0;e<4;++e){ const float q0_=__uint_as_float(qa[e]<<16), q1_=__uint_as_float(qa[e]&0xffff0000u); d+=q0_*__uint_as_float(ka[e]<<16)+q1_*__uint_as_float(ka[e]&0xffff0000u); qq+=q0_*q0_+q1_*q1_; } }
      d+=__shfl_xor(d,1); qq+=__shfl_xor(qq,1);
      #pragma unroll
      for(int o=2;o<64;o<<=1){ d=fminf(d,__shfl_xor(d,o)); qq=fmaxf(qq,__shfl_xor(qq,o)); }
      dg=d; qg=qq; }
    float*slotf=(float*)(lds+segp_off)+16;
    if((tid&63)==0){ slotf[tid>>6]=dg; slotf[8+(tid>>6)]=qg; }
    __syncthreads();
    float dmin=slotf[0], qmu=slotf[8];
    #pragma unroll
    for(int w=1;w<NW;++w){ dmin=fminf(dmin,slotf[w]); qmu=fmaxf(qmu,slotf[8+w]); }
    (void)qm;
    const float X=PRUNE_THR+sqrtf(qmu*km)-dmin+1.5f;
    const bool skip=(tid<4*qb)&&((cgk-cg0)*L2E>X);
    const unsigned long long bal=__ballot(skip); if((tid&63)==0)slot[1+(tid>>6)]=__popcll(bal);
    __syncthreads();
    int t0=0;
    #pragma unroll
    for(int w=0;w<NW;++w)t0+=slot[1+w];
    t0&=~1;
    attn_unit<THRL>(b,h,qb,t0,T.Q,T.K,T.V,T.O,T.cumT,lds,tab_off,segp_off,ctr);
  }
}
#undef SBAR
#undef WAIT_BAR
}
#define GAS __attribute__((address_space(1)))
#define LAS __attribute__((address_space(3)))
typedef unsigned short bf16;
typedef unsigned v4u __attribute__((ext_vector_type(4)));
typedef float f32x4 __attribute__((ext_vector_type(4)));
typedef short bf16x8 __attribute__((ext_vector_type(8)));
typedef GAS unsigned gu32;
typedef GAS unsigned long long gu64;
#define RLX_AGENT __ATOMIC_RELAXED, __HIP_MEMORY_SCOPE_AGENT
#define LDS_WAIT() asm volatile("s_waitcnt lgkmcnt(0)" ::: "memory")
#define VM_WAIT() asm volatile("s_waitcnt vmcnt(0)" ::: "memory")
__device__ __forceinline__ unsigned long long rt() { return __builtin_amdgcn_s_memrealtime(); }
typedef float pk_f32x2 __attribute__((ext_vector_type(2))); typedef __bf16 pk_bf16x2 __attribute__((ext_vector_type(2)));
__device__ __forceinline__ unsigned pk2(float lo, float hi) { pk_f32x2 v = {lo, hi}; pk_bf16x2 b = __builtin_convertvector(v, pk_bf16x2); return __builtin_bit_cast(unsigned, b); }
__device__ __forceinline__ unsigned f2bf(float f) { return pk2(f, 0.f) & 0xffffu; }

#define XB_TMO      128
#define XB_XCNT(j)  (256  + 64 * (j))
#define XB_XSUB(j)  (1280 + 64 * (j))
#define XB_XGEN(j)  (2304 + 64 * (j))
#define XB_TOP      3328
#define XB_TOPGEN   3392
#define XCD_BAR_WORDS 3456
#define XB_SPIN_CAP (1u << 18)

__device__ __forceinline__ unsigned xb_ld(unsigned* p)              { return __hip_atomic_load(p, __ATOMIC_RELAXED, __HIP_MEMORY_SCOPE_AGENT); }
__device__ __forceinline__ unsigned xb_add(unsigned* p, unsigned v) { return __hip_atomic_fetch_add(p, v, __ATOMIC_RELAXED, __HIP_MEMORY_SCOPE_AGENT); }
__device__ __forceinline__ unsigned xb_xcc_id() { return (unsigned)__builtin_amdgcn_s_getreg((3 << 11) | 20) & 0xFu; }
#define XB_SPIN(cond, bar) do { unsigned _sp = 0; while (cond) { __builtin_amdgcn_s_sleep(1); \
    if ((++_sp & 255u) == 0u) { if (xb_ld(&(bar)[XB_TMO])) break; if (_sp > XB_SPIN_CAP) { atomicAdd(&(bar)[XB_TMO], 1u); break; } } } } while (0)

struct XcdBarrier {
    unsigned* bar; unsigned x;
    volatile LAS unsigned* st;
};

__device__ __forceinline__ XcdBarrier xcd_barrier_post(unsigned* bar, volatile LAS unsigned* st) {
    XcdBarrier b; b.bar = bar; b.x = xb_xcc_id(); b.st = st;
    if (threadIdx.x == 0) (void)xb_add(&bar[XB_XCNT(b.x)], 1u);
    return b;
}
__device__ __forceinline__ void xcd_barrier_complete(unsigned* bar, unsigned x, unsigned& nloc, unsigned& nx) {
    const unsigned G = gridDim.x * gridDim.y * gridDim.z;
    unsigned sum, cnt, mine, sp = 0u;
    for (;;) {
        sum = 0u; cnt = 0u; mine = 0u;
#pragma unroll
        for (unsigned j = 0; j < 16; ++j) { const unsigned c = xb_ld(&bar[XB_XCNT(j)]); sum += c; cnt += (c > 0u) ? 1u : 0u; mine = (j == x) ? c : mine; }
        if (sum == G) break;
        __builtin_amdgcn_s_sleep(1);
        if ((++sp & 255u) == 0u) { if (xb_ld(&bar[XB_TMO])) break; if (sp > XB_SPIN_CAP) { atomicAdd(&bar[XB_TMO], 1u); break; } }
    }
    nloc = mine > 0u ? mine : 1u; nx = cnt > 0u ? cnt : 1u;
}

__device__ __forceinline__ void xcd_barrier(const XcdBarrier& b) {
    asm volatile("s_waitcnt vmcnt(0)" ::: "memory");
    __syncthreads();
    if (threadIdx.x == 0) {
        unsigned* bar = b.bar;
        __builtin_amdgcn_s_waitcnt(0);
        unsigned nloc = b.st[0], nx = b.st[1];
        if (nloc == 0u) { xcd_barrier_complete(bar, b.x, nloc, nx); b.st[0] = nloc; b.st[1] = nx; }
        const unsigned old = xb_add(&bar[XB_XSUB(b.x)], 1u);
        const unsigned gen = old / nloc;
        if (old + 1u == (gen + 1u) * nloc) {
            __builtin_amdgcn_fence(__ATOMIC_RELEASE, "agent");
            asm volatile("s_waitcnt vmcnt(0)" ::: "memory");
            const unsigned og = xb_add(&bar[XB_TOP], 1u);
            const unsigned tg = og / nx;
            if (og + 1u == (tg + 1u) * nx) xb_add(&bar[XB_TOPGEN], 1u);
            else XB_SPIN(xb_ld(&bar[XB_TOPGEN]) == tg, bar);
            __builtin_amdgcn_fence(__ATOMIC_ACQUIRE, "agent");
            xb_add(&bar[XB_XGEN(b.x)], 1u);
            asm volatile("s_waitcnt vmcnt(0)" ::: "memory");
        } else {
            XB_SPIN(xb_ld(&bar[XB_XGEN(b.x)]) == gen, bar);
            __builtin_amdgcn_fence(__ATOMIC_ACQUIRE, "agent");
            asm volatile("s_waitcnt vmcnt(0)" ::: "memory");
        }
    }
    __syncthreads();
}

constexpr int NWAVES = 8;
constexpr int BATCH = 2, SEQ = 16384, D = 1024, M = BATCH * SEQ;
constexpr int FH = 8, FW = 512, RWW = 512, SHW = 1792, DIN = 5384, NIN = 5376;
constexpr int NE = 32, DE = 512, NROUTE = 36;
constexpr int MAXSLOT = 2 * M + NE * 256;
constexpr int MAXTILE = MAXSLOT / 256;
constexpr float ATT_C2 = 0.125f * 1.4426950408889634f;

constexpr size_t MiB = 1u << 20;
constexpr size_t WS_CTL = 0, CTL_ZERO_BYTES = 1 * MiB;
constexpr size_t WS_MOD = 1 * MiB;
constexpr size_t WS_SEGTOT = 1 * MiB + 64 * 1024;
constexpr size_t WS_BLKCNT = 1 * MiB + 96 * 1024;
constexpr size_t WS_WIN = 2 * MiB;
constexpr size_t WS_WOF = 13 * MiB, WS_WOR = 14 * MiB, WS_WO = 15 * MiB;
constexpr size_t WS_LW2 = 17 * MiB, WS_LA2 = 17 * MiB + 64 * 1024, WS_LG2 = 17 * MiB + 128 * 1024;
constexpr size_t WS_CUM = 18 * MiB;
constexpr size_t WS_ROUTE = 19 * MiB;
constexpr size_t WS_ROWTOK = 20 * MiB;
constexpr size_t WS_BON = 21 * MiB;
constexpr size_t WS_XN = 24 * MiB;
constexpr size_t WS_Q = 88 * MiB, WS_K = 120 * MiB, WS_V = 152 * MiB;
constexpr size_t WS_PRW = 184 * MiB;
constexpr size_t WS_GATES = 296 * MiB;
constexpr size_t WS_F = 424 * MiB;
constexpr size_t WS_END = 512 * MiB;
constexpr size_t WS_Y = WS_K;
constexpr size_t WS_H = WS_Q;
constexpr size_t WS_W13 = WS_PRW, WS_W2T = WS_PRW + 64 * MiB;
constexpr size_t WS_TMP = WS_PRW;
constexpr size_t WS_YM = 280 * MiB;
constexpr size_t WS_X1 = 424 * MiB;
static_assert(WS_YM + (size_t)MAXSLOT * 1024 * 2 <= WS_END, "ws map");
static_assert(WS_H + (size_t)MAXSLOT * 512 * 2 <= WS_PRW, "ws map");
constexpr int CW_TMO = 0, CW_CODE = 1;
constexpr int CW_BAR = 4096;
constexpr int CW_QKMAX = 8192;
constexpr int CW_QUEUE = 8448;
constexpr int CW_DIAG = 8704;

constexpr int RING_OFF = 0, RING_BYTES = 131072;
constexpr int TAB_OFF = 83968;
constexpr int SEGP_OFF = TAB_OFF + 65536;
constexpr int TILE_OFF = 131072;
constexpr int LDSCTL_OFF = SEGP_OFF + 512, MISC_OFF = LDSCTL_OFF + 320;
constexpr int LDS_BYTES = LDSCTL_OFF + 512;
static_assert(attn_body::LDS_BYTES <= TAB_OFF, "attention LDS");


#define PHASE_IDS() int tid_ = threadIdx.x; asm volatile("" : "+v"(tid_)); const int lane_ = tid_ & 63; const int wave_ = __builtin_amdgcn_readfirstlane(tid_ >> 6); (void)lane_; (void)wave_
struct Frame {
    LAS unsigned char* lds;
    volatile LAS unsigned* MISC;
    gu32* ctl;
    int tid, lane, wave;
    int vcu, G;
    const float* const* in;
};
template <int CTRL> __device__ __forceinline__ float dpp_f(float v) { return __int_as_float(__builtin_amdgcn_mov_dpp(__float_as_int(v), CTRL, 0xf, 0xf, true)); }
__device__ __forceinline__ float row_sum16(float v) { v += dpp_f<0xB1>(v); v += dpp_f<0x4E>(v); v += dpp_f<0x141>(v); v += dpp_f<0x140>(v); return v; }
__device__ __forceinline__ float wave_sum(float v) { v = row_sum16(v); v += __shfl_xor(v, 16); v += __shfl_xor(v, 32); return v; }
__device__ __forceinline__ float bflo(unsigned w) { return __uint_as_float(w << 16); }
__device__ __forceinline__ float bfhi(unsigned w) { return __uint_as_float(w & 0xffff0000u); }
__device__ __forceinline__ float sigm(float x) { return 1.0f / (1.0f + __expf(-x)); }

__device__ __forceinline__ void transpose_item(const float* W, int ld, int col, int k0, int K, bf16* WT, size_t drow, LAS float* scr, int lane) {
#pragma unroll 8
    for (int i = 0; i < 32; ++i) { const int kk = 2 * i + (lane >> 5); scr[kk * 33 + (lane & 31)] = W[(size_t)(k0 + kk) * ld + col + (lane & 31)]; }
    LDS_WAIT(); asm volatile("" ::: "memory");
    const int c = lane & 7;
#pragma unroll
    for (int j = 0; j < 4; ++j) { const int n = (lane >> 3) + 8 * j; const LAS float* s = scr + (8 * c) * 33 + n;
        v4u o; o.x = pk2(s[0 * 33], s[1 * 33]); o.y = pk2(s[2 * 33], s[3 * 33]); o.z = pk2(s[4 * 33], s[5 * 33]); o.w = pk2(s[6 * 33], s[7 * 33]);
        *(GAS v4u*)(WT + (drow + n) * K + k0 + 8 * c) = o; }
    LDS_WAIT(); asm volatile("" ::: "memory");
}
__device__ __forceinline__ void conv_seg(Frame& F, const float* W, int ld, int col0, int K, int ncols, bf16* WT, size_t drow0) {
    PHASE_IDS();
    LAS float* scr = (LAS float*)(F.lds + RING_OFF + wave_ * 16384);
    const int gw = F.vcu * NWAVES + wave_, NGW = F.G * NWAVES, nkb = K / 64, nnb = ncols / 32;
    for (int it = gw; it < nkb * nnb; it += NGW) { const int kb = it / nnb, nb = it % nnb; transpose_item(W, ld, col0 + 32 * nb, 64 * kb, K, WT, drow0 + 32 * nb, scr, lane_); }
}

struct Args { const float* in[30]; float* out; unsigned char* ws; };

__device__ __forceinline__ void p0_prologue(Frame& F, const Args& A) {
    PHASE_IDS();
    unsigned char* ws = A.ws;
    if (blockIdx.x < 96) {
        const float* c = A.in[1]; const float* aw = A.in[2]; const float* ab = A.in[3];
        const int col = blockIdx.x * 64 + lane_; float a0 = 0.f, a1 = 0.f;
        const int kbeg = wave_ * 128;
#pragma unroll 8
        for (int k = kbeg; k < kbeg + 128; ++k) { const float wv = aw[(size_t)k * 6144 + col]; const float c0 = c[k], c1 = c[1024 + k];
            a0 += c0 * sigm(c0) * wv; a1 += c1 * sigm(c1) * wv; }
        LAS float* red = (LAS float*)(F.lds + 8 * 16384 - 4096);
        red[(wave_ * 2 + 0) * 64 + lane_] = a0; red[(wave_ * 2 + 1) * 64 + lane_] = a1;
        __syncthreads();
        if (wave_ < 2) { float s = 0.f;
#pragma unroll
            for (int w = 0; w < 8; ++w) s += red[(w * 2 + wave_) * 64 + lane_];
            ((float*)(ws + WS_MOD))[wave_ * 6144 + col] = s + ab[col]; }
        __syncthreads();
    }
}

__device__ __forceinline__ void p_convert_early(Frame& F, const Args& A) {
    unsigned char* ws = A.ws;
    const float* w_in = A.in[5];
    conv_seg(F, w_in, DIN, 0, 1024, 1536, (bf16*)(ws + WS_WIN), 0);
    conv_seg(F, w_in, DIN, 1544, 1024, 1792, (bf16*)(ws + WS_WIN), 1536);
    conv_seg(F, w_in, DIN, 3336, 1024, 2048, (bf16*)(ws + WS_WIN), 3328);
    conv_seg(F, A.in[18], 1024, 0, 512, 1024, (bf16*)(ws + WS_WOF), 0);
    conv_seg(F, A.in[19], 1024, 0, 512, 1024, (bf16*)(ws + WS_WOR), 0);
    conv_seg(F, A.in[20], 1024, 0, 1024, 1024, (bf16*)(ws + WS_WO), 0);
    conv_seg(F, A.in[9], 512, 0, 64, 512, (bf16*)(ws + WS_LW2), 0);
    conv_seg(F, A.in[11], 512, 0, 64, 512, (bf16*)(ws + WS_LA2), 0);
    conv_seg(F, A.in[12], 512, 0, 128, 512, (bf16*)(ws + WS_LG2), 0);
}

__device__ __forceinline__ void p1_norm(Frame& F, const Args& A) {
    PHASE_IDS();
    unsigned char* ws = A.ws;
    LAS float* wf = (LAS float*)(F.lds);
    LAS float* lfl = (LAS float*)(F.lds + 32768);
    LAS float* part = (LAS float*)(F.lds + 32768 + 4096);
    const float* x = A.in[0]; const float* g1 = A.in[4]; const float* w_in = A.in[5]; const float* fb = A.in[6];
    const float* mod = (const float*)(ws + WS_MOD);
    bf16* XN = (bf16*)(ws + WS_XN); float* cumT = (float*)(ws + WS_CUM); float* segtot = (float*)(ws + WS_SEGTOT);
    for (int i = tid_; i < 8192; i += NWAVES * 64) wf[(i & 7) * 1024 + (i >> 3)] = w_in[(size_t)(i >> 3) * DIN + 1536 + (i & 7)];
    __syncthreads();
    for (int blk = blockIdx.x; blk < M / 128; blk += F.G) {
        const int b = blk / (SEQ / 128);
        f32x4 gm[4], sh[4];
#pragma unroll
        for (int j = 0; j < 4; ++j) { const int col = 4 * lane_ + 256 * j; const f32x4 g = *(const f32x4*)(g1 + col), sc = *(const f32x4*)(mod + b * 6144 + 1024 + col);
            gm[j] = g * (sc + 1.0f); sh[j] = *(const f32x4*)(mod + b * 6144 + col); }
        float fbv = fb[((lane_ >> 5) & 1) * 4 + ((lane_ >> 4) & 1) * 2 + ((lane_ >> 3) & 1)];
        f32x4 nv[4];
        { const GAS f32x4* xr0 = (const GAS f32x4*)(x + ((size_t)blk * 128 + wave_ * 16) * D) + lane_;
#pragma unroll
          for (int j = 0; j < 4; ++j) nv[j] = xr0[64 * j]; }
        for (int i = 0; i < 16; ++i) {
            const int tl = wave_ * 16 + i; const size_t tok = (size_t)blk * 128 + tl;
            f32x4 v[4]; float s = 0.f;
#pragma unroll
            for (int j = 0; j < 4; ++j) { v[j] = nv[j]; s += (v[j].x * v[j].x + v[j].y * v[j].y) + (v[j].z * v[j].z + v[j].w * v[j].w); }
            { const GAS f32x4* xr = (const GAS f32x4*)(x + (tok + ((i + 1 < 16) ? 1 : 0)) * D) + lane_;
#pragma unroll
                for (int j = 0; j < 4; ++j) nv[j] = xr[64 * j]; }
            const float rstd = 1.0f / sqrtf(wave_sum(s) * (1.f / D) + 1e-6f);
            GAS unsigned long long* o8 = (GAS unsigned long long*)(XN + tok * D) + lane_;
            float f[8];
#pragma unroll
            for (int hh = 0; hh < 8; ++hh) f[hh] = 0.f;
#pragma unroll
            for (int j = 0; j < 4; ++j) { v[j] = v[j] * rstd * gm[j] + sh[j];
                o8[64 * j] = (unsigned long long)pk2(v[j].x, v[j].y) | ((unsigned long long)pk2(v[j].z, v[j].w) << 32);
#pragma unroll
                for (int hh = 0; hh < 8; ++hh) { const f32x4 w4 = *(const LAS f32x4*)(wf + hh * 1024 + 4 * lane_ + 256 * j); f[hh] += (v[j].x * w4.x + v[j].y * w4.y) + (v[j].z * w4.z + v[j].w * w4.w); } }
            float g4[4], g2v[2], z;
            { const bool up = (lane_ & 32) != 0;
#pragma unroll
              for (int i = 0; i < 4; ++i) { const float keep = up ? f[4 + i] : f[i], send = up ? f[i] : f[4 + i]; g4[i] = keep + __shfl_xor(send, 32); } }
            { const bool up = (lane_ & 16) != 0;
#pragma unroll
              for (int i = 0; i < 2; ++i) { const float keep = up ? g4[2 + i] : g4[i], send = up ? g4[i] : g4[2 + i]; g2v[i] = keep + __shfl_xor(send, 16); } }
            { const bool up = (lane_ & 8) != 0; const float keep = up ? g2v[1] : g2v[0], send = up ? g2v[0] : g2v[1]; z = keep + __shfl_xor(send, 8); }
            z += __shfl_xor(z, 1); z += __shfl_xor(z, 2); z += __shfl_xor(z, 4);
            const int myh = ((lane_ >> 5) & 1) * 4 + ((lane_ >> 4) & 1) * 2 + ((lane_ >> 3) & 1);
            z += fbv;
            const float lf = (z >= 0.f) ? -log1pf(__expf(-z)) : z - log1pf(__expf(z));
            if ((lane_ & 7) == 0) lfl[tl * 8 + myh] = lf;
        }
        __syncthreads();
        const int hh = tid_ & 7, p = tid_ >> 3;
        if (tid_ < 64) { float run = 0.f; for (int i = 0; i < 16; ++i) { run += lfl[(p * 16 + i) * 8 + hh]; lfl[(p * 16 + i) * 8 + hh] = run; } part[p * 8 + hh] = run; }
        __syncthreads();
        if (tid_ < 64) { float off = 0.f; for (int q = 0; q < p; ++q) off += part[q * 8 + hh];
            const int t0 = (blk % (SEQ / 128)) * 128 + p * 16; float* dst = cumT + ((size_t)(b * 8 + hh)) * SEQ + t0;
            for (int i = 0; i < 16; ++i) dst[i] = lfl[(p * 16 + i) * 8 + hh] + off;
            if (p == 7) segtot[blk * 8 + hh] = off + part[7 * 8 + hh]; }
        __syncthreads();
    }
}


__device__ __forceinline__ void p_cumfix(Frame& F, const Args& A) {
    PHASE_IDS();
    unsigned char* ws = A.ws; float* cumT = (float*)(ws + WS_CUM); const float* segtot = (const float*)(ws + WS_SEGTOT);
    LAS float* pre = (LAS float*)(F.lds);
    for (int blk = blockIdx.x; blk < M / 128; blk += F.G) {
        const int b = blk / (SEQ / 128), seg = blk % (SEQ / 128);
        __syncthreads();
        if (tid_ < 64) { const int hh = tid_ & 7, part = tid_ >> 3; float a = 0.f; for (int s = part; s < seg; s += 8) a += segtot[(b * 128 + s) * 8 + hh];
            a += __shfl_xor(a, 8); a += __shfl_xor(a, 16); a += __shfl_xor(a, 32); if (part == 0) pre[hh] = a; }
        __syncthreads();
        for (int i = tid_; i < 8 * 128; i += NWAVES * 64) { const int hh = i >> 7, t = i & 127; cumT[((size_t)(b * 8 + hh)) * SEQ + seg * 128 + t] += pre[hh]; }
    }
}
__device__ __forceinline__ void p_qknorm(Frame& F, const Args& A, unsigned* qkmax) {
    PHASE_IDS();
    unsigned char* ws = A.ws; const bf16* Q = (const bf16*)(ws + WS_Q); const bf16* K = (const bf16*)(ws + WS_K);
    const int gw = F.vcu * NWAVES + wave_, NGW = F.G * NWAVES, hd = lane_ >> 3;
    float mq[2] = {0.f, 0.f}, mk[2] = {0.f, 0.f};
    for (int m = gw; m < M; m += NGW) { const int b = m / SEQ;
        const v4u qw = *(const v4u*)(Q + (size_t)m * 512 + 8 * lane_), kw = *(const v4u*)(K + (size_t)m * 512 + 8 * lane_);
        float sq = 0.f, sk = 0.f;
#pragma unroll
        for (int e = 0; e < 4; ++e) { const float a = bflo(qw[e]), c = bfhi(qw[e]), d = bflo(kw[e]), f = bfhi(kw[e]); sq += a * a + c * c; sk += d * d + f * f; }
        sq += __shfl_xor(sq, 1); sq += __shfl_xor(sq, 2); sq += __shfl_xor(sq, 4); sk += __shfl_xor(sk, 1); sk += __shfl_xor(sk, 2); sk += __shfl_xor(sk, 4);
        if (b == 0) { mq[0] = fmaxf(mq[0], sq); mk[0] = fmaxf(mk[0], sk); } else { mq[1] = fmaxf(mq[1], sq); mk[1] = fmaxf(mk[1], sk); } }
    if ((lane_ & 7) == 0) {
#pragma unroll
        for (int b = 0; b < 2; ++b) { if (mq[b] > 0.f) atomicMax(qkmax + (b * 8 + hd) * 2, __float_as_uint(mq[b])); if (mk[b] > 0.f) atomicMax(qkmax + (b * 8 + hd) * 2 + 1, __float_as_uint(mk[b])); } }
}

template <int WITH_MOE>
__device__ __forceinline__ void p_final(Frame& F, const Args& A, const float* src) {
    PHASE_IDS();
    unsigned char* ws = A.ws; const float* fg = A.in[29]; const float* mod = (const float*)(ws + WS_MOD);
    const int* route = (const int*)(ws + WS_ROUTE); const bf16* Y = (const bf16*)(ws + WS_YM);
    f32x4 fgv[4];
#pragma unroll
    for (int j = 0; j < 4; ++j) fgv[j] = *(const f32x4*)(fg + 4 * lane_ + 256 * j);
    const int gw = F.vcu * NWAVES + wave_, NGW = F.G * NWAVES;
    for (int m = gw; m < M; m += NGW) {
        f32x4 v[4]; float s = 0.f;
        if (WITH_MOE) { const GAS unsigned long long* xb = (const GAS unsigned long long*)((const bf16*)(ws + WS_X1) + (size_t)m * D) + lane_;
#pragma unroll
            for (int j = 0; j < 4; ++j) { const unsigned long long a = xb[64 * j]; const unsigned al = (unsigned)a, ah = (unsigned)(a >> 32); v[j] = (f32x4){bflo(al), bfhi(al), bflo(ah), bfhi(ah)}; } }
        else { const GAS f32x4* xr = (const GAS f32x4*)(src + (size_t)m * D) + lane_;
#pragma unroll
            for (int j = 0; j < 4; ++j) v[j] = xr[64 * j]; }
        if (WITH_MOE) {
            const int b = m / SEQ; const int* rt_ = route + (size_t)m * 8;
            const float w0 = __int_as_float(rt_[2]), w1 = __int_as_float(rt_[3]); const int s0 = rt_[6], s1 = rt_[7];
            const GAS unsigned* y0 = (const GAS unsigned*)((const unsigned char*)Y + (size_t)s0 * D) + lane_; const GAS unsigned* y1 = (const GAS unsigned*)((const unsigned char*)Y + (size_t)s1 * D) + lane_;
#pragma unroll
            for (int j = 0; j < 4; ++j) { const int a = (int)y0[64 * j], c = (int)y1[64 * j]; const f32x4 g2 = *(const f32x4*)(mod + b * 6144 + 5120 + 4 * lane_ + 256 * j);
                f32x4 y; y.x = w0 * __builtin_amdgcn_cvt_f32_fp8(a, 0) + w1 * __builtin_amdgcn_cvt_f32_fp8(c, 0); y.y = w0 * __builtin_amdgcn_cvt_f32_fp8(a, 1) + w1 * __builtin_amdgcn_cvt_f32_fp8(c, 1);
                y.z = w0 * __builtin_amdgcn_cvt_f32_fp8(a, 2) + w1 * __builtin_amdgcn_cvt_f32_fp8(c, 2); y.w = w0 * __builtin_amdgcn_cvt_f32_fp8(a, 3) + w1 * __builtin_amdgcn_cvt_f32_fp8(c, 3);
                v[j] = v[j] + g2 * y; }
        }
#pragma unroll
        for (int j = 0; j < 4; ++j) s += (v[j].x * v[j].x + v[j].y * v[j].y) + (v[j].z * v[j].z + v[j].w * v[j].w);
        float rstd = 1.0f / sqrtf(wave_sum(s) * (1.f / D) + 1e-6f);
        if (WITH_MOE == 2) { if (((const unsigned*)(ws + WS_CTL))[CW_DIAG]) rstd = 0.f; }
        GAS f32x4* o = (GAS f32x4*)(A.out + (size_t)m * D) + lane_;
#pragma unroll
        for (int j = 0; j < 4; ++j) o[64 * j] = v[j] * rstd * fgv[j];
    }
}

typedef float f32x16 __attribute__((ext_vector_type(16)));
typedef unsigned u32x2 __attribute__((ext_vector_type(2)));
__device__ __forceinline__ f32x4 shift4(const bf16* p, bool has_prev, const float* mu) {
    const u32x2 c = *(const u32x2*)p; u32x2 q = *(const u32x2*)(has_prev ? p - SHW : p); if (!has_prev) q = (u32x2){0u, 0u};
    const f32x4 m = *(const f32x4*)mu;
    f32x4 cv = {bflo(c.x), bfhi(c.x), bflo(c.y), bfhi(c.y)}, pv = {bflo(q.x), bfhi(q.x), bflo(q.y), bfhi(q.y)};
    return cv + (pv - cv) * m;
}
__device__ __forceinline__ u32x2 pack4(f32x4 v) { u32x2 r; r.x = pk2(v.x, v.y); r.y = pk2(v.z, v.w); return r; }

__device__ __forceinline__ float fsig(float x) { return __builtin_amdgcn_rcpf(1.0f + __builtin_amdgcn_exp2f(-1.4426950408889634f * x)); }
__device__ __forceinline__ float ftanh(float x) { const float xc = fminf(fmaxf(x, -15.f), 15.f); return 1.0f - 2.0f * __builtin_amdgcn_rcpf(1.0f + __builtin_amdgcn_exp2f(2.8853900817779268f * xc)); }
__device__ __forceinline__ float half_sum32(float v) { v = row_sum16(v); v += __shfl_xor(v, 16); return v; }
__device__ __forceinline__ void shift2(const bf16* p, bool has_prev, const float (&mu)[2], float (&o)[2]) {
    const unsigned c = *(const unsigned*)p; unsigned q = *(const unsigned*)(has_prev ? p - SHW : p); if (!has_prev) q = 0u;
    const float c0 = bflo(c), c1 = bfhi(c); o[0] = c0 + (bflo(q) - c0) * mu[0]; o[1] = c1 + (bfhi(q) - c1) * mu[1];
}
template <int VAR> __device__ __forceinline__ void rwkv_pre(Frame& F, const Args& A, int ci_lo, int ci_hi) {
    PHASE_IDS();
    unsigned char* ws = A.ws;
    const bf16* PRW = (const bf16*)(ws + WS_PRW);
    const float* mu = A.in[7]; const float* w0 = A.in[8]; const float* a0 = A.in[10]; const float* k_k = A.in[13]; const float* k_a = A.in[14]; const float* r_k = A.in[15];
    const bf16* LW2 = (const bf16*)(ws + WS_LW2); const bf16* LA2 = (const bf16*)(ws + WS_LA2); const bf16* LG2 = (const bf16*)(ws + WS_LG2);
    float* LW = (float*)A.out; bf16* R = (bf16*)((unsigned char*)A.out + 64 * MiB); bf16* KP = (bf16*)((unsigned char*)A.out + 96 * MiB);
    bf16* VV = (bf16*)(ws + WS_XN); bf16* AV = (bf16*)(ws + WS_XN + 32 * MiB); bf16* BV = (bf16*)(ws + WS_F); bf16* GG = (bf16*)(ws + WS_F + 32 * MiB);
    float* BON = (float*)(ws + WS_BON);
    LAS bf16* Xw = (LAS bf16*)(F.lds); LAS bf16* Xa = (LAS bf16*)(F.lds + 9216); LAS bf16* Xg = (LAS bf16*)(F.lds + 18432);
    const int h = wave_;
    for (int ci = ci_lo; ci < ci_hi; ci += F.G) {
        __syncthreads();
        {
            int tl_ = threadIdx.x; asm volatile("" : "+v"(tl_));
            const int row = tl_ >> 3, cg = tl_ & 7; const size_t tok = (size_t)ci * 64 + row; const bool hp = (tok % SEQ) != 0;
            const bf16* src = PRW + tok * SHW + 1536 + 32 * cg; const float* mup = mu + 1536 + 32 * cg;
            LAS bf16* dst = (cg < 2) ? (Xw + row * 72 + 32 * cg) : (cg < 4) ? (Xa + row * 72 + 32 * (cg - 2)) : (Xg + row * 136 + 32 * (cg - 4));
#pragma unroll
            for (int q = 0; q < 8; ++q) { f32x4 v = shift4(src + 4 * q, hp, mup + 4 * q);
                if (cg < 2) { v.x = ftanh(v.x); v.y = ftanh(v.y); v.z = ftanh(v.z); v.w = ftanh(v.w); }
                else if (cg >= 4) { v.x = fsig(v.x); v.y = fsig(v.y); v.z = fsig(v.z); v.w = fsig(v.w); }
                *(LAS u32x2*)(dst + 4 * q) = pack4(v); }
        }
        __syncthreads();
        int ln_ = threadIdx.x & 63; asm volatile("" : "+v"(ln_));
        const int c = ln_ & 31, hh = ln_ >> 5, colb = 64 * h + 2 * c;
    float mur[2], muk[2], muv[2], kkc[2], kac[2], rkc[2], a0c[2], w0c[2];
#pragma unroll
    for (int e = 0; e < 2; ++e) { mur[e] = mu[colb + e]; muk[e] = mu[512 + colb + e]; muv[e] = mu[1024 + colb + e]; kkc[e] = k_k[colb + e]; kac[e] = k_a[colb + e]; rkc[e] = r_k[colb + e]; a0c[e] = a0[colb + e]; w0c[e] = w0[colb + e]; }
#pragma unroll 1
        for (int tb = 0; tb < ((VAR == 3) ? 0 : 2); ++tb) {
            f32x16 aa[2], aw[2], ag[2];
            aa[0] = f32x16{}; aa[1] = f32x16{}; aw[0] = f32x16{}; aw[1] = f32x16{}; ag[0] = f32x16{}; ag[1] = f32x16{};
            if (VAR != 4) {
#pragma unroll
            for (int ks = 0; ks < 4; ++ks) { const bf16x8 afr = *(const LAS bf16x8*)(Xa + (32 * tb + c) * 72 + 16 * ks + 8 * hh), wfr = *(const LAS bf16x8*)(Xw + (32 * tb + c) * 72 + 16 * ks + 8 * hh);
#pragma unroll
                for (int jb = 0; jb < 2; ++jb) { const bf16x8 b1 = *(const bf16x8*)(LA2 + (size_t)(colb + jb) * 64 + 16 * ks + 8 * hh), b2 = *(const bf16x8*)(LW2 + (size_t)(colb + jb) * 64 + 16 * ks + 8 * hh);
                    aa[jb] = __builtin_amdgcn_mfma_f32_32x32x16_bf16(afr, b1, aa[jb], 0, 0, 0); aw[jb] = __builtin_amdgcn_mfma_f32_32x32x16_bf16(wfr, b2, aw[jb], 0, 0, 0); } }
#pragma unroll
            for (int ks = 0; ks < 8; ++ks) { const bf16x8 gfr = *(const LAS bf16x8*)(Xg + (32 * tb + c) * 136 + 16 * ks + 8 * hh);
#pragma unroll
                for (int jb = 0; jb < 2; ++jb) { const bf16x8 b3 = *(const bf16x8*)(LG2 + (size_t)(colb + jb) * 128 + 16 * ks + 8 * hh); ag[jb] = __builtin_amdgcn_mfma_f32_32x32x16_bf16(gfr, b3, ag[jb], 0, 0, 0); } }
            }
            unsigned gpk[16], apk[16];
#pragma unroll
            for (int reg = 0; reg < 16; ++reg) { gpk[reg] = pk2(ag[0][reg], ag[1][reg]); apk[reg] = pk2(fsig(a0c[0] + aa[0][reg]), fsig(a0c[1] + aa[1][reg])); }
            unsigned rawc[16][3], rawq[4][3];
#pragma unroll
            for (int reg = 0; reg < 16; ++reg) { const int t = 32 * tb + (reg & 3) + 8 * (reg >> 2) + 4 * hh; const size_t tok = (size_t)ci * 64 + t; const bool hp = (tok % SEQ) != 0;
                const bf16* prow = PRW + tok * SHW + colb; const bf16* pprev = hp ? prow - SHW : prow;
#pragma unroll
                for (int x = 0; x < 3; ++x) { if (VAR == 2) { rawc[reg][x] = 0x3f803f80u + reg; if ((reg & 3) == 0) rawq[reg >> 2][x] = 0x3f803f80u; } else { rawc[reg][x] = *(const unsigned*)(prow + 512 * x); if ((reg & 3) == 0) { const unsigned q = *(const unsigned*)(pprev + 512 * x); rawq[reg >> 2][x] = hp ? q : 0u; } } } }
#pragma unroll
            for (int reg = 0; reg < 16; ++reg) {
                const int t = 32 * tb + (reg & 3) + 8 * (reg >> 2) + 4 * hh; const size_t tok = (size_t)ci * 64 + t;
                unsigned rawp_[3];
#pragma unroll
                for (int x = 0; x < 3; ++x) rawp_[x] = ((reg & 3) == 0) ? rawq[reg >> 2][x] : rawc[(reg + 15) & 15][x];
                float kx[2], rx[2], vx[2];
                { const unsigned cc_ = rawc[reg][0], pp_ = rawp_[0]; const float c0 = bflo(cc_), c1 = bfhi(cc_); rx[0] = c0 + (bflo(pp_) - c0) * mur[0]; rx[1] = c1 + (bfhi(pp_) - c1) * mur[1]; }
                { const unsigned cc_ = rawc[reg][1], pp_ = rawp_[1]; const float c0 = bflo(cc_), c1 = bfhi(cc_); kx[0] = c0 + (bflo(pp_) - c0) * muk[0]; kx[1] = c1 + (bfhi(pp_) - c1) * muk[1]; }
                { const unsigned cc_ = rawc[reg][2], pp_ = rawp_[2]; const float c0 = bflo(cc_), c1 = bfhi(cc_); vx[0] = c0 + (bflo(pp_) - c0) * muv[0]; vx[1] = c1 + (bfhi(pp_) - c1) * muv[1]; }
                const float as0 = bflo(apk[reg]), as1 = bfhi(apk[reg]);
                const float kr0 = kx[0] * kkc[0], kr1 = kx[1] * kkc[1];
                const float ss = half_sum32(kr0 * kr0 + kr1 * kr1); const float inv = __builtin_amdgcn_rsqf(fmaxf(ss, 1e-24f));
                const float kk0 = kr0 * inv, kk1 = kr1 * inv, kp0 = kx[0] * (1.0f + (as0 - 1.0f) * kac[0]), kp1 = kx[1] * (1.0f + (as1 - 1.0f) * kac[1]);
                const float bon = half_sum32(rx[0] * kp0 * rkc[0] + rx[1] * kp1 * rkc[1]);
                float o2[2];
#pragma unroll
                for (int e = 0; e < 2; ++e) { const float z = -(w0c[e] + aw[e][reg]);
                    const float sp = fmaxf(z, 0.f) + 0.6931471805599453f * __builtin_amdgcn_logf(1.0f + __builtin_amdgcn_exp2f(-1.4426950408889634f * fabsf(z))); o2[e] = -__builtin_amdgcn_exp2f(-1.4426950408889634f * (sp + 0.5f)); }
                const unsigned ob = (unsigned)tok * 1024u + (unsigned)colb * 2u;
                if (VAR == 0) {
                *(unsigned*)((unsigned char*)R + ob) = pk2(rx[0], rx[1]); *(unsigned*)((unsigned char*)KP + ob) = pk2(kp0, kp1); *(unsigned*)((unsigned char*)VV + ob) = pk2(vx[0], vx[1]);
                *(unsigned*)((unsigned char*)AV + ob) = pk2(-kk0, -kk1); *(unsigned*)((unsigned char*)BV + ob) = pk2(kk0 * as0, kk1 * as1);
                *(float2*)((unsigned char*)LW + 2u * ob) = make_float2(o2[0], o2[1]); *(unsigned*)((unsigned char*)GG + ob) = gpk[reg];
                if (c == 0) BON[tok * 8 + h] = bon;
                } else { asm volatile("" :: "v"(pk2(rx[0], rx[1])), "v"(pk2(kp0, kp1)), "v"(pk2(vx[0], vx[1])), "v"(pk2(-kk0, -kk1)), "v"(pk2(kk0 * as0, kk1 * as1)), "v"(o2[0]), "v"(o2[1]), "v"(gpk[reg]), "v"(bon), "v"(ob)); }
                if ((reg & 3) == 3) __builtin_amdgcn_sched_barrier(0);
            }
        }
    }
}

__device__ __forceinline__ void rwkv_scan_seq(Frame& F, const Args& A) {
    PHASE_IDS();
    if (blockIdx.x >= BATCH * 8) return;
    unsigned char* ws = A.ws;
    const float* LW = (const float*)A.out; const bf16* R = (const bf16*)((unsigned char*)A.out + 64 * MiB); const bf16* KP = (const bf16*)((unsigned char*)A.out + 96 * MiB);
    const bf16* VV = (const bf16*)(ws + WS_XN); const bf16* AV = (const bf16*)(ws + WS_XN + 32 * MiB); const bf16* BV = (const bf16*)(ws + WS_F);
    float* Y = (float*)(ws + WS_Y);
    const int b = blockIdx.x >> 3, h = blockIdx.x & 7;
    constexpr int STEPB = 896, CH = 16, BUFB = STEPB * CH;
    LAS unsigned char* buf = F.lds;
    const size_t tok0 = (size_t)b * SEQ;
    const bool loader = wave_ >= 4; const int lt = tid_ - 256;
    auto load_chunk = [&](int cidx, int slot) {
        for (int p = lt; p < CH * 56; p += 256) { const int s = p / 56, q = p % 56; const size_t tok = tok0 + (size_t)cidx * CH + s; v4u val;
            if (q < 16) val = *(const v4u*)(LW + tok * 512 + 64 * h + 4 * q);
            else { const int a = (q - 16) >> 3, o8 = (q - 16) & 7; const bf16* src = (a == 0) ? AV : (a == 1) ? BV : (a == 2) ? KP : (a == 3) ? R : VV; val = *(const v4u*)(src + tok * 512 + 64 * h + 8 * o8); }
            *(LAS v4u*)(buf + slot * BUFB + s * STEPB + q * 16) = val; }
    };
    if (loader) load_chunk(0, 0);
    __syncthreads();
    float S[16];
#pragma unroll
    for (int j = 0; j < 16; ++j) S[j] = 0.f;
    const int il = lane_ & 15, jq = lane_ >> 4, irow = 16 * wave_ + il;
    for (int cidx = 0; cidx < SEQ / CH; ++cidx) {
        if (loader) { if (cidx + 1 < SEQ / CH) load_chunk(cidx + 1, (cidx + 1) & 1); }
        else {
            const LAS unsigned char* bb = buf + (cidx & 1) * BUFB;
#pragma unroll 4
            for (int s = 0; s < CH; ++s) { const LAS unsigned char* sp = bb + s * STEPB;
                float w[16], av[16], bv[16], kv[16], rv[16];
#pragma unroll
                for (int q = 0; q < 4; ++q) { const f32x4 l4 = *(const LAS f32x4*)(sp + 64 * jq + 16 * q); w[4 * q] = __expf(l4.x); w[4 * q + 1] = __expf(l4.y); w[4 * q + 2] = __expf(l4.z); w[4 * q + 3] = __expf(l4.w); }
#pragma unroll
                for (int q = 0; q < 2; ++q) { const v4u a4 = *(const LAS v4u*)(sp + 256 + 32 * jq + 16 * q), b4 = *(const LAS v4u*)(sp + 384 + 32 * jq + 16 * q), k4 = *(const LAS v4u*)(sp + 512 + 32 * jq + 16 * q), r4 = *(const LAS v4u*)(sp + 640 + 32 * jq + 16 * q);
#pragma unroll
                    for (int e = 0; e < 4; ++e) { av[8 * q + 2 * e] = bflo(a4[e]); av[8 * q + 2 * e + 1] = bfhi(a4[e]); bv[8 * q + 2 * e] = bflo(b4[e]); bv[8 * q + 2 * e + 1] = bfhi(b4[e]);
                        kv[8 * q + 2 * e] = bflo(k4[e]); kv[8 * q + 2 * e + 1] = bfhi(k4[e]); rv[8 * q + 2 * e] = bflo(r4[e]); rv[8 * q + 2 * e + 1] = bfhi(r4[e]); } }
                const unsigned short vraw = *(const LAS unsigned short*)(sp + 768 + 2 * irow); const float vi = __uint_as_float((unsigned)vraw << 16);
                float sa = 0.f;
#pragma unroll
                for (int j = 0; j < 16; ++j) sa += S[j] * av[j];
                sa += __shfl_xor(sa, 16); sa += __shfl_xor(sa, 32);
                float y = 0.f;
#pragma unroll
                for (int j = 0; j < 16; ++j) { S[j] = S[j] * w[j] + sa * bv[j] + vi * kv[j]; y += S[j] * rv[j]; }
                y += __shfl_xor(y, 16); y += __shfl_xor(y, 32);
                if (jq == 0) Y[(tok0 + (size_t)cidx * CH + s) * 512 + 64 * h + irow] = y;
            }
        }
        __syncthreads();
    }
}

__device__ __forceinline__ void rwkv_post(Frame& F, const Args& A) {
    PHASE_IDS();
    unsigned char* ws = A.ws;
    const float* Y = (const float*)(ws + WS_Y); const bf16* VV = (const bf16*)(ws + WS_XN); const bf16* GG = (const bf16*)(ws + WS_F + 32 * MiB); const float* BON = (const float*)(ws + WS_BON);
    bf16* O = (bf16*)(ws + WS_F);
    const float* lg = A.in[16]; const float* lb = A.in[17];
    const int gw = F.vcu * NWAVES + wave_, NGW = F.G * NWAVES, col = 8 * lane_, hd = lane_ >> 3;
    const f32x4 g0 = *(const f32x4*)(lg + col), g1 = *(const f32x4*)(lg + col + 4), b0 = *(const f32x4*)(lb + col), b1 = *(const f32x4*)(lb + col + 4);
    for (int m = gw; m < M; m += NGW) {
        const f32x4 y0 = *(const f32x4*)(Y + (size_t)m * 512 + col), y1 = *(const f32x4*)(Y + (size_t)m * 512 + col + 4);
        float s = (y0.x + y0.y) + (y0.z + y0.w) + (y1.x + y1.y) + (y1.z + y1.w);
        s += __shfl_xor(s, 1); s += __shfl_xor(s, 2); s += __shfl_xor(s, 4);
        const float mean = s * (1.f / 64.f); const f32x4 d0 = y0 - mean, d1 = y1 - mean;
        float q = (d0.x * d0.x + d0.y * d0.y) + (d0.z * d0.z + d0.w * d0.w) + (d1.x * d1.x + d1.y * d1.y) + (d1.z * d1.z + d1.w * d1.w);
        q += __shfl_xor(q, 1); q += __shfl_xor(q, 2); q += __shfl_xor(q, 4);
        const float rstd = 1.0f / sqrtf(q * (1.f / 64.f) + 64e-5f);
        const float bon = BON[(size_t)m * 8 + hd];
        const v4u vw = *(const v4u*)(VV + (size_t)m * 512 + col), gw4 = *(const v4u*)(GG + (size_t)m * 512 + col);
        f32x4 o0 = (d0 * rstd * g0 + b0), o1 = (d1 * rstd * g1 + b1);
        o0.x = (o0.x + bon * bflo(vw.x)) * bflo(gw4.x); o0.y = (o0.y + bon * bfhi(vw.x)) * bfhi(gw4.x); o0.z = (o0.z + bon * bflo(vw.y)) * bflo(gw4.y); o0.w = (o0.w + bon * bfhi(vw.y)) * bfhi(gw4.y);
        o1.x = (o1.x + bon * bflo(vw.z)) * bflo(gw4.z); o1.y = (o1.y + bon * bfhi(vw.z)) * bfhi(gw4.z); o1.z = (o1.z + bon * bflo(vw.w)) * bflo(gw4.w); o1.w = (o1.w + bon * bfhi(vw.w)) * bfhi(gw4.w);
        v4u ow; ow.x = pk2(o0.x, o0.y); ow.y = pk2(o0.z, o0.w); ow.z = pk2(o1.x, o1.y); ow.w = pk2(o1.z, o1.w);
        *(v4u*)(O + (size_t)m * 512 + col) = ow;
    }
}

__device__ __forceinline__ size_t pq_off(int it) { const int ch = it >> 8, cc = it & 255; return WS_PRW + ((size_t)(ch >> 3) * SEQ + (size_t)cc * 64) * (SHW * 2) + (size_t)(ch & 7) * 24576; }
__device__ __forceinline__ size_t y0_off(int it, int idx) { const int ch = it >> 8, cc = it & 255; return (((size_t)(ch >> 3) * SEQ + (size_t)cc * 64 + (idx >> 4)) * 512 + 64 * (ch & 7)) * 4 + (size_t)(idx & 15) * 16; }
constexpr size_t ST_OFF = 64 * MiB;
constexpr int CH_ITEMS = BATCH * 8 * (SEQ / 64);

__device__ __forceinline__ int sw16(int row, int chunk) { return row * 128 + ((chunk ^ (row & 7)) << 4); }
typedef float f32x4c __attribute__((ext_vector_type(4)));
__device__ __forceinline__ bf16x8 ld_frag(const LAS unsigned char* Mx, int row, int chunk) { return *(const LAS bf16x8*)(Mx + sw16(row, chunk)); }
template <bool SWAP>
__device__ __forceinline__ void mm_tile(const LAS unsigned char* Am, const LAS unsigned char* Bm, int r0, int c0, int l15, int kg, f32x4c (&acc)[2]) {
    bf16x8 a[2], b[2][2];
#pragma unroll
    for (int ks = 0; ks < 2; ++ks) { a[ks] = ld_frag(Am, r0 + l15, 4 * ks + kg);
#pragma unroll
        for (int n = 0; n < 2; ++n) b[ks][n] = ld_frag(Bm, c0 + 16 * n + l15, 4 * ks + kg); }
#pragma unroll
    for (int ks = 0; ks < 2; ++ks)
#pragma unroll
        for (int n = 0; n < 2; ++n)
            acc[n] = SWAP ? __builtin_amdgcn_mfma_f32_16x16x32_bf16(b[ks][n], a[ks], acc[n], 0, 0, 0) : __builtin_amdgcn_mfma_f32_16x16x32_bf16(a[ks], b[ks][n], acc[n], 0, 0, 0);
}
__device__ __forceinline__ unsigned long long pack4u(f32x4c v) { return (unsigned long long)pk2(v[0], v[1]) | ((unsigned long long)pk2(v[2], v[3]) << 32); }
__device__ __forceinline__ void st_nat(LAS unsigned char* O, int r0, int c0, int l15, int kg, const f32x4c (&acc)[2]) {
#pragma unroll
    for (int n = 0; n < 2; ++n) { const int row = r0 + l15, col = c0 + 16 * n + 4 * kg; *(LAS unsigned long long*)(O + sw16(row, col >> 3) + (col & 4) * 2) = pack4u(acc[n]); }
}
__device__ __forceinline__ void st_tr(LAS unsigned char* OT, int r0, int c0, int l15, int kg, const f32x4c (&acc)[2]) {
#pragma unroll
    for (int n = 0; n < 2; ++n)
#pragma unroll
        for (int e = 0; e < 4; ++e) { const int row = r0 + l15, col = c0 + 16 * n + 4 * kg + e; *(LAS unsigned short*)(OT + sw16(col, row >> 3) + (row & 7) * 2) = (unsigned short)f2bf(acc[n][e]); }
}
__device__ __forceinline__ f32x4c ld_nat4(const LAS unsigned char* O, int row, int col) { const unsigned long long w = *(const LAS unsigned long long*)(O + sw16(row, col >> 3) + (col & 4) * 2);
    const unsigned lo = (unsigned)w, hi = (unsigned)(w >> 32); return (f32x4c){bflo(lo), bfhi(lo), bflo(hi), bfhi(hi)}; }

template <int VAR> __device__ __forceinline__ void rwkv_r1(Frame& F, const Args& A, int it_lo, int it_hi, int it_step) {
    PHASE_IDS();
    unsigned char* ws = A.ws;
    const float* LW = (const float*)A.out; const bf16* R = (const bf16*)((unsigned char*)A.out + 64 * MiB); const bf16* KP = (const bf16*)((unsigned char*)A.out + 96 * MiB);
    const bf16* VV = (const bf16*)(ws + WS_XN); const bf16* AV = (const bf16*)(ws + WS_XN + 32 * MiB); const bf16* BV = (const bf16*)(ws + WS_F);
    LAS unsigned char* L = F.lds;
#define MB(i) (L + (i) * 8192)
    LAS float* gCs = (LAS float*)(L + 17 * 8192); LAS float* part = gCs + 64;
    const int w = wave_, j = lane_, l15 = lane_ & 15, kg = lane_ >> 4, r0 = 16 * (w >> 1), c0 = 32 * (w & 1);
#define R1_BAR() asm volatile("s_waitcnt lgkmcnt(0)\n\ts_barrier" ::: "memory")
    float nlw[8]; unsigned short nav[8], nbv[8], nkv[8], nrv[8], nvv[8];
#define R1_LOAD(itx) do { const int ch_ = (itx) >> 8, cc_ = (itx) & 255; const size_t tb_ = (size_t)(ch_ >> 3) * SEQ + (size_t)cc_ * 64 + 8 * w; const int cg_ = 64 * (ch_ & 7) + j; \
        _Pragma("unroll") for (int t = 0; t < 8; ++t) { const size_t o = (tb_ + t) * 512 + cg_; nlw[t] = LW[o]; nav[t] = AV[o]; nbv[t] = BV[o]; nkv[t] = KP[o]; nrv[t] = R[o]; nvv[t] = VV[o]; } } while (0)
    if (it_lo < it_hi) R1_LOAD(it_lo);
    for (int it = it_lo; it < it_hi; it += it_step) {
        R1_BAR();
        {
            float g[8], lw[8], av[8], bv[8], kv[8], rv[8]; unsigned short vraw[8]; float run = 0.f;
#pragma unroll
            for (int t = 0; t < 8; ++t) { lw[t] = nlw[t]; av[t] = __uint_as_float((unsigned)nav[t] << 16); bv[t] = __uint_as_float((unsigned)nbv[t] << 16);
                kv[t] = __uint_as_float((unsigned)nkv[t] << 16); rv[t] = __uint_as_float((unsigned)nrv[t] << 16); vraw[t] = nvv[t]; run += lw[t]; g[t] = run; }
            { const int itn_ = (it + it_step < it_hi) ? it + it_step : it; R1_LOAD(itn_); }
            part[w * 64 + j] = run;
            R1_BAR();
            float pre = 0.f, tot = 0.f;
#pragma unroll
            for (int q = 0; q < 8; ++q) { const float p = part[q * 64 + j]; tot += p; if (q < w) pre += p; }
            if (w == 0) gCs[j] = __expf(tot);
            unsigned short atT[8], bhT[8], khT[8];
#pragma unroll
            for (int t = 0; t < 8; ++t) { const float G = pre + g[t]; const float eg = __expf(G), en = __expf(-G), ea = __expf(G - lw[t]), ec = __expf(tot - G);
                const int row = 8 * w + t; const int off = sw16(row, j >> 3) + (j & 7) * 2;
                const unsigned short at = (unsigned short)f2bf(av[t] * ea);
                *(LAS unsigned short*)(MB(0) + off) = at; atT[t] = at;
                *(LAS unsigned short*)(MB(2) + off) = (unsigned short)f2bf(bv[t] * en);
                *(LAS unsigned short*)(MB(3) + off) = (unsigned short)f2bf(kv[t] * en);
                *(LAS unsigned short*)(MB(4) + off) = (unsigned short)f2bf(rv[t] * eg);
                bhT[t] = (unsigned short)f2bf(bv[t] * ec); khT[t] = (unsigned short)f2bf(kv[t] * ec); }
            v4u x;
            x.x = atT[0] | ((unsigned)atT[1] << 16); x.y = atT[2] | ((unsigned)atT[3] << 16); x.z = atT[4] | ((unsigned)atT[5] << 16); x.w = atT[6] | ((unsigned)atT[7] << 16); *(LAS v4u*)(MB(1) + sw16(j, w)) = x;
            x.x = bhT[0] | ((unsigned)bhT[1] << 16); x.y = bhT[2] | ((unsigned)bhT[3] << 16); x.z = bhT[4] | ((unsigned)bhT[5] << 16); x.w = bhT[6] | ((unsigned)bhT[7] << 16); *(LAS v4u*)(MB(5) + sw16(j, w)) = x;
            x.x = khT[0] | ((unsigned)khT[1] << 16); x.y = khT[2] | ((unsigned)khT[3] << 16); x.z = khT[4] | ((unsigned)khT[5] << 16); x.w = khT[6] | ((unsigned)khT[7] << 16); *(LAS v4u*)(MB(6) + sw16(j, w)) = x;
            x.x = vraw[0] | ((unsigned)vraw[1] << 16); x.y = vraw[2] | ((unsigned)vraw[3] << 16); x.z = vraw[4] | ((unsigned)vraw[5] << 16); x.w = vraw[6] | ((unsigned)vraw[7] << 16); *(LAS v4u*)(MB(7) + sw16(j, w)) = x;
        }
        R1_BAR();
        if (VAR == 1) continue;
        f32x4c acc[2];
        const int trow = r0 + l15;
        {
            acc[0] = f32x4c{}; acc[1] = f32x4c{}; mm_tile<true>(MB(0), MB(2), r0, c0, l15, kg, acc);
#pragma unroll
            for (int n = 0; n < 2; ++n)
#pragma unroll
                for (int e = 0; e < 4; ++e) { const int s = c0 + 16 * n + 4 * kg + e; if (s >= trow) acc[n][e] = 0.f; }
            st_nat(MB(8), r0, c0, l15, kg, acc); st_tr(MB(9), r0, c0, l15, kg, acc);
#pragma unroll
            for (int n = 0; n < 2; ++n)
#pragma unroll
                for (int e = 0; e < 4; ++e) { const int s = c0 + 16 * n + 4 * kg + e; if (s == trow) acc[n][e] = 1.f; }
            st_nat(MB(15), r0, c0, l15, kg, acc);
            acc[0] = f32x4c{}; acc[1] = f32x4c{}; mm_tile<true>(MB(0), MB(3), r0, c0, l15, kg, acc);
#pragma unroll
            for (int n = 0; n < 2; ++n)
#pragma unroll
                for (int e = 0; e < 4; ++e) { const int s = c0 + 16 * n + 4 * kg + e; if (s >= trow) acc[n][e] = 0.f; }
            st_nat(MB(10), r0, c0, l15, kg, acc);
            acc[0] = f32x4c{}; acc[1] = f32x4c{}; mm_tile<true>(MB(4), MB(2), r0, c0, l15, kg, acc);
#pragma unroll
            for (int n = 0; n < 2; ++n)
#pragma unroll
                for (int e = 0; e < 4; ++e) { const int s = c0 + 16 * n + 4 * kg + e; if (s > trow) acc[n][e] = 0.f; }
            st_nat(MB(11), r0, c0, l15, kg, acc);
            acc[0] = f32x4c{}; acc[1] = f32x4c{}; mm_tile<true>(MB(4), MB(3), r0, c0, l15, kg, acc);
#pragma unroll
            for (int n = 0; n < 2; ++n)
#pragma unroll
                for (int e = 0; e < 4; ++e) { const int s = c0 + 16 * n + 4 * kg + e; if (s > trow) acc[n][e] = 0.f; }
            st_nat(MB(12), r0, c0, l15, kg, acc);
        }
        R1_BAR();
        if (VAR == 2) continue;
        acc[0] = f32x4c{}; acc[1] = f32x4c{}; mm_tile<true>(MB(8), MB(9), r0, c0, l15, kg, acc); st_nat(MB(13), r0, c0, l15, kg, acc); st_tr(MB(14), r0, c0, l15, kg, acc);
        acc[0] = f32x4c{}; acc[1] = f32x4c{}; mm_tile<true>(MB(7), MB(10), r0, c0, l15, kg, acc); st_nat(MB(3), r0, c0, l15, kg, acc);
        R1_BAR();
#define SQUARE(xi, xti, xo, xto) do { acc[0] = f32x4c{}; acc[1] = f32x4c{}; mm_tile<true>(MB(xi), MB(xti), r0, c0, l15, kg, acc); st_nat(MB(xo), r0, c0, l15, kg, acc); st_tr(MB(xto), r0, c0, l15, kg, acc); } while (0)
#define MUPD(mi, xti, mo) do { acc[0] = ld_nat4(MB(mi), trow, c0 + 4 * kg); acc[1] = ld_nat4(MB(mi), trow, c0 + 16 + 4 * kg); mm_tile<true>(MB(mi), MB(xti), r0, c0, l15, kg, acc); st_nat(MB(mo), r0, c0, l15, kg, acc); } while (0)
        SQUARE(13, 14, 0, 2); MUPD(15, 14, 16); R1_BAR();
        SQUARE(0, 2, 13, 14); MUPD(16, 2, 15); R1_BAR();
        SQUARE(13, 14, 0, 2); MUPD(15, 14, 16); R1_BAR();
        SQUARE(0, 2, 13, 14); MUPD(16, 2, 15); R1_BAR();
        MUPD(15, 14, 16); R1_BAR();
        acc[0] = f32x4c{}; acc[1] = f32x4c{}; mm_tile<true>(MB(1), MB(16), r0, c0, l15, kg, acc); st_nat(MB(13), r0, c0, l15, kg, acc);
        acc[0] = f32x4c{}; acc[1] = f32x4c{}; mm_tile<true>(MB(3), MB(16), r0, c0, l15, kg, acc); st_nat(MB(14), r0, c0, l15, kg, acc);
        R1_BAR();
        if (VAR == 3) continue;
        unsigned char* og = ws + pq_off(it); unsigned char* oy = (unsigned char*)A.out + y0_off(it, w * 64 + lane_);
        {
            acc[0] = f32x4c{}; acc[1] = f32x4c{}; mm_tile<true>(MB(5), MB(13), r0, c0, l15, kg, acc);
            const float gc = gCs[trow];
#pragma unroll
            for (int n = 0; n < 2; ++n) { const int col = c0 + 16 * n + 4 * kg;
#pragma unroll
                for (int e = 0; e < 4; ++e) if (col + e == trow) acc[n][e] += gc;
                const int jj_ = col & 31, q_ = jj_ & 15; const size_t po_ = ((size_t)((((trow >> 5) * 2 + (col >> 5)) * 2 + (jj_ >> 4)) * 64 + (trow & 31) + 32 * ((q_ >> 2) & 1)) * 16 + (size_t)(4 * (q_ >> 3)) * 2);
                if (VAR == 0) *(unsigned long long*)(og + po_) = pack4u(acc[n]); else asm volatile("" :: "v"(pack4u(acc[n]))); }
            acc[0] = ld_nat4(MB(4), trow, c0 + 4 * kg); acc[1] = ld_nat4(MB(4), trow, c0 + 16 + 4 * kg); mm_tile<true>(MB(11), MB(13), r0, c0, l15, kg, acc);
#pragma unroll
            for (int n = 0; n < 2; ++n) { const int col = c0 + 16 * n + 4 * kg; if (VAR == 0) *(unsigned long long*)(og + 16384 + (size_t)(trow * 64 + col) * 2) = pack4u(acc[n]); else asm volatile("" :: "v"(pack4u(acc[n]))); }
            acc[0] = f32x4c{}; acc[1] = f32x4c{}; mm_tile<false>(MB(5), MB(14), r0, c0, l15, kg, acc); mm_tile<false>(MB(6), MB(7), r0, c0, l15, kg, acc);
#pragma unroll
            for (int n = 0; n < 2; ++n) { const int i_ = c0 + 16 * n + l15, jr_ = r0 + 4 * kg, rr_ = jr_ & 31;
                const size_t qo_ = (size_t)((((i_ >> 5) * 2 + (jr_ >> 5)) * 64 + (i_ & 31) + 32 * ((rr_ >> 2) & 1)) * 32 + (4 * (rr_ >> 3)) * 2);
                if (VAR == 0) *(unsigned long long*)(og + 8192 + qo_) = pack4u(acc[n]); else asm volatile("" :: "v"(pack4u(acc[n]))); }
            acc[0] = f32x4c{}; acc[1] = f32x4c{}; mm_tile<false>(MB(11), MB(14), r0, c0, l15, kg, acc); mm_tile<false>(MB(12), MB(7), r0, c0, l15, kg, acc);
            { v4u q; q.x = pk2(acc[0][0], acc[0][1]); q.y = pk2(acc[0][2], acc[0][3]); q.z = pk2(acc[1][0], acc[1][1]); q.w = pk2(acc[1][2], acc[1][3]); if (VAR == 0) *(v4u*)oy = q; else asm volatile("" :: "v"(q)); }
        }
    }
#undef SQUARE
#undef MUPD
#undef MB
#undef R1_BAR
#undef R1_LOAD
}

template <int VAR> __device__ __forceinline__ void rwkv_r2(Frame& F, const Args& A, unsigned char* stbase) {
    PHASE_IDS();
    if (blockIdx.x >= BATCH * 8) return;
    unsigned char* ws = A.ws;
    LAS unsigned char* L = F.lds;
    const int ch = blockIdx.x, w = wave_, l15 = lane_ & 15, kg = lane_ >> 4, r0 = 16 * (w >> 1), c0 = 32 * (w & 1);
    const unsigned char* pq = ws + pq_off(ch * 256); unsigned char* st = stbase + (size_t)ch * 256 * 8192;
    for (int i = tid_; i < 2048; i += NWAVES * 64) { ((LAS unsigned*)L)[i] = 0u; }
    for (int i = tid_; i < 512; i += NWAVES * 64) ((v4u*)st)[i] = (v4u){0u, 0u, 0u, 0u};
    __syncthreads();
    constexpr int PF = 8;
    bf16x8 pa[PF][2]; v4u qf[PF];
#define R2_LOAD(slot, step) do { const unsigned char* p_ = pq + (size_t)(step) * (64 * SHW * 2); \
        pa[slot][0] = *(const bf16x8*)(p_ + (size_t)((r0 + l15) * 64 + 8 * kg) * 2); pa[slot][1] = *(const bf16x8*)(p_ + (size_t)((r0 + l15) * 64 + 32 + 8 * kg) * 2); \
        qf[slot] = *(const v4u*)(p_ + 8192 + (size_t)(w * 64 + lane_) * 16); } while (0)
#pragma unroll
    for (int s = 0; s < PF; ++s) R2_LOAD(s, s);
    for (int c = 0; c < 256; c += PF) {
#pragma unroll
        for (int s = 0; s < PF; ++s) {
            const int step = c + s; const LAS unsigned char* Sin = L + (step & 15) * 8192; LAS unsigned char* Sout = L + ((step + 1) & 15) * 8192;
            f32x4c acc[2];
            acc[0] = (f32x4c){bflo(qf[s].x), bfhi(qf[s].x), bflo(qf[s].y), bfhi(qf[s].y)}; acc[1] = (f32x4c){bflo(qf[s].z), bfhi(qf[s].z), bflo(qf[s].w), bfhi(qf[s].w)};
            bf16x8 sf[2][2];
#pragma unroll
            for (int ks = 0; ks < 2; ++ks)
#pragma unroll
                for (int n = 0; n < 2; ++n) sf[ks][n] = ld_frag(Sin, c0 + 16 * n + l15, 4 * ks + kg);
#pragma unroll
            for (int ks = 0; ks < 2; ++ks)
#pragma unroll
                for (int n = 0; n < 2; ++n) acc[n] = __builtin_amdgcn_mfma_f32_16x16x32_bf16(pa[s][ks], sf[ks][n], acc[n], 0, 0, 0);
#pragma unroll
            for (int n = 0; n < 2; ++n) { const int row = c0 + 16 * n + l15, col = r0 + 4 * kg; const unsigned long long pkd = pack4u(acc[n]);
                *(LAS unsigned long long*)(Sout + sw16(row, col >> 3) + (col & 4) * 2) = pkd;
                }
            if (VAR != 3) { if (step + PF < 256) R2_LOAD(s, step + PF); }
            if (VAR != 4) asm volatile("s_waitcnt lgkmcnt(0)\n\ts_barrier" ::: "memory");
        }
        if (VAR != 2) { const int nflush = (c + PF < 256) ? PF * 8192 : (PF - 1) * 8192; unsigned char* dst = st + (size_t)(c + 1) * 8192;
          for (int o = tid_ * 16; o < nflush; o += NWAVES * 64 * 16) { const int row_ = (o >> 7) & 63, chk_ = (o >> 4) & 7, slot_ = (c + 1 + (o >> 13)) & 15; *(v4u*)(dst + o) = *(const LAS v4u*)(L + slot_ * 8192 + sw16(row_, chk_)); } }
    }
#undef R2_LOAD
}

__device__ __forceinline__ void rwkv_r2w(Frame& F, const Args& A, unsigned char* stbase) {
    PHASE_IDS();
    if (blockIdx.x >= BATCH * 8) return;
    unsigned char* ws = A.ws;
    LAS unsigned char* HB = F.lds;
    const int ch = blockIdx.x, it = wave_ & 1, cl = lane_ & 31, hh = lane_ >> 5; const bool chain = wave_ < 2;
    const unsigned char* pq = ws + pq_off(ch * 256); unsigned char* st = stbase + (size_t)ch * 256 * 8192;
    for (int i = tid_; i < 512; i += NWAVES * 64) ((v4u*)st)[i] = (v4u){0u, 0u, 0u, 0u};
    f32x16 H[2]; H[0] = f32x16{}; H[1] = f32x16{};
    constexpr int PF = 2;
    bf16x8 pf[PF][8]; v4u qf[PF][4];
#define RW_LOAD(slot, step) do { const unsigned char* p_ = pq + (size_t)(step) * (64 * SHW * 2); \
        _Pragma("unroll") for (int f = 0; f < 8; ++f) pf[slot][f] = *(const bf16x8*)(p_ + (size_t)(f * 64 + lane_) * 16); \
        _Pragma("unroll") for (int jt = 0; jt < 2; ++jt) { const unsigned char* q_ = p_ + 8192 + (size_t)((it * 2 + jt) * 64 + lane_) * 32; qf[slot][2 * jt] = *(const v4u*)q_; qf[slot][2 * jt + 1] = *(const v4u*)(q_ + 16); } } while (0)
    if (chain) {
#pragma unroll
        for (int s = 0; s < PF; ++s) RW_LOAD(s, s); }
    for (int g = 0; g < 64; ++g) {
        LAS unsigned char* hb = HB + (g & 1) * 32768;
        if (chain) {
#pragma unroll
            for (int s = 0; s < 4; ++s) {
                const int step = 4 * g + s; if (step >= 255) break;
                bf16x8 B[2][2];
#pragma unroll
                for (int jt2 = 0; jt2 < 2; ++jt2)
#pragma unroll
                    for (int k = 0; k < 2; ++k) { v4u p_; p_.x = pk2(H[jt2][8 * k], H[jt2][8 * k + 1]); p_.y = pk2(H[jt2][8 * k + 2], H[jt2][8 * k + 3]); p_.z = pk2(H[jt2][8 * k + 4], H[jt2][8 * k + 5]); p_.w = pk2(H[jt2][8 * k + 6], H[jt2][8 * k + 7]); B[jt2][k] = __builtin_bit_cast(bf16x8, p_); }
#pragma unroll
                for (int jt = 0; jt < 2; ++jt) { f32x16 n_;
#pragma unroll
                    for (int e = 0; e < 4; ++e) { const unsigned a_ = qf[s & 1][2 * jt][e], b_ = qf[s & 1][2 * jt + 1][e]; n_[2 * e] = bflo(a_); n_[2 * e + 1] = bfhi(a_); n_[8 + 2 * e] = bflo(b_); n_[8 + 2 * e + 1] = bfhi(b_); }
#pragma unroll
                    for (int jt2 = 0; jt2 < 2; ++jt2)
#pragma unroll
                        for (int k = 0; k < 2; ++k) n_ = __builtin_amdgcn_mfma_f32_32x32x16_bf16(pf[s & 1][(jt * 2 + jt2) * 2 + k], B[jt2][k], n_, 0, 0, 0);
                    H[jt] = n_; }
#pragma unroll
                for (int jt = 0; jt < 2; ++jt)
#pragma unroll
                    for (int q = 0; q < 4; ++q) { const int row = 32 * it + cl, col = 32 * jt + 8 * q + 4 * hh;
                        *(LAS unsigned long long*)(hb + s * 8192 + sw16(row, col >> 3) + (col & 4) * 2) = (unsigned long long)pk2(H[jt][4 * q], H[jt][4 * q + 1]) | ((unsigned long long)pk2(H[jt][4 * q + 2], H[jt][4 * q + 3]) << 32); }
                RW_LOAD(s & 1, (step + PF < 255) ? step + PF : 254);
            }
        }
        asm volatile("s_waitcnt lgkmcnt(0)\n\ts_barrier" ::: "memory");
        if (!chain) {
            const int nst = (4 * g + 4 <= 255) ? 4 : 255 - 4 * g; unsigned char* dst = st + (size_t)(4 * g + 1) * 8192; const int ft = tid_ - 128;
            for (int o = ft * 16; o < nst * 8192; o += 384 * 16) { const int row_ = (o >> 7) & 63, chk_ = (o >> 4) & 7; *(v4u*)(dst + o) = *(const LAS v4u*)(hb + (o & ~8191) + sw16(row_, chk_)); }
        }
    }
    asm volatile("s_waitcnt vmcnt(0) lgkmcnt(0)\n\ts_barrier" ::: "memory");
#undef RW_LOAD
}

__device__ __forceinline__ void rwkv_r3(Frame& F, const Args& A) {
    PHASE_IDS();
    unsigned char* ws = A.ws;
    const bf16* VV = (const bf16*)(ws + WS_XN); const bf16* GG = (const bf16*)(ws + WS_F + 32 * MiB); const float* BON = (const float*)(ws + WS_BON);
    bf16* O = (bf16*)(ws + WS_F); const float* lg = A.in[16]; const float* lb = A.in[17];
    LAS float* Yt = (LAS float*)F.lds;
    const int w = wave_, l15 = lane_ & 15, kg = lane_ >> 4, r0 = 16 * (w >> 1), c0 = 32 * (w & 1);
#define R3_BAR() asm volatile("s_waitcnt lgkmcnt(0)\n\ts_barrier" ::: "memory")
    v4u nq, nvw, ngw; bf16x8 na[2], nb[2][2]; float nbon;
    const int pt_ = tid_ >> 3, pi0_ = 8 * (tid_ & 7);
#define R3_LOAD(itx) do { const int ch_ = (itx) >> 8, cc_ = (itx) & 255; const unsigned char* og_ = ws + pq_off(itx); const unsigned char* sg_ = (const unsigned char*)A.out + ST_OFF + (size_t)(itx) * 8192; \
        nq = *(const v4u*)((const unsigned char*)A.out + y0_off(itx, w * 64 + lane_)); \
        _Pragma("unroll") for (int ks = 0; ks < 2; ++ks) { na[ks] = *(const bf16x8*)(og_ + 16384 + (size_t)((r0 + l15) * 64 + 32 * ks + 8 * kg) * 2); \
            _Pragma("unroll") for (int n = 0; n < 2; ++n) nb[ks][n] = *(const bf16x8*)(sg_ + (size_t)((c0 + 16 * n + l15) * 64 + 32 * ks + 8 * kg) * 2); } \
        const size_t m_ = (size_t)(ch_ >> 3) * SEQ + (size_t)cc_ * 64 + pt_; const int col_ = 64 * (ch_ & 7) + pi0_; \
        nvw = *(const v4u*)(VV + m_ * 512 + col_); ngw = *(const v4u*)(GG + m_ * 512 + col_); nbon = BON[m_ * 8 + (ch_ & 7)]; } while (0)
    if ((int)blockIdx.x < CH_ITEMS) R3_LOAD((int)blockIdx.x);
    for (int it = blockIdx.x; it < CH_ITEMS; it += F.G) {
        const int ch = it >> 8, cc = it & 255, b = ch >> 3, h = ch & 7;
        f32x4c acc[2];
        acc[0] = (f32x4c){bflo(nq.x), bfhi(nq.x), bflo(nq.y), bfhi(nq.y)}; acc[1] = (f32x4c){bflo(nq.z), bfhi(nq.z), bflo(nq.w), bfhi(nq.w)};
#pragma unroll
        for (int ks = 0; ks < 2; ++ks)
#pragma unroll
            for (int n = 0; n < 2; ++n) acc[n] = __builtin_amdgcn_mfma_f32_16x16x32_bf16(na[ks], nb[ks][n], acc[n], 0, 0, 0);
        const v4u vw = nvw, gw4 = ngw; const float bon = nbon;
        { const int itn_ = (it + (int)F.G < CH_ITEMS) ? it + (int)F.G : it; R3_LOAD(itn_); }
        R3_BAR();
#pragma unroll
        for (int n = 0; n < 2; ++n)
#pragma unroll
            for (int e = 0; e < 4; ++e) Yt[(r0 + 4 * kg + e) * 68 + c0 + 16 * n + l15] = acc[n][e];
        R3_BAR();
        {   const int t = pt_, i0 = pi0_; const size_t m = (size_t)b * SEQ + (size_t)cc * 64 + t; const int col = 64 * h + i0;
            const f32x4 y0 = *(const LAS f32x4*)(Yt + t * 68 + i0), y1 = *(const LAS f32x4*)(Yt + t * 68 + i0 + 4);
            float s = (y0.x + y0.y) + (y0.z + y0.w) + (y1.x + y1.y) + (y1.z + y1.w);
            s += __shfl_xor(s, 1); s += __shfl_xor(s, 2); s += __shfl_xor(s, 4);
            const float mean = s * (1.f / 64.f); const f32x4 d0 = y0 - mean, d1 = y1 - mean;
            float q = (d0.x * d0.x + d0.y * d0.y) + (d0.z * d0.z + d0.w * d0.w) + (d1.x * d1.x + d1.y * d1.y) + (d1.z * d1.z + d1.w * d1.w);
            q += __shfl_xor(q, 1); q += __shfl_xor(q, 2); q += __shfl_xor(q, 4);
            const float rstd = 1.0f / sqrtf(q * (1.f / 64.f) + 64e-5f);
            const f32x4 g0 = *(const f32x4*)(lg + col), g1 = *(const f32x4*)(lg + col + 4), b0 = *(const f32x4*)(lb + col), b1 = *(const f32x4*)(lb + col + 4);
            f32x4 o0 = (d0 * rstd * g0 + b0), o1 = (d1 * rstd * g1 + b1);
            o0.x = (o0.x + bon * bflo(vw.x)) * bflo(gw4.x); o0.y = (o0.y + bon * bfhi(vw.x)) * bfhi(gw4.x); o0.z = (o0.z + bon * bflo(vw.y)) * bflo(gw4.y); o0.w = (o0.w + bon * bfhi(vw.y)) * bfhi(gw4.y);
            o1.x = (o1.x + bon * bflo(vw.z)) * bflo(gw4.z); o1.y = (o1.y + bon * bfhi(vw.z)) * bfhi(gw4.z); o1.z = (o1.z + bon * bflo(vw.w)) * bflo(gw4.w); o1.w = (o1.w + bon * bfhi(vw.w)) * bfhi(gw4.w);
            v4u ow; ow.x = pk2(o0.x, o0.y); ow.y = pk2(o0.z, o0.w); ow.z = pk2(o1.x, o1.y); ow.w = pk2(o1.z, o1.w);
            *(v4u*)(O + m * 512 + col) = ow; }
    }
#undef R3_BAR
#undef R3_LOAD
}

__device__ __forceinline__ void p_norm2_route(Frame& F, const Args& A) {
    PHASE_IDS();
    unsigned char* ws = A.ws;
    constexpr int WROW = 2064;
    LAS unsigned char* WH = F.lds; LAS unsigned char* WL = F.lds + 36 * WROW;
    LAS float* LG = (LAS float*)F.lds;
    LAS int* eid = (LAS int*)(F.lds + 128 * 36 * 4);
    const bf16* x1 = (const bf16*)(ws + WS_X1); const float* g2 = A.in[21]; const float* mod = (const float*)(ws + WS_MOD);
    const float* rgw = A.in[22]; const float* rgb = A.in[23]; const float* rew = A.in[24]; const float* reb = A.in[25];
    bf16* XN2 = (bf16*)(ws + WS_XN); int* route = (int*)(ws + WS_ROUTE); int* blkcnt = (int*)(ws + WS_BLKCNT);
    const int l15 = lane_ & 15, kg = lane_ >> 4;
    for (int blk = blockIdx.x; blk < M / 128; blk += F.G) {
        __syncthreads();
        for (int i = tid_; i < 4096; i += NWAVES * 64) { const float w = rgw[i]; const unsigned hi = f2bf(w); const unsigned lo = f2bf(w - __uint_as_float(hi << 16)); const int off = (i & 3) * WROW + (i >> 2) * 2;
            *(LAS unsigned short*)(WH + off) = (unsigned short)hi; *(LAS unsigned short*)(WL + off) = (unsigned short)lo; }
        for (int i = tid_; i < 32768; i += NWAVES * 64) { const float w = rew[i]; const unsigned hi = f2bf(w); const unsigned lo = f2bf(w - __uint_as_float(hi << 16)); const int off = (4 + (i & 31)) * WROW + (i >> 5) * 2;
            *(LAS unsigned short*)(WH + off) = (unsigned short)hi; *(LAS unsigned short*)(WL + off) = (unsigned short)lo; }
        __syncthreads();
        const int b = blk / (SEQ / 128); const size_t tok = (size_t)blk * 128 + wave_ * 16 + l15;
        const bf16* xrow = x1 + tok * D + 8 * kg; const float* gmp = g2 + 8 * kg; const float* scp = mod + b * 6144 + 4096 + 8 * kg; const float* shp = mod + b * 6144 + 3072 + 8 * kg;
        float ss = 0.f;
#pragma unroll 8
        for (int ks = 0; ks < 32; ++ks) { const v4u xw = *(const v4u*)(xrow + 32 * ks);
#pragma unroll
            for (int e = 0; e < 4; ++e) { const float lo_ = bflo(xw[e]), hi_ = bfhi(xw[e]); ss += lo_ * lo_ + hi_ * hi_; } }
        ss += __shfl_xor(ss, 16); ss += __shfl_xor(ss, 32);
        const float rstd = 1.0f / sqrtf(ss * (1.f / D) + 1e-6f);
        f32x4 acc[3]; acc[0] = f32x4{0.f, 0.f, 0.f, 0.f}; acc[1] = acc[0]; acc[2] = acc[0];
        int wcol[3];
#pragma unroll
        for (int ct = 0; ct < 3; ++ct) { const int col = 16 * ct + l15; wcol[ct] = (col < 36 ? col : 35) * WROW + 16 * kg; }
#pragma unroll 2
        for (int ks = 0; ks < 32; ++ks) {
            float hv[8];
            { const v4u xw = *(const v4u*)(xrow + 32 * ks); const f32x4 a = {bflo(xw.x), bfhi(xw.x), bflo(xw.y), bfhi(xw.y)}, c = {bflo(xw.z), bfhi(xw.z), bflo(xw.w), bfhi(xw.w)};
              const f32x4 g0 = *(const f32x4*)(gmp + 32 * ks), g1 = *(const f32x4*)(gmp + 32 * ks + 4), s0 = *(const f32x4*)(scp + 32 * ks), s1 = *(const f32x4*)(scp + 32 * ks + 4), h0 = *(const f32x4*)(shp + 32 * ks), h1 = *(const f32x4*)(shp + 32 * ks + 4);
              const f32x4 u0 = a * rstd * (g0 * (s0 + 1.0f)) + h0, u1 = c * rstd * (g1 * (s1 + 1.0f)) + h1;
              hv[0] = u0.x; hv[1] = u0.y; hv[2] = u0.z; hv[3] = u0.w; hv[4] = u1.x; hv[5] = u1.y; hv[6] = u1.z; hv[7] = u1.w; }
            unsigned hiw[4], low[4];
#pragma unroll
            for (int e = 0; e < 4; ++e) { const unsigned h0 = f2bf(hv[2 * e]), h1 = f2bf(hv[2 * e + 1]); hiw[e] = h0 | (h1 << 16);
                low[e] = f2bf(hv[2 * e] - __uint_as_float(h0 << 16)) | (f2bf(hv[2 * e + 1] - __uint_as_float(h1 << 16)) << 16); }
            v4u hq; hq.x = hiw[0]; hq.y = hiw[1]; hq.z = hiw[2]; hq.w = hiw[3];
            *(v4u*)(XN2 + tok * D + 32 * ks + 8 * kg) = hq;
            v4u lq; lq.x = low[0]; lq.y = low[1]; lq.z = low[2]; lq.w = low[3];
            const bf16x8 ah = __builtin_bit_cast(bf16x8, hq), al = __builtin_bit_cast(bf16x8, lq);
#pragma unroll
            for (int ct = 0; ct < 3; ++ct) { const bf16x8 bh = *(const LAS bf16x8*)(WH + wcol[ct] + 64 * ks), bl = *(const LAS bf16x8*)(WL + wcol[ct] + 64 * ks);
                acc[ct] = __builtin_amdgcn_mfma_f32_16x16x32_bf16(ah, bh, acc[ct], 0, 0, 0); acc[ct] = __builtin_amdgcn_mfma_f32_16x16x32_bf16(ah, bl, acc[ct], 0, 0, 0); acc[ct] = __builtin_amdgcn_mfma_f32_16x16x32_bf16(al, bh, acc[ct], 0, 0, 0); }
        }
        __syncthreads();
#pragma unroll
        for (int ct = 0; ct < 3; ++ct) { const int col = 16 * ct + l15; if (col < 36) { const float bias = (col < 4) ? rgb[col] : reb[col - 4];
#pragma unroll
            for (int e = 0; e < 4; ++e) LG[(wave_ * 16 + 4 * kg + e) * 36 + col] = acc[ct][e] + bias; } }
        __syncthreads();
        if (tid_ < 128) { const LAS float* lg = LG + tid_ * 36;
            int gi = 0; float gmax = lg[0];
#pragma unroll
            for (int i = 1; i < 4; ++i) if (lg[i] > gmax) { gmax = lg[i]; gi = i; }
            float den = 0.f;
#pragma unroll
            for (int i = 0; i < 4; ++i) den += __expf(lg[i] - gmax);
            const float gp = 1.0f / den;
            float el[8];
#pragma unroll
            for (int i = 0; i < 8; ++i) el[i] = lg[4 + 8 * gi + i];
            int i0 = 0; float m0 = el[0];
#pragma unroll
            for (int i = 1; i < 8; ++i) if (el[i] > m0) { m0 = el[i]; i0 = i; }
            int i1 = -1; float m1 = -INFINITY;
#pragma unroll
            for (int i = 0; i < 8; ++i) if (i != i0 && el[i] > m1) { m1 = el[i]; i1 = i; }
            if (i1 < 0) { i1 = (i0 + 1) & 7; m1 = m0; }
            const float p1 = __expf(m1 - m0), w0 = gp / (1.0f + p1), w1 = gp * p1 / (1.0f + p1);
            int* rt_ = route + ((size_t)blk * 128 + tid_) * 8; rt_[0] = gi * 8 + i0; rt_[1] = gi * 8 + i1; rt_[2] = __float_as_int(w0); rt_[3] = __float_as_int(w1);
            eid[tid_ * 2] = gi * 8 + i0; eid[tid_ * 2 + 1] = gi * 8 + i1; }
        __syncthreads();
        if (tid_ < 256) { const int e = eid[tid_]; int rk = 0; for (int a = 0; a < tid_; ++a) rk += (eid[a] == e) ? 1 : 0; route[((size_t)blk * 128 + (tid_ >> 1)) * 8 + 4 + (tid_ & 1)] = rk; }
        else if (tid_ < 288) { const int e = tid_ - 256; int cn = 0; for (int a = 0; a < 256; ++a) cn += (eid[a] == e) ? 1 : 0; blkcnt[blk * 32 + e] = cn; }
    }
}

__device__ __forceinline__ void conv_experts(Frame& F, const Args& A) {
    PHASE_IDS();
    unsigned char* ws = A.ws; bf16* W13 = (bf16*)(ws + WS_W13); bf16* W2T = (bf16*)(ws + WS_W2T);
    LAS float* scr = (LAS float*)(F.lds + RING_OFF + wave_ * 16384);
    const int gw = F.vcu * NWAVES + wave_, NGW = F.G * NWAVES;
    for (int it = gw; it < 3 * 8192; it += NGW) {
        const int which = it >> 13, r = it & 8191;
        if (which < 2) { const int e = r >> 8, kb = (r >> 4) & 15, nb = r & 15, n0 = 32 * nb;
            transpose_item(A.in[26 + which] + (size_t)e * 1024 * 512, 512, n0, 64 * kb, 1024, W13, (size_t)e * 1024 + (n0 >> 7) * 256 + which * 128 + (n0 & 127), scr, lane_); }
        else { const int e = r >> 8, kb = (r >> 5) & 7, nb = r & 31;
            transpose_item(A.in[28] + (size_t)e * 512 * 1024, 1024, 32 * nb, 64 * kb, 512, W2T, (size_t)e * 1024 + 32 * nb, scr, lane_); }
    }
}

__device__ __forceinline__ void p_slots(Frame& F, const Args& A) {
    PHASE_IDS();
    unsigned char* ws = A.ws;
    LAS int* tile_e = (LAS int*)(F.lds + TILE_OFF); LAS int* base = tile_e + 288; LAS int* tot = base + 32; LAS int* pre = tot + 32; LAS int* ntl = pre + 32; LAS int* part = ntl + 4;
    const int* blkcnt = (const int*)(ws + WS_BLKCNT); int* route = (int*)(ws + WS_ROUTE); int* rowtok = (int*)(ws + WS_ROWTOK);
    { const int e = tid_ & 31, pt = tid_ >> 5; int s = 0; for (int bb = 16 * pt; bb < 16 * pt + 16; ++bb) s += blkcnt[bb * 32 + e]; part[pt * 32 + e] = s; }
    __syncthreads();
    if (tid_ < 32) { int t = 0; for (int p = 0; p < 16; ++p) t += part[p * 32 + tid_]; tot[tid_] = t; }
    __syncthreads();
    if (tid_ == 0) { int run = 0, nt = 0; for (int e = 0; e < 32; ++e) { base[e] = run; const int pad = (tot[e] + 255) >> 8; for (int i = 0; i < pad; ++i) tile_e[nt++] = e; run += pad * 256; } ntl[0] = nt; }
    __syncthreads();
    for (int blk = blockIdx.x; blk < M / 128; blk += F.G) {
        { const int e = tid_ & 31, pt = tid_ >> 5; int s = 0; for (int bb = pt; bb < blk; bb += 16) s += blkcnt[bb * 32 + e]; part[pt * 32 + e] = s; }
        __syncthreads();
        if (tid_ < 32) { int p = 0; for (int q = 0; q < 16; ++q) p += part[q * 32 + tid_]; pre[tid_] = p; }
        __syncthreads();
        if (tid_ < 256) { const size_t tok = (size_t)blk * 128 + (tid_ >> 1); const int k = tid_ & 1; const int e = route[tok * 8 + k], lr = route[tok * 8 + 4 + k];
            const int slot = base[e] + pre[e] + lr; route[tok * 8 + 6 + k] = slot; rowtok[slot] = (int)tok; }
        __syncthreads();
    }
    for (int e = blockIdx.x; e < 32; e += F.G) { const int lo = base[e] + tot[e], hi = base[e] + (((tot[e] + 255) >> 8) << 8); for (int s = lo + tid_; s < hi; s += NWAVES * 64) rowtok[s] = 0; }
}

#ifndef STAGE_UNUSED
#define STAGE 4
#endif
#ifndef PHASES
#define PHASES 0xffff
#endif
#ifndef RWKV_CHUNKED
#define RWKV_CHUNKED 1
#endif

__device__ __forceinline__ void ph_gemm1(Frame& F, const Args& args) { unsigned char* ws = args.ws;
    pg8::Gemm g{(const pg8::bf16_t*)(ws + WS_XN), (const pg8::bf16_t*)(ws + WS_WIN), nullptr, 1024, NIN};
    pg8::StaticOrder S; S.init(M, NIN, F.G, (int)blockIdx.x);
    pg8::EpiIn E{(pg8::bf16_t*)(ws + WS_Q), (pg8::bf16_t*)(ws + WS_K), (pg8::bf16_t*)(ws + WS_V), (pg8::bf16_t*)(ws + WS_PRW), (pg8::bf16_t*)(ws + WS_GATES), ATT_C2};
    pg8::gemm_phase<pg8::EpiIn, pg8::StaticOrder>(F.lds + RING_OFF, g, S, E); }
__device__ __forceinline__ void ph_attn_wrap(unsigned char* lds, Frame& F, const Args& args, size_t out_off, int qslot) { unsigned char* ws = args.ws;
    const attn_body::AttnTensors AT{(const attn_body::bf16*)(ws + WS_Q), (const attn_body::bf16*)(ws + WS_K), (const attn_body::bf16*)(ws + WS_V), (attn_body::bf16*)(ws + out_off), (const float*)(ws + WS_CUM), (const float*)(ws + WS_SEGTOT)};
    attn_body::attn_phase_dyn<8>((char*)lds + RING_OFF, AT, (unsigned*)(F.ctl + CW_QUEUE + 64 * qslot), (const unsigned*)(F.ctl + CW_QKMAX), TAB_OFF, SEGP_OFF); }
__device__ __forceinline__ void ph_gemm2a(Frame& F, const Args& args) { unsigned char* ws = args.ws;
    pg8::Gemm g{(const pg8::bf16_t*)(ws + WS_Q), (const pg8::bf16_t*)(ws + WS_WOF), nullptr, 512, 1024};
    pg8::StaticOrder S; S.init(M, 1024, F.G, (int)blockIdx.x);
    pg8::EpiGate<1> E{(pg8::bf16_t*)(ws + WS_TMP), 1024, (const pg8::bf16_t*)(ws + WS_GATES), 2048, 0};
    pg8::gemm_phase<pg8::EpiGate<1>, pg8::StaticOrder>(F.lds + RING_OFF, g, S, E); }
__device__ __forceinline__ void ph_gemm2b(Frame& F, const Args& args) { unsigned char* ws = args.ws;
    pg8::Gemm g{(const pg8::bf16_t*)(ws + WS_F), (const pg8::bf16_t*)(ws + WS_WOR), nullptr, 512, 1024};
    pg8::StaticOrder S; S.init(M, 1024, F.G, (int)blockIdx.x);
    pg8::EpiGate<2> E{(pg8::bf16_t*)(ws + WS_TMP), 1024, (const pg8::bf16_t*)(ws + WS_GATES), 2048, 1024};
    pg8::gemm_phase<pg8::EpiGate<2>, pg8::StaticOrder>(F.lds + RING_OFF, g, S, E); }
__device__ __forceinline__ void ph_gemm3(Frame& F, const Args& args) { unsigned char* ws = args.ws;
    pg8::Gemm g{(const pg8::bf16_t*)(ws + WS_TMP), (const pg8::bf16_t*)(ws + WS_WO), nullptr, 1024, 1024};
    pg8::StaticOrder S; S.init(M, 1024, F.G, (int)blockIdx.x);
    pg8::EpiRes E{args.in[0], (pg8::bf16_t*)(ws + WS_X1), (const float*)(ws + WS_MOD) + 2048, SEQ, 6144};
    pg8::gemm_phase<pg8::EpiRes, pg8::StaticOrder>(F.lds + RING_OFF, g, S, E); }
__device__ __forceinline__ void ph_moe_up(Frame& F, const Args& args) { unsigned char* ws = args.ws;
    const LAS int* tile_e = (const LAS int*)(F.lds + TILE_OFF); const int ntiles = tile_e[288 + 96];
    LAS int* rows = (LAS int*)(F.lds + TILE_OFF + 4096);
    { const int* rowtok = (const int*)(ws + WS_ROWTOK); int tid_ = threadIdx.x; asm volatile("" : "+v"(tid_));
      for (int i = 0; i < 8; ++i) { const int L = i * F.G + (int)blockIdx.x; if (L >= ntiles * 4) break; if (tid_ < 256) rows[i * 256 + tid_] = rowtok[(L >> 2) * 256 + tid_]; }
      __syncthreads(); }
    pg8::Gemm g{(const pg8::bf16_t*)(ws + WS_XN), (const pg8::bf16_t*)(ws + WS_W13), rows, 1024, 1024};
    pg8::MoeOrder S{ntiles * 4, F.G, (int)blockIdx.x, 2, tile_e};
    pg8::EpiSwiGLU E{(pg8::bf16_t*)(ws + WS_H)};
    pg8::gemm_phase<pg8::EpiSwiGLU, pg8::MoeOrder, true>(F.lds + RING_OFF, g, S, E); }
__device__ __forceinline__ void ph_moe_down(Frame& F, const Args& args) { unsigned char* ws = args.ws;
    const LAS int* tile_e = (const LAS int*)(F.lds + TILE_OFF); const int ntiles = tile_e[288 + 96];
    pg8::Gemm g{(const pg8::bf16_t*)(ws + WS_H), (const pg8::bf16_t*)(ws + WS_W2T), nullptr, 512, 1024};
    pg8::MoeOrder S{ntiles * 4, F.G, (int)blockIdx.x, 2, tile_e};
    pg8::EpiFp8 E{ws + WS_YM, 1024};
    pg8::gemm_phase<pg8::EpiFp8, pg8::MoeOrder>(F.lds + RING_OFF, g, S, E); }

__global__ void __launch_bounds__(NWAVES * 64, 2) fwd_kernel(Args args) {
    extern __shared__ __attribute__((aligned(16))) unsigned char lds[];
    Frame F;
    F.lds = (LAS unsigned char*)lds;
    F.MISC = (volatile LAS unsigned*)(F.lds + MISC_OFF);
    F.tid = threadIdx.x; F.lane = F.tid & 63; F.wave = __builtin_amdgcn_readfirstlane(F.tid >> 6);
    F.G = gridDim.x; { const int bx = blockIdx.x; F.vcu = (F.G % 8 == 0) ? (bx % 8) * (F.G / 8) + bx / 8 : bx; }
    unsigned char* ws = args.ws;
    F.ctl = (gu32*)(ws + WS_CTL);
    for (int u = F.tid; u < (LDS_BYTES - LDSCTL_OFF) / 4; u += NWAVES * 64) ((LAS unsigned*)(F.lds + LDSCTL_OFF))[u] = 0u;
    __syncthreads();
    XcdBarrier bar = xcd_barrier_post((unsigned*)(F.ctl + CW_BAR), F.MISC + 8);
#define GRID_BAR() xcd_barrier(bar)

    p0_prologue(F, args); GRID_BAR();
    p1_norm(F, args); __syncthreads(); p_convert_early(F, args); GRID_BAR();
    p_cumfix(F, args);
    ph_gemm1(F, args); GRID_BAR();
    p_qknorm(F, args, (unsigned*)(F.ctl + CW_QKMAX));
    for (int cb = (int)blockIdx.x; cb < SEQ / 64; cb += F.G)
    for (int half = 0; half < 2; ++half) {
        rwkv_pre<0>(F, args, cb + 256 * half, cb + 256 * half + 1);
        __syncthreads();
        rwkv_r1<0>(F, args, cb + 2048 * half, cb + 2048 * half + 2048, 256);
        __syncthreads();
    }
    GRID_BAR();
    rwkv_r2w(F, args, (unsigned char*)args.out + ST_OFF);
    ph_attn_wrap(lds, F, args, WS_Q, 0); GRID_BAR();
    rwkv_r3(F, args); GRID_BAR();
    ph_gemm2a(F, args);
    ph_gemm2b(F, args); GRID_BAR();
    ph_gemm3(F, args); GRID_BAR();
    p_norm2_route(F, args); GRID_BAR();
    p_slots(F, args); conv_experts(F, args); GRID_BAR();
    ph_moe_up(F, args); GRID_BAR();
    ph_moe_down(F, args); GRID_BAR();
    p_final<1>(F, args, args.out);
}

extern "C" void kernel_launch(void* const* d_in, const int* in_sizes, int n_in, void* d_out, int out_size, void* d_ws, size_t ws_size, hipStream_t stream) {
    static int grid = 0;
    if (grid == 0) {
        if (n_in != 30 || in_sizes[0] != M * D || out_size != M * D || ws_size < WS_END) { fprintf(stderr, "kernel_launch: unexpected shapes (n_in %d, in0 %d, out %d, ws %zu)\n", n_in, n_in > 0 ? in_sizes[0] : -1, out_size, ws_size); grid = -1; return; }
        int dev = 0, cus = 0, per_cu = 0;
        if (hipGetDevice(&dev) != hipSuccess || hipDeviceGetAttribute(&cus, hipDeviceAttributeMultiprocessorCount, dev) != hipSuccess) { grid = -1; return; }
        if (hipFuncSetAttribute((const void*)fwd_kernel, hipFuncAttributeMaxDynamicSharedMemorySize, LDS_BYTES) != hipSuccess) { fprintf(stderr, "kernel_launch: hipFuncSetAttribute failed\n"); grid = -1; return; }
        if (hipOccupancyMaxActiveBlocksPerMultiprocessor(&per_cu, (const void*)fwd_kernel, NWAVES * 64, LDS_BYTES) != hipSuccess || per_cu < 1)
            fprintf(stderr, "kernel_launch: occupancy query reports %d\n", per_cu);
        (void)hipGetLastError();
        grid = cus;
        if (grid > 256) grid = 256;
    }
    if (grid < 0) return;
    if (hipMemsetAsync((char*)d_ws + WS_CTL, 0, CTL_ZERO_BYTES, stream) != hipSuccess) return;
    Args a{};
    for (int i = 0; i < 30; ++i) a.in[i] = (const float*)d_in[i];
    a.out = (float*)d_out; a.ws = (unsigned char*)d_ws;
    hipLaunchKernelGGL(fwd_kernel, dim3(grid), dim3(NWAVES * 64), LDS_BYTES, stream, a);
}
```

```cpp
#include <hip/hip_runtime.h>
#include <hip/hip_bf16.h>
#include <cstdio>
#include <cstdint>
#include <cmath>

namespace pg8 {
#define PG8_LAS __attribute__((address_space(3)))
typedef unsigned short bf16_t;
typedef short bf16x8 __attribute__((ext_vector_type(8)));
typedef float f32x4 __attribute__((ext_vector_type(4)));
typedef unsigned u32x4 __attribute__((ext_vector_type(4)));
typedef unsigned u32x2 __attribute__((ext_vector_type(2)));
constexpr int BM = 256, BK = 64, HALF = 128, HTB = HALF * BK * 2, STAGE_BYTES = 8 * HTB, NXCD = 8, WGM = 8;

__host__ __device__ __forceinline__ int lds_byte(int r, int c) { const int st = (r >> 4) * 2 + (c >> 5), rr = r & 15, cc = c & 31, ob = rr * 64 + cc * 2; return st * 1024 + (ob ^ (((ob >> 9) & 1) << 5)); }
__host__ __device__ __forceinline__ void stage_rc(int b, int& R, int& C) { const int st = b / 1024, sb = b % 1024, swz = sb ^ (((sb >> 9) & 1) << 5); R = (st >> 1) * 16 + swz / 64; C = (st & 1) * 32 + (swz % 64) / 2; }
__host__ __device__ __forceinline__ int perm32(int rho) { const int n = rho >> 4, i = rho & 15; return 8 * (i >> 2) + 4 * n + (i & 3); }

struct Unit { int pm, pn, e; };
struct Gemm { const bf16_t* A; const bf16_t* Bt; const PG8_LAS int* rowlds; int K; int nB; };

struct StaticOrder {
    int nM, nN, nwg, G, c;
    __host__ __device__ void init(int M, int N, int G_, int c_) { nM = M / BM; nN = N / BM; nwg = nM * nN; G = G_; c = c_; }
    __host__ __device__ bool next(int i, Unit& u) const {
        const long L = (long)i * G + c; if (L >= nwg) return false;
        int wgid = (int)L; { const int q = nwg / NXCD, r = nwg % NXCD, xcd = wgid % NXCD, off = wgid / NXCD; wgid = (xcd < r ? xcd * (q + 1) : r * (q + 1) + (xcd - r) * q) + off; }
        const int nig = WGM * nN, gid = wgid / nig, fm = gid * WGM, gsz = (nM - fm) < WGM ? (nM - fm) : WGM;
        u.pm = fm + ((wgid % nig) % gsz); u.pn = (wgid % nig) / gsz; u.e = 0; return true;
    }
};

__device__ __forceinline__ unsigned cvt_pk_bf16(float lo, float hi) { unsigned r; asm volatile("v_cvt_pk_bf16_f32 %0, %1, %2" : "=v"(r) : "v"(lo), "v"(hi)); return r; }
__device__ __forceinline__ float bf_lo(unsigned w) { return __uint_as_float(w << 16); }
__device__ __forceinline__ float bf_hi(unsigned w) { return __uint_as_float(w & 0xffff0000u); }
__device__ __forceinline__ float fsigmoid(float x) { return __builtin_amdgcn_rcpf(1.0f + __builtin_amdgcn_exp2f(-1.4426950408889634f * x)); }

template <class Epi, class Sched, bool GATHER = false>
__device__ __forceinline__ void gemm_phase(PG8_LAS unsigned char* lds, const Gemm g, const Sched& S, const Epi& E) {
    int tid_ = threadIdx.x; asm volatile("" : "+v"(tid_));
    const int tid = tid_, wid = __builtin_amdgcn_readfirstlane(tid >> 6), lane = tid & 63, wr = wid >> 2, wc = wid & 3, fr = lane & 15, fq = lane >> 4;
    const int K = g.K, nt = K / BK;
    int RA[2], CA[2]; unsigned voffA[2], voffB[2];
#pragma unroll
    for (int i = 0; i < 2; ++i) { int R, C; stage_rc(tid * 16 + i * 8192, R, C); const int Rb = Epi::PERM ? ((R & ~31) + perm32(R & 31)) : R;
        RA[i] = R; CA[i] = C; voffA[i] = (unsigned)(R * K + C) * 2u; voffB[i] = (unsigned)(Rb * K + C) * 2u; }
    const size_t tstep = 2 * (size_t)HALF * K * 2;
    const size_t kstep = (size_t)(BK * 2);
    const size_t hstep = (size_t)HALF * K * 2;
    const unsigned ldsw = (unsigned)wid * 1024u;
    const int aoff = lds_byte(wr * 64 + fr, fq * 8), boff = lds_byte(wc * 32 + fr, fq * 8);
#define PG8_SA(b, h) (((b) * 2 + (h)) * HTB)
#define PG8_SB(b, h) ((4 + (b) * 2 + (h)) * HTB)
#define PG8_STAGE(bufoff, gbase, v0, v1) do { \
        __builtin_amdgcn_global_load_lds((const unsigned*)((const char*)(gbase) + (v0)), (PG8_LAS unsigned*)(lds + (bufoff) + ldsw), 16, 0, 0); \
        __builtin_amdgcn_global_load_lds((const unsigned*)((const char*)(gbase) + (v1)), (PG8_LAS unsigned*)(lds + (bufoff) + ldsw + 8192), 16, 0, 0); } while (0)
#define PG8_STAGEB(bufoff, gbase) PG8_STAGE(bufoff, gbase, voffB[0], voffB[1])
#define PG8_STAGEA(bufoff, abase, h, VA) do { if constexpr (GATHER) { PG8_STAGE(bufoff, abase, VA[h][0], VA[h][1]); } else { PG8_STAGE(bufoff, (abase) + (h) * hstep, voffA[0], voffA[1]); } } while (0)
#define PG8_LDA(dst, b, h) do { _Pragma("unroll") for (int m = 0; m < 4; ++m) _Pragma("unroll") for (int k = 0; k < 2; ++k) dst[m][k] = *(const PG8_LAS bf16x8*)(lds + PG8_SA(b, h) + aoff + m * 2048 + k * 1024); } while (0)
#define PG8_LDB(dst, b, h) do { _Pragma("unroll") for (int n = 0; n < 2; ++n) _Pragma("unroll") for (int k = 0; k < 2; ++k) dst[n][k] = *(const PG8_LAS bf16x8*)(lds + PG8_SB(b, h) + boff + n * 2048 + k * 1024); } while (0)
#define PG8_MMA(ai, bj, At, Bt) do { __builtin_amdgcn_s_setprio(1); _Pragma("unroll") for (int m = 0; m < 4; ++m) _Pragma("unroll") for (int n = 0; n < 2; ++n) _Pragma("unroll") for (int k = 0; k < 2; ++k) \
        acc[ai][bj][m][n] = __builtin_amdgcn_mfma_f32_16x16x32_bf16(Bt[n][k], At[m][k], acc[ai][bj][m][n], 0, 0, 0); __builtin_amdgcn_s_setprio(0); } while (0)
#define PG8_WAIT_V(n) asm volatile("s_waitcnt vmcnt(" #n ")" ::: "memory")
#define PG8_WAIT_L(n) asm volatile("s_waitcnt lgkmcnt(" #n ")" ::: "memory")
#define PG8_BAR __builtin_amdgcn_s_barrier()
#define PG8_SCHED __builtin_amdgcn_sched_barrier(0)
#define PG8_AOFF(dst, ord) do { _Pragma("unroll") for (int h_ = 0; h_ < 2; ++h_) _Pragma("unroll") for (int i_ = 0; i_ < 2; ++i_) { \
        const int src_ = g.rowlds[(ord) * BM + h_ * HALF + RA[i_]]; dst[h_][i_] = (unsigned)(src_ * K + CA[i_]) * 2u; } } while (0)
    Unit cur, nxt; int ui = 0;
    if (!S.next(0, cur)) return;
    f32x4 acc[2][2][4][2];
#pragma unroll
    for (int a = 0; a < 2; ++a)
#pragma unroll
        for (int b = 0; b < 2; ++b)
#pragma unroll
            for (int m = 0; m < 4; ++m)
#pragma unroll
                for (int n = 0; n < 2; ++n) acc[a][b][m][n] = (f32x4){0.f, 0.f, 0.f, 0.f};
    bf16x8 At[4][2], B0[2][2], B1[2][2];
    unsigned vA[2][2], nvA[2][2];
    if constexpr (GATHER) { PG8_AOFF(vA, 0); }
    const char* cA = GATHER ? (const char*)g.A : (const char*)g.A + (size_t)cur.pm * tstep;
    const char* cB = (const char*)g.Bt + ((size_t)cur.e * g.nB + (size_t)cur.pn * BM) * K * 2;
    PG8_STAGEB(PG8_SB(0, 0), cB); PG8_STAGEB(PG8_SB(0, 1), cB + hstep); PG8_STAGEA(PG8_SA(0, 0), cA, 0, vA); PG8_STAGEA(PG8_SA(0, 1), cA, 1, vA);
    if (wr == 1) PG8_BAR;
    PG8_WAIT_V(2); PG8_BAR;
    PG8_STAGEB(PG8_SB(1, 0), cB + kstep); PG8_STAGEA(PG8_SA(1, 0), cA + kstep, 0, vA); PG8_STAGEB(PG8_SB(1, 1), cB + hstep + kstep);
    PG8_WAIT_V(6); PG8_BAR;
    for (;;) {
        const bool has_next = S.next(ui + 1, nxt);
        if constexpr (GATHER) { if (has_next) { PG8_AOFF(nvA, ui + 1); } else {
#pragma unroll
            for (int h_ = 0; h_ < 2; ++h_)
#pragma unroll
                for (int i_ = 0; i_ < 2; ++i_) nvA[h_][i_] = vA[h_][i_]; } }
        const char* nA = GATHER ? cA : (has_next ? (const char*)g.A + (size_t)nxt.pm * tstep : cA);
        const char* nB = has_next ? (const char*)g.Bt + ((size_t)nxt.e * g.nB + (size_t)nxt.pn * BM) * K * 2 : cB;
        for (int t = 0; t < nt; t += 2) {
            const bool last = (t == nt - 2);
            const char* a1 = cA + (size_t)(t + 1) * kstep;
            const char* a2 = last ? nA : cA + (size_t)(t + 2) * kstep; const char* b2 = last ? nB : cB + (size_t)(t + 2) * kstep;
            const char* a3 = a2 + kstep; const char* b3 = b2 + kstep;
            unsigned wv[2][2];
            if constexpr (GATHER) { wv[0][0] = last ? nvA[0][0] : vA[0][0]; wv[0][1] = last ? nvA[0][1] : vA[0][1]; wv[1][0] = last ? nvA[1][0] : vA[1][0]; wv[1][1] = last ? nvA[1][1] : vA[1][1]; }
            PG8_LDB(B0, 0, 0); PG8_LDB(B1, 0, 1); PG8_SCHED; PG8_LDA(At, 0, 0); PG8_STAGEA(PG8_SA(1, 1), a1, 1, vA);
            PG8_WAIT_V(8); PG8_WAIT_L(0); PG8_BAR; PG8_MMA(0, 0, At, B0); PG8_MMA(0, 1, At, B1); PG8_BAR; PG8_SCHED;
            PG8_LDA(At, 0, 1); PG8_STAGEB(PG8_SB(0, 0), b2); PG8_STAGEB(PG8_SB(0, 1), b2 + hstep); PG8_STAGEA(PG8_SA(0, 0), a2, 0, wv);
            PG8_WAIT_V(8); PG8_WAIT_L(0); PG8_BAR; PG8_MMA(1, 0, At, B0); PG8_MMA(1, 1, At, B1); PG8_BAR; PG8_SCHED;
            PG8_LDB(B0, 1, 0); PG8_LDB(B1, 1, 1); PG8_SCHED; PG8_LDA(At, 1, 0); PG8_STAGEA(PG8_SA(0, 1), a2, 1, wv);
            PG8_WAIT_V(8); PG8_WAIT_L(0); PG8_BAR; PG8_MMA(0, 0, At, B0); PG8_MMA(0, 1, At, B1); PG8_BAR; PG8_SCHED;
            PG8_LDA(At, 1, 1); PG8_STAGEB(PG8_SB(1, 0), b3); PG8_STAGEB(PG8_SB(1, 1), b3 + hstep); PG8_STAGEA(PG8_SA(1, 0), a3, 0, wv);
            PG8_WAIT_V(8); PG8_WAIT_L(0); PG8_BAR; PG8_MMA(1, 0, At, B0); PG8_MMA(1, 1, At, B1); PG8_BAR; PG8_SCHED;
        }
        if (wr == 0) PG8_BAR;
        E(acc, cur, wr, wc, fr, fq);
        if (!has_next) break;
#pragma unroll
        for (int a = 0; a < 2; ++a)
#pragma unroll
            for (int b = 0; b < 2; ++b)
#pragma unroll
                for (int m = 0; m < 4; ++m)
#pragma unroll
                    for (int n = 0; n < 2; ++n) acc[a][b][m][n] = (f32x4){0.f, 0.f, 0.f, 0.f};
        cur = nxt; cB = nB; cA = nA; ++ui;
        if constexpr (GATHER) {
#pragma unroll
        for (int h_ = 0; h_ < 2; ++h_)
#pragma unroll
            for (int i_ = 0; i_ < 2; ++i_) vA[h_][i_] = nvA[h_][i_]; }
        if (wr == 1) PG8_BAR;
    }
    PG8_WAIT_V(0);
    PG8_BAR;
#undef PG8_SA
#undef PG8_SB
#undef PG8_STAGE
#undef PG8_STAGEB
#undef PG8_STAGEA
#undef PG8_LDA
#undef PG8_LDB
#undef PG8_MMA
#undef PG8_WAIT_V
#undef PG8_WAIT_L
#undef PG8_BAR
#undef PG8_SCHED
#undef PG8_AOFF
}
}

namespace pg8 {
struct EpiIn {
    static constexpr bool PERM = true;
    bf16_t *Q, *Kb, *V, *PRW, *GT; float qscale;
    __device__ __forceinline__ void operator()(const f32x4 (&acc)[2][2][4][2], const Unit& u, int wr, int wc, int fr, int fq) const {
        const int pn = u.pn; bf16_t* base; int ld, colt, mode = 0;
        if (pn < 2) { base = Q; ld = 512; colt = pn * 256; mode = 1; }
        else if (pn < 4) { base = Kb; ld = 512; colt = (pn - 2) * 256; }
        else if (pn < 6) { base = V; ld = 512; colt = (pn - 4) * 256; }
        else if (pn < 13) { base = PRW; ld = 1792; colt = (pn - 6) * 256; }
        else { base = GT; ld = 2048; colt = (pn - 13) * 256; mode = 2; }
        const int row0 = u.pm * BM + wr * 64 + fr, col0 = colt + wc * 32 + 8 * fq;
        const float sc = (mode == 1) ? qscale : 1.0f;
#pragma unroll
        for (int ai = 0; ai < 2; ++ai)
#pragma unroll
            for (int m = 0; m < 4; ++m) { bf16_t* rowp = base + (size_t)(row0 + ai * HALF + m * 16) * ld + col0;
#pragma unroll
                for (int bj = 0; bj < 2; ++bj) { f32x4 v0 = acc[ai][bj][m][0] * sc, v1 = acc[ai][bj][m][1] * sc;
                    if (mode == 2) {
#pragma unroll
                        for (int e = 0; e < 4; ++e) { v0[e] = fsigmoid(v0[e]); v1[e] = fsigmoid(v1[e]); } }
                    u32x4 w; w.x = cvt_pk_bf16(v0[0], v0[1]); w.y = cvt_pk_bf16(v0[2], v0[3]); w.z = cvt_pk_bf16(v1[0], v1[1]); w.w = cvt_pk_bf16(v1[2], v1[3]);
                    *(u32x4*)(rowp + bj * HALF) = w; } }
    }
};
template <int MODE> struct EpiGate {
    static constexpr bool PERM = true;
    bf16_t* O; int ldo; const bf16_t* G; int ldg; int gcol0;
    __device__ __forceinline__ void operator()(const f32x4 (&acc)[2][2][4][2], const Unit& u, int wr, int wc, int fr, int fq) const {
        const int row0 = u.pm * BM + wr * 64 + fr, col0 = u.pn * BM + wc * 32 + 8 * fq;
#pragma unroll
        for (int ai = 0; ai < 2; ++ai)
#pragma unroll
            for (int m = 0; m < 4; ++m) { const size_t row = (size_t)(row0 + ai * HALF + m * 16); bf16_t* rowp = O + row * ldo + col0;
#pragma unroll
                for (int bj = 0; bj < 2; ++bj) { f32x4 v0 = acc[ai][bj][m][0], v1 = acc[ai][bj][m][1];
                    if (MODE >= 1) { const u32x4 gw = *(const u32x4*)(G + row * ldg + gcol0 + col0 + bj * HALF);
                        v0[0] *= bf_lo(gw.x); v0[1] *= bf_hi(gw.x); v0[2] *= bf_lo(gw.y); v0[3] *= bf_hi(gw.y); v1[0] *= bf_lo(gw.z); v1[1] *= bf_hi(gw.z); v1[2] *= bf_lo(gw.w); v1[3] *= bf_hi(gw.w); }
                    if (MODE == 2) { const u32x4 ow = *(const u32x4*)(rowp + bj * HALF);
                        v0[0] += bf_lo(ow.x); v0[1] += bf_hi(ow.x); v0[2] += bf_lo(ow.y); v0[3] += bf_hi(ow.y); v1[0] += bf_lo(ow.z); v1[1] += bf_hi(ow.z); v1[2] += bf_lo(ow.w); v1[3] += bf_hi(ow.w); }
                    u32x4 w; w.x = cvt_pk_bf16(v0[0], v0[1]); w.y = cvt_pk_bf16(v0[2], v0[3]); w.z = cvt_pk_bf16(v1[0], v1[1]); w.w = cvt_pk_bf16(v1[2], v1[3]);
                    *(u32x4*)(rowp + bj * HALF) = w; } }
    }
};
struct EpiRes {
    static constexpr bool PERM = true;
    const float* X; bf16_t* O; const float* gate; int seq; int gstride;
    __device__ __forceinline__ void operator()(const f32x4 (&acc)[2][2][4][2], const Unit& u, int wr, int wc, int fr, int fq) const {
        const int row0 = u.pm * BM + wr * 64 + fr, col0 = u.pn * BM + wc * 32 + 8 * fq;
        const float* gp = gate + (size_t)((u.pm * BM) / seq) * gstride + col0;
        f32x4 gv[2][2];
#pragma unroll
        for (int bj = 0; bj < 2; ++bj)
#pragma unroll
            for (int n = 0; n < 2; ++n) gv[bj][n] = *(const f32x4*)(gp + bj * HALF + n * 4);
#pragma unroll
        for (int ai = 0; ai < 2; ++ai)
#pragma unroll
            for (int m = 0; m < 4; ++m) { const size_t off = (size_t)(row0 + ai * HALF + m * 16) * 1024 + col0;
#pragma unroll
                for (int bj = 0; bj < 2; ++bj) { const f32x4 x0 = *(const f32x4*)(X + off + bj * HALF), x1 = *(const f32x4*)(X + off + bj * HALF + 4);
                    const f32x4 v0 = x0 + gv[bj][0] * acc[ai][bj][m][0], v1 = x1 + gv[bj][1] * acc[ai][bj][m][1];
                    u32x4 w; w.x = cvt_pk_bf16(v0[0], v0[1]); w.y = cvt_pk_bf16(v0[2], v0[3]); w.z = cvt_pk_bf16(v1[0], v1[1]); w.w = cvt_pk_bf16(v1[2], v1[3]);
                    *(u32x4*)(O + off + bj * HALF) = w; } }
    }
};
struct EpiSwiGLU {
    static constexpr bool PERM = true;
    bf16_t* H;
    __device__ __forceinline__ void operator()(const f32x4 (&acc)[2][2][4][2], const Unit& u, int wr, int wc, int fr, int fq) const {
        const int row0 = u.pm * BM + wr * 64 + fr, col0 = u.pn * HALF + wc * 32 + 8 * fq;
#pragma unroll
        for (int ai = 0; ai < 2; ++ai)
#pragma unroll
            for (int m = 0; m < 4; ++m) { bf16_t* rowp = H + (size_t)(row0 + ai * HALF + m * 16) * 512 + col0;
                f32x4 v0, v1;
#pragma unroll
                for (int e = 0; e < 4; ++e) { const float a0 = acc[ai][0][m][0][e], a1 = acc[ai][0][m][1][e];
                    v0[e] = a0 * fsigmoid(a0) * acc[ai][1][m][0][e]; v1[e] = a1 * fsigmoid(a1) * acc[ai][1][m][1][e]; }
                u32x4 w; w.x = cvt_pk_bf16(v0[0], v0[1]); w.y = cvt_pk_bf16(v0[2], v0[3]); w.z = cvt_pk_bf16(v1[0], v1[1]); w.w = cvt_pk_bf16(v1[2], v1[3]);
                *(u32x4*)rowp = w; }
    }
};
struct EpiFp8 {
    static constexpr bool PERM = true;
    unsigned char* O; int ldo;
    __device__ __forceinline__ void operator()(const f32x4 (&acc)[2][2][4][2], const Unit& u, int wr, int wc, int fr, int fq) const {
        const int row0 = u.pm * BM + wr * 64 + fr, col0 = u.pn * BM + wc * 32 + 8 * fq;
#pragma unroll
        for (int ai = 0; ai < 2; ++ai)
#pragma unroll
            for (int m = 0; m < 4; ++m) { unsigned char* rowp = O + (size_t)(row0 + ai * HALF + m * 16) * ldo + col0;
#pragma unroll
                for (int bj = 0; bj < 2; ++bj) { const f32x4 v0 = acc[ai][bj][m][0], v1 = acc[ai][bj][m][1];
                    int lo = __builtin_amdgcn_cvt_pk_fp8_f32(v0[0], v0[1], 0, false); lo = __builtin_amdgcn_cvt_pk_fp8_f32(v0[2], v0[3], lo, true);
                    int hi = __builtin_amdgcn_cvt_pk_fp8_f32(v1[0], v1[1], 0, false); hi = __builtin_amdgcn_cvt_pk_fp8_f32(v1[2], v1[3], hi, true);
                    *(u32x2*)(rowp + bj * HALF) = (u32x2){(unsigned)lo, (unsigned)hi}; } }
    }
};
struct MoeOrder {
    int nunits, G, c, cshift; const PG8_LAS int* tile_e;
    __device__ __forceinline__ bool next(int i, Unit& u) const {
        const int L = i * G + c; if (L >= nunits) return false;
        u.pm = L >> cshift; u.pn = L & ((1 << cshift) - 1); u.e = tile_e[u.pm]; return true;
    }
};
}
#include <hip/hip_bf16.h>
#include <cmath>
namespace attn_body {
using bf16=__hip_bfloat16;
using bf16x8=__attribute__((ext_vector_type(8)))short;
using s16x4=__attribute__((ext_vector_type(4)))short;
using f32x16=__attribute__((ext_vector_type(16)))float;
using u32x4=__attribute__((ext_vector_type(4)))unsigned;
constexpr int BATCH=2,NHEAD=8,SEQ=16384,D=64,DM=NHEAD*D;
constexpr int NW=8,QBLK=32,QB=QBLK*NW,KVBLK=64,NQB=SEQ/QB;
constexpr int ATTN_PITCH=DM, ATTN_UNIT_ROWS=QB;
__device__ __forceinline__ int crow(int r,int hi){return (r&3)+8*(r>>2)+4*hi;}
#define SBAR() __builtin_amdgcn_sched_barrier(0)
__device__ __forceinline__ void cmask(f32x16&p0,f32x16&p1,int jb,int qrel,int hi){
  const float NEG=-INFINITY; int x=qrel-64*jb-4*hi; asm volatile("":"+v"(x));
  #pragma unroll
  for(int r=0;r<16;++r){const int c=(r&3)+8*(r>>2); if(c>x)p0[r]=NEG; if(c+32>x)p1[r]=NEG;}
}

constexpr int NSLOT=3, SLOTB=8192;
constexpr int LDS_K=0, LDS_V=NSLOT*SLOTB, LDS_WS=2*NSLOT*SLOTB, LDS_OST=LDS_WS+NW*64*4, LDS_BYTES=LDS_OST+NW*4096;
constexpr float C2=0.125f*1.4426950408889634f;
__device__ __forceinline__ void glds16(const void*gsrc,unsigned lds_dst){unsigned keep;
  asm volatile("s_mov_b32 %0, m0\n\ts_mov_b32 m0, %2\n\ts_nop 0\n\tglobal_load_lds_dwordx4 %1, off\n\ts_mov_b32 m0, %0":"=&s"(keep):"v"(gsrc),"s"(lds_dst):"memory");}
__device__ __forceinline__ float max3f(float a,float b,float c){float r;asm("v_max3_f32 %0, %1, %2, %3":"=v"(r):"v"(a),"v"(b),"v"(c));return r;}
__device__ __forceinline__ float max2f(float a,float b){float r;asm("v_max_f32_e32 %0, %1, %2":"=v"(r):"v"(a),"v"(b));return r;}
__device__ __forceinline__ float fadd_s(float a,float b){float r;asm("v_add_f32_e32 %0, %1, %2":"=v"(r):"v"(a),"v"(b));return r;}
__device__ __forceinline__ float fsub_s(float a,float b){float r;asm("v_sub_f32_e32 %0, %1, %2":"=v"(r):"v"(a),"v"(b));return r;}
typedef float f32x2_t __attribute__((ext_vector_type(2))); typedef __bf16 bf16x2_t __attribute__((ext_vector_type(2)));
__device__ __forceinline__ unsigned cvtpk_s(float lo,float hi){f32x2_t v={lo,hi};bf16x2_t b=__builtin_convertvector(v,bf16x2_t);return __builtin_bit_cast(unsigned,b);}
#define WAIT_BAR(N) asm volatile("s_waitcnt vmcnt(" #N ") lgkmcnt(0)\n\ts_barrier":::"memory")

__device__ __forceinline__ void qkt(f32x16&p0,f32x16&p1,const char*Kslot,const bf16x8*qr,int r32,int hi){
  const char*kb=Kslot+hi*1024+r32*16;
  #pragma unroll
  for(int d0=0;d0<4;++d0){
    const bf16x8 b0=*reinterpret_cast<const bf16x8*>(kb+d0*2048);
    const bf16x8 b1=*reinterpret_cast<const bf16x8*>(kb+d0*2048+512);
    if(d0==0){p0=__builtin_amdgcn_mfma_f32_32x32x16_bf16(b0,qr[0],p0,0,0,0);p1=__builtin_amdgcn_mfma_f32_32x32x16_bf16(b1,qr[0],p1,0,0,0);}
    else{p0=__builtin_amdgcn_mfma_f32_32x32x16_bf16(b0,qr[d0],p0,0,0,0);p1=__builtin_amdgcn_mfma_f32_32x32x16_bf16(b1,qr[d0],p1,0,0,0);}}
}
typedef __attribute__((address_space(3))) const char* lds_cptr;
typedef short v4i16_t __attribute__((ext_vector_type(4)));
__device__ __forceinline__ void kload8(bf16x8*kf,lds_cptr kp){
  kf[0]=*(const __attribute__((address_space(3))) bf16x8*)(kp);      kf[1]=*(const __attribute__((address_space(3))) bf16x8*)(kp+512);
  kf[2]=*(const __attribute__((address_space(3))) bf16x8*)(kp+2048); kf[3]=*(const __attribute__((address_space(3))) bf16x8*)(kp+2560);
  kf[4]=*(const __attribute__((address_space(3))) bf16x8*)(kp+4096); kf[5]=*(const __attribute__((address_space(3))) bf16x8*)(kp+4608);
  kf[6]=*(const __attribute__((address_space(3))) bf16x8*)(kp+6144); kf[7]=*(const __attribute__((address_space(3))) bf16x8*)(kp+6656);
}
__device__ __forceinline__ void kload2(bf16x8*kf,lds_cptr kp,int j){ kf[2*j]=*(const __attribute__((address_space(3))) bf16x8*)(kp+j*2048); kf[2*j+1]=*(const __attribute__((address_space(3))) bf16x8*)(kp+j*2048+512); }
__device__ __forceinline__ s16x4 vtr(lds_cptr p){ return __builtin_bit_cast(s16x4,__builtin_amdgcn_ds_read_tr16_b64_v4i16((__attribute__((address_space(3))) v4i16_t*)p)); }
__device__ __forceinline__ float rowmax(const f32x16&p0,const f32x16&p1){
  float a=max3f(p0[0],p0[1],p1[0]),b=max3f(p0[2],p0[3],p1[1]);a=max3f(a,p1[2],p1[3]);
  #pragma unroll
  for(int r=4;r<16;r+=4){a=max3f(a,p0[r],p0[r+1]);b=max3f(b,p0[r+2],p0[r+3]);a=max3f(a,p1[r],p1[r+1]);b=max3f(b,p1[r+2],p1[r+3]);}
  const float m=max2f(a,b);
  auto rr=__builtin_amdgcn_permlane32_swap(__float_as_uint(m),__float_as_uint(m),false,false);
  return max2f(__uint_as_float(rr[0]),__uint_as_float(rr[1]));
}
__device__ __forceinline__ void pv(f32x16*o,int vb,bf16x8 pa0,bf16x8 pa1,bf16x8 pa2,bf16x8 pa3){
  #pragma unroll
  for(int d0=0;d0<2;++d0){s16x4 lo[4],hi[4];
    #pragma unroll
    for(int ks=0;ks<4;++ks){
      asm volatile("ds_read_b64_tr_b16 %0,%1 offset:%c2":"=&v"(lo[ks]):"v"(vb),"i"(d0*4096+ks*1024):"memory");
      asm volatile("ds_read_b64_tr_b16 %0,%1 offset:%c2":"=&v"(hi[ks]):"v"(vb),"i"(d0*4096+ks*1024+512):"memory");}
    asm volatile("s_waitcnt lgkmcnt(0)":::"memory");SBAR();
    #define PK(k) (bf16x8){lo[k][0],lo[k][1],lo[k][2],lo[k][3],hi[k][0],hi[k][1],hi[k][2],hi[k][3]}
    o[d0]=__builtin_amdgcn_mfma_f32_32x32x16_bf16(pa0,PK(0),o[d0],0,0,0);
    o[d0]=__builtin_amdgcn_mfma_f32_32x32x16_bf16(pa1,PK(1),o[d0],0,0,0);
    o[d0]=__builtin_amdgcn_mfma_f32_32x32x16_bf16(pa2,PK(2),o[d0],0,0,0);
    o[d0]=__builtin_amdgcn_mfma_f32_32x32x16_bf16(pa3,PK(3),o[d0],0,0,0);
    #undef PK
  }
}

#ifndef ATTN_STORE16
#define ATTN_STORE16(p,v) (*(u32x4*)(p)=(v))
#endif
typedef float f32x4_t __attribute__((ext_vector_type(4)));
#define NBLD(dst,off) dst=*(const __attribute__((address_space(3))) f32x4_t*)(tbn_+(off))
#define NBSUB(P,b,src) do{ P[(b)]=nmn_-src[0]; P[(b)+1]=nmn_-src[1]; P[(b)+2]=nmn_-src[2]; P[(b)+3]=nmn_-src[3]; }while(0)
#define NEXTB(P0,P1,tt) do{ const __attribute__((address_space(3))) float* tb_=tab3+(tt)*64+4*hi; const float nm_=-mhat; \
  _Pragma("unroll") for(int g_=0;g_<4;++g_){ const f32x4_t b0_=*(const __attribute__((address_space(3))) f32x4_t*)(tb_+8*g_); const f32x4_t b1_=*(const __attribute__((address_space(3))) f32x4_t*)(tb_+32+8*g_); \
    _Pragma("unroll") for(int j_=0;j_<4;++j_){ P0[4*g_+j_]=nm_-b0_[j_]; P1[4*g_+j_]=nm_-b1_[j_]; } } }while(0)
template<int THRL> __device__ __forceinline__ void attn_unit(int b,int h,int qb,int t0,const bf16*Q,const bf16*__restrict__ K,const bf16*__restrict__ V,bf16*O,const float*__restrict__ cumT,char*shm,int tab_off,int segp_off,unsigned*qctr){
  const int tid=threadIdx.x,lane=tid&63,r32=lane&31,hi=lane>>5; const int wid=__builtin_amdgcn_readfirstlane(tid>>6);
  const long rowbase=(long)b*SEQ; const int q0=qb*QB;
  const bf16*Qw=Q+(rowbase+q0+wid*QBLK)*DM+h*D;
  const bf16*Kh=K+(rowbase+(long)t0*KVBLK)*DM+h*D,*Vh=V+(rowbase+(long)t0*KVBLK)*DM+h*D;
  const unsigned lds0=(unsigned)(uintptr_t)shm;
  float*wsf=(float*)(shm+LDS_WS)+wid*64;
  const bf16*ksrc=Kh+(long)lane*DM+wid*8;
  const bf16*vsrc=Vh+(long)(16*(wid&3)+(lane>>2))*DM+(wid>>2)*32+(lane&3)*8;
  const unsigned kdst=lds0+LDS_K+wid*1024, vdst=lds0+LDS_V+wid*1024;
  #define DMA_K(t,slot) glds16(ksrc+(long)(t)*KVBLK*DM,(unsigned)__builtin_amdgcn_readfirstlane(kdst+(slot)))
  #define DMA_V(t,slot) glds16(vsrc+(long)(t)*KVBLK*DM,(unsigned)__builtin_amdgcn_readfirstlane(vdst+(slot)))
  const int vb0=(int)(lds0+LDS_V)+((lane>>4)&1)*32+(lane&3)*8+(4*hi+((lane&15)>>2))*64;
  const char*Kbase=shm+LDS_K; bf16x8 kf[8];
  const lds_cptr shm3=(lds_cptr)shm; const lds_cptr kp0=shm3+LDS_K+hi*1024+r32*16; const lds_cptr vp0=shm3+LDS_V+((lane>>4)&1)*32+(lane&3)*8+(4*hi+((lane&15)>>2))*64;
  const int NT=(q0+QB)/KVBLK-t0;
  const __attribute__((address_space(3))) float* tab3=(const __attribute__((address_space(3))) float*)(shm3+tab_off);
  { int tl_=threadIdx.x; asm volatile("":"+v"(tl_));
    float*tabw=(float*)(shm+tab_off); const float L2E=1.4426950408889634f;
    const float*cg=cumT+((long)(b*NHEAD+h))*SEQ; const float cref=cg[q0]*L2E;
    for(int i=tl_;i<NT*KVBLK;i+=NW*64){ const int kv=t0*KVBLK+i; tabw[i]=cg[kv]*L2E-cref; }
    asm volatile("s_waitcnt vmcnt(0) lgkmcnt(0)\n\ts_barrier":::"memory"); }
  DMA_K(0,0);DMA_V(0,0);DMA_K(1,SLOTB);
  bf16x8 qr[4];
  #pragma unroll
  for(int d0=0;d0<4;++d0)qr[d0]=*reinterpret_cast<const bf16x8*>(&Qw[(long)r32*DM+d0*16+hi*8]);
  float mhat=0.f,l_reg=0.f;f32x16 o[2];o[0]=f32x16{};o[1]=f32x16{};
  const int qrel=wid*QBLK+r32;
  #define CMASK(P0,P1,t) do{int jb_=(t)-(NT-4); if(jb_>=0)cmask(P0,P1,jb_,qrel,hi);}while(0)
  bool resc=false;
  #define START(P0,P1) do{ const float rm=rowmax(P0,P1); resc=false; \
    { const float dl=rm; mhat=fadd_s(mhat,dl); \
      _Pragma("unroll") for(int r=0;r<16;++r){P0[r]=fsub_s(P0[r],dl);P1[r]=fsub_s(P1[r],dl);} \
      } \
    _Pragma("unroll") for(int r=0;r<16;++r)P0[r]=__builtin_amdgcn_exp2f(P0[r]); }while(0)
  #define RESC() do{ if(resc){ asm volatile("s_waitcnt lgkmcnt(0)":::"memory"); \
      _Pragma("unroll") for(int d_=0;d_<2;++d_) _Pragma("unroll") for(int r=0;r<16;++r)o[d_][r]*=wsf[crow(r,hi)]; } }while(0)
  f32x16 pA0,pA1,pB0,pB1;
  int sl_prev=0,sl_cur=0,sl_next=SLOTB;
  #define ROT() do{sl_prev=sl_cur;sl_cur=sl_next;sl_next=(sl_next==(NSLOT-1)*SLOTB)?0:sl_next+SLOTB;}while(0)
  DMA_K(2,2*SLOTB);
  WAIT_BAR(3);
  NEXTB(pA0,pA1,0);
  qkt(pA0,pA1,Kbase,qr,r32,hi);asm volatile("s_nop 15\n\ts_nop 7":"+v"(pA0),"+v"(pA1));CMASK(pA0,pA1,0);
  START(pA0,pA1);
  NEXTB(pB0,pB1,1);
  _Pragma("unroll") for(int r=0;r<16;++r)pA1[r]=__builtin_amdgcn_exp2f(pA1[r]);
  WAIT_BAR(0);
  DMA_K(3,0);DMA_V(1,SLOTB);
  ROT();
  kload8(kf,kp0+sl_cur);
  WAIT_BAR(2);
  s16x4 vlo[8],vhi[8]; u32x4 pw0,pw1,pw2,pw3;
  #define PKW(P,B) cvtpk_s(P[B],P[B+1])
  #define PAF(k) __builtin_bit_cast(bf16x8,pw##k)
  #define VFR(i) (bf16x8){vlo[i][0],vlo[i][1],vlo[i][2],vlo[i][3],vhi[i][0],vhi[i][1],vhi[i][2],vhi[i][3]}
  #define PIN(x) asm volatile("":"+v"(x))
  #define MX3(a,b,c) __builtin_fmaxf(__builtin_fmaxf((a),(b)),(c))
  #define GAPA(MF,A0,A1,A2,A3,W0,W1,PW) do{ MF; sacc+=A0; sacc+=A1; sacc+=A2; sacc+=A3; PIN(sacc); W0; W1; PIN(PW); SBAR(); }while(0)
  #define EX(v) __builtin_amdgcn_exp2f(v)
  #define GAPB(MF,X,B) do{ MF; X[B]=EX(X[B]); X[B+1]=EX(X[B+1]); X[B+2]=EX(X[B+2]); X[B+3]=EX(X[B+3]); PIN(X); SBAR(); }while(0)
  #define VRD(i) do{ vlo[i]=vtr(vp_+(((i)>>2)*4096+((i)&3)*1024)); vhi[i]=vtr(vp_+(((i)>>2)*4096+((i)&3)*1024+512)); }while(0)
  #define KRD(G,j) do{ if(G){ kload2(kf,kp0+sl_next,j); SBAR(); } }while(0)
  #define STEP(C0,C1,P0,P1,t,GK,GV,GL) do{ SBAR(); \
    const lds_cptr vp_=vp0+sl_prev; \
    VRD(0); SBAR(); float sacc=(P0[0]+P0[1]); \
    GAPA(C0=__builtin_amdgcn_mfma_f32_32x32x16_bf16(kf[0],qr[0],C0,0,0,0), P0[2],P0[3],P0[4],P0[5],     pw0[0]=PKW(P0,0), pw0[1]=PKW(P0,2), pw0); \
    VRD(4); SBAR(); GAPA(C1=__builtin_amdgcn_mfma_f32_32x32x16_bf16(kf[1],qr[0],C1,0,0,0), P0[6],P0[7],P0[8],P0[9],     pw0[2]=PKW(P0,4), pw0[3]=PKW(P0,6), pw0); \
    VRD(1); SBAR(); GAPA(C0=__builtin_amdgcn_mfma_f32_32x32x16_bf16(kf[2],qr[1],C0,0,0,0),   P0[10],P0[11],P0[12],P0[13], pw1[0]=PKW(P0,8), pw1[1]=PKW(P0,10), pw1); \
    VRD(5); SBAR(); GAPA(C1=__builtin_amdgcn_mfma_f32_32x32x16_bf16(kf[3],qr[1],C1,0,0,0),   P0[14],P0[15],P1[0],P1[1],   pw1[2]=PKW(P0,12),pw1[3]=PKW(P0,14), pw1); \
    VRD(2); SBAR(); GAPA(C0=__builtin_amdgcn_mfma_f32_32x32x16_bf16(kf[4],qr[2],C0,0,0,0),   P1[2],P1[3],P1[4],P1[5],     pw2[0]=PKW(P1,0), pw2[1]=PKW(P1,2), pw2); \
    VRD(6); SBAR(); GAPA(C1=__builtin_amdgcn_mfma_f32_32x32x16_bf16(kf[5],qr[2],C1,0,0,0),   P1[6],P1[7],P1[8],P1[9],     pw2[2]=PKW(P1,4), pw2[3]=PKW(P1,6), pw2); \
    VRD(3); SBAR(); GAPA(C0=__builtin_amdgcn_mfma_f32_32x32x16_bf16(kf[6],qr[3],C0,0,0,0),   P1[10],P1[11],P1[12],P1[13], pw3[0]=PKW(P1,8), pw3[1]=PKW(P1,10), pw3); \
    VRD(7); SBAR(); GAPA(C1=__builtin_amdgcn_mfma_f32_32x32x16_bf16(kf[7],qr[3],C1,0,0,0),   P1[14],P1[15],0.f,0.f,       pw3[2]=PKW(P1,12),pw3[3]=PKW(P1,14), pw3); \
    l_reg+=sacc; \
    if(GK){DMA_K((t)+3,sl_cur);} if(GV){DMA_V((t)+1,sl_next);} \
    CMASK(C0,C1,t); \
    { float a=MX3(C0[0],C0[1],C1[0]),b=MX3(C0[2],C0[3],C1[1]); a=MX3(a,C1[2],C1[3]); \
      _Pragma("unroll") for(int r=4;r<16;r+=4){a=MX3(a,C0[r],C0[r+1]);b=MX3(b,C0[r+2],C0[r+3]);a=MX3(a,C1[r],C1[r+1]);b=MX3(b,C1[r+2],C1[r+3]);} \
      float rm=__builtin_fmaxf(a,b); { auto rr=__builtin_amdgcn_permlane32_swap(__float_as_uint(rm),__float_as_uint(rm),false,false); rm=__builtin_fmaxf(__uint_as_float(rr[0]),__uint_as_float(rr[1])); } \
      resc=false; \
      if(__builtin_expect(__any(rm>(float)THRL),0)){ const float dl=__builtin_fmaxf(rm,0.f); mhat+=dl; \
        _Pragma("unroll") for(int r=0;r<16;++r){C0[r]-=dl;C1[r]-=dl;} \
        const float f=__builtin_amdgcn_exp2f(-dl); l_reg*=f; if(hi==0)wsf[r32]=f; resc=true; } } \
      \
    const __attribute__((address_space(3))) float* tbn_=tab3+((t)+1)*64+4*hi; const float nmn_=-mhat; f32x4_t nbA_,nbB_; \
    SBAR(); \
    if(GL){NBLD(nbA_,0);} GAPB(o[0]=__builtin_amdgcn_mfma_f32_32x32x16_bf16(PAF(0),VFR(0),o[0],0,0,0), C0,0); \
    if(GL){NBLD(nbB_,8); NBSUB(P0,0,nbA_);} GAPB(o[1]=__builtin_amdgcn_mfma_f32_32x32x16_bf16(PAF(0),VFR(4),o[1],0,0,0), C0,4); \
    if(GL){NBLD(nbA_,16); NBSUB(P0,4,nbB_);} KRD(GL,0); GAPB(o[0]=__builtin_amdgcn_mfma_f32_32x32x16_bf16(PAF(1),VFR(1),o[0],0,0,0), C0,8); \
    if(GL){NBLD(nbB_,24); NBSUB(P0,8,nbA_);} KRD(GL,1); GAPB(o[1]=__builtin_amdgcn_mfma_f32_32x32x16_bf16(PAF(1),VFR(5),o[1],0,0,0), C0,12); \
    if(GL){NBLD(nbA_,32); NBSUB(P0,12,nbB_);} KRD(GL,2); GAPB(o[0]=__builtin_amdgcn_mfma_f32_32x32x16_bf16(PAF(2),VFR(2),o[0],0,0,0), C1,0); \
    if(GL){NBLD(nbB_,40); NBSUB(P1,0,nbA_);} KRD(GL,3); GAPB(o[1]=__builtin_amdgcn_mfma_f32_32x32x16_bf16(PAF(2),VFR(6),o[1],0,0,0), C1,4); \
    if(GL){NBLD(nbA_,48); NBSUB(P1,4,nbB_);} GAPB(o[0]=__builtin_amdgcn_mfma_f32_32x32x16_bf16(PAF(3),VFR(3),o[0],0,0,0), C1,8); \
    if(GL){NBLD(nbB_,56); NBSUB(P1,8,nbA_);} GAPB(o[1]=__builtin_amdgcn_mfma_f32_32x32x16_bf16(PAF(3),VFR(7),o[1],0,0,0), C1,12); \
    if(GL){NBSUB(P1,12,nbB_);} \
    }while(0)
  int t=1;
  #undef CMASK
  #define CMASK(P0,P1,t) do{}while(0)
  for(;t+5<NT;t+=2){
    STEP(pB0,pB1,pA0,pA1,t,true,true,true);     WAIT_BAR(2); RESC(); ROT();
    STEP(pA0,pA1,pB0,pB1,t+1,true,true,true);   WAIT_BAR(2); RESC(); ROT();
  }
  #undef CMASK
  #define CMASK(P0,P1,t) do{int jb_=(t)-(NT-4); if(jb_>=0)cmask(P0,P1,jb_,qrel,hi);}while(0)
  #define ENDW(tt) do{ if((tt)+3<NT){WAIT_BAR(2);} else if((tt)+2<NT){WAIT_BAR(1);} else {WAIT_BAR(0);} }while(0)
  for(;t+1<NT;t+=2){
    STEP(pB0,pB1,pA0,pA1,t,(t+3<NT),(t+1<NT),(t+1<NT));       ENDW(t);   RESC(); ROT();
    STEP(pA0,pA1,pB0,pB1,t+1,(t+4<NT),(t+2<NT),(t+2<NT));     ENDW(t+1); RESC(); ROT();
  }
  STEP(pB0,pB1,pA0,pA1,NT-1,false,false,false); RESC();
  { float sacc=pB0[0]+pB0[1]; _Pragma("unroll") for(int r=2;r<16;++r)sacc+=pB0[r]; _Pragma("unroll") for(int r=0;r<16;++r)sacc+=pB1[r]; l_reg+=sacc;
    pw0=(u32x4){PKW(pB0,0),PKW(pB0,2),PKW(pB0,4),PKW(pB0,6)};pw1=(u32x4){PKW(pB0,8),PKW(pB0,10),PKW(pB0,12),PKW(pB0,14)};pw2=(u32x4){PKW(pB1,0),PKW(pB1,2),PKW(pB1,4),PKW(pB1,6)};pw3=(u32x4){PKW(pB1,8),PKW(pB1,10),PKW(pB1,12),PKW(pB1,14)};
    SBAR(); pv(o,vb0+sl_cur,PAF(0),PAF(1),PAF(2),PAF(3)); }
  #undef PKW
  #undef PAF
  #undef VFR
  #undef PIN
  #undef MX3
  #undef GAPA
  #undef GAPB
  #undef EX
  #undef VRD
  #undef KRD
  #undef STEP
  #undef ENDW
  {auto rr=__builtin_amdgcn_permlane32_swap(__float_as_uint(l_reg),__float_as_uint(l_reg),false,false);l_reg=__uint_as_float(rr[0])+__uint_as_float(rr[1]);}
  int un_=0; if(threadIdx.x==0)un_=(int)__hip_atomic_fetch_add(qctr,1u,__ATOMIC_RELAXED,__HIP_MEMORY_SCOPE_AGENT);
  int lane_e=threadIdx.x&63; asm volatile("":"+v"(lane_e));
  const int r32e=lane_e&31,hie=lane_e>>5;
  if(hie==0)wsf[32+r32e]=l_reg;asm volatile("s_waitcnt lgkmcnt(0)":::"memory");
  float rli[16];
  #pragma unroll
  for(int r=0;r<16;++r)rli[r]=__builtin_amdgcn_rcpf(wsf[32+crow(r,hie)]);
  bf16*Ow=O+(rowbase+q0+wid*QBLK)*DM+h*D;
  { bf16*stg=(bf16*)(shm+LDS_OST)+wid*2048;
    #pragma unroll
    for(int r=0;r<16;++r){const int orow=crow(r,hie);
      #pragma unroll
      for(int d0=0;d0<2;++d0)stg[orow*64+d0*32+r32e]=__float2bfloat16(o[d0][r]*rli[r]);}
    asm volatile("s_waitcnt lgkmcnt(0)":::"memory");
    #pragma unroll
    for(int i=0;i<4;++i){const int row=i*8+(lane_e>>3),ch=lane_e&7; const u32x4 v=*(const u32x4*)(stg+row*64+ch*8); ATTN_STORE16(Ow+(long)row*DM+ch*8,v);} }
  if(threadIdx.x==0)*(volatile int*)(shm+segp_off)=un_;
  asm volatile("s_waitcnt lgkmcnt(0)\n\ts_barrier":::"memory");
  #undef DMA_K
  #undef DMA_V
  #undef CMASK
  #undef START
  #undef RESC
  #undef ROT
}
constexpr int ATTN_LDS_BYTES=LDS_BYTES;
struct AttnTensors { const bf16* Q; const bf16* K; const bf16* V; bf16* O; const float* cumT; const float* segtot; };
struct AttnUnit { int bh; int qb; };
struct StaticOrder {
  int vcu;
  __device__ __forceinline__ explicit StaticOrder(int grid,int block):vcu((block%8)*(grid/8)+block/8){}
  __device__ __forceinline__ bool next(int i,AttnUnit&u)const{ if(i>=4||vcu>=256)return false; const int s=vcu&15; u.bh=vcu>>4; u.qb=(i==0)?63-s:(i==1)?32+s:(i==2)?31-s:s; return true; }
  __device__ __forceinline__ void a_ready(const AttnUnit&)const{}
  __device__ __forceinline__ void done(const AttnUnit&)const{}
};
constexpr float PRUNE_THR=20.0f;
template<int THRL=8> __device__ __forceinline__ void attn_phase_dyn(char*lds,const AttnTensors&T,unsigned*ctr,const unsigned*qkmax,const unsigned*ktmax,int tab_off,int segp_off){
  volatile int*slot=(volatile int*)(lds+segp_off);
  __syncthreads();
  if(threadIdx.x==0)slot[0]=(int)__hip_atomic_fetch_add(ctr,1u,__ATOMIC_RELAXED,__HIP_MEMORY_SCOPE_AGENT);
  __syncthreads();
  for(;;){
    int tid=threadIdx.x; asm volatile("":"+v"(tid));
    const int u=slot[0]; if(u>=BATCH*NHEAD*NQB)break;
    const int bh=u&15, qb=(NQB-1)-(u>>4), b=bh/NHEAD, h=bh%NHEAD, q0=qb*QB;
    const float qm=__uint_as_float(qkmax[bh*2]), km=__uint_as_float(qkmax[bh*2+1]);
    const float L2E=1.4426950408889634f; const float*cg=T.cumT+((long)(b*NHEAD+h))*SEQ;
    const float cgk=cg[(tid<4*qb)?64*tid+63:q0], cg0=cg[q0];
    const float kt2=__uint_as_float(ktmax[bh*256+((tid<4*qb)?tid:0)]);
    float dg, qg;
    { const int row=tid>>1, hf=tid&1; const long ro=((long)b*SEQ+q0+row)*DM+h*D+32*hf; const u32x4*qp=(const u32x4*)(T.Q+ro); const u32x4*kp=(const u32x4*)(T.K+ro); float d=0.f, qq=0.f;
      #pragma unroll
      for(int c4=0;c4<4;++c4){ const u32x4 qa=qp[c4], ka=kp[c4];
        #pragma unroll
        for(int e=0;e<4;++e){ const float q0_=__uint_as_float(qa[e]<<16), q1_=__uint_as_float(qa[e]&0xffff0000u); d+=q0_*__uint_as_float(ka[e]<<16)+q1_*__uint_as_float(ka[e]&0xffff0000u); qq+=q0_*q0_+q1_*q1_; } }
      d+=__shfl_xor(d,1); qq+=__shfl_xor(qq,1);
      #pragma unroll
      for(int o=2;o<64;o<<=1){ d=fminf(d,__shfl_xor(d,o)); qq=fmaxf(qq,__shfl_xor(qq,o)); }
      dg=d; qg=qq; }
    float*slotf=(float*)(lds+segp_off)+16;
    if((tid&63)==0){ slotf[tid>>6]=dg; slotf[8+(tid>>6)]=qg; }
    __syncthreads();
    float dmin=slotf[0], qmu=slotf[8];
    #pragma unroll
    for(int w=1;w<NW;++w){ dmin=fminf(dmin,slotf[w]); qmu=fmaxf(qmu,slotf[8+w]); }
    (void)qm; (void)km;
    const float X=PRUNE_THR+sqrtf(qmu*kt2)-dmin+1.5f;
    const bool keep=(tid<4*qb)&&!((cgk-cg0)*L2E>X);
    const unsigned long long bal=__ballot(keep); if((tid&63)==0)slot[1+(tid>>6)]=bal?((tid>>6)*64+(int)__builtin_ctzll(bal)):4*qb;
    __syncthreads();
    int t0=4*qb;
    #pragma unroll
    for(int w=0;w<NW;++w){ const int f_=slot[1+w]; t0=f_<t0?f_:t0; }
    t0&=~1;
    attn_unit<THRL>(b,h,qb,t0,T.Q,T.K,T.V,T.O,T.cumT,lds,tab_off,segp_off,ctr);
  }
}
#undef SBAR
#undef WAIT_BAR
}
#define GAS __attribute__((address_space(1)))
#define LAS __attribute__((address_space(3)))
typedef unsigned short bf16;
typedef unsigned v4u __attribute__((ext_vector_type(4)));
typedef float f32x4 __attribute__((ext_vector_type(4)));
typedef short bf16x8 __attribute__((ext_vector_type(8)));
typedef GAS unsigned gu32;
typedef GAS unsigned long long gu64;
#define RLX_AGENT __ATOMIC_RELAXED, __HIP_MEMORY_SCOPE_AGENT
#define LDS_WAIT() asm volatile("s_waitcnt lgkmcnt(0)" ::: "memory")
#define VM_WAIT() asm volatile("s_waitcnt vmcnt(0)" ::: "memory")
__device__ __forceinline__ unsigned long long rt() { return __builtin_amdgcn_s_memrealtime(); }
typedef float pk_f32x2 __attribute__((ext_vector_type(2))); typedef __bf16 pk_bf16x2 __attribute__((ext_vector_type(2)));
__device__ __forceinline__ unsigned pk2(float lo, float hi) { pk_f32x2 v = {lo, hi}; pk_bf16x2 b = __builtin_convertvector(v, pk_bf16x2); return __builtin_bit_cast(unsigned, b); }
__device__ __forceinline__ unsigned f2bf(float f) { return pk2(f, 0.f) & 0xffffu; }

#define XB_TMO      128
#define XB_XCNT(j)  (256  + 64 * (j))
#define XB_XSUB(j)  (1280 + 64 * (j))
#define XB_XGEN(j)  (2304 + 64 * (j))
#define XB_TOP      3328
#define XB_TOPGEN   3392
#define XCD_BAR_WORDS 3456
#define XB_SPIN_CAP (1u << 18)

__device__ __forceinline__ unsigned xb_ld(unsigned* p)              { return __hip_atomic_load(p, __ATOMIC_RELAXED, __HIP_MEMORY_SCOPE_AGENT); }
__device__ __forceinline__ unsigned xb_add(unsigned* p, unsigned v) { return __hip_atomic_fetch_add(p, v, __ATOMIC_RELAXED, __HIP_MEMORY_SCOPE_AGENT); }
__device__ __forceinline__ unsigned xb_xcc_id() { return (unsigned)__builtin_amdgcn_s_getreg((3 << 11) | 20) & 0xFu; }
#define XB_SPIN(cond, bar) do { unsigned _sp = 0; while (cond) { __builtin_amdgcn_s_sleep(1); \
    if ((++_sp & 255u) == 0u) { if (xb_ld(&(bar)[XB_TMO])) break; if (_sp > XB_SPIN_CAP) { atomicAdd(&(bar)[XB_TMO], 1u); break; } } } } while (0)

struct XcdBarrier {
    unsigned* bar; unsigned x;
    volatile LAS unsigned* st;
};

__device__ __forceinline__ XcdBarrier xcd_barrier_post(unsigned* bar, volatile LAS unsigned* st) {
    XcdBarrier b; b.bar = bar; b.x = xb_xcc_id(); b.st = st;
    if (threadIdx.x == 0) (void)xb_add(&bar[XB_XCNT(b.x)], 1u);
    return b;
}
__device__ __forceinline__ void xcd_barrier_complete(unsigned* bar, unsigned x, unsigned& nloc, unsigned& nx) {
    const unsigned G = gridDim.x * gridDim.y * gridDim.z;
    unsigned sum, cnt, mine, sp = 0u;
    for (;;) {
        sum = 0u; cnt = 0u; mine = 0u;
#pragma unroll
        for (unsigned j = 0; j < 16; ++j) { const unsigned c = xb_ld(&bar[XB_XCNT(j)]); sum += c; cnt += (c > 0u) ? 1u : 0u; mine = (j == x) ? c : mine; }
        if (sum == G) break;
        __builtin_amdgcn_s_sleep(1);
        if ((++sp & 255u) == 0u) { if (xb_ld(&bar[XB_TMO])) break; if (sp > XB_SPIN_CAP) { atomicAdd(&bar[XB_TMO], 1u); break; } }
    }
    nloc = mine > 0u ? mine : 1u; nx = cnt > 0u ? cnt : 1u;
}

__device__ __forceinline__ void xcd_barrier(const XcdBarrier& b) {
    asm volatile("s_waitcnt vmcnt(0)" ::: "memory");
    __syncthreads();
    if (threadIdx.x == 0) {
        unsigned* bar = b.bar;
        __builtin_amdgcn_s_waitcnt(0);
        unsigned nloc = b.st[0], nx = b.st[1];
        if (nloc == 0u) { xcd_barrier_complete(bar, b.x, nloc, nx); b.st[0] = nloc; b.st[1] = nx; }
        const unsigned old = xb_add(&bar[XB_XSUB(b.x)], 1u);
        const unsigned gen = old / nloc;
        if (old + 1u == (gen + 1u) * nloc) {
            __builtin_amdgcn_fence(__ATOMIC_RELEASE, "agent");
            asm volatile("s_waitcnt vmcnt(0)" ::: "memory");
            const unsigned og = xb_add(&bar[XB_TOP], 1u);
            const unsigned tg = og / nx;
            if (og + 1u == (tg + 1u) * nx) xb_add(&bar[XB_TOPGEN], 1u);
            else XB_SPIN(xb_ld(&bar[XB_TOPGEN]) == tg, bar);
            __builtin_amdgcn_fence(__ATOMIC_ACQUIRE, "agent");
            xb_add(&bar[XB_XGEN(b.x)], 1u);
            asm volatile("s_waitcnt vmcnt(0)" ::: "memory");
        } else {
            XB_SPIN(xb_ld(&bar[XB_XGEN(b.x)]) == gen, bar);
            __builtin_amdgcn_fence(__ATOMIC_ACQUIRE, "agent");
            asm volatile("s_waitcnt vmcnt(0)" ::: "memory");
        }
    }
    __syncthreads();
}

constexpr int NWAVES = 8;
constexpr int BATCH = 2, SEQ = 16384, D = 1024, M = BATCH * SEQ;
constexpr int FH = 8, FW = 512, RWW = 512, SHW = 1792, DIN = 5384, NIN = 5376;
constexpr int NE = 32, DE = 512, NROUTE = 36;
constexpr int MAXSLOT = 2 * M + NE * 256;
constexpr int MAXTILE = MAXSLOT / 256;
constexpr float ATT_C2 = 0.125f * 1.4426950408889634f;

constexpr size_t MiB = 1u << 20;
constexpr size_t WS_CTL = 0, CTL_ZERO_BYTES = 1 * MiB;
constexpr size_t WS_MOD = 1 * MiB;
constexpr size_t WS_SEGTOT = 1 * MiB + 64 * 1024;
constexpr size_t WS_BLKCNT = 1 * MiB + 96 * 1024;
constexpr size_t WS_WIN = 2 * MiB;
constexpr size_t WS_WOF = 13 * MiB, WS_WOR = 14 * MiB, WS_WO = 15 * MiB;
constexpr size_t WS_LW2 = 17 * MiB, WS_LA2 = 17 * MiB + 64 * 1024, WS_LG2 = 17 * MiB + 128 * 1024;
constexpr size_t WS_CUM = 18 * MiB;
constexpr size_t WS_ROUTE = 19 * MiB;
constexpr size_t WS_ROWTOK = 20 * MiB;
constexpr size_t WS_BON = 21 * MiB;
constexpr size_t WS_XN = 24 * MiB;
constexpr size_t WS_Q = 88 * MiB, WS_K = 120 * MiB, WS_V = 152 * MiB;
constexpr size_t WS_PRW = 184 * MiB;
constexpr size_t WS_GATES = 296 * MiB;
constexpr size_t WS_F = 424 * MiB;
constexpr size_t WS_END = 512 * MiB;
constexpr size_t WS_Y = WS_K;
constexpr size_t WS_H = WS_Q;
constexpr size_t WS_W13 = WS_PRW, WS_W2T = WS_PRW + 64 * MiB;
constexpr size_t WS_TMP = WS_PRW;
constexpr size_t WS_YM = 280 * MiB;
constexpr size_t WS_X1 = 424 * MiB;
static_assert(WS_YM + (size_t)MAXSLOT * 1024 * 2 <= WS_END, "ws map");
static_assert(WS_H + (size_t)MAXSLOT * 512 * 2 <= WS_PRW, "ws map");
constexpr int CW_TMO = 0, CW_CODE = 1;
constexpr int CW_BAR = 4096;
constexpr int CW_QKMAX = 8192;
constexpr int CW_QUEUE = 8448;
constexpr int CW_KTMAX = 12288;
constexpr int CW_DIAG = 8704;

constexpr int RING_OFF = 0, RING_BYTES = 131072;
constexpr int TAB_OFF = 83968;
constexpr int SEGP_OFF = TAB_OFF + 65536;
constexpr int TILE_OFF = 131072;
constexpr int LDSCTL_OFF = SEGP_OFF + 512, MISC_OFF = LDSCTL_OFF + 320;
constexpr int LDS_BYTES = LDSCTL_OFF + 512;
static_assert(attn_body::LDS_BYTES <= TAB_OFF, "attention LDS");


#define PHASE_IDS() int tid_ = threadIdx.x; asm volatile("" : "+v"(tid_)); const int lane_ = tid_ & 63; const int wave_ = __builtin_amdgcn_readfirstlane(tid_ >> 6); (void)lane_; (void)wave_
struct Frame {
    LAS unsigned char* lds;
    volatile LAS unsigned* MISC;
    gu32* ctl;
    int tid, lane, wave;
    int vcu, G;
    const float* const* in;
};
template <int CTRL> __device__ __forceinline__ float dpp_f(float v) { return __int_as_float(__builtin_amdgcn_mov_dpp(__float_as_int(v), CTRL, 0xf, 0xf, true)); }
__device__ __forceinline__ float row_sum16(float v) { v += dpp_f<0xB1>(v); v += dpp_f<0x4E>(v); v += dpp_f<0x141>(v); v += dpp_f<0x140>(v); return v; }
__device__ __forceinline__ float wave_sum(float v) { v = row_sum16(v); v += __shfl_xor(v, 16); v += __shfl_xor(v, 32); return v; }
__device__ __forceinline__ float bflo(unsigned w) { return __uint_as_float(w << 16); }
__device__ __forceinline__ float bfhi(unsigned w) { return __uint_as_float(w & 0xffff0000u); }
__device__ __forceinline__ float sigm(float x) { return 1.0f / (1.0f + __expf(-x)); }

__device__ __forceinline__ void transpose_item(const float* W, int ld, int col, int k0, int K, bf16* WT, size_t drow, LAS float* scr, int lane) {
#pragma unroll 8
    for (int i = 0; i < 32; ++i) { const int kk = 2 * i + (lane >> 5); scr[kk * 33 + (lane & 31)] = W[(size_t)(k0 + kk) * ld + col + (lane & 31)]; }
    LDS_WAIT(); asm volatile("" ::: "memory");
    const int c = lane & 7;
#pragma unroll
    for (int j = 0; j < 4; ++j) { const int n = (lane >> 3) + 8 * j; const LAS float* s = scr + (8 * c) * 33 + n;
        v4u o; o.x = pk2(s[0 * 33], s[1 * 33]); o.y = pk2(s[2 * 33], s[3 * 33]); o.z = pk2(s[4 * 33], s[5 * 33]); o.w = pk2(s[6 * 33], s[7 * 33]);
        *(GAS v4u*)(WT + (drow + n) * K + k0 + 8 * c) = o; }
    LDS_WAIT(); asm volatile("" ::: "memory");
}
__device__ __forceinline__ void conv_seg(Frame& F, const float* W, int ld, int col0, int K, int ncols, bf16* WT, size_t drow0) {
    PHASE_IDS();
    LAS float* scr = (LAS float*)(F.lds + RING_OFF + wave_ * 16384);
    const int gw = F.vcu * NWAVES + wave_, NGW = F.G * NWAVES, nkb = K / 64, nnb = ncols / 32;
    for (int it = gw; it < nkb * nnb; it += NGW) { const int kb = it / nnb, nb = it % nnb; transpose_item(W, ld, col0 + 32 * nb, 64 * kb, K, WT, drow0 + 32 * nb, scr, lane_); }
}

struct Args { const float* in[30]; float* out; unsigned char* ws; };

__device__ __forceinline__ void p0_prologue(Frame& F, const Args& A) {
    PHASE_IDS();
    unsigned char* ws = A.ws;
    if (blockIdx.x < 96) {
        const float* c = A.in[1]; const float* aw = A.in[2]; const float* ab = A.in[3];
        const int col = blockIdx.x * 64 + lane_; float a0 = 0.f, a1 = 0.f;
        const int kbeg = wave_ * 128;
#pragma unroll 8
        for (int k = kbeg; k < kbeg + 128; ++k) { const float wv = aw[(size_t)k * 6144 + col]; const float c0 = c[k], c1 = c[1024 + k];
            a0 += c0 * sigm(c0) * wv; a1 += c1 * sigm(c1) * wv; }
        LAS float* red = (LAS float*)(F.lds + 8 * 16384 - 4096);
        red[(wave_ * 2 + 0) * 64 + lane_] = a0; red[(wave_ * 2 + 1) * 64 + lane_] = a1;
        __syncthreads();
        if (wave_ < 2) { float s = 0.f;
#pragma unroll
            for (int w = 0; w < 8; ++w) s += red[(w * 2 + wave_) * 64 + lane_];
            ((float*)(ws + WS_MOD))[wave_ * 6144 + col] = s + ab[col]; }
        __syncthreads();
    }
}

__device__ __forceinline__ void p_convert_early(Frame& F, const Args& A) {
    unsigned char* ws = A.ws;
    const float* w_in = A.in[5];
    conv_seg(F, w_in, DIN, 0, 1024, 1536, (bf16*)(ws + WS_WIN), 0);
    conv_seg(F, w_in, DIN, 1544, 1024, 1792, (bf16*)(ws + WS_WIN), 1536);
    conv_seg(F, w_in, DIN, 3336, 1024, 2048, (bf16*)(ws + WS_WIN), 3328);
    conv_seg(F, A.in[18], 1024, 0, 512, 1024, (bf16*)(ws + WS_WOF), 0);
    conv_seg(F, A.in[19], 1024, 0, 512, 1024, (bf16*)(ws + WS_WOR), 0);
    conv_seg(F, A.in[20], 1024, 0, 1024, 1024, (bf16*)(ws + WS_WO), 0);
    conv_seg(F, A.in[9], 512, 0, 64, 512, (bf16*)(ws + WS_LW2), 0);
    conv_seg(F, A.in[11], 512, 0, 64, 512, (bf16*)(ws + WS_LA2), 0);
    conv_seg(F, A.in[12], 512, 0, 128, 512, (bf16*)(ws + WS_LG2), 0);
}

__device__ __forceinline__ void p1_norm(Frame& F, const Args& A) {
    PHASE_IDS();
    unsigned char* ws = A.ws;
    LAS float* wf = (LAS float*)(F.lds);
    LAS float* lfl = (LAS float*)(F.lds + 32768);
    LAS float* part = (LAS float*)(F.lds + 32768 + 4096);
    const float* x = A.in[0]; const float* g1 = A.in[4]; const float* w_in = A.in[5]; const float* fb = A.in[6];
    const float* mod = (const float*)(ws + WS_MOD);
    bf16* XN = (bf16*)(ws + WS_XN); float* cumT = (float*)(ws + WS_CUM); float* segtot = (float*)(ws + WS_SEGTOT);
    for (int i = tid_; i < 8192; i += NWAVES * 64) wf[(i & 7) * 1024 + (i >> 3)] = w_in[(size_t)(i >> 3) * DIN + 1536 + (i & 7)];
    __syncthreads();
    for (int blk = blockIdx.x; blk < M / 128; blk += F.G) {
        const int b = blk / (SEQ / 128);
        f32x4 gm[4], sh[4];
#pragma unroll
        for (int j = 0; j < 4; ++j) { const int col = 4 * lane_ + 256 * j; const f32x4 g = *(const f32x4*)(g1 + col), sc = *(const f32x4*)(mod + b * 6144 + 1024 + col);
            gm[j] = g * (sc + 1.0f); sh[j] = *(const f32x4*)(mod + b * 6144 + col); }
        float fbv = fb[((lane_ >> 5) & 1) * 4 + ((lane_ >> 4) & 1) * 2 + ((lane_ >> 3) & 1)];
        f32x4 nv[4];
        { const GAS f32x4* xr0 = (const GAS f32x4*)(x + ((size_t)blk * 128 + wave_ * 16) * D) + lane_;
#pragma unroll
          for (int j = 0; j < 4; ++j) nv[j] = xr0[64 * j]; }
        for (int i = 0; i < 16; ++i) {
            const int tl = wave_ * 16 + i; const size_t tok = (size_t)blk * 128 + tl;
            f32x4 v[4]; float s = 0.f;
#pragma unroll
            for (int j = 0; j < 4; ++j) { v[j] = nv[j]; s += (v[j].x * v[j].x + v[j].y * v[j].y) + (v[j].z * v[j].z + v[j].w * v[j].w); }
            { const GAS f32x4* xr = (const GAS f32x4*)(x + (tok + ((i + 1 < 16) ? 1 : 0)) * D) + lane_;
#pragma unroll
                for (int j = 0; j < 4; ++j) nv[j] = xr[64 * j]; }
            const float rstd = 1.0f / sqrtf(wave_sum(s) * (1.f / D) + 1e-6f);
            GAS unsigned long long* o8 = (GAS unsigned long long*)(XN + tok * D) + lane_;
            float f[8];
#pragma unroll
            for (int hh = 0; hh < 8; ++hh) f[hh] = 0.f;
#pragma unroll
            for (int j = 0; j < 4; ++j) { v[j] = v[j] * rstd * gm[j] + sh[j];
                o8[64 * j] = (unsigned long long)pk2(v[j].x, v[j].y) | ((unsigned long long)pk2(v[j].z, v[j].w) << 32);
#pragma unroll
                for (int hh = 0; hh < 8; ++hh) { const f32x4 w4 = *(const LAS f32x4*)(wf + hh * 1024 + 4 * lane_ + 256 * j); f[hh] += (v[j].x * w4.x + v[j].y * w4.y) + (v[j].z * w4.z + v[j].w * w4.w); } }
            float g4[4], g2v[2], z;
            { const bool up = (lane_ & 32) != 0;
#pragma unroll
              for (int i = 0; i < 4; ++i) { const float keep = up ? f[4 + i] : f[i], send = up ? f[i] : f[4 + i]; g4[i] = keep + __shfl_xor(send, 32); } }
            { const bool up = (lane_ & 16) != 0;
#pragma unroll
              for (int i = 0; i < 2; ++i) { const float keep = up ? g4[2 + i] : g4[i], send = up ? g4[i] : g4[2 + i]; g2v[i] = keep + __shfl_xor(send, 16); } }
            { const bool up = (lane_ & 8) != 0; const float keep = up ? g2v[1] : g2v[0], send = up ? g2v[0] : g2v[1]; z = keep + __shfl_xor(send, 8); }
            z += __shfl_xor(z, 1); z += __shfl_xor(z, 2); z += __shfl_xor(z, 4);
            const int myh = ((lane_ >> 5) & 1) * 4 + ((lane_ >> 4) & 1) * 2 + ((lane_ >> 3) & 1);
            z += fbv;
            const float lf = (z >= 0.f) ? -log1pf(__expf(-z)) : z - log1pf(__expf(z));
            if ((lane_ & 7) == 0) lfl[tl * 8 + myh] = lf;
        }
        __syncthreads();
        const int hh = tid_ & 7, p = tid_ >> 3;
        if (tid_ < 64) { float run = 0.f; for (int i = 0; i < 16; ++i) { run += lfl[(p * 16 + i) * 8 + hh]; lfl[(p * 16 + i) * 8 + hh] = run; } part[p * 8 + hh] = run; }
        __syncthreads();
        if (tid_ < 64) { float off = 0.f; for (int q = 0; q < p; ++q) off += part[q * 8 + hh];
            const int t0 = (blk % (SEQ / 128)) * 128 + p * 16; float* dst = cumT + ((size_t)(b * 8 + hh)) * SEQ + t0;
            for (int i = 0; i < 16; ++i) dst[i] = lfl[(p * 16 + i) * 8 + hh] + off;
            if (p == 7) segtot[blk * 8 + hh] = off + part[7 * 8 + hh]; }
        __syncthreads();
    }
}


__device__ __forceinline__ void p_cumfix(Frame& F, const Args& A) {
    PHASE_IDS();
    unsigned char* ws = A.ws; float* cumT = (float*)(ws + WS_CUM); const float* segtot = (const float*)(ws + WS_SEGTOT);
    LAS float* pre = (LAS float*)(F.lds);
    for (int blk = blockIdx.x; blk < M / 128; blk += F.G) {
        const int b = blk / (SEQ / 128), seg = blk % (SEQ / 128);
        __syncthreads();
        if (tid_ < 64) { const int hh = tid_ & 7, part = tid_ >> 3; float a = 0.f; for (int s = part; s < seg; s += 8) a += segtot[(b * 128 + s) * 8 + hh];
            a += __shfl_xor(a, 8); a += __shfl_xor(a, 16); a += __shfl_xor(a, 32); if (part == 0) pre[hh] = a; }
        __syncthreads();
        for (int i = tid_; i < 8 * 128; i += NWAVES * 64) { const int hh = i >> 7, t = i & 127; cumT[((size_t)(b * 8 + hh)) * SEQ + seg * 128 + t] += pre[hh]; }
    }
}
__device__ __forceinline__ void p_qknorm(Frame& F, const Args& A, unsigned* qkmax, unsigned* ktmax) {
    PHASE_IDS();
    unsigned char* ws = A.ws; const bf16* Q = (const bf16*)(ws + WS_Q); const bf16* K = (const bf16*)(ws + WS_K);
    const int gw = F.vcu * NWAVES + wave_, NGW = F.G * NWAVES, hd = lane_ >> 3;
    for (int g = gw; g < M / 16; g += NGW) { const int m0 = 16 * g, b = m0 / SEQ, tile = (m0 % SEQ) >> 6; float mq = 0.f, mk = 0.f;
#pragma unroll 4
        for (int i = 0; i < 16; ++i) { const size_t m = (size_t)(m0 + i);
            const v4u qw = *(const v4u*)(Q + m * 512 + 8 * lane_), kw = *(const v4u*)(K + m * 512 + 8 * lane_);
            float sq = 0.f, sk = 0.f;
#pragma unroll
            for (int e = 0; e < 4; ++e) { const float a = bflo(qw[e]), c = bfhi(qw[e]), d = bflo(kw[e]), f = bfhi(kw[e]); sq += a * a + c * c; sk += d * d + f * f; }
            sq += dpp_f<0xB1>(sq); sq += dpp_f<0x4E>(sq); sq += dpp_f<0x141>(sq);
            sk += dpp_f<0xB1>(sk); sk += dpp_f<0x4E>(sk); sk += dpp_f<0x141>(sk);
            mq = fmaxf(mq, sq); mk = fmaxf(mk, sk); }
        if ((lane_ & 7) == 0) { const int bh = b * 8 + hd;
            atomicMax(qkmax + bh * 2, __float_as_uint(mq)); atomicMax(qkmax + bh * 2 + 1, __float_as_uint(mk)); atomicMax(ktmax + bh * 256 + tile, __float_as_uint(mk)); } }
}

template <int WITH_MOE>
__device__ __forceinline__ void p_final(Frame& F, const Args& A, const float* src) {
    PHASE_IDS();
    unsigned char* ws = A.ws; const float* fg = A.in[29]; const float* mod = (const float*)(ws + WS_MOD);
    const int* route = (const int*)(ws + WS_ROUTE); const bf16* Y = (const bf16*)(ws + WS_YM);
    f32x4 fgv[4];
#pragma unroll
    for (int j = 0; j < 4; ++j) fgv[j] = *(const f32x4*)(fg + 4 * lane_ + 256 * j);
    const int gw = F.vcu * NWAVES + wave_, NGW = F.G * NWAVES;
    for (int m = gw; m < M; m += NGW) {
        f32x4 v[4]; float s = 0.f;
        if (WITH_MOE) { const GAS unsigned long long* xb = (const GAS unsigned long long*)((const bf16*)(ws + WS_X1) + (size_t)m * D) + lane_;
#pragma unroll
            for (int j = 0; j < 4; ++j) { const unsigned long long a = xb[64 * j]; const unsigned al = (unsigned)a, ah = (unsigned)(a >> 32); v[j] = (f32x4){bflo(al), bfhi(al), bflo(ah), bfhi(ah)}; } }
        else { const GAS f32x4* xr = (const GAS f32x4*)(src + (size_t)m * D) + lane_;
#pragma unroll
            for (int j = 0; j < 4; ++j) v[j] = xr[64 * j]; }
        if (WITH_MOE) {
            const int b = m / SEQ; const int* rt_ = route + (size_t)m * 8;
            const float w0 = __int_as_float(rt_[2]), w1 = __int_as_float(rt_[3]); const int s0 = rt_[6], s1 = rt_[7];
            const GAS unsigned* y0 = (const GAS unsigned*)((const unsigned char*)Y + (size_t)s0 * D) + lane_; const GAS unsigned* y1 = (const GAS unsigned*)((const unsigned char*)Y + (size_t)s1 * D) + lane_;
#pragma unroll
            for (int j = 0; j < 4; ++j) { const int a = (int)y0[64 * j], c = (int)y1[64 * j]; const f32x4 g2 = *(const f32x4*)(mod + b * 6144 + 5120 + 4 * lane_ + 256 * j);
                f32x4 y; y.x = w0 * __builtin_amdgcn_cvt_f32_fp8(a, 0) + w1 * __builtin_amdgcn_cvt_f32_fp8(c, 0); y.y = w0 * __builtin_amdgcn_cvt_f32_fp8(a, 1) + w1 * __builtin_amdgcn_cvt_f32_fp8(c, 1);
                y.z = w0 * __builtin_amdgcn_cvt_f32_fp8(a, 2) + w1 * __builtin_amdgcn_cvt_f32_fp8(c, 2); y.w = w0 * __builtin_amdgcn_cvt_f32_fp8(a, 3) + w1 * __builtin_amdgcn_cvt_f32_fp8(c, 3);
                v[j] = v[j] + g2 * y; }
        }
#pragma unroll
        for (int j = 0; j < 4; ++j) s += (v[j].x * v[j].x + v[j].y * v[j].y) + (v[j].z * v[j].z + v[j].w * v[j].w);
        float rstd = 1.0f / sqrtf(wave_sum(s) * (1.f / D) + 1e-6f);
        if (WITH_MOE == 2) { if (((const unsigned*)(ws + WS_CTL))[CW_DIAG]) rstd = 0.f; }
        GAS f32x4* o = (GAS f32x4*)(A.out + (size_t)m * D) + lane_;
#pragma unroll
        for (int j = 0; j < 4; ++j) o[64 * j] = v[j] * rstd * fgv[j];
    }
}

typedef float f32x16 __attribute__((ext_vector_type(16)));
typedef unsigned u32x2 __attribute__((ext_vector_type(2)));
__device__ __forceinline__ f32x4 shift4(const bf16* p, bool has_prev, const float* mu) {
    const u32x2 c = *(const u32x2*)p; u32x2 q = *(const u32x2*)(has_prev ? p - SHW : p); if (!has_prev) q = (u32x2){0u, 0u};
    const f32x4 m = *(const f32x4*)mu;
    f32x4 cv = {bflo(c.x), bfhi(c.x), bflo(c.y), bfhi(c.y)}, pv = {bflo(q.x), bfhi(q.x), bflo(q.y), bfhi(q.y)};
    return cv + (pv - cv) * m;
}
__device__ __forceinline__ u32x2 pack4(f32x4 v) { u32x2 r; r.x = pk2(v.x, v.y); r.y = pk2(v.z, v.w); return r; }

__device__ __forceinline__ float fsig(float x) { return __builtin_amdgcn_rcpf(1.0f + __builtin_amdgcn_exp2f(-1.4426950408889634f * x)); }
__device__ __forceinline__ float ftanh(float x) { const float xc = fminf(fmaxf(x, -15.f), 15.f); return 1.0f - 2.0f * __builtin_amdgcn_rcpf(1.0f + __builtin_amdgcn_exp2f(2.8853900817779268f * xc)); }
__device__ __forceinline__ float half_sum32(float v) { v = row_sum16(v); v += __shfl_xor(v, 16); return v; }
__device__ __forceinline__ void shift2(const bf16* p, bool has_prev, const float (&mu)[2], float (&o)[2]) {
    const unsigned c = *(const unsigned*)p; unsigned q = *(const unsigned*)(has_prev ? p - SHW : p); if (!has_prev) q = 0u;
    const float c0 = bflo(c), c1 = bfhi(c); o[0] = c0 + (bflo(q) - c0) * mu[0]; o[1] = c1 + (bfhi(q) - c1) * mu[1];
}
template <int VAR> __device__ __forceinline__ void rwkv_pre(Frame& F, const Args& A, int ci_lo, int ci_hi) {
    PHASE_IDS();
    unsigned char* ws = A.ws;
    const bf16* PRW = (const bf16*)(ws + WS_PRW);
    const float* mu = A.in[7]; const float* w0 = A.in[8]; const float* a0 = A.in[10]; const float* k_k = A.in[13]; const float* k_a = A.in[14]; const float* r_k = A.in[15];
    const bf16* LW2 = (const bf16*)(ws + WS_LW2); const bf16* LA2 = (const bf16*)(ws + WS_LA2); const bf16* LG2 = (const bf16*)(ws + WS_LG2);
    float* LW = (float*)A.out; bf16* R = (bf16*)((unsigned char*)A.out + 64 * MiB); bf16* KP = (bf16*)((unsigned char*)A.out + 96 * MiB);
    bf16* VV = (bf16*)(ws + WS_XN); bf16* AV = (bf16*)(ws + WS_XN + 32 * MiB); bf16* BV = (bf16*)(ws + WS_F); bf16* GG = (bf16*)(ws + WS_F + 32 * MiB);
    float* BON = (float*)(ws + WS_BON);
    LAS bf16* Xw = (LAS bf16*)(F.lds); LAS bf16* Xa = (LAS bf16*)(F.lds + 9216); LAS bf16* Xg = (LAS bf16*)(F.lds + 18432);
    const int h = wave_;
    for (int ci = ci_lo; ci < ci_hi; ci += F.G) {
        __syncthreads();
        {
            int tl_ = threadIdx.x; asm volatile("" : "+v"(tl_));
            const int row = tl_ >> 3, cg = tl_ & 7; const size_t tok = (size_t)ci * 64 + row; const bool hp = (tok % SEQ) != 0;
            const bf16* src = PRW + tok * SHW + 1536 + 32 * cg; const float* mup = mu + 1536 + 32 * cg;
            LAS bf16* dst = (cg < 2) ? (Xw + row * 72 + 32 * cg) : (cg < 4) ? (Xa + row * 72 + 32 * (cg - 2)) : (Xg + row * 136 + 32 * (cg - 4));
#pragma unroll
            for (int q = 0; q < 8; ++q) { f32x4 v = shift4(src + 4 * q, hp, mup + 4 * q);
                if (cg < 2) { v.x = ftanh(v.x); v.y = ftanh(v.y); v.z = ftanh(v.z); v.w = ftanh(v.w); }
                else if (cg >= 4) { v.x = fsig(v.x); v.y = fsig(v.y); v.z = fsig(v.z); v.w = fsig(v.w); }
                *(LAS u32x2*)(dst + 4 * q) = pack4(v); }
        }
        __syncthreads();
        int ln_ = threadIdx.x & 63; asm volatile("" : "+v"(ln_));
        const int c = ln_ & 31, hh = ln_ >> 5, colb = 64 * h + 2 * c;
    float mur[2], muk[2], muv[2], kkc[2], kac[2], rkc[2], a0c[2], w0c[2];
#pragma unroll
    for (int e = 0; e < 2; ++e) { mur[e] = mu[colb + e]; muk[e] = mu[512 + colb + e]; muv[e] = mu[1024 + colb + e]; kkc[e] = k_k[colb + e]; kac[e] = k_a[colb + e]; rkc[e] = r_k[colb + e]; a0c[e] = a0[colb + e]; w0c[e] = w0[colb + e]; }
#pragma unroll 1
        for (int tb = 0; tb < ((VAR == 3) ? 0 : 2); ++tb) {
            f32x16 aa[2], aw[2], ag[2];
            aa[0] = f32x16{}; aa[1] = f32x16{}; aw[0] = f32x16{}; aw[1] = f32x16{}; ag[0] = f32x16{}; ag[1] = f32x16{};
            if (VAR != 4) {
#pragma unroll
            for (int ks = 0; ks < 4; ++ks) { const bf16x8 afr = *(const LAS bf16x8*)(Xa + (32 * tb + c) * 72 + 16 * ks + 8 * hh), wfr = *(const LAS bf16x8*)(Xw + (32 * tb + c) * 72 + 16 * ks + 8 * hh);
#pragma unroll
                for (int jb = 0; jb < 2; ++jb) { const bf16x8 b1 = *(const bf16x8*)(LA2 + (size_t)(colb + jb) * 64 + 16 * ks + 8 * hh), b2 = *(const bf16x8*)(LW2 + (size_t)(colb + jb) * 64 + 16 * ks + 8 * hh);
                    aa[jb] = __builtin_amdgcn_mfma_f32_32x32x16_bf16(afr, b1, aa[jb], 0, 0, 0); aw[jb] = __builtin_amdgcn_mfma_f32_32x32x16_bf16(wfr, b2, aw[jb], 0, 0, 0); } }
#pragma unroll
            for (int ks = 0; ks < 8; ++ks) { const bf16x8 gfr = *(const LAS bf16x8*)(Xg + (32 * tb + c) * 136 + 16 * ks + 8 * hh);
#pragma unroll
                for (int jb = 0; jb < 2; ++jb) { const bf16x8 b3 = *(const bf16x8*)(LG2 + (size_t)(colb + jb) * 128 + 16 * ks + 8 * hh); ag[jb] = __builtin_amdgcn_mfma_f32_32x32x16_bf16(gfr, b3, ag[jb], 0, 0, 0); } }
            }
            unsigned gpk[16], apk[16];
#pragma unroll
            for (int reg = 0; reg < 16; ++reg) { gpk[reg] = pk2(ag[0][reg], ag[1][reg]); apk[reg] = pk2(fsig(a0c[0] + aa[0][reg]), fsig(a0c[1] + aa[1][reg])); }
            unsigned rawc[16][3], rawq[4][3];
#pragma unroll
            for (int reg = 0; reg < 16; ++reg) { const int t = 32 * tb + (reg & 3) + 8 * (reg >> 2) + 4 * hh; const size_t tok = (size_t)ci * 64 + t; const bool hp = (tok % SEQ) != 0;
                const bf16* prow = PRW + tok * SHW + colb; const bf16* pprev = hp ? prow - SHW : prow;
#pragma unroll
                for (int x = 0; x < 3; ++x) { if (VAR == 2) { rawc[reg][x] = 0x3f803f80u + reg; if ((reg & 3) == 0) rawq[reg >> 2][x] = 0x3f803f80u; } else { rawc[reg][x] = *(const unsigned*)(prow + 512 * x); if ((reg & 3) == 0) { const unsigned q = *(const unsigned*)(pprev + 512 * x); rawq[reg >> 2][x] = hp ? q : 0u; } } } }
#pragma unroll
            for (int reg = 0; reg < 16; ++reg) {
                const int t = 32 * tb + (reg & 3) + 8 * (reg >> 2) + 4 * hh; const size_t tok = (size_t)ci * 64 + t;
                unsigned rawp_[3];
#pragma unroll
                for (int x = 0; x < 3; ++x) rawp_[x] = ((reg & 3) == 0) ? rawq[reg >> 2][x] : rawc[(reg + 15) & 15][x];
                float kx[2], rx[2], vx[2];
                { const unsigned cc_ = rawc[reg][0], pp_ = rawp_[0]; const float c0 = bflo(cc_), c1 = bfhi(cc_); rx[0] = c0 + (bflo(pp_) - c0) * mur[0]; rx[1] = c1 + (bfhi(pp_) - c1) * mur[1]; }
                { const unsigned cc_ = rawc[reg][1], pp_ = rawp_[1]; const float c0 = bflo(cc_), c1 = bfhi(cc_); kx[0] = c0 + (bflo(pp_) - c0) * muk[0]; kx[1] = c1 + (bfhi(pp_) - c1) * muk[1]; }
                { const unsigned cc_ = rawc[reg][2], pp_ = rawp_[2]; const float c0 = bflo(cc_), c1 = bfhi(cc_); vx[0] = c0 + (bflo(pp_) - c0) * muv[0]; vx[1] = c1 + (bfhi(pp_) - c1) * muv[1]; }
                const float as0 = bflo(apk[reg]), as1 = bfhi(apk[reg]);
                const float kr0 = kx[0] * kkc[0], kr1 = kx[1] * kkc[1];
                const float ss = half_sum32(kr0 * kr0 + kr1 * kr1); const float inv = __builtin_amdgcn_rsqf(fmaxf(ss, 1e-24f));
                const float kk0 = kr0 * inv, kk1 = kr1 * inv, kp0 = kx[0] * (1.0f + (as0 - 1.0f) * kac[0]), kp1 = kx[1] * (1.0f + (as1 - 1.0f) * kac[1]);
                const float bon = half_sum32(rx[0] * kp0 * rkc[0] + rx[1] * kp1 * rkc[1]);
                float o2[2];
#pragma unroll
                for (int e = 0; e < 2; ++e) { const float z = -(w0c[e] + aw[e][reg]);
                    const float sp = fmaxf(z, 0.f) + 0.6931471805599453f * __builtin_amdgcn_logf(1.0f + __builtin_amdgcn_exp2f(-1.4426950408889634f * fabsf(z))); o2[e] = -__builtin_amdgcn_exp2f(-1.4426950408889634f * (sp + 0.5f)); }
                const unsigned ob = (unsigned)tok * 1024u + (unsigned)colb * 2u;
                if (VAR == 0) {
                *(unsigned*)((unsigned char*)R + ob) = pk2(rx[0], rx[1]); *(unsigned*)((unsigned char*)KP + ob) = pk2(kp0, kp1); *(unsigned*)((unsigned char*)VV + ob) = pk2(vx[0], vx[1]);
                *(unsigned*)((unsigned char*)AV + ob) = pk2(-kk0, -kk1); *(unsigned*)((unsigned char*)BV + ob) = pk2(kk0 * as0, kk1 * as1);
                *(float2*)((unsigned char*)LW + 2u * ob) = make_float2(o2[0], o2[1]); *(unsigned*)((unsigned char*)GG + ob) = gpk[reg];
                if (c == 0) BON[tok * 8 + h] = bon;
                } else { asm volatile("" :: "v"(pk2(rx[0], rx[1])), "v"(pk2(kp0, kp1)), "v"(pk2(vx[0], vx[1])), "v"(pk2(-kk0, -kk1)), "v"(pk2(kk0 * as0, kk1 * as1)), "v"(o2[0]), "v"(o2[1]), "v"(gpk[reg]), "v"(bon), "v"(ob)); }
                if ((reg & 3) == 3) __builtin_amdgcn_sched_barrier(0);
            }
        }
    }
}

__device__ __forceinline__ void rwkv_scan_seq(Frame& F, const Args& A) {
    PHASE_IDS();
    if (blockIdx.x >= BATCH * 8) return;
    unsigned char* ws = A.ws;
    const float* LW = (const float*)A.out; const bf16* R = (const bf16*)((unsigned char*)A.out + 64 * MiB); const bf16* KP = (const bf16*)((unsigned char*)A.out + 96 * MiB);
    const bf16* VV = (const bf16*)(ws + WS_XN); const bf16* AV = (const bf16*)(ws + WS_XN + 32 * MiB); const bf16* BV = (const bf16*)(ws + WS_F);
    float* Y = (float*)(ws + WS_Y);
    const int b = blockIdx.x >> 3, h = blockIdx.x & 7;
    constexpr int STEPB = 896, CH = 16, BUFB = STEPB * CH;
    LAS unsigned char* buf = F.lds;
    const size_t tok0 = (size_t)b * SEQ;
    const bool loader = wave_ >= 4; const int lt = tid_ - 256;
    auto load_chunk = [&](int cidx, int slot) {
        for (int p = lt; p < CH * 56; p += 256) { const int s = p / 56, q = p % 56; const size_t tok = tok0 + (size_t)cidx * CH + s; v4u val;
            if (q < 16) val = *(const v4u*)(LW + tok * 512 + 64 * h + 4 * q);
            else { const int a = (q - 16) >> 3, o8 = (q - 16) & 7; const bf16* src = (a == 0) ? AV : (a == 1) ? BV : (a == 2) ? KP : (a == 3) ? R : VV; val = *(const v4u*)(src + tok * 512 + 64 * h + 8 * o8); }
            *(LAS v4u*)(buf + slot * BUFB + s * STEPB + q * 16) = val; }
    };
    if (loader) load_chunk(0, 0);
    __syncthreads();
    float S[16];
#pragma unroll
    for (int j = 0; j < 16; ++j) S[j] = 0.f;
    const int il = lane_ & 15, jq = lane_ >> 4, irow = 16 * wave_ + il;
    for (int cidx = 0; cidx < SEQ / CH; ++cidx) {
        if (loader) { if (cidx + 1 < SEQ / CH) load_chunk(cidx + 1, (cidx + 1) & 1); }
        else {
            const LAS unsigned char* bb = buf + (cidx & 1) * BUFB;
#pragma unroll 4
            for (int s = 0; s < CH; ++s) { const LAS unsigned char* sp = bb + s * STEPB;
                float w[16], av[16], bv[16], kv[16], rv[16];
#pragma unroll
                for (int q = 0; q < 4; ++q) { const f32x4 l4 = *(const LAS f32x4*)(sp + 64 * jq + 16 * q); w[4 * q] = __expf(l4.x); w[4 * q + 1] = __expf(l4.y); w[4 * q + 2] = __expf(l4.z); w[4 * q + 3] = __expf(l4.w); }
#pragma unroll
                for (int q = 0; q < 2; ++q) { const v4u a4 = *(const LAS v4u*)(sp + 256 + 32 * jq + 16 * q), b4 = *(const LAS v4u*)(sp + 384 + 32 * jq + 16 * q), k4 = *(const LAS v4u*)(sp + 512 + 32 * jq + 16 * q), r4 = *(const LAS v4u*)(sp + 640 + 32 * jq + 16 * q);
#pragma unroll
                    for (int e = 0; e < 4; ++e) { av[8 * q + 2 * e] = bflo(a4[e]); av[8 * q + 2 * e + 1] = bfhi(a4[e]); bv[8 * q + 2 * e] = bflo(b4[e]); bv[8 * q + 2 * e + 1] = bfhi(b4[e]);
                        kv[8 * q + 2 * e] = bflo(k4[e]); kv[8 * q + 2 * e + 1] = bfhi(k4[e]); rv[8 * q + 2 * e] = bflo(r4[e]); rv[8 * q + 2 * e + 1] = bfhi(r4[e]); } }
                const unsigned short vraw = *(const LAS unsigned short*)(sp + 768 + 2 * irow); const float vi = __uint_as_float((unsigned)vraw << 16);
                float sa = 0.f;
#pragma unroll
                for (int j = 0; j < 16; ++j) sa += S[j] * av[j];
                sa += __shfl_xor(sa, 16); sa += __shfl_xor(sa, 32);
                float y = 0.f;
#pragma unroll
                for (int j = 0; j < 16; ++j) { S[j] = S[j] * w[j] + sa * bv[j] + vi * kv[j]; y += S[j] * rv[j]; }
                y += __shfl_xor(y, 16); y += __shfl_xor(y, 32);
                if (jq == 0) Y[(tok0 + (size_t)cidx * CH + s) * 512 + 64 * h + irow] = y;
            }
        }
        __syncthreads();
    }
}

__device__ __forceinline__ void rwkv_post(Frame& F, const Args& A) {
    PHASE_IDS();
    unsigned char* ws = A.ws;
    const float* Y = (const float*)(ws + WS_Y); const bf16* VV = (const bf16*)(ws + WS_XN); const bf16* GG = (const bf16*)(ws + WS_F + 32 * MiB); const float* BON = (const float*)(ws + WS_BON);
    bf16* O = (bf16*)(ws + WS_F);
    const float* lg = A.in[16]; const float* lb = A.in[17];
    const int gw = F.vcu * NWAVES + wave_, NGW = F.G * NWAVES, col = 8 * lane_, hd = lane_ >> 3;
    const f32x4 g0 = *(const f32x4*)(lg + col), g1 = *(const f32x4*)(lg + col + 4), b0 = *(const f32x4*)(lb + col), b1 = *(const f32x4*)(lb + col + 4);
    for (int m = gw; m < M; m += NGW) {
        const f32x4 y0 = *(const f32x4*)(Y + (size_t)m * 512 + col), y1 = *(const f32x4*)(Y + (size_t)m * 512 + col + 4);
        float s = (y0.x + y0.y) + (y0.z + y0.w) + (y1.x + y1.y) + (y1.z + y1.w);
        s += __shfl_xor(s, 1); s += __shfl_xor(s, 2); s += __shfl_xor(s, 4);
        const float mean = s * (1.f / 64.f); const f32x4 d0 = y0 - mean, d1 = y1 - mean;
        float q = (d0.x * d0.x + d0.y * d0.y) + (d0.z * d0.z + d0.w * d0.w) + (d1.x * d1.x + d1.y * d1.y) + (d1.z * d1.z + d1.w * d1.w);
        q += __shfl_xor(q, 1); q += __shfl_xor(q, 2); q += __shfl_xor(q, 4);
        const float rstd = 1.0f / sqrtf(q * (1.f / 64.f) + 64e-5f);
        const float bon = BON[(size_t)m * 8 + hd];
        const v4u vw = *(const v4u*)(VV + (size_t)m * 512 + col), gw4 = *(const v4u*)(GG + (size_t)m * 512 + col);
        f32x4 o0 = (d0 * rstd * g0 + b0), o1 = (d1 * rstd * g1 + b1);
        o0.x = (o0.x + bon * bflo(vw.x)) * bflo(gw4.x); o0.y = (o0.y + bon * bfhi(vw.x)) * bfhi(gw4.x); o0.z = (o0.z + bon * bflo(vw.y)) * bflo(gw4.y); o0.w = (o0.w + bon * bfhi(vw.y)) * bfhi(gw4.y);
        o1.x = (o1.x + bon * bflo(vw.z)) * bflo(gw4.z); o1.y = (o1.y + bon * bfhi(vw.z)) * bfhi(gw4.z); o1.z = (o1.z + bon * bflo(vw.w)) * bflo(gw4.w); o1.w = (o1.w + bon * bfhi(vw.w)) * bfhi(gw4.w);
        v4u ow; ow.x = pk2(o0.x, o0.y); ow.y = pk2(o0.z, o0.w); ow.z = pk2(o1.x, o1.y); ow.w = pk2(o1.z, o1.w);
        *(v4u*)(O + (size_t)m * 512 + col) = ow;
    }
}

__device__ __forceinline__ size_t pq_off(int it) { const int ch = it >> 8, cc = it & 255; return WS_PRW + ((size_t)(ch >> 3) * SEQ + (size_t)cc * 64) * (SHW * 2) + (size_t)(ch & 7) * 24576; }
__device__ __forceinline__ size_t y0_off(int it, int idx) { const int ch = it >> 8, cc = it & 255; return (((size_t)(ch >> 3) * SEQ + (size_t)cc * 64 + (idx >> 4)) * 512 + 64 * (ch & 7)) * 4 + (size_t)(idx & 15) * 16; }
constexpr size_t ST_OFF = 64 * MiB;
constexpr int CH_ITEMS = BATCH * 8 * (SEQ / 64);

__device__ __forceinline__ int sw16(int row, int chunk) { return row * 128 + ((chunk ^ (row & 7)) << 4); }
typedef float f32x4c __attribute__((ext_vector_type(4)));
__device__ __forceinline__ bf16x8 ld_frag(const LAS unsigned char* Mx, int row, int chunk) { return *(const LAS bf16x8*)(Mx + sw16(row, chunk)); }
template <bool SWAP>
__device__ __forceinline__ void mm_tile(const LAS unsigned char* Am, const LAS unsigned char* Bm, int r0, int c0, int l15, int kg, f32x4c (&acc)[2]) {
    bf16x8 a[2], b[2][2];
#pragma unroll
    for (int ks = 0; ks < 2; ++ks) { a[ks] = ld_frag(Am, r0 + l15, 4 * ks + kg);
#pragma unroll
        for (int n = 0; n < 2; ++n) b[ks][n] = ld_frag(Bm, c0 + 16 * n + l15, 4 * ks + kg); }
#pragma unroll
    for (int ks = 0; ks < 2; ++ks)
#pragma unroll
        for (int n = 0; n < 2; ++n)
            acc[n] = SWAP ? __builtin_amdgcn_mfma_f32_16x16x32_bf16(b[ks][n], a[ks], acc[n], 0, 0, 0) : __builtin_amdgcn_mfma_f32_16x16x32_bf16(a[ks], b[ks][n], acc[n], 0, 0, 0);
}
__device__ __forceinline__ unsigned long long pack4u(f32x4c v) { return (unsigned long long)pk2(v[0], v[1]) | ((unsigned long long)pk2(v[2], v[3]) << 32); }
__device__ __forceinline__ void st_nat(LAS unsigned char* O, int r0, int c0, int l15, int kg, const f32x4c (&acc)[2]) {
#pragma unroll
    for (int n = 0; n < 2; ++n) { const int row = r0 + l15, col = c0 + 16 * n + 4 * kg; *(LAS unsigned long long*)(O + sw16(row, col >> 3) + (col & 4) * 2) = pack4u(acc[n]); }
}
__device__ __forceinline__ void st_tr(LAS unsigned char* OT, int r0, int c0, int l15, int kg, const f32x4c (&acc)[2]) {
#pragma unroll
    for (int n = 0; n < 2; ++n)
#pragma unroll
        for (int e = 0; e < 4; ++e) { const int row = r0 + l15, col = c0 + 16 * n + 4 * kg + e; *(LAS unsigned short*)(OT + sw16(col, row >> 3) + (row & 7) * 2) = (unsigned short)f2bf(acc[n][e]); }
}
__device__ __forceinline__ f32x4c ld_nat4(const LAS unsigned char* O, int row, int col) { const unsigned long long w = *(const LAS unsigned long long*)(O + sw16(row, col >> 3) + (col & 4) * 2);
    const unsigned lo = (unsigned)w, hi = (unsigned)(w >> 32); return (f32x4c){bflo(lo), bfhi(lo), bflo(hi), bfhi(hi)}; }

template <int VAR> __device__ __forceinline__ void rwkv_r1(Frame& F, const Args& A, int it_lo, int it_hi, int it_step) {
    PHASE_IDS();
    unsigned char* ws = A.ws;
    const float* LW = (const float*)A.out; const bf16* R = (const bf16*)((unsigned char*)A.out + 64 * MiB); const bf16* KP = (const bf16*)((unsigned char*)A.out + 96 * MiB);
    const bf16* VV = (const bf16*)(ws + WS_XN); const bf16* AV = (const bf16*)(ws + WS_XN + 32 * MiB); const bf16* BV = (const bf16*)(ws + WS_F);
    LAS unsigned char* L = F.lds;
#define MB(i) (L + (i) * 8192)
    LAS float* gCs = (LAS float*)(L + 17 * 8192); LAS float* part = gCs + 64;
    const int w = wave_, j = lane_, l15 = lane_ & 15, kg = lane_ >> 4, r0 = 16 * (w >> 1), c0 = 32 * (w & 1);
#define R1_BAR() asm volatile("s_waitcnt lgkmcnt(0)\n\ts_barrier" ::: "memory")
    float nlw[8]; unsigned short nav[8], nbv[8], nkv[8], nrv[8], nvv[8];
#define R1_LOAD(itx) do { const int ch_ = (itx) >> 8, cc_ = (itx) & 255; const size_t tb_ = (size_t)(ch_ >> 3) * SEQ + (size_t)cc_ * 64 + 8 * w; const int cg_ = 64 * (ch_ & 7) + j; \
        _Pragma("unroll") for (int t = 0; t < 8; ++t) { const size_t o = (tb_ + t) * 512 + cg_; nlw[t] = LW[o]; nav[t] = AV[o]; nbv[t] = BV[o]; nkv[t] = KP[o]; nrv[t] = R[o]; nvv[t] = VV[o]; } } while (0)
    if (it_lo < it_hi) R1_LOAD(it_lo);
    for (int it = it_lo; it < it_hi; it += it_step) {
        R1_BAR();
        {
            float g[8], lw[8], av[8], bv[8], kv[8], rv[8]; unsigned short vraw[8]; float run = 0.f;
#pragma unroll
            for (int t = 0; t < 8; ++t) { lw[t] = nlw[t]; av[t] = __uint_as_float((unsigned)nav[t] << 16); bv[t] = __uint_as_float((unsigned)nbv[t] << 16);
                kv[t] = __uint_as_float((unsigned)nkv[t] << 16); rv[t] = __uint_as_float((unsigned)nrv[t] << 16); vraw[t] = nvv[t]; run += lw[t]; g[t] = run; }
            { const int itn_ = (it + it_step < it_hi) ? it + it_step : it; R1_LOAD(itn_); }
            part[w * 64 + j] = run;
            R1_BAR();
            float pre = 0.f, tot = 0.f;
#pragma unroll
            for (int q = 0; q < 8; ++q) { const float p = part[q * 64 + j]; tot += p; if (q < w) pre += p; }
            if (w == 0) gCs[j] = __expf(tot);
            unsigned short atT[8], bhT[8], khT[8];
#pragma unroll
            for (int t = 0; t < 8; ++t) { const float G = pre + g[t]; const float eg = __expf(G), en = __expf(-G), ea = __expf(G - lw[t]), ec = __expf(tot - G);
                const int row = 8 * w + t; const int off = sw16(row, j >> 3) + (j & 7) * 2;
                const unsigned short at = (unsigned short)f2bf(av[t] * ea);
                *(LAS unsigned short*)(MB(0) + off) = at; atT[t] = at;
                *(LAS unsigned short*)(MB(2) + off) = (unsigned short)f2bf(bv[t] * en);
                *(LAS unsigned short*)(MB(3) + off) = (unsigned short)f2bf(kv[t] * en);
                *(LAS unsigned short*)(MB(4) + off) = (unsigned short)f2bf(rv[t] * eg);
                bhT[t] = (unsigned short)f2bf(bv[t] * ec); khT[t] = (unsigned short)f2bf(kv[t] * ec); }
            v4u x;
            x.x = atT[0] | ((unsigned)atT[1] << 16); x.y = atT[2] | ((unsigned)atT[3] << 16); x.z = atT[4] | ((unsigned)atT[5] << 16); x.w = atT[6] | ((unsigned)atT[7] << 16); *(LAS v4u*)(MB(1) + sw16(j, w)) = x;
            x.x = bhT[0] | ((unsigned)bhT[1] << 16); x.y = bhT[2] | ((unsigned)bhT[3] << 16); x.z = bhT[4] | ((unsigned)bhT[5] << 16); x.w = bhT[6] | ((unsigned)bhT[7] << 16); *(LAS v4u*)(MB(5) + sw16(j, w)) = x;
            x.x = khT[0] | ((unsigned)khT[1] << 16); x.y = khT[2] | ((unsigned)khT[3] << 16); x.z = khT[4] | ((unsigned)khT[5] << 16); x.w = khT[6] | ((unsigned)khT[7] << 16); *(LAS v4u*)(MB(6) + sw16(j, w)) = x;
            x.x = vraw[0] | ((unsigned)vraw[1] << 16); x.y = vraw[2] | ((unsigned)vraw[3] << 16); x.z = vraw[4] | ((unsigned)vraw[5] << 16); x.w = vraw[6] | ((unsigned)vraw[7] << 16); *(LAS v4u*)(MB(7) + sw16(j, w)) = x;
        }
        R1_BAR();
        if (VAR == 1) continue;
        f32x4c acc[2];
        const int trow = r0 + l15;
        {
            acc[0] = f32x4c{}; acc[1] = f32x4c{}; mm_tile<true>(MB(0), MB(2), r0, c0, l15, kg, acc);
#pragma unroll
            for (int n = 0; n < 2; ++n)
#pragma unroll
                for (int e = 0; e < 4; ++e) { const int s = c0 + 16 * n + 4 * kg + e; if (s >= trow) acc[n][e] = 0.f; }
            st_nat(MB(8), r0, c0, l15, kg, acc); st_tr(MB(9), r0, c0, l15, kg, acc);
#pragma unroll
            for (int n = 0; n < 2; ++n)
#pragma unroll
                for (int e = 0; e < 4; ++e) { const int s = c0 + 16 * n + 4 * kg + e; if (s == trow) acc[n][e] = 1.f; }
            st_nat(MB(15), r0, c0, l15, kg, acc);
            acc[0] = f32x4c{}; acc[1] = f32x4c{}; mm_tile<true>(MB(0), MB(3), r0, c0, l15, kg, acc);
#pragma unroll
            for (int n = 0; n < 2; ++n)
#pragma unroll
                for (int e = 0; e < 4; ++e) { const int s = c0 + 16 * n + 4 * kg + e; if (s >= trow) acc[n][e] = 0.f; }
            st_nat(MB(10), r0, c0, l15, kg, acc);
            acc[0] = f32x4c{}; acc[1] = f32x4c{}; mm_tile<true>(MB(4), MB(2), r0, c0, l15, kg, acc);
#pragma unroll
            for (int n = 0; n < 2; ++n)
#pragma unroll
                for (int e = 0; e < 4; ++e) { const int s = c0 + 16 * n + 4 * kg + e; if (s > trow) acc[n][e] = 0.f; }
            st_nat(MB(11), r0, c0, l15, kg, acc);
            acc[0] = f32x4c{}; acc[1] = f32x4c{}; mm_tile<true>(MB(4), MB(3), r0, c0, l15, kg, acc);
#pragma unroll
            for (int n = 0; n < 2; ++n)
#pragma unroll
                for (int e = 0; e < 4; ++e) { const int s = c0 + 16 * n + 4 * kg + e; if (s > trow) acc[n][e] = 0.f; }
            st_nat(MB(12), r0, c0, l15, kg, acc);
        }
        R1_BAR();
        if (VAR == 2) continue;
        acc[0] = f32x4c{}; acc[1] = f32x4c{}; mm_tile<true>(MB(8), MB(9), r0, c0, l15, kg, acc); st_nat(MB(13), r0, c0, l15, kg, acc); st_tr(MB(14), r0, c0, l15, kg, acc);
        acc[0] = f32x4c{}; acc[1] = f32x4c{}; mm_tile<true>(MB(7), MB(10), r0, c0, l15, kg, acc); st_nat(MB(3), r0, c0, l15, kg, acc);
        R1_BAR();
#define SQUARE(xi, xti, xo, xto) do { acc[0] = f32x4c{}; acc[1] = f32x4c{}; mm_tile<true>(MB(xi), MB(xti), r0, c0, l15, kg, acc); st_nat(MB(xo), r0, c0, l15, kg, acc); st_tr(MB(xto), r0, c0, l15, kg, acc); } while (0)
#define MUPD(mi, xti, mo) do { acc[0] = ld_nat4(MB(mi), trow, c0 + 4 * kg); acc[1] = ld_nat4(MB(mi), trow, c0 + 16 + 4 * kg); mm_tile<true>(MB(mi), MB(xti), r0, c0, l15, kg, acc); st_nat(MB(mo), r0, c0, l15, kg, acc); } while (0)
        SQUARE(13, 14, 0, 2); MUPD(15, 14, 16); R1_BAR();
        SQUARE(0, 2, 13, 14); MUPD(16, 2, 15); R1_BAR();
        SQUARE(13, 14, 0, 2); MUPD(15, 14, 16); R1_BAR();
        SQUARE(0, 2, 13, 14); MUPD(16, 2, 15); R1_BAR();
        MUPD(15, 14, 16); R1_BAR();
        acc[0] = f32x4c{}; acc[1] = f32x4c{}; mm_tile<true>(MB(1), MB(16), r0, c0, l15, kg, acc); st_nat(MB(13), r0, c0, l15, kg, acc);
        acc[0] = f32x4c{}; acc[1] = f32x4c{}; mm_tile<true>(MB(3), MB(16), r0, c0, l15, kg, acc); st_nat(MB(14), r0, c0, l15, kg, acc);
        R1_BAR();
        if (VAR == 3) continue;
        unsigned char* og = ws + pq_off(it); unsigned char* oy = (unsigned char*)A.out + y0_off(it, w * 64 + lane_);
        {
            acc[0] = f32x4c{}; acc[1] = f32x4c{}; mm_tile<true>(MB(5), MB(13), r0, c0, l15, kg, acc);
            const float gc = gCs[trow];
#pragma unroll
            for (int n = 0; n < 2; ++n) { const int col = c0 + 16 * n + 4 * kg;
#pragma unroll
                for (int e = 0; e < 4; ++e) if (col + e == trow) acc[n][e] += gc;
                const int jj_ = col & 31, q_ = jj_ & 15; const size_t po_ = ((size_t)((((trow >> 5) * 2 + (col >> 5)) * 2 + (jj_ >> 4)) * 64 + (trow & 31) + 32 * ((q_ >> 2) & 1)) * 16 + (size_t)(4 * (q_ >> 3)) * 2);
                if (VAR == 0) *(unsigned long long*)(og + po_) = pack4u(acc[n]); else asm volatile("" :: "v"(pack4u(acc[n]))); }
            acc[0] = ld_nat4(MB(4), trow, c0 + 4 * kg); acc[1] = ld_nat4(MB(4), trow, c0 + 16 + 4 * kg); mm_tile<true>(MB(11), MB(13), r0, c0, l15, kg, acc);
#pragma unroll
            for (int n = 0; n < 2; ++n) { const int col = c0 + 16 * n + 4 * kg; if (VAR == 0) *(unsigned long long*)(og + 16384 + (size_t)(trow * 64 + col) * 2) = pack4u(acc[n]); else asm volatile("" :: "v"(pack4u(acc[n]))); }
            acc[0] = f32x4c{}; acc[1] = f32x4c{}; mm_tile<false>(MB(5), MB(14), r0, c0, l15, kg, acc); mm_tile<false>(MB(6), MB(7), r0, c0, l15, kg, acc);
#pragma unroll
            for (int n = 0; n < 2; ++n) { const int i_ = c0 + 16 * n + l15, jr_ = r0 + 4 * kg, rr_ = jr_ & 31;
                const size_t qo_ = (size_t)((((i_ >> 5) * 2 + (jr_ >> 5)) * 64 + (i_ & 31) + 32 * ((rr_ >> 2) & 1)) * 32 + (4 * (rr_ >> 3)) * 2);
                if (VAR == 0) *(unsigned long long*)(og + 8192 + qo_) = pack4u(acc[n]); else asm volatile("" :: "v"(pack4u(acc[n]))); }
            acc[0] = f32x4c{}; acc[1] = f32x4c{}; mm_tile<false>(MB(11), MB(14), r0, c0, l15, kg, acc); mm_tile<false>(MB(12), MB(7), r0, c0, l15, kg, acc);
            { v4u q; q.x = pk2(acc[0][0], acc[0][1]); q.y = pk2(acc[0][2], acc[0][3]); q.z = pk2(acc[1][0], acc[1][1]); q.w = pk2(acc[1][2], acc[1][3]); if (VAR == 0) *(v4u*)oy = q; else asm volatile("" :: "v"(q)); }
        }
    }
#undef SQUARE
#undef MUPD
#undef MB
#undef R1_BAR
#undef R1_LOAD
}

template <int VAR> __device__ __forceinline__ void rwkv_r2(Frame& F, const Args& A, unsigned char* stbase) {
    PHASE_IDS();
    if (blockIdx.x >= BATCH * 8) return;
    unsigned char* ws = A.ws;
    LAS unsigned char* L = F.lds;
    const int ch = blockIdx.x, w = wave_, l15 = lane_ & 15, kg = lane_ >> 4, r0 = 16 * (w >> 1), c0 = 32 * (w & 1);
    const unsigned char* pq = ws + pq_off(ch * 256); unsigned char* st = stbase + (size_t)ch * 256 * 8192;
    for (int i = tid_; i < 2048; i += NWAVES * 64) { ((LAS unsigned*)L)[i] = 0u; }
    for (int i = tid_; i < 512; i += NWAVES * 64) ((v4u*)st)[i] = (v4u){0u, 0u, 0u, 0u};
    __syncthreads();
    constexpr int PF = 8;
    bf16x8 pa[PF][2]; v4u qf[PF];
#define R2_LOAD(slot, step) do { const unsigned char* p_ = pq + (size_t)(step) * (64 * SHW * 2); \
        pa[slot][0] = *(const bf16x8*)(p_ + (size_t)((r0 + l15) * 64 + 8 * kg) * 2); pa[slot][1] = *(const bf16x8*)(p_ + (size_t)((r0 + l15) * 64 + 32 + 8 * kg) * 2); \
        qf[slot] = *(const v4u*)(p_ + 8192 + (size_t)(w * 64 + lane_) * 16); } while (0)
#pragma unroll
    for (int s = 0; s < PF; ++s) R2_LOAD(s, s);
    for (int c = 0; c < 256; c += PF) {
#pragma unroll
        for (int s = 0; s < PF; ++s) {
            const int step = c + s; const LAS unsigned char* Sin = L + (step & 15) * 8192; LAS unsigned char* Sout = L + ((step + 1) & 15) * 8192;
            f32x4c acc[2];
            acc[0] = (f32x4c){bflo(qf[s].x), bfhi(qf[s].x), bflo(qf[s].y), bfhi(qf[s].y)}; acc[1] = (f32x4c){bflo(qf[s].z), bfhi(qf[s].z), bflo(qf[s].w), bfhi(qf[s].w)};
            bf16x8 sf[2][2];
#pragma unroll
            for (int ks = 0; ks < 2; ++ks)
#pragma unroll
                for (int n = 0; n < 2; ++n) sf[ks][n] = ld_frag(Sin, c0 + 16 * n + l15, 4 * ks + kg);
#pragma unroll
            for (int ks = 0; ks < 2; ++ks)
#pragma unroll
                for (int n = 0; n < 2; ++n) acc[n] = __builtin_amdgcn_mfma_f32_16x16x32_bf16(pa[s][ks], sf[ks][n], acc[n], 0, 0, 0);
#pragma unroll
            for (int n = 0; n < 2; ++n) { const int row = c0 + 16 * n + l15, col = r0 + 4 * kg; const unsigned long long pkd = pack4u(acc[n]);
                *(LAS unsigned long long*)(Sout + sw16(row, col >> 3) + (col & 4) * 2) = pkd;
                }
            if (VAR != 3) { if (step + PF < 256) R2_LOAD(s, step + PF); }
            if (VAR != 4) asm volatile("s_waitcnt lgkmcnt(0)\n\ts_barrier" ::: "memory");
        }
        if (VAR != 2) { const int nflush = (c + PF < 256) ? PF * 8192 : (PF - 1) * 8192; unsigned char* dst = st + (size_t)(c + 1) * 8192;
          for (int o = tid_ * 16; o < nflush; o += NWAVES * 64 * 16) { const int row_ = (o >> 7) & 63, chk_ = (o >> 4) & 7, slot_ = (c + 1 + (o >> 13)) & 15; *(v4u*)(dst + o) = *(const LAS v4u*)(L + slot_ * 8192 + sw16(row_, chk_)); } }
    }
#undef R2_LOAD
}

__device__ __forceinline__ void rwkv_r2w(Frame& F, const Args& A, unsigned char* stbase) {
    PHASE_IDS();
    if (blockIdx.x >= BATCH * 8) return;
    unsigned char* ws = A.ws;
    LAS unsigned char* HB = F.lds;
    const int ch = blockIdx.x, it = wave_ & 1, cl = lane_ & 31, hh = lane_ >> 5; const bool chain = wave_ < 2;
    const unsigned char* pq = ws + pq_off(ch * 256); unsigned char* st = stbase + (size_t)ch * 256 * 8192;
    for (int i = tid_; i < 512; i += NWAVES * 64) ((v4u*)st)[i] = (v4u){0u, 0u, 0u, 0u};
    f32x16 H[2]; H[0] = f32x16{}; H[1] = f32x16{};
    constexpr int PF = 2;
    bf16x8 pf[PF][8]; v4u qf[PF][4];
#define RW_LOAD(slot, step) do { const unsigned char* p_ = pq + (size_t)(step) * (64 * SHW * 2); \
        _Pragma("unroll") for (int f = 0; f < 8; ++f) pf[slot][f] = *(const bf16x8*)(p_ + (size_t)(f * 64 + lane_) * 16); \
        _Pragma("unroll") for (int jt = 0; jt < 2; ++jt) { const unsigned char* q_ = p_ + 8192 + (size_t)((it * 2 + jt) * 64 + lane_) * 32; qf[slot][2 * jt] = *(const v4u*)q_; qf[slot][2 * jt + 1] = *(const v4u*)(q_ + 16); } } while (0)
    if (chain) {
#pragma unroll
        for (int s = 0; s < PF; ++s) RW_LOAD(s, s); }
    for (int g = 0; g < 64; ++g) {
        LAS unsigned char* hb = HB + (g & 1) * 32768;
        if (chain) {
#pragma unroll
            for (int s = 0; s < 4; ++s) {
                const int step = 4 * g + s; if (step >= 255) break;
                bf16x8 B[2][2];
#pragma unroll
                for (int jt2 = 0; jt2 < 2; ++jt2)
#pragma unroll
                    for (int k = 0; k < 2; ++k) { v4u p_; p_.x = pk2(H[jt2][8 * k], H[jt2][8 * k + 1]); p_.y = pk2(H[jt2][8 * k + 2], H[jt2][8 * k + 3]); p_.z = pk2(H[jt2][8 * k + 4], H[jt2][8 * k + 5]); p_.w = pk2(H[jt2][8 * k + 6], H[jt2][8 * k + 7]); B[jt2][k] = __builtin_bit_cast(bf16x8, p_); }
#pragma unroll
                for (int jt = 0; jt < 2; ++jt) { f32x16 n_;
#pragma unroll
                    for (int e = 0; e < 4; ++e) { const unsigned a_ = qf[s & 1][2 * jt][e], b_ = qf[s & 1][2 * jt + 1][e]; n_[2 * e] = bflo(a_); n_[2 * e + 1] = bfhi(a_); n_[8 + 2 * e] = bflo(b_); n_[8 + 2 * e + 1] = bfhi(b_); }
#pragma unroll
                    for (int jt2 = 0; jt2 < 2; ++jt2)
#pragma unroll
                        for (int k = 0; k < 2; ++k) n_ = __builtin_amdgcn_mfma_f32_32x32x16_bf16(pf[s & 1][(jt * 2 + jt2) * 2 + k], B[jt2][k], n_, 0, 0, 0);
                    H[jt] = n_; }
#pragma unroll
                for (int jt = 0; jt < 2; ++jt)
#pragma unroll
                    for (int q = 0; q < 4; ++q) { const int row = 32 * it + cl, col = 32 * jt + 8 * q + 4 * hh;
                        *(LAS unsigned long long*)(hb + s * 8192 + sw16(row, col >> 3) + (col & 4) * 2) = (unsigned long long)pk2(H[jt][4 * q], H[jt][4 * q + 1]) | ((unsigned long long)pk2(H[jt][4 * q + 2], H[jt][4 * q + 3]) << 32); }
                RW_LOAD(s & 1, (step + PF < 255) ? step + PF : 254);
            }
        }
        asm volatile("s_waitcnt lgkmcnt(0)\n\ts_barrier" ::: "memory");
        if (!chain) {
            const int nst = (4 * g + 4 <= 255) ? 4 : 255 - 4 * g; unsigned char* dst = st + (size_t)(4 * g + 1) * 8192; const int ft = tid_ - 128;
            for (int o = ft * 16; o < nst * 8192; o += 384 * 16) { const int row_ = (o >> 7) & 63, chk_ = (o >> 4) & 7; *(v4u*)(dst + o) = *(const LAS v4u*)(hb + (o & ~8191) + sw16(row_, chk_)); }
        }
    }
    asm volatile("s_waitcnt vmcnt(0) lgkmcnt(0)\n\ts_barrier" ::: "memory");
#undef RW_LOAD
}

__device__ __forceinline__ void rwkv_r3(Frame& F, const Args& A) {
    PHASE_IDS();
    unsigned char* ws = A.ws;
    const bf16* VV = (const bf16*)(ws + WS_XN); const bf16* GG = (const bf16*)(ws + WS_F + 32 * MiB); const float* BON = (const float*)(ws + WS_BON);
    bf16* O = (bf16*)(ws + WS_F); const float* lg = A.in[16]; const float* lb = A.in[17];
    LAS float* Yt = (LAS float*)F.lds;
    const int w = wave_, l15 = lane_ & 15, kg = lane_ >> 4, r0 = 16 * (w >> 1), c0 = 32 * (w & 1);
#define R3_BAR() asm volatile("s_waitcnt lgkmcnt(0)\n\ts_barrier" ::: "memory")
    v4u nq, nvw, ngw; bf16x8 na[2], nb[2][2]; float nbon;
    const int pt_ = tid_ >> 3, pi0_ = 8 * (tid_ & 7);
#define R3_LOAD(itx) do { const int ch_ = (itx) >> 8, cc_ = (itx) & 255; const unsigned char* og_ = ws + pq_off(itx); const unsigned char* sg_ = (const unsigned char*)A.out + ST_OFF + (size_t)(itx) * 8192; \
        nq = *(const v4u*)((const unsigned char*)A.out + y0_off(itx, w * 64 + lane_)); \
        _Pragma("unroll") for (int ks = 0; ks < 2; ++ks) { na[ks] = *(const bf16x8*)(og_ + 16384 + (size_t)((r0 + l15) * 64 + 32 * ks + 8 * kg) * 2); \
            _Pragma("unroll") for (int n = 0; n < 2; ++n) nb[ks][n] = *(const bf16x8*)(sg_ + (size_t)((c0 + 16 * n + l15) * 64 + 32 * ks + 8 * kg) * 2); } \
        const size_t m_ = (size_t)(ch_ >> 3) * SEQ + (size_t)cc_ * 64 + pt_; const int col_ = 64 * (ch_ & 7) + pi0_; \
        nvw = *(const v4u*)(VV + m_ * 512 + col_); ngw = *(const v4u*)(GG + m_ * 512 + col_); nbon = BON[m_ * 8 + (ch_ & 7)]; } while (0)
    if ((int)blockIdx.x < CH_ITEMS) R3_LOAD((int)blockIdx.x);
    for (int it = blockIdx.x; it < CH_ITEMS; it += F.G) {
        const int ch = it >> 8, cc = it & 255, b = ch >> 3, h = ch & 7;
        f32x4c acc[2];
        acc[0] = (f32x4c){bflo(nq.x), bfhi(nq.x), bflo(nq.y), bfhi(nq.y)}; acc[1] = (f32x4c){bflo(nq.z), bfhi(nq.z), bflo(nq.w), bfhi(nq.w)};
#pragma unroll
        for (int ks = 0; ks < 2; ++ks)
#pragma unroll
            for (int n = 0; n < 2; ++n) acc[n] = __builtin_amdgcn_mfma_f32_16x16x32_bf16(na[ks], nb[ks][n], acc[n], 0, 0, 0);
        const v4u vw = nvw, gw4 = ngw; const float bon = nbon;
        { const int itn_ = (it + (int)F.G < CH_ITEMS) ? it + (int)F.G : it; R3_LOAD(itn_); }
        R3_BAR();
#pragma unroll
        for (int n = 0; n < 2; ++n)
#pragma unroll
            for (int e = 0; e < 4; ++e) Yt[(r0 + 4 * kg + e) * 68 + c0 + 16 * n + l15] = acc[n][e];
        R3_BAR();
        {   const int t = pt_, i0 = pi0_; const size_t m = (size_t)b * SEQ + (size_t)cc * 64 + t; const int col = 64 * h + i0;
            const f32x4 y0 = *(const LAS f32x4*)(Yt + t * 68 + i0), y1 = *(const LAS f32x4*)(Yt + t * 68 + i0 + 4);
            float s = (y0.x + y0.y) + (y0.z + y0.w) + (y1.x + y1.y) + (y1.z + y1.w);
            s += __shfl_xor(s, 1); s += __shfl_xor(s, 2); s += __shfl_xor(s, 4);
            const float mean = s * (1.f / 64.f); const f32x4 d0 = y0 - mean, d1 = y1 - mean;
            float q = (d0.x * d0.x + d0.y * d0.y) + (d0.z * d0.z + d0.w * d0.w) + (d1.x * d1.x + d1.y * d1.y) + (d1.z * d1.z + d1.w * d1.w);
            q += __shfl_xor(q, 1); q += __shfl_xor(q, 2); q += __shfl_xor(q, 4);
            const float rstd = 1.0f / sqrtf(q * (1.f / 64.f) + 64e-5f);
            const f32x4 g0 = *(const f32x4*)(lg + col), g1 = *(const f32x4*)(lg + col + 4), b0 = *(const f32x4*)(lb + col), b1 = *(const f32x4*)(lb + col + 4);
            f32x4 o0 = (d0 * rstd * g0 + b0), o1 = (d1 * rstd * g1 + b1);
            o0.x = (o0.x + bon * bflo(vw.x)) * bflo(gw4.x); o0.y = (o0.y + bon * bfhi(vw.x)) * bfhi(gw4.x); o0.z = (o0.z + bon * bflo(vw.y)) * bflo(gw4.y); o0.w = (o0.w + bon * bfhi(vw.y)) * bfhi(gw4.y);
            o1.x = (o1.x + bon * bflo(vw.z)) * bflo(gw4.z); o1.y = (o1.y + bon * bfhi(vw.z)) * bfhi(gw4.z); o1.z = (o1.z + bon * bflo(vw.w)) * bflo(gw4.w); o1.w = (o1.w + bon * bfhi(vw.w)) * bfhi(gw4.w);
            v4u ow; ow.x = pk2(o0.x, o0.y); ow.y = pk2(o0.z, o0.w); ow.z = pk2(o1.x, o1.y); ow.w = pk2(o1.z, o1.w);
            *(v4u*)(O + m * 512 + col) = ow; }
    }
#undef R3_BAR
#undef R3_LOAD
}

__device__ __forceinline__ void p_norm2_route(Frame& F, const Args& A) {
    PHASE_IDS();
    unsigned char* ws = A.ws;
    constexpr int WROW = 2064;
    LAS unsigned char* WH = F.lds; LAS unsigned char* WL = F.lds + 36 * WROW;
    LAS float* LG = (LAS float*)F.lds;
    LAS int* eid = (LAS int*)(F.lds + 128 * 36 * 4);
    const bf16* x1 = (const bf16*)(ws + WS_X1); const float* g2 = A.in[21]; const float* mod = (const float*)(ws + WS_MOD);
    const float* rgw = A.in[22]; const float* rgb = A.in[23]; const float* rew = A.in[24]; const float* reb = A.in[25];
    bf16* XN2 = (bf16*)(ws + WS_XN); int* route = (int*)(ws + WS_ROUTE); int* blkcnt = (int*)(ws + WS_BLKCNT);
    const int l15 = lane_ & 15, kg = lane_ >> 4;
    for (int blk = blockIdx.x; blk < M / 128; blk += F.G) {
        __syncthreads();
        for (int i = tid_; i < 4096; i += NWAVES * 64) { const float w = rgw[i]; const unsigned hi = f2bf(w); const unsigned lo = f2bf(w - __uint_as_float(hi << 16)); const int off = (i & 3) * WROW + (i >> 2) * 2;
            *(LAS unsigned short*)(WH + off) = (unsigned short)hi; *(LAS unsigned short*)(WL + off) = (unsigned short)lo; }
        for (int i = tid_; i < 32768; i += NWAVES * 64) { const float w = rew[i]; const unsigned hi = f2bf(w); const unsigned lo = f2bf(w - __uint_as_float(hi << 16)); const int off = (4 + (i & 31)) * WROW + (i >> 5) * 2;
            *(LAS unsigned short*)(WH + off) = (unsigned short)hi; *(LAS unsigned short*)(WL + off) = (unsigned short)lo; }
        __syncthreads();
        const int b = blk / (SEQ / 128); const size_t tok = (size_t)blk * 128 + wave_ * 16 + l15;
        const bf16* xrow = x1 + tok * D + 8 * kg; const float* gmp = g2 + 8 * kg; const float* scp = mod + b * 6144 + 4096 + 8 * kg; const float* shp = mod + b * 6144 + 3072 + 8 * kg;
        float ss = 0.f;
#pragma unroll 8
        for (int ks = 0; ks < 32; ++ks) { const v4u xw = *(const v4u*)(xrow + 32 * ks);
#pragma unroll
            for (int e = 0; e < 4; ++e) { const float lo_ = bflo(xw[e]), hi_ = bfhi(xw[e]); ss += lo_ * lo_ + hi_ * hi_; } }
        ss += __shfl_xor(ss, 16); ss += __shfl_xor(ss, 32);
        const float rstd = 1.0f / sqrtf(ss * (1.f / D) + 1e-6f);
        f32x4 acc[3]; acc[0] = f32x4{0.f, 0.f, 0.f, 0.f}; acc[1] = acc[0]; acc[2] = acc[0];
        int wcol[3];
#pragma unroll
        for (int ct = 0; ct < 3; ++ct) { const int col = 16 * ct + l15; wcol[ct] = (col < 36 ? col : 35) * WROW + 16 * kg; }
#pragma unroll 2
        for (int ks = 0; ks < 32; ++ks) {
            float hv[8];
            { const v4u xw = *(const v4u*)(xrow + 32 * ks); const f32x4 a = {bflo(xw.x), bfhi(xw.x), bflo(xw.y), bfhi(xw.y)}, c = {bflo(xw.z), bfhi(xw.z), bflo(xw.w), bfhi(xw.w)};
              const f32x4 g0 = *(const f32x4*)(gmp + 32 * ks), g1 = *(const f32x4*)(gmp + 32 * ks + 4), s0 = *(const f32x4*)(scp + 32 * ks), s1 = *(const f32x4*)(scp + 32 * ks + 4), h0 = *(const f32x4*)(shp + 32 * ks), h1 = *(const f32x4*)(shp + 32 * ks + 4);
              const f32x4 u0 = a * rstd * (g0 * (s0 + 1.0f)) + h0, u1 = c * rstd * (g1 * (s1 + 1.0f)) + h1;
              hv[0] = u0.x; hv[1] = u0.y; hv[2] = u0.z; hv[3] = u0.w; hv[4] = u1.x; hv[5] = u1.y; hv[6] = u1.z; hv[7] = u1.w; }
            unsigned hiw[4], low[4];
#pragma unroll
            for (int e = 0; e < 4; ++e) { const unsigned h0 = f2bf(hv[2 * e]), h1 = f2bf(hv[2 * e + 1]); hiw[e] = h0 | (h1 << 16);
                low[e] = f2bf(hv[2 * e] - __uint_as_float(h0 << 16)) | (f2bf(hv[2 * e + 1] - __uint_as_float(h1 << 16)) << 16); }
            v4u hq; hq.x = hiw[0]; hq.y = hiw[1]; hq.z = hiw[2]; hq.w = hiw[3];
            *(v4u*)(XN2 + tok * D + 32 * ks + 8 * kg) = hq;
            v4u lq; lq.x = low[0]; lq.y = low[1]; lq.z = low[2]; lq.w = low[3];
            const bf16x8 ah = __builtin_bit_cast(bf16x8, hq), al = __builtin_bit_cast(bf16x8, lq);
#pragma unroll
            for (int ct = 0; ct < 3; ++ct) { const bf16x8 bh = *(const LAS bf16x8*)(WH + wcol[ct] + 64 * ks), bl = *(const LAS bf16x8*)(WL + wcol[ct] + 64 * ks);
                acc[ct] = __builtin_amdgcn_mfma_f32_16x16x32_bf16(ah, bh, acc[ct], 0, 0, 0); acc[ct] = __builtin_amdgcn_mfma_f32_16x16x32_bf16(ah, bl, acc[ct], 0, 0, 0); acc[ct] = __builtin_amdgcn_mfma_f32_16x16x32_bf16(al, bh, acc[ct], 0, 0, 0); }
        }
        __syncthreads();
#pragma unroll
        for (int ct = 0; ct < 3; ++ct) { const int col = 16 * ct + l15; if (col < 36) { const float bias = (col < 4) ? rgb[col] : reb[col - 4];
#pragma unroll
            for (int e = 0; e < 4; ++e) LG[(wave_ * 16 + 4 * kg + e) * 36 + col] = acc[ct][e] + bias; } }
        __syncthreads();
        if (tid_ < 128) { const LAS float* lg = LG + tid_ * 36;
            int gi = 0; float gmax = lg[0];
#pragma unroll
            for (int i = 1; i < 4; ++i) if (lg[i] > gmax) { gmax = lg[i]; gi = i; }
            float den = 0.f;
#pragma unroll
            for (int i = 0; i < 4; ++i) den += __expf(lg[i] - gmax);
            const float gp = 1.0f / den;
            float el[8];
#pragma unroll
            for (int i = 0; i < 8; ++i) el[i] = lg[4 + 8 * gi + i];
            int i0 = 0; float m0 = el[0];
#pragma unroll
            for (int i = 1; i < 8; ++i) if (el[i] > m0) { m0 = el[i]; i0 = i; }
            int i1 = -1; float m1 = -INFINITY;
#pragma unroll
            for (int i = 0; i < 8; ++i) if (i != i0 && el[i] > m1) { m1 = el[i]; i1 = i; }
            if (i1 < 0) { i1 = (i0 + 1) & 7; m1 = m0; }
            const float p1 = __expf(m1 - m0), w0 = gp / (1.0f + p1), w1 = gp * p1 / (1.0f + p1);
            int* rt_ = route + ((size_t)blk * 128 + tid_) * 8; rt_[0] = gi * 8 + i0; rt_[1] = gi * 8 + i1; rt_[2] = __float_as_int(w0); rt_[3] = __float_as_int(w1);
            eid[tid_ * 2] = gi * 8 + i0; eid[tid_ * 2 + 1] = gi * 8 + i1; }
        __syncthreads();
        if (tid_ < 256) { const int e = eid[tid_]; int rk = 0; for (int a = 0; a < tid_; ++a) rk += (eid[a] == e) ? 1 : 0; route[((size_t)blk * 128 + (tid_ >> 1)) * 8 + 4 + (tid_ & 1)] = rk; }
        else if (tid_ < 288) { const int e = tid_ - 256; int cn = 0; for (int a = 0; a < 256; ++a) cn += (eid[a] == e) ? 1 : 0; blkcnt[blk * 32 + e] = cn; }
    }
}

__device__ __forceinline__ void conv_experts(Frame& F, const Args& A) {
    PHASE_IDS();
    unsigned char* ws = A.ws; bf16* W13 = (bf16*)(ws + WS_W13); bf16* W2T = (bf16*)(ws + WS_W2T);
    LAS float* scr = (LAS float*)(F.lds + RING_OFF + wave_ * 16384);
    const int gw = F.vcu * NWAVES + wave_, NGW = F.G * NWAVES;
    for (int it = gw; it < 3 * 8192; it += NGW) {
        const int which = it >> 13, r = it & 8191;
        if (which < 2) { const int e = r >> 8, kb = (r >> 4) & 15, nb = r & 15, n0 = 32 * nb;
            transpose_item(A.in[26 + which] + (size_t)e * 1024 * 512, 512, n0, 64 * kb, 1024, W13, (size_t)e * 1024 + (n0 >> 7) * 256 + which * 128 + (n0 & 127), scr, lane_); }
        else { const int e = r >> 8, kb = (r >> 5) & 7, nb = r & 31;
            transpose_item(A.in[28] + (size_t)e * 512 * 1024, 1024, 32 * nb, 64 * kb, 512, W2T, (size_t)e * 1024 + 32 * nb, scr, lane_); }
    }
}

__device__ __forceinline__ void p_slots(Frame& F, const Args& A) {
    PHASE_IDS();
    unsigned char* ws = A.ws;
    LAS int* tile_e = (LAS int*)(F.lds + TILE_OFF); LAS int* base = tile_e + 288; LAS int* tot = base + 32; LAS int* pre = tot + 32; LAS int* ntl = pre + 32; LAS int* part = ntl + 4;
    const int* blkcnt = (const int*)(ws + WS_BLKCNT); int* route = (int*)(ws + WS_ROUTE); int* rowtok = (int*)(ws + WS_ROWTOK);
    { const int e = tid_ & 31, pt = tid_ >> 5; int s = 0; for (int bb = 16 * pt; bb < 16 * pt + 16; ++bb) s += blkcnt[bb * 32 + e]; part[pt * 32 + e] = s; }
    __syncthreads();
    if (tid_ < 32) { int t = 0; for (int p = 0; p < 16; ++p) t += part[p * 32 + tid_]; tot[tid_] = t; }
    __syncthreads();
    if (tid_ == 0) { int run = 0, nt = 0; for (int e = 0; e < 32; ++e) { base[e] = run; const int pad = (tot[e] + 255) >> 8; for (int i = 0; i < pad; ++i) tile_e[nt++] = e; run += pad * 256; } ntl[0] = nt; }
    __syncthreads();
    for (int blk = blockIdx.x; blk < M / 128; blk += F.G) {
        { const int e = tid_ & 31, pt = tid_ >> 5; int s = 0; for (int bb = pt; bb < blk; bb += 16) s += blkcnt[bb * 32 + e]; part[pt * 32 + e] = s; }
        __syncthreads();
        if (tid_ < 32) { int p = 0; for (int q = 0; q < 16; ++q) p += part[q * 32 + tid_]; pre[tid_] = p; }
        __syncthreads();
        if (tid_ < 256) { const size_t tok = (size_t)blk * 128 + (tid_ >> 1); const int k = tid_ & 1; const int e = route[tok * 8 + k], lr = route[tok * 8 + 4 + k];
            const int slot = base[e] + pre[e] + lr; route[tok * 8 + 6 + k] = slot; rowtok[slot] = (int)tok; }
        __syncthreads();
    }
    for (int e = blockIdx.x; e < 32; e += F.G) { const int lo = base[e] + tot[e], hi = base[e] + (((tot[e] + 255) >> 8) << 8); for (int s = lo + tid_; s < hi; s += NWAVES * 64) rowtok[s] = 0; }
}

#ifndef STAGE_UNUSED
#define STAGE 4
#endif
#ifndef PHASES
#define PHASES 0xffff
#endif
#ifndef RWKV_CHUNKED
#define RWKV_CHUNKED 1
#endif

__device__ __forceinline__ void ph_gemm1(Frame& F, const Args& args) { unsigned char* ws = args.ws;
    pg8::Gemm g{(const pg8::bf16_t*)(ws + WS_XN), (const pg8::bf16_t*)(ws + WS_WIN), nullptr, 1024, NIN};
    pg8::StaticOrder S; S.init(M, NIN, F.G, (int)blockIdx.x);
    pg8::EpiIn E{(pg8::bf16_t*)(ws + WS_Q), (pg8::bf16_t*)(ws + WS_K), (pg8::bf16_t*)(ws + WS_V), (pg8::bf16_t*)(ws + WS_PRW), (pg8::bf16_t*)(ws + WS_GATES), ATT_C2};
    pg8::gemm_phase<pg8::EpiIn, pg8::StaticOrder>(F.lds + RING_OFF, g, S, E); }
__device__ __forceinline__ void ph_attn_wrap(unsigned char* lds, Frame& F, const Args& args, size_t out_off, int qslot) { unsigned char* ws = args.ws;
    const attn_body::AttnTensors AT{(const attn_body::bf16*)(ws + WS_Q), (const attn_body::bf16*)(ws + WS_K), (const attn_body::bf16*)(ws + WS_V), (attn_body::bf16*)(ws + out_off), (const float*)(ws + WS_CUM), (const float*)(ws + WS_SEGTOT)};
    attn_body::attn_phase_dyn<8>((char*)lds + RING_OFF, AT, (unsigned*)(F.ctl + CW_QUEUE + 64 * qslot), (const unsigned*)(F.ctl + CW_QKMAX), (const unsigned*)(F.ctl + CW_KTMAX), TAB_OFF, SEGP_OFF); }
__device__ __forceinline__ void ph_gemm2a(Frame& F, const Args& args) { unsigned char* ws = args.ws;
    pg8::Gemm g{(const pg8::bf16_t*)(ws + WS_Q), (const pg8::bf16_t*)(ws + WS_WOF), nullptr, 512, 1024};
    pg8::StaticOrder S; S.init(M, 1024, F.G, (int)blockIdx.x);
    pg8::EpiGate<1> E{(pg8::bf16_t*)(ws + WS_TMP), 1024, (const pg8::bf16_t*)(ws + WS_GATES), 2048, 0};
    pg8::gemm_phase<pg8::EpiGate<1>, pg8::StaticOrder>(F.lds + RING_OFF, g, S, E); }
__device__ __forceinline__ void ph_gemm2b(Frame& F, const Args& args) { unsigned char* ws = args.ws;
    pg8::Gemm g{(const pg8::bf16_t*)(ws + WS_F), (const pg8::bf16_t*)(ws + WS_WOR), nullptr, 512, 1024};
    pg8::StaticOrder S; S.init(M, 1024, F.G, (int)blockIdx.x);
    pg8::EpiGate<2> E{(pg8::bf16_t*)(ws + WS_TMP), 1024, (const pg8::bf16_t*)(ws + WS_GATES), 2048, 1024};
    pg8::gemm_phase<pg8::EpiGate<2>, pg8::StaticOrder>(F.lds + RING_OFF, g, S, E); }
__device__ __forceinline__ void ph_gemm3(Frame& F, const Args& args) { unsigned char* ws = args.ws;
    pg8::Gemm g{(const pg8::bf16_t*)(ws + WS_TMP), (const pg8::bf16_t*)(ws + WS_WO), nullptr, 1024, 1024};
    pg8::StaticOrder S; S.init(M, 1024, F.G, (int)blockIdx.x);
    pg8::EpiRes E{args.in[0], (pg8::bf16_t*)(ws + WS_X1), (const float*)(ws + WS_MOD) + 2048, SEQ, 6144};
    pg8::gemm_phase<pg8::EpiRes, pg8::StaticOrder>(F.lds + RING_OFF, g, S, E); }
__device__ __forceinline__ void ph_moe_up(Frame& F, const Args& args) { unsigned char* ws = args.ws;
    const LAS int* tile_e = (const LAS int*)(F.lds + TILE_OFF); const int ntiles = tile_e[288 + 96];
    LAS int* rows = (LAS int*)(F.lds + TILE_OFF + 4096);
    { const int* rowtok = (const int*)(ws + WS_ROWTOK); int tid_ = threadIdx.x; asm volatile("" : "+v"(tid_));
      for (int i = 0; i < 8; ++i) { const int L = i * F.G + (int)blockIdx.x; if (L >= ntiles * 4) break; if (tid_ < 256) rows[i * 256 + tid_] = rowtok[(L >> 2) * 256 + tid_]; }
      __syncthreads(); }
    pg8::Gemm g{(const pg8::bf16_t*)(ws + WS_XN), (const pg8::bf16_t*)(ws + WS_W13), rows, 1024, 1024};
    pg8::MoeOrder S{ntiles * 4, F.G, (int)blockIdx.x, 2, tile_e};
    pg8::EpiSwiGLU E{(pg8::bf16_t*)(ws + WS_H)};
    pg8::gemm_phase<pg8::EpiSwiGLU, pg8::MoeOrder, true>(F.lds + RING_OFF, g, S, E); }
__device__ __forceinline__ void ph_moe_down(Frame& F, const Args& args) { unsigned char* ws = args.ws;
    const LAS int* tile_e = (const LAS int*)(F.lds + TILE_OFF); const int ntiles = tile_e[288 + 96];
    pg8::Gemm g{(const pg8::bf16_t*)(ws + WS_H), (const pg8::bf16_t*)(ws + WS_W2T), nullptr, 512, 1024};
    pg8::MoeOrder S{ntiles * 4, F.G, (int)blockIdx.x, 2, tile_e};
    pg8::EpiFp8 E{ws + WS_YM, 1024};
    pg8::gemm_phase<pg8::EpiFp8, pg8::MoeOrder>(F.lds + RING_OFF, g, S, E); }

__global__ void __launch_bounds__(NWAVES * 64, 2) fwd_kernel(Args args) {
    extern __shared__ __attribute__((aligned(16))) unsigned char lds[];
    Frame F;
    F.lds = (LAS unsigned char*)lds;
    F.MISC = (volatile LAS unsigned*)(F.lds + MISC_OFF);
    F.tid = threadIdx.x; F.lane = F.tid & 63; F.wave = __builtin_amdgcn_readfirstlane(F.tid >> 6);
    F.G = gridDim.x; { const int bx = blockIdx.x; F.vcu = (F.G % 8 == 0) ? (bx % 8) * (F.G / 8) + bx / 8 : bx; }
    unsigned char* ws = args.ws;
    F.ctl = (gu32*)(ws + WS_CTL);
    for (int u = F.tid; u < (LDS_BYTES - LDSCTL_OFF) / 4; u += NWAVES * 64) ((LAS unsigned*)(F.lds + LDSCTL_OFF))[u] = 0u;
    __syncthreads();
    XcdBarrier bar = xcd_barrier_post((unsigned*)(F.ctl + CW_BAR), F.MISC + 8);
#define GRID_BAR() xcd_barrier(bar)

    p0_prologue(F, args); GRID_BAR();
    p1_norm(F, args); __syncthreads(); p_convert_early(F, args); GRID_BAR();
    p_cumfix(F, args);
    ph_gemm1(F, args); GRID_BAR();
    p_qknorm(F, args, (unsigned*)(F.ctl + CW_QKMAX), (unsigned*)(F.ctl + CW_KTMAX));
    for (int cb = (int)blockIdx.x; cb < SEQ / 64; cb += F.G)
    for (int half = 0; half < 2; ++half) {
        rwkv_pre<0>(F, args, cb + 256 * half, cb + 256 * half + 1);
        __syncthreads();
        rwkv_r1<0>(F, args, cb + 2048 * half, cb + 2048 * half + 2048, 256);
        __syncthreads();
    }
    GRID_BAR();
    rwkv_r2w(F, args, (unsigned char*)args.out + ST_OFF);
    ph_attn_wrap(lds, F, args, WS_Q, 0); GRID_BAR();
    rwkv_r3(F, args); GRID_BAR();
    ph_gemm2a(F, args);
    ph_gemm2b(F, args); GRID_BAR();
    ph_gemm3(F, args); GRID_BAR();
    p_norm2_route(F, args); GRID_BAR();
    p_slots(F, args); conv_experts(F, args); GRID_BAR();
    ph_moe_up(F, args); GRID_BAR();
    ph_moe_down(F, args); GRID_BAR();
    p_final<1>(F, args, args.out);
}

extern "C" void kernel_launch(void* const* d_in, const int* in_sizes, int n_in, void* d_out, int out_size, void* d_ws, size_t ws_size, hipStream_t stream) {
    static int grid = 0;
    if (grid == 0) {
        if (n_in != 30 || in_sizes[0] != M * D || out_size != M * D || ws_size < WS_END) { fprintf(stderr, "kernel_launch: unexpected shapes (n_in %d, in0 %d, out %d, ws %zu)\n", n_in, n_in > 0 ? in_sizes[0] : -1, out_size, ws_size); grid = -1; return; }
        int dev = 0, cus = 0, per_cu = 0;
        if (hipGetDevice(&dev) != hipSuccess || hipDeviceGetAttribute(&cus, hipDeviceAttributeMultiprocessorCount, dev) != hipSuccess) { grid = -1; return; }
        if (hipFuncSetAttribute((const void*)fwd_kernel, hipFuncAttributeMaxDynamicSharedMemorySize, LDS_BYTES) != hipSuccess) { fprintf(stderr, "kernel_launch: hipFuncSetAttribute failed\n"); grid = -1; return; }
        if (hipOccupancyMaxActiveBlocksPerMultiprocessor(&per_cu, (const void*)fwd_kernel, NWAVES * 64, LDS_BYTES) != hipSuccess || per_cu < 1)
            fprintf(stderr, "kernel_launch: occupancy query reports %d\n", per_cu);
        (void)hipGetLastError();
        grid = cus;
        if (grid > 256) grid = 256;
    }
    if (grid < 0) return;
    if (hipMemsetAsync((char*)d_ws + WS_CTL, 0, CTL_ZERO_BYTES, stream) != hipSuccess) return;
    Args a{};
    for (int i = 0; i < 30; ++i) a.in[i] = (const float*)d_in[i];
    a.out = (float*)d_out; a.ws = (unsigned char*)d_ws;
    hipLaunchKernelGGL(fwd_kernel, dim3(grid), dim3(NWAVES * 64), LDS_BYTES, stream, a);
}
```

```cpp
#include <hip/hip_runtime.h>
#include <hip/hip_bf16.h>
#include <cstdio>
#include <cstdint>
#include <cmath>

namespace pg8 {
#define PG8_LAS __attribute__((address_space(3)))
typedef unsigned short bf16_t;
typedef short bf16x8 __attribute__((ext_vector_type(8)));
typedef float f32x4 __attribute__((ext_vector_type(4)));
typedef unsigned u32x4 __attribute__((ext_vector_type(4)));
typedef unsigned u32x2 __attribute__((ext_vector_type(2)));
constexpr int BM = 256, BK = 64, HALF = 128, HTB = HALF * BK * 2, STAGE_BYTES = 8 * HTB, NXCD = 8, WGM = 8;

__host__ __device__ __forceinline__ int lds_byte(int r, int c) { const int st = (r >> 4) * 2 + (c >> 5), rr = r & 15, cc = c & 31, ob = rr * 64 + cc * 2; return st * 1024 + (ob ^ (((ob >> 9) & 1) << 5)); }
__host__ __device__ __forceinline__ void stage_rc(int b, int& R, int& C) { const int st = b / 1024, sb = b % 1024, swz = sb ^ (((sb >> 9) & 1) << 5); R = (st >> 1) * 16 + swz / 64; C = (st & 1) * 32 + (swz % 64) / 2; }
__host__ __device__ __forceinline__ int perm32(int rho) { const int n = rho >> 4, i = rho & 15; return 8 * (i >> 2) + 4 * n + (i & 3); }

struct Unit { int pm, pn, e; };
struct Gemm { const bf16_t* A; const bf16_t* Bt; const PG8_LAS int* rowlds; int K; int nB; };

struct StaticOrder {
    int nM, nN, nwg, G, c;
    __host__ __device__ void init(int M, int N, int G_, int c_) { nM = M / BM; nN = N / BM; nwg = nM * nN; G = G_; c = c_; }
    __host__ __device__ bool next(int i, Unit& u) const {
        const long L = (long)i * G + c; if (L >= nwg) return false;
        int wgid = (int)L; { const int q = nwg / NXCD, r = nwg % NXCD, xcd = wgid % NXCD, off = wgid / NXCD; wgid = (xcd < r ? xcd * (q + 1) : r * (q + 1) + (xcd - r) * q) + off; }
        const int nig = WGM * nN, gid = wgid / nig, fm = gid * WGM, gsz = (nM - fm) < WGM ? (nM - fm) : WGM;
        u.pm = fm + ((wgid % nig) % gsz); u.pn = (wgid % nig) / gsz; u.e = 0; return true;
    }
};

__device__ __forceinline__ unsigned cvt_pk_bf16(float lo, float hi) { unsigned r; asm volatile("v_cvt_pk_bf16_f32 %0, %1, %2" : "=v"(r) : "v"(lo), "v"(hi)); return r; }
__device__ __forceinline__ float bf_lo(unsigned w) { return __uint_as_float(w << 16); }
__device__ __forceinline__ float bf_hi(unsigned w) { return __uint_as_float(w & 0xffff0000u); }
__device__ __forceinline__ float fsigmoid(float x) { return __builtin_amdgcn_rcpf(1.0f + __builtin_amdgcn_exp2f(-1.4426950408889634f * x)); }

template <class Epi, class Sched, bool GATHER = false>
__device__ __forceinline__ void gemm_phase(PG8_LAS unsigned char* lds, const Gemm g, const Sched& S, const Epi& E) {
    int tid_ = threadIdx.x; asm volatile("" : "+v"(tid_));
    const int tid = tid_, wid = __builtin_amdgcn_readfirstlane(tid >> 6), lane = tid & 63, wr = wid >> 2, wc = wid & 3, fr = lane & 15, fq = lane >> 4;
    const int K = g.K, nt = K / BK;
    int RA[2], CA[2]; unsigned voffA[2], voffB[2];
#pragma unroll
    for (int i = 0; i < 2; ++i) { int R, C; stage_rc(tid * 16 + i * 8192, R, C); const int Rb = Epi::PERM ? ((R & ~31) + perm32(R & 31)) : R;
        RA[i] = R; CA[i] = C; voffA[i] = (unsigned)(R * K + C) * 2u; voffB[i] = (unsigned)(Rb * K + C) * 2u; }
    const size_t tstep = 2 * (size_t)HALF * K * 2;
    const size_t kstep = (size_t)(BK * 2);
    const size_t hstep = (size_t)HALF * K * 2;
    const unsigned ldsw = (unsigned)wid * 1024u;
    const int aoff = lds_byte(wr * 64 + fr, fq * 8), boff = lds_byte(wc * 32 + fr, fq * 8);
#define PG8_SA(b, h) (((b) * 2 + (h)) * HTB)
#define PG8_SB(b, h) ((4 + (b) * 2 + (h)) * HTB)
#define PG8_STAGE(bufoff, gbase, v0, v1) do { \
        __builtin_amdgcn_global_load_lds((const unsigned*)((const char*)(gbase) + (v0)), (PG8_LAS unsigned*)(lds + (bufoff) + ldsw), 16, 0, 0); \
        __builtin_amdgcn_global_load_lds((const unsigned*)((const char*)(gbase) + (v1)), (PG8_LAS unsigned*)(lds + (bufoff) + ldsw + 8192), 16, 0, 0); } while (0)
#define PG8_STAGEB(bufoff, gbase) PG8_STAGE(bufoff, gbase, voffB[0], voffB[1])
#define PG8_STAGEA(bufoff, abase, h, VA) do { if constexpr (GATHER) { PG8_STAGE(bufoff, abase, VA[h][0], VA[h][1]); } else { PG8_STAGE(bufoff, (abase) + (h) * hstep, voffA[0], voffA[1]); } } while (0)
#define PG8_LDA(dst, b, h) do { _Pragma("unroll") for (int m = 0; m < 4; ++m) _Pragma("unroll") for (int k = 0; k < 2; ++k) dst[m][k] = *(const PG8_LAS bf16x8*)(lds + PG8_SA(b, h) + aoff + m * 2048 + k * 1024); } while (0)
#define PG8_LDB(dst, b, h) do { _Pragma("unroll") for (int n = 0; n < 2; ++n) _Pragma("unroll") for (int k = 0; k < 2; ++k) dst[n][k] = *(const PG8_LAS bf16x8*)(lds + PG8_SB(b, h) + boff + n * 2048 + k * 1024); } while (0)
#define PG8_MMA(ai, bj, At, Bt) do { __builtin_amdgcn_s_setprio(1); _Pragma("unroll") for (int m = 0; m < 4; ++m) _Pragma("unroll") for (int n = 0; n < 2; ++n) _Pragma("unroll") for (int k = 0; k < 2; ++k) \
        acc[ai][bj][m][n] = __builtin_amdgcn_mfma_f32_16x16x32_bf16(Bt[n][k], At[m][k], acc[ai][bj][m][n], 0, 0, 0); __builtin_amdgcn_s_setprio(0); } while (0)
#define PG8_WAIT_V(n) asm volatile("s_waitcnt vmcnt(" #n ")" ::: "memory")
#define PG8_WAIT_L(n) asm volatile("s_waitcnt lgkmcnt(" #n ")" ::: "memory")
#define PG8_BAR __builtin_amdgcn_s_barrier()
#define PG8_SCHED __builtin_amdgcn_sched_barrier(0)
#define PG8_AOFF(dst, ord) do { _Pragma("unroll") for (int h_ = 0; h_ < 2; ++h_) _Pragma("unroll") for (int i_ = 0; i_ < 2; ++i_) { \
        const int src_ = g.rowlds[(ord) * BM + h_ * HALF + RA[i_]]; dst[h_][i_] = (unsigned)(src_ * K + CA[i_]) * 2u; } } while (0)
    Unit cur, nxt; int ui = 0;
    if (!S.next(0, cur)) return;
    f32x4 acc[2][2][4][2];
#pragma unroll
    for (int a = 0; a < 2; ++a)
#pragma unroll
        for (int b = 0; b < 2; ++b)
#pragma unroll
            for (int m = 0; m < 4; ++m)
#pragma unroll
                for (int n = 0; n < 2; ++n) acc[a][b][m][n] = (f32x4){0.f, 0.f, 0.f, 0.f};
    bf16x8 At[4][2], B0[2][2], B1[2][2];
    unsigned vA[2][2], nvA[2][2];
    if constexpr (GATHER) { PG8_AOFF(vA, 0); }
    const char* cA = GATHER ? (const char*)g.A : (const char*)g.A + (size_t)cur.pm * tstep;
    const char* cB = (const char*)g.Bt + ((size_t)cur.e * g.nB + (size_t)cur.pn * BM) * K * 2;
    PG8_STAGEB(PG8_SB(0, 0), cB); PG8_STAGEB(PG8_SB(0, 1), cB + hstep); PG8_STAGEA(PG8_SA(0, 0), cA, 0, vA); PG8_STAGEA(PG8_SA(0, 1), cA, 1, vA);
    if (wr == 1) PG8_BAR;
    PG8_WAIT_V(2); PG8_BAR;
    PG8_STAGEB(PG8_SB(1, 0), cB + kstep); PG8_STAGEA(PG8_SA(1, 0), cA + kstep, 0, vA); PG8_STAGEB(PG8_SB(1, 1), cB + hstep + kstep);
    PG8_WAIT_V(6); PG8_BAR;
    for (;;) {
        const bool has_next = S.next(ui + 1, nxt);
        if constexpr (GATHER) { if (has_next) { PG8_AOFF(nvA, ui + 1); } else {
#pragma unroll
            for (int h_ = 0; h_ < 2; ++h_)
#pragma unroll
                for (int i_ = 0; i_ < 2; ++i_) nvA[h_][i_] = vA[h_][i_]; } }
        const char* nA = GATHER ? cA : (has_next ? (const char*)g.A + (size_t)nxt.pm * tstep : cA);
        const char* nB = has_next ? (const char*)g.Bt + ((size_t)nxt.e * g.nB + (size_t)nxt.pn * BM) * K * 2 : cB;
        for (int t = 0; t < nt; t += 2) {
            const bool last = (t == nt - 2);
            const char* a1 = cA + (size_t)(t + 1) * kstep;
            const char* a2 = last ? nA : cA + (size_t)(t + 2) * kstep; const char* b2 = last ? nB : cB + (size_t)(t + 2) * kstep;
            const char* a3 = a2 + kstep; const char* b3 = b2 + kstep;
            unsigned wv[2][2];
            if constexpr (GATHER) { wv[0][0] = last ? nvA[0][0] : vA[0][0]; wv[0][1] = last ? nvA[0][1] : vA[0][1]; wv[1][0] = last ? nvA[1][0] : vA[1][0]; wv[1][1] = last ? nvA[1][1] : vA[1][1]; }
            PG8_LDB(B0, 0, 0); PG8_LDB(B1, 0, 1); PG8_SCHED; PG8_LDA(At, 0, 0); PG8_STAGEA(PG8_SA(1, 1), a1, 1, vA);
            PG8_WAIT_V(8); PG8_WAIT_L(0); PG8_BAR; PG8_MMA(0, 0, At, B0); PG8_MMA(0, 1, At, B1); PG8_BAR; PG8_SCHED;
            PG8_LDA(At, 0, 1); PG8_STAGEB(PG8_SB(0, 0), b2); PG8_STAGEB(PG8_SB(0, 1), b2 + hstep); PG8_STAGEA(PG8_SA(0, 0), a2, 0, wv);
            PG8_WAIT_V(8); PG8_WAIT_L(0); PG8_BAR; PG8_MMA(1, 0, At, B0); PG8_MMA(1, 1, At, B1); PG8_BAR; PG8_SCHED;
            PG8_LDB(B0, 1, 0); PG8_LDB(B1, 1, 1); PG8_SCHED; PG8_LDA(At, 1, 0); PG8_STAGEA(PG8_SA(0, 1), a2, 1, wv);
            PG8_WAIT_V(8); PG8_WAIT_L(0); PG8_BAR; PG8_MMA(0, 0, At, B0); PG8_MMA(0, 1, At, B1); PG8_BAR; PG8_SCHED;
            PG8_LDA(At, 1, 1); PG8_STAGEB(PG8_SB(1, 0), b3); PG8_STAGEB(PG8_SB(1, 1), b3 + hstep); PG8_STAGEA(PG8_SA(1, 0), a3, 0, wv);
            PG8_WAIT_V(8); PG8_WAIT_L(0); PG8_BAR; PG8_MMA(1, 0, At, B0); PG8_MMA(1, 1, At, B1); PG8_BAR; PG8_SCHED;
        }
        if (wr == 0) PG8_BAR;
        E(acc, cur, wr, wc, fr, fq);
        if (!has_next) break;
#pragma unroll
        for (int a = 0; a < 2; ++a)
#pragma unroll
            for (int b = 0; b < 2; ++b)
#pragma unroll
                for (int m = 0; m < 4; ++m)
#pragma unroll
                    for (int n = 0; n < 2; ++n) acc[a][b][m][n] = (f32x4){0.f, 0.f, 0.f, 0.f};
        cur = nxt; cB = nB; cA = nA; ++ui;
        if constexpr (GATHER) {
#pragma unroll
        for (int h_ = 0; h_ < 2; ++h_)
#pragma unroll
            for (int i_ = 0; i_ < 2; ++i_) vA[h_][i_] = nvA[h_][i_]; }
        if (wr == 1) PG8_BAR;
    }
    PG8_WAIT_V(0);
    PG8_BAR;
#undef PG8_SA
#undef PG8_SB
#undef PG8_STAGE
#undef PG8_STAGEB
#undef PG8_STAGEA
#undef PG8_LDA
#undef PG8_LDB
#undef PG8_MMA
#undef PG8_WAIT_V
#undef PG8_WAIT_L
#undef PG8_BAR
#undef PG8_SCHED
#undef PG8_AOFF
}
}

namespace pg8 {
struct EpiIn {
    static constexpr bool PERM = true;
    bf16_t *Q, *Kb, *V, *PRW, *GT; float qscale;
    __device__ __forceinline__ void operator()(const f32x4 (&acc)[2][2][4][2], const Unit& u, int wr, int wc, int fr, int fq) const {
        const int pn = u.pn; bf16_t* base; int ld, colt, mode = 0;
        if (pn < 2) { base = Q; ld = 512; colt = pn * 256; mode = 1; }
        else if (pn < 4) { base = Kb; ld = 512; colt = (pn - 2) * 256; }
        else if (pn < 6) { base = V; ld = 512; colt = (pn - 4) * 256; }
        else if (pn < 13) { base = PRW; ld = 1792; colt = (pn - 6) * 256; }
        else { base = GT; ld = 2048; colt = (pn - 13) * 256; mode = 2; }
        const int row0 = u.pm * BM + wr * 64 + fr, col0 = colt + wc * 32 + 8 * fq;
        const float sc = (mode == 1) ? qscale : 1.0f;
#pragma unroll
        for (int ai = 0; ai < 2; ++ai)
#pragma unroll
            for (int m = 0; m < 4; ++m) { bf16_t* rowp = base + (size_t)(row0 + ai * HALF + m * 16) * ld + col0;
#pragma unroll
                for (int bj = 0; bj < 2; ++bj) { f32x4 v0 = acc[ai][bj][m][0] * sc, v1 = acc[ai][bj][m][1] * sc;
                    if (mode == 2) {
#pragma unroll
                        for (int e = 0; e < 4; ++e) { v0[e] = fsigmoid(v0[e]); v1[e] = fsigmoid(v1[e]); } }
                    u32x4 w; w.x = cvt_pk_bf16(v0[0], v0[1]); w.y = cvt_pk_bf16(v0[2], v0[3]); w.z = cvt_pk_bf16(v1[0], v1[1]); w.w = cvt_pk_bf16(v1[2], v1[3]);
                    *(u32x4*)(rowp + bj * HALF) = w; } }
    }
};
template <int MODE> struct EpiGate {
    static constexpr bool PERM = true;
    bf16_t* O; int ldo; const bf16_t* G; int ldg; int gcol0;
    __device__ __forceinline__ void operator()(const f32x4 (&acc)[2][2][4][2], const Unit& u, int wr, int wc, int fr, int fq) const {
        const int row0 = u.pm * BM + wr * 64 + fr, col0 = u.pn * BM + wc * 32 + 8 * fq;
#pragma unroll
        for (int ai = 0; ai < 2; ++ai)
#pragma unroll
            for (int m = 0; m < 4; ++m) { const size_t row = (size_t)(row0 + ai * HALF + m * 16); bf16_t* rowp = O + row * ldo + col0;
#pragma unroll
                for (int bj = 0; bj < 2; ++bj) { f32x4 v0 = acc[ai][bj][m][0], v1 = acc[ai][bj][m][1];
                    if (MODE >= 1) { const u32x4 gw = *(const u32x4*)(G + row * ldg + gcol0 + col0 + bj * HALF);
                        v0[0] *= bf_lo(gw.x); v0[1] *= bf_hi(gw.x); v0[2] *= bf_lo(gw.y); v0[3] *= bf_hi(gw.y); v1[0] *= bf_lo(gw.z); v1[1] *= bf_hi(gw.z); v1[2] *= bf_lo(gw.w); v1[3] *= bf_hi(gw.w); }
                    if (MODE == 2) { const u32x4 ow = *(const u32x4*)(rowp + bj * HALF);
                        v0[0] += bf_lo(ow.x); v0[1] += bf_hi(ow.x); v0[2] += bf_lo(ow.y); v0[3] += bf_hi(ow.y); v1[0] += bf_lo(ow.z); v1[1] += bf_hi(ow.z); v1[2] += bf_lo(ow.w); v1[3] += bf_hi(ow.w); }
                    u32x4 w; w.x = cvt_pk_bf16(v0[0], v0[1]); w.y = cvt_pk_bf16(v0[2], v0[3]); w.z = cvt_pk_bf16(v1[0], v1[1]); w.w = cvt_pk_bf16(v1[2], v1[3]);
                    *(u32x4*)(rowp + bj * HALF) = w; } }
    }
};
struct EpiRes {
    static constexpr bool PERM = true;
    const float* X; bf16_t* O; const float* gate; int seq; int gstride;
    __device__ __forceinline__ void operator()(const f32x4 (&acc)[2][2][4][2], const Unit& u, int wr, int wc, int fr, int fq) const {
        const int row0 = u.pm * BM + wr * 64 + fr, col0 = u.pn * BM + wc * 32 + 8 * fq;
        const float* gp = gate + (size_t)((u.pm * BM) / seq) * gstride + col0;
        f32x4 gv[2][2];
#pragma unroll
        for (int bj = 0; bj < 2; ++bj)
#pragma unroll
            for (int n = 0; n < 2; ++n) gv[bj][n] = *(const f32x4*)(gp + bj * HALF + n * 4);
#pragma unroll
        for (int ai = 0; ai < 2; ++ai)
#pragma unroll
            for (int m = 0; m < 4; ++m) { const size_t off = (size_t)(row0 + ai * HALF + m * 16) * 1024 + col0;
#pragma unroll
                for (int bj = 0; bj < 2; ++bj) { const f32x4 x0 = *(const f32x4*)(X + off + bj * HALF), x1 = *(const f32x4*)(X + off + bj * HALF + 4);
                    const f32x4 v0 = x0 + gv[bj][0] * acc[ai][bj][m][0], v1 = x1 + gv[bj][1] * acc[ai][bj][m][1];
                    u32x4 w; w.x = cvt_pk_bf16(v0[0], v0[1]); w.y = cvt_pk_bf16(v0[2], v0[3]); w.z = cvt_pk_bf16(v1[0], v1[1]); w.w = cvt_pk_bf16(v1[2], v1[3]);
                    *(u32x4*)(O + off + bj * HALF) = w; } }
    }
};
struct EpiSwiGLU {
    static constexpr bool PERM = true;
    bf16_t* H;
    __device__ __forceinline__ void operator()(const f32x4 (&acc)[2][2][4][2], const Unit& u, int wr, int wc, int fr, int fq) const {
        const int row0 = u.pm * BM + wr * 64 + fr, col0 = u.pn * HALF + wc * 32 + 8 * fq;
#pragma unroll
        for (int ai = 0; ai < 2; ++ai)
#pragma unroll
            for (int m = 0; m < 4; ++m) { bf16_t* rowp = H + (size_t)(row0 + ai * HALF + m * 16) * 512 + col0;
                f32x4 v0, v1;
#pragma unroll
                for (int e = 0; e < 4; ++e) { const float a0 = acc[ai][0][m][0][e], a1 = acc[ai][0][m][1][e];
                    v0[e] = a0 * fsigmoid(a0) * acc[ai][1][m][0][e]; v1[e] = a1 * fsigmoid(a1) * acc[ai][1][m][1][e]; }
                u32x4 w; w.x = cvt_pk_bf16(v0[0], v0[1]); w.y = cvt_pk_bf16(v0[2], v0[3]); w.z = cvt_pk_bf16(v1[0], v1[1]); w.w = cvt_pk_bf16(v1[2], v1[3]);
                *(u32x4*)rowp = w; }
    }
};
struct EpiFp8 {
    static constexpr bool PERM = true;
    unsigned char* O; int ldo;
    __device__ __forceinline__ void operator()(const f32x4 (&acc)[2][2][4][2], const Unit& u, int wr, int wc, int fr, int fq) const {
        const int row0 = u.pm * BM + wr * 64 + fr, col0 = u.pn * BM + wc * 32 + 8 * fq;
#pragma unroll
        for (int ai = 0; ai < 2; ++ai)
#pragma unroll
            for (int m = 0; m < 4; ++m) { unsigned char* rowp = O + (size_t)(row0 + ai * HALF + m * 16) * ldo + col0;
#pragma unroll
                for (int bj = 0; bj < 2; ++bj) { const f32x4 v0 = acc[ai][bj][m][0], v1 = acc[ai][bj][m][1];
                    int lo = __builtin_amdgcn_cvt_pk_fp8_f32(v0[0], v0[1], 0, false); lo = __builtin_amdgcn_cvt_pk_fp8_f32(v0[2], v0[3], lo, true);
                    int hi = __builtin_amdgcn_cvt_pk_fp8_f32(v1[0], v1[1], 0, false); hi = __builtin_amdgcn_cvt_pk_fp8_f32(v1[2], v1[3], hi, true);
                    *(u32x2*)(rowp + bj * HALF) = (u32x2){(unsigned)lo, (unsigned)hi}; } }
    }
};
struct MoeOrder {
    int nunits, G, c, cshift; const PG8_LAS int* tile_e;
    __device__ __forceinline__ bool next(int i, Unit& u) const {
        const int L = i * G + c; if (L >= nunits) return false;
        u.pm = L >> cshift; u.pn = L & ((1 << cshift) - 1); u.e = tile_e[u.pm]; return true;
    }
};
}
#include <hip/hip_bf16.h>
#include <cmath>
namespace attn_body {
using bf16=__hip_bfloat16;
using bf16x8=__attribute__((ext_vector_type(8)))short;
using s16x4=__attribute__((ext_vector_type(4)))short;
using f32x16=__attribute__((ext_vector_type(16)))float;
using u32x4=__attribute__((ext_vector_type(4)))unsigned;
constexpr int BATCH=2,NHEAD=8,SEQ=16384,D=64,DM=NHEAD*D;
constexpr int NW=8,QBLK=32,QB=QBLK*NW,KVBLK=64,NQB=SEQ/QB;
constexpr int ATTN_PITCH=DM, ATTN_UNIT_ROWS=QB;
__device__ __forceinline__ int crow(int r,int hi){return (r&3)+8*(r>>2)+4*hi;}
#define SBAR() __builtin_amdgcn_sched_barrier(0)
__device__ __forceinline__ void cmask(f32x16&p0,f32x16&p1,int jb,int qrel,int hi){
  const float NEG=-INFINITY; int x=qrel-64*jb-4*hi; asm volatile("":"+v"(x));
  #pragma unroll
  for(int r=0;r<16;++r){const int c=(r&3)+8*(r>>2); if(c>x)p0[r]=NEG; if(c+32>x)p1[r]=NEG;}
}

constexpr int NSLOT=3, SLOTB=8192;
constexpr int LDS_K=0, LDS_V=NSLOT*SLOTB, LDS_WS=2*NSLOT*SLOTB, LDS_OST=LDS_WS+NW*64*4, LDS_BYTES=LDS_OST+NW*4096;
constexpr float C2=0.125f*1.4426950408889634f;
__device__ __forceinline__ void glds16(const void*gsrc,unsigned lds_dst){unsigned keep;
  asm volatile("s_mov_b32 %0, m0\n\ts_mov_b32 m0, %2\n\ts_nop 0\n\tglobal_load_lds_dwordx4 %1, off\n\ts_mov_b32 m0, %0":"=&s"(keep):"v"(gsrc),"s"(lds_dst):"memory");}
__device__ __forceinline__ float max3f(float a,float b,float c){float r;asm("v_max3_f32 %0, %1, %2, %3":"=v"(r):"v"(a),"v"(b),"v"(c));return r;}
__device__ __forceinline__ float max2f(float a,float b){float r;asm("v_max_f32_e32 %0, %1, %2":"=v"(r):"v"(a),"v"(b));return r;}
__device__ __forceinline__ float fadd_s(float a,float b){float r;asm("v_add_f32_e32 %0, %1, %2":"=v"(r):"v"(a),"v"(b));return r;}
__device__ __forceinline__ float fsub_s(float a,float b){float r;asm("v_sub_f32_e32 %0, %1, %2":"=v"(r):"v"(a),"v"(b));return r;}
typedef float f32x2_t __attribute__((ext_vector_type(2))); typedef __bf16 bf16x2_t __attribute__((ext_vector_type(2)));
__device__ __forceinline__ unsigned cvtpk_s(float lo,float hi){f32x2_t v={lo,hi};bf16x2_t b=__builtin_convertvector(v,bf16x2_t);return __builtin_bit_cast(unsigned,b);}
#define WAIT_BAR(N) asm volatile("s_waitcnt vmcnt(" #N ") lgkmcnt(0)\n\ts_barrier":::"memory")

__device__ __forceinline__ void qkt(f32x16&p0,f32x16&p1,const char*Kslot,const bf16x8*qr,int r32,int hi){
  const char*kb=Kslot+hi*1024+r32*16;
  #pragma unroll
  for(int d0=0;d0<4;++d0){
    const bf16x8 b0=*reinterpret_cast<const bf16x8*>(kb+d0*2048);
    const bf16x8 b1=*reinterpret_cast<const bf16x8*>(kb+d0*2048+512);
    if(d0==0){p0=__builtin_amdgcn_mfma_f32_32x32x16_bf16(b0,qr[0],p0,0,0,0);p1=__builtin_amdgcn_mfma_f32_32x32x16_bf16(b1,qr[0],p1,0,0,0);}
    else{p0=__builtin_amdgcn_mfma_f32_32x32x16_bf16(b0,qr[d0],p0,0,0,0);p1=__builtin_amdgcn_mfma_f32_32x32x16_bf16(b1,qr[d0],p1,0,0,0);}}
}
typedef __attribute__((address_space(3))) const char* lds_cptr;
typedef short v4i16_t __attribute__((ext_vector_type(4)));
__device__ __forceinline__ void kload8(bf16x8*kf,lds_cptr kp){
  kf[0]=*(const __attribute__((address_space(3))) bf16x8*)(kp);      kf[1]=*(const __attribute__((address_space(3))) bf16x8*)(kp+512);
  kf[2]=*(const __attribute__((address_space(3))) bf16x8*)(kp+2048); kf[3]=*(const __attribute__((address_space(3))) bf16x8*)(kp+2560);
  kf[4]=*(const __attribute__((address_space(3))) bf16x8*)(kp+4096); kf[5]=*(const __attribute__((address_space(3))) bf16x8*)(kp+4608);
  kf[6]=*(const __attribute__((address_space(3))) bf16x8*)(kp+6144); kf[7]=*(const __attribute__((address_space(3))) bf16x8*)(kp+6656);
}
__device__ __forceinline__ void kload2(bf16x8*kf,lds_cptr kp,int j){ kf[2*j]=*(const __attribute__((address_space(3))) bf16x8*)(kp+j*2048); kf[2*j+1]=*(const __attribute__((address_space(3))) bf16x8*)(kp+j*2048+512); }
__device__ __forceinline__ s16x4 vtr(lds_cptr p){ return __builtin_bit_cast(s16x4,__builtin_amdgcn_ds_read_tr16_b64_v4i16((__attribute__((address_space(3))) v4i16_t*)p)); }
__device__ __forceinline__ float rowmax(const f32x16&p0,const f32x16&p1){
  float a=max3f(p0[0],p0[1],p1[0]),b=max3f(p0[2],p0[3],p1[1]);a=max3f(a,p1[2],p1[3]);
  #pragma unroll
  for(int r=4;r<16;r+=4){a=max3f(a,p0[r],p0[r+1]);b=max3f(b,p0[r+2],p0[r+3]);a=max3f(a,p1[r],p1[r+1]);b=max3f(b,p1[r+2],p1[r+3]);}
  const float m=max2f(a,b);
  auto rr=__builtin_amdgcn_permlane32_swap(__float_as_uint(m),__float_as_uint(m),false,false);
  return max2f(__uint_as_float(rr[0]),__uint_as_float(rr[1]));
}
__device__ __forceinline__ void pv(f32x16*o,int vb,bf16x8 pa0,bf16x8 pa1,bf16x8 pa2,bf16x8 pa3){
  #pragma unroll
  for(int d0=0;d0<2;++d0){s16x4 lo[4],hi[4];
    #pragma unroll
    for(int ks=0;ks<4;++ks){
      asm volatile("ds_read_b64_tr_b16 %0,%1 offset:%c2":"=&v"(lo[ks]):"v"(vb),"i"(d0*4096+ks*1024):"memory");
      asm volatile("ds_read_b64_tr_b16 %0,%1 offset:%c2":"=&v"(hi[ks]):"v"(vb),"i"(d0*4096+ks*1024+512):"memory");}
    asm volatile("s_waitcnt lgkmcnt(0)":::"memory");SBAR();
    #define PK(k) (bf16x8){lo[k][0],lo[k][1],lo[k][2],lo[k][3],hi[k][0],hi[k][1],hi[k][2],hi[k][3]}
    o[d0]=__builtin_amdgcn_mfma_f32_32x32x16_bf16(pa0,PK(0),o[d0],0,0,0);
    o[d0]=__builtin_amdgcn_mfma_f32_32x32x16_bf16(pa1,PK(1),o[d0],0,0,0);
    o[d0]=__builtin_amdgcn_mfma_f32_32x32x16_bf16(pa2,PK(2),o[d0],0,0,0);
    o[d0]=__builtin_amdgcn_mfma_f32_32x32x16_bf16(pa3,PK(3),o[d0],0,0,0);
    #undef PK
  }
}

#ifndef ATTN_STORE16
#define ATTN_STORE16(p,v) (*(u32x4*)(p)=(v))
#endif
typedef float f32x4_t __attribute__((ext_vector_type(4)));
#define NBLD(dst,off) dst=*(const __attribute__((address_space(3))) f32x4_t*)(tbn_+(off))
#define NBSUB(P,b,src) do{ P[(b)]=nmn_-src[0]; P[(b)+1]=nmn_-src[1]; P[(b)+2]=nmn_-src[2]; P[(b)+3]=nmn_-src[3]; }while(0)
#define NEXTB(P0,P1,tt) do{ const __attribute__((address_space(3))) float* tb_=tab3+(tt)*64+4*hi; const float nm_=-mhat; \
  _Pragma("unroll") for(int g_=0;g_<4;++g_){ const f32x4_t b0_=*(const __attribute__((address_space(3))) f32x4_t*)(tb_+8*g_); const f32x4_t b1_=*(const __attribute__((address_space(3))) f32x4_t*)(tb_+32+8*g_); \
    _Pragma("unroll") for(int j_=0;j_<4;++j_){ P0[4*g_+j_]=nm_-b0_[j_]; P1[4*g_+j_]=nm_-b1_[j_]; } } }while(0)
template<int THRL> __device__ __forceinline__ void attn_unit(int b,int h,int qb,int t0,const bf16*Q,const bf16*__restrict__ K,const bf16*__restrict__ V,bf16*O,const float*__restrict__ cumT,char*shm,int tab_off,int segp_off,unsigned*qctr){
  const int tid=threadIdx.x,lane=tid&63,r32=lane&31,hi=lane>>5; const int wid=__builtin_amdgcn_readfirstlane(tid>>6);
  const long rowbase=(long)b*SEQ; const int q0=qb*QB;
  const bf16*Qw=Q+(rowbase+q0+wid*QBLK)*DM+h*D;
  const bf16*Kh=K+(rowbase+(long)t0*KVBLK)*DM+h*D,*Vh=V+(rowbase+(long)t0*KVBLK)*DM+h*D;
  const unsigned lds0=(unsigned)(uintptr_t)shm;
  float*wsf=(float*)(shm+LDS_WS)+wid*64;
  const bf16*ksrc=Kh+(long)lane*DM+wid*8;
  const bf16*vsrc=Vh+(long)(16*(wid&3)+(lane>>2))*DM+(wid>>2)*32+(lane&3)*8;
  const unsigned kdst=lds0+LDS_K+wid*1024, vdst=lds0+LDS_V+wid*1024;
  #define DMA_K(t,slot) glds16(ksrc+(long)(t)*KVBLK*DM,(unsigned)__builtin_amdgcn_readfirstlane(kdst+(slot)))
  #define DMA_V(t,slot) glds16(vsrc+(long)(t)*KVBLK*DM,(unsigned)__builtin_amdgcn_readfirstlane(vdst+(slot)))
  const int vb0=(int)(lds0+LDS_V)+((lane>>4)&1)*32+(lane&3)*8+(4*hi+((lane&15)>>2))*64;
  const char*Kbase=shm+LDS_K; bf16x8 kf[8];
  const lds_cptr shm3=(lds_cptr)shm; const lds_cptr kp0=shm3+LDS_K+hi*1024+r32*16; const lds_cptr vp0=shm3+LDS_V+((lane>>4)&1)*32+(lane&3)*8+(4*hi+((lane&15)>>2))*64;
  const int NT=(q0+QB)/KVBLK-t0;
  const __attribute__((address_space(3))) float* tab3=(const __attribute__((address_space(3))) float*)(shm3+tab_off);
  { int tl_=threadIdx.x; asm volatile("":"+v"(tl_));
    float*tabw=(float*)(shm+tab_off); const float L2E=1.4426950408889634f;
    const float*cg=cumT+((long)(b*NHEAD+h))*SEQ; const float cref=cg[q0]*L2E;
    for(int i=tl_;i<NT*KVBLK;i+=NW*64){ const int kv=t0*KVBLK+i; tabw[i]=cg[kv]*L2E-cref; }
    asm volatile("s_waitcnt vmcnt(0) lgkmcnt(0)\n\ts_barrier":::"memory"); }
  DMA_K(0,0);DMA_V(0,0);DMA_K(1,SLOTB);
  bf16x8 qr[4];
  #pragma unroll
  for(int d0=0;d0<4;++d0)qr[d0]=*reinterpret_cast<const bf16x8*>(&Qw[(long)r32*DM+d0*16+hi*8]);
  float mhat=0.f,l_reg=0.f;f32x16 o[2];o[0]=f32x16{};o[1]=f32x16{};
  const int qrel=wid*QBLK+r32;
  #define CMASK(P0,P1,t) do{int jb_=(t)-(NT-4); if(jb_>=0)cmask(P0,P1,jb_,qrel,hi);}while(0)
  bool resc=false;
  #define START(P0,P1) do{ const float rm=rowmax(P0,P1); resc=false; \
    { const float dl=rm; mhat=fadd_s(mhat,dl); \
      _Pragma("unroll") for(int r=0;r<16;++r){P0[r]=fsub_s(P0[r],dl);P1[r]=fsub_s(P1[r],dl);} \
      } \
    _Pragma("unroll") for(int r=0;r<16;++r)P0[r]=__builtin_amdgcn_exp2f(P0[r]); }while(0)
  #define RESC() do{ if(resc){ asm volatile("s_waitcnt lgkmcnt(0)":::"memory"); \
      _Pragma("unroll") for(int d_=0;d_<2;++d_) _Pragma("unroll") for(int r=0;r<16;++r)o[d_][r]*=wsf[crow(r,hi)]; } }while(0)
  f32x16 pA0,pA1,pB0,pB1;
  int sl_prev=0,sl_cur=0,sl_next=SLOTB;
  #define ROT() do{sl_prev=sl_cur;sl_cur=sl_next;sl_next=(sl_next==(NSLOT-1)*SLOTB)?0:sl_next+SLOTB;}while(0)
  DMA_K(2,2*SLOTB);
  WAIT_BAR(3);
  NEXTB(pA0,pA1,0);
  qkt(pA0,pA1,Kbase,qr,r32,hi);asm volatile("s_nop 15\n\ts_nop 7":"+v"(pA0),"+v"(pA1));CMASK(pA0,pA1,0);
  START(pA0,pA1);
  NEXTB(pB0,pB1,1);
  _Pragma("unroll") for(int r=0;r<16;++r)pA1[r]=__builtin_amdgcn_exp2f(pA1[r]);
  WAIT_BAR(0);
  DMA_K(3,0);DMA_V(1,SLOTB);
  ROT();
  kload8(kf,kp0+sl_cur);
  WAIT_BAR(2);
  s16x4 vlo[8],vhi[8]; u32x4 pw0,pw1,pw2,pw3;
  #define PKW(P,B) cvtpk_s(P[B],P[B+1])
  #define PAF(k) __builtin_bit_cast(bf16x8,pw##k)
  #define VFR(i) (bf16x8){vlo[i][0],vlo[i][1],vlo[i][2],vlo[i][3],vhi[i][0],vhi[i][1],vhi[i][2],vhi[i][3]}
  #define PIN(x) asm volatile("":"+v"(x))
  #define MX3(a,b,c) __builtin_fmaxf(__builtin_fmaxf((a),(b)),(c))
  #define GAPA(MF,A0,A1,A2,A3,W0,W1,PW) do{ MF; sacc+=A0; sacc+=A1; sacc+=A2; sacc+=A3; PIN(sacc); W0; W1; PIN(PW); SBAR(); }while(0)
  #define EX(v) __builtin_amdgcn_exp2f(v)
  #define GAPB(MF,X,B) do{ MF; X[B]=EX(X[B]); X[B+1]=EX(X[B+1]); X[B+2]=EX(X[B+2]); X[B+3]=EX(X[B+3]); PIN(X); SBAR(); }while(0)
  #define VRD(i) do{ vlo[i]=vtr(vp_+(((i)>>2)*4096+((i)&3)*1024)); vhi[i]=vtr(vp_+(((i)>>2)*4096+((i)&3)*1024+512)); }while(0)
  #define KRD(G,j) do{ if(G){ kload2(kf,kp0+sl_next,j); SBAR(); } }while(0)
  #define STEP(C0,C1,P0,P1,t,GK,GV,GL) do{ SBAR(); \
    const lds_cptr vp_=vp0+sl_prev; \
    VRD(0); SBAR(); float sacc=(P0[0]+P0[1]); \
    GAPA(C0=__builtin_amdgcn_mfma_f32_32x32x16_bf16(kf[0],qr[0],C0,0,0,0), P0[2],P0[3],P0[4],P0[5],     pw0[0]=PKW(P0,0), pw0[1]=PKW(P0,2), pw0); \
    VRD(4); SBAR(); GAPA(C1=__builtin_amdgcn_mfma_f32_32x32x16_bf16(kf[1],qr[0],C1,0,0,0), P0[6],P0[7],P0[8],P0[9],     pw0[2]=PKW(P0,4), pw0[3]=PKW(P0,6), pw0); \
    VRD(1); SBAR(); GAPA(C0=__builtin_amdgcn_mfma_f32_32x32x16_bf16(kf[2],qr[1],C0,0,0,0),   P0[10],P0[11],P0[12],P0[13], pw1[0]=PKW(P0,8), pw1[1]=PKW(P0,10), pw1); \
    VRD(5); SBAR(); GAPA(C1=__builtin_amdgcn_mfma_f32_32x32x16_bf16(kf[3],qr[1],C1,0,0,0),   P0[14],P0[15],P1[0],P1[1],   pw1[2]=PKW(P0,12),pw1[3]=PKW(P0,14), pw1); \
    VRD(2); SBAR(); GAPA(C0=__builtin_amdgcn_mfma_f32_32x32x16_bf16(kf[4],qr[2],C0,0,0,0),   P1[2],P1[3],P1[4],P1[5],     pw2[0]=PKW(P1,0), pw2[1]=PKW(P1,2), pw2); \
    VRD(6); SBAR(); GAPA(C1=__builtin_amdgcn_mfma_f32_32x32x16_bf16(kf[5],qr[2],C1,0,0,0),   P1[6],P1[7],P1[8],P1[9],     pw2[2]=PKW(P1,4), pw2[3]=PKW(P1,6), pw2); \
    VRD(3); SBAR(); GAPA(C0=__builtin_amdgcn_mfma_f32_32x32x16_bf16(kf[6],qr[3],C0,0,0,0),   P1[10],P1[11],P1[12],P1[13], pw3[0]=PKW(P1,8), pw3[1]=PKW(P1,10), pw3); \
    VRD(7); SBAR(); GAPA(C1=__builtin_amdgcn_mfma_f32_32x32x16_bf16(kf[7],qr[3],C1,0,0,0),   P1[14],P1[15],0.f,0.f,       pw3[2]=PKW(P1,12),pw3[3]=PKW(P1,14), pw3); \
    l_reg+=sacc; \
    if(GK){DMA_K((t)+3,sl_cur);} if(GV){DMA_V((t)+1,sl_next);} \
    CMASK(C0,C1,t); \
    { float a=MX3(C0[0],C0[1],C1[0]),b=MX3(C0[2],C0[3],C1[1]); a=MX3(a,C1[2],C1[3]); \
      _Pragma("unroll") for(int r=4;r<16;r+=4){a=MX3(a,C0[r],C0[r+1]);b=MX3(b,C0[r+2],C0[r+3]);a=MX3(a,C1[r],C1[r+1]);b=MX3(b,C1[r+2],C1[r+3]);} \
      float rm=__builtin_fmaxf(a,b); { auto rr=__builtin_amdgcn_permlane32_swap(__float_as_uint(rm),__float_as_uint(rm),false,false); rm=__builtin_fmaxf(__uint_as_float(rr[0]),__uint_as_float(rr[1])); } \
      resc=false; \
      if(__builtin_expect(__any(rm>(float)THRL),0)){ const float dl=__builtin_fmaxf(rm,0.f); mhat+=dl; \
        _Pragma("unroll") for(int r=0;r<16;++r){C0[r]-=dl;C1[r]-=dl;} \
        const float f=__builtin_amdgcn_exp2f(-dl); l_reg*=f; if(hi==0)wsf[r32]=f; resc=true; } } \
      \
    const __attribute__((address_space(3))) float* tbn_=tab3+((t)+1)*64+4*hi; const float nmn_=-mhat; f32x4_t nbA_,nbB_; \
    SBAR(); \
    if(GL){NBLD(nbA_,0);} GAPB(o[0]=__builtin_amdgcn_mfma_f32_32x32x16_bf16(PAF(0),VFR(0),o[0],0,0,0), C0,0); \
    if(GL){NBLD(nbB_,8); NBSUB(P0,0,nbA_);} GAPB(o[1]=__builtin_amdgcn_mfma_f32_32x32x16_bf16(PAF(0),VFR(4),o[1],0,0,0), C0,4); \
    if(GL){NBLD(nbA_,16); NBSUB(P0,4,nbB_);} KRD(GL,0); GAPB(o[0]=__builtin_amdgcn_mfma_f32_32x32x16_bf16(PAF(1),VFR(1),o[0],0,0,0), C0,8); \
    if(GL){NBLD(nbB_,24); NBSUB(P0,8,nbA_);} KRD(GL,1); GAPB(o[1]=__builtin_amdgcn_mfma_f32_32x32x16_bf16(PAF(1),VFR(5),o[1],0,0,0), C0,12); \
    if(GL){NBLD(nbA_,32); NBSUB(P0,12,nbB_);} KRD(GL,2); GAPB(o[0]=__builtin_amdgcn_mfma_f32_32x32x16_bf16(PAF(2),VFR(2),o[0],0,0,0), C1,0); \
    if(GL){NBLD(nbB_,40); NBSUB(P1,0,nbA_);} KRD(GL,3); GAPB(o[1]=__builtin_amdgcn_mfma_f32_32x32x16_bf16(PAF(2),VFR(6),o[1],0,0,0), C1,4); \
    if(GL){NBLD(nbA_,48); NBSUB(P1,4,nbB_);} GAPB(o[0]=__builtin_amdgcn_mfma_f32_32x32x16_bf16(PAF(3),VFR(3),o[0],0,0,0), C1,8); \
    if(GL){NBLD(nbB_,56); NBSUB(P1,8,nbA_);} GAPB(o[1]=__builtin_amdgcn_mfma_f32_32x32x16_bf16(PAF(3),VFR(7),o[1],0,0,0), C1,12); \
    if(GL){NBSUB(P1,12,nbB_);} \
    }while(0)
  int t=1;
  #undef CMASK
  #define CMASK(P0,P1,t) do{}while(0)
  for(;t+5<NT;t+=2){
    STEP(pB0,pB1,pA0,pA1,t,true,true,true);     WAIT_BAR(2); RESC(); ROT();
    STEP(pA0,pA1,pB0,pB1,t+1,true,true,true);   WAIT_BAR(2); RESC(); ROT();
  }
  #undef CMASK
  #define CMASK(P0,P1,t) do{int jb_=(t)-(NT-4); if(jb_>=0)cmask(P0,P1,jb_,qrel,hi);}while(0)
  #define ENDW(tt) do{ if((tt)+3<NT){WAIT_BAR(2);} else if((tt)+2<NT){WAIT_BAR(1);} else {WAIT_BAR(0);} }while(0)
  for(;t+1<NT;t+=2){
    STEP(pB0,pB1,pA0,pA1,t,(t+3<NT),(t+1<NT),(t+1<NT));       ENDW(t);   RESC(); ROT();
    STEP(pA0,pA1,pB0,pB1,t+1,(t+4<NT),(t+2<NT),(t+2<NT));     ENDW(t+1); RESC(); ROT();
  }
  STEP(pB0,pB1,pA0,pA1,NT-1,false,false,false); RESC();
  { float sacc=pB0[0]+pB0[1]; _Pragma("unroll") for(int r=2;r<16;++r)sacc+=pB0[r]; _Pragma("unroll") for(int r=0;r<16;++r)sacc+=pB1[r]; l_reg+=sacc;
    pw0=(u32x4){PKW(pB0,0),PKW(pB0,2),PKW(pB0,4),PKW(pB0,6)};pw1=(u32x4){PKW(pB0,8),PKW(pB0,10),PKW(pB0,12),PKW(pB0,14)};pw2=(u32x4){PKW(pB1,0),PKW(pB1,2),PKW(pB1,4),PKW(pB1,6)};pw3=(u32x4){PKW(pB1,8),PKW(pB1,10),PKW(pB1,12),PKW(pB1,14)};
    SBAR(); pv(o,vb0+sl_cur,PAF(0),PAF(1),PAF(2),PAF(3)); }
  #undef PKW
  #undef PAF
  #undef VFR
  #undef PIN
  #undef MX3
  #undef GAPA
  #undef GAPB
  #undef EX
  #undef VRD
  #undef KRD
  #undef STEP
  #undef ENDW
  {auto rr=__builtin_amdgcn_permlane32_swap(__float_as_uint(l_reg),__float_as_uint(l_reg),false,false);l_reg=__uint_as_float(rr[0])+__uint_as_float(rr[1]);}
  int un_=0; if(threadIdx.x==0)un_=(int)__hip_atomic_fetch_add(qctr,1u,__ATOMIC_RELAXED,__HIP_MEMORY_SCOPE_AGENT);
  int lane_e=threadIdx.x&63; asm volatile("":"+v"(lane_e));
  const int r32e=lane_e&31,hie=lane_e>>5;
  if(hie==0)wsf[32+r32e]=l_reg;asm volatile("s_waitcnt lgkmcnt(0)":::"memory");
  float rli[16];
  #pragma unroll
  for(int r=0;r<16;++r)rli[r]=__builtin_amdgcn_rcpf(wsf[32+crow(r,hie)]);
  bf16*Ow=O+(rowbase+q0+wid*QBLK)*DM+h*D;
  { bf16*stg=(bf16*)(shm+LDS_OST)+wid*2048;
    #pragma unroll
    for(int r=0;r<16;++r){const int orow=crow(r,hie);
      #pragma unroll
      for(int d0=0;d0<2;++d0)stg[orow*64+d0*32+r32e]=__float2bfloat16(o[d0][r]*rli[r]);}
    asm volatile("s_waitcnt lgkmcnt(0)":::"memory");
    #pragma unroll
    for(int i=0;i<4;++i){const int row=i*8+(lane_e>>3),ch=lane_e&7; const u32x4 v=*(const u32x4*)(stg+row*64+ch*8); ATTN_STORE16(Ow+(long)row*DM+ch*8,v);} }
  if(threadIdx.x==0)*(volatile int*)(shm+segp_off)=un_;
  asm volatile("s_waitcnt lgkmcnt(0)\n\ts_barrier":::"memory");
  #undef DMA_K
  #undef DMA_V
  #undef CMASK
  #undef START
  #undef RESC
  #undef ROT
}
constexpr int ATTN_LDS_BYTES=LDS_BYTES;
struct AttnTensors { const bf16* Q; const bf16* K; const bf16* V; bf16* O; const float* cumT; const float* segtot; };
struct AttnUnit { int bh; int qb; };
struct StaticOrder {
  int vcu;
  __device__ __forceinline__ explicit StaticOrder(int grid,int block):vcu((block%8)*(grid/8)+block/8){}
  __device__ __forceinline__ bool next(int i,AttnUnit&u)const{ if(i>=4||vcu>=256)return false; const int s=vcu&15; u.bh=vcu>>4; u.qb=(i==0)?63-s:(i==1)?32+s:(i==2)?31-s:s; return true; }
  __device__ __forceinline__ void a_ready(const AttnUnit&)const{}
  __device__ __forceinline__ void done(const AttnUnit&)const{}
};
constexpr float PRUNE_THR=20.0f;
template<int THRL=8> __device__ __forceinline__ void attn_phase_dyn(char*lds,const AttnTensors&T,unsigned*ctr,const unsigned*qkmax,const unsigned*ktmax,int tab_off,int segp_off){
  volatile int*slot=(volatile int*)(lds+segp_off);
  __syncthreads();
  if(threadIdx.x==0)slot[0]=(int)__hip_atomic_fetch_add(ctr,1u,__ATOMIC_RELAXED,__HIP_MEMORY_SCOPE_AGENT);
  __syncthreads();
  for(;;){
    int tid=threadIdx.x; asm volatile("":"+v"(tid));
    const int u=slot[0]; if(u>=BATCH*NHEAD*NQB)break;
    const int bh=u&15, qb=(NQB-1)-(u>>4), b=bh/NHEAD, h=bh%NHEAD, q0=qb*QB;
    const float qm=__uint_as_float(qkmax[bh*2]), km=__uint_as_float(qkmax[bh*2+1]);
    const float L2E=1.4426950408889634f; const float*cg=T.cumT+((long)(b*NHEAD+h))*SEQ;
    const float cgk=cg[(tid<4*qb)?64*tid+63:q0], cg0=cg[q0];
    const float kt2=__uint_as_float(ktmax[bh*256+((tid<4*qb)?tid:0)]);
    float dg, qg;
    { const int row=tid>>1, hf=tid&1; const long ro=((long)b*SEQ+q0+row)*DM+h*D+32*hf; const u32x4*qp=(const u32x4*)(T.Q+ro); const u32x4*kp=(const u32x4*)(T.K+ro); float d=0.f, qq=0.f;
      #pragma unroll
      for(int c4=0;c4<4;++c4){ const u32x4 qa=qp[c4], ka=kp[c4];
        #pragma unroll
        for(int e=0;e<4;++e){ const float q0_=__uint_as_float(qa[e]<<16), q1_=__uint_as_float(qa[e]&0xffff0000u); d+=q0_*__uint_as_float(ka[e]<<16)+q1_*__uint_as_float(ka[e]&0xffff0000u); qq+=q0_*q0_+q1_*q1_; } }
      d+=__shfl_xor(d,1); qq+=__shfl_xor(qq,1);
      #pragma unroll
      for(int o=2;o<64;o<<=1){ d=fminf(d,__shfl_xor(d,o)); qq=fmaxf(qq,__shfl_xor(qq,o)); }
      dg=d; qg=qq; }
    float*slotf=(float*)(lds+segp_off)+16;
    if((tid&63)==0){ slotf[tid>>6]=dg; slotf[8+(tid>>6)]=qg; }
    __syncthreads();
    float dmin=slotf[0], qmu=slotf[8];
    #pragma unroll
    for(int w=1;w<NW;++w){ dmin=fminf(dmin,slotf[w]); qmu=fmaxf(qmu,slotf[8+w]); }
    (void)qm; (void)km;
    const float X=PRUNE_THR+sqrtf(qmu*kt2)-dmin+1.5f;
    const bool keep=(tid<4*qb)&&!((cgk-cg0)*L2E>X);
    const unsigned long long bal=__ballot(keep); if((tid&63)==0)slot[1+(tid>>6)]=bal?((tid>>6)*64+(int)__builtin_ctzll(bal)):4*qb;
    __syncthreads();
    int t0=4*qb;
    #pragma unroll
    for(int w=0;w<NW;++w){ const int f_=slot[1+w]; t0=f_<t0?f_:t0; }
    t0&=~1;
    attn_unit<THRL>(b,h,qb,t0,T.Q,T.K,T.V,T.O,T.cumT,lds,tab_off,segp_off,ctr);
  }
}
#undef SBAR
#undef WAIT_BAR
}
#define GAS __attribute__((address_space(1)))
#define LAS __attribute__((address_space(3)))
typedef unsigned short bf16;
typedef unsigned v4u __attribute__((ext_vector_type(4)));
typedef float f32x4 __attribute__((ext_vector_type(4)));
typedef short bf16x8 __attribute__((ext_vector_type(8)));
typedef GAS unsigned gu32;
typedef GAS unsigned long long gu64;
#define RLX_AGENT __ATOMIC_RELAXED, __HIP_MEMORY_SCOPE_AGENT
#define LDS_WAIT() asm volatile("s_waitcnt lgkmcnt(0)" ::: "memory")
#define VM_WAIT() asm volatile("s_waitcnt vmcnt(0)" ::: "memory")
__device__ __forceinline__ unsigned long long rt() { return __builtin_amdgcn_s_memrealtime(); }
typedef float pk_f32x2 __attribute__((ext_vector_type(2))); typedef __bf16 pk_bf16x2 __attribute__((ext_vector_type(2)));
__device__ __forceinline__ unsigned pk2(float lo, float hi) { pk_f32x2 v = {lo, hi}; pk_bf16x2 b = __builtin_convertvector(v, pk_bf16x2); return __builtin_bit_cast(unsigned, b); }
__device__ __forceinline__ unsigned f2bf(float f) { return pk2(f, 0.f) & 0xffffu; }

#define XB_TMO      128
#define XB_XCNT(j)  (256  + 64 * (j))
#define XB_XSUB(j)  (1280 + 64 * (j))
#define XB_XGEN(j)  (2304 + 64 * (j))
#define XB_TOP      3328
#define XB_TOPGEN   3392
#define XCD_BAR_WORDS 3456
#define XB_SPIN_CAP (1u << 18)

__device__ __forceinline__ unsigned xb_ld(unsigned* p)              { return __hip_atomic_load(p, __ATOMIC_RELAXED, __HIP_MEMORY_SCOPE_AGENT); }
__device__ __forceinline__ unsigned xb_add(unsigned* p, unsigned v) { return __hip_atomic_fetch_add(p, v, __ATOMIC_RELAXED, __HIP_MEMORY_SCOPE_AGENT); }
__device__ __forceinline__ unsigned xb_xcc_id() { return (unsigned)__builtin_amdgcn_s_getreg((3 << 11) | 20) & 0xFu; }
#define XB_SPIN(cond, bar) do { unsigned _sp = 0; while (cond) { __builtin_amdgcn_s_sleep(1); \
    if ((++_sp & 255u) == 0u) { if (xb_ld(&(bar)[XB_TMO])) break; if (_sp > XB_SPIN_CAP) { atomicAdd(&(bar)[XB_TMO], 1u); break; } } } } while (0)

struct XcdBarrier {
    unsigned* bar; unsigned x;
    volatile LAS unsigned* st;
};

__device__ __forceinline__ XcdBarrier xcd_barrier_post(unsigned* bar, volatile LAS unsigned* st) {
    XcdBarrier b; b.bar = bar; b.x = xb_xcc_id(); b.st = st;
    if (threadIdx.x == 0) (void)xb_add(&bar[XB_XCNT(b.x)], 1u);
    return b;
}
__device__ __forceinline__ void xcd_barrier_complete(unsigned* bar, unsigned x, unsigned& nloc, unsigned& nx) {
    const unsigned G = gridDim.x * gridDim.y * gridDim.z;
    unsigned sum, cnt, mine, sp = 0u;
    for (;;) {
        sum = 0u; cnt = 0u; mine = 0u;
#pragma unroll
        for (unsigned j = 0; j < 16; ++j) { const unsigned c = xb_ld(&bar[XB_XCNT(j)]); sum += c; cnt += (c > 0u) ? 1u : 0u; mine = (j == x) ? c : mine; }
        if (sum == G) break;
        __builtin_amdgcn_s_sleep(1);
        if ((++sp & 255u) == 0u) { if (xb_ld(&bar[XB_TMO])) break; if (sp > XB_SPIN_CAP) { atomicAdd(&bar[XB_TMO], 1u); break; } }
    }
    nloc = mine > 0u ? mine : 1u; nx = cnt > 0u ? cnt : 1u;
}

__device__ __forceinline__ void xcd_barrier(const XcdBarrier& b) {
    asm volatile("s_waitcnt vmcnt(0)" ::: "memory");
    __syncthreads();
    if (threadIdx.x == 0) {
        unsigned* bar = b.bar;
        __builtin_amdgcn_s_waitcnt(0);
        unsigned nloc = b.st[0], nx = b.st[1];
        if (nloc == 0u) { xcd_barrier_complete(bar, b.x, nloc, nx); b.st[0] = nloc; b.st[1] = nx; }
        const unsigned old = xb_add(&bar[XB_XSUB(b.x)], 1u);
        const unsigned gen = old / nloc;
        if (old + 1u == (gen + 1u) * nloc) {
            __builtin_amdgcn_fence(__ATOMIC_RELEASE, "agent");
            asm volatile("s_waitcnt vmcnt(0)" ::: "memory");
            const unsigned og = xb_add(&bar[XB_TOP], 1u);
            const unsigned tg = og / nx;
            if (og + 1u == (tg + 1u) * nx) xb_add(&bar[XB_TOPGEN], 1u);
            else XB_SPIN(xb_ld(&bar[XB_TOPGEN]) == tg, bar);
            __builtin_amdgcn_fence(__ATOMIC_ACQUIRE, "agent");
            xb_add(&bar[XB_XGEN(b.x)], 1u);
            asm volatile("s_waitcnt vmcnt(0)" ::: "memory");
        } else {
            XB_SPIN(xb_ld(&bar[XB_XGEN(b.x)]) == gen, bar);
            __builtin_amdgcn_fence(__ATOMIC_ACQUIRE, "agent");
            asm volatile("s_waitcnt vmcnt(0)" ::: "memory");
        }
    }
    __syncthreads();
}

constexpr int NWAVES = 8;
constexpr int BATCH = 2, SEQ = 16384, D = 1024, M = BATCH * SEQ;
constexpr int FH = 8, FW = 512, RWW = 512, SHW = 1792, DIN = 5384, NIN = 5376;
constexpr int NE = 32, DE = 512, NROUTE = 36;
constexpr int MAXSLOT = 2 * M + NE * 256;
constexpr int MAXTILE = MAXSLOT / 256;
constexpr float ATT_C2 = 0.125f * 1.4426950408889634f;

constexpr size_t MiB = 1u << 20;
constexpr size_t WS_CTL = 0, CTL_ZERO_BYTES = 1 * MiB;
constexpr size_t WS_MOD = 1 * MiB;
constexpr size_t WS_SEGTOT = 1 * MiB + 64 * 1024;
constexpr size_t WS_BLKCNT = 1 * MiB + 96 * 1024;
constexpr size_t WS_WIN = 2 * MiB;
constexpr size_t WS_WOF = 13 * MiB, WS_WOR = 14 * MiB, WS_WO = 15 * MiB;
constexpr size_t WS_LW2 = 17 * MiB, WS_LA2 = 17 * MiB + 64 * 1024, WS_LG2 = 17 * MiB + 128 * 1024;
constexpr size_t WS_CUM = 18 * MiB;
constexpr size_t WS_ROUTE = 19 * MiB;
constexpr size_t WS_ROWTOK = 20 * MiB;
constexpr size_t WS_BON = 21 * MiB;
constexpr size_t WS_XN = 24 * MiB;
constexpr size_t WS_Q = 88 * MiB, WS_K = 120 * MiB, WS_V = 152 * MiB;
constexpr size_t WS_PRW = 184 * MiB;
constexpr size_t WS_GATES = 296 * MiB;
constexpr size_t WS_F = 424 * MiB;
constexpr size_t WS_END = 512 * MiB;
constexpr size_t WS_Y = WS_K;
constexpr size_t WS_H = WS_Q;
constexpr size_t WS_W13 = WS_PRW, WS_W2T = WS_PRW + 64 * MiB;
constexpr size_t WS_TMP = WS_PRW;
constexpr size_t WS_YM = 280 * MiB;
constexpr size_t WS_X1 = 424 * MiB;
static_assert(WS_YM + (size_t)MAXSLOT * 1024 * 2 <= WS_END, "ws map");
static_assert(WS_H + (size_t)MAXSLOT * 512 * 2 <= WS_PRW, "ws map");
constexpr int CW_TMO = 0, CW_CODE = 1;
constexpr int CW_BAR = 4096;
constexpr int CW_QKMAX = 8192;
constexpr int CW_QUEUE = 8448;
constexpr int CW_KTMAX = 12288;
constexpr int CW_DIAG = 8704;

constexpr int RING_OFF = 0, RING_BYTES = 131072;
constexpr int TAB_OFF = 83968;
constexpr int SEGP_OFF = TAB_OFF + 65536;
constexpr int TILE_OFF = 131072;
constexpr int LDSCTL_OFF = SEGP_OFF + 512, MISC_OFF = LDSCTL_OFF + 320;
constexpr int LDS_BYTES = LDSCTL_OFF + 512;
static_assert(attn_body::LDS_BYTES <= TAB_OFF, "attention LDS");


#define PHASE_IDS() int tid_ = threadIdx.x; asm volatile("" : "+v"(tid_)); const int lane_ = tid_ & 63; const int wave_ = __builtin_amdgcn_readfirstlane(tid_ >> 6); (void)lane_; (void)wave_
struct Frame {
    LAS unsigned char* lds;
    volatile LAS unsigned* MISC;
    gu32* ctl;
    int tid, lane, wave;
    int vcu, G;
    const float* const* in;
};
template <int CTRL> __device__ __forceinline__ float dpp_f(float v) { return __int_as_float(__builtin_amdgcn_mov_dpp(__float_as_int(v), CTRL, 0xf, 0xf, true)); }
__device__ __forceinline__ float row_sum16(float v) { v += dpp_f<0xB1>(v); v += dpp_f<0x4E>(v); v += dpp_f<0x141>(v); v += dpp_f<0x140>(v); return v; }
__device__ __forceinline__ float wave_sum(float v) { v = row_sum16(v); v += __shfl_xor(v, 16); v += __shfl_xor(v, 32); return v; }
__device__ __forceinline__ float bflo(unsigned w) { return __uint_as_float(w << 16); }
__device__ __forceinline__ float bfhi(unsigned w) { return __uint_as_float(w & 0xffff0000u); }
__device__ __forceinline__ float sigm(float x) { return 1.0f / (1.0f + __expf(-x)); }

__device__ __forceinline__ void transpose_item(const float* W, int ld, int col, int k0, int K, bf16* WT, size_t drow, LAS float* scr, int lane) {
#pragma unroll 8
    for (int i = 0; i < 32; ++i) { const int kk = 2 * i + (lane >> 5); scr[kk * 33 + (lane & 31)] = W[(size_t)(k0 + kk) * ld + col + (lane & 31)]; }
    LDS_WAIT(); asm volatile("" ::: "memory");
    const int c = lane & 7;
#pragma unroll
    for (int j = 0; j < 4; ++j) { const int n = (lane >> 3) + 8 * j; const LAS float* s = scr + (8 * c) * 33 + n;
        v4u o; o.x = pk2(s[0 * 33], s[1 * 33]); o.y = pk2(s[2 * 33], s[3 * 33]); o.z = pk2(s[4 * 33], s[5 * 33]); o.w = pk2(s[6 * 33], s[7 * 33]);
        *(GAS v4u*)(WT + (drow + n) * K + k0 + 8 * c) = o; }
    LDS_WAIT(); asm volatile("" ::: "memory");
}
__device__ __forceinline__ void conv_seg(Frame& F, const float* W, int ld, int col0, int K, int ncols, bf16* WT, size_t drow0) {
    PHASE_IDS();
    LAS float* scr = (LAS float*)(F.lds + RING_OFF + wave_ * 16384);
    const int gw = F.vcu * NWAVES + wave_, NGW = F.G * NWAVES, nkb = K / 64, nnb = ncols / 32;
    for (int it = gw; it < nkb * nnb; it += NGW) { const int kb = it / nnb, nb = it % nnb; transpose_item(W, ld, col0 + 32 * nb, 64 * kb, K, WT, drow0 + 32 * nb, scr, lane_); }
}

struct Args { const float* in[30]; float* out; unsigned char* ws; };

__device__ __forceinline__ void p0_prologue(Frame& F, const Args& A) {
    PHASE_IDS();
    unsigned char* ws = A.ws;
    if (blockIdx.x < 96) {
        const float* c = A.in[1]; const float* aw = A.in[2]; const float* ab = A.in[3];
        const int col = blockIdx.x * 64 + lane_; float a0 = 0.f, a1 = 0.f;
        const int kbeg = wave_ * 128;
#pragma unroll 8
        for (int k = kbeg; k < kbeg + 128; ++k) { const float wv = aw[(size_t)k * 6144 + col]; const float c0 = c[k], c1 = c[1024 + k];
            a0 += c0 * sigm(c0) * wv; a1 += c1 * sigm(c1) * wv; }
        LAS float* red = (LAS float*)(F.lds + 8 * 16384 - 4096);
        red[(wave_ * 2 + 0) * 64 + lane_] = a0; red[(wave_ * 2 + 1) * 64 + lane_] = a1;
        __syncthreads();
        if (wave_ < 2) { float s = 0.f;
#pragma unroll
            for (int w = 0; w < 8; ++w) s += red[(w * 2 + wave_) * 64 + lane_];
            ((float*)(ws + WS_MOD))[wave_ * 6144 + col] = s + ab[col]; }
        __syncthreads();
    }
}

__device__ __forceinline__ void p_convert_early(Frame& F, const Args& A) {
    unsigned char* ws = A.ws;
    const float* w_in = A.in[5];
    conv_seg(F, w_in, DIN, 0, 1024, 1536, (bf16*)(ws + WS_WIN), 0);
    conv_seg(F, w_in, DIN, 1544, 1024, 1792, (bf16*)(ws + WS_WIN), 1536);
    conv_seg(F, w_in, DIN, 3336, 1024, 2048, (bf16*)(ws + WS_WIN), 3328);
    conv_seg(F, A.in[18], 1024, 0, 512, 1024, (bf16*)(ws + WS_WOF), 0);
    conv_seg(F, A.in[19], 1024, 0, 512, 1024, (bf16*)(ws + WS_WOR), 0);
    conv_seg(F, A.in[20], 1024, 0, 1024, 1024, (bf16*)(ws + WS_WO), 0);
    conv_seg(F, A.in[9], 512, 0, 64, 512, (bf16*)(ws + WS_LW2), 0);
    conv_seg(F, A.in[11], 512, 0, 64, 512, (bf16*)(ws + WS_LA2), 0);
    conv_seg(F, A.in[12], 512, 0, 128, 512, (bf16*)(ws + WS_LG2), 0);
}

__device__ __forceinline__ void p1_norm(Frame& F, const Args& A) {
    PHASE_IDS();
    unsigned char* ws = A.ws;
    LAS float* wf = (LAS float*)(F.lds);
    LAS float* lfl = (LAS float*)(F.lds + 32768);
    LAS float* part = (LAS float*)(F.lds + 32768 + 4096);
    const float* x = A.in[0]; const float* g1 = A.in[4]; const float* w_in = A.in[5]; const float* fb = A.in[6];
    const float* mod = (const float*)(ws + WS_MOD);
    bf16* XN = (bf16*)(ws + WS_XN); float* cumT = (float*)(ws + WS_CUM); float* segtot = (float*)(ws + WS_SEGTOT);
    for (int i = tid_; i < 8192; i += NWAVES * 64) wf[(i & 7) * 1024 + (i >> 3)] = w_in[(size_t)(i >> 3) * DIN + 1536 + (i & 7)];
    __syncthreads();
    for (int blk = blockIdx.x; blk < M / 128; blk += F.G) {
        const int b = blk / (SEQ / 128);
        f32x4 gm[4], sh[4];
#pragma unroll
        for (int j = 0; j < 4; ++j) { const int col = 4 * lane_ + 256 * j; const f32x4 g = *(const f32x4*)(g1 + col), sc = *(const f32x4*)(mod + b * 6144 + 1024 + col);
            gm[j] = g * (sc + 1.0f); sh[j] = *(const f32x4*)(mod + b * 6144 + col); }
        float fbv = fb[((lane_ >> 5) & 1) * 4 + ((lane_ >> 4) & 1) * 2 + ((lane_ >> 3) & 1)];
        f32x4 nv[4];
        { const GAS f32x4* xr0 = (const GAS f32x4*)(x + ((size_t)blk * 128 + wave_ * 16) * D) + lane_;
#pragma unroll
          for (int j = 0; j < 4; ++j) nv[j] = xr0[64 * j]; }
        for (int i = 0; i < 16; ++i) {
            const int tl = wave_ * 16 + i; const size_t tok = (size_t)blk * 128 + tl;
            f32x4 v[4]; float s = 0.f;
#pragma unroll
            for (int j = 0; j < 4; ++j) { v[j] = nv[j]; s += (v[j].x * v[j].x + v[j].y * v[j].y) + (v[j].z * v[j].z + v[j].w * v[j].w); }
            { const GAS f32x4* xr = (const GAS f32x4*)(x + (tok + ((i + 1 < 16) ? 1 : 0)) * D) + lane_;
#pragma unroll
                for (int j = 0; j < 4; ++j) nv[j] = xr[64 * j]; }
            const float rstd = 1.0f / sqrtf(wave_sum(s) * (1.f / D) + 1e-6f);
            GAS unsigned long long* o8 = (GAS unsigned long long*)(XN + tok * D) + lane_;
            float f[8];
#pragma unroll
            for (int hh = 0; hh < 8; ++hh) f[hh] = 0.f;
#pragma unroll
            for (int j = 0; j < 4; ++j) { v[j] = v[j] * rstd * gm[j] + sh[j];
                o8[64 * j] = (unsigned long long)pk2(v[j].x, v[j].y) | ((unsigned long long)pk2(v[j].z, v[j].w) << 32);
#pragma unroll
                for (int hh = 0; hh < 8; ++hh) { const f32x4 w4 = *(const LAS f32x4*)(wf + hh * 1024 + 4 * lane_ + 256 * j); f[hh] += (v[j].x * w4.x + v[j].y * w4.y) + (v[j].z * w4.z + v[j].w * w4.w); } }
            float g4[4], g2v[2], z;
            { const bool up = (lane_ & 32) != 0;
#pragma unroll
              for (int i = 0; i < 4; ++i) { const float keep = up ? f[4 + i] : f[i], send = up ? f[i] : f[4 + i]; g4[i] = keep + __shfl_xor(send, 32); } }
            { const bool up = (lane_ & 16) != 0;
#pragma unroll
              for (int i = 0; i < 2; ++i) { const float keep = up ? g4[2 + i] : g4[i], send = up ? g4[i] : g4[2 + i]; g2v[i] = keep + __shfl_xor(send, 16); } }
            { const bool up = (lane_ & 8) != 0; const float keep = up ? g2v[1] : g2v[0], send = up ? g2v[0] : g2v[1]; z = keep + __shfl_xor(send, 8); }
            z += __shfl_xor(z, 1); z += __shfl_xor(z, 2); z += __shfl_xor(z, 4);
            const int myh = ((lane_ >> 5) & 1) * 4 + ((lane_ >> 4) & 1) * 2 + ((lane_ >> 3) & 1);
            z += fbv;
            const float lf = (z >= 0.f) ? -log1pf(__expf(-z)) : z - log1pf(__expf(z));
            if ((lane_ & 7) == 0) lfl[tl * 8 + myh] = lf;
        }
        __syncthreads();
        const int hh = tid_ & 7, p = tid_ >> 3;
        if (tid_ < 64) { float run = 0.f; for (int i = 0; i < 16; ++i) { run += lfl[(p * 16 + i) * 8 + hh]; lfl[(p * 16 + i) * 8 + hh] = run; } part[p * 8 + hh] = run; }
        __syncthreads();
        if (tid_ < 64) { float off = 0.f; for (int q = 0; q < p; ++q) off += part[q * 8 + hh];
            const int t0 = (blk % (SEQ / 128)) * 128 + p * 16; float* dst = cumT + ((size_t)(b * 8 + hh)) * SEQ + t0;
            for (int i = 0; i < 16; ++i) dst[i] = lfl[(p * 16 + i) * 8 + hh] + off;
            if (p == 7) segtot[blk * 8 + hh] = off + part[7 * 8 + hh]; }
        __syncthreads();
    }
}


__device__ __forceinline__ void p_cumfix(Frame& F, const Args& A) {
    PHASE_IDS();
    unsigned char* ws = A.ws; float* cumT = (float*)(ws + WS_CUM); const float* segtot = (const float*)(ws + WS_SEGTOT);
    LAS float* pre = (LAS float*)(F.lds);
    for (int blk = blockIdx.x; blk < M / 128; blk += F.G) {
        const int b = blk / (SEQ / 128), seg = blk % (SEQ / 128);
        __syncthreads();
        if (tid_ < 64) { const int hh = tid_ & 7, part = tid_ >> 3; float a = 0.f; for (int s = part; s < seg; s += 8) a += segtot[(b * 128 + s) * 8 + hh];
            a += __shfl_xor(a, 8); a += __shfl_xor(a, 16); a += __shfl_xor(a, 32); if (part == 0) pre[hh] = a; }
        __syncthreads();
        for (int i = tid_; i < 8 * 128; i += NWAVES * 64) { const int hh = i >> 7, t = i & 127; cumT[((size_t)(b * 8 + hh)) * SEQ + seg * 128 + t] += pre[hh]; }
    }
}
__device__ __forceinline__ void p_qknorm(Frame& F, const Args& A, unsigned* qkmax, unsigned* ktmax) {
    PHASE_IDS();
    unsigned char* ws = A.ws; const bf16* Q = (const bf16*)(ws + WS_Q); const bf16* K = (const bf16*)(ws + WS_K);
    const int gw = F.vcu * NWAVES + wave_, NGW = F.G * NWAVES, hd = lane_ >> 3;
    for (int g = gw; g < M / 16; g += NGW) { const int m0 = 16 * g, b = m0 / SEQ, tile = (m0 % SEQ) >> 6; float mq = 0.f, mk = 0.f;
#pragma unroll 4
        for (int i = 0; i < 16; ++i) { const size_t m = (size_t)(m0 + i);
            const v4u qw = *(const v4u*)(Q + m * 512 + 8 * lane_), kw = *(const v4u*)(K + m * 512 + 8 * lane_);
            float sq = 0.f, sk = 0.f;
#pragma unroll
            for (int e = 0; e < 4; ++e) { const float a = bflo(qw[e]), c = bfhi(qw[e]), d = bflo(kw[e]), f = bfhi(kw[e]); sq += a * a + c * c; sk += d * d + f * f; }
            sq += dpp_f<0xB1>(sq); sq += dpp_f<0x4E>(sq); sq += dpp_f<0x141>(sq);
            sk += dpp_f<0xB1>(sk); sk += dpp_f<0x4E>(sk); sk += dpp_f<0x141>(sk);
            mq = fmaxf(mq, sq); mk = fmaxf(mk, sk); }
        if ((lane_ & 7) == 0) { const int bh = b * 8 + hd;
            atomicMax(qkmax + bh * 2, __float_as_uint(mq)); atomicMax(qkmax + bh * 2 + 1, __float_as_uint(mk)); atomicMax(ktmax + bh * 256 + tile, __float_as_uint(mk)); } }
}

template <int WITH_MOE>
__device__ __forceinline__ void p_final(Frame& F, const Args& A, const float* src) {
    PHASE_IDS();
    unsigned char* ws = A.ws; const float* fg = A.in[29]; const float* mod = (const float*)(ws + WS_MOD);
    const int* route = (const int*)(ws + WS_ROUTE); const bf16* Y = (const bf16*)(ws + WS_YM);
    f32x4 fgv[4];
#pragma unroll
    for (int j = 0; j < 4; ++j) fgv[j] = *(const f32x4*)(fg + 4 * lane_ + 256 * j);
    const int gw = F.vcu * NWAVES + wave_, NGW = F.G * NWAVES;
    for (int m = gw; m < M; m += NGW) {
        f32x4 v[4]; float s = 0.f;
        if (WITH_MOE) { const GAS unsigned long long* xb = (const GAS unsigned long long*)((const bf16*)(ws + WS_X1) + (size_t)m * D) + lane_;
#pragma unroll
            for (int j = 0; j < 4; ++j) { const unsigned long long a = xb[64 * j]; const unsigned al = (unsigned)a, ah = (unsigned)(a >> 32); v[j] = (f32x4){bflo(al), bfhi(al), bflo(ah), bfhi(ah)}; } }
        else { const GAS f32x4* xr = (const GAS f32x4*)(src + (size_t)m * D) + lane_;
#pragma unroll
            for (int j = 0; j < 4; ++j) v[j] = xr[64 * j]; }
        if (WITH_MOE) {
            const int b = m / SEQ; const int* rt_ = route + (size_t)m * 8;
            const float w0 = __int_as_float(rt_[2]), w1 = __int_as_float(rt_[3]); const int s0 = rt_[6], s1 = rt_[7];
            const GAS unsigned* y0 = (const GAS unsigned*)((const unsigned char*)Y + (size_t)s0 * D) + lane_; const GAS unsigned* y1 = (const GAS unsigned*)((const unsigned char*)Y + (size_t)s1 * D) + lane_;
#pragma unroll
            for (int j = 0; j < 4; ++j) { const int a = (int)y0[64 * j], c = (int)y1[64 * j]; const f32x4 g2 = *(const f32x4*)(mod + b * 6144 + 5120 + 4 * lane_ + 256 * j);
                f32x4 y; y.x = w0 * __builtin_amdgcn_cvt_f32_fp8(a, 0) + w1 * __builtin_amdgcn_cvt_f32_fp8(c, 0); y.y = w0 * __builtin_amdgcn_cvt_f32_fp8(a, 1) + w1 * __builtin_amdgcn_cvt_f32_fp8(c, 1);
                y.z = w0 * __builtin_amdgcn_cvt_f32_fp8(a, 2) + w1 * __builtin_amdgcn_cvt_f32_fp8(c, 2); y.w = w0 * __builtin_amdgcn_cvt_f32_fp8(a, 3) + w1 * __builtin_amdgcn_cvt_f32_fp8(c, 3);
                v[j] = v[j] + g2 * y; }
        }
#pragma unroll
        for (int j = 0; j < 4; ++j) s += (v[j].x * v[j].x + v[j].y * v[j].y) + (v[j].z * v[j].z + v[j].w * v[j].w);
        float rstd = 1.0f / sqrtf(wave_sum(s) * (1.f / D) + 1e-6f);
        if (WITH_MOE == 2) { if (((const unsigned*)(ws + WS_CTL))[CW_DIAG]) rstd = 0.f; }
        GAS f32x4* o = (GAS f32x4*)(A.out + (size_t)m * D) + lane_;
#pragma unroll
        for (int j = 0; j < 4; ++j) o[64 * j] = v[j] * rstd * fgv[j];
    }
}

typedef float f32x16 __attribute__((ext_vector_type(16)));
typedef unsigned u32x2 __attribute__((ext_vector_type(2)));
__device__ __forceinline__ f32x4 shift4(const bf16* p, bool has_prev, const float* mu) {
    const u32x2 c = *(const u32x2*)p; u32x2 q = *(const u32x2*)(has_prev ? p - SHW : p); if (!has_prev) q = (u32x2){0u, 0u};
    const f32x4 m = *(const f32x4*)mu;
    f32x4 cv = {bflo(c.x), bfhi(c.x), bflo(c.y), bfhi(c.y)}, pv = {bflo(q.x), bfhi(q.x), bflo(q.y), bfhi(q.y)};
    return cv + (pv - cv) * m;
}
__device__ __forceinline__ u32x2 pack4(f32x4 v) { u32x2 r; r.x = pk2(v.x, v.y); r.y = pk2(v.z, v.w); return r; }

__device__ __forceinline__ float fsig(float x) { return __builtin_amdgcn_rcpf(1.0f + __builtin_amdgcn_exp2f(-1.4426950408889634f * x)); }
__device__ __forceinline__ float ftanh(float x) { const float xc = fminf(fmaxf(x, -15.f), 15.f); return 1.0f - 2.0f * __builtin_amdgcn_rcpf(1.0f + __builtin_amdgcn_exp2f(2.8853900817779268f * xc)); }
__device__ __forceinline__ float half_sum32(float v) { v = row_sum16(v); v += __shfl_xor(v, 16); return v; }
__device__ __forceinline__ void shift2(const bf16* p, bool has_prev, const float (&mu)[2], float (&o)[2]) {
    const unsigned c = *(const unsigned*)p; unsigned q = *(const unsigned*)(has_prev ? p - SHW : p); if (!has_prev) q = 0u;
    const float c0 = bflo(c), c1 = bfhi(c); o[0] = c0 + (bflo(q) - c0) * mu[0]; o[1] = c1 + (bfhi(q) - c1) * mu[1];
}
template <int VAR> __device__ __forceinline__ void rwkv_pre(Frame& F, const Args& A, int ci_lo, int ci_hi) {
    PHASE_IDS();
    unsigned char* ws = A.ws;
    const bf16* PRW = (const bf16*)(ws + WS_PRW);
    const float* mu = A.in[7]; const float* w0 = A.in[8]; const float* a0 = A.in[10]; const float* k_k = A.in[13]; const float* k_a = A.in[14]; const float* r_k = A.in[15];
    const bf16* LW2 = (const bf16*)(ws + WS_LW2); const bf16* LA2 = (const bf16*)(ws + WS_LA2); const bf16* LG2 = (const bf16*)(ws + WS_LG2);
    float* LW = (float*)A.out; bf16* R = (bf16*)((unsigned char*)A.out + 64 * MiB); bf16* KP = (bf16*)((unsigned char*)A.out + 96 * MiB);
    bf16* VV = (bf16*)(ws + WS_XN); bf16* AV = (bf16*)(ws + WS_XN + 32 * MiB); bf16* BV = (bf16*)(ws + WS_F); bf16* GG = (bf16*)(ws + WS_F + 32 * MiB);
    float* BON = (float*)(ws + WS_BON);
    LAS bf16* Xw = (LAS bf16*)(F.lds); LAS bf16* Xa = (LAS bf16*)(F.lds + 9216); LAS bf16* Xg = (LAS bf16*)(F.lds + 18432);
    const int h = wave_;
    for (int ci = ci_lo; ci < ci_hi; ci += F.G) {
        __syncthreads();
        {
            int tl_ = threadIdx.x; asm volatile("" : "+v"(tl_));
            const int row = tl_ >> 3, cg = tl_ & 7; const size_t tok = (size_t)ci * 64 + row; const bool hp = (tok % SEQ) != 0;
            const bf16* src = PRW + tok * SHW + 1536 + 32 * cg; const float* mup = mu + 1536 + 32 * cg;
            LAS bf16* dst = (cg < 2) ? (Xw + row * 72 + 32 * cg) : (cg < 4) ? (Xa + row * 72 + 32 * (cg - 2)) : (Xg + row * 136 + 32 * (cg - 4));
#pragma unroll
            for (int q = 0; q < 8; ++q) { f32x4 v = shift4(src + 4 * q, hp, mup + 4 * q);
                if (cg < 2) { v.x = ftanh(v.x); v.y = ftanh(v.y); v.z = ftanh(v.z); v.w = ftanh(v.w); }
                else if (cg >= 4) { v.x = fsig(v.x); v.y = fsig(v.y); v.z = fsig(v.z); v.w = fsig(v.w); }
                *(LAS u32x2*)(dst + 4 * q) = pack4(v); }
        }
        __syncthreads();
        int ln_ = threadIdx.x & 63; asm volatile("" : "+v"(ln_));
        const int c = ln_ & 31, hh = ln_ >> 5, colb = 64 * h + 2 * c;
    float mur[2], muk[2], muv[2], kkc[2], kac[2], rkc[2], a0c[2], w0c[2];
#pragma unroll
    for (int e = 0; e < 2; ++e) { mur[e] = mu[colb + e]; muk[e] = mu[512 + colb + e]; muv[e] = mu[1024 + colb + e]; kkc[e] = k_k[colb + e]; kac[e] = k_a[colb + e]; rkc[e] = r_k[colb + e]; a0c[e] = a0[colb + e]; w0c[e] = w0[colb + e]; }
#pragma unroll 1
        for (int tb = 0; tb < ((VAR == 3) ? 0 : 2); ++tb) {
            f32x16 aa[2], aw[2], ag[2];
            aa[0] = f32x16{}; aa[1] = f32x16{}; aw[0] = f32x16{}; aw[1] = f32x16{}; ag[0] = f32x16{}; ag[1] = f32x16{};
            if (VAR != 4) {
#pragma unroll
            for (int ks = 0; ks < 4; ++ks) { const bf16x8 afr = *(const LAS bf16x8*)(Xa + (32 * tb + c) * 72 + 16 * ks + 8 * hh), wfr = *(const LAS bf16x8*)(Xw + (32 * tb + c) * 72 + 16 * ks + 8 * hh);
#pragma unroll
                for (int jb = 0; jb < 2; ++jb) { const bf16x8 b1 = *(const bf16x8*)(LA2 + (size_t)(colb + jb) * 64 + 16 * ks + 8 * hh), b2 = *(const bf16x8*)(LW2 + (size_t)(colb + jb) * 64 + 16 * ks + 8 * hh);
                    aa[jb] = __builtin_amdgcn_mfma_f32_32x32x16_bf16(afr, b1, aa[jb], 0, 0, 0); aw[jb] = __builtin_amdgcn_mfma_f32_32x32x16_bf16(wfr, b2, aw[jb], 0, 0, 0); } }
#pragma unroll
            for (int ks = 0; ks < 8; ++ks) { const bf16x8 gfr = *(const LAS bf16x8*)(Xg + (32 * tb + c) * 136 + 16 * ks + 8 * hh);
#pragma unroll
                for (int jb = 0; jb < 2; ++jb) { const bf16x8 b3 = *(const bf16x8*)(LG2 + (size_t)(colb + jb) * 128 + 16 * ks + 8 * hh); ag[jb] = __builtin_amdgcn_mfma_f32_32x32x16_bf16(gfr, b3, ag[jb], 0, 0, 0); } }
            }
            unsigned gpk[16], apk[16];
#pragma unroll
            for (int reg = 0; reg < 16; ++reg) { gpk[reg] = pk2(ag[0][reg], ag[1][reg]); apk[reg] = pk2(fsig(a0c[0] + aa[0][reg]), fsig(a0c[1] + aa[1][reg])); }
            unsigned rawc[16][3], rawq[4][3];
#pragma unroll
            for (int reg = 0; reg < 16; ++reg) { const int t = 32 * tb + (reg & 3) + 8 * (reg >> 2) + 4 * hh; const size_t tok = (size_t)ci * 64 + t; const bool hp = (tok % SEQ) != 0;
                const bf16* prow = PRW + tok * SHW + colb; const bf16* pprev = hp ? prow - SHW : prow;
#pragma unroll
                for (int x = 0; x < 3; ++x) { if (VAR == 2) { rawc[reg][x] = 0x3f803f80u + reg; if ((reg & 3) == 0) rawq[reg >> 2][x] = 0x3f803f80u; } else { rawc[reg][x] = *(const unsigned*)(prow + 512 * x); if ((reg & 3) == 0) { const unsigned q = *(const unsigned*)(pprev + 512 * x); rawq[reg >> 2][x] = hp ? q : 0u; } } } }
#pragma unroll
            for (int reg = 0; reg < 16; ++reg) {
                const int t = 32 * tb + (reg & 3) + 8 * (reg >> 2) + 4 * hh; const size_t tok = (size_t)ci * 64 + t;
                unsigned rawp_[3];
#pragma unroll
                for (int x = 0; x < 3; ++x) rawp_[x] = ((reg & 3) == 0) ? rawq[reg >> 2][x] : rawc[(reg + 15) & 15][x];
                float kx[2], rx[2], vx[2];
                { const unsigned cc_ = rawc[reg][0], pp_ = rawp_[0]; const float c0 = bflo(cc_), c1 = bfhi(cc_); rx[0] = c0 + (bflo(pp_) - c0) * mur[0]; rx[1] = c1 + (bfhi(pp_) - c1) * mur[1]; }
                { const unsigned cc_ = rawc[reg][1], pp_ = rawp_[1]; const float c0 = bflo(cc_), c1 = bfhi(cc_); kx[0] = c0 + (bflo(pp_) - c0) * muk[0]; kx[1] = c1 + (bfhi(pp_) - c1) * muk[1]; }
                { const unsigned cc_ = rawc[reg][2], pp_ = rawp_[2]; const float c0 = bflo(cc_), c1 = bfhi(cc_); vx[0] = c0 + (bflo(pp_) - c0) * muv[0]; vx[1] = c1 + (bfhi(pp_) - c1) * muv[1]; }
                const float as0 = bflo(apk[reg]), as1 = bfhi(apk[reg]);
                const float kr0 = kx[0] * kkc[0], kr1 = kx[1] * kkc[1];
                const float ss = half_sum32(kr0 * kr0 + kr1 * kr1); const float inv = __builtin_amdgcn_rsqf(fmaxf(ss, 1e-24f));
                const float kk0 = kr0 * inv, kk1 = kr1 * inv, kp0 = kx[0] * (1.0f + (as0 - 1.0f) * kac[0]), kp1 = kx[1] * (1.0f + (as1 - 1.0f) * kac[1]);
                const float bon = half_sum32(rx[0] * kp0 * rkc[0] + rx[1] * kp1 * rkc[1]);
                float o2[2];
#pragma unroll
                for (int e = 0; e < 2; ++e) { const float z = -(w0c[e] + aw[e][reg]);
                    const float sp = fmaxf(z, 0.f) + 0.6931471805599453f * __builtin_amdgcn_logf(1.0f + __builtin_amdgcn_exp2f(-1.4426950408889634f * fabsf(z))); o2[e] = -__builtin_amdgcn_exp2f(-1.4426950408889634f * (sp + 0.5f)); }
                const unsigned ob = (unsigned)tok * 1024u + (unsigned)colb * 2u;
                if (VAR == 0) {
                *(unsigned*)((unsigned char*)R + ob) = pk2(rx[0], rx[1]); *(unsigned*)((unsigned char*)KP + ob) = pk2(kp0, kp1); *(unsigned*)((unsigned char*)VV + ob) = pk2(vx[0], vx[1]);
                *(unsigned*)((unsigned char*)AV + ob) = pk2(-kk0, -kk1); *(unsigned*)((unsigned char*)BV + ob) = pk2(kk0 * as0, kk1 * as1);
                *(float2*)((unsigned char*)LW + 2u * ob) = make_float2(o2[0], o2[1]); *(unsigned*)((unsigned char*)GG + ob) = gpk[reg];
                if (c == 0) BON[tok * 8 + h] = bon;
                } else { asm volatile("" :: "v"(pk2(rx[0], rx[1])), "v"(pk2(kp0, kp1)), "v"(pk2(vx[0], vx[1])), "v"(pk2(-kk0, -kk1)), "v"(pk2(kk0 * as0, kk1 * as1)), "v"(o2[0]), "v"(o2[1]), "v"(gpk[reg]), "v"(bon), "v"(ob)); }
                if ((reg & 3) == 3) __builtin_amdgcn_sched_barrier(0);
            }
        }
    }
}

__device__ __forceinline__ void rwkv_scan_seq(Frame& F, const Args& A) {
    PHASE_IDS();
    if (blockIdx.x >= BATCH * 8) return;
    unsigned char* ws = A.ws;
    const float* LW = (const float*)A.out; const bf16* R = (const bf16*)((unsigned char*)A.out + 64 * MiB); const bf16* KP = (const bf16*)((unsigned char*)A.out + 96 * MiB);
    const bf16* VV = (const bf16*)(ws + WS_XN); const bf16* AV = (const bf16*)(ws + WS_XN + 32 * MiB); const bf16* BV = (const bf16*)(ws + WS_F);
    float* Y = (float*)(ws + WS_Y);
    const int b = blockIdx.x >> 3, h = blockIdx.x & 7;
    constexpr int STEPB = 896, CH = 16, BUFB = STEPB * CH;
    LAS unsigned char* buf = F.lds;
    const size_t tok0 = (size_t)b * SEQ;
    const bool loader = wave_ >= 4; const int lt = tid_ - 256;
    auto load_chunk = [&](int cidx, int slot) {
        for (int p = lt; p < CH * 56; p += 256) { const int s = p / 56, q = p % 56; const size_t tok = tok0 + (size_t)cidx * CH + s; v4u val;
            if (q < 16) val = *(const v4u*)(LW + tok * 512 + 64 * h + 4 * q);
            else { const int a = (q - 16) >> 3, o8 = (q - 16) & 7; const bf16* src = (a == 0) ? AV : (a == 1) ? BV : (a == 2) ? KP : (a == 3) ? R : VV; val = *(const v4u*)(src + tok * 512 + 64 * h + 8 * o8); }
            *(LAS v4u*)(buf + slot * BUFB + s * STEPB + q * 16) = val; }
    };
    if (loader) load_chunk(0, 0);
    __syncthreads();
    float S[16];
#pragma unroll
    for (int j = 0; j < 16; ++j) S[j] = 0.f;
    const int il = lane_ & 15, jq = lane_ >> 4, irow = 16 * wave_ + il;
    for (int cidx = 0; cidx < SEQ / CH; ++cidx) {
        if (loader) { if (cidx + 1 < SEQ / CH) load_chunk(cidx + 1, (cidx + 1) & 1); }
        else {
            const LAS unsigned char* bb = buf + (cidx & 1) * BUFB;
#pragma unroll 4
            for (int s = 0; s < CH; ++s) { const LAS unsigned char* sp = bb + s * STEPB;
                float w[16], av[16], bv[16], kv[16], rv[16];
#pragma unroll
                for (int q = 0; q < 4; ++q) { const f32x4 l4 = *(const LAS f32x4*)(sp + 64 * jq + 16 * q); w[4 * q] = __expf(l4.x); w[4 * q + 1] = __expf(l4.y); w[4 * q + 2] = __expf(l4.z); w[4 * q + 3] = __expf(l4.w); }
#pragma unroll
                for (int q = 0; q < 2; ++q) { const v4u a4 = *(const LAS v4u*)(sp + 256 + 32 * jq + 16 * q), b4 = *(const LAS v4u*)(sp + 384 + 32 * jq + 16 * q), k4 = *(const LAS v4u*)(sp + 512 + 32 * jq + 16 * q), r4 = *(const LAS v4u*)(sp + 640 + 32 * jq + 16 * q);
#pragma unroll
                    for (int e = 0; e < 4; ++e) { av[8 * q + 2 * e] = bflo(a4[e]); av[8 * q + 2 * e + 1] = bfhi(a4[e]); bv[8 * q + 2 * e] = bflo(b4[e]); bv[8 * q + 2 * e + 1] = bfhi(b4[e]);
                        kv[8 * q + 2 * e] = bflo(k4[e]); kv[8 * q + 2 * e + 1] = bfhi(k4[e]); rv[8 * q + 2 * e] = bflo(r4[e]); rv[8 * q + 2 * e + 1] = bfhi(r4[e]); } }
                const unsigned short vraw = *(const LAS unsigned short*)(sp + 768 + 2 * irow); const float vi = __uint_as_float((unsigned)vraw << 16);
                float sa = 0.f;
#pragma unroll
                for (int j = 0; j < 16; ++j) sa += S[j] * av[j];
                sa += __shfl_xor(sa, 16); sa += __shfl_xor(sa, 32);
                float y = 0.f;
#pragma unroll
                for (int j = 0; j < 16; ++j) { S[j] = S[j] * w[j] + sa * bv[j] + vi * kv[j]; y += S[j] * rv[j]; }
                y += __shfl_xor(y, 16); y += __shfl_xor(y, 32);
                if (jq == 0) Y[(tok0 + (size_t)cidx * CH + s) * 512 + 64 * h + irow] = y;
            }
        }
        __syncthreads();
    }
}

__device__ __forceinline__ void rwkv_post(Frame& F, const Args& A) {
    PHASE_IDS();
    unsigned char* ws = A.ws;
    const float* Y = (const float*)(ws + WS_Y); const bf16* VV = (const bf16*)(ws + WS_XN); const bf16* GG = (const bf16*)(ws + WS_F + 32 * MiB); const float* BON = (const float*)(ws + WS_BON);
    bf16* O = (bf16*)(ws + WS_F);
    const float* lg = A.in[16]; const float* lb = A.in[17];
    const int gw = F.vcu * NWAVES + wave_, NGW = F.G * NWAVES, col = 8 * lane_, hd = lane_ >> 3;
    const f32x4 g0 = *(const f32x4*)(lg + col), g1 = *(const f32x4*)(lg + col + 4), b0 = *(const f32x4*)(lb + col), b1 = *(const f32x4*)(lb + col + 4);
    for (int m = gw; m < M; m += NGW) {
        const f32x4 y0 = *(const f32x4*)(Y + (size_t)m * 512 + col), y1 = *(const f32x4*)(Y + (size_t)m * 512 + col + 4);
        float s = (y0.x + y0.y) + (y0.z + y0.w) + (y1.x + y1.y) + (y1.z + y1.w);
        s += __shfl_xor(s, 1); s += __shfl_xor(s, 2); s += __shfl_xor(s, 4);
        const float mean = s * (1.f / 64.f); const f32x4 d0 = y0 - mean, d1 = y1 - mean;
        float q = (d0.x * d0.x + d0.y * d0.y) + (d0.z * d0.z + d0.w * d0.w) + (d1.x * d1.x + d1.y * d1.y) + (d1.z * d1.z + d1.w * d1.w);
        q += __shfl_xor(q, 1); q += __shfl_xor(q, 2); q += __shfl_xor(q, 4);
        const float rstd = 1.0f / sqrtf(q * (1.f / 64.f) + 64e-5f);
        const float bon = BON[(size_t)m * 8 + hd];
        const v4u vw = *(const v4u*)(VV + (size_t)m * 512 + col), gw4 = *(const v4u*)(GG + (size_t)m * 512 + col);
        f32x4 o0 = (d0 * rstd * g0 + b0), o1 = (d1 * rstd * g1 + b1);
        o0.x = (o0.x + bon * bflo(vw.x)) * bflo(gw4.x); o0.y = (o0.y + bon * bfhi(vw.x)) * bfhi(gw4.x); o0.z = (o0.z + bon * bflo(vw.y)) * bflo(gw4.y); o0.w = (o0.w + bon * bfhi(vw.y)) * bfhi(gw4.y);
        o1.x = (o1.x + bon * bflo(vw.z)) * bflo(gw4.z); o1.y = (o1.y + bon * bfhi(vw.z)) * bfhi(gw4.z); o1.z = (o1.z + bon * bflo(vw.w)) * bflo(gw4.w); o1.w = (o1.w + bon * bfhi(vw.w)) * bfhi(gw4.w);
        v4u ow; ow.x = pk2(o0.x, o0.y); ow.y = pk2(o0.z, o0.w); ow.z = pk2(o1.x, o1.y); ow.w = pk2(o1.z, o1.w);
        *(v4u*)(O + (size_t)m * 512 + col) = ow;
    }
}

__device__ __forceinline__ size_t pq_off(int it) { const int ch = it >> 8, cc = it & 255; return WS_PRW + ((size_t)(ch >> 3) * SEQ + (size_t)cc * 64) * (SHW * 2) + (size_t)(ch & 7) * 24576; }
__device__ __forceinline__ size_t y0_off(int it, int idx) { const int ch = it >> 8, cc = it & 255; return (((size_t)(ch >> 3) * SEQ + (size_t)cc * 64 + (idx >> 4)) * 512 + 64 * (ch & 7)) * 4 + (size_t)(idx & 15) * 16; }
constexpr size_t ST_OFF = 64 * MiB;
constexpr int CH_ITEMS = BATCH * 8 * (SEQ / 64);

__device__ __forceinline__ int sw16(int row, int chunk) { return row * 128 + ((chunk ^ (row & 7)) << 4); }
typedef float f32x4c __attribute__((ext_vector_type(4)));
__device__ __forceinline__ bf16x8 ld_frag(const LAS unsigned char* Mx, int row, int chunk) { return *(const LAS bf16x8*)(Mx + sw16(row, chunk)); }
template <bool SWAP>
__device__ __forceinline__ void mm_tile(const LAS unsigned char* Am, const LAS unsigned char* Bm, int r0, int c0, int l15, int kg, f32x4c (&acc)[2]) {
    bf16x8 a[2], b[2][2];
#pragma unroll
    for (int ks = 0; ks < 2; ++ks) { a[ks] = ld_frag(Am, r0 + l15, 4 * ks + kg);
#pragma unroll
        for (int n = 0; n < 2; ++n) b[ks][n] = ld_frag(Bm, c0 + 16 * n + l15, 4 * ks + kg); }
#pragma unroll
    for (int ks = 0; ks < 2; ++ks)
#pragma unroll
        for (int n = 0; n < 2; ++n)
            acc[n] = SWAP ? __builtin_amdgcn_mfma_f32_16x16x32_bf16(b[ks][n], a[ks], acc[n], 0, 0, 0) : __builtin_amdgcn_mfma_f32_16x16x32_bf16(a[ks], b[ks][n], acc[n], 0, 0, 0);
}
__device__ __forceinline__ unsigned long long pack4u(f32x4c v) { return (unsigned long long)pk2(v[0], v[1]) | ((unsigned long long)pk2(v[2], v[3]) << 32); }
__device__ __forceinline__ void st_nat(LAS unsigned char* O, int r0, int c0, int l15, int kg, const f32x4c (&acc)[2]) {
#pragma unroll
    for (int n = 0; n < 2; ++n) { const int row = r0 + l15, col = c0 + 16 * n + 4 * kg; *(LAS unsigned long long*)(O + sw16(row, col >> 3) + (col & 4) * 2) = pack4u(acc[n]); }
}
__device__ __forceinline__ void st_tr(LAS unsigned char* OT, int r0, int c0, int l15, int kg, const f32x4c (&acc)[2]) {
#pragma unroll
    for (int n = 0; n < 2; ++n)
#pragma unroll
        for (int e = 0; e < 4; ++e) { const int row = r0 + l15, col = c0 + 16 * n + 4 * kg + e; *(LAS unsigned short*)(OT + sw16(col, row >> 3) + (row & 7) * 2) = (unsigned short)f2bf(acc[n][e]); }
}
__device__ __forceinline__ f32x4c ld_nat4(const LAS unsigned char* O, int row, int col) { const unsigned long long w = *(const LAS unsigned long long*)(O + sw16(row, col >> 3) + (col & 4) * 2);
    const unsigned lo = (unsigned)w, hi = (unsigned)(w >> 32); return (f32x4c){bflo(lo), bfhi(lo), bflo(hi), bfhi(hi)}; }

template <int VAR> __device__ __forceinline__ void rwkv_r1(Frame& F, const Args& A, int it_lo, int it_hi, int it_step) {
    PHASE_IDS();
    unsigned char* ws = A.ws;
    const float* LW = (const float*)A.out; const bf16* R = (const bf16*)((unsigned char*)A.out + 64 * MiB); const bf16* KP = (const bf16*)((unsigned char*)A.out + 96 * MiB);
    const bf16* VV = (const bf16*)(ws + WS_XN); const bf16* AV = (const bf16*)(ws + WS_XN + 32 * MiB); const bf16* BV = (const bf16*)(ws + WS_F);
    LAS unsigned char* L = F.lds;
#define MB(i) (L + (i) * 8192)
    LAS float* gCs = (LAS float*)(L + 17 * 8192); LAS float* part = gCs + 64;
    const int w = wave_, j = lane_, l15 = lane_ & 15, kg = lane_ >> 4, r0 = 16 * (w >> 1), c0 = 32 * (w & 1);
#define R1_BAR() asm volatile("s_waitcnt lgkmcnt(0)\n\ts_barrier" ::: "memory")
    float nlw[8]; unsigned short nav[8], nbv[8], nkv[8], nrv[8], nvv[8];
#define R1_LOAD(itx) do { const int ch_ = (itx) >> 8, cc_ = (itx) & 255; const size_t tb_ = (size_t)(ch_ >> 3) * SEQ + (size_t)cc_ * 64 + 8 * w; const int cg_ = 64 * (ch_ & 7) + j; \
        _Pragma("unroll") for (int t = 0; t < 8; ++t) { const size_t o = (tb_ + t) * 512 + cg_; nlw[t] = LW[o]; nav[t] = AV[o]; nbv[t] = BV[o]; nkv[t] = KP[o]; nrv[t] = R[o]; nvv[t] = VV[o]; } } while (0)
    if (it_lo < it_hi) R1_LOAD(it_lo);
    for (int it = it_lo; it < it_hi; it += it_step) {
        R1_BAR();
        {
            float g[8], lw[8], av[8], bv[8], kv[8], rv[8]; unsigned short vraw[8]; float run = 0.f;
#pragma unroll
            for (int t = 0; t < 8; ++t) { lw[t] = nlw[t]; av[t] = __uint_as_float((unsigned)nav[t] << 16); bv[t] = __uint_as_float((unsigned)nbv[t] << 16);
                kv[t] = __uint_as_float((unsigned)nkv[t] << 16); rv[t] = __uint_as_float((unsigned)nrv[t] << 16); vraw[t] = nvv[t]; run += lw[t]; g[t] = run; }
            { const int itn_ = (it + it_step < it_hi) ? it + it_step : it; R1_LOAD(itn_); }
            part[w * 64 + j] = run;
            R1_BAR();
            float pre = 0.f, tot = 0.f;
#pragma unroll
            for (int q = 0; q < 8; ++q) { const float p = part[q * 64 + j]; tot += p; if (q < w) pre += p; }
            if (w == 0) gCs[j] = __expf(tot);
            unsigned short atT[8], bhT[8], khT[8];
#pragma unroll
            for (int t = 0; t < 8; ++t) { const float G = pre + g[t]; const float eg = __expf(G), en = __expf(-G), ea = __expf(G - lw[t]), ec = __expf(tot - G);
                const int row = 8 * w + t; const int off = sw16(row, j >> 3) + (j & 7) * 2;
                const unsigned short at = (unsigned short)f2bf(av[t] * ea);
                *(LAS unsigned short*)(MB(0) + off) = at; atT[t] = at;
                *(LAS unsigned short*)(MB(2) + off) = (unsigned short)f2bf(bv[t] * en);
                *(LAS unsigned short*)(MB(3) + off) = (unsigned short)f2bf(kv[t] * en);
                *(LAS unsigned short*)(MB(4) + off) = (unsigned short)f2bf(rv[t] * eg);
                bhT[t] = (unsigned short)f2bf(bv[t] * ec); khT[t] = (unsigned short)f2bf(kv[t] * ec); }
            v4u x;
            x.x = atT[0] | ((unsigned)atT[1] << 16); x.y = atT[2] | ((unsigned)atT[3] << 16); x.z = atT[4] | ((unsigned)atT[5] << 16); x.w = atT[6] | ((unsigned)atT[7] << 16); *(LAS v4u*)(MB(1) + sw16(j, w)) = x;
            x.x = bhT[0] | ((unsigned)bhT[1] << 16); x.y = bhT[2] | ((unsigned)bhT[3] << 16); x.z = bhT[4] | ((unsigned)bhT[5] << 16); x.w = bhT[6] | ((unsigned)bhT[7] << 16); *(LAS v4u*)(MB(5) + sw16(j, w)) = x;
            x.x = khT[0] | ((unsigned)khT[1] << 16); x.y = khT[2] | ((unsigned)khT[3] << 16); x.z = khT[4] | ((unsigned)khT[5] << 16); x.w = khT[6] | ((unsigned)khT[7] << 16); *(LAS v4u*)(MB(6) + sw16(j, w)) = x;
            x.x = vraw[0] | ((unsigned)vraw[1] << 16); x.y = vraw[2] | ((unsigned)vraw[3] << 16); x.z = vraw[4] | ((unsigned)vraw[5] << 16); x.w = vraw[6] | ((unsigned)vraw[7] << 16); *(LAS v4u*)(MB(7) + sw16(j, w)) = x;
        }
        R1_BAR();
        if (VAR == 1) continue;
        f32x4c acc[2];
        const int trow = r0 + l15;
        {
            acc[0] = f32x4c{}; acc[1] = f32x4c{}; mm_tile<true>(MB(0), MB(2), r0, c0, l15, kg, acc);
#pragma unroll
            for (int n = 0; n < 2; ++n)
#pragma unroll
                for (int e = 0; e < 4; ++e) { const int s = c0 + 16 * n + 4 * kg + e; if (s >= trow) acc[n][e] = 0.f; }
            st_nat(MB(8), r0, c0, l15, kg, acc); st_tr(MB(9), r0, c0, l15, kg, acc);
#pragma unroll
            for (int n = 0; n < 2; ++n)
#pragma unroll
                for (int e = 0; e < 4; ++e) { const int s = c0 + 16 * n + 4 * kg + e; if (s == trow) acc[n][e] = 1.f; }
            st_nat(MB(15), r0, c0, l15, kg, acc);
            acc[0] = f32x4c{}; acc[1] = f32x4c{}; mm_tile<true>(MB(0), MB(3), r0, c0, l15, kg, acc);
#pragma unroll
            for (int n = 0; n < 2; ++n)
#pragma unroll
                for (int e = 0; e < 4; ++e) { const int s = c0 + 16 * n + 4 * kg + e; if (s >= trow) acc[n][e] = 0.f; }
            st_nat(MB(10), r0, c0, l15, kg, acc);
            acc[0] = f32x4c{}; acc[1] = f32x4c{}; mm_tile<true>(MB(4), MB(2), r0, c0, l15, kg, acc);
#pragma unroll
            for (int n = 0; n < 2; ++n)
#pragma unroll
                for (int e = 0; e < 4; ++e) { const int s = c0 + 16 * n + 4 * kg + e; if (s > trow) acc[n][e] = 0.f; }
            st_nat(MB(11), r0, c0, l15, kg, acc);
            acc[0] = f32x4c{}; acc[1] = f32x4c{}; mm_tile<true>(MB(4), MB(3), r0, c0, l15, kg, acc);
#pragma unroll
            for (int n = 0; n < 2; ++n)
#pragma unroll
                for (int e = 0; e < 4; ++e) { const int s = c0 + 16 * n + 4 * kg + e; if (s > trow) acc[n][e] = 0.f; }
            st_nat(MB(12), r0, c0, l15, kg, acc);
        }
        R1_BAR();
        if (VAR == 2) continue;
        acc[0] = f32x4c{}; acc[1] = f32x4c{}; mm_tile<true>(MB(8), MB(9), r0, c0, l15, kg, acc); st_nat(MB(13), r0, c0, l15, kg, acc); st_tr(MB(14), r0, c0, l15, kg, acc);
        acc[0] = f32x4c{}; acc[1] = f32x4c{}; mm_tile<true>(MB(7), MB(10), r0, c0, l15, kg, acc); st_nat(MB(3), r0, c0, l15, kg, acc);
        R1_BAR();
#define SQUARE(xi, xti, xo, xto) do { acc[0] = f32x4c{}; acc[1] = f32x4c{}; mm_tile<true>(MB(xi), MB(xti), r0, c0, l15, kg, acc); st_nat(MB(xo), r0, c0, l15, kg, acc); st_tr(MB(xto), r0, c0, l15, kg, acc); } while (0)
#define MUPD(mi, xti, mo) do { acc[0] = ld_nat4(MB(mi), trow, c0 + 4 * kg); acc[1] = ld_nat4(MB(mi), trow, c0 + 16 + 4 * kg); mm_tile<true>(MB(mi), MB(xti), r0, c0, l15, kg, acc); st_nat(MB(mo), r0, c0, l15, kg, acc); } while (0)
        SQUARE(13, 14, 0, 2); MUPD(15, 14, 16); R1_BAR();
        SQUARE(0, 2, 13, 14); MUPD(16, 2, 15); R1_BAR();
        SQUARE(13, 14, 0, 2); MUPD(15, 14, 16); R1_BAR();
        SQUARE(0, 2, 13, 14); MUPD(16, 2, 15); R1_BAR();
        MUPD(15, 14, 16); R1_BAR();
        acc[0] = f32x4c{}; acc[1] = f32x4c{}; mm_tile<true>(MB(1), MB(16), r0, c0, l15, kg, acc); st_nat(MB(13), r0, c0, l15, kg, acc);
        acc[0] = f32x4c{}; acc[1] = f32x4c{}; mm_tile<true>(MB(3), MB(16), r0, c0, l15, kg, acc); st_nat(MB(14), r0, c0, l15, kg, acc);
        R1_BAR();
        if (VAR == 3) continue;
        unsigned char* og = ws + pq_off(it); unsigned char* oy = (unsigned char*)A.out + y0_off(it, w * 64 + lane_);
        {
            acc[0] = f32x4c{}; acc[1] = f32x4c{}; mm_tile<true>(MB(5), MB(13), r0, c0, l15, kg, acc);
            const float gc = gCs[trow];
#pragma unroll
            for (int n = 0; n < 2; ++n) { const int col = c0 + 16 * n + 4 * kg;
#pragma unroll
                for (int e = 0; e < 4; ++e) if (col + e == trow) acc[n][e] += gc;
                const int jj_ = col & 31, q_ = jj_ & 15; const size_t po_ = ((size_t)((((trow >> 5) * 2 + (col >> 5)) * 2 + (jj_ >> 4)) * 64 + (trow & 31) + 32 * ((q_ >> 2) & 1)) * 16 + (size_t)(4 * (q_ >> 3)) * 2);
                if (VAR == 0) *(unsigned long long*)(og + po_) = pack4u(acc[n]); else asm volatile("" :: "v"(pack4u(acc[n]))); }
            acc[0] = ld_nat4(MB(4), trow, c0 + 4 * kg); acc[1] = ld_nat4(MB(4), trow, c0 + 16 + 4 * kg); mm_tile<true>(MB(11), MB(13), r0, c0, l15, kg, acc);
#pragma unroll
            for (int n = 0; n < 2; ++n) { const int col = c0 + 16 * n + 4 * kg; if (VAR == 0) *(unsigned long long*)(og + 16384 + (size_t)(trow * 64 + col) * 2) = pack4u(acc[n]); else asm volatile("" :: "v"(pack4u(acc[n]))); }
            acc[0] = f32x4c{}; acc[1] = f32x4c{}; mm_tile<false>(MB(5), MB(14), r0, c0, l15, kg, acc); mm_tile<false>(MB(6), MB(7), r0, c0, l15, kg, acc);
#pragma unroll
            for (int n = 0; n < 2; ++n) { const int i_ = c0 + 16 * n + l15, jr_ = r0 + 4 * kg, rr_ = jr_ & 31;
                const size_t qo_ = (size_t)((((i_ >> 5) * 2 + (jr_ >> 5)) * 64 + (i_ & 31) + 32 * ((rr_ >> 2) & 1)) * 32 + (4 * (rr_ >> 3)) * 2);
                if (VAR == 0) *(unsigned long long*)(og + 8192 + qo_) = pack4u(acc[n]); else asm volatile("" :: "v"(pack4u(acc[n]))); }
            acc[0] = f32x4c{}; acc[1] = f32x4c{}; mm_tile<false>(MB(11), MB(14), r0, c0, l15, kg, acc); mm_tile<false>(MB(12), MB(7), r0, c0, l15, kg, acc);
            { v4u q; q.x = pk2(acc[0][0], acc[0][1]); q.y = pk2(acc[0][2], acc[0][3]); q.z = pk2(acc[1][0], acc[1][1]); q.w = pk2(acc[1][2], acc[1][3]); if (VAR == 0) *(v4u*)oy = q; else asm volatile("" :: "v"(q)); }
        }
    }
#undef SQUARE
#undef MUPD
#undef MB
#undef R1_BAR
#undef R1_LOAD
}

template <int VAR> __device__ __forceinline__ void rwkv_r2(Frame& F, const Args& A, unsigned char* stbase) {
    PHASE_IDS();
    if (blockIdx.x >= BATCH * 8) return;
    unsigned char* ws = A.ws;
    LAS unsigned char* L = F.lds;
    const int ch = blockIdx.x, w = wave_, l15 = lane_ & 15, kg = lane_ >> 4, r0 = 16 * (w >> 1), c0 = 32 * (w & 1);
    const unsigned char* pq = ws + pq_off(ch * 256); unsigned char* st = stbase + (size_t)ch * 256 * 8192;
    for (int i = tid_; i < 2048; i += NWAVES * 64) { ((LAS unsigned*)L)[i] = 0u; }
    for (int i = tid_; i < 512; i += NWAVES * 64) ((v4u*)st)[i] = (v4u){0u, 0u, 0u, 0u};
    __syncthreads();
    constexpr int PF = 8;
    bf16x8 pa[PF][2]; v4u qf[PF];
#define R2_LOAD(slot, step) do { const unsigned char* p_ = pq + (size_t)(step) * (64 * SHW * 2); \
        pa[slot][0] = *(const bf16x8*)(p_ + (size_t)((r0 + l15) * 64 + 8 * kg) * 2); pa[slot][1] = *(const bf16x8*)(p_ + (size_t)((r0 + l15) * 64 + 32 + 8 * kg) * 2); \
        qf[slot] = *(const v4u*)(p_ + 8192 + (size_t)(w * 64 + lane_) * 16); } while (0)
#pragma unroll
    for (int s = 0; s < PF; ++s) R2_LOAD(s, s);
    for (int c = 0; c < 256; c += PF) {
#pragma unroll
        for (int s = 0; s < PF; ++s) {
            const int step = c + s; const LAS unsigned char* Sin = L + (step & 15) * 8192; LAS unsigned char* Sout = L + ((step + 1) & 15) * 8192;
            f32x4c acc[2];
            acc[0] = (f32x4c){bflo(qf[s].x), bfhi(qf[s].x), bflo(qf[s].y), bfhi(qf[s].y)}; acc[1] = (f32x4c){bflo(qf[s].z), bfhi(qf[s].z), bflo(qf[s].w), bfhi(qf[s].w)};
            bf16x8 sf[2][2];
#pragma unroll
            for (int ks = 0; ks < 2; ++ks)
#pragma unroll
                for (int n = 0; n < 2; ++n) sf[ks][n] = ld_frag(Sin, c0 + 16 * n + l15, 4 * ks + kg);
#pragma unroll
            for (int ks = 0; ks < 2; ++ks)
#pragma unroll
                for (int n = 0; n < 2; ++n) acc[n] = __builtin_amdgcn_mfma_f32_16x16x32_bf16(pa[s][ks], sf[ks][n], acc[n], 0, 0, 0);
#pragma unroll
            for (int n = 0; n < 2; ++n) { const int row = c0 + 16 * n + l15, col = r0 + 4 * kg; const unsigned long long pkd = pack4u(acc[n]);
                *(LAS unsigned long long*)(Sout + sw16(row, col >> 3) + (col & 4) * 2) = pkd;
                }
            if (VAR != 3) { if (step + PF < 256) R2_LOAD(s, step + PF); }
            if (VAR != 4) asm volatile("s_waitcnt lgkmcnt(0)\n\ts_barrier" ::: "memory");
        }
        if (VAR != 2) { const int nflush = (c + PF < 256) ? PF * 8192 : (PF - 1) * 8192; unsigned char* dst = st + (size_t)(c + 1) * 8192;
          for (int o = tid_ * 16; o < nflush; o += NWAVES * 64 * 16) { const int row_ = (o >> 7) & 63, chk_ = (o >> 4) & 7, slot_ = (c + 1 + (o >> 13)) & 15; *(v4u*)(dst + o) = *(const LAS v4u*)(L + slot_ * 8192 + sw16(row_, chk_)); } }
    }
#undef R2_LOAD
}

__device__ __forceinline__ void rwkv_r2w(Frame& F, const Args& A, unsigned char* stbase) {
    PHASE_IDS();
    if (blockIdx.x >= BATCH * 8) return;
    unsigned char* ws = A.ws;
    LAS unsigned char* RING = F.lds;
    LAS unsigned char* HB = F.lds + 98304;
    const int ch = blockIdx.x, it = wave_ & 1, cl = lane_ & 31, hh = lane_ >> 5; const bool chain = wave_ < 2;
    const unsigned char* pq = ws + pq_off(ch * 256); unsigned char* st = stbase + (size_t)ch * 256 * 8192;
    const int ft = tid_ - 128;
    f32x16 H[2]; H[0] = f32x16{}; H[1] = f32x16{};
    v4u hx[3][6];
#define HP_LOAD(set, grp) do { _Pragma("unroll") for (int j = 0; j < 6; ++j) { const int pc_ = ft + 384 * j; const int pcc_ = pc_ < 2048 ? pc_ : 2047; int stp_ = 2 * (grp) + (pcc_ >> 10); stp_ = stp_ < 255 ? stp_ : 254; \
        hx[set][j] = *(const v4u*)(pq + (size_t)stp_ * (64 * SHW * 2) + (size_t)(pcc_ & 1023) * 16); } } while (0)
#define HP_STORE(set, slot) do { LAS unsigned char* rg_ = RING + (slot) * 32768; _Pragma("unroll") for (int j = 0; j < 6; ++j) { const int pc_ = ft + 384 * j; const int pcc_ = pc_ < 2048 ? pc_ : 2047; *(LAS v4u*)(rg_ + pcc_ * 16) = hx[set][j]; } } while (0)
#define CH_READ(PF_, QF_, rs_) do { _Pragma("unroll") for (int f = 0; f < 8; ++f) PF_[f] = *(const LAS bf16x8*)((rs_) + (f * 64 + lane_) * 16); \
        _Pragma("unroll") for (int jt = 0; jt < 2; ++jt) { const LAS unsigned char* q_ = (rs_) + 8192 + ((it * 2 + jt) * 64 + lane_) * 32; QF_[2 * jt] = *(const LAS v4u*)q_; QF_[2 * jt + 1] = *(const LAS v4u*)(q_ + 16); } } while (0)
#define CH_STEP(PF_, QF_, hbs_) do { bf16x8 B[2][2]; \
        _Pragma("unroll") for (int jt2 = 0; jt2 < 2; ++jt2) _Pragma("unroll") for (int k = 0; k < 2; ++k) { v4u p_; p_.x = pk2(H[jt2][8 * k], H[jt2][8 * k + 1]); p_.y = pk2(H[jt2][8 * k + 2], H[jt2][8 * k + 3]); \
            p_.z = pk2(H[jt2][8 * k + 4], H[jt2][8 * k + 5]); p_.w = pk2(H[jt2][8 * k + 6], H[jt2][8 * k + 7]); B[jt2][k] = __builtin_bit_cast(bf16x8, p_); } \
        _Pragma("unroll") for (int jt = 0; jt < 2; ++jt) { f32x16 n_; \
            _Pragma("unroll") for (int e = 0; e < 4; ++e) { const unsigned a_ = QF_[2 * jt][e], b_ = QF_[2 * jt + 1][e]; n_[2 * e] = bflo(a_); n_[2 * e + 1] = bfhi(a_); n_[8 + 2 * e] = bflo(b_); n_[8 + 2 * e + 1] = bfhi(b_); } \
            _Pragma("unroll") for (int jt2 = 0; jt2 < 2; ++jt2) _Pragma("unroll") for (int k = 0; k < 2; ++k) n_ = __builtin_amdgcn_mfma_f32_32x32x16_bf16(PF_[(jt * 2 + jt2) * 2 + k], B[jt2][k], n_, 0, 0, 0); \
            H[jt] = n_; } \
          \
        _Pragma("unroll") for (int jt = 0; jt < 2; ++jt) _Pragma("unroll") for (int q = 0; q < 4; ++q) { const int row = 32 * it + cl, col = 32 * jt + 8 * q + 4 * hh; \
            *(LAS unsigned long long*)((hbs_) + sw16(row, col >> 3) + (col & 4) * 2) = (unsigned long long)pk2(H[jt][4 * q], H[jt][4 * q + 1]) | ((unsigned long long)pk2(H[jt][4 * q + 2], H[jt][4 * q + 3]) << 32); } } while (0)
    if (!chain) {
        for (int o = ft * 16; o < 8192; o += 384 * 16) *(LAS v4u*)(HB + 16384 + 8192 + o) = (v4u){0u, 0u, 0u, 0u};
        HP_LOAD(0, 0); HP_STORE(0, 0); HP_LOAD(1, 1); HP_LOAD(2, 2); HP_LOAD(0, 3);
    }
    __syncthreads();
    for (int g0 = 0; g0 < 129; g0 += 3) {
#pragma unroll
        for (int u = 0; u < 3; ++u) {
            const int g = g0 + u;
            if (chain) {
                const LAS unsigned char* rg = RING + u * 32768; LAS unsigned char* hb = HB + (g & 1) * 16384;
                bf16x8 pfa[8], pfb[8]; v4u qfa[4], qfb[4];
                CH_READ(pfa, qfa, rg); CH_READ(pfb, qfb, rg + 16384);
                if (2 * g < 255) CH_STEP(pfa, qfa, hb);
                if (2 * g + 1 < 255) CH_STEP(pfb, qfb, hb + 8192);
            } else {
                HP_STORE((u + 1) % 3, (u + 1) % 3);
                HP_LOAD((u + 1) % 3, g + 4);
                const LAS unsigned char* hbp = HB + ((g - 1) & 1) * 16384; unsigned char* dst = st + (long)(2 * g - 1) * 8192;
                const int lo_ = g == 0 ? 512 : 0, hi_ = g == 128 ? 511 : 1023;
#pragma unroll
                for (int j = 0; j < 3; ++j) { int pc_ = ft + 384 * j; pc_ = pc_ < lo_ ? pc_ + 512 : pc_; pc_ = pc_ > hi_ ? hi_ : pc_; const int o = pc_ * 16; const int row_ = (o >> 7) & 63, chk_ = (o >> 4) & 7;
                    *(v4u*)(dst + o) = *(const LAS v4u*)(hbp + (o & ~8191) + sw16(row_, chk_)); }
            }
            asm volatile("s_waitcnt lgkmcnt(0)\n\ts_barrier" ::: "memory");
        }
    }
    asm volatile("s_waitcnt vmcnt(0) lgkmcnt(0)\n\ts_barrier" ::: "memory");
#undef HP_LOAD
#undef HP_STORE
#undef CH_READ
#undef CH_STEP
}

__device__ __forceinline__ void rwkv_r3(Frame& F, const Args& A) {
    PHASE_IDS();
    unsigned char* ws = A.ws;
    const bf16* VV = (const bf16*)(ws + WS_XN); const bf16* GG = (const bf16*)(ws + WS_F + 32 * MiB); const float* BON = (const float*)(ws + WS_BON);
    bf16* O = (bf16*)(ws + WS_F); const float* lg = A.in[16]; const float* lb = A.in[17];
    LAS float* Yt = (LAS float*)F.lds;
    const int w = wave_, l15 = lane_ & 15, kg = lane_ >> 4, r0 = 16 * (w >> 1), c0 = 32 * (w & 1);
#define R3_BAR() asm volatile("s_waitcnt lgkmcnt(0)\n\ts_barrier" ::: "memory")
    v4u nq, nvw, ngw; bf16x8 na[2], nb[2][2]; float nbon;
    const int pt_ = tid_ >> 3, pi0_ = 8 * (tid_ & 7);
#define R3_LOAD(itx) do { const int ch_ = (itx) >> 8, cc_ = (itx) & 255; const unsigned char* og_ = ws + pq_off(itx); const unsigned char* sg_ = (const unsigned char*)A.out + ST_OFF + (size_t)(itx) * 8192; \
        nq = *(const v4u*)((const unsigned char*)A.out + y0_off(itx, w * 64 + lane_)); \
        _Pragma("unroll") for (int ks = 0; ks < 2; ++ks) { na[ks] = *(const bf16x8*)(og_ + 16384 + (size_t)((r0 + l15) * 64 + 32 * ks + 8 * kg) * 2); \
            _Pragma("unroll") for (int n = 0; n < 2; ++n) nb[ks][n] = *(const bf16x8*)(sg_ + (size_t)((c0 + 16 * n + l15) * 64 + 32 * ks + 8 * kg) * 2); } \
        const size_t m_ = (size_t)(ch_ >> 3) * SEQ + (size_t)cc_ * 64 + pt_; const int col_ = 64 * (ch_ & 7) + pi0_; \
        nvw = *(const v4u*)(VV + m_ * 512 + col_); ngw = *(const v4u*)(GG + m_ * 512 + col_); nbon = BON[m_ * 8 + (ch_ & 7)]; } while (0)
    if ((int)blockIdx.x < CH_ITEMS) R3_LOAD((int)blockIdx.x);
    for (int it = blockIdx.x; it < CH_ITEMS; it += F.G) {
        const int ch = it >> 8, cc = it & 255, b = ch >> 3, h = ch & 7;
        f32x4c acc[2];
        acc[0] = (f32x4c){bflo(nq.x), bfhi(nq.x), bflo(nq.y), bfhi(nq.y)}; acc[1] = (f32x4c){bflo(nq.z), bfhi(nq.z), bflo(nq.w), bfhi(nq.w)};
#pragma unroll
        for (int ks = 0; ks < 2; ++ks)
#pragma unroll
            for (int n = 0; n < 2; ++n) acc[n] = __builtin_amdgcn_mfma_f32_16x16x32_bf16(na[ks], nb[ks][n], acc[n], 0, 0, 0);
        const v4u vw = nvw, gw4 = ngw; const float bon = nbon;
        { const int itn_ = (it + (int)F.G < CH_ITEMS) ? it + (int)F.G : it; R3_LOAD(itn_); }
        R3_BAR();
#pragma unroll
        for (int n = 0; n < 2; ++n)
#pragma unroll
            for (int e = 0; e < 4; ++e) Yt[(r0 + 4 * kg + e) * 68 + c0 + 16 * n + l15] = acc[n][e];
        R3_BAR();
        {   const int t = pt_, i0 = pi0_; const size_t m = (size_t)b * SEQ + (size_t)cc * 64 + t; const int col = 64 * h + i0;
            const f32x4 y0 = *(const LAS f32x4*)(Yt + t * 68 + i0), y1 = *(const LAS f32x4*)(Yt + t * 68 + i0 + 4);
            float s = (y0.x + y0.y) + (y0.z + y0.w) + (y1.x + y1.y) + (y1.z + y1.w);
            s += __shfl_xor(s, 1); s += __shfl_xor(s, 2); s += __shfl_xor(s, 4);
            const float mean = s * (1.f / 64.f); const f32x4 d0 = y0 - mean, d1 = y1 - mean;
            float q = (d0.x * d0.x + d0.y * d0.y) + (d0.z * d0.z + d0.w * d0.w) + (d1.x * d1.x + d1.y * d1.y) + (d1.z * d1.z + d1.w * d1.w);
            q += __shfl_xor(q, 1); q += __shfl_xor(q, 2); q += __shfl_xor(q, 4);
            const float rstd = 1.0f / sqrtf(q * (1.f / 64.f) + 64e-5f);
            const f32x4 g0 = *(const f32x4*)(lg + col), g1 = *(const f32x4*)(lg + col + 4), b0 = *(const f32x4*)(lb + col), b1 = *(const f32x4*)(lb + col + 4);
            f32x4 o0 = (d0 * rstd * g0 + b0), o1 = (d1 * rstd * g1 + b1);
            o0.x = (o0.x + bon * bflo(vw.x)) * bflo(gw4.x); o0.y = (o0.y + bon * bfhi(vw.x)) * bfhi(gw4.x); o0.z = (o0.z + bon * bflo(vw.y)) * bflo(gw4.y); o0.w = (o0.w + bon * bfhi(vw.y)) * bfhi(gw4.y);
            o1.x = (o1.x + bon * bflo(vw.z)) * bflo(gw4.z); o1.y = (o1.y + bon * bfhi(vw.z)) * bfhi(gw4.z); o1.z = (o1.z + bon * bflo(vw.w)) * bflo(gw4.w); o1.w = (o1.w + bon * bfhi(vw.w)) * bfhi(gw4.w);
            v4u ow; ow.x = pk2(o0.x, o0.y); ow.y = pk2(o0.z, o0.w); ow.z = pk2(o1.x, o1.y); ow.w = pk2(o1.z, o1.w);
            *(v4u*)(O + m * 512 + col) = ow; }
    }
#undef R3_BAR
#undef R3_LOAD
}

__device__ __forceinline__ void p_norm2_route(Frame& F, const Args& A) {
    PHASE_IDS();
    unsigned char* ws = A.ws;
    constexpr int WROW = 2064;
    LAS unsigned char* WH = F.lds; LAS unsigned char* WL = F.lds + 36 * WROW;
    LAS float* LG = (LAS float*)F.lds;
    LAS int* eid = (LAS int*)(F.lds + 128 * 36 * 4);
    const bf16* x1 = (const bf16*)(ws + WS_X1); const float* g2 = A.in[21]; const float* mod = (const float*)(ws + WS_MOD);
    const float* rgw = A.in[22]; const float* rgb = A.in[23]; const float* rew = A.in[24]; const float* reb = A.in[25];
    bf16* XN2 = (bf16*)(ws + WS_XN); int* route = (int*)(ws + WS_ROUTE); int* blkcnt = (int*)(ws + WS_BLKCNT);
    const int l15 = lane_ & 15, kg = lane_ >> 4;
    for (int blk = blockIdx.x; blk < M / 128; blk += F.G) {
        __syncthreads();
        for (int i = tid_; i < 4096; i += NWAVES * 64) { const float w = rgw[i]; const unsigned hi = f2bf(w); const unsigned lo = f2bf(w - __uint_as_float(hi << 16)); const int off = (i & 3) * WROW + (i >> 2) * 2;
            *(LAS unsigned short*)(WH + off) = (unsigned short)hi; *(LAS unsigned short*)(WL + off) = (unsigned short)lo; }
        for (int i = tid_; i < 32768; i += NWAVES * 64) { const float w = rew[i]; const unsigned hi = f2bf(w); const unsigned lo = f2bf(w - __uint_as_float(hi << 16)); const int off = (4 + (i & 31)) * WROW + (i >> 5) * 2;
            *(LAS unsigned short*)(WH + off) = (unsigned short)hi; *(LAS unsigned short*)(WL + off) = (unsigned short)lo; }
        __syncthreads();
        const int b = blk / (SEQ / 128); const size_t tok = (size_t)blk * 128 + wave_ * 16 + l15;
        const bf16* xrow = x1 + tok * D + 8 * kg; const float* gmp = g2 + 8 * kg; const float* scp = mod + b * 6144 + 4096 + 8 * kg; const float* shp = mod + b * 6144 + 3072 + 8 * kg;
        float ss = 0.f;
#pragma unroll 8
        for (int ks = 0; ks < 32; ++ks) { const v4u xw = *(const v4u*)(xrow + 32 * ks);
#pragma unroll
            for (int e = 0; e < 4; ++e) { const float lo_ = bflo(xw[e]), hi_ = bfhi(xw[e]); ss += lo_ * lo_ + hi_ * hi_; } }
        ss += __shfl_xor(ss, 16); ss += __shfl_xor(ss, 32);
        const float rstd = 1.0f / sqrtf(ss * (1.f / D) + 1e-6f);
        f32x4 acc[3]; acc[0] = f32x4{0.f, 0.f, 0.f, 0.f}; acc[1] = acc[0]; acc[2] = acc[0];
        int wcol[3];
#pragma unroll
        for (int ct = 0; ct < 3; ++ct) { const int col = 16 * ct + l15; wcol[ct] = (col < 36 ? col : 35) * WROW + 16 * kg; }
#pragma unroll 2
        for (int ks = 0; ks < 32; ++ks) {
            float hv[8];
            { const v4u xw = *(const v4u*)(xrow + 32 * ks); const f32x4 a = {bflo(xw.x), bfhi(xw.x), bflo(xw.y), bfhi(xw.y)}, c = {bflo(xw.z), bfhi(xw.z), bflo(xw.w), bfhi(xw.w)};
              const f32x4 g0 = *(const f32x4*)(gmp + 32 * ks), g1 = *(const f32x4*)(gmp + 32 * ks + 4), s0 = *(const f32x4*)(scp + 32 * ks), s1 = *(const f32x4*)(scp + 32 * ks + 4), h0 = *(const f32x4*)(shp + 32 * ks), h1 = *(const f32x4*)(shp + 32 * ks + 4);
              const f32x4 u0 = a * rstd * (g0 * (s0 + 1.0f)) + h0, u1 = c * rstd * (g1 * (s1 + 1.0f)) + h1;
              hv[0] = u0.x; hv[1] = u0.y; hv[2] = u0.z; hv[3] = u0.w; hv[4] = u1.x; hv[5] = u1.y; hv[6] = u1.z; hv[7] = u1.w; }
            unsigned hiw[4], low[4];
#pragma unroll
            for (int e = 0; e < 4; ++e) { const unsigned h0 = f2bf(hv[2 * e]), h1 = f2bf(hv[2 * e + 1]); hiw[e] = h0 | (h1 << 16);
                low[e] = f2bf(hv[2 * e] - __uint_as_float(h0 << 16)) | (f2bf(hv[2 * e + 1] - __uint_as_float(h1 << 16)) << 16); }
            v4u hq; hq.x = hiw[0]; hq.y = hiw[1]; hq.z = hiw[2]; hq.w = hiw[3];
            *(v4u*)(XN2 + tok * D + 32 * ks + 8 * kg) = hq;
            v4u lq; lq.x = low[0]; lq.y = low[1]; lq.z = low[2]; lq.w = low[3];
            const bf16x8 ah = __builtin_bit_cast(bf16x8, hq), al = __builtin_bit_cast(bf16x8, lq);
#pragma unroll
            for (int ct = 0; ct < 3; ++ct) { const bf16x8 bh = *(const LAS bf16x8*)(WH + wcol[ct] + 64 * ks), bl = *(const LAS bf16x8*)(WL + wcol[ct] + 64 * ks);
                acc[ct] = __builtin_amdgcn_mfma_f32_16x16x32_bf16(ah, bh, acc[ct], 0, 0, 0); acc[ct] = __builtin_amdgcn_mfma_f32_16x16x32_bf16(ah, bl, acc[ct], 0, 0, 0); acc[ct] = __builtin_amdgcn_mfma_f32_16x16x32_bf16(al, bh, acc[ct], 0, 0, 0); }
        }
        __syncthreads();
#pragma unroll
        for (int ct = 0; ct < 3; ++ct) { const int col = 16 * ct + l15; if (col < 36) { const float bias = (col < 4) ? rgb[col] : reb[col - 4];
#pragma unroll
            for (int e = 0; e < 4; ++e) LG[(wave_ * 16 + 4 * kg + e) * 36 + col] = acc[ct][e] + bias; } }
        __syncthreads();
        if (tid_ < 128) { const LAS float* lg = LG + tid_ * 36;
            int gi = 0; float gmax = lg[0];
#pragma unroll
            for (int i = 1; i < 4; ++i) if (lg[i] > gmax) { gmax = lg[i]; gi = i; }
            float den = 0.f;
#pragma unroll
            for (int i = 0; i < 4; ++i) den += __expf(lg[i] - gmax);
            const float gp = 1.0f / den;
            float el[8];
#pragma unroll
            for (int i = 0; i < 8; ++i) el[i] = lg[4 + 8 * gi + i];
            int i0 = 0; float m0 = el[0];
#pragma unroll
            for (int i = 1; i < 8; ++i) if (el[i] > m0) { m0 = el[i]; i0 = i; }
            int i1 = -1; float m1 = -INFINITY;
#pragma unroll
            for (int i = 0; i < 8; ++i) if (i != i0 && el[i] > m1) { m1 = el[i]; i1 = i; }
            if (i1 < 0) { i1 = (i0 + 1) & 7; m1 = m0; }
            const float p1 = __expf(m1 - m0), w0 = gp / (1.0f + p1), w1 = gp * p1 / (1.0f + p1);
            int* rt_ = route + ((size_t)blk * 128 + tid_) * 8; rt_[0] = gi * 8 + i0; rt_[1] = gi * 8 + i1; rt_[2] = __float_as_int(w0); rt_[3] = __float_as_int(w1);
            eid[tid_ * 2] = gi * 8 + i0; eid[tid_ * 2 + 1] = gi * 8 + i1; }
        __syncthreads();
        if (tid_ < 256) { const int e = eid[tid_]; int rk = 0; for (int a = 0; a < tid_; ++a) rk += (eid[a] == e) ? 1 : 0; route[((size_t)blk * 128 + (tid_ >> 1)) * 8 + 4 + (tid_ & 1)] = rk; }
        else if (tid_ < 288) { const int e = tid_ - 256; int cn = 0; for (int a = 0; a < 256; ++a) cn += (eid[a] == e) ? 1 : 0; blkcnt[blk * 32 + e] = cn; }
    }
}

__device__ __forceinline__ void conv_experts(Frame& F, const Args& A) {
    PHASE_IDS();
    unsigned char* ws = A.ws; bf16* W13 = (bf16*)(ws + WS_W13); bf16* W2T = (bf16*)(ws + WS_W2T);
    LAS float* scr = (LAS float*)(F.lds + RING_OFF + wave_ * 16384);
    const int gw = F.vcu * NWAVES + wave_, NGW = F.G * NWAVES;
    for (int it = gw; it < 3 * 8192; it += NGW) {
        const int which = it >> 13, r = it & 8191;
        if (which < 2) { const int e = r >> 8, kb = (r >> 4) & 15, nb = r & 15, n0 = 32 * nb;
            transpose_item(A.in[26 + which] + (size_t)e * 1024 * 512, 512, n0, 64 * kb, 1024, W13, (size_t)e * 1024 + (n0 >> 7) * 256 + which * 128 + (n0 & 127), scr, lane_); }
        else { const int e = r >> 8, kb = (r >> 5) & 7, nb = r & 31;
            transpose_item(A.in[28] + (size_t)e * 512 * 1024, 1024, 32 * nb, 64 * kb, 512, W2T, (size_t)e * 1024 + 32 * nb, scr, lane_); }
    }
}

__device__ __forceinline__ void p_slots(Frame& F, const Args& A) {
    PHASE_IDS();
    unsigned char* ws = A.ws;
    LAS int* tile_e = (LAS int*)(F.lds + TILE_OFF); LAS int* base = tile_e + 288; LAS int* tot = base + 32; LAS int* pre = tot + 32; LAS int* ntl = pre + 32; LAS int* part = ntl + 4;
    const int* blkcnt = (const int*)(ws + WS_BLKCNT); int* route = (int*)(ws + WS_ROUTE); int* rowtok = (int*)(ws + WS_ROWTOK);
    { const int e = tid_ & 31, pt = tid_ >> 5; int s = 0; for (int bb = 16 * pt; bb < 16 * pt + 16; ++bb) s += blkcnt[bb * 32 + e]; part[pt * 32 + e] = s; }
    __syncthreads();
    if (tid_ < 32) { int t = 0; for (int p = 0; p < 16; ++p) t += part[p * 32 + tid_]; tot[tid_] = t; }
    __syncthreads();
    if (tid_ == 0) { int run = 0, nt = 0; for (int e = 0; e < 32; ++e) { base[e] = run; const int pad = (tot[e] + 255) >> 8; for (int i = 0; i < pad; ++i) tile_e[nt++] = e; run += pad * 256; } ntl[0] = nt; }
    __syncthreads();
    for (int blk = blockIdx.x; blk < M / 128; blk += F.G) {
        { const int e = tid_ & 31, pt = tid_ >> 5; int s = 0; for (int bb = pt; bb < blk; bb += 16) s += blkcnt[bb * 32 + e]; part[pt * 32 + e] = s; }
        __syncthreads();
        if (tid_ < 32) { int p = 0; for (int q = 0; q < 16; ++q) p += part[q * 32 + tid_]; pre[tid_] = p; }
        __syncthreads();
        if (tid_ < 256) { const size_t tok = (size_t)blk * 128 + (tid_ >> 1); const int k = tid_ & 1; const int e = route[tok * 8 + k], lr = route[tok * 8 + 4 + k];
            const int slot = base[e] + pre[e] + lr; route[tok * 8 + 6 + k] = slot; rowtok[slot] = (int)tok; }
        __syncthreads();
    }
    for (int e = blockIdx.x; e < 32; e += F.G) { const int lo = base[e] + tot[e], hi = base[e] + (((tot[e] + 255) >> 8) << 8); for (int s = lo + tid_; s < hi; s += NWAVES * 64) rowtok[s] = 0; }
}

#ifndef STAGE_UNUSED
#define STAGE 4
#endif
#ifndef PHASES
#define PHASES 0xffff
#endif
#ifndef RWKV_CHUNKED
#define RWKV_CHUNKED 1
#endif

__device__ __forceinline__ void ph_gemm1(Frame& F, const Args& args) { unsigned char* ws = args.ws;
    pg8::Gemm g{(const pg8::bf16_t*)(ws + WS_XN), (const pg8::bf16_t*)(ws + WS_WIN), nullptr, 1024, NIN};
    pg8::StaticOrder S; S.init(M, NIN, F.G, (int)blockIdx.x);
    pg8::EpiIn E{(pg8::bf16_t*)(ws + WS_Q), (pg8::bf16_t*)(ws + WS_K), (pg8::bf16_t*)(ws + WS_V), (pg8::bf16_t*)(ws + WS_PRW), (pg8::bf16_t*)(ws + WS_GATES), ATT_C2};
    pg8::gemm_phase<pg8::EpiIn, pg8::StaticOrder>(F.lds + RING_OFF, g, S, E); }
__device__ __forceinline__ void ph_attn_wrap(unsigned char* lds, Frame& F, const Args& args, size_t out_off, int qslot) { unsigned char* ws = args.ws;
    const attn_body::AttnTensors AT{(const attn_body::bf16*)(ws + WS_Q), (const attn_body::bf16*)(ws + WS_K), (const attn_body::bf16*)(ws + WS_V), (attn_body::bf16*)(ws + out_off), (const float*)(ws + WS_CUM), (const float*)(ws + WS_SEGTOT)};
    attn_body::attn_phase_dyn<8>((char*)lds + RING_OFF, AT, (unsigned*)(F.ctl + CW_QUEUE + 64 * qslot), (const unsigned*)(F.ctl + CW_QKMAX), (const unsigned*)(F.ctl + CW_KTMAX), TAB_OFF, SEGP_OFF); }
__device__ __forceinline__ void ph_gemm2a(Frame& F, const Args& args) { unsigned char* ws = args.ws;
    pg8::Gemm g{(const pg8::bf16_t*)(ws + WS_Q), (const pg8::bf16_t*)(ws + WS_WOF), nullptr, 512, 1024};
    pg8::StaticOrder S; S.init(M, 1024, F.G, (int)blockIdx.x);
    pg8::EpiGate<1> E{(pg8::bf16_t*)(ws + WS_TMP), 1024, (const pg8::bf16_t*)(ws + WS_GATES), 2048, 0};
    pg8::gemm_phase<pg8::EpiGate<1>, pg8::StaticOrder>(F.lds + RING_OFF, g, S, E); }
__device__ __forceinline__ void ph_gemm2b(Frame& F, const Args& args) { unsigned char* ws = args.ws;
    pg8::Gemm g{(const pg8::bf16_t*)(ws + WS_F), (const pg8::bf16_t*)(ws + WS_WOR), nullptr, 512, 1024};
    pg8::StaticOrder S; S.init(M, 1024, F.G, (int)blockIdx.x);
    pg8::EpiGate<2> E{(pg8::bf16_t*)(ws + WS_TMP), 1024, (const pg8::bf16_t*)(ws + WS_GATES), 2048, 1024};
    pg8::gemm_phase<pg8::EpiGate<2>, pg8::StaticOrder>(F.lds + RING_OFF, g, S, E); }
__device__ __forceinline__ void ph_gemm3(Frame& F, const Args& args) { unsigned char* ws = args.ws;
    pg8::Gemm g{(const pg8::bf16_t*)(ws + WS_TMP), (const pg8::bf16_t*)(ws + WS_WO), nullptr, 1024, 1024};
    pg8::StaticOrder S; S.init(M, 1024, F.G, (int)blockIdx.x);
    pg8::EpiRes E{args.in[0], (pg8::bf16_t*)(ws + WS_X1), (const float*)(ws + WS_MOD) + 2048, SEQ, 6144};
    pg8::gemm_phase<pg8::EpiRes, pg8::StaticOrder>(F.lds + RING_OFF, g, S, E); }
__device__ __forceinline__ void ph_moe_up(Frame& F, const Args& args) { unsigned char* ws = args.ws;
    const LAS int* tile_e = (const LAS int*)(F.lds + TILE_OFF); const int ntiles = tile_e[288 + 96];
    LAS int* rows = (LAS int*)(F.lds + TILE_OFF + 4096);
    { const int* rowtok = (const int*)(ws + WS_ROWTOK); int tid_ = threadIdx.x; asm volatile("" : "+v"(tid_));
      for (int i = 0; i < 8; ++i) { const int L = i * F.G + (int)blockIdx.x; if (L >= ntiles * 4) break; if (tid_ < 256) rows[i * 256 + tid_] = rowtok[(L >> 2) * 256 + tid_]; }
      __syncthreads(); }
    pg8::Gemm g{(const pg8::bf16_t*)(ws + WS_XN), (const pg8::bf16_t*)(ws + WS_W13), rows, 1024, 1024};
    pg8::MoeOrder S{ntiles * 4, F.G, (int)blockIdx.x, 2, tile_e};
    pg8::EpiSwiGLU E{(pg8::bf16_t*)(ws + WS_H)};
    pg8::gemm_phase<pg8::EpiSwiGLU, pg8::MoeOrder, true>(F.lds + RING_OFF, g, S, E); }
__device__ __forceinline__ void ph_moe_down(Frame& F, const Args& args) { unsigned char* ws = args.ws;
    const LAS int* tile_e = (const LAS int*)(F.lds + TILE_OFF); const int ntiles = tile_e[288 + 96];
    pg8::Gemm g{(const pg8::bf16_t*)(ws + WS_H), (const pg8::bf16_t*)(ws + WS_W2T), nullptr, 512, 1024};
    pg8::MoeOrder S{ntiles * 4, F.G, (int)blockIdx.x, 2, tile_e};
    pg8::EpiFp8 E{ws + WS_YM, 1024};
    pg8::gemm_phase<pg8::EpiFp8, pg8::MoeOrder>(F.lds + RING_OFF, g, S, E); }

__global__ void __launch_bounds__(NWAVES * 64, 2) fwd_kernel(Args args) {
    extern __shared__ __attribute__((aligned(16))) unsigned char lds[];
    Frame F;
    F.lds = (LAS unsigned char*)lds;
    F.MISC = (volatile LAS unsigned*)(F.lds + MISC_OFF);
    F.tid = threadIdx.x; F.lane = F.tid & 63; F.wave = __builtin_amdgcn_readfirstlane(F.tid >> 6);
    F.G = gridDim.x; { const int bx = blockIdx.x; F.vcu = (F.G % 8 == 0) ? (bx % 8) * (F.G / 8) + bx / 8 : bx; }
    unsigned char* ws = args.ws;
    F.ctl = (gu32*)(ws + WS_CTL);
    for (int u = F.tid; u < (LDS_BYTES - LDSCTL_OFF) / 4; u += NWAVES * 64) ((LAS unsigned*)(F.lds + LDSCTL_OFF))[u] = 0u;
    __syncthreads();
    XcdBarrier bar = xcd_barrier_post((unsigned*)(F.ctl + CW_BAR), F.MISC + 8);
#define GRID_BAR() xcd_barrier(bar)

    p0_prologue(F, args); GRID_BAR();
    p1_norm(F, args); __syncthreads(); p_convert_early(F, args); GRID_BAR();
    p_cumfix(F, args);
    ph_gemm1(F, args); GRID_BAR();
    p_qknorm(F, args, (unsigned*)(F.ctl + CW_QKMAX), (unsigned*)(F.ctl + CW_KTMAX));
    for (int cb = (int)blockIdx.x; cb < SEQ / 64; cb += F.G)
    for (int half = 0; half < 2; ++half) {
        rwkv_pre<0>(F, args, cb + 256 * half, cb + 256 * half + 1);
        __syncthreads();
        rwkv_r1<0>(F, args, cb + 2048 * half, cb + 2048 * half + 2048, 256);
        __syncthreads();
    }
    GRID_BAR();
    rwkv_r2w(F, args, (unsigned char*)args.out + ST_OFF);
    ph_attn_wrap(lds, F, args, WS_Q, 0); GRID_BAR();
    rwkv_r3(F, args); GRID_BAR();
    ph_gemm2a(F, args);
    ph_gemm2b(F, args); GRID_BAR();
    ph_gemm3(F, args); GRID_BAR();
    p_norm2_route(F, args); GRID_BAR();
    p_slots(F, args); conv_experts(F, args); GRID_BAR();
    ph_moe_up(F, args); GRID_BAR();
    ph_moe_down(F, args); GRID_BAR();
    p_final<1>(F, args, args.out);
}

extern "C" void kernel_launch(void* const* d_in, const int* in_sizes, int n_in, void* d_out, int out_size, void* d_ws, size_t ws_size, hipStream_t stream) {
    static int grid = 0;
    if (grid == 0) {
        if (n_in != 30 || in_sizes[0] != M * D || out_size != M * D || ws_size < WS_END) { fprintf(stderr, "kernel_launch: unexpected shapes (n_in %d, in0 %d, out %d, ws %zu)\n", n_in, n_in > 0 ? in_sizes[0] : -1, out_size, ws_size); grid = -1; return; }
        int dev = 0, cus = 0, per_cu = 0;
        if (hipGetDevice(&dev) != hipSuccess || hipDeviceGetAttribute(&cus, hipDeviceAttributeMultiprocessorCount, dev) != hipSuccess) { grid = -1; return; }
        if (hipFuncSetAttribute((const void*)fwd_kernel, hipFuncAttributeMaxDynamicSharedMemorySize, LDS_BYTES) != hipSuccess) { fprintf(stderr, "kernel_launch: hipFuncSetAttribute failed\n"); grid = -1; return; }
        if (hipOccupancyMaxActiveBlocksPerMultiprocessor(&per_cu, (const void*)fwd_kernel, NWAVES * 64, LDS_BYTES) != hipSuccess || per_cu < 1)
            fprintf(stderr, "kernel_launch: occupancy query reports %d\n", per_cu);
        (void)hipGetLastError();
        grid = cus;
        if (grid > 256) grid = 256;
    }
    if (grid < 0) return;
    if (hipMemsetAsync((char*)d_ws + WS_CTL, 0, CTL_ZERO_BYTES, stream) != hipSuccess) return;
    Args a{};
    for (int i = 0; i < 30; ++i) a.in[i] = (const float*)d_in[i];
    a.out = (float*)d_out; a.ws = (unsigned char*)d_ws;
    hipLaunchKernelGGL(fwd_kernel, dim3(grid), dim3(NWAVES * 64), LDS_BYTES, stream, a);
}
```

```cpp
#include <hip/hip_runtime.h>
#include <hip/hip_bf16.h>
#include <cstdio>
#include <cstdint>
#include <cmath>

namespace pg8 {
#define PG8_LAS __attribute__((address_space(3)))
typedef unsigned short bf16_t;
typedef short bf16x8 __attribute__((ext_vector_type(8)));
typedef float f32x4 __attribute__((ext_vector_type(4)));
typedef unsigned u32x4 __attribute__((ext_vector_type(4)));
typedef unsigned u32x2 __attribute__((ext_vector_type(2)));
constexpr int BM = 256, BK = 64, HALF = 128, HTB = HALF * BK * 2, STAGE_BYTES = 8 * HTB, NXCD = 8, WGM = 8;

__host__ __device__ __forceinline__ int lds_byte(int r, int c) { const int st = (r >> 4) * 2 + (c >> 5), rr = r & 15, cc = c & 31, ob = rr * 64 + cc * 2; return st * 1024 + (ob ^ (((ob >> 9) & 1) << 5)); }
__host__ __device__ __forceinline__ void stage_rc(int b, int& R, int& C) { const int st = b / 1024, sb = b % 1024, swz = sb ^ (((sb >> 9) & 1) << 5); R = (st >> 1) * 16 + swz / 64; C = (st & 1) * 32 + (swz % 64) / 2; }
__host__ __device__ __forceinline__ int perm32(int rho) { const int n = rho >> 4, i = rho & 15; return 8 * (i >> 2) + 4 * n + (i & 3); }

struct Unit { int pm, pn, e; };
struct Gemm { const bf16_t* A; const bf16_t* Bt; const PG8_LAS int* rowlds; int K; int nB; };

struct StaticOrder {
    int nM, nN, nwg, G, c;
    __host__ __device__ void init(int M, int N, int G_, int c_) { nM = M / BM; nN = N / BM; nwg = nM * nN; G = G_; c = c_; }
    __host__ __device__ bool next(int i, Unit& u) const {
        const long L = (long)i * G + c; if (L >= nwg) return false;
        int wgid = (int)L; { const int q = nwg / NXCD, r = nwg % NXCD, xcd = wgid % NXCD, off = wgid / NXCD; wgid = (xcd < r ? xcd * (q + 1) : r * (q + 1) + (xcd - r) * q) + off; }
        const int nig = WGM * nN, gid = wgid / nig, fm = gid * WGM, gsz = (nM - fm) < WGM ? (nM - fm) : WGM;
        u.pm = fm + ((wgid % nig) % gsz); u.pn = (wgid % nig) / gsz; u.e = 0; return true;
    }
};

__device__ __forceinline__ unsigned cvt_pk_bf16(float lo, float hi) { unsigned r; asm volatile("v_cvt_pk_bf16_f32 %0, %1, %2" : "=v"(r) : "v"(lo), "v"(hi)); return r; }
__device__ __forceinline__ float bf_lo(unsigned w) { return __uint_as_float(w << 16); }
__device__ __forceinline__ float bf_hi(unsigned w) { return __uint_as_float(w & 0xffff0000u); }
__device__ __forceinline__ float fsigmoid(float x) { return __builtin_amdgcn_rcpf(1.0f + __builtin_amdgcn_exp2f(-1.4426950408889634f * x)); }

template <class Epi, class Sched, bool GATHER = false>
__device__ __forceinline__ void gemm_phase(PG8_LAS unsigned char* lds, const Gemm g, const Sched& S, const Epi& E) {
    int tid_ = threadIdx.x; asm volatile("" : "+v"(tid_));
    const int tid = tid_, wid = __builtin_amdgcn_readfirstlane(tid >> 6), lane = tid & 63, wr = wid >> 2, wc = wid & 3, fr = lane & 15, fq = lane >> 4;
    const int K = g.K, nt = K / BK;
    int RA[2], CA[2]; unsigned voffA[2], voffB[2];
#pragma unroll
    for (int i = 0; i < 2; ++i) { int R, C; stage_rc(tid * 16 + i * 8192, R, C); const int Rb = Epi::PERM ? ((R & ~31) + perm32(R & 31)) : R;
        RA[i] = R; CA[i] = C; voffA[i] = (unsigned)(R * K + C) * 2u; voffB[i] = (unsigned)(Rb * K + C) * 2u; }
    const size_t tstep = 2 * (size_t)HALF * K * 2;
    const size_t kstep = (size_t)(BK * 2);
    const size_t hstep = (size_t)HALF * K * 2;
    const unsigned ldsw = (unsigned)wid * 1024u;
    const int aoff = lds_byte(wr * 64 + fr, fq * 8), boff = lds_byte(wc * 32 + fr, fq * 8);
#define PG8_SA(b, h) (((b) * 2 + (h)) * HTB)
#define PG8_SB(b, h) ((4 + (b) * 2 + (h)) * HTB)
#define PG8_STAGE(bufoff, gbase, v0, v1) do { \
        __builtin_amdgcn_global_load_lds((const unsigned*)((const char*)(gbase) + (v0)), (PG8_LAS unsigned*)(lds + (bufoff) + ldsw), 16, 0, 0); \
        __builtin_amdgcn_global_load_lds((const unsigned*)((const char*)(gbase) + (v1)), (PG8_LAS unsigned*)(lds + (bufoff) + ldsw + 8192), 16, 0, 0); } while (0)
#define PG8_STAGEB(bufoff, gbase) PG8_STAGE(bufoff, gbase, voffB[0], voffB[1])
#define PG8_STAGEA(bufoff, abase, h, VA) do { if constexpr (GATHER) { PG8_STAGE(bufoff, abase, VA[h][0], VA[h][1]); } else { PG8_STAGE(bufoff, (abase) + (h) * hstep, voffA[0], voffA[1]); } } while (0)
#define PG8_LDA(dst, b, h) do { _Pragma("unroll") for (int m = 0; m < 4; ++m) _Pragma("unroll") for (int k = 0; k < 2; ++k) dst[m][k] = *(const PG8_LAS bf16x8*)(lds + PG8_SA(b, h) + aoff + m * 2048 + k * 1024); } while (0)
#define PG8_LDB(dst, b, h) do { _Pragma("unroll") for (int n = 0; n < 2; ++n) _Pragma("unroll") for (int k = 0; k < 2; ++k) dst[n][k] = *(const PG8_LAS bf16x8*)(lds + PG8_SB(b, h) + boff + n * 2048 + k * 1024); } while (0)
#define PG8_MMA(ai, bj, At, Bt) do { __builtin_amdgcn_s_setprio(1); _Pragma("unroll") for (int m = 0; m < 4; ++m) _Pragma("unroll") for (int n = 0; n < 2; ++n) _Pragma("unroll") for (int k = 0; k < 2; ++k) \
        acc[ai][bj][m][n] = __builtin_amdgcn_mfma_f32_16x16x32_bf16(Bt[n][k], At[m][k], acc[ai][bj][m][n], 0, 0, 0); __builtin_amdgcn_s_setprio(0); } while (0)
#define PG8_WAIT_V(n) asm volatile("s_waitcnt vmcnt(" #n ")" ::: "memory")
#define PG8_WAIT_L(n) asm volatile("s_waitcnt lgkmcnt(" #n ")" ::: "memory")
#define PG8_BAR __builtin_amdgcn_s_barrier()
#define PG8_SCHED __builtin_amdgcn_sched_barrier(0)
#define PG8_AOFF(dst, ord) do { _Pragma("unroll") for (int h_ = 0; h_ < 2; ++h_) _Pragma("unroll") for (int i_ = 0; i_ < 2; ++i_) { \
        const int src_ = g.rowlds[(ord) * BM + h_ * HALF + RA[i_]]; dst[h_][i_] = (unsigned)(src_ * K + CA[i_]) * 2u; } } while (0)
    Unit cur, nxt; int ui = 0;
    if (!S.next(0, cur)) return;
    f32x4 acc[2][2][4][2];
#pragma unroll
    for (int a = 0; a < 2; ++a)
#pragma unroll
        for (int b = 0; b < 2; ++b)
#pragma unroll
            for (int m = 0; m < 4; ++m)
#pragma unroll
                for (int n = 0; n < 2; ++n) acc[a][b][m][n] = (f32x4){0.f, 0.f, 0.f, 0.f};
    bf16x8 At[4][2], B0[2][2], B1[2][2];
    unsigned vA[2][2], nvA[2][2];
    if constexpr (GATHER) { PG8_AOFF(vA, 0); }
    const char* cA = GATHER ? (const char*)g.A : (const char*)g.A + (size_t)cur.pm * tstep;
    const char* cB = (const char*)g.Bt + ((size_t)cur.e * g.nB + (size_t)cur.pn * BM) * K * 2;
    PG8_STAGEB(PG8_SB(0, 0), cB); PG8_STAGEB(PG8_SB(0, 1), cB + hstep); PG8_STAGEA(PG8_SA(0, 0), cA, 0, vA); PG8_STAGEA(PG8_SA(0, 1), cA, 1, vA);
    if (wr == 1) PG8_BAR;
    PG8_WAIT_V(2); PG8_BAR;
    PG8_STAGEB(PG8_SB(1, 0), cB + kstep); PG8_STAGEA(PG8_SA(1, 0), cA + kstep, 0, vA); PG8_STAGEB(PG8_SB(1, 1), cB + hstep + kstep);
    PG8_WAIT_V(6); PG8_BAR;
    for (;;) {
        const bool has_next = S.next(ui + 1, nxt);
        if constexpr (GATHER) { if (has_next) { PG8_AOFF(nvA, ui + 1); } else {
#pragma unroll
            for (int h_ = 0; h_ < 2; ++h_)
#pragma unroll
                for (int i_ = 0; i_ < 2; ++i_) nvA[h_][i_] = vA[h_][i_]; } }
        const char* nA = GATHER ? cA : (has_next ? (const char*)g.A + (size_t)nxt.pm * tstep : cA);
        const char* nB = has_next ? (const char*)g.Bt + ((size_t)nxt.e * g.nB + (size_t)nxt.pn * BM) * K * 2 : cB;
        for (int t = 0; t < nt; t += 2) {
            const bool last = (t == nt - 2);
            const char* a1 = cA + (size_t)(t + 1) * kstep;
            const char* a2 = last ? nA : cA + (size_t)(t + 2) * kstep; const char* b2 = last ? nB : cB + (size_t)(t + 2) * kstep;
            const char* a3 = a2 + kstep; const char* b3 = b2 + kstep;
            unsigned wv[2][2];
            if constexpr (GATHER) { wv[0][0] = last ? nvA[0][0] : vA[0][0]; wv[0][1] = last ? nvA[0][1] : vA[0][1]; wv[1][0] = last ? nvA[1][0] : vA[1][0]; wv[1][1] = last ? nvA[1][1] : vA[1][1]; }
            PG8_LDB(B0, 0, 0); PG8_LDB(B1, 0, 1); PG8_SCHED; PG8_LDA(At, 0, 0); PG8_STAGEA(PG8_SA(1, 1), a1, 1, vA);
            PG8_WAIT_V(8); PG8_WAIT_L(0); PG8_BAR; PG8_MMA(0, 0, At, B0); PG8_MMA(0, 1, At, B1); PG8_BAR; PG8_SCHED;
            PG8_LDA(At, 0, 1); PG8_STAGEB(PG8_SB(0, 0), b2); PG8_STAGEB(PG8_SB(0, 1), b2 + hstep); PG8_STAGEA(PG8_SA(0, 0), a2, 0, wv);
            PG8_WAIT_V(8); PG8_WAIT_L(0); PG8_BAR; PG8_MMA(1, 0, At, B0); PG8_MMA(1, 1, At, B1); PG8_BAR; PG8_SCHED;
            PG8_LDB(B0, 1, 0); PG8_LDB(B1, 1, 1); PG8_SCHED; PG8_LDA(At, 1, 0); PG8_STAGEA(PG8_SA(0, 1), a2, 1, wv);
            PG8_WAIT_V(8); PG8_WAIT_L(0); PG8_BAR; PG8_MMA(0, 0, At, B0); PG8_MMA(0, 1, At, B1); PG8_BAR; PG8_SCHED;
            PG8_LDA(At, 1, 1); PG8_STAGEB(PG8_SB(1, 0), b3); PG8_STAGEB(PG8_SB(1, 1), b3 + hstep); PG8_STAGEA(PG8_SA(1, 0), a3, 0, wv);
            PG8_WAIT_V(8); PG8_WAIT_L(0); PG8_BAR; PG8_MMA(1, 0, At, B0); PG8_MMA(1, 1, At, B1); PG8_BAR; PG8_SCHED;
        }
        if (wr == 0) PG8_BAR;
        E(acc, cur, wr, wc, fr, fq);
        if (!has_next) break;
#pragma unroll
        for (int a = 0; a < 2; ++a)
#pragma unroll
            for (int b = 0; b < 2; ++b)
#pragma unroll
                for (int m = 0; m < 4; ++m)
#pragma unroll
                    for (int n = 0; n < 2; ++n) acc[a][b][m][n] = (f32x4){0.f, 0.f, 0.f, 0.f};
        cur = nxt; cB = nB; cA = nA; ++ui;
        if constexpr (GATHER) {
#pragma unroll
        for (int h_ = 0; h_ < 2; ++h_)
#pragma unroll
            for (int i_ = 0; i_ < 2; ++i_) vA[h_][i_] = nvA[h_][i_]; }
        if (wr == 1) PG8_BAR;
    }
    PG8_WAIT_V(0);
    PG8_BAR;
#undef PG8_SA
#undef PG8_SB
#undef PG8_STAGE
#undef PG8_STAGEB
#undef PG8_STAGEA
#undef PG8_LDA
#undef PG8_LDB
#undef PG8_MMA
#undef PG8_WAIT_V
#undef PG8_WAIT_L
#undef PG8_BAR
#undef PG8_SCHED
#undef PG8_AOFF
}
}

namespace pg8 {
struct EpiIn {
    static constexpr bool PERM = true;
    bf16_t *Q, *Kb, *V, *PRW, *GT; float qscale;
    __device__ __forceinline__ void operator()(const f32x4 (&acc)[2][2][4][2], const Unit& u, int wr, int wc, int fr, int fq) const {
        const int pn = u.pn; bf16_t* base; int ld, colt, mode = 0;
        if (pn < 2) { base = Q; ld = 512; colt = pn * 256; mode = 1; }
        else if (pn < 4) { base = Kb; ld = 512; colt = (pn - 2) * 256; }
        else if (pn < 6) { base = V; ld = 512; colt = (pn - 4) * 256; }
        else if (pn < 13) { base = PRW; ld = 1792; colt = (pn - 6) * 256; }
        else { base = GT; ld = 2048; colt = (pn - 13) * 256; mode = 2; }
        const int row0 = u.pm * BM + wr * 64 + fr, col0 = colt + wc * 32 + 8 * fq;
        const float sc = (mode == 1) ? qscale : 1.0f;
#pragma unroll
        for (int ai = 0; ai < 2; ++ai)
#pragma unroll
            for (int m = 0; m < 4; ++m) { bf16_t* rowp = base + (size_t)(row0 + ai * HALF + m * 16) * ld + col0;
#pragma unroll
                for (int bj = 0; bj < 2; ++bj) { f32x4 v0 = acc[ai][bj][m][0] * sc, v1 = acc[ai][bj][m][1] * sc;
                    if (mode == 2) {
#pragma unroll
                        for (int e = 0; e < 4; ++e) { v0[e] = fsigmoid(v0[e]); v1[e] = fsigmoid(v1[e]); } }
                    u32x4 w; w.x = cvt_pk_bf16(v0[0], v0[1]); w.y = cvt_pk_bf16(v0[2], v0[3]); w.z = cvt_pk_bf16(v1[0], v1[1]); w.w = cvt_pk_bf16(v1[2], v1[3]);
                    *(u32x4*)(rowp + bj * HALF) = w; } }
    }
};
template <int MODE> struct EpiGate {
    static constexpr bool PERM = true;
    bf16_t* O; int ldo; const bf16_t* G; int ldg; int gcol0;
    __device__ __forceinline__ void operator()(const f32x4 (&acc)[2][2][4][2], const Unit& u, int wr, int wc, int fr, int fq) const {
        const int row0 = u.pm * BM + wr * 64 + fr, col0 = u.pn * BM + wc * 32 + 8 * fq;
#pragma unroll
        for (int ai = 0; ai < 2; ++ai)
#pragma unroll
            for (int m = 0; m < 4; ++m) { const size_t row = (size_t)(row0 + ai * HALF + m * 16); bf16_t* rowp = O + row * ldo + col0;
#pragma unroll
                for (int bj = 0; bj < 2; ++bj) { f32x4 v0 = acc[ai][bj][m][0], v1 = acc[ai][bj][m][1];
                    if (MODE >= 1) { const u32x4 gw = *(const u32x4*)(G + row * ldg + gcol0 + col0 + bj * HALF);
                        v0[0] *= bf_lo(gw.x); v0[1] *= bf_hi(gw.x); v0[2] *= bf_lo(gw.y); v0[3] *= bf_hi(gw.y); v1[0] *= bf_lo(gw.z); v1[1] *= bf_hi(gw.z); v1[2] *= bf_lo(gw.w); v1[3] *= bf_hi(gw.w); }
                    if (MODE == 2) { const u32x4 ow = *(const u32x4*)(rowp + bj * HALF);
                        v0[0] += bf_lo(ow.x); v0[1] += bf_hi(ow.x); v0[2] += bf_lo(ow.y); v0[3] += bf_hi(ow.y); v1[0] += bf_lo(ow.z); v1[1] += bf_hi(ow.z); v1[2] += bf_lo(ow.w); v1[3] += bf_hi(ow.w); }
                    u32x4 w; w.x = cvt_pk_bf16(v0[0], v0[1]); w.y = cvt_pk_bf16(v0[2], v0[3]); w.z = cvt_pk_bf16(v1[0], v1[1]); w.w = cvt_pk_bf16(v1[2], v1[3]);
                    *(u32x4*)(rowp + bj * HALF) = w; } }
    }
};
struct EpiRes {
    static constexpr bool PERM = true;
    const float* X; bf16_t* O; const float* gate; int seq; int gstride;
    __device__ __forceinline__ void operator()(const f32x4 (&acc)[2][2][4][2], const Unit& u, int wr, int wc, int fr, int fq) const {
        const int row0 = u.pm * BM + wr * 64 + fr, col0 = u.pn * BM + wc * 32 + 8 * fq;
        const float* gp = gate + (size_t)((u.pm * BM) / seq) * gstride + col0;
        f32x4 gv[2][2];
#pragma unroll
        for (int bj = 0; bj < 2; ++bj)
#pragma unroll
            for (int n = 0; n < 2; ++n) gv[bj][n] = *(const f32x4*)(gp + bj * HALF + n * 4);
#pragma unroll
        for (int ai = 0; ai < 2; ++ai)
#pragma unroll
            for (int m = 0; m < 4; ++m) { const size_t off = (size_t)(row0 + ai * HALF + m * 16) * 1024 + col0;
#pragma unroll
                for (int bj = 0; bj < 2; ++bj) { const f32x4 x0 = *(const f32x4*)(X + off + bj * HALF), x1 = *(const f32x4*)(X + off + bj * HALF + 4);
                    const f32x4 v0 = x0 + gv[bj][0] * acc[ai][bj][m][0], v1 = x1 + gv[bj][1] * acc[ai][bj][m][1];
                    u32x4 w; w.x = cvt_pk_bf16(v0[0], v0[1]); w.y = cvt_pk_bf16(v0[2], v0[3]); w.z = cvt_pk_bf16(v1[0], v1[1]); w.w = cvt_pk_bf16(v1[2], v1[3]);
                    *(u32x4*)(O + off + bj * HALF) = w; } }
    }
};
struct EpiSwiGLU {
    static constexpr bool PERM = true;
    bf16_t* H;
    __device__ __forceinline__ void operator()(const f32x4 (&acc)[2][2][4][2], const Unit& u, int wr, int wc, int fr, int fq) const {
        const int row0 = u.pm * BM + wr * 64 + fr, col0 = u.pn * HALF + wc * 32 + 8 * fq;
#pragma unroll
        for (int ai = 0; ai < 2; ++ai)
#pragma unroll
            for (int m = 0; m < 4; ++m) { bf16_t* rowp = H + (size_t)(row0 + ai * HALF + m * 16) * 512 + col0;
                f32x4 v0, v1;
#pragma unroll
                for (int e = 0; e < 4; ++e) { const float a0 = acc[ai][0][m][0][e], a1 = acc[ai][0][m][1][e];
                    v0[e] = a0 * fsigmoid(a0) * acc[ai][1][m][0][e]; v1[e] = a1 * fsigmoid(a1) * acc[ai][1][m][1][e]; }
                u32x4 w; w.x = cvt_pk_bf16(v0[0], v0[1]); w.y = cvt_pk_bf16(v0[2], v0[3]); w.z = cvt_pk_bf16(v1[0], v1[1]); w.w = cvt_pk_bf16(v1[2], v1[3]);
                *(u32x4*)rowp = w; }
    }
};
struct EpiFp8 {
    static constexpr bool PERM = true;
    unsigned char* O; int ldo;
    __device__ __forceinline__ void operator()(const f32x4 (&acc)[2][2][4][2], const Unit& u, int wr, int wc, int fr, int fq) const {
        const int row0 = u.pm * BM + wr * 64 + fr, col0 = u.pn * BM + wc * 32 + 8 * fq;
#pragma unroll
        for (int ai = 0; ai < 2; ++ai)
#pragma unroll
            for (int m = 0; m < 4; ++m) { unsigned char* rowp = O + (size_t)(row0 + ai * HALF + m * 16) * ldo + col0;
#pragma unroll
                for (int bj = 0; bj < 2; ++bj) { const f32x4 v0 = acc[ai][bj][m][0], v1 = acc[ai][bj][m][1];
                    int lo = __builtin_amdgcn_cvt_pk_fp8_f32(v0[0], v0[1], 0, false); lo = __builtin_amdgcn_cvt_pk_fp8_f32(v0[2], v0[3], lo, true);
                    int hi = __builtin_amdgcn_cvt_pk_fp8_f32(v1[0], v1[1], 0, false); hi = __builtin_amdgcn_cvt_pk_fp8_f32(v1[2], v1[3], hi, true);
                    *(u32x2*)(rowp + bj * HALF) = (u32x2){(unsigned)lo, (unsigned)hi}; } }
    }
};
struct MoeOrder {
    int nunits, G, c, cshift; const PG8_LAS int* tile_e;
    __device__ __forceinline__ bool next(int i, Unit& u) const {
        const int L = i * G + c; if (L >= nunits) return false;
        u.pm = L >> cshift; u.pn = L & ((1 << cshift) - 1); u.e = tile_e[u.pm]; return true;
    }
};
}
#include <hip/hip_bf16.h>
#include <cmath>
namespace attn_body {
using bf16=__hip_bfloat16;
using bf16x8=__attribute__((ext_vector_type(8)))short;
using s16x4=__attribute__((ext_vector_type(4)))short;
using f32x16=__attribute__((ext_vector_type(16)))float;
using u32x4=__attribute__((ext_vector_type(4)))unsigned;
constexpr int BATCH=2,NHEAD=8,SEQ=16384,D=64,DM=NHEAD*D;
constexpr int NW=8,QBLK=32,QB=QBLK*NW,KVBLK=64,NQB=SEQ/QB;
constexpr int ATTN_PITCH=DM, ATTN_UNIT_ROWS=QB;
__device__ __forceinline__ int crow(int r,int hi){return (r&3)+8*(r>>2)+4*hi;}
#define SBAR() __builtin_amdgcn_sched_barrier(0)
__device__ __forceinline__ void cmask(f32x16&p0,f32x16&p1,int jb,int qrel,int hi){
  const float NEG=-INFINITY; int x=qrel-64*jb-4*hi; asm volatile("":"+v"(x));
  #pragma unroll
  for(int r=0;r<16;++r){const int c=(r&3)+8*(r>>2); if(c>x)p0[r]=NEG; if(c+32>x)p1[r]=NEG;}
}

constexpr int NSLOT=3, SLOTB=8192;
constexpr int LDS_K=0, LDS_V=NSLOT*SLOTB, LDS_WS=2*NSLOT*SLOTB, LDS_OST=LDS_WS+NW*64*4, LDS_BYTES=LDS_OST+NW*4096;
constexpr float C2=0.125f*1.4426950408889634f;
__device__ __forceinline__ void glds16(const void*gsrc,unsigned lds_dst){unsigned keep;
  asm volatile("s_mov_b32 %0, m0\n\ts_mov_b32 m0, %2\n\ts_nop 0\n\tglobal_load_lds_dwordx4 %1, off\n\ts_mov_b32 m0, %0":"=&s"(keep):"v"(gsrc),"s"(lds_dst):"memory");}
__device__ __forceinline__ float max3f(float a,float b,float c){float r;asm("v_max3_f32 %0, %1, %2, %3":"=v"(r):"v"(a),"v"(b),"v"(c));return r;}
__device__ __forceinline__ float max2f(float a,float b){float r;asm("v_max_f32_e32 %0, %1, %2":"=v"(r):"v"(a),"v"(b));return r;}
__device__ __forceinline__ float fadd_s(float a,float b){float r;asm("v_add_f32_e32 %0, %1, %2":"=v"(r):"v"(a),"v"(b));return r;}
__device__ __forceinline__ float fsub_s(float a,float b){float r;asm("v_sub_f32_e32 %0, %1, %2":"=v"(r):"v"(a),"v"(b));return r;}
typedef float f32x2_t __attribute__((ext_vector_type(2))); typedef __bf16 bf16x2_t __attribute__((ext_vector_type(2)));
__device__ __forceinline__ unsigned cvtpk_s(float lo,float hi){f32x2_t v={lo,hi};bf16x2_t b=__builtin_convertvector(v,bf16x2_t);return __builtin_bit_cast(unsigned,b);}
#define WAIT_BAR(N) asm volatile("s_waitcnt vmcnt(" #N ") lgkmcnt(0)\n\ts_barrier":::"memory")

__device__ __forceinline__ void qkt(f32x16&p0,f32x16&p1,const char*Kslot,const bf16x8*qr,int r32,int hi){
  const char*kb=Kslot+hi*1024+r32*16;
  #pragma unroll
  for(int d0=0;d0<4;++d0){
    const bf16x8 b0=*reinterpret_cast<const bf16x8*>(kb+d0*2048);
    const bf16x8 b1=*reinterpret_cast<const bf16x8*>(kb+d0*2048+512);
    if(d0==0){p0=__builtin_amdgcn_mfma_f32_32x32x16_bf16(b0,qr[0],p0,0,0,0);p1=__builtin_amdgcn_mfma_f32_32x32x16_bf16(b1,qr[0],p1,0,0,0);}
    else{p0=__builtin_amdgcn_mfma_f32_32x32x16_bf16(b0,qr[d0],p0,0,0,0);p1=__builtin_amdgcn_mfma_f32_32x32x16_bf16(b1,qr[d0],p1,0,0,0);}}
}
typedef __attribute__((address_space(3))) const char* lds_cptr;
typedef short v4i16_t __attribute__((ext_vector_type(4)));
__device__ __forceinline__ void kload8(bf16x8*kf,lds_cptr kp){
  kf[0]=*(const __attribute__((address_space(3))) bf16x8*)(kp);      kf[1]=*(const __attribute__((address_space(3))) bf16x8*)(kp+512);
  kf[2]=*(const __attribute__((address_space(3))) bf16x8*)(kp+2048); kf[3]=*(const __attribute__((address_space(3))) bf16x8*)(kp+2560);
  kf[4]=*(const __attribute__((address_space(3))) bf16x8*)(kp+4096); kf[5]=*(const __attribute__((address_space(3))) bf16x8*)(kp+4608);
  kf[6]=*(const __attribute__((address_space(3))) bf16x8*)(kp+6144); kf[7]=*(const __attribute__((address_space(3))) bf16x8*)(kp+6656);
}
__device__ __forceinline__ void kload2(bf16x8*kf,lds_cptr kp,int j){ kf[2*j]=*(const __attribute__((address_space(3))) bf16x8*)(kp+j*2048); kf[2*j+1]=*(const __attribute__((address_space(3))) bf16x8*)(kp+j*2048+512); }
__device__ __forceinline__ s16x4 vtr(lds_cptr p){ return __builtin_bit_cast(s16x4,__builtin_amdgcn_ds_read_tr16_b64_v4i16((__attribute__((address_space(3))) v4i16_t*)p)); }
__device__ __forceinline__ float rowmax(const f32x16&p0,const f32x16&p1){
  float a=max3f(p0[0],p0[1],p1[0]),b=max3f(p0[2],p0[3],p1[1]);a=max3f(a,p1[2],p1[3]);
  #pragma unroll
  for(int r=4;r<16;r+=4){a=max3f(a,p0[r],p0[r+1]);b=max3f(b,p0[r+2],p0[r+3]);a=max3f(a,p1[r],p1[r+1]);b=max3f(b,p1[r+2],p1[r+3]);}
  const float m=max2f(a,b);
  auto rr=__builtin_amdgcn_permlane32_swap(__float_as_uint(m),__float_as_uint(m),false,false);
  return max2f(__uint_as_float(rr[0]),__uint_as_float(rr[1]));
}
__device__ __forceinline__ void pv(f32x16*o,int vb,bf16x8 pa0,bf16x8 pa1,bf16x8 pa2,bf16x8 pa3){
  #pragma unroll
  for(int d0=0;d0<2;++d0){s16x4 lo[4],hi[4];
    #pragma unroll
    for(int ks=0;ks<4;++ks){
      asm volatile("ds_read_b64_tr_b16 %0,%1 offset:%c2":"=&v"(lo[ks]):"v"(vb),"i"(d0*4096+ks*1024):"memory");
      asm volatile("ds_read_b64_tr_b16 %0,%1 offset:%c2":"=&v"(hi[ks]):"v"(vb),"i"(d0*4096+ks*1024+512):"memory");}
    asm volatile("s_waitcnt lgkmcnt(0)":::"memory");SBAR();
    #define PK(k) (bf16x8){lo[k][0],lo[k][1],lo[k][2],lo[k][3],hi[k][0],hi[k][1],hi[k][2],hi[k][3]}
    o[d0]=__builtin_amdgcn_mfma_f32_32x32x16_bf16(pa0,PK(0),o[d0],0,0,0);
    o[d0]=__builtin_amdgcn_mfma_f32_32x32x16_bf16(pa1,PK(1),o[d0],0,0,0);
    o[d0]=__builtin_amdgcn_mfma_f32_32x32x16_bf16(pa2,PK(2),o[d0],0,0,0);
    o[d0]=__builtin_amdgcn_mfma_f32_32x32x16_bf16(pa3,PK(3),o[d0],0,0,0);
    #undef PK
  }
}

#ifndef ATTN_STORE16
#define ATTN_STORE16(p,v) (*(u32x4*)(p)=(v))
#endif
typedef float f32x4_t __attribute__((ext_vector_type(4)));
#define NBLD(dst,off) dst=*(const __attribute__((address_space(3))) f32x4_t*)(tbn_+(off))
#define NBSUB(P,b,src) do{ P[(b)]=nmn_-src[0]; P[(b)+1]=nmn_-src[1]; P[(b)+2]=nmn_-src[2]; P[(b)+3]=nmn_-src[3]; }while(0)
#define NEXTB(P0,P1,tt) do{ const __attribute__((address_space(3))) float* tb_=tab3+(tt)*64+4*hi; const float nm_=-mhat; \
  _Pragma("unroll") for(int g_=0;g_<4;++g_){ const f32x4_t b0_=*(const __attribute__((address_space(3))) f32x4_t*)(tb_+8*g_); const f32x4_t b1_=*(const __attribute__((address_space(3))) f32x4_t*)(tb_+32+8*g_); \
    _Pragma("unroll") for(int j_=0;j_<4;++j_){ P0[4*g_+j_]=nm_-b0_[j_]; P1[4*g_+j_]=nm_-b1_[j_]; } } }while(0)
template<int THRL> __device__ __forceinline__ void attn_unit(int b,int h,int qb,int t0,const bf16*Q,const bf16*__restrict__ K,const bf16*__restrict__ V,bf16*O,const float*__restrict__ cumT,char*shm,int tab_off,int segp_off,unsigned*qctr){
  const int tid=threadIdx.x,lane=tid&63,r32=lane&31,hi=lane>>5; const int wid=__builtin_amdgcn_readfirstlane(tid>>6);
  const long rowbase=(long)b*SEQ; const int q0=qb*QB;
  const bf16*Qw=Q+(rowbase+q0+wid*QBLK)*DM+h*D;
  const bf16*Kh=K+(rowbase+(long)t0*KVBLK)*DM+h*D,*Vh=V+(rowbase+(long)t0*KVBLK)*DM+h*D;
  const unsigned lds0=(unsigned)(uintptr_t)shm;
  float*wsf=(float*)(shm+LDS_WS)+wid*64;
  const bf16*ksrc=Kh+(long)lane*DM+wid*8;
  const bf16*vsrc=Vh+(long)(16*(wid&3)+(lane>>2))*DM+(wid>>2)*32+(lane&3)*8;
  const unsigned kdst=lds0+LDS_K+wid*1024, vdst=lds0+LDS_V+wid*1024;
  #define DMA_K(t,slot) glds16(ksrc+(long)(t)*KVBLK*DM,(unsigned)__builtin_amdgcn_readfirstlane(kdst+(slot)))
  #define DMA_V(t,slot) glds16(vsrc+(long)(t)*KVBLK*DM,(unsigned)__builtin_amdgcn_readfirstlane(vdst+(slot)))
  const int vb0=(int)(lds0+LDS_V)+((lane>>4)&1)*32+(lane&3)*8+(4*hi+((lane&15)>>2))*64;
  const char*Kbase=shm+LDS_K; bf16x8 kf[8];
  const lds_cptr shm3=(lds_cptr)shm; const lds_cptr kp0=shm3+LDS_K+hi*1024+r32*16; const lds_cptr vp0=shm3+LDS_V+((lane>>4)&1)*32+(lane&3)*8+(4*hi+((lane&15)>>2))*64;
  const int NT=(q0+QB)/KVBLK-t0;
  const __attribute__((address_space(3))) float* tab3=(const __attribute__((address_space(3))) float*)(shm3+tab_off);
  { int tl_=threadIdx.x; asm volatile("":"+v"(tl_));
    float*tabw=(float*)(shm+tab_off); const float L2E=1.4426950408889634f;
    const float*cg=cumT+((long)(b*NHEAD+h))*SEQ; const float cref=cg[q0]*L2E;
    for(int i=tl_;i<NT*KVBLK;i+=NW*64){ const int kv=t0*KVBLK+i; tabw[i]=cg[kv]*L2E-cref; }
    asm volatile("s_waitcnt vmcnt(0) lgkmcnt(0)\n\ts_barrier":::"memory"); }
  DMA_K(0,0);DMA_V(0,0);DMA_K(1,SLOTB);
  bf16x8 qr[4];
  #pragma unroll
  for(int d0=0;d0<4;++d0)qr[d0]=*reinterpret_cast<const bf16x8*>(&Qw[(long)r32*DM+d0*16+hi*8]);
  float mhat=0.f,l_reg=0.f;f32x16 o[2];o[0]=f32x16{};o[1]=f32x16{};
  const int qrel=wid*QBLK+r32;
  #define CMASK(P0,P1,t) do{int jb_=(t)-(NT-4); if(jb_>=0)cmask(P0,P1,jb_,qrel,hi);}while(0)
  bool resc=false;
  #define START(P0,P1) do{ const float rm=rowmax(P0,P1); resc=false; \
    { const float dl=rm; mhat=fadd_s(mhat,dl); \
      _Pragma("unroll") for(int r=0;r<16;++r){P0[r]=fsub_s(P0[r],dl);P1[r]=fsub_s(P1[r],dl);} \
      } \
    _Pragma("unroll") for(int r=0;r<16;++r)P0[r]=__builtin_amdgcn_exp2f(P0[r]); }while(0)
  #define RESC() do{ if(resc){ asm volatile("s_waitcnt lgkmcnt(0)":::"memory"); \
      _Pragma("unroll") for(int d_=0;d_<2;++d_) _Pragma("unroll") for(int r=0;r<16;++r)o[d_][r]*=wsf[crow(r,hi)]; } }while(0)
  f32x16 pA0,pA1,pB0,pB1;
  int sl_prev=0,sl_cur=0,sl_next=SLOTB;
  #define ROT() do{sl_prev=sl_cur;sl_cur=sl_next;sl_next=(sl_next==(NSLOT-1)*SLOTB)?0:sl_next+SLOTB;}while(0)
  DMA_K(2,2*SLOTB);
  WAIT_BAR(3);
  NEXTB(pA0,pA1,0);
  qkt(pA0,pA1,Kbase,qr,r32,hi);asm volatile("s_nop 15\n\ts_nop 7":"+v"(pA0),"+v"(pA1));CMASK(pA0,pA1,0);
  START(pA0,pA1);
  NEXTB(pB0,pB1,1);
  _Pragma("unroll") for(int r=0;r<16;++r)pA1[r]=__builtin_amdgcn_exp2f(pA1[r]);
  WAIT_BAR(0);
  DMA_K(3,0);DMA_V(1,SLOTB);
  ROT();
  kload8(kf,kp0+sl_cur);
  WAIT_BAR(2);
  s16x4 vlo[8],vhi[8]; u32x4 pw0,pw1,pw2,pw3;
  #define PKW(P,B) cvtpk_s(P[B],P[B+1])
  #define PAF(k) __builtin_bit_cast(bf16x8,pw##k)
  #define VFR(i) (bf16x8){vlo[i][0],vlo[i][1],vlo[i][2],vlo[i][3],vhi[i][0],vhi[i][1],vhi[i][2],vhi[i][3]}
  #define PIN(x) asm volatile("":"+v"(x))
  #define MX3(a,b,c) __builtin_fmaxf(__builtin_fmaxf((a),(b)),(c))
  #define GAPA(MF,A0,A1,A2,A3,W0,W1,PW) do{ MF; sacc+=A0; sacc+=A1; sacc+=A2; sacc+=A3; PIN(sacc); W0; W1; PIN(PW); SBAR(); }while(0)
  #define EX(v) __builtin_amdgcn_exp2f(v)
  #define GAPB(MF,X,B) do{ MF; X[B]=EX(X[B]); X[B+1]=EX(X[B+1]); X[B+2]=EX(X[B+2]); X[B+3]=EX(X[B+3]); PIN(X); SBAR(); }while(0)
  #define VRD(i) do{ vlo[i]=vtr(vp_+(((i)>>2)*4096+((i)&3)*1024)); vhi[i]=vtr(vp_+(((i)>>2)*4096+((i)&3)*1024+512)); }while(0)
  #define KRD(G,j) do{ if(G){ kload2(kf,kp0+sl_next,j); SBAR(); } }while(0)
  #define STEP(C0,C1,P0,P1,t,GK,GV,GL) do{ SBAR(); \
    const lds_cptr vp_=vp0+sl_prev; \
    VRD(0); SBAR(); float sacc=(P0[0]+P0[1]); \
    GAPA(C0=__builtin_amdgcn_mfma_f32_32x32x16_bf16(kf[0],qr[0],C0,0,0,0), P0[2],P0[3],P0[4],P0[5],     pw0[0]=PKW(P0,0), pw0[1]=PKW(P0,2), pw0); \
    VRD(4); SBAR(); GAPA(C1=__builtin_amdgcn_mfma_f32_32x32x16_bf16(kf[1],qr[0],C1,0,0,0), P0[6],P0[7],P0[8],P0[9],     pw0[2]=PKW(P0,4), pw0[3]=PKW(P0,6), pw0); \
    VRD(1); SBAR(); GAPA(C0=__builtin_amdgcn_mfma_f32_32x32x16_bf16(kf[2],qr[1],C0,0,0,0),   P0[10],P0[11],P0[12],P0[13], pw1[0]=PKW(P0,8), pw1[1]=PKW(P0,10), pw1); \
    VRD(5); SBAR(); GAPA(C1=__builtin_amdgcn_mfma_f32_32x32x16_bf16(kf[3],qr[1],C1,0,0,0),   P0[14],P0[15],P1[0],P1[1],   pw1[2]=PKW(P0,12),pw1[3]=PKW(P0,14), pw1); \
    VRD(2); SBAR(); GAPA(C0=__builtin_amdgcn_mfma_f32_32x32x16_bf16(kf[4],qr[2],C0,0,0,0),   P1[2],P1[3],P1[4],P1[5],     pw2[0]=PKW(P1,0), pw2[1]=PKW(P1,2), pw2); \
    VRD(6); SBAR(); GAPA(C1=__builtin_amdgcn_mfma_f32_32x32x16_bf16(kf[5],qr[2],C1,0,0,0),   P1[6],P1[7],P1[8],P1[9],     pw2[2]=PKW(P1,4), pw2[3]=PKW(P1,6), pw2); \
    VRD(3); SBAR(); GAPA(C0=__builtin_amdgcn_mfma_f32_32x32x16_bf16(kf[6],qr[3],C0,0,0,0),   P1[10],P1[11],P1[12],P1[13], pw3[0]=PKW(P1,8), pw3[1]=PKW(P1,10), pw3); \
    VRD(7); SBAR(); GAPA(C1=__builtin_amdgcn_mfma_f32_32x32x16_bf16(kf[7],qr[3],C1,0,0,0),   P1[14],P1[15],0.f,0.f,       pw3[2]=PKW(P1,12),pw3[3]=PKW(P1,14), pw3); \
    l_reg+=sacc; \
    if(GK){DMA_K((t)+3,sl_cur);} if(GV){DMA_V((t)+1,sl_next);} \
    CMASK(C0,C1,t); \
    { float a=MX3(C0[0],C0[1],C1[0]),b=MX3(C0[2],C0[3],C1[1]); a=MX3(a,C1[2],C1[3]); \
      _Pragma("unroll") for(int r=4;r<16;r+=4){a=MX3(a,C0[r],C0[r+1]);b=MX3(b,C0[r+2],C0[r+3]);a=MX3(a,C1[r],C1[r+1]);b=MX3(b,C1[r+2],C1[r+3]);} \
      float rm=__builtin_fmaxf(a,b); { auto rr=__builtin_amdgcn_permlane32_swap(__float_as_uint(rm),__float_as_uint(rm),false,false); rm=__builtin_fmaxf(__uint_as_float(rr[0]),__uint_as_float(rr[1])); } \
      resc=false; \
      if(__builtin_expect(__any(rm>(float)THRL),0)){ const float dl=__builtin_fmaxf(rm,0.f); mhat+=dl; \
        _Pragma("unroll") for(int r=0;r<16;++r){C0[r]-=dl;C1[r]-=dl;} \
        const float f=__builtin_amdgcn_exp2f(-dl); l_reg*=f; if(hi==0)wsf[r32]=f; resc=true; } } \
      \
    const __attribute__((address_space(3))) float* tbn_=tab3+((t)+1)*64+4*hi; const float nmn_=-mhat; f32x4_t nbA_,nbB_; \
    SBAR(); \
    if(GL){NBLD(nbA_,0);} GAPB(o[0]=__builtin_amdgcn_mfma_f32_32x32x16_bf16(PAF(0),VFR(0),o[0],0,0,0), C0,0); \
    if(GL){NBLD(nbB_,8); NBSUB(P0,0,nbA_);} GAPB(o[1]=__builtin_amdgcn_mfma_f32_32x32x16_bf16(PAF(0),VFR(4),o[1],0,0,0), C0,4); \
    if(GL){NBLD(nbA_,16); NBSUB(P0,4,nbB_);} KRD(GL,0); GAPB(o[0]=__builtin_amdgcn_mfma_f32_32x32x16_bf16(PAF(1),VFR(1),o[0],0,0,0), C0,8); \
    if(GL){NBLD(nbB_,24); NBSUB(P0,8,nbA_);} KRD(GL,1); GAPB(o[1]=__builtin_amdgcn_mfma_f32_32x32x16_bf16(PAF(1),VFR(5),o[1],0,0,0), C0,12); \
    if(GL){NBLD(nbA_,32); NBSUB(P0,12,nbB_);} KRD(GL,2); GAPB(o[0]=__builtin_amdgcn_mfma_f32_32x32x16_bf16(PAF(2),VFR(2),o[0],0,0,0), C1,0); \
    if(GL){NBLD(nbB_,40); NBSUB(P1,0,nbA_);} KRD(GL,3); GAPB(o[1]=__builtin_amdgcn_mfma_f32_32x32x16_bf16(PAF(2),VFR(6),o[1],0,0,0), C1,4); \
    if(GL){NBLD(nbA_,48); NBSUB(P1,4,nbB_);} GAPB(o[0]=__builtin_amdgcn_mfma_f32_32x32x16_bf16(PAF(3),VFR(3),o[0],0,0,0), C1,8); \
    if(GL){NBLD(nbB_,56); NBSUB(P1,8,nbA_);} GAPB(o[1]=__builtin_amdgcn_mfma_f32_32x32x16_bf16(PAF(3),VFR(7),o[1],0,0,0), C1,12); \
    if(GL){NBSUB(P1,12,nbB_);} \
    }while(0)
  int t=1;
  #undef CMASK
  #define CMASK(P0,P1,t) do{}while(0)
  for(;t+5<NT;t+=2){
    STEP(pB0,pB1,pA0,pA1,t,true,true,true);     WAIT_BAR(2); RESC(); ROT();
    STEP(pA0,pA1,pB0,pB1,t+1,true,true,true);   WAIT_BAR(2); RESC(); ROT();
  }
  #undef CMASK
  #define CMASK(P0,P1,t) do{int jb_=(t)-(NT-4); if(jb_>=0)cmask(P0,P1,jb_,qrel,hi);}while(0)
  #define ENDW(tt) do{ if((tt)+3<NT){WAIT_BAR(2);} else if((tt)+2<NT){WAIT_BAR(1);} else {WAIT_BAR(0);} }while(0)
  for(;t+1<NT;t+=2){
    STEP(pB0,pB1,pA0,pA1,t,(t+3<NT),(t+1<NT),(t+1<NT));       ENDW(t);   RESC(); ROT();
    STEP(pA0,pA1,pB0,pB1,t+1,(t+4<NT),(t+2<NT),(t+2<NT));     ENDW(t+1); RESC(); ROT();
  }
  STEP(pB0,pB1,pA0,pA1,NT-1,false,false,false); RESC();
  { float sacc=pB0[0]+pB0[1]; _Pragma("unroll") for(int r=2;r<16;++r)sacc+=pB0[r]; _Pragma("unroll") for(int r=0;r<16;++r)sacc+=pB1[r]; l_reg+=sacc;
    pw0=(u32x4){PKW(pB0,0),PKW(pB0,2),PKW(pB0,4),PKW(pB0,6)};pw1=(u32x4){PKW(pB0,8),PKW(pB0,10),PKW(pB0,12),PKW(pB0,14)};pw2=(u32x4){PKW(pB1,0),PKW(pB1,2),PKW(pB1,4),PKW(pB1,6)};pw3=(u32x4){PKW(pB1,8),PKW(pB1,10),PKW(pB1,12),PKW(pB1,14)};
    SBAR(); pv(o,vb0+sl_cur,PAF(0),PAF(1),PAF(2),PAF(3)); }
  #undef PKW
  #undef PAF
  #undef VFR
  #undef PIN
  #undef MX3
  #undef GAPA
  #undef GAPB
  #undef EX
  #undef VRD
  #undef KRD
  #undef STEP
  #undef ENDW
  {auto rr=__builtin_amdgcn_permlane32_swap(__float_as_uint(l_reg),__float_as_uint(l_reg),false,false);l_reg=__uint_as_float(rr[0])+__uint_as_float(rr[1]);}
  int un_=0; if(threadIdx.x==0)un_=(int)__hip_atomic_fetch_add(qctr,1u,__ATOMIC_RELAXED,__HIP_MEMORY_SCOPE_AGENT);
  int lane_e=threadIdx.x&63; asm volatile("":"+v"(lane_e));
  const int r32e=lane_e&31,hie=lane_e>>5;
  if(hie==0)wsf[32+r32e]=l_reg;asm volatile("s_waitcnt lgkmcnt(0)":::"memory");
  float rli[16];
  #pragma unroll
  for(int r=0;r<16;++r)rli[r]=__builtin_amdgcn_rcpf(wsf[32+crow(r,hie)]);
  bf16*Ow=O+(rowbase+q0+wid*QBLK)*DM+h*D;
  { bf16*stg=(bf16*)(shm+LDS_OST)+wid*2048;
    #pragma unroll
    for(int r=0;r<16;++r){const int orow=crow(r,hie);
      #pragma unroll
      for(int d0=0;d0<2;++d0)stg[orow*64+d0*32+r32e]=__float2bfloat16(o[d0][r]*rli[r]);}
    asm volatile("s_waitcnt lgkmcnt(0)":::"memory");
    #pragma unroll
    for(int i=0;i<4;++i){const int row=i*8+(lane_e>>3),ch=lane_e&7; const u32x4 v=*(const u32x4*)(stg+row*64+ch*8); ATTN_STORE16(Ow+(long)row*DM+ch*8,v);} }
  if(threadIdx.x==0)*(volatile int*)(shm+segp_off)=un_;
  asm volatile("s_waitcnt lgkmcnt(0)\n\ts_barrier":::"memory");
  #undef DMA_K
  #undef DMA_V
  #undef CMASK
  #undef START
  #undef RESC
  #undef ROT
}
constexpr int ATTN_LDS_BYTES=LDS_BYTES;
struct AttnTensors { const bf16* Q; const bf16* K; const bf16* V; bf16* O; const float* cumT; const float* segtot; };
struct AttnUnit { int bh; int qb; };
struct StaticOrder {
  int vcu;
  __device__ __forceinline__ explicit StaticOrder(int grid,int block):vcu((block%8)*(grid/8)+block/8){}
  __device__ __forceinline__ bool next(int i,AttnUnit&u)const{ if(i>=4||vcu>=256)return false; const int s=vcu&15; u.bh=vcu>>4; u.qb=(i==0)?63-s:(i==1)?32+s:(i==2)?31-s:s; return true; }
  __device__ __forceinline__ void a_ready(const AttnUnit&)const{}
  __device__ __forceinline__ void done(const AttnUnit&)const{}
};
constexpr float PRUNE_THR=20.0f;
template<int THRL=8> __device__ __forceinline__ void attn_phase_dyn(char*lds,const AttnTensors&T,unsigned*ctr,const unsigned*qkmax,const unsigned*ktmax,int tab_off,int segp_off){
  volatile int*slot=(volatile int*)(lds+segp_off);
  __syncthreads();
  if(threadIdx.x==0)slot[0]=(int)__hip_atomic_fetch_add(ctr,1u,__ATOMIC_RELAXED,__HIP_MEMORY_SCOPE_AGENT);
  __syncthreads();
  for(;;){
    int tid=threadIdx.x; asm volatile("":"+v"(tid));
    const int u=slot[0]; if(u>=BATCH*NHEAD*NQB)break;
    const int bh=u&15, qb=(NQB-1)-(u>>4), b=bh/NHEAD, h=bh%NHEAD, q0=qb*QB;
    const float qm=__uint_as_float(qkmax[bh*2]), km=__uint_as_float(qkmax[bh*2+1]);
    const float L2E=1.4426950408889634f; const float*cg=T.cumT+((long)(b*NHEAD+h))*SEQ;
    const float cgk=cg[(tid<4*qb)?64*tid+63:q0], cg0=cg[q0];
    const float kt2=__uint_as_float(ktmax[bh*256+((tid<4*qb)?tid:0)]);
    float dg, qg;
    { const int row=tid>>1, hf=tid&1; const long ro=((long)b*SEQ+q0+row)*DM+h*D+32*hf; const u32x4*qp=(const u32x4*)(T.Q+ro); const u32x4*kp=(const u32x4*)(T.K+ro); float d=0.f, qq=0.f;
      #pragma unroll
      for(int c4=0;c4<4;++c4){ const u32x4 qa=qp[c4], ka=kp[c4];
        #pragma unroll
        for(int e=0;e<4;++e){ const float q0_=__uint_as_float(qa[e]<<16), q1_=__uint_as_float(qa[e]&0xffff0000u); d+=q0_*__uint_as_float(ka[e]<<16)+q1_*__uint_as_float(ka[e]&0xffff0000u); qq+=q0_*q0_+q1_*q1_; } }
      d+=__shfl_xor(d,1); qq+=__shfl_xor(qq,1);
      #pragma unroll
      for(int o=2;o<64;o<<=1){ d=fminf(d,__shfl_xor(d,o)); qq=fmaxf(qq,__shfl_xor(qq,o)); }
      dg=d; qg=qq; }
    float*slotf=(float*)(lds+segp_off)+16;
    if((tid&63)==0){ slotf[tid>>6]=dg; slotf[8+(tid>>6)]=qg; }
    __syncthreads();
    float dmin=slotf[0], qmu=slotf[8];
    #pragma unroll
    for(int w=1;w<NW;++w){ dmin=fminf(dmin,slotf[w]); qmu=fmaxf(qmu,slotf[8+w]); }
    (void)qm; (void)km;
    const float X=PRUNE_THR+sqrtf(qmu*kt2)-dmin+1.5f;
    const bool keep=(tid<4*qb)&&!((cgk-cg0)*L2E>X);
    const unsigned long long bal=__ballot(keep); if((tid&63)==0)slot[1+(tid>>6)]=bal?((tid>>6)*64+(int)__builtin_ctzll(bal)):4*qb;
    __syncthreads();
    int t0=4*qb;
    #pragma unroll
    for(int w=0;w<NW;++w){ const int f_=slot[1+w]; t0=f_<t0?f_:t0; }
    t0&=~1;
    attn_unit<THRL>(b,h,qb,t0,T.Q,T.K,T.V,T.O,T.cumT,lds,tab_off,segp_off,ctr);
  }
}
#undef SBAR
#undef WAIT_BAR
}
#define GAS __attribute__((address_space(1)))
#define LAS __attribute__((address_space(3)))
typedef unsigned short bf16;
typedef unsigned v4u __attribute__((ext_vector_type(4)));
typedef float f32x4 __attribute__((ext_vector_type(4)));
typedef short bf16x8 __attribute__((ext_vector_type(8)));
typedef GAS unsigned gu32;
typedef GAS unsigned long long gu64;
#define RLX_AGENT __ATOMIC_RELAXED, __HIP_MEMORY_SCOPE_AGENT
#define LDS_WAIT() asm volatile("s_waitcnt lgkmcnt(0)" ::: "memory")
#define VM_WAIT() asm volatile("s_waitcnt vmcnt(0)" ::: "memory")
__device__ __forceinline__ unsigned long long rt() { return __builtin_amdgcn_s_memrealtime(); }
typedef float pk_f32x2 __attribute__((ext_vector_type(2))); typedef __bf16 pk_bf16x2 __attribute__((ext_vector_type(2)));
__device__ __forceinline__ unsigned pk2(float lo, float hi) { pk_f32x2 v = {lo, hi}; pk_bf16x2 b = __builtin_convertvector(v, pk_bf16x2); return __builtin_bit_cast(unsigned, b); }
__device__ __forceinline__ unsigned f2bf(float f) { return pk2(f, 0.f) & 0xffffu; }

#define XB_TMO      128
#define XB_XCNT(j)  (256  + 64 * (j))
#define XB_XSUB(j)  (1280 + 64 * (j))
#define XB_XGEN(j)  (2304 + 64 * (j))
#define XB_TOP      3328
#define XB_TOPGEN   3392
#define XCD_BAR_WORDS 3456
#define XB_SPIN_CAP (1u << 18)

__device__ __forceinline__ unsigned xb_ld(unsigned* p)              { return __hip_atomic_load(p, __ATOMIC_RELAXED, __HIP_MEMORY_SCOPE_AGENT); }
__device__ __forceinline__ unsigned xb_add(unsigned* p, unsigned v) { return __hip_atomic_fetch_add(p, v, __ATOMIC_RELAXED, __HIP_MEMORY_SCOPE_AGENT); }
__device__ __forceinline__ unsigned xb_xcc_id() { return (unsigned)__builtin_amdgcn_s_getreg((3 << 11) | 20) & 0xFu; }
#define XB_SPIN(cond, bar) do { unsigned _sp = 0; while (cond) { __builtin_amdgcn_s_sleep(1); \
    if ((++_sp & 255u) == 0u) { if (xb_ld(&(bar)[XB_TMO])) break; if (_sp > XB_SPIN_CAP) { atomicAdd(&(bar)[XB_TMO], 1u); break; } } } } while (0)

struct XcdBarrier {
    unsigned* bar; unsigned x;
    volatile LAS unsigned* st;
};

__device__ __forceinline__ XcdBarrier xcd_barrier_post(unsigned* bar, volatile LAS unsigned* st) {
    XcdBarrier b; b.bar = bar; b.x = xb_xcc_id(); b.st = st;
    if (threadIdx.x == 0) (void)xb_add(&bar[XB_XCNT(b.x)], 1u);
    return b;
}
__device__ __forceinline__ void xcd_barrier_complete(unsigned* bar, unsigned x, unsigned& nloc, unsigned& nx) {
    const unsigned G = gridDim.x * gridDim.y * gridDim.z;
    unsigned sum, cnt, mine, sp = 0u;
    for (;;) {
        sum = 0u; cnt = 0u; mine = 0u;
#pragma unroll
        for (unsigned j = 0; j < 16; ++j) { const unsigned c = xb_ld(&bar[XB_XCNT(j)]); sum += c; cnt += (c > 0u) ? 1u : 0u; mine = (j == x) ? c : mine; }
        if (sum == G) break;
        __builtin_amdgcn_s_sleep(1);
        if ((++sp & 255u) == 0u) { if (xb_ld(&bar[XB_TMO])) break; if (sp > XB_SPIN_CAP) { atomicAdd(&bar[XB_TMO], 1u); break; } }
    }
    nloc = mine > 0u ? mine : 1u; nx = cnt > 0u ? cnt : 1u;
}

__device__ __forceinline__ void xcd_barrier(const XcdBarrier& b) {
    asm volatile("s_waitcnt vmcnt(0)" ::: "memory");
    __syncthreads();
    if (threadIdx.x == 0) {
        unsigned* bar = b.bar;
        __builtin_amdgcn_s_waitcnt(0);
        unsigned nloc = b.st[0], nx = b.st[1];
        if (nloc == 0u) { xcd_barrier_complete(bar, b.x, nloc, nx); b.st[0] = nloc; b.st[1] = nx; }
        const unsigned old = xb_add(&bar[XB_XSUB(b.x)], 1u);
        const unsigned gen = old / nloc;
        if (old + 1u == (gen + 1u) * nloc) {
            __builtin_amdgcn_fence(__ATOMIC_RELEASE, "agent");
            asm volatile("s_waitcnt vmcnt(0)" ::: "memory");
            const unsigned og = xb_add(&bar[XB_TOP], 1u);
            const unsigned tg = og / nx;
            if (og + 1u == (tg + 1u) * nx) xb_add(&bar[XB_TOPGEN], 1u);
            else XB_SPIN(xb_ld(&bar[XB_TOPGEN]) == tg, bar);
            __builtin_amdgcn_fence(__ATOMIC_ACQUIRE, "agent");
            xb_add(&bar[XB_XGEN(b.x)], 1u);
            asm volatile("s_waitcnt vmcnt(0)" ::: "memory");
        } else {
            XB_SPIN(xb_ld(&bar[XB_XGEN(b.x)]) == gen, bar);
            __builtin_amdgcn_fence(__ATOMIC_ACQUIRE, "agent");
            asm volatile("s_waitcnt vmcnt(0)" ::: "memory");
        }
    }
    __syncthreads();
}

constexpr int NWAVES = 8;
constexpr int BATCH = 2, SEQ = 16384, D = 1024, M = BATCH * SEQ;
constexpr int FH = 8, FW = 512, RWW = 512, SHW = 1792, DIN = 5384, NIN = 5376;
constexpr int NE = 32, DE = 512, NROUTE = 36;
constexpr int MAXSLOT = 2 * M + NE * 256;
constexpr int MAXTILE = MAXSLOT / 256;
constexpr float ATT_C2 = 0.125f * 1.4426950408889634f;

constexpr size_t MiB = 1u << 20;
constexpr size_t WS_CTL = 0, CTL_ZERO_BYTES = 1 * MiB;
constexpr size_t WS_MOD = 1 * MiB;
constexpr size_t WS_SEGTOT = 1 * MiB + 64 * 1024;
constexpr size_t WS_BLKCNT = 1 * MiB + 96 * 1024;
constexpr size_t WS_WIN = 2 * MiB;
constexpr size_t WS_WOF = 13 * MiB, WS_WOR = 14 * MiB, WS_WO = 15 * MiB;
constexpr size_t WS_LW2 = 17 * MiB, WS_LA2 = 17 * MiB + 64 * 1024, WS_LG2 = 17 * MiB + 128 * 1024;
constexpr size_t WS_CUM = 18 * MiB;
constexpr size_t WS_ROUTE = 19 * MiB;
constexpr size_t WS_ROWTOK = 20 * MiB;
constexpr size_t WS_BON = 21 * MiB;
constexpr size_t WS_XN = 24 * MiB;
constexpr size_t WS_Q = 88 * MiB, WS_K = 120 * MiB, WS_V = 152 * MiB;
constexpr size_t WS_PRW = 184 * MiB;
constexpr size_t WS_GATES = 296 * MiB;
constexpr size_t WS_F = 424 * MiB;
constexpr size_t WS_END = 512 * MiB;
constexpr size_t WS_Y = WS_K;
constexpr size_t WS_H = WS_Q;
constexpr size_t WS_W13 = WS_PRW, WS_W2T = WS_PRW + 64 * MiB;
constexpr size_t WS_TMP = WS_PRW;
constexpr size_t WS_YM = 280 * MiB;
constexpr size_t WS_X1 = 424 * MiB;
static_assert(WS_YM + (size_t)MAXSLOT * 1024 * 2 <= WS_END, "ws map");
static_assert(WS_H + (size_t)MAXSLOT * 512 * 2 <= WS_PRW, "ws map");
constexpr int CW_TMO = 0, CW_CODE = 1;
constexpr int CW_BAR = 4096;
constexpr int CW_QKMAX = 8192;
constexpr int CW_QUEUE = 8448;
constexpr int CW_KTMAX = 12288;
constexpr int CW_DIAG = 8704;

constexpr int RING_OFF = 0, RING_BYTES = 131072;
constexpr int TAB_OFF = 83968;
constexpr int SEGP_OFF = TAB_OFF + 65536;
constexpr int TILE_OFF = 131072;
constexpr int LDSCTL_OFF = SEGP_OFF + 512, MISC_OFF = LDSCTL_OFF + 320;
constexpr int LDS_BYTES = LDSCTL_OFF + 512;
static_assert(attn_body::LDS_BYTES <= TAB_OFF, "attention LDS");


#define PHASE_IDS() int tid_ = threadIdx.x; asm volatile("" : "+v"(tid_)); const int lane_ = tid_ & 63; const int wave_ = __builtin_amdgcn_readfirstlane(tid_ >> 6); (void)lane_; (void)wave_
struct Frame {
    LAS unsigned char* lds;
    volatile LAS unsigned* MISC;
    gu32* ctl;
    int tid, lane, wave;
    int vcu, G;
    const float* const* in;
};
template <int CTRL> __device__ __forceinline__ float dpp_f(float v) { return __int_as_float(__builtin_amdgcn_mov_dpp(__float_as_int(v), CTRL, 0xf, 0xf, true)); }
__device__ __forceinline__ float row_sum16(float v) { v += dpp_f<0xB1>(v); v += dpp_f<0x4E>(v); v += dpp_f<0x141>(v); v += dpp_f<0x140>(v); return v; }
__device__ __forceinline__ float wave_sum(float v) { v = row_sum16(v); v += __shfl_xor(v, 16); v += __shfl_xor(v, 32); return v; }
__device__ __forceinline__ float bflo(unsigned w) { return __uint_as_float(w << 16); }
__device__ __forceinline__ float bfhi(unsigned w) { return __uint_as_float(w & 0xffff0000u); }
__device__ __forceinline__ float sigm(float x) { return 1.0f / (1.0f + __expf(-x)); }

__device__ __forceinline__ void transpose_item(const float* W, int ld, int col, int k0, int K, bf16* WT, size_t drow, LAS float* scr, int lane) {
#pragma unroll 8
    for (int i = 0; i < 32; ++i) { const int kk = 2 * i + (lane >> 5); scr[kk * 33 + (lane & 31)] = W[(size_t)(k0 + kk) * ld + col + (lane & 31)]; }
    LDS_WAIT(); asm volatile("" ::: "memory");
    const int c = lane & 7;
#pragma unroll
    for (int j = 0; j < 4; ++j) { const int n = (lane >> 3) + 8 * j; const LAS float* s = scr + (8 * c) * 33 + n;
        v4u o; o.x = pk2(s[0 * 33], s[1 * 33]); o.y = pk2(s[2 * 33], s[3 * 33]); o.z = pk2(s[4 * 33], s[5 * 33]); o.w = pk2(s[6 * 33], s[7 * 33]);
        *(GAS v4u*)(WT + (drow + n) * K + k0 + 8 * c) = o; }
    LDS_WAIT(); asm volatile("" ::: "memory");
}
__device__ __forceinline__ void conv_seg(Frame& F, const float* W, int ld, int col0, int K, int ncols, bf16* WT, size_t drow0) {
    PHASE_IDS();
    LAS float* scr = (LAS float*)(F.lds + RING_OFF + wave_ * 16384);
    const int gw = F.vcu * NWAVES + wave_, NGW = F.G * NWAVES, nkb = K / 64, nnb = ncols / 32;
    for (int it = gw; it < nkb * nnb; it += NGW) { const int kb = it / nnb, nb = it % nnb; transpose_item(W, ld, col0 + 32 * nb, 64 * kb, K, WT, drow0 + 32 * nb, scr, lane_); }
}

struct Args { const float* in[30]; float* out; unsigned char* ws; };

__device__ __forceinline__ void p0_prologue(Frame& F, const Args& A) {
    PHASE_IDS();
    unsigned char* ws = A.ws;
    if (blockIdx.x < 96) {
        const float* c = A.in[1]; const float* aw = A.in[2]; const float* ab = A.in[3];
        const int col = blockIdx.x * 64 + lane_; float a0 = 0.f, a1 = 0.f;
        const int kbeg = wave_ * 128;
#pragma unroll 8
        for (int k = kbeg; k < kbeg + 128; ++k) { const float wv = aw[(size_t)k * 6144 + col]; const float c0 = c[k], c1 = c[1024 + k];
            a0 += c0 * sigm(c0) * wv; a1 += c1 * sigm(c1) * wv; }
        LAS float* red = (LAS float*)(F.lds + 8 * 16384 - 4096);
        red[(wave_ * 2 + 0) * 64 + lane_] = a0; red[(wave_ * 2 + 1) * 64 + lane_] = a1;
        __syncthreads();
        if (wave_ < 2) { float s = 0.f;
#pragma unroll
            for (int w = 0; w < 8; ++w) s += red[(w * 2 + wave_) * 64 + lane_];
            ((float*)(ws + WS_MOD))[wave_ * 6144 + col] = s + ab[col]; }
        __syncthreads();
    }
}

__device__ __forceinline__ void p_convert_early(Frame& F, const Args& A) {
    unsigned char* ws = A.ws;
    const float* w_in = A.in[5];
    conv_seg(F, w_in, DIN, 0, 1024, 1536, (bf16*)(ws + WS_WIN), 0);
    conv_seg(F, w_in, DIN, 1544, 1024, 1792, (bf16*)(ws + WS_WIN), 1536);
    conv_seg(F, w_in, DIN, 3336, 1024, 2048, (bf16*)(ws + WS_WIN), 3328);
    conv_seg(F, A.in[18], 1024, 0, 512, 1024, (bf16*)(ws + WS_WOF), 0);
    conv_seg(F, A.in[19], 1024, 0, 512, 1024, (bf16*)(ws + WS_WOR), 0);
    conv_seg(F, A.in[20], 1024, 0, 1024, 1024, (bf16*)(ws + WS_WO), 0);
    conv_seg(F, A.in[9], 512, 0, 64, 512, (bf16*)(ws + WS_LW2), 0);
    conv_seg(F, A.in[11], 512, 0, 64, 512, (bf16*)(ws + WS_LA2), 0);
    conv_seg(F, A.in[12], 512, 0, 128, 512, (bf16*)(ws + WS_LG2), 0);
}

__device__ __forceinline__ void p1_norm(Frame& F, const Args& A) {
    PHASE_IDS();
    unsigned char* ws = A.ws;
    LAS float* wf = (LAS float*)(F.lds);
    LAS float* lfl = (LAS float*)(F.lds + 32768);
    LAS float* part = (LAS float*)(F.lds + 32768 + 4096);
    const float* x = A.in[0]; const float* g1 = A.in[4]; const float* w_in = A.in[5]; const float* fb = A.in[6];
    const float* mod = (const float*)(ws + WS_MOD);
    bf16* XN = (bf16*)(ws + WS_XN); float* cumT = (float*)(ws + WS_CUM); float* segtot = (float*)(ws + WS_SEGTOT);
    for (int i = tid_; i < 8192; i += NWAVES * 64) wf[(i & 7) * 1024 + (i >> 3)] = w_in[(size_t)(i >> 3) * DIN + 1536 + (i & 7)];
    __syncthreads();
    for (int blk = blockIdx.x; blk < M / 128; blk += F.G) {
        const int b = blk / (SEQ / 128);
        f32x4 gm[4], sh[4];
#pragma unroll
        for (int j = 0; j < 4; ++j) { const int col = 4 * lane_ + 256 * j; const f32x4 g = *(const f32x4*)(g1 + col), sc = *(const f32x4*)(mod + b * 6144 + 1024 + col);
            gm[j] = g * (sc + 1.0f); sh[j] = *(const f32x4*)(mod + b * 6144 + col); }
        float fbv = fb[((lane_ >> 5) & 1) * 4 + ((lane_ >> 4) & 1) * 2 + ((lane_ >> 3) & 1)];
        f32x4 nv[4];
        { const GAS f32x4* xr0 = (const GAS f32x4*)(x + ((size_t)blk * 128 + wave_ * 16) * D) + lane_;
#pragma unroll
          for (int j = 0; j < 4; ++j) nv[j] = xr0[64 * j]; }
        for (int i = 0; i < 16; ++i) {
            const int tl = wave_ * 16 + i; const size_t tok = (size_t)blk * 128 + tl;
            f32x4 v[4]; float s = 0.f;
#pragma unroll
            for (int j = 0; j < 4; ++j) { v[j] = nv[j]; s += (v[j].x * v[j].x + v[j].y * v[j].y) + (v[j].z * v[j].z + v[j].w * v[j].w); }
            { const GAS f32x4* xr = (const GAS f32x4*)(x + (tok + ((i + 1 < 16) ? 1 : 0)) * D) + lane_;
#pragma unroll
                for (int j = 0; j < 4; ++j) nv[j] = xr[64 * j]; }
            const float rstd = 1.0f / sqrtf(wave_sum(s) * (1.f / D) + 1e-6f);
            GAS unsigned long long* o8 = (GAS unsigned long long*)(XN + tok * D) + lane_;
            float f[8];
#pragma unroll
            for (int hh = 0; hh < 8; ++hh) f[hh] = 0.f;
#pragma unroll
            for (int j = 0; j < 4; ++j) { v[j] = v[j] * rstd * gm[j] + sh[j];
                o8[64 * j] = (unsigned long long)pk2(v[j].x, v[j].y) | ((unsigned long long)pk2(v[j].z, v[j].w) << 32);
#pragma unroll
                for (int hh = 0; hh < 8; ++hh) { const f32x4 w4 = *(const LAS f32x4*)(wf + hh * 1024 + 4 * lane_ + 256 * j); f[hh] += (v[j].x * w4.x + v[j].y * w4.y) + (v[j].z * w4.z + v[j].w * w4.w); } }
            float g4[4], g2v[2], z;
            { const bool up = (lane_ & 32) != 0;
#pragma unroll
              for (int i = 0; i < 4; ++i) { const float keep = up ? f[4 + i] : f[i], send = up ? f[i] : f[4 + i]; g4[i] = keep + __shfl_xor(send, 32); } }
            { const bool up = (lane_ & 16) != 0;
#pragma unroll
              for (int i = 0; i < 2; ++i) { const float keep = up ? g4[2 + i] : g4[i], send = up ? g4[i] : g4[2 + i]; g2v[i] = keep + __shfl_xor(send, 16); } }
            { const bool up = (lane_ & 8) != 0; const float keep = up ? g2v[1] : g2v[0], send = up ? g2v[0] : g2v[1]; z = keep + __shfl_xor(send, 8); }
            z += __shfl_xor(z, 1); z += __shfl_xor(z, 2); z += __shfl_xor(z, 4);
            const int myh = ((lane_ >> 5) & 1) * 4 + ((lane_ >> 4) & 1) * 2 + ((lane_ >> 3) & 1);
            z += fbv;
            const float lf = (z >= 0.f) ? -log1pf(__expf(-z)) : z - log1pf(__expf(z));
            if ((lane_ & 7) == 0) lfl[tl * 8 + myh] = lf;
        }
        __syncthreads();
        const int hh = tid_ & 7, p = tid_ >> 3;
        if (tid_ < 64) { float run = 0.f; for (int i = 0; i < 16; ++i) { run += lfl[(p * 16 + i) * 8 + hh]; lfl[(p * 16 + i) * 8 + hh] = run; } part[p * 8 + hh] = run; }
        __syncthreads();
        if (tid_ < 64) { float off = 0.f; for (int q = 0; q < p; ++q) off += part[q * 8 + hh];
            const int t0 = (blk % (SEQ / 128)) * 128 + p * 16; float* dst = cumT + ((size_t)(b * 8 + hh)) * SEQ + t0;
            for (int i = 0; i < 16; ++i) dst[i] = lfl[(p * 16 + i) * 8 + hh] + off;
            if (p == 7) segtot[blk * 8 + hh] = off + part[7 * 8 + hh]; }
        __syncthreads();
    }
}


__device__ __forceinline__ void p_cumfix(Frame& F, const Args& A) {
    PHASE_IDS();
    unsigned char* ws = A.ws; float* cumT = (float*)(ws + WS_CUM); const float* segtot = (const float*)(ws + WS_SEGTOT);
    LAS float* pre = (LAS float*)(F.lds);
    for (int blk = blockIdx.x; blk < M / 128; blk += F.G) {
        const int b = blk / (SEQ / 128), seg = blk % (SEQ / 128);
        __syncthreads();
        if (tid_ < 64) { const int hh = tid_ & 7, part = tid_ >> 3; float a = 0.f; for (int s = part; s < seg; s += 8) a += segtot[(b * 128 + s) * 8 + hh];
            a += __shfl_xor(a, 8); a += __shfl_xor(a, 16); a += __shfl_xor(a, 32); if (part == 0) pre[hh] = a; }
        __syncthreads();
        for (int i = tid_; i < 8 * 128; i += NWAVES * 64) { const int hh = i >> 7, t = i & 127; cumT[((size_t)(b * 8 + hh)) * SEQ + seg * 128 + t] += pre[hh]; }
    }
}
__device__ __forceinline__ void p_qknorm(Frame& F, const Args& A, unsigned* qkmax, unsigned* ktmax) {
    PHASE_IDS();
    unsigned char* ws = A.ws; const bf16* Q = (const bf16*)(ws + WS_Q); const bf16* K = (const bf16*)(ws + WS_K);
    const int gw = F.vcu * NWAVES + wave_, NGW = F.G * NWAVES, hd = lane_ >> 3;
    for (int g = gw; g < M / 16; g += NGW) { const int m0 = 16 * g, b = m0 / SEQ, tile = (m0 % SEQ) >> 6; float mq = 0.f, mk = 0.f;
#pragma unroll 4
        for (int i = 0; i < 16; ++i) { const size_t m = (size_t)(m0 + i);
            const v4u qw = *(const v4u*)(Q + m * 512 + 8 * lane_), kw = *(const v4u*)(K + m * 512 + 8 * lane_);
            float sq = 0.f, sk = 0.f;
#pragma unroll
            for (int e = 0; e < 4; ++e) { const float a = bflo(qw[e]), c = bfhi(qw[e]), d = bflo(kw[e]), f = bfhi(kw[e]); sq += a * a + c * c; sk += d * d + f * f; }
            sq += dpp_f<0xB1>(sq); sq += dpp_f<0x4E>(sq); sq += dpp_f<0x141>(sq);
            sk += dpp_f<0xB1>(sk); sk += dpp_f<0x4E>(sk); sk += dpp_f<0x141>(sk);
            mq = fmaxf(mq, sq); mk = fmaxf(mk, sk); }
        if ((lane_ & 7) == 0) { const int bh = b * 8 + hd;
            atomicMax(qkmax + bh * 2, __float_as_uint(mq)); atomicMax(qkmax + bh * 2 + 1, __float_as_uint(mk)); atomicMax(ktmax + bh * 256 + tile, __float_as_uint(mk)); } }
}

template <int WITH_MOE>
__device__ __forceinline__ void p_final(Frame& F, const Args& A, const float* src) {
    PHASE_IDS();
    unsigned char* ws = A.ws; const float* fg = A.in[29]; const float* mod = (const float*)(ws + WS_MOD);
    const int* route = (const int*)(ws + WS_ROUTE); const bf16* Y = (const bf16*)(ws + WS_YM);
    f32x4 fgv[4];
#pragma unroll
    for (int j = 0; j < 4; ++j) fgv[j] = *(const f32x4*)(fg + 4 * lane_ + 256 * j);
    const int gw = F.vcu * NWAVES + wave_, NGW = F.G * NWAVES;
    for (int m = gw; m < M; m += NGW) {
        f32x4 v[4]; float s = 0.f;
        if (WITH_MOE) { const GAS unsigned long long* xb = (const GAS unsigned long long*)((const bf16*)(ws + WS_X1) + (size_t)m * D) + lane_;
#pragma unroll
            for (int j = 0; j < 4; ++j) { const unsigned long long a = xb[64 * j]; const unsigned al = (unsigned)a, ah = (unsigned)(a >> 32); v[j] = (f32x4){bflo(al), bfhi(al), bflo(ah), bfhi(ah)}; } }
        else { const GAS f32x4* xr = (const GAS f32x4*)(src + (size_t)m * D) + lane_;
#pragma unroll
            for (int j = 0; j < 4; ++j) v[j] = xr[64 * j]; }
        if (WITH_MOE) {
            const int b = m / SEQ; const int* rt_ = route + (size_t)m * 8;
            const float w0 = __int_as_float(rt_[2]), w1 = __int_as_float(rt_[3]); const int s0 = rt_[6], s1 = rt_[7];
            const GAS unsigned* y0 = (const GAS unsigned*)((const unsigned char*)Y + (size_t)s0 * D) + lane_; const GAS unsigned* y1 = (const GAS unsigned*)((const unsigned char*)Y + (size_t)s1 * D) + lane_;
#pragma unroll
            for (int j = 0; j < 4; ++j) { const int a = (int)y0[64 * j], c = (int)y1[64 * j]; const f32x4 g2 = *(const f32x4*)(mod + b * 6144 + 5120 + 4 * lane_ + 256 * j);
                f32x4 y; y.x = w0 * __builtin_amdgcn_cvt_f32_fp8(a, 0) + w1 * __builtin_amdgcn_cvt_f32_fp8(c, 0); y.y = w0 * __builtin_amdgcn_cvt_f32_fp8(a, 1) + w1 * __builtin_amdgcn_cvt_f32_fp8(c, 1);
                y.z = w0 * __builtin_amdgcn_cvt_f32_fp8(a, 2) + w1 * __builtin_amdgcn_cvt_f32_fp8(c, 2); y.w = w0 * __builtin_amdgcn_cvt_f32_fp8(a, 3) + w1 * __builtin_amdgcn_cvt_f32_fp8(c, 3);
                v[j] = v[j] + g2 * y; }
        }
#pragma unroll
        for (int j = 0; j < 4; ++j) s += (v[j].x * v[j].x + v[j].y * v[j].y) + (v[j].z * v[j].z + v[j].w * v[j].w);
        float rstd = 1.0f / sqrtf(wave_sum(s) * (1.f / D) + 1e-6f);
        if (WITH_MOE == 2) { if (((const unsigned*)(ws + WS_CTL))[CW_DIAG]) rstd = 0.f; }
        GAS f32x4* o = (GAS f32x4*)(A.out + (size_t)m * D) + lane_;
#pragma unroll
        for (int j = 0; j < 4; ++j) o[64 * j] = v[j] * rstd * fgv[j];
    }
}

typedef float f32x16 __attribute__((ext_vector_type(16)));
typedef unsigned u32x2 __attribute__((ext_vector_type(2)));
__device__ __forceinline__ f32x4 shift4(const bf16* p, bool has_prev, const float* mu) {
    const u32x2 c = *(const u32x2*)p; u32x2 q = *(const u32x2*)(has_prev ? p - SHW : p); if (!has_prev) q = (u32x2){0u, 0u};
    const f32x4 m = *(const f32x4*)mu;
    f32x4 cv = {bflo(c.x), bfhi(c.x), bflo(c.y), bfhi(c.y)}, pv = {bflo(q.x), bfhi(q.x), bflo(q.y), bfhi(q.y)};
    return cv + (pv - cv) * m;
}
__device__ __forceinline__ u32x2 pack4(f32x4 v) { u32x2 r; r.x = pk2(v.x, v.y); r.y = pk2(v.z, v.w); return r; }

__device__ __forceinline__ float fsig(float x) { return __builtin_amdgcn_rcpf(1.0f + __builtin_amdgcn_exp2f(-1.4426950408889634f * x)); }
__device__ __forceinline__ float ftanh(float x) { const float xc = fminf(fmaxf(x, -15.f), 15.f); return 1.0f - 2.0f * __builtin_amdgcn_rcpf(1.0f + __builtin_amdgcn_exp2f(2.8853900817779268f * xc)); }
__device__ __forceinline__ float half_sum32(float v) { v = row_sum16(v); v += __shfl_xor(v, 16); return v; }
__device__ __forceinline__ void shift2(const bf16* p, bool has_prev, const float (&mu)[2], float (&o)[2]) {
    const unsigned c = *(const unsigned*)p; unsigned q = *(const unsigned*)(has_prev ? p - SHW : p); if (!has_prev) q = 0u;
    const float c0 = bflo(c), c1 = bfhi(c); o[0] = c0 + (bflo(q) - c0) * mu[0]; o[1] = c1 + (bfhi(q) - c1) * mu[1];
}
__device__ __forceinline__ size_t gc_off(int b, int h, int cc) { return (((size_t)b * SEQ + (size_t)cc * 64 + 32) * 512 + 64 * h) * 4; }
template <int VAR> __device__ __forceinline__ void rwkv_pre(Frame& F, const Args& A, int ci_lo, int ci_hi) {
    PHASE_IDS();
    unsigned char* ws = A.ws;
    const bf16* PRW = (const bf16*)(ws + WS_PRW);
    const float* mu = A.in[7]; const float* w0 = A.in[8]; const float* a0 = A.in[10]; const float* k_k = A.in[13]; const float* k_a = A.in[14]; const float* r_k = A.in[15];
    const bf16* LW2 = (const bf16*)(ws + WS_LW2); const bf16* LA2 = (const bf16*)(ws + WS_LA2); const bf16* LG2 = (const bf16*)(ws + WS_LG2);
    bf16* R = (bf16*)((unsigned char*)A.out + 64 * MiB); bf16* KP = (bf16*)((unsigned char*)A.out + 96 * MiB);
    bf16* VV = (bf16*)(ws + WS_XN); bf16* AV = (bf16*)(ws + WS_XN + 32 * MiB); bf16* BV = (bf16*)(ws + WS_F); bf16* GG = (bf16*)(ws + WS_F + 32 * MiB);
    float* BON = (float*)(ws + WS_BON);
    LAS bf16* Xw = (LAS bf16*)(F.lds); LAS bf16* Xa = (LAS bf16*)(F.lds + 9216); LAS bf16* Xg = (LAS bf16*)(F.lds + 18432);
    const int h = wave_;
    for (int ci = ci_lo; ci < ci_hi; ci += F.G) {
        __syncthreads();
        {
            int tl_ = threadIdx.x; asm volatile("" : "+v"(tl_));
            const int row = tl_ >> 3, cg = tl_ & 7; const size_t tok = (size_t)ci * 64 + row; const bool hp = (tok % SEQ) != 0;
            const bf16* src = PRW + tok * SHW + 1536 + 32 * cg; const float* mup = mu + 1536 + 32 * cg;
            LAS bf16* dst = (cg < 2) ? (Xw + row * 72 + 32 * cg) : (cg < 4) ? (Xa + row * 72 + 32 * (cg - 2)) : (Xg + row * 136 + 32 * (cg - 4));
#pragma unroll
            for (int q = 0; q < 8; ++q) { f32x4 v = shift4(src + 4 * q, hp, mup + 4 * q);
                if (cg < 2) { v.x = ftanh(v.x); v.y = ftanh(v.y); v.z = ftanh(v.z); v.w = ftanh(v.w); }
                else if (cg >= 4) { v.x = fsig(v.x); v.y = fsig(v.y); v.z = fsig(v.z); v.w = fsig(v.w); }
                *(LAS u32x2*)(dst + 4 * q) = pack4(v); }
        }
        __syncthreads();
        int ln_ = threadIdx.x & 63; asm volatile("" : "+v"(ln_));
        const int c = ln_ & 31, hh = ln_ >> 5, colb = 64 * h + 2 * c;
    float mur[2], muk[2], muv[2], kkc[2], kac[2], rkc[2], a0c[2], w0c[2];
#pragma unroll
    for (int e = 0; e < 2; ++e) { mur[e] = mu[colb + e]; muk[e] = mu[512 + colb + e]; muv[e] = mu[1024 + colb + e]; kkc[e] = k_k[colb + e]; kac[e] = k_a[colb + e]; rkc[e] = r_k[colb + e]; a0c[e] = a0[colb + e]; w0c[e] = w0[colb + e]; }
        float carry[2] = {0.f, 0.f};
#pragma unroll 1
        for (int tb = 0; tb < ((VAR == 3) ? 0 : 2); ++tb) {
            f32x16 aa[2], aw[2], ag[2];
            aa[0] = f32x16{}; aa[1] = f32x16{}; aw[0] = f32x16{}; aw[1] = f32x16{}; ag[0] = f32x16{}; ag[1] = f32x16{};
            if (VAR != 4) {
#pragma unroll
            for (int ks = 0; ks < 4; ++ks) { const bf16x8 afr = *(const LAS bf16x8*)(Xa + (32 * tb + c) * 72 + 16 * ks + 8 * hh), wfr = *(const LAS bf16x8*)(Xw + (32 * tb + c) * 72 + 16 * ks + 8 * hh);
#pragma unroll
                for (int jb = 0; jb < 2; ++jb) { const bf16x8 b1 = *(const bf16x8*)(LA2 + (size_t)(colb + jb) * 64 + 16 * ks + 8 * hh), b2 = *(const bf16x8*)(LW2 + (size_t)(colb + jb) * 64 + 16 * ks + 8 * hh);
                    aa[jb] = __builtin_amdgcn_mfma_f32_32x32x16_bf16(afr, b1, aa[jb], 0, 0, 0); aw[jb] = __builtin_amdgcn_mfma_f32_32x32x16_bf16(wfr, b2, aw[jb], 0, 0, 0); } }
#pragma unroll
            for (int ks = 0; ks < 8; ++ks) { const bf16x8 gfr = *(const LAS bf16x8*)(Xg + (32 * tb + c) * 136 + 16 * ks + 8 * hh);
#pragma unroll
                for (int jb = 0; jb < 2; ++jb) { const bf16x8 b3 = *(const bf16x8*)(LG2 + (size_t)(colb + jb) * 128 + 16 * ks + 8 * hh); ag[jb] = __builtin_amdgcn_mfma_f32_32x32x16_bf16(gfr, b3, ag[jb], 0, 0, 0); } }
            }
            unsigned gpk[16], apk[16];
#pragma unroll
            for (int reg = 0; reg < 16; ++reg) { gpk[reg] = pk2(ag[0][reg], ag[1][reg]); apk[reg] = pk2(fsig(a0c[0] + aa[0][reg]), fsig(a0c[1] + aa[1][reg])); }
            float G2[2][16], gb[2][4];
#pragma unroll
            for (int e = 0; e < 2; ++e) {
#pragma unroll
                for (int reg = 0; reg < 16; ++reg) { const float z = -(w0c[e] + aw[e][reg]);
                    const float sp = fmaxf(z, 0.f) + 0.6931471805599453f * __builtin_amdgcn_logf(1.0f + __builtin_amdgcn_exp2f(-1.4426950408889634f * fabsf(z)));
                    G2[e][reg] = -1.4426950408889634f * __builtin_amdgcn_exp2f(-1.4426950408889634f * (sp + 0.5f)); }
                float run = carry[e];
#pragma unroll
                for (int q = 0; q < 4; ++q) { G2[e][4 * q + 1] += G2[e][4 * q]; G2[e][4 * q + 2] += G2[e][4 * q + 1]; G2[e][4 * q + 3] += G2[e][4 * q + 2];
                    const float s_ = G2[e][4 * q + 3], sp_ = __shfl_xor(s_, 32); const float base = run + (hh ? sp_ : 0.f); gb[e][q] = base;
#pragma unroll
                    for (int x = 0; x < 4; ++x) G2[e][4 * q + x] += base;
                    run += s_ + sp_; }
                carry[e] = run; }
            float egp[2] = {0.f, 0.f};
            unsigned rawc[16][3], rawq[4][3];
#pragma unroll
            for (int reg = 0; reg < 16; ++reg) { const int t = 32 * tb + (reg & 3) + 8 * (reg >> 2) + 4 * hh; const size_t tok = (size_t)ci * 64 + t; const bool hp = (tok % SEQ) != 0;
                const bf16* prow = PRW + tok * SHW + colb; const bf16* pprev = hp ? prow - SHW : prow;
#pragma unroll
                for (int x = 0; x < 3; ++x) { if (VAR == 2) { rawc[reg][x] = 0x3f803f80u + reg; if ((reg & 3) == 0) rawq[reg >> 2][x] = 0x3f803f80u; } else { rawc[reg][x] = *(const unsigned*)(prow + 512 * x); if ((reg & 3) == 0) { const unsigned q = *(const unsigned*)(pprev + 512 * x); rawq[reg >> 2][x] = hp ? q : 0u; } } } }
#pragma unroll
            for (int reg = 0; reg < 16; ++reg) { const int t = 32 * tb + (reg & 3) + 8 * (reg >> 2) + 4 * hh; *(unsigned*)((unsigned char*)GG + ((unsigned)(ci * 64 + t) * 1024u + (unsigned)colb * 2u)) = gpk[reg]; }
#pragma unroll
            for (int reg = 0; reg < 16; ++reg) {
                const int t = 32 * tb + (reg & 3) + 8 * (reg >> 2) + 4 * hh; const size_t tok = (size_t)ci * 64 + t;
                unsigned rawp_[3];
#pragma unroll
                for (int x = 0; x < 3; ++x) rawp_[x] = ((reg & 3) == 0) ? rawq[reg >> 2][x] : rawc[(reg + 15) & 15][x];
                float kx[2], rx[2], vx[2];
                { const unsigned cc_ = rawc[reg][0], pp_ = rawp_[0]; const float c0 = bflo(cc_), c1 = bfhi(cc_); rx[0] = c0 + (bflo(pp_) - c0) * mur[0]; rx[1] = c1 + (bfhi(pp_) - c1) * mur[1]; }
                { const unsigned cc_ = rawc[reg][1], pp_ = rawp_[1]; const float c0 = bflo(cc_), c1 = bfhi(cc_); kx[0] = c0 + (bflo(pp_) - c0) * muk[0]; kx[1] = c1 + (bfhi(pp_) - c1) * muk[1]; }
                { const unsigned cc_ = rawc[reg][2], pp_ = rawp_[2]; const float c0 = bflo(cc_), c1 = bfhi(cc_); vx[0] = c0 + (bflo(pp_) - c0) * muv[0]; vx[1] = c1 + (bfhi(pp_) - c1) * muv[1]; }
                const float as0 = bflo(apk[reg]), as1 = bfhi(apk[reg]);
                const float kr0 = kx[0] * kkc[0], kr1 = kx[1] * kkc[1];
                const float ss = half_sum32(kr0 * kr0 + kr1 * kr1); const float inv = __builtin_amdgcn_rsqf(fmaxf(ss, 1e-24f));
                const float kk0 = kr0 * inv, kk1 = kr1 * inv, kp0 = kx[0] * (1.0f + (as0 - 1.0f) * kac[0]), kp1 = kx[1] * (1.0f + (as1 - 1.0f) * kac[1]);
                const float bon = half_sum32(rx[0] * kp0 * rkc[0] + rx[1] * kp1 * rkc[1]);
                float eg[2], en[2], ea[2];
#pragma unroll
                for (int e = 0; e < 2; ++e) { eg[e] = __builtin_amdgcn_exp2f(G2[e][reg]); en[e] = __builtin_amdgcn_rcpf(eg[e]); ea[e] = ((reg & 3) == 0) ? __builtin_amdgcn_exp2f(gb[e][reg >> 2]) : egp[e]; egp[e] = eg[e]; }
                const unsigned ob = (unsigned)tok * 1024u + (unsigned)colb * 2u;
                if (VAR == 0) {
                *(unsigned*)((unsigned char*)R + ob) = pk2(rx[0] * eg[0], rx[1] * eg[1]); *(unsigned*)((unsigned char*)KP + ob) = pk2(kp0 * en[0], kp1 * en[1]); *(unsigned*)((unsigned char*)VV + ob) = pk2(vx[0], vx[1]);
                *(unsigned*)((unsigned char*)AV + ob) = pk2(-kk0 * ea[0], -kk1 * ea[1]); *(unsigned*)((unsigned char*)BV + ob) = pk2(kk0 * as0 * en[0], kk1 * as1 * en[1]);
                if (c == 0) BON[tok * 8 + h] = bon;
                }
                if ((reg & 3) == 3) __builtin_amdgcn_sched_barrier(0);
            }
        }
        if (hh == 0) { *(float2*)((unsigned char*)A.out + gc_off(ci >> 8, h, ci & 255) + (size_t)c * 8) = make_float2(__builtin_amdgcn_exp2f(carry[0]), __builtin_amdgcn_exp2f(carry[1])); }
    }
}

__device__ __forceinline__ void rwkv_scan_seq(Frame& F, const Args& A) {
    PHASE_IDS();
    if (blockIdx.x >= BATCH * 8) return;
    unsigned char* ws = A.ws;
    const float* LW = (const float*)A.out; const bf16* R = (const bf16*)((unsigned char*)A.out + 64 * MiB); const bf16* KP = (const bf16*)((unsigned char*)A.out + 96 * MiB);
    const bf16* VV = (const bf16*)(ws + WS_XN); const bf16* AV = (const bf16*)(ws + WS_XN + 32 * MiB); const bf16* BV = (const bf16*)(ws + WS_F);
    float* Y = (float*)(ws + WS_Y);
    const int b = blockIdx.x >> 3, h = blockIdx.x & 7;
    constexpr int STEPB = 896, CH = 16, BUFB = STEPB * CH;
    LAS unsigned char* buf = F.lds;
    const size_t tok0 = (size_t)b * SEQ;
    const bool loader = wave_ >= 4; const int lt = tid_ - 256;
    auto load_chunk = [&](int cidx, int slot) {
        for (int p = lt; p < CH * 56; p += 256) { const int s = p / 56, q = p % 56; const size_t tok = tok0 + (size_t)cidx * CH + s; v4u val;
            if (q < 16) val = *(const v4u*)(LW + tok * 512 + 64 * h + 4 * q);
            else { const int a = (q - 16) >> 3, o8 = (q - 16) & 7; const bf16* src = (a == 0) ? AV : (a == 1) ? BV : (a == 2) ? KP : (a == 3) ? R : VV; val = *(const v4u*)(src + tok * 512 + 64 * h + 8 * o8); }
            *(LAS v4u*)(buf + slot * BUFB + s * STEPB + q * 16) = val; }
    };
    if (loader) load_chunk(0, 0);
    __syncthreads();
    float S[16];
#pragma unroll
    for (int j = 0; j < 16; ++j) S[j] = 0.f;
    const int il = lane_ & 15, jq = lane_ >> 4, irow = 16 * wave_ + il;
    for (int cidx = 0; cidx < SEQ / CH; ++cidx) {
        if (loader) { if (cidx + 1 < SEQ / CH) load_chunk(cidx + 1, (cidx + 1) & 1); }
        else {
            const LAS unsigned char* bb = buf + (cidx & 1) * BUFB;
#pragma unroll 4
            for (int s = 0; s < CH; ++s) { const LAS unsigned char* sp = bb + s * STEPB;
                float w[16], av[16], bv[16], kv[16], rv[16];
#pragma unroll
                for (int q = 0; q < 4; ++q) { const f32x4 l4 = *(const LAS f32x4*)(sp + 64 * jq + 16 * q); w[4 * q] = __expf(l4.x); w[4 * q + 1] = __expf(l4.y); w[4 * q + 2] = __expf(l4.z); w[4 * q + 3] = __expf(l4.w); }
#pragma unroll
                for (int q = 0; q < 2; ++q) { const v4u a4 = *(const LAS v4u*)(sp + 256 + 32 * jq + 16 * q), b4 = *(const LAS v4u*)(sp + 384 + 32 * jq + 16 * q), k4 = *(const LAS v4u*)(sp + 512 + 32 * jq + 16 * q), r4 = *(const LAS v4u*)(sp + 640 + 32 * jq + 16 * q);
#pragma unroll
                    for (int e = 0; e < 4; ++e) { av[8 * q + 2 * e] = bflo(a4[e]); av[8 * q + 2 * e + 1] = bfhi(a4[e]); bv[8 * q + 2 * e] = bflo(b4[e]); bv[8 * q + 2 * e + 1] = bfhi(b4[e]);
                        kv[8 * q + 2 * e] = bflo(k4[e]); kv[8 * q + 2 * e + 1] = bfhi(k4[e]); rv[8 * q + 2 * e] = bflo(r4[e]); rv[8 * q + 2 * e + 1] = bfhi(r4[e]); } }
                const unsigned short vraw = *(const LAS unsigned short*)(sp + 768 + 2 * irow); const float vi = __uint_as_float((unsigned)vraw << 16);
                float sa = 0.f;
#pragma unroll
                for (int j = 0; j < 16; ++j) sa += S[j] * av[j];
                sa += __shfl_xor(sa, 16); sa += __shfl_xor(sa, 32);
                float y = 0.f;
#pragma unroll
                for (int j = 0; j < 16; ++j) { S[j] = S[j] * w[j] + sa * bv[j] + vi * kv[j]; y += S[j] * rv[j]; }
                y += __shfl_xor(y, 16); y += __shfl_xor(y, 32);
                if (jq == 0) Y[(tok0 + (size_t)cidx * CH + s) * 512 + 64 * h + irow] = y;
            }
        }
        __syncthreads();
    }
}

__device__ __forceinline__ void rwkv_post(Frame& F, const Args& A) {
    PHASE_IDS();
    unsigned char* ws = A.ws;
    const float* Y = (const float*)(ws + WS_Y); const bf16* VV = (const bf16*)(ws + WS_XN); const bf16* GG = (const bf16*)(ws + WS_F + 32 * MiB); const float* BON = (const float*)(ws + WS_BON);
    bf16* O = (bf16*)(ws + WS_F);
    const float* lg = A.in[16]; const float* lb = A.in[17];
    const int gw = F.vcu * NWAVES + wave_, NGW = F.G * NWAVES, col = 8 * lane_, hd = lane_ >> 3;
    const f32x4 g0 = *(const f32x4*)(lg + col), g1 = *(const f32x4*)(lg + col + 4), b0 = *(const f32x4*)(lb + col), b1 = *(const f32x4*)(lb + col + 4);
    for (int m = gw; m < M; m += NGW) {
        const f32x4 y0 = *(const f32x4*)(Y + (size_t)m * 512 + col), y1 = *(const f32x4*)(Y + (size_t)m * 512 + col + 4);
        float s = (y0.x + y0.y) + (y0.z + y0.w) + (y1.x + y1.y) + (y1.z + y1.w);
        s += __shfl_xor(s, 1); s += __shfl_xor(s, 2); s += __shfl_xor(s, 4);
        const float mean = s * (1.f / 64.f); const f32x4 d0 = y0 - mean, d1 = y1 - mean;
        float q = (d0.x * d0.x + d0.y * d0.y) + (d0.z * d0.z + d0.w * d0.w) + (d1.x * d1.x + d1.y * d1.y) + (d1.z * d1.z + d1.w * d1.w);
        q += __shfl_xor(q, 1); q += __shfl_xor(q, 2); q += __shfl_xor(q, 4);
        const float rstd = 1.0f / sqrtf(q * (1.f / 64.f) + 64e-5f);
        const float bon = BON[(size_t)m * 8 + hd];
        const v4u vw = *(const v4u*)(VV + (size_t)m * 512 + col), gw4 = *(const v4u*)(GG + (size_t)m * 512 + col);
        f32x4 o0 = (d0 * rstd * g0 + b0), o1 = (d1 * rstd * g1 + b1);
        o0.x = (o0.x + bon * bflo(vw.x)) * bflo(gw4.x); o0.y = (o0.y + bon * bfhi(vw.x)) * bfhi(gw4.x); o0.z = (o0.z + bon * bflo(vw.y)) * bflo(gw4.y); o0.w = (o0.w + bon * bfhi(vw.y)) * bfhi(gw4.y);
        o1.x = (o1.x + bon * bflo(vw.z)) * bflo(gw4.z); o1.y = (o1.y + bon * bfhi(vw.z)) * bfhi(gw4.z); o1.z = (o1.z + bon * bflo(vw.w)) * bflo(gw4.w); o1.w = (o1.w + bon * bfhi(vw.w)) * bfhi(gw4.w);
        v4u ow; ow.x = pk2(o0.x, o0.y); ow.y = pk2(o0.z, o0.w); ow.z = pk2(o1.x, o1.y); ow.w = pk2(o1.z, o1.w);
        *(v4u*)(O + (size_t)m * 512 + col) = ow;
    }
}

__device__ __forceinline__ size_t pq_off(int it) { const int ch = it >> 8, cc = it & 255; return WS_PRW + ((size_t)(ch >> 3) * SEQ + (size_t)cc * 64) * (SHW * 2) + (size_t)(ch & 7) * 24576; }
__device__ __forceinline__ size_t y0_off(int it, int idx) { const int ch = it >> 8, cc = it & 255; return (((size_t)(ch >> 3) * SEQ + (size_t)cc * 64 + (idx >> 4)) * 512 + 64 * (ch & 7)) * 4 + (size_t)(idx & 15) * 16; }
constexpr size_t ST_OFF = 64 * MiB;
constexpr int CH_ITEMS = BATCH * 8 * (SEQ / 64);

__device__ __forceinline__ int sw16(int row, int chunk) { return row * 128 + ((chunk ^ (row & 7)) << 4); }
typedef float f32x4c __attribute__((ext_vector_type(4)));
__device__ __forceinline__ bf16x8 ld_frag(const LAS unsigned char* Mx, int row, int chunk) { return *(const LAS bf16x8*)(Mx + sw16(row, chunk)); }
template <bool SWAP>
__device__ __forceinline__ void mm_tile(const LAS unsigned char* Am, const LAS unsigned char* Bm, int r0, int c0, int l15, int kg, f32x4c (&acc)[2]) {
    bf16x8 a[2], b[2][2];
#pragma unroll
    for (int ks = 0; ks < 2; ++ks) { a[ks] = ld_frag(Am, r0 + l15, 4 * ks + kg);
#pragma unroll
        for (int n = 0; n < 2; ++n) b[ks][n] = ld_frag(Bm, c0 + 16 * n + l15, 4 * ks + kg); }
#pragma unroll
    for (int ks = 0; ks < 2; ++ks)
#pragma unroll
        for (int n = 0; n < 2; ++n)
            acc[n] = SWAP ? __builtin_amdgcn_mfma_f32_16x16x32_bf16(b[ks][n], a[ks], acc[n], 0, 0, 0) : __builtin_amdgcn_mfma_f32_16x16x32_bf16(a[ks], b[ks][n], acc[n], 0, 0, 0);
}
__device__ __forceinline__ unsigned long long pack4u(f32x4c v) { return (unsigned long long)pk2(v[0], v[1]) | ((unsigned long long)pk2(v[2], v[3]) << 32); }
__device__ __forceinline__ void st_nat(LAS unsigned char* O, int r0, int c0, int l15, int kg, const f32x4c (&acc)[2]) {
#pragma unroll
    for (int n = 0; n < 2; ++n) { const int row = r0 + l15, col = c0 + 16 * n + 4 * kg; *(LAS unsigned long long*)(O + sw16(row, col >> 3) + (col & 4) * 2) = pack4u(acc[n]); }
}
__device__ __forceinline__ void st_tr(LAS unsigned char* OT, int r0, int c0, int l15, int kg, const f32x4c (&acc)[2]) {
#pragma unroll
    for (int n = 0; n < 2; ++n)
#pragma unroll
        for (int e = 0; e < 4; ++e) { const int row = r0 + l15, col = c0 + 16 * n + 4 * kg + e; *(LAS unsigned short*)(OT + sw16(col, row >> 3) + (row & 7) * 2) = (unsigned short)f2bf(acc[n][e]); }
}
__device__ __forceinline__ f32x4c ld_nat4(const LAS unsigned char* O, int row, int col) { const unsigned long long w = *(const LAS unsigned long long*)(O + sw16(row, col >> 3) + (col & 4) * 2);
    const unsigned lo = (unsigned)w, hi = (unsigned)(w >> 32); return (f32x4c){bflo(lo), bfhi(lo), bflo(hi), bfhi(hi)}; }

template <int VAR> __device__ __forceinline__ void rwkv_r1(Frame& F, const Args& A, int it_lo, int it_hi, int it_step) {
    PHASE_IDS();
    unsigned char* ws = A.ws;
    const bf16* R = (const bf16*)((unsigned char*)A.out + 64 * MiB); const bf16* KP = (const bf16*)((unsigned char*)A.out + 96 * MiB);
    const bf16* VV = (const bf16*)(ws + WS_XN); const bf16* AV = (const bf16*)(ws + WS_XN + 32 * MiB); const bf16* BV = (const bf16*)(ws + WS_F);
    LAS unsigned char* L = F.lds;
#define MB(i) (L + (i) * 8192)
    LAS float* gCs = (LAS float*)(L + 17 * 8192); LAS float* part = gCs + 64;
    const int w = wave_, j = lane_, l15 = lane_ & 15, kg = lane_ >> 4, r0 = 16 * (w >> 1), c0 = 32 * (w & 1);
#define R1_BAR() asm volatile("s_waitcnt lgkmcnt(0)\n\ts_barrier" ::: "memory")
    float ngc; unsigned short nav[8], nbv[8], nkv[8], nrv[8], nvv[8];
#define R1_LOAD(itx) do { const int ch_ = (itx) >> 8, cc_ = (itx) & 255; const size_t tb_ = (size_t)(ch_ >> 3) * SEQ + (size_t)cc_ * 64 + 8 * w; const int cg_ = 64 * (ch_ & 7) + j; \
        _Pragma("unroll") for (int t = 0; t < 8; ++t) { const size_t o = (tb_ + t) * 512 + cg_; nav[t] = AV[o]; nbv[t] = BV[o]; nkv[t] = KP[o]; nrv[t] = R[o]; nvv[t] = VV[o]; } ngc = *(const float*)((const unsigned char*)A.out + gc_off(ch_ >> 3, ch_ & 7, cc_) + (size_t)j * 4); } while (0)
    if (it_lo < it_hi) R1_LOAD(it_lo);
    for (int it = it_lo; it < it_hi; it += it_step) {
        R1_BAR();
        {
            float av[8], bv[8], kv[8], rv[8]; unsigned short vraw[8]; const float gcj = ngc;
#pragma unroll
            for (int t = 0; t < 8; ++t) { av[t] = __uint_as_float((unsigned)nav[t] << 16); bv[t] = __uint_as_float((unsigned)nbv[t] << 16);
                kv[t] = __uint_as_float((unsigned)nkv[t] << 16); rv[t] = __uint_as_float((unsigned)nrv[t] << 16); vraw[t] = nvv[t]; }
            { const int itn_ = (it + it_step < it_hi) ? it + it_step : it; R1_LOAD(itn_); }
            R1_BAR();
            if (w == 0) gCs[j] = gcj;
            unsigned short atT[8], bhT[8], khT[8];
#pragma unroll
            for (int t = 0; t < 8; ++t) {
                const int row = 8 * w + t; const int off = sw16(row, j >> 3) + (j & 7) * 2;
                const unsigned short at = (unsigned short)f2bf(av[t]);
                *(LAS unsigned short*)(MB(0) + off) = at; atT[t] = at;
                *(LAS unsigned short*)(MB(2) + off) = (unsigned short)f2bf(bv[t]);
                *(LAS unsigned short*)(MB(3) + off) = (unsigned short)f2bf(kv[t]);
                *(LAS unsigned short*)(MB(4) + off) = (unsigned short)f2bf(rv[t]);
                bhT[t] = (unsigned short)f2bf(bv[t] * gcj); khT[t] = (unsigned short)f2bf(kv[t] * gcj); }
            v4u x;
            x.x = atT[0] | ((unsigned)atT[1] << 16); x.y = atT[2] | ((unsigned)atT[3] << 16); x.z = atT[4] | ((unsigned)atT[5] << 16); x.w = atT[6] | ((unsigned)atT[7] << 16); *(LAS v4u*)(MB(1) + sw16(j, w)) = x;
            x.x = bhT[0] | ((unsigned)bhT[1] << 16); x.y = bhT[2] | ((unsigned)bhT[3] << 16); x.z = bhT[4] | ((unsigned)bhT[5] << 16); x.w = bhT[6] | ((unsigned)bhT[7] << 16); *(LAS v4u*)(MB(5) + sw16(j, w)) = x;
            x.x = khT[0] | ((unsigned)khT[1] << 16); x.y = khT[2] | ((unsigned)khT[3] << 16); x.z = khT[4] | ((unsigned)khT[5] << 16); x.w = khT[6] | ((unsigned)khT[7] << 16); *(LAS v4u*)(MB(6) + sw16(j, w)) = x;
            x.x = vraw[0] | ((unsigned)vraw[1] << 16); x.y = vraw[2] | ((unsigned)vraw[3] << 16); x.z = vraw[4] | ((unsigned)vraw[5] << 16); x.w = vraw[6] | ((unsigned)vraw[7] << 16); *(LAS v4u*)(MB(7) + sw16(j, w)) = x;
        }
        R1_BAR();
        if (VAR == 1) continue;
        f32x4c acc[2];
        const int trow = r0 + l15;
        {
            acc[0] = f32x4c{}; acc[1] = f32x4c{}; mm_tile<true>(MB(0), MB(2), r0, c0, l15, kg, acc);
#pragma unroll
            for (int n = 0; n < 2; ++n)
#pragma unroll
                for (int e = 0; e < 4; ++e) { const int s = c0 + 16 * n + 4 * kg + e; if (s >= trow) acc[n][e] = 0.f; }
            st_nat(MB(8), r0, c0, l15, kg, acc); st_tr(MB(9), r0, c0, l15, kg, acc);
#pragma unroll
            for (int n = 0; n < 2; ++n)
#pragma unroll
                for (int e = 0; e < 4; ++e) { const int s = c0 + 16 * n + 4 * kg + e; if (s == trow) acc[n][e] = 1.f; }
            st_nat(MB(15), r0, c0, l15, kg, acc);
            acc[0] = f32x4c{}; acc[1] = f32x4c{}; mm_tile<true>(MB(0), MB(3), r0, c0, l15, kg, acc);
#pragma unroll
            for (int n = 0; n < 2; ++n)
#pragma unroll
                for (int e = 0; e < 4; ++e) { const int s = c0 + 16 * n + 4 * kg + e; if (s >= trow) acc[n][e] = 0.f; }
            st_nat(MB(10), r0, c0, l15, kg, acc);
            acc[0] = f32x4c{}; acc[1] = f32x4c{}; mm_tile<true>(MB(4), MB(2), r0, c0, l15, kg, acc);
#pragma unroll
            for (int n = 0; n < 2; ++n)
#pragma unroll
                for (int e = 0; e < 4; ++e) { const int s = c0 + 16 * n + 4 * kg + e; if (s > trow) acc[n][e] = 0.f; }
            st_nat(MB(11), r0, c0, l15, kg, acc);
            acc[0] = f32x4c{}; acc[1] = f32x4c{}; mm_tile<true>(MB(4), MB(3), r0, c0, l15, kg, acc);
#pragma unroll
            for (int n = 0; n < 2; ++n)
#pragma unroll
                for (int e = 0; e < 4; ++e) { const int s = c0 + 16 * n + 4 * kg + e; if (s > trow) acc[n][e] = 0.f; }
            st_nat(MB(12), r0, c0, l15, kg, acc);
        }
        R1_BAR();
        if (VAR == 2) continue;
        acc[0] = f32x4c{}; acc[1] = f32x4c{}; mm_tile<true>(MB(8), MB(9), r0, c0, l15, kg, acc); st_nat(MB(13), r0, c0, l15, kg, acc); st_tr(MB(14), r0, c0, l15, kg, acc);
        acc[0] = f32x4c{}; acc[1] = f32x4c{}; mm_tile<true>(MB(7), MB(10), r0, c0, l15, kg, acc); st_nat(MB(3), r0, c0, l15, kg, acc);
        R1_BAR();
#define SQUARE(xi, xti, xo, xto) do { acc[0] = f32x4c{}; acc[1] = f32x4c{}; mm_tile<true>(MB(xi), MB(xti), r0, c0, l15, kg, acc); st_nat(MB(xo), r0, c0, l15, kg, acc); st_tr(MB(xto), r0, c0, l15, kg, acc); } while (0)
#define MUPD(mi, xti, mo) do { acc[0] = ld_nat4(MB(mi), trow, c0 + 4 * kg); acc[1] = ld_nat4(MB(mi), trow, c0 + 16 + 4 * kg); mm_tile<true>(MB(mi), MB(xti), r0, c0, l15, kg, acc); st_nat(MB(mo), r0, c0, l15, kg, acc); } while (0)
        SQUARE(13, 14, 0, 2); MUPD(15, 14, 16); R1_BAR();
        SQUARE(0, 2, 13, 14); MUPD(16, 2, 15); R1_BAR();
        SQUARE(13, 14, 0, 2); MUPD(15, 14, 16); R1_BAR();
        SQUARE(0, 2, 13, 14); MUPD(16, 2, 15); R1_BAR();
        MUPD(15, 14, 16); R1_BAR();
        acc[0] = f32x4c{}; acc[1] = f32x4c{}; mm_tile<true>(MB(1), MB(16), r0, c0, l15, kg, acc); st_nat(MB(13), r0, c0, l15, kg, acc);
        acc[0] = f32x4c{}; acc[1] = f32x4c{}; mm_tile<true>(MB(3), MB(16), r0, c0, l15, kg, acc); st_nat(MB(14), r0, c0, l15, kg, acc);
        R1_BAR();
        if (VAR == 3) continue;
        unsigned char* og = ws + pq_off(it); unsigned char* oy = (unsigned char*)A.out + y0_off(it, w * 64 + lane_);
        {
            acc[0] = f32x4c{}; acc[1] = f32x4c{}; mm_tile<true>(MB(5), MB(13), r0, c0, l15, kg, acc);
            const float gc = gCs[trow];
#pragma unroll
            for (int n = 0; n < 2; ++n) { const int col = c0 + 16 * n + 4 * kg;
#pragma unroll
                for (int e = 0; e < 4; ++e) if (col + e == trow) acc[n][e] += gc;
                const int jj_ = col & 31, q_ = jj_ & 15; const size_t po_ = ((size_t)((((trow >> 5) * 2 + (col >> 5)) * 2 + (jj_ >> 4)) * 64 + (trow & 31) + 32 * ((q_ >> 2) & 1)) * 16 + (size_t)(4 * (q_ >> 3)) * 2);
                if (VAR == 0) *(unsigned long long*)(og + po_) = pack4u(acc[n]); else asm volatile("" :: "v"(pack4u(acc[n]))); }
            acc[0] = ld_nat4(MB(4), trow, c0 + 4 * kg); acc[1] = ld_nat4(MB(4), trow, c0 + 16 + 4 * kg); mm_tile<true>(MB(11), MB(13), r0, c0, l15, kg, acc);
#pragma unroll
            for (int n = 0; n < 2; ++n) { const int col = c0 + 16 * n + 4 * kg; if (VAR == 0) *(unsigned long long*)(og + 16384 + (size_t)(trow * 64 + col) * 2) = pack4u(acc[n]); else asm volatile("" :: "v"(pack4u(acc[n]))); }
            acc[0] = f32x4c{}; acc[1] = f32x4c{}; mm_tile<false>(MB(5), MB(14), r0, c0, l15, kg, acc); mm_tile<false>(MB(6), MB(7), r0, c0, l15, kg, acc);
#pragma unroll
            for (int n = 0; n < 2; ++n) { const int i_ = c0 + 16 * n + l15, jr_ = r0 + 4 * kg, rr_ = jr_ & 31;
                const size_t qo_ = (size_t)((((i_ >> 5) * 2 + (jr_ >> 5)) * 64 + (i_ & 31) + 32 * ((rr_ >> 2) & 1)) * 32 + (4 * (rr_ >> 3)) * 2);
                if (VAR == 0) *(unsigned long long*)(og + 8192 + qo_) = pack4u(acc[n]); else asm volatile("" :: "v"(pack4u(acc[n]))); }
            acc[0] = f32x4c{}; acc[1] = f32x4c{}; mm_tile<false>(MB(11), MB(14), r0, c0, l15, kg, acc); mm_tile<false>(MB(12), MB(7), r0, c0, l15, kg, acc);
            { v4u q; q.x = pk2(acc[0][0], acc[0][1]); q.y = pk2(acc[0][2], acc[0][3]); q.z = pk2(acc[1][0], acc[1][1]); q.w = pk2(acc[1][2], acc[1][3]); if (VAR == 0) *(v4u*)oy = q; else asm volatile("" :: "v"(q)); }
        }
    }
#undef SQUARE
#undef MUPD
#undef MB
#undef R1_BAR
#undef R1_LOAD
}

template <int VAR> __device__ __forceinline__ void rwkv_r2(Frame& F, const Args& A, unsigned char* stbase) {
    PHASE_IDS();
    if (blockIdx.x >= BATCH * 8) return;
    unsigned char* ws = A.ws;
    LAS unsigned char* L = F.lds;
    const int ch = blockIdx.x, w = wave_, l15 = lane_ & 15, kg = lane_ >> 4, r0 = 16 * (w >> 1), c0 = 32 * (w & 1);
    const unsigned char* pq = ws + pq_off(ch * 256); unsigned char* st = stbase + (size_t)ch * 256 * 8192;
    for (int i = tid_; i < 2048; i += NWAVES * 64) { ((LAS unsigned*)L)[i] = 0u; }
    for (int i = tid_; i < 512; i += NWAVES * 64) ((v4u*)st)[i] = (v4u){0u, 0u, 0u, 0u};
    __syncthreads();
    constexpr int PF = 8;
    bf16x8 pa[PF][2]; v4u qf[PF];
#define R2_LOAD(slot, step) do { const unsigned char* p_ = pq + (size_t)(step) * (64 * SHW * 2); \
        pa[slot][0] = *(const bf16x8*)(p_ + (size_t)((r0 + l15) * 64 + 8 * kg) * 2); pa[slot][1] = *(const bf16x8*)(p_ + (size_t)((r0 + l15) * 64 + 32 + 8 * kg) * 2); \
        qf[slot] = *(const v4u*)(p_ + 8192 + (size_t)(w * 64 + lane_) * 16); } while (0)
#pragma unroll
    for (int s = 0; s < PF; ++s) R2_LOAD(s, s);
    for (int c = 0; c < 256; c += PF) {
#pragma unroll
        for (int s = 0; s < PF; ++s) {
            const int step = c + s; const LAS unsigned char* Sin = L + (step & 15) * 8192; LAS unsigned char* Sout = L + ((step + 1) & 15) * 8192;
            f32x4c acc[2];
            acc[0] = (f32x4c){bflo(qf[s].x), bfhi(qf[s].x), bflo(qf[s].y), bfhi(qf[s].y)}; acc[1] = (f32x4c){bflo(qf[s].z), bfhi(qf[s].z), bflo(qf[s].w), bfhi(qf[s].w)};
            bf16x8 sf[2][2];
#pragma unroll
            for (int ks = 0; ks < 2; ++ks)
#pragma unroll
                for (int n = 0; n < 2; ++n) sf[ks][n] = ld_frag(Sin, c0 + 16 * n + l15, 4 * ks + kg);
#pragma unroll
            for (int ks = 0; ks < 2; ++ks)
#pragma unroll
                for (int n = 0; n < 2; ++n) acc[n] = __builtin_amdgcn_mfma_f32_16x16x32_bf16(pa[s][ks], sf[ks][n], acc[n], 0, 0, 0);
#pragma unroll
            for (int n = 0; n < 2; ++n) { const int row = c0 + 16 * n + l15, col = r0 + 4 * kg; const unsigned long long pkd = pack4u(acc[n]);
                *(LAS unsigned long long*)(Sout + sw16(row, col >> 3) + (col & 4) * 2) = pkd;
                }
            if (VAR != 3) { if (step + PF < 256) R2_LOAD(s, step + PF); }
            if (VAR != 4) asm volatile("s_waitcnt lgkmcnt(0)\n\ts_barrier" ::: "memory");
        }
        if (VAR != 2) { const int nflush = (c + PF < 256) ? PF * 8192 : (PF - 1) * 8192; unsigned char* dst = st + (size_t)(c + 1) * 8192;
          for (int o = tid_ * 16; o < nflush; o += NWAVES * 64 * 16) { const int row_ = (o >> 7) & 63, chk_ = (o >> 4) & 7, slot_ = (c + 1 + (o >> 13)) & 15; *(v4u*)(dst + o) = *(const LAS v4u*)(L + slot_ * 8192 + sw16(row_, chk_)); } }
    }
#undef R2_LOAD
}

__device__ __forceinline__ void rwkv_r2w(Frame& F, const Args& A, unsigned char* stbase) {
    PHASE_IDS();
    if (blockIdx.x >= BATCH * 8) return;
    unsigned char* ws = A.ws;
    LAS unsigned char* RING = F.lds;
    LAS unsigned char* HB = F.lds + 98304;
    const int ch = blockIdx.x, it = wave_ & 1, cl = lane_ & 31, hh = lane_ >> 5; const bool chain = wave_ < 2;
    const unsigned char* pq = ws + pq_off(ch * 256); unsigned char* st = stbase + (size_t)ch * 256 * 8192;
    const int ft = tid_ - 128;
    f32x16 H[2]; H[0] = f32x16{}; H[1] = f32x16{};
    v4u hx[3][6];
#define HP_LOAD(set, grp) do { _Pragma("unroll") for (int j = 0; j < 6; ++j) { const int pc_ = ft + 384 * j; const int pcc_ = pc_ < 2048 ? pc_ : 2047; int stp_ = 2 * (grp) + (pcc_ >> 10); stp_ = stp_ < 255 ? stp_ : 254; \
        hx[set][j] = *(const v4u*)(pq + (size_t)stp_ * (64 * SHW * 2) + (size_t)(pcc_ & 1023) * 16); } } while (0)
#define HP_STORE(set, slot) do { LAS unsigned char* rg_ = RING + (slot) * 32768; _Pragma("unroll") for (int j = 0; j < 6; ++j) { const int pc_ = ft + 384 * j; const int pcc_ = pc_ < 2048 ? pc_ : 2047; *(LAS v4u*)(rg_ + pcc_ * 16) = hx[set][j]; } } while (0)
#define CH_READ(PF_, QF_, rs_) do { _Pragma("unroll") for (int f = 0; f < 8; ++f) PF_[f] = *(const LAS bf16x8*)((rs_) + (f * 64 + lane_) * 16); \
        _Pragma("unroll") for (int jt = 0; jt < 2; ++jt) { const LAS unsigned char* q_ = (rs_) + 8192 + ((it * 2 + jt) * 64 + lane_) * 32; QF_[2 * jt] = *(const LAS v4u*)q_; QF_[2 * jt + 1] = *(const LAS v4u*)(q_ + 16); } } while (0)
#define CH_STEP(PF_, QF_, hbs_) do { bf16x8 B[2][2]; \
        _Pragma("unroll") for (int jt2 = 0; jt2 < 2; ++jt2) _Pragma("unroll") for (int k = 0; k < 2; ++k) { v4u p_; p_.x = pk2(H[jt2][8 * k], H[jt2][8 * k + 1]); p_.y = pk2(H[jt2][8 * k + 2], H[jt2][8 * k + 3]); \
            p_.z = pk2(H[jt2][8 * k + 4], H[jt2][8 * k + 5]); p_.w = pk2(H[jt2][8 * k + 6], H[jt2][8 * k + 7]); B[jt2][k] = __builtin_bit_cast(bf16x8, p_); } \
        _Pragma("unroll") for (int jt = 0; jt < 2; ++jt) { f32x16 n_; \
            _Pragma("unroll") for (int e = 0; e < 4; ++e) { const unsigned a_ = QF_[2 * jt][e], b_ = QF_[2 * jt + 1][e]; n_[2 * e] = bflo(a_); n_[2 * e + 1] = bfhi(a_); n_[8 + 2 * e] = bflo(b_); n_[8 + 2 * e + 1] = bfhi(b_); } \
            _Pragma("unroll") for (int jt2 = 0; jt2 < 2; ++jt2) _Pragma("unroll") for (int k = 0; k < 2; ++k) n_ = __builtin_amdgcn_mfma_f32_32x32x16_bf16(PF_[(jt * 2 + jt2) * 2 + k], B[jt2][k], n_, 0, 0, 0); \
            H[jt] = n_; } \
          \
        _Pragma("unroll") for (int jt = 0; jt < 2; ++jt) _Pragma("unroll") for (int q = 0; q < 4; ++q) { const int row = 32 * it + cl, col = 32 * jt + 8 * q + 4 * hh; \
            *(LAS unsigned long long*)((hbs_) + sw16(row, col >> 3) + (col & 4) * 2) = (unsigned long long)pk2(H[jt][4 * q], H[jt][4 * q + 1]) | ((unsigned long long)pk2(H[jt][4 * q + 2], H[jt][4 * q + 3]) << 32); } } while (0)
    if (!chain) {
        for (int o = ft * 16; o < 8192; o += 384 * 16) *(LAS v4u*)(HB + 16384 + 8192 + o) = (v4u){0u, 0u, 0u, 0u};
        HP_LOAD(0, 0); HP_STORE(0, 0); HP_LOAD(1, 1); HP_LOAD(2, 2); HP_LOAD(0, 3);
    }
    __syncthreads();
    for (int g0 = 0; g0 < 129; g0 += 3) {
#pragma unroll
        for (int u = 0; u < 3; ++u) {
            const int g = g0 + u;
            if (chain) {
                const LAS unsigned char* rg = RING + u * 32768; LAS unsigned char* hb = HB + (g & 1) * 16384;
                bf16x8 pfa[8], pfb[8]; v4u qfa[4], qfb[4];
                CH_READ(pfa, qfa, rg); CH_READ(pfb, qfb, rg + 16384);
                if (2 * g < 255) CH_STEP(pfa, qfa, hb);
                if (2 * g + 1 < 255) CH_STEP(pfb, qfb, hb + 8192);
            } else {
                HP_STORE((u + 1) % 3, (u + 1) % 3);
                HP_LOAD((u + 1) % 3, g + 4);
                const LAS unsigned char* hbp = HB + ((g - 1) & 1) * 16384; unsigned char* dst = st + (long)(2 * g - 1) * 8192;
                const int lo_ = g == 0 ? 512 : 0, hi_ = g == 128 ? 511 : 1023;
#pragma unroll
                for (int j = 0; j < 3; ++j) { int pc_ = ft + 384 * j; pc_ = pc_ < lo_ ? pc_ + 512 : pc_; pc_ = pc_ > hi_ ? hi_ : pc_; const int o = pc_ * 16; const int row_ = (o >> 7) & 63, chk_ = (o >> 4) & 7;
                    *(v4u*)(dst + o) = *(const LAS v4u*)(hbp + (o & ~8191) + sw16(row_, chk_)); }
            }
            asm volatile("s_waitcnt lgkmcnt(0)\n\ts_barrier" ::: "memory");
        }
    }
    asm volatile("s_waitcnt vmcnt(0) lgkmcnt(0)\n\ts_barrier" ::: "memory");
#undef HP_LOAD
#undef HP_STORE
#undef CH_READ
#undef CH_STEP
}

__device__ __forceinline__ void rwkv_r3(Frame& F, const Args& A) {
    PHASE_IDS();
    unsigned char* ws = A.ws;
    const bf16* VV = (const bf16*)(ws + WS_XN); const bf16* GG = (const bf16*)(ws + WS_F + 32 * MiB); const float* BON = (const float*)(ws + WS_BON);
    bf16* O = (bf16*)(ws + WS_F); const float* lg = A.in[16]; const float* lb = A.in[17];
    LAS float* Yt = (LAS float*)F.lds;
    const int w = wave_, l15 = lane_ & 15, kg = lane_ >> 4, r0 = 16 * (w >> 1), c0 = 32 * (w & 1);
#define R3_BAR() asm volatile("s_waitcnt lgkmcnt(0)\n\ts_barrier" ::: "memory")
    v4u nq, nvw, ngw; bf16x8 na[2], nb[2][2]; float nbon;
    const int pt_ = tid_ >> 3, pi0_ = 8 * (tid_ & 7);
#define R3_LOAD(itx) do { const int ch_ = (itx) >> 8, cc_ = (itx) & 255; const unsigned char* og_ = ws + pq_off(itx); const unsigned char* sg_ = (const unsigned char*)A.out + ST_OFF + (size_t)(itx) * 8192; \
        nq = *(const v4u*)((const unsigned char*)A.out + y0_off(itx, w * 64 + lane_)); \
        _Pragma("unroll") for (int ks = 0; ks < 2; ++ks) { na[ks] = *(const bf16x8*)(og_ + 16384 + (size_t)((r0 + l15) * 64 + 32 * ks + 8 * kg) * 2); \
            _Pragma("unroll") for (int n = 0; n < 2; ++n) nb[ks][n] = *(const bf16x8*)(sg_ + (size_t)((c0 + 16 * n + l15) * 64 + 32 * ks + 8 * kg) * 2); } \
        const size_t m_ = (size_t)(ch_ >> 3) * SEQ + (size_t)cc_ * 64 + pt_; const int col_ = 64 * (ch_ & 7) + pi0_; \
        nvw = *(const v4u*)(VV + m_ * 512 + col_); ngw = *(const v4u*)(GG + m_ * 512 + col_); nbon = BON[m_ * 8 + (ch_ & 7)]; } while (0)
    if ((int)blockIdx.x < CH_ITEMS) R3_LOAD((int)blockIdx.x);
    for (int it = blockIdx.x; it < CH_ITEMS; it += F.G) {
        const int ch = it >> 8, cc = it & 255, b = ch >> 3, h = ch & 7;
        f32x4c acc[2];
        acc[0] = (f32x4c){bflo(nq.x), bfhi(nq.x), bflo(nq.y), bfhi(nq.y)}; acc[1] = (f32x4c){bflo(nq.z), bfhi(nq.z), bflo(nq.w), bfhi(nq.w)};
#pragma unroll
        for (int ks = 0; ks < 2; ++ks)
#pragma unroll
            for (int n = 0; n < 2; ++n) acc[n] = __builtin_amdgcn_mfma_f32_16x16x32_bf16(na[ks], nb[ks][n], acc[n], 0, 0, 0);
        const v4u vw = nvw, gw4 = ngw; const float bon = nbon;
        { const int itn_ = (it + (int)F.G < CH_ITEMS) ? it + (int)F.G : it; R3_LOAD(itn_); }
        R3_BAR();
#pragma unroll
        for (int n = 0; n < 2; ++n)
#pragma unroll
            for (int e = 0; e < 4; ++e) Yt[(r0 + 4 * kg + e) * 68 + c0 + 16 * n + l15] = acc[n][e];
        R3_BAR();
        {   const int t = pt_, i0 = pi0_; const size_t m = (size_t)b * SEQ + (size_t)cc * 64 + t; const int col = 64 * h + i0;
            const f32x4 y0 = *(const LAS f32x4*)(Yt + t * 68 + i0), y1 = *(const LAS f32x4*)(Yt + t * 68 + i0 + 4);
            float s = (y0.x + y0.y) + (y0.z + y0.w) + (y1.x + y1.y) + (y1.z + y1.w);
            s += __shfl_xor(s, 1); s += __shfl_xor(s, 2); s += __shfl_xor(s, 4);
            const float mean = s * (1.f / 64.f); const f32x4 d0 = y0 - mean, d1 = y1 - mean;
            float q = (d0.x * d0.x + d0.y * d0.y) + (d0.z * d0.z + d0.w * d0.w) + (d1.x * d1.x + d1.y * d1.y) + (d1.z * d1.z + d1.w * d1.w);
            q += __shfl_xor(q, 1); q += __shfl_xor(q, 2); q += __shfl_xor(q, 4);
            const float rstd = 1.0f / sqrtf(q * (1.f / 64.f) + 64e-5f);
            const f32x4 g0 = *(const f32x4*)(lg + col), g1 = *(const f32x4*)(lg + col + 4), b0 = *(const f32x4*)(lb + col), b1 = *(const f32x4*)(lb + col + 4);
            f32x4 o0 = (d0 * rstd * g0 + b0), o1 = (d1 * rstd * g1 + b1);
            o0.x = (o0.x + bon * bflo(vw.x)) * bflo(gw4.x); o0.y = (o0.y + bon * bfhi(vw.x)) * bfhi(gw4.x); o0.z = (o0.z + bon * bflo(vw.y)) * bflo(gw4.y); o0.w = (o0.w + bon * bfhi(vw.y)) * bfhi(gw4.y);
            o1.x = (o1.x + bon * bflo(vw.z)) * bflo(gw4.z); o1.y = (o1.y + bon * bfhi(vw.z)) * bfhi(gw4.z); o1.z = (o1.z + bon * bflo(vw.w)) * bflo(gw4.w); o1.w = (o1.w + bon * bfhi(vw.w)) * bfhi(gw4.w);
            v4u ow; ow.x = pk2(o0.x, o0.y); ow.y = pk2(o0.z, o0.w); ow.z = pk2(o1.x, o1.y); ow.w = pk2(o1.z, o1.w);
            *(v4u*)(O + m * 512 + col) = ow; }
    }
#undef R3_BAR
#undef R3_LOAD
}

__device__ __forceinline__ void p_norm2_route(Frame& F, const Args& A) {
    PHASE_IDS();
    unsigned char* ws = A.ws;
    constexpr int WROW = 2064;
    LAS unsigned char* WH = F.lds; LAS unsigned char* WL = F.lds + 36 * WROW;
    LAS float* LG = (LAS float*)F.lds;
    LAS int* eid = (LAS int*)(F.lds + 128 * 36 * 4);
    const bf16* x1 = (const bf16*)(ws + WS_X1); const float* g2 = A.in[21]; const float* mod = (const float*)(ws + WS_MOD);
    const float* rgw = A.in[22]; const float* rgb = A.in[23]; const float* rew = A.in[24]; const float* reb = A.in[25];
    bf16* XN2 = (bf16*)(ws + WS_XN); int* route = (int*)(ws + WS_ROUTE); int* blkcnt = (int*)(ws + WS_BLKCNT);
    const int l15 = lane_ & 15, kg = lane_ >> 4;
    for (int blk = blockIdx.x; blk < M / 128; blk += F.G) {
        __syncthreads();
        for (int i = tid_; i < 4096; i += NWAVES * 64) { const float w = rgw[i]; const unsigned hi = f2bf(w); const unsigned lo = f2bf(w - __uint_as_float(hi << 16)); const int off = (i & 3) * WROW + (i >> 2) * 2;
            *(LAS unsigned short*)(WH + off) = (unsigned short)hi; *(LAS unsigned short*)(WL + off) = (unsigned short)lo; }
        for (int i = tid_; i < 32768; i += NWAVES * 64) { const float w = rew[i]; const unsigned hi = f2bf(w); const unsigned lo = f2bf(w - __uint_as_float(hi << 16)); const int off = (4 + (i & 31)) * WROW + (i >> 5) * 2;
            *(LAS unsigned short*)(WH + off) = (unsigned short)hi; *(LAS unsigned short*)(WL + off) = (unsigned short)lo; }
        __syncthreads();
        const int b = blk / (SEQ / 128); const size_t tok = (size_t)blk * 128 + wave_ * 16 + l15;
        const bf16* xrow = x1 + tok * D + 8 * kg; const float* gmp = g2 + 8 * kg; const float* scp = mod + b * 6144 + 4096 + 8 * kg; const float* shp = mod + b * 6144 + 3072 + 8 * kg;
        float ss = 0.f;
#pragma unroll 8
        for (int ks = 0; ks < 32; ++ks) { const v4u xw = *(const v4u*)(xrow + 32 * ks);
#pragma unroll
            for (int e = 0; e < 4; ++e) { const float lo_ = bflo(xw[e]), hi_ = bfhi(xw[e]); ss += lo_ * lo_ + hi_ * hi_; } }
        ss += __shfl_xor(ss, 16); ss += __shfl_xor(ss, 32);
        const float rstd = 1.0f / sqrtf(ss * (1.f / D) + 1e-6f);
        f32x4 acc[3]; acc[0] = f32x4{0.f, 0.f, 0.f, 0.f}; acc[1] = acc[0]; acc[2] = acc[0];
        int wcol[3];
#pragma unroll
        for (int ct = 0; ct < 3; ++ct) { const int col = 16 * ct + l15; wcol[ct] = (col < 36 ? col : 35) * WROW + 16 * kg; }
#pragma unroll 2
        for (int ks = 0; ks < 32; ++ks) {
            float hv[8];
            { const v4u xw = *(const v4u*)(xrow + 32 * ks); const f32x4 a = {bflo(xw.x), bfhi(xw.x), bflo(xw.y), bfhi(xw.y)}, c = {bflo(xw.z), bfhi(xw.z), bflo(xw.w), bfhi(xw.w)};
              const f32x4 g0 = *(const f32x4*)(gmp + 32 * ks), g1 = *(const f32x4*)(gmp + 32 * ks + 4), s0 = *(const f32x4*)(scp + 32 * ks), s1 = *(const f32x4*)(scp + 32 * ks + 4), h0 = *(const f32x4*)(shp + 32 * ks), h1 = *(const f32x4*)(shp + 32 * ks + 4);
              const f32x4 u0 = a * rstd * (g0 * (s0 + 1.0f)) + h0, u1 = c * rstd * (g1 * (s1 + 1.0f)) + h1;
              hv[0] = u0.x; hv[1] = u0.y; hv[2] = u0.z; hv[3] = u0.w; hv[4] = u1.x; hv[5] = u1.y; hv[6] = u1.z; hv[7] = u1.w; }
            unsigned hiw[4], low[4];
#pragma unroll
            for (int e = 0; e < 4; ++e) { const unsigned h0 = f2bf(hv[2 * e]), h1 = f2bf(hv[2 * e + 1]); hiw[e] = h0 | (h1 << 16);
                low[e] = f2bf(hv[2 * e] - __uint_as_float(h0 << 16)) | (f2bf(hv[2 * e + 1] - __uint_as_float(h1 << 16)) << 16); }
            v4u hq; hq.x = hiw[0]; hq.y = hiw[1]; hq.z = hiw[2]; hq.w = hiw[3];
            *(v4u*)(XN2 + tok * D + 32 * ks + 8 * kg) = hq;
            v4u lq; lq.x = low[0]; lq.y = low[1]; lq.z = low[2]; lq.w = low[3];
            const bf16x8 ah = __builtin_bit_cast(bf16x8, hq), al = __builtin_bit_cast(bf16x8, lq);
#pragma unroll
            for (int ct = 0; ct < 3; ++ct) { const bf16x8 bh = *(const LAS bf16x8*)(WH + wcol[ct] + 64 * ks), bl = *(const LAS bf16x8*)(WL + wcol[ct] + 64 * ks);
                acc[ct] = __builtin_amdgcn_mfma_f32_16x16x32_bf16(ah, bh, acc[ct], 0, 0, 0); acc[ct] = __builtin_amdgcn_mfma_f32_16x16x32_bf16(ah, bl, acc[ct], 0, 0, 0); acc[ct] = __builtin_amdgcn_mfma_f32_16x16x32_bf16(al, bh, acc[ct], 0, 0, 0); }
        }
        __syncthreads();
#pragma unroll
        for (int ct = 0; ct < 3; ++ct) { const int col = 16 * ct + l15; if (col < 36) { const float bias = (col < 4) ? rgb[col] : reb[col - 4];
#pragma unroll
            for (int e = 0; e < 4; ++e) LG[(wave_ * 16 + 4 * kg + e) * 36 + col] = acc[ct][e] + bias; } }
        __syncthreads();
        if (tid_ < 128) { const LAS float* lg = LG + tid_ * 36;
            int gi = 0; float gmax = lg[0];
#pragma unroll
            for (int i = 1; i < 4; ++i) if (lg[i] > gmax) { gmax = lg[i]; gi = i; }
            float den = 0.f;
#pragma unroll
            for (int i = 0; i < 4; ++i) den += __expf(lg[i] - gmax);
            const float gp = 1.0f / den;
            float el[8];
#pragma unroll
            for (int i = 0; i < 8; ++i) el[i] = lg[4 + 8 * gi + i];
            int i0 = 0; float m0 = el[0];
#pragma unroll
            for (int i = 1; i < 8; ++i) if (el[i] > m0) { m0 = el[i]; i0 = i; }
            int i1 = -1; float m1 = -INFINITY;
#pragma unroll
            for (int i = 0; i < 8; ++i) if (i != i0 && el[i] > m1) { m1 = el[i]; i1 = i; }
            if (i1 < 0) { i1 = (i0 + 1) & 7; m1 = m0; }
            const float p1 = __expf(m1 - m0), w0 = gp / (1.0f + p1), w1 = gp * p1 / (1.0f + p1);
            int* rt_ = route + ((size_t)blk * 128 + tid_) * 8; rt_[0] = gi * 8 + i0; rt_[1] = gi * 8 + i1; rt_[2] = __float_as_int(w0); rt_[3] = __float_as_int(w1);
            eid[tid_ * 2] = gi * 8 + i0; eid[tid_ * 2 + 1] = gi * 8 + i1; }
        __syncthreads();
        if (tid_ < 256) { const int e = eid[tid_]; int rk = 0; for (int a = 0; a < tid_; ++a) rk += (eid[a] == e) ? 1 : 0; route[((size_t)blk * 128 + (tid_ >> 1)) * 8 + 4 + (tid_ & 1)] = rk; }
        else if (tid_ < 288) { const int e = tid_ - 256; int cn = 0; for (int a = 0; a < 256; ++a) cn += (eid[a] == e) ? 1 : 0; blkcnt[blk * 32 + e] = cn; }
    }
}

__device__ __forceinline__ void conv_experts(Frame& F, const Args& A) {
    PHASE_IDS();
    unsigned char* ws = A.ws; bf16* W13 = (bf16*)(ws + WS_W13); bf16* W2T = (bf16*)(ws + WS_W2T);
    LAS float* scr = (LAS float*)(F.lds + RING_OFF + wave_ * 16384);
    const int gw = F.vcu * NWAVES + wave_, NGW = F.G * NWAVES;
    for (int it = gw; it < 3 * 8192; it += NGW) {
        const int which = it >> 13, r = it & 8191;
        if (which < 2) { const int e = r >> 8, kb = (r >> 4) & 15, nb = r & 15, n0 = 32 * nb;
            transpose_item(A.in[26 + which] + (size_t)e * 1024 * 512, 512, n0, 64 * kb, 1024, W13, (size_t)e * 1024 + (n0 >> 7) * 256 + which * 128 + (n0 & 127), scr, lane_); }
        else { const int e = r >> 8, kb = (r >> 5) & 7, nb = r & 31;
            transpose_item(A.in[28] + (size_t)e * 512 * 1024, 1024, 32 * nb, 64 * kb, 512, W2T, (size_t)e * 1024 + 32 * nb, scr, lane_); }
    }
}

__device__ __forceinline__ void p_slots(Frame& F, const Args& A) {
    PHASE_IDS();
    unsigned char* ws = A.ws;
    LAS int* tile_e = (LAS int*)(F.lds + TILE_OFF); LAS int* base = tile_e + 288; LAS int* tot = base + 32; LAS int* pre = tot + 32; LAS int* ntl = pre + 32; LAS int* part = ntl + 4;
    const int* blkcnt = (const int*)(ws + WS_BLKCNT); int* route = (int*)(ws + WS_ROUTE); int* rowtok = (int*)(ws + WS_ROWTOK);
    { const int e = tid_ & 31, pt = tid_ >> 5; int s = 0; for (int bb = 16 * pt; bb < 16 * pt + 16; ++bb) s += blkcnt[bb * 32 + e]; part[pt * 32 + e] = s; }
    __syncthreads();
    if (tid_ < 32) { int t = 0; for (int p = 0; p < 16; ++p) t += part[p * 32 + tid_]; tot[tid_] = t; }
    __syncthreads();
    if (tid_ == 0) { int run = 0, nt = 0; for (int e = 0; e < 32; ++e) { base[e] = run; const int pad = (tot[e] + 255) >> 8; for (int i = 0; i < pad; ++i) tile_e[nt++] = e; run += pad * 256; } ntl[0] = nt; }
    __syncthreads();
    for (int blk = blockIdx.x; blk < M / 128; blk += F.G) {
        { const int e = tid_ & 31, pt = tid_ >> 5; int s = 0; for (int bb = pt; bb < blk; bb += 16) s += blkcnt[bb * 32 + e]; part[pt * 32 + e] = s; }
        __syncthreads();
        if (tid_ < 32) { int p = 0; for (int q = 0; q < 16; ++q) p += part[q * 32 + tid_]; pre[tid_] = p; }
        __syncthreads();
        if (tid_ < 256) { const size_t tok = (size_t)blk * 128 + (tid_ >> 1); const int k = tid_ & 1; const int e = route[tok * 8 + k], lr = route[tok * 8 + 4 + k];
            const int slot = base[e] + pre[e] + lr; route[tok * 8 + 6 + k] = slot; rowtok[slot] = (int)tok; }
        __syncthreads();
    }
    for (int e = blockIdx.x; e < 32; e += F.G) { const int lo = base[e] + tot[e], hi = base[e] + (((tot[e] + 255) >> 8) << 8); for (int s = lo + tid_; s < hi; s += NWAVES * 64) rowtok[s] = 0; }
}

#ifndef STAGE_UNUSED
#define STAGE 4
#endif
#ifndef PHASES
#define PHASES 0xffff
#endif
#ifndef RWKV_CHUNKED
#define RWKV_CHUNKED 1
#endif

__device__ __forceinline__ void ph_gemm1(Frame& F, const Args& args) { unsigned char* ws = args.ws;
    pg8::Gemm g{(const pg8::bf16_t*)(ws + WS_XN), (const pg8::bf16_t*)(ws + WS_WIN), nullptr, 1024, NIN};
    pg8::StaticOrder S; S.init(M, NIN, F.G, (int)blockIdx.x);
    pg8::EpiIn E{(pg8::bf16_t*)(ws + WS_Q), (pg8::bf16_t*)(ws + WS_K), (pg8::bf16_t*)(ws + WS_V), (pg8::bf16_t*)(ws + WS_PRW), (pg8::bf16_t*)(ws + WS_GATES), ATT_C2};
    pg8::gemm_phase<pg8::EpiIn, pg8::StaticOrder>(F.lds + RING_OFF, g, S, E); }
__device__ __forceinline__ void ph_attn_wrap(unsigned char* lds, Frame& F, const Args& args, size_t out_off, int qslot) { unsigned char* ws = args.ws;
    const attn_body::AttnTensors AT{(const attn_body::bf16*)(ws + WS_Q), (const attn_body::bf16*)(ws + WS_K), (const attn_body::bf16*)(ws + WS_V), (attn_body::bf16*)(ws + out_off), (const float*)(ws + WS_CUM), (const float*)(ws + WS_SEGTOT)};
    attn_body::attn_phase_dyn<8>((char*)lds + RING_OFF, AT, (unsigned*)(F.ctl + CW_QUEUE + 64 * qslot), (const unsigned*)(F.ctl + CW_QKMAX), (const unsigned*)(F.ctl + CW_KTMAX), TAB_OFF, SEGP_OFF); }
__device__ __forceinline__ void ph_gemm2a(Frame& F, const Args& args) { unsigned char* ws = args.ws;
    pg8::Gemm g{(const pg8::bf16_t*)(ws + WS_Q), (const pg8::bf16_t*)(ws + WS_WOF), nullptr, 512, 1024};
    pg8::StaticOrder S; S.init(M, 1024, F.G, (int)blockIdx.x);
    pg8::EpiGate<1> E{(pg8::bf16_t*)(ws + WS_TMP), 1024, (const pg8::bf16_t*)(ws + WS_GATES), 2048, 0};
    pg8::gemm_phase<pg8::EpiGate<1>, pg8::StaticOrder>(F.lds + RING_OFF, g, S, E); }
__device__ __forceinline__ void ph_gemm2b(Frame& F, const Args& args) { unsigned char* ws = args.ws;
    pg8::Gemm g{(const pg8::bf16_t*)(ws + WS_F), (const pg8::bf16_t*)(ws + WS_WOR), nullptr, 512, 1024};
    pg8::StaticOrder S; S.init(M, 1024, F.G, (int)blockIdx.x);
    pg8::EpiGate<2> E{(pg8::bf16_t*)(ws + WS_TMP), 1024, (const pg8::bf16_t*)(ws + WS_GATES), 2048, 1024};
    pg8::gemm_phase<pg8::EpiGate<2>, pg8::StaticOrder>(F.lds + RING_OFF, g, S, E); }
__device__ __forceinline__ void ph_gemm3(Frame& F, const Args& args) { unsigned char* ws = args.ws;
    pg8::Gemm g{(const pg8::bf16_t*)(ws + WS_TMP), (const pg8::bf16_t*)(ws + WS_WO), nullptr, 1024, 1024};
    pg8::StaticOrder S; S.init(M, 1024, F.G, (int)blockIdx.x);
    pg8::EpiRes E{args.in[0], (pg8::bf16_t*)(ws + WS_X1), (const float*)(ws + WS_MOD) + 2048, SEQ, 6144};
    pg8::gemm_phase<pg8::EpiRes, pg8::StaticOrder>(F.lds + RING_OFF, g, S, E); }
__device__ __forceinline__ void ph_moe_up(Frame& F, const Args& args) { unsigned char* ws = args.ws;
    const LAS int* tile_e = (const LAS int*)(F.lds + TILE_OFF); const int ntiles = tile_e[288 + 96];
    LAS int* rows = (LAS int*)(F.lds + TILE_OFF + 4096);
    { const int* rowtok = (const int*)(ws + WS_ROWTOK); int tid_ = threadIdx.x; asm volatile("" : "+v"(tid_));
      for (int i = 0; i < 8; ++i) { const int L = i * F.G + (int)blockIdx.x; if (L >= ntiles * 4) break; if (tid_ < 256) rows[i * 256 + tid_] = rowtok[(L >> 2) * 256 + tid_]; }
      __syncthreads(); }
    pg8::Gemm g{(const pg8::bf16_t*)(ws + WS_XN), (const pg8::bf16_t*)(ws + WS_W13), rows, 1024, 1024};
    pg8::MoeOrder S{ntiles * 4, F.G, (int)blockIdx.x, 2, tile_e};
    pg8::EpiSwiGLU E{(pg8::bf16_t*)(ws + WS_H)};
    pg8::gemm_phase<pg8::EpiSwiGLU, pg8::MoeOrder, true>(F.lds + RING_OFF, g, S, E); }
__device__ __forceinline__ void ph_moe_down(Frame& F, const Args& args) { unsigned char* ws = args.ws;
    const LAS int* tile_e = (const LAS int*)(F.lds + TILE_OFF); const int ntiles = tile_e[288 + 96];
    pg8::Gemm g{(const pg8::bf16_t*)(ws + WS_H), (const pg8::bf16_t*)(ws + WS_W2T), nullptr, 512, 1024};
    pg8::MoeOrder S{ntiles * 4, F.G, (int)blockIdx.x, 2, tile_e};
    pg8::EpiFp8 E{ws + WS_YM, 1024};
    pg8::gemm_phase<pg8::EpiFp8, pg8::MoeOrder>(F.lds + RING_OFF, g, S, E); }

__global__ void __launch_bounds__(NWAVES * 64, 2) fwd_kernel(Args args) {
    extern __shared__ __attribute__((aligned(16))) unsigned char lds[];
    Frame F;
    F.lds = (LAS unsigned char*)lds;
    F.MISC = (volatile LAS unsigned*)(F.lds + MISC_OFF);
    F.tid = threadIdx.x; F.lane = F.tid & 63; F.wave = __builtin_amdgcn_readfirstlane(F.tid >> 6);
    F.G = gridDim.x; { const int bx = blockIdx.x; F.vcu = (F.G % 8 == 0) ? (bx % 8) * (F.G / 8) + bx / 8 : bx; }
    unsigned char* ws = args.ws;
    F.ctl = (gu32*)(ws + WS_CTL);
    for (int u = F.tid; u < (LDS_BYTES - LDSCTL_OFF) / 4; u += NWAVES * 64) ((LAS unsigned*)(F.lds + LDSCTL_OFF))[u] = 0u;
    __syncthreads();
    XcdBarrier bar = xcd_barrier_post((unsigned*)(F.ctl + CW_BAR), F.MISC + 8);
#define GRID_BAR() xcd_barrier(bar)

    p0_prologue(F, args); GRID_BAR();
    p1_norm(F, args); __syncthreads(); p_convert_early(F, args); GRID_BAR();
    p_cumfix(F, args);
    ph_gemm1(F, args); GRID_BAR();
    p_qknorm(F, args, (unsigned*)(F.ctl + CW_QKMAX), (unsigned*)(F.ctl + CW_KTMAX));
    for (int cb = (int)blockIdx.x; cb < SEQ / 64; cb += F.G)
    for (int half = 0; half < 2; ++half) {
        rwkv_pre<0>(F, args, cb + 256 * half, cb + 256 * half + 1);
        __syncthreads();
        rwkv_r1<0>(F, args, cb + 2048 * half, cb + 2048 * half + 2048, 256);
        __syncthreads();
    }
    GRID_BAR();
    rwkv_r2w(F, args, (unsigned char*)args.out + ST_OFF);
    ph_attn_wrap(lds, F, args, WS_Q, 0); GRID_BAR();
    rwkv_r3(F, args); GRID_BAR();
    ph_gemm2a(F, args);
    ph_gemm2b(F, args); GRID_BAR();
    ph_gemm3(F, args); GRID_BAR();
    p_norm2_route(F, args); GRID_BAR();
    p_slots(F, args); conv_experts(F, args); GRID_BAR();
    ph_moe_up(F, args); GRID_BAR();
    ph_moe_down(F, args); GRID_BAR();
    p_final<1>(F, args, args.out);
}

extern "C" void kernel_launch(void* const* d_in, const int* in_sizes, int n_in, void* d_out, int out_size, void* d_ws, size_t ws_size, hipStream_t stream) {
    static int grid = 0;
    if (grid == 0) {
        if (n_in != 30 || in_sizes[0] != M * D || out_size != M * D || ws_size < WS_END) { fprintf(stderr, "kernel_launch: unexpected shapes (n_in %d, in0 %d, out %d, ws %zu)\n", n_in, n_in > 0 ? in_sizes[0] : -1, out_size, ws_size); grid = -1; return; }
        int dev = 0, cus = 0, per_cu = 0;
        if (hipGetDevice(&dev) != hipSuccess || hipDeviceGetAttribute(&cus, hipDeviceAttributeMultiprocessorCount, dev) != hipSuccess) { grid = -1; return; }
        if (hipFuncSetAttribute((const void*)fwd_kernel, hipFuncAttributeMaxDynamicSharedMemorySize, LDS_BYTES) != hipSuccess) { fprintf(stderr, "kernel_launch: hipFuncSetAttribute failed\n"); grid = -1; return; }
        if (hipOccupancyMaxActiveBlocksPerMultiprocessor(&per_cu, (const void*)fwd_kernel, NWAVES * 64, LDS_BYTES) != hipSuccess || per_cu < 1)
            fprintf(stderr, "kernel_launch: occupancy query reports %d\n", per_cu);
        (void)hipGetLastError();
        grid = cus;
        if (grid > 256) grid = 256;
    }
    if (grid < 0) return;
    if (hipMemsetAsync((char*)d_ws + WS_CTL, 0, CTL_ZERO_BYTES, stream) != hipSuccess) return;
    Args a{};
    for (int i = 0; i < 30; ++i) a.in[i] = (const float*)d_in[i];
    a.out = (float*)d_out; a.ws = (unsigned char*)d_ws;
    hipLaunchKernelGGL(fwd_kernel, dim3(grid), dim3(NWAVES * 64), LDS_BYTES, stream, a);
}
```

```cpp
#include <hip/hip_runtime.h>
#include <hip/hip_bf16.h>
#include <cstdio>
#include <cstdint>
#include <cmath>

namespace pg8 {
#define PG8_LAS __attribute__((address_space(3)))
typedef unsigned short bf16_t;
typedef short bf16x8 __attribute__((ext_vector_type(8)));
typedef float f32x4 __attribute__((ext_vector_type(4)));
typedef unsigned u32x4 __attribute__((ext_vector_type(4)));
typedef unsigned u32x2 __attribute__((ext_vector_type(2)));
constexpr int BM = 256, BK = 64, HALF = 128, HTB = HALF * BK * 2, STAGE_BYTES = 8 * HTB, NXCD = 8, WGM = 8;

__host__ __device__ __forceinline__ int lds_byte(int r, int c) { const int st = (r >> 4) * 2 + (c >> 5), rr = r & 15, cc = c & 31, ob = rr * 64 + cc * 2; return st * 1024 + (ob ^ (((ob >> 9) & 1) << 5)); }
__host__ __device__ __forceinline__ void stage_rc(int b, int& R, int& C) { const int st = b / 1024, sb = b % 1024, swz = sb ^ (((sb >> 9) & 1) << 5); R = (st >> 1) * 16 + swz / 64; C = (st & 1) * 32 + (swz % 64) / 2; }
__host__ __device__ __forceinline__ int perm32(int rho) { const int n = rho >> 4, i = rho & 15; return 8 * (i >> 2) + 4 * n + (i & 3); }

struct Unit { int pm, pn, e; };
struct Gemm { const bf16_t* A; const bf16_t* Bt; const PG8_LAS int* rowlds; int K; int nB; };

struct StaticOrder {
    int nM, nN, nwg, G, c;
    __host__ __device__ void init(int M, int N, int G_, int c_) { nM = M / BM; nN = N / BM; nwg = nM * nN; G = G_; c = c_; }
    __host__ __device__ bool next(int i, Unit& u) const {
        const long L = (long)i * G + c; if (L >= nwg) return false;
        int wgid = (int)L; { const int q = nwg / NXCD, r = nwg % NXCD, xcd = wgid % NXCD, off = wgid / NXCD; wgid = (xcd < r ? xcd * (q + 1) : r * (q + 1) + (xcd - r) * q) + off; }
        const int nig = WGM * nN, gid = wgid / nig, fm = gid * WGM, gsz = (nM - fm) < WGM ? (nM - fm) : WGM;
        u.pm = fm + ((wgid % nig) % gsz); u.pn = (wgid % nig) / gsz; u.e = 0; return true;
    }
};

__device__ __forceinline__ unsigned cvt_pk_bf16(float lo, float hi) { unsigned r; asm volatile("v_cvt_pk_bf16_f32 %0, %1, %2" : "=v"(r) : "v"(lo), "v"(hi)); return r; }
__device__ __forceinline__ float bf_lo(unsigned w) { return __uint_as_float(w << 16); }
__device__ __forceinline__ float bf_hi(unsigned w) { return __uint_as_float(w & 0xffff0000u); }
__device__ __forceinline__ float fsigmoid(float x) { return __builtin_amdgcn_rcpf(1.0f + __builtin_amdgcn_exp2f(-1.4426950408889634f * x)); }

template <class Epi, class Sched, bool GATHER = false>
__device__ __forceinline__ void gemm_phase(PG8_LAS unsigned char* lds, const Gemm g, const Sched& S, const Epi& E) {
    int tid_ = threadIdx.x; asm volatile("" : "+v"(tid_));
    const int tid = tid_, wid = __builtin_amdgcn_readfirstlane(tid >> 6), lane = tid & 63, wr = wid >> 2, wc = wid & 3, fr = lane & 15, fq = lane >> 4;
    const int K = g.K, nt = K / BK;
    int RA[2], CA[2]; unsigned voffA[2], voffB[2];
#pragma unroll
    for (int i = 0; i < 2; ++i) { int R, C; stage_rc(tid * 16 + i * 8192, R, C); const int Rb = Epi::PERM ? ((R & ~31) + perm32(R & 31)) : R;
        RA[i] = R; CA[i] = C; voffA[i] = (unsigned)(R * K + C) * 2u; voffB[i] = (unsigned)(Rb * K + C) * 2u; }
    const size_t tstep = 2 * (size_t)HALF * K * 2;
    const size_t kstep = (size_t)(BK * 2);
    const size_t hstep = (size_t)HALF * K * 2;
    const unsigned ldsw = (unsigned)wid * 1024u;
    const int aoff = lds_byte(wr * 64 + fr, fq * 8), boff = lds_byte(wc * 32 + fr, fq * 8);
#define PG8_SA(b, h) (((b) * 2 + (h)) * HTB)
#define PG8_SB(b, h) ((4 + (b) * 2 + (h)) * HTB)
#define PG8_STAGE(bufoff, gbase, v0, v1) do { \
        __builtin_amdgcn_global_load_lds((const unsigned*)((const char*)(gbase) + (v0)), (PG8_LAS unsigned*)(lds + (bufoff) + ldsw), 16, 0, 0); \
        __builtin_amdgcn_global_load_lds((const unsigned*)((const char*)(gbase) + (v1)), (PG8_LAS unsigned*)(lds + (bufoff) + ldsw + 8192), 16, 0, 0); } while (0)
#define PG8_STAGEB(bufoff, gbase) PG8_STAGE(bufoff, gbase, voffB[0], voffB[1])
#define PG8_STAGEA(bufoff, abase, h, VA) do { if constexpr (GATHER) { PG8_STAGE(bufoff, abase, VA[h][0], VA[h][1]); } else { PG8_STAGE(bufoff, (abase) + (h) * hstep, voffA[0], voffA[1]); } } while (0)
#define PG8_LDA(dst, b, h) do { _Pragma("unroll") for (int m = 0; m < 4; ++m) _Pragma("unroll") for (int k = 0; k < 2; ++k) dst[m][k] = *(const PG8_LAS bf16x8*)(lds + PG8_SA(b, h) + aoff + m * 2048 + k * 1024); } while (0)
#define PG8_LDB(dst, b, h) do { _Pragma("unroll") for (int n = 0; n < 2; ++n) _Pragma("unroll") for (int k = 0; k < 2; ++k) dst[n][k] = *(const PG8_LAS bf16x8*)(lds + PG8_SB(b, h) + boff + n * 2048 + k * 1024); } while (0)
#define PG8_MMA(ai, bj, At, Bt) do { __builtin_amdgcn_s_setprio(1); _Pragma("unroll") for (int m = 0; m < 4; ++m) _Pragma("unroll") for (int n = 0; n < 2; ++n) _Pragma("unroll") for (int k = 0; k < 2; ++k) \
        acc[ai][bj][m][n] = __builtin_amdgcn_mfma_f32_16x16x32_bf16(Bt[n][k], At[m][k], acc[ai][bj][m][n], 0, 0, 0); __builtin_amdgcn_s_setprio(0); } while (0)
#define PG8_WAIT_V(n) asm volatile("s_waitcnt vmcnt(" #n ")" ::: "memory")
#define PG8_WAIT_L(n) asm volatile("s_waitcnt lgkmcnt(" #n ")" ::: "memory")
#define PG8_BAR __builtin_amdgcn_s_barrier()
#define PG8_SCHED __builtin_amdgcn_sched_barrier(0)
#define PG8_AOFF(dst, ord) do { _Pragma("unroll") for (int h_ = 0; h_ < 2; ++h_) _Pragma("unroll") for (int i_ = 0; i_ < 2; ++i_) { \
        const int src_ = g.rowlds[(ord) * BM + h_ * HALF + RA[i_]]; dst[h_][i_] = (unsigned)(src_ * K + CA[i_]) * 2u; } } while (0)
    Unit cur, nxt; int ui = 0;
    if (!S.next(0, cur)) return;
    f32x4 acc[2][2][4][2];
#pragma unroll
    for (int a = 0; a < 2; ++a)
#pragma unroll
        for (int b = 0; b < 2; ++b)
#pragma unroll
            for (int m = 0; m < 4; ++m)
#pragma unroll
                for (int n = 0; n < 2; ++n) acc[a][b][m][n] = (f32x4){0.f, 0.f, 0.f, 0.f};
    bf16x8 At[4][2], B0[2][2], B1[2][2];
    unsigned vA[2][2], nvA[2][2];
    if constexpr (GATHER) { PG8_AOFF(vA, 0); }
    const char* cA = GATHER ? (const char*)g.A : (const char*)g.A + (size_t)cur.pm * tstep;
    const char* cB = (const char*)g.Bt + ((size_t)cur.e * g.nB + (size_t)cur.pn * BM) * K * 2;
    PG8_STAGEB(PG8_SB(0, 0), cB); PG8_STAGEB(PG8_SB(0, 1), cB + hstep); PG8_STAGEA(PG8_SA(0, 0), cA, 0, vA); PG8_STAGEA(PG8_SA(0, 1), cA, 1, vA);
    if (wr == 1) PG8_BAR;
    PG8_WAIT_V(2); PG8_BAR;
    PG8_STAGEB(PG8_SB(1, 0), cB + kstep); PG8_STAGEA(PG8_SA(1, 0), cA + kstep, 0, vA); PG8_STAGEB(PG8_SB(1, 1), cB + hstep + kstep);
    PG8_WAIT_V(6); PG8_BAR;
    for (;;) {
        const bool has_next = S.next(ui + 1, nxt);
        if constexpr (GATHER) { if (has_next) { PG8_AOFF(nvA, ui + 1); } else {
#pragma unroll
            for (int h_ = 0; h_ < 2; ++h_)
#pragma unroll
                for (int i_ = 0; i_ < 2; ++i_) nvA[h_][i_] = vA[h_][i_]; } }
        const char* nA = GATHER ? cA : (has_next ? (const char*)g.A + (size_t)nxt.pm * tstep : cA);
        const char* nB = has_next ? (const char*)g.Bt + ((size_t)nxt.e * g.nB + (size_t)nxt.pn * BM) * K * 2 : cB;
        for (int t = 0; t < nt; t += 2) {
            const bool last = (t == nt - 2);
            const char* a1 = cA + (size_t)(t + 1) * kstep;
            const char* a2 = last ? nA : cA + (size_t)(t + 2) * kstep; const char* b2 = last ? nB : cB + (size_t)(t + 2) * kstep;
            const char* a3 = a2 + kstep; const char* b3 = b2 + kstep;
            unsigned wv[2][2];
            if constexpr (GATHER) { wv[0][0] = last ? nvA[0][0] : vA[0][0]; wv[0][1] = last ? nvA[0][1] : vA[0][1]; wv[1][0] = last ? nvA[1][0] : vA[1][0]; wv[1][1] = last ? nvA[1][1] : vA[1][1]; }
            PG8_LDB(B0, 0, 0); PG8_LDB(B1, 0, 1); PG8_SCHED; PG8_LDA(At, 0, 0); PG8_STAGEA(PG8_SA(1, 1), a1, 1, vA);
            PG8_WAIT_V(8); PG8_WAIT_L(0); PG8_BAR; PG8_MMA(0, 0, At, B0); PG8_MMA(0, 1, At, B1); PG8_BAR; PG8_SCHED;
            PG8_LDA(At, 0, 1); PG8_STAGEB(PG8_SB(0, 0), b2); PG8_STAGEB(PG8_SB(0, 1), b2 + hstep); PG8_STAGEA(PG8_SA(0, 0), a2, 0, wv);
            PG8_WAIT_V(8); PG8_WAIT_L(0); PG8_BAR; PG8_MMA(1, 0, At, B0); PG8_MMA(1, 1, At, B1); PG8_BAR; PG8_SCHED;
            PG8_LDB(B0, 1, 0); PG8_LDB(B1, 1, 1); PG8_SCHED; PG8_LDA(At, 1, 0); PG8_STAGEA(PG8_SA(0, 1), a2, 1, wv);
            PG8_WAIT_V(8); PG8_WAIT_L(0); PG8_BAR; PG8_MMA(0, 0, At, B0); PG8_MMA(0, 1, At, B1); PG8_BAR; PG8_SCHED;
            PG8_LDA(At, 1, 1); PG8_STAGEB(PG8_SB(1, 0), b3); PG8_STAGEB(PG8_SB(1, 1), b3 + hstep); PG8_STAGEA(PG8_SA(1, 0), a3, 0, wv);
            PG8_WAIT_V(8); PG8_WAIT_L(0); PG8_BAR; PG8_MMA(1, 0, At, B0); PG8_MMA(1, 1, At, B1); PG8_BAR; PG8_SCHED;
        }
        if (wr == 0) PG8_BAR;
        E(acc, cur, wr, wc, fr, fq);
        if (!has_next) break;
#pragma unroll
        for (int a = 0; a < 2; ++a)
#pragma unroll
            for (int b = 0; b < 2; ++b)
#pragma unroll
                for (int m = 0; m < 4; ++m)
#pragma unroll
                    for (int n = 0; n < 2; ++n) acc[a][b][m][n] = (f32x4){0.f, 0.f, 0.f, 0.f};
        cur = nxt; cB = nB; cA = nA; ++ui;
        if constexpr (GATHER) {
#pragma unroll
        for (int h_ = 0; h_ < 2; ++h_)
#pragma unroll
            for (int i_ = 0; i_ < 2; ++i_) vA[h_][i_] = nvA[h_][i_]; }
        if (wr == 1) PG8_BAR;
    }
    PG8_WAIT_V(0);
    PG8_BAR;
#undef PG8_SA
#undef PG8_SB
#undef PG8_STAGE
#undef PG8_STAGEB
#undef PG8_STAGEA
#undef PG8_LDA
#undef PG8_LDB
#undef PG8_MMA
#undef PG8_WAIT_V
#undef PG8_WAIT_L
#undef PG8_BAR
#undef PG8_SCHED
#undef PG8_AOFF
}
}

namespace pg8 {
struct EpiIn {
    static constexpr bool PERM = true;
    bf16_t *Q, *Kb, *V, *PRW, *GT; float qscale;
    __device__ __forceinline__ void operator()(const f32x4 (&acc)[2][2][4][2], const Unit& u, int wr, int wc, int fr, int fq) const {
        const int pn = u.pn; bf16_t* base; int ld, colt, mode = 0;
        if (pn < 2) { base = Q; ld = 512; colt = pn * 256; mode = 1; }
        else if (pn < 4) { base = Kb; ld = 512; colt = (pn - 2) * 256; }
        else if (pn < 6) { base = V; ld = 512; colt = (pn - 4) * 256; }
        else if (pn < 13) { base = PRW; ld = 1792; colt = (pn - 6) * 256; }
        else { base = GT; ld = 2048; colt = (pn - 13) * 256; mode = 2; }
        const int row0 = u.pm * BM + wr * 64 + fr, col0 = colt + wc * 32 + 8 * fq;
        const float sc = (mode == 1) ? qscale : 1.0f;
#pragma unroll
        for (int ai = 0; ai < 2; ++ai)
#pragma unroll
            for (int m = 0; m < 4; ++m) { bf16_t* rowp = base + (size_t)(row0 + ai * HALF + m * 16) * ld + col0;
#pragma unroll
                for (int bj = 0; bj < 2; ++bj) { f32x4 v0 = acc[ai][bj][m][0] * sc, v1 = acc[ai][bj][m][1] * sc;
                    if (mode == 2) {
#pragma unroll
                        for (int e = 0; e < 4; ++e) { v0[e] = fsigmoid(v0[e]); v1[e] = fsigmoid(v1[e]); } }
                    u32x4 w; w.x = cvt_pk_bf16(v0[0], v0[1]); w.y = cvt_pk_bf16(v0[2], v0[3]); w.z = cvt_pk_bf16(v1[0], v1[1]); w.w = cvt_pk_bf16(v1[2], v1[3]);
                    *(u32x4*)(rowp + bj * HALF) = w; } }
    }
};
template <int MODE> struct EpiGate {
    static constexpr bool PERM = true;
    bf16_t* O; int ldo; const bf16_t* G; int ldg; int gcol0;
    __device__ __forceinline__ void operator()(const f32x4 (&acc)[2][2][4][2], const Unit& u, int wr, int wc, int fr, int fq) const {
        const int row0 = u.pm * BM + wr * 64 + fr, col0 = u.pn * BM + wc * 32 + 8 * fq;
#pragma unroll
        for (int ai = 0; ai < 2; ++ai)
#pragma unroll
            for (int m = 0; m < 4; ++m) { const size_t row = (size_t)(row0 + ai * HALF + m * 16); bf16_t* rowp = O + row * ldo + col0;
#pragma unroll
                for (int bj = 0; bj < 2; ++bj) { f32x4 v0 = acc[ai][bj][m][0], v1 = acc[ai][bj][m][1];
                    if (MODE >= 1) { const u32x4 gw = *(const u32x4*)(G + row * ldg + gcol0 + col0 + bj * HALF);
                        v0[0] *= bf_lo(gw.x); v0[1] *= bf_hi(gw.x); v0[2] *= bf_lo(gw.y); v0[3] *= bf_hi(gw.y); v1[0] *= bf_lo(gw.z); v1[1] *= bf_hi(gw.z); v1[2] *= bf_lo(gw.w); v1[3] *= bf_hi(gw.w); }
                    if (MODE == 2) { const u32x4 ow = *(const u32x4*)(rowp + bj * HALF);
                        v0[0] += bf_lo(ow.x); v0[1] += bf_hi(ow.x); v0[2] += bf_lo(ow.y); v0[3] += bf_hi(ow.y); v1[0] += bf_lo(ow.z); v1[1] += bf_hi(ow.z); v1[2] += bf_lo(ow.w); v1[3] += bf_hi(ow.w); }
                    u32x4 w; w.x = cvt_pk_bf16(v0[0], v0[1]); w.y = cvt_pk_bf16(v0[2], v0[3]); w.z = cvt_pk_bf16(v1[0], v1[1]); w.w = cvt_pk_bf16(v1[2], v1[3]);
                    *(u32x4*)(rowp + bj * HALF) = w; } }
    }
};
struct EpiRes {
    static constexpr bool PERM = true;
    const float* X; bf16_t* O; const float* gate; int seq; int gstride;
    __device__ __forceinline__ void operator()(const f32x4 (&acc)[2][2][4][2], const Unit& u, int wr, int wc, int fr, int fq) const {
        const int row0 = u.pm * BM + wr * 64 + fr, col0 = u.pn * BM + wc * 32 + 8 * fq;
        const float* gp = gate + (size_t)((u.pm * BM) / seq) * gstride + col0;
        f32x4 gv[2][2];
#pragma unroll
        for (int bj = 0; bj < 2; ++bj)
#pragma unroll
            for (int n = 0; n < 2; ++n) gv[bj][n] = *(const f32x4*)(gp + bj * HALF + n * 4);
#pragma unroll
        for (int ai = 0; ai < 2; ++ai)
#pragma unroll
            for (int m = 0; m < 4; ++m) { const size_t off = (size_t)(row0 + ai * HALF + m * 16) * 1024 + col0;
#pragma unroll
                for (int bj = 0; bj < 2; ++bj) { const f32x4 x0 = *(const f32x4*)(X + off + bj * HALF), x1 = *(const f32x4*)(X + off + bj * HALF + 4);
                    const f32x4 v0 = x0 + gv[bj][0] * acc[ai][bj][m][0], v1 = x1 + gv[bj][1] * acc[ai][bj][m][1];
                    u32x4 w; w.x = cvt_pk_bf16(v0[0], v0[1]); w.y = cvt_pk_bf16(v0[2], v0[3]); w.z = cvt_pk_bf16(v1[0], v1[1]); w.w = cvt_pk_bf16(v1[2], v1[3]);
                    *(u32x4*)(O + off + bj * HALF) = w; } }
    }
};
struct EpiSwiGLU {
    static constexpr bool PERM = true;
    bf16_t* H;
    __device__ __forceinline__ void operator()(const f32x4 (&acc)[2][2][4][2], const Unit& u, int wr, int wc, int fr, int fq) const {
        const int row0 = u.pm * BM + wr * 64 + fr, col0 = u.pn * HALF + wc * 32 + 8 * fq;
#pragma unroll
        for (int ai = 0; ai < 2; ++ai)
#pragma unroll
            for (int m = 0; m < 4; ++m) { bf16_t* rowp = H + (size_t)(row0 + ai * HALF + m * 16) * 512 + col0;
                f32x4 v0, v1;
#pragma unroll
                for (int e = 0; e < 4; ++e) { const float a0 = acc[ai][0][m][0][e], a1 = acc[ai][0][m][1][e];
                    v0[e] = a0 * fsigmoid(a0) * acc[ai][1][m][0][e]; v1[e] = a1 * fsigmoid(a1) * acc[ai][1][m][1][e]; }
                u32x4 w; w.x = cvt_pk_bf16(v0[0], v0[1]); w.y = cvt_pk_bf16(v0[2], v0[3]); w.z = cvt_pk_bf16(v1[0], v1[1]); w.w = cvt_pk_bf16(v1[2], v1[3]);
                *(u32x4*)rowp = w; }
    }
};
struct EpiFp8 {
    static constexpr bool PERM = true;
    unsigned char* O; int ldo;
    __device__ __forceinline__ void operator()(const f32x4 (&acc)[2][2][4][2], const Unit& u, int wr, int wc, int fr, int fq) const {
        const int row0 = u.pm * BM + wr * 64 + fr, col0 = u.pn * BM + wc * 32 + 8 * fq;
#pragma unroll
        for (int ai = 0; ai < 2; ++ai)
#pragma unroll
            for (int m = 0; m < 4; ++m) { unsigned char* rowp = O + (size_t)(row0 + ai * HALF + m * 16) * ldo + col0;
#pragma unroll
                for (int bj = 0; bj < 2; ++bj) { const f32x4 v0 = acc[ai][bj][m][0], v1 = acc[ai][bj][m][1];
                    int lo = __builtin_amdgcn_cvt_pk_fp8_f32(v0[0], v0[1], 0, false); lo = __builtin_amdgcn_cvt_pk_fp8_f32(v0[2], v0[3], lo, true);
                    int hi = __builtin_amdgcn_cvt_pk_fp8_f32(v1[0], v1[1], 0, false); hi = __builtin_amdgcn_cvt_pk_fp8_f32(v1[2], v1[3], hi, true);
                    *(u32x2*)(rowp + bj * HALF) = (u32x2){(unsigned)lo, (unsigned)hi}; } }
    }
};
struct MoeOrder {
    int nunits, G, c, cshift; const PG8_LAS int* tile_e;
    __device__ __forceinline__ bool next(int i, Unit& u) const {
        const int L = i * G + c; if (L >= nunits) return false;
        u.pm = L >> cshift; u.pn = L & ((1 << cshift) - 1); u.e = tile_e[u.pm]; return true;
    }
};
}
#include <hip/hip_bf16.h>
#include <cmath>
namespace attn_body {
using bf16=__hip_bfloat16;
using bf16x8=__attribute__((ext_vector_type(8)))short;
using s16x4=__attribute__((ext_vector_type(4)))short;
using f32x16=__attribute__((ext_vector_type(16)))float;
using u32x4=__attribute__((ext_vector_type(4)))unsigned;
constexpr int BATCH=2,NHEAD=8,SEQ=16384,D=64,DM=NHEAD*D;
constexpr int NW=8,QBLK=32,QB=QBLK*NW,KVBLK=64,NQB=SEQ/QB;
constexpr int ATTN_PITCH=DM, ATTN_UNIT_ROWS=QB;
__device__ __forceinline__ int crow(int r,int hi){return (r&3)+8*(r>>2)+4*hi;}
#define SBAR() __builtin_amdgcn_sched_barrier(0)
__device__ __forceinline__ void cmask(f32x16&p0,f32x16&p1,int jb,int qrel,int hi){
  const float NEG=-INFINITY; int x=qrel-64*jb-4*hi; asm volatile("":"+v"(x));
  #pragma unroll
  for(int r=0;r<16;++r){const int c=(r&3)+8*(r>>2); if(c>x)p0[r]=NEG; if(c+32>x)p1[r]=NEG;}
}

constexpr int NSLOT=3, SLOTB=8192;
constexpr int LDS_K=0, LDS_V=NSLOT*SLOTB, LDS_WS=2*NSLOT*SLOTB, LDS_OST=LDS_WS+NW*64*4, LDS_BYTES=LDS_OST+NW*4096;
constexpr float C2=0.125f*1.4426950408889634f;
__device__ __forceinline__ void glds16(const void*gsrc,unsigned lds_dst){unsigned keep;
  asm volatile("s_mov_b32 %0, m0\n\ts_mov_b32 m0, %2\n\ts_nop 0\n\tglobal_load_lds_dwordx4 %1, off\n\ts_mov_b32 m0, %0":"=&s"(keep):"v"(gsrc),"s"(lds_dst):"memory");}
__device__ __forceinline__ float max3f(float a,float b,float c){float r;asm("v_max3_f32 %0, %1, %2, %3":"=v"(r):"v"(a),"v"(b),"v"(c));return r;}
__device__ __forceinline__ float max2f(float a,float b){float r;asm("v_max_f32_e32 %0, %1, %2":"=v"(r):"v"(a),"v"(b));return r;}
__device__ __forceinline__ float fadd_s(float a,float b){float r;asm("v_add_f32_e32 %0, %1, %2":"=v"(r):"v"(a),"v"(b));return r;}
__device__ __forceinline__ float fsub_s(float a,float b){float r;asm("v_sub_f32_e32 %0, %1, %2":"=v"(r):"v"(a),"v"(b));return r;}
typedef float f32x2_t __attribute__((ext_vector_type(2))); typedef __bf16 bf16x2_t __attribute__((ext_vector_type(2)));
__device__ __forceinline__ unsigned cvtpk_s(float lo,float hi){f32x2_t v={lo,hi};bf16x2_t b=__builtin_convertvector(v,bf16x2_t);return __builtin_bit_cast(unsigned,b);}
#define WAIT_BAR(N) asm volatile("s_waitcnt vmcnt(" #N ") lgkmcnt(0)\n\ts_barrier":::"memory")

__device__ __forceinline__ void qkt(f32x16&p0,f32x16&p1,const char*Kslot,const bf16x8*qr,int r32,int hi){
  const char*kb=Kslot+hi*1024+r32*16;
  #pragma unroll
  for(int d0=0;d0<4;++d0){
    const bf16x8 b0=*reinterpret_cast<const bf16x8*>(kb+d0*2048);
    const bf16x8 b1=*reinterpret_cast<const bf16x8*>(kb+d0*2048+512);
    if(d0==0){p0=__builtin_amdgcn_mfma_f32_32x32x16_bf16(b0,qr[0],p0,0,0,0);p1=__builtin_amdgcn_mfma_f32_32x32x16_bf16(b1,qr[0],p1,0,0,0);}
    else{p0=__builtin_amdgcn_mfma_f32_32x32x16_bf16(b0,qr[d0],p0,0,0,0);p1=__builtin_amdgcn_mfma_f32_32x32x16_bf16(b1,qr[d0],p1,0,0,0);}}
}
typedef __attribute__((address_space(3))) const char* lds_cptr;
typedef short v4i16_t __attribute__((ext_vector_type(4)));
__device__ __forceinline__ void kload8(bf16x8*kf,lds_cptr kp){
  kf[0]=*(const __attribute__((address_space(3))) bf16x8*)(kp);      kf[1]=*(const __attribute__((address_space(3))) bf16x8*)(kp+512);
  kf[2]=*(const __attribute__((address_space(3))) bf16x8*)(kp+2048); kf[3]=*(const __attribute__((address_space(3))) bf16x8*)(kp+2560);
  kf[4]=*(const __attribute__((address_space(3))) bf16x8*)(kp+4096); kf[5]=*(const __attribute__((address_space(3))) bf16x8*)(kp+4608);
  kf[6]=*(const __attribute__((address_space(3))) bf16x8*)(kp+6144); kf[7]=*(const __attribute__((address_space(3))) bf16x8*)(kp+6656);
}
__device__ __forceinline__ void kload2(bf16x8*kf,lds_cptr kp,int j){ kf[2*j]=*(const __attribute__((address_space(3))) bf16x8*)(kp+j*2048); kf[2*j+1]=*(const __attribute__((address_space(3))) bf16x8*)(kp+j*2048+512); }
__device__ __forceinline__ s16x4 vtr(lds_cptr p){ return __builtin_bit_cast(s16x4,__builtin_amdgcn_ds_read_tr16_b64_v4i16((__attribute__((address_space(3))) v4i16_t*)p)); }
__device__ __forceinline__ float rowmax(const f32x16&p0,const f32x16&p1){
  float a=max3f(p0[0],p0[1],p1[0]),b=max3f(p0[2],p0[3],p1[1]);a=max3f(a,p1[2],p1[3]);
  #pragma unroll
  for(int r=4;r<16;r+=4){a=max3f(a,p0[r],p0[r+1]);b=max3f(b,p0[r+2],p0[r+3]);a=max3f(a,p1[r],p1[r+1]);b=max3f(b,p1[r+2],p1[r+3]);}
  const float m=max2f(a,b);
  auto rr=__builtin_amdgcn_permlane32_swap(__float_as_uint(m),__float_as_uint(m),false,false);
  return max2f(__uint_as_float(rr[0]),__uint_as_float(rr[1]));
}
__device__ __forceinline__ void pv(f32x16*o,int vb,bf16x8 pa0,bf16x8 pa1,bf16x8 pa2,bf16x8 pa3){
  #pragma unroll
  for(int d0=0;d0<2;++d0){s16x4 lo[4],hi[4];
    #pragma unroll
    for(int ks=0;ks<4;++ks){
      asm volatile("ds_read_b64_tr_b16 %0,%1 offset:%c2":"=&v"(lo[ks]):"v"(vb),"i"(d0*4096+ks*1024):"memory");
      asm volatile("ds_read_b64_tr_b16 %0,%1 offset:%c2":"=&v"(hi[ks]):"v"(vb),"i"(d0*4096+ks*1024+512):"memory");}
    asm volatile("s_waitcnt lgkmcnt(0)":::"memory");SBAR();
    #define PK(k) (bf16x8){lo[k][0],lo[k][1],lo[k][2],lo[k][3],hi[k][0],hi[k][1],hi[k][2],hi[k][3]}
    o[d0]=__builtin_amdgcn_mfma_f32_32x32x16_bf16(pa0,PK(0),o[d0],0,0,0);
    o[d0]=__builtin_amdgcn_mfma_f32_32x32x16_bf16(pa1,PK(1),o[d0],0,0,0);
    o[d0]=__builtin_amdgcn_mfma_f32_32x32x16_bf16(pa2,PK(2),o[d0],0,0,0);
    o[d0]=__builtin_amdgcn_mfma_f32_32x32x16_bf16(pa3,PK(3),o[d0],0,0,0);
    #undef PK
  }
}

#ifndef ATTN_STORE16
#define ATTN_STORE16(p,v) (*(u32x4*)(p)=(v))
#endif
typedef float f32x4_t __attribute__((ext_vector_type(4)));
#define NBLD(dst,off) dst=*(const __attribute__((address_space(3))) f32x4_t*)(tbn_+(off))
#define NBSUB(P,b,src) do{ P[(b)]=nmn_-src[0]; P[(b)+1]=nmn_-src[1]; P[(b)+2]=nmn_-src[2]; P[(b)+3]=nmn_-src[3]; }while(0)
#define NEXTB(P0,P1,tt) do{ const __attribute__((address_space(3))) float* tb_=tab3+(tt)*64+4*hi; const float nm_=-mhat; \
  _Pragma("unroll") for(int g_=0;g_<4;++g_){ const f32x4_t b0_=*(const __attribute__((address_space(3))) f32x4_t*)(tb_+8*g_); const f32x4_t b1_=*(const __attribute__((address_space(3))) f32x4_t*)(tb_+32+8*g_); \
    _Pragma("unroll") for(int j_=0;j_<4;++j_){ P0[4*g_+j_]=nm_-b0_[j_]; P1[4*g_+j_]=nm_-b1_[j_]; } } }while(0)
template<int THRL> __device__ __forceinline__ void attn_unit(int b,int h,int qb,int t0,const bf16*Q,const bf16*__restrict__ K,const bf16*__restrict__ V,bf16*O,const float*__restrict__ cumT,char*shm,int tab_off,int segp_off,unsigned*qctr){
  const int tid=threadIdx.x,lane=tid&63,r32=lane&31,hi=lane>>5; const int wid=__builtin_amdgcn_readfirstlane(tid>>6);
  const long rowbase=(long)b*SEQ; const int q0=qb*QB;
  const bf16*Qw=Q+(rowbase+q0+wid*QBLK)*DM+h*D;
  const bf16*Kh=K+(rowbase+(long)t0*KVBLK)*DM+h*D,*Vh=V+(rowbase+(long)t0*KVBLK)*DM+h*D;
  const unsigned lds0=(unsigned)(uintptr_t)shm;
  float*wsf=(float*)(shm+LDS_WS)+wid*64;
  const bf16*ksrc=Kh+(long)lane*DM+wid*8;
  const bf16*vsrc=Vh+(long)(16*(wid&3)+(lane>>2))*DM+(wid>>2)*32+(lane&3)*8;
  const unsigned kdst=lds0+LDS_K+wid*1024, vdst=lds0+LDS_V+wid*1024;
  #define DMA_K(t,slot) glds16(ksrc+(long)(t)*KVBLK*DM,(unsigned)__builtin_amdgcn_readfirstlane(kdst+(slot)))
  #define DMA_V(t,slot) glds16(vsrc+(long)(t)*KVBLK*DM,(unsigned)__builtin_amdgcn_readfirstlane(vdst+(slot)))
  const int vb0=(int)(lds0+LDS_V)+((lane>>4)&1)*32+(lane&3)*8+(4*hi+((lane&15)>>2))*64;
  const char*Kbase=shm+LDS_K; bf16x8 kf[8];
  const lds_cptr shm3=(lds_cptr)shm; const lds_cptr kp0=shm3+LDS_K+hi*1024+r32*16; const lds_cptr vp0=shm3+LDS_V+((lane>>4)&1)*32+(lane&3)*8+(4*hi+((lane&15)>>2))*64;
  const int NT=(q0+QB)/KVBLK-t0;
  const __attribute__((address_space(3))) float* tab3=(const __attribute__((address_space(3))) float*)(shm3+tab_off);
  { int tl_=threadIdx.x; asm volatile("":"+v"(tl_));
    float*tabw=(float*)(shm+tab_off); const float L2E=1.4426950408889634f;
    const float*cg=cumT+((long)(b*NHEAD+h))*SEQ; const float cref=cg[q0]*L2E;
    for(int i=tl_;i<NT*KVBLK;i+=NW*64){ const int kv=t0*KVBLK+i; tabw[i]=cg[kv]*L2E-cref; }
    asm volatile("s_waitcnt vmcnt(0) lgkmcnt(0)\n\ts_barrier":::"memory"); }
  DMA_K(0,0);DMA_V(0,0);DMA_K(1,SLOTB);
  bf16x8 qr[4];
  #pragma unroll
  for(int d0=0;d0<4;++d0)qr[d0]=*reinterpret_cast<const bf16x8*>(&Qw[(long)r32*DM+d0*16+hi*8]);
  float mhat=0.f,l_reg=0.f;f32x16 o[2];o[0]=f32x16{};o[1]=f32x16{};
  const int qrel=wid*QBLK+r32;
  #define CMASK(P0,P1,t) do{int jb_=(t)-(NT-4); if(jb_>=0)cmask(P0,P1,jb_,qrel,hi);}while(0)
  bool resc=false;
  #define START(P0,P1) do{ const float rm=rowmax(P0,P1); resc=false; \
    { const float dl=rm; mhat=fadd_s(mhat,dl); \
      _Pragma("unroll") for(int r=0;r<16;++r){P0[r]=fsub_s(P0[r],dl);P1[r]=fsub_s(P1[r],dl);} \
      } \
    _Pragma("unroll") for(int r=0;r<16;++r)P0[r]=__builtin_amdgcn_exp2f(P0[r]); }while(0)
  #define RESC() do{ if(resc){ asm volatile("s_waitcnt lgkmcnt(0)":::"memory"); \
      _Pragma("unroll") for(int d_=0;d_<2;++d_) _Pragma("unroll") for(int r=0;r<16;++r)o[d_][r]*=wsf[crow(r,hi)]; } }while(0)
  f32x16 pA0,pA1,pB0,pB1;
  int sl_prev=0,sl_cur=0,sl_next=SLOTB;
  #define ROT() do{sl_prev=sl_cur;sl_cur=sl_next;sl_next=(sl_next==(NSLOT-1)*SLOTB)?0:sl_next+SLOTB;}while(0)
  DMA_K(2,2*SLOTB);
  WAIT_BAR(3);
  NEXTB(pA0,pA1,0);
  qkt(pA0,pA1,Kbase,qr,r32,hi);asm volatile("s_nop 15\n\ts_nop 7":"+v"(pA0),"+v"(pA1));CMASK(pA0,pA1,0);
  START(pA0,pA1);
  NEXTB(pB0,pB1,1);
  _Pragma("unroll") for(int r=0;r<16;++r)pA1[r]=__builtin_amdgcn_exp2f(pA1[r]);
  WAIT_BAR(0);
  DMA_K(3,0);DMA_V(1,SLOTB);
  ROT();
  kload8(kf,kp0+sl_cur);
  WAIT_BAR(2);
  s16x4 vlo[8],vhi[8]; u32x4 pw0,pw1,pw2,pw3;
  #define PKW(P,B) cvtpk_s(P[B],P[B+1])
  #define PAF(k) __builtin_bit_cast(bf16x8,pw##k)
  #define VFR(i) (bf16x8){vlo[i][0],vlo[i][1],vlo[i][2],vlo[i][3],vhi[i][0],vhi[i][1],vhi[i][2],vhi[i][3]}
  #define PIN(x) asm volatile("":"+v"(x))
  #define MX3(a,b,c) __builtin_fmaxf(__builtin_fmaxf((a),(b)),(c))
  #define GAPA(MF,A0,A1,A2,A3,W0,W1,PW) do{ MF; sacc+=A0; sacc+=A1; sacc+=A2; sacc+=A3; PIN(sacc); W0; W1; PIN(PW); SBAR(); }while(0)
  #define EX(v) __builtin_amdgcn_exp2f(v)
  #define GAPB(MF,X,B) do{ MF; X[B]=EX(X[B]); X[B+1]=EX(X[B+1]); X[B+2]=EX(X[B+2]); X[B+3]=EX(X[B+3]); PIN(X); SBAR(); }while(0)
  #define VRD(i) do{ vlo[i]=vtr(vp_+(((i)>>2)*4096+((i)&3)*1024)); vhi[i]=vtr(vp_+(((i)>>2)*4096+((i)&3)*1024+512)); }while(0)
  #define KRD(G,j) do{ if(G){ kload2(kf,kp0+sl_next,j); SBAR(); } }while(0)
  #define STEP(C0,C1,P0,P1,t,GK,GV,GL) do{ SBAR(); \
    const lds_cptr vp_=vp0+sl_prev; \
    VRD(0); SBAR(); float sacc=(P0[0]+P0[1]); \
    GAPA(C0=__builtin_amdgcn_mfma_f32_32x32x16_bf16(kf[0],qr[0],C0,0,0,0), P0[2],P0[3],P0[4],P0[5],     pw0[0]=PKW(P0,0), pw0[1]=PKW(P0,2), pw0); \
    VRD(4); SBAR(); GAPA(C1=__builtin_amdgcn_mfma_f32_32x32x16_bf16(kf[1],qr[0],C1,0,0,0), P0[6],P0[7],P0[8],P0[9],     pw0[2]=PKW(P0,4), pw0[3]=PKW(P0,6), pw0); \
    VRD(1); SBAR(); GAPA(C0=__builtin_amdgcn_mfma_f32_32x32x16_bf16(kf[2],qr[1],C0,0,0,0),   P0[10],P0[11],P0[12],P0[13], pw1[0]=PKW(P0,8), pw1[1]=PKW(P0,10), pw1); \
    VRD(5); SBAR(); GAPA(C1=__builtin_amdgcn_mfma_f32_32x32x16_bf16(kf[3],qr[1],C1,0,0,0),   P0[14],P0[15],P1[0],P1[1],   pw1[2]=PKW(P0,12),pw1[3]=PKW(P0,14), pw1); \
    VRD(2); SBAR(); GAPA(C0=__builtin_amdgcn_mfma_f32_32x32x16_bf16(kf[4],qr[2],C0,0,0,0),   P1[2],P1[3],P1[4],P1[5],     pw2[0]=PKW(P1,0), pw2[1]=PKW(P1,2), pw2); \
    VRD(6); SBAR(); GAPA(C1=__builtin_amdgcn_mfma_f32_32x32x16_bf16(kf[5],qr[2],C1,0,0,0),   P1[6],P1[7],P1[8],P1[9],     pw2[2]=PKW(P1,4), pw2[3]=PKW(P1,6), pw2); \
    VRD(3); SBAR(); GAPA(C0=__builtin_amdgcn_mfma_f32_32x32x16_bf16(kf[6],qr[3],C0,0,0,0),   P1[10],P1[11],P1[12],P1[13], pw3[0]=PKW(P1,8), pw3[1]=PKW(P1,10), pw3); \
    VRD(7); SBAR(); GAPA(C1=__builtin_amdgcn_mfma_f32_32x32x16_bf16(kf[7],qr[3],C1,0,0,0),   P1[14],P1[15],0.f,0.f,       pw3[2]=PKW(P1,12),pw3[3]=PKW(P1,14), pw3); \
    l_reg+=sacc; \
    if(GK){DMA_K((t)+3,sl_cur);} if(GV){DMA_V((t)+1,sl_next);} \
    CMASK(C0,C1,t); \
    { float a=MX3(C0[0],C0[1],C1[0]),b=MX3(C0[2],C0[3],C1[1]); a=MX3(a,C1[2],C1[3]); \
      _Pragma("unroll") for(int r=4;r<16;r+=4){a=MX3(a,C0[r],C0[r+1]);b=MX3(b,C0[r+2],C0[r+3]);a=MX3(a,C1[r],C1[r+1]);b=MX3(b,C1[r+2],C1[r+3]);} \
      float rm=__builtin_fmaxf(a,b); { auto rr=__builtin_amdgcn_permlane32_swap(__float_as_uint(rm),__float_as_uint(rm),false,false); rm=__builtin_fmaxf(__uint_as_float(rr[0]),__uint_as_float(rr[1])); } \
      resc=false; \
      if(__builtin_expect(__any(rm>(float)THRL),0)){ const float dl=__builtin_fmaxf(rm,0.f); mhat+=dl; \
        _Pragma("unroll") for(int r=0;r<16;++r){C0[r]-=dl;C1[r]-=dl;} \
        const float f=__builtin_amdgcn_exp2f(-dl); l_reg*=f; if(hi==0)wsf[r32]=f; resc=true; } } \
      \
    const __attribute__((address_space(3))) float* tbn_=tab3+((t)+1)*64+4*hi; const float nmn_=-mhat; f32x4_t nbA_,nbB_; \
    SBAR(); \
    if(GL){NBLD(nbA_,0);} GAPB(o[0]=__builtin_amdgcn_mfma_f32_32x32x16_bf16(PAF(0),VFR(0),o[0],0,0,0), C0,0); \
    if(GL){NBLD(nbB_,8); NBSUB(P0,0,nbA_);} GAPB(o[1]=__builtin_amdgcn_mfma_f32_32x32x16_bf16(PAF(0),VFR(4),o[1],0,0,0), C0,4); \
    if(GL){NBLD(nbA_,16); NBSUB(P0,4,nbB_);} KRD(GL,0); GAPB(o[0]=__builtin_amdgcn_mfma_f32_32x32x16_bf16(PAF(1),VFR(1),o[0],0,0,0), C0,8); \
    if(GL){NBLD(nbB_,24); NBSUB(P0,8,nbA_);} KRD(GL,1); GAPB(o[1]=__builtin_amdgcn_mfma_f32_32x32x16_bf16(PAF(1),VFR(5),o[1],0,0,0), C0,12); \
    if(GL){NBLD(nbA_,32); NBSUB(P0,12,nbB_);} KRD(GL,2); GAPB(o[0]=__builtin_amdgcn_mfma_f32_32x32x16_bf16(PAF(2),VFR(2),o[0],0,0,0), C1,0); \
    if(GL){NBLD(nbB_,40); NBSUB(P1,0,nbA_);} KRD(GL,3); GAPB(o[1]=__builtin_amdgcn_mfma_f32_32x32x16_bf16(PAF(2),VFR(6),o[1],0,0,0), C1,4); \
    if(GL){NBLD(nbA_,48); NBSUB(P1,4,nbB_);} GAPB(o[0]=__builtin_amdgcn_mfma_f32_32x32x16_bf16(PAF(3),VFR(3),o[0],0,0,0), C1,8); \
    if(GL){NBLD(nbB_,56); NBSUB(P1,8,nbA_);} GAPB(o[1]=__builtin_amdgcn_mfma_f32_32x32x16_bf16(PAF(3),VFR(7),o[1],0,0,0), C1,12); \
    if(GL){NBSUB(P1,12,nbB_);} \
    }while(0)
  int t=1;
  #undef CMASK
  #define CMASK(P0,P1,t) do{}while(0)
  for(;t+5<NT;t+=2){
    STEP(pB0,pB1,pA0,pA1,t,true,true,true);     WAIT_BAR(2); RESC(); ROT();
    STEP(pA0,pA1,pB0,pB1,t+1,true,true,true);   WAIT_BAR(2); RESC(); ROT();
  }
  #undef CMASK
  #define CMASK(P0,P1,t) do{int jb_=(t)-(NT-4); if(jb_>=0)cmask(P0,P1,jb_,qrel,hi);}while(0)
  #define ENDW(tt) do{ if((tt)+3<NT){WAIT_BAR(2);} else if((tt)+2<NT){WAIT_BAR(1);} else {WAIT_BAR(0);} }while(0)
  for(;t+1<NT;t+=2){
    STEP(pB0,pB1,pA0,pA1,t,(t+3<NT),(t+1<NT),(t+1<NT));       ENDW(t);   RESC(); ROT();
    STEP(pA0,pA1,pB0,pB1,t+1,(t+4<NT),(t+2<NT),(t+2<NT));     ENDW(t+1); RESC(); ROT();
  }
  STEP(pB0,pB1,pA0,pA1,NT-1,false,false,false); RESC();
  { float sacc=pB0[0]+pB0[1]; _Pragma("unroll") for(int r=2;r<16;++r)sacc+=pB0[r]; _Pragma("unroll") for(int r=0;r<16;++r)sacc+=pB1[r]; l_reg+=sacc;
    pw0=(u32x4){PKW(pB0,0),PKW(pB0,2),PKW(pB0,4),PKW(pB0,6)};pw1=(u32x4){PKW(pB0,8),PKW(pB0,10),PKW(pB0,12),PKW(pB0,14)};pw2=(u32x4){PKW(pB1,0),PKW(pB1,2),PKW(pB1,4),PKW(pB1,6)};pw3=(u32x4){PKW(pB1,8),PKW(pB1,10),PKW(pB1,12),PKW(pB1,14)};
    SBAR(); pv(o,vb0+sl_cur,PAF(0),PAF(1),PAF(2),PAF(3)); }
  #undef PKW
  #undef PAF
  #undef VFR
  #undef PIN
  #undef MX3
  #undef GAPA
  #undef GAPB
  #undef EX
  #undef VRD
  #undef KRD
  #undef STEP
  #undef ENDW
  {auto rr=__builtin_amdgcn_permlane32_swap(__float_as_uint(l_reg),__float_as_uint(l_reg),false,false);l_reg=__uint_as_float(rr[0])+__uint_as_float(rr[1]);}
  int un_=0; if(threadIdx.x==0)un_=(int)__hip_atomic_fetch_add(qctr,1u,__ATOMIC_RELAXED,__HIP_MEMORY_SCOPE_AGENT);
  int lane_e=threadIdx.x&63; asm volatile("":"+v"(lane_e));
  const int r32e=lane_e&31,hie=lane_e>>5;
  if(hie==0)wsf[32+r32e]=l_reg;asm volatile("s_waitcnt lgkmcnt(0)":::"memory");
  float rli[16];
  #pragma unroll
  for(int r=0;r<16;++r)rli[r]=__builtin_amdgcn_rcpf(wsf[32+crow(r,hie)]);
  bf16*Ow=O+(rowbase+q0+wid*QBLK)*DM+h*D;
  { bf16*stg=(bf16*)(shm+LDS_OST)+wid*2048;
    #pragma unroll
    for(int r=0;r<16;++r){const int orow=crow(r,hie);
      #pragma unroll
      for(int d0=0;d0<2;++d0)stg[orow*64+d0*32+r32e]=__float2bfloat16(o[d0][r]*rli[r]);}
    asm volatile("s_waitcnt lgkmcnt(0)":::"memory");
    #pragma unroll
    for(int i=0;i<4;++i){const int row=i*8+(lane_e>>3),ch=lane_e&7; const u32x4 v=*(const u32x4*)(stg+row*64+ch*8); ATTN_STORE16(Ow+(long)row*DM+ch*8,v);} }
  if(threadIdx.x==0)*(volatile int*)(shm+segp_off)=un_;
  asm volatile("s_waitcnt lgkmcnt(0)\n\ts_barrier":::"memory");
  #undef DMA_K
  #undef DMA_V
  #undef CMASK
  #undef START
  #undef RESC
  #undef ROT
}
constexpr int ATTN_LDS_BYTES=LDS_BYTES;
struct AttnTensors { const bf16* Q; const bf16* K; const bf16* V; bf16* O; const float* cumT; const float* segtot; };
struct AttnUnit { int bh; int qb; };
struct StaticOrder {
  int vcu;
  __device__ __forceinline__ explicit StaticOrder(int grid,int block):vcu((block%8)*(grid/8)+block/8){}
  __device__ __forceinline__ bool next(int i,AttnUnit&u)const{ if(i>=4||vcu>=256)return false; const int s=vcu&15; u.bh=vcu>>4; u.qb=(i==0)?63-s:(i==1)?32+s:(i==2)?31-s:s; return true; }
  __device__ __forceinline__ void a_ready(const AttnUnit&)const{}
  __device__ __forceinline__ void done(const AttnUnit&)const{}
};
constexpr float PRUNE_THR=20.0f;
template<int THRL=8> __device__ __forceinline__ void attn_phase_dyn(char*lds,const AttnTensors&T,unsigned*ctr,const unsigned*qkmax,const unsigned*ktmax,int tab_off,int segp_off){
  volatile int*slot=(volatile int*)(lds+segp_off);
  __syncthreads();
  if(threadIdx.x==0)slot[0]=(int)__hip_atomic_fetch_add(ctr,1u,__ATOMIC_RELAXED,__HIP_MEMORY_SCOPE_AGENT);
  __syncthreads();
  for(;;){
    int tid=threadIdx.x; asm volatile("":"+v"(tid));
    const int u=slot[0]; if(u>=BATCH*NHEAD*NQB)break;
    const int bh=u&15, qb=(NQB-1)-(u>>4), b=bh/NHEAD, h=bh%NHEAD, q0=qb*QB;
    const float qm=__uint_as_float(qkmax[bh*2]), km=__uint_as_float(qkmax[bh*2+1]);
    const float L2E=1.4426950408889634f; const float*cg=T.cumT+((long)(b*NHEAD+h))*SEQ;
    const float cgk=cg[(tid<4*qb)?64*tid+63:q0], cg0=cg[q0];
    const float kt2=__uint_as_float(ktmax[bh*256+((tid<4*qb)?tid:0)]);
    float dg, qg;
    { const int row=tid>>1, hf=tid&1; const long ro=((long)b*SEQ+q0+row)*DM+h*D+32*hf; const u32x4*qp=(const u32x4*)(T.Q+ro); const u32x4*kp=(const u32x4*)(T.K+ro); float d=0.f, qq=0.f;
      #pragma unroll
      for(int c4=0;c4<4;++c4){ const u32x4 qa=qp[c4], ka=kp[c4];
        #pragma unroll
        for(int e=0;e<4;++e){ const float q0_=__uint_as_float(qa[e]<<16), q1_=__uint_as_float(qa[e]&0xffff0000u); d+=q0_*__uint_as_float(ka[e]<<16)+q1_*__uint_as_float(ka[e]&0xffff0000u); qq+=q0_*q0_+q1_*q1_; } }
      d+=__shfl_xor(d,1); qq+=__shfl_xor(qq,1);
      #pragma unroll
      for(int o=2;o<64;o<<=1){ d=fminf(d,__shfl_xor(d,o)); qq=fmaxf(qq,__shfl_xor(qq,o)); }
      dg=d; qg=qq; }
    float*slotf=(float*)(lds+segp_off)+16;
    if((tid&63)==0){ slotf[tid>>6]=dg; slotf[8+(tid>>6)]=qg; }
    __syncthreads();
    float dmin=slotf[0], qmu=slotf[8];
    #pragma unroll
    for(int w=1;w<NW;++w){ dmin=fminf(dmin,slotf[w]); qmu=fmaxf(qmu,slotf[8+w]); }
    (void)qm; (void)km;
    const float X=PRUNE_THR+sqrtf(qmu*kt2)-dmin+1.5f;
    const bool keep=(tid<4*qb)&&!((cgk-cg0)*L2E>X);
    const unsigned long long bal=__ballot(keep); if((tid&63)==0)slot[1+(tid>>6)]=bal?((tid>>6)*64+(int)__builtin_ctzll(bal)):4*qb;
    __syncthreads();
    int t0=4*qb;
    #pragma unroll
    for(int w=0;w<NW;++w){ const int f_=slot[1+w]; t0=f_<t0?f_:t0; }
    t0&=~1;
    attn_unit<THRL>(b,h,qb,t0,T.Q,T.K,T.V,T.O,T.cumT,lds,tab_off,segp_off,ctr);
  }
}
#undef SBAR
#undef WAIT_BAR
}
#define GAS __attribute__((address_space(1)))
#define LAS __attribute__((address_space(3)))
typedef unsigned short bf16;
typedef unsigned v4u __attribute__((ext_vector_type(4)));
typedef float f32x4 __attribute__((ext_vector_type(4)));
typedef short bf16x8 __attribute__((ext_vector_type(8)));
typedef GAS unsigned gu32;
typedef GAS unsigned long long gu64;
#define RLX_AGENT __ATOMIC_RELAXED, __HIP_MEMORY_SCOPE_AGENT
#define LDS_WAIT() asm volatile("s_waitcnt lgkmcnt(0)" ::: "memory")
#define VM_WAIT() asm volatile("s_waitcnt vmcnt(0)" ::: "memory")
__device__ __forceinline__ unsigned long long rt() { return __builtin_amdgcn_s_memrealtime(); }
typedef float pk_f32x2 __attribute__((ext_vector_type(2))); typedef __bf16 pk_bf16x2 __attribute__((ext_vector_type(2)));
__device__ __forceinline__ unsigned pk2(float lo, float hi) { pk_f32x2 v = {lo, hi}; pk_bf16x2 b = __builtin_convertvector(v, pk_bf16x2); return __builtin_bit_cast(unsigned, b); }
__device__ __forceinline__ unsigned f2bf(float f) { return pk2(f, 0.f) & 0xffffu; }

#define XB_TMO      128
#define XB_XCNT(j)  (256  + 64 * (j))
#define XB_XSUB(j)  (1280 + 64 * (j))
#define XB_XGEN(j)  (2304 + 64 * (j))
#define XB_TOP      3328
#define XB_TOPGEN   3392
#define XCD_BAR_WORDS 3456
#define XB_SPIN_CAP (1u << 18)

__device__ __forceinline__ unsigned xb_ld(unsigned* p)              { return __hip_atomic_load(p, __ATOMIC_RELAXED, __HIP_MEMORY_SCOPE_AGENT); }
__device__ __forceinline__ unsigned xb_add(unsigned* p, unsigned v) { return __hip_atomic_fetch_add(p, v, __ATOMIC_RELAXED, __HIP_MEMORY_SCOPE_AGENT); }
__device__ __forceinline__ unsigned xb_xcc_id() { return (unsigned)__builtin_amdgcn_s_getreg((3 << 11) | 20) & 0xFu; }
#define XB_SPIN(cond, bar) do { unsigned _sp = 0; while (cond) { __builtin_amdgcn_s_sleep(1); \
    if ((++_sp & 255u) == 0u) { if (xb_ld(&(bar)[XB_TMO])) break; if (_sp > XB_SPIN_CAP) { atomicAdd(&(bar)[XB_TMO], 1u); break; } } } } while (0)

struct XcdBarrier {
    unsigned* bar; unsigned x;
    volatile LAS unsigned* st;
};

__device__ __forceinline__ XcdBarrier xcd_barrier_post(unsigned* bar, volatile LAS unsigned* st) {
    XcdBarrier b; b.bar = bar; b.x = xb_xcc_id(); b.st = st;
    if (threadIdx.x == 0) (void)xb_add(&bar[XB_XCNT(b.x)], 1u);
    return b;
}
__device__ __forceinline__ void xcd_barrier_complete(unsigned* bar, unsigned x, unsigned& nloc, unsigned& nx) {
    const unsigned G = gridDim.x * gridDim.y * gridDim.z;
    unsigned sum, cnt, mine, sp = 0u;
    for (;;) {
        sum = 0u; cnt = 0u; mine = 0u;
#pragma unroll
        for (unsigned j = 0; j < 16; ++j) { const unsigned c = xb_ld(&bar[XB_XCNT(j)]); sum += c; cnt += (c > 0u) ? 1u : 0u; mine = (j == x) ? c : mine; }
        if (sum == G) break;
        __builtin_amdgcn_s_sleep(1);
        if ((++sp & 255u) == 0u) { if (xb_ld(&bar[XB_TMO])) break; if (sp > XB_SPIN_CAP) { atomicAdd(&bar[XB_TMO], 1u); break; } }
    }
    nloc = mine > 0u ? mine : 1u; nx = cnt > 0u ? cnt : 1u;
}

__device__ __forceinline__ void xcd_barrier(const XcdBarrier& b) {
    asm volatile("s_waitcnt vmcnt(0)" ::: "memory");
    __syncthreads();
    if (threadIdx.x == 0) {
        unsigned* bar = b.bar;
        __builtin_amdgcn_s_waitcnt(0);
        unsigned nloc = b.st[0], nx = b.st[1];
        if (nloc == 0u) { xcd_barrier_complete(bar, b.x, nloc, nx); b.st[0] = nloc; b.st[1] = nx; }
        const unsigned old = xb_add(&bar[XB_XSUB(b.x)], 1u);
        const unsigned gen = old / nloc;
        if (old + 1u == (gen + 1u) * nloc) {
            __builtin_amdgcn_fence(__ATOMIC_RELEASE, "agent");
            asm volatile("s_waitcnt vmcnt(0)" ::: "memory");
            const unsigned og = xb_add(&bar[XB_TOP], 1u);
            const unsigned tg = og / nx;
            if (og + 1u == (tg + 1u) * nx) xb_add(&bar[XB_TOPGEN], 1u);
            else XB_SPIN(xb_ld(&bar[XB_TOPGEN]) == tg, bar);
            __builtin_amdgcn_fence(__ATOMIC_ACQUIRE, "agent");
            xb_add(&bar[XB_XGEN(b.x)], 1u);
            asm volatile("s_waitcnt vmcnt(0)" ::: "memory");
        } else {
            XB_SPIN(xb_ld(&bar[XB_XGEN(b.x)]) == gen, bar);
            __builtin_amdgcn_fence(__ATOMIC_ACQUIRE, "agent");
            asm volatile("s_waitcnt vmcnt(0)" ::: "memory");
        }
    }
    __syncthreads();
}

constexpr int NWAVES = 8;
constexpr int BATCH = 2, SEQ = 16384, D = 1024, M = BATCH * SEQ;
constexpr int FH = 8, FW = 512, RWW = 512, SHW = 1792, DIN = 5384, NIN = 5376;
constexpr int NE = 32, DE = 512, NROUTE = 36;
constexpr int MAXSLOT = 2 * M + NE * 256;
constexpr int MAXTILE = MAXSLOT / 256;
constexpr float ATT_C2 = 0.125f * 1.4426950408889634f;

constexpr size_t MiB = 1u << 20;
constexpr size_t WS_CTL = 0, CTL_ZERO_BYTES = 1 * MiB;
constexpr size_t WS_MOD = 1 * MiB;
constexpr size_t WS_SEGTOT = 1 * MiB + 64 * 1024;
constexpr size_t WS_BLKCNT = 1 * MiB + 96 * 1024;
constexpr size_t WS_WIN = 2 * MiB;
constexpr size_t WS_WOF = 13 * MiB, WS_WOR = 14 * MiB, WS_WO = 15 * MiB;
constexpr size_t WS_LW2 = 17 * MiB, WS_LA2 = 17 * MiB + 64 * 1024, WS_LG2 = 17 * MiB + 128 * 1024;
constexpr size_t WS_CUM = 18 * MiB;
constexpr size_t WS_ROUTE = 19 * MiB;
constexpr size_t WS_ROWTOK = 20 * MiB;
constexpr size_t WS_BON = 21 * MiB;
constexpr size_t WS_XN = 24 * MiB;
constexpr size_t WS_Q = 88 * MiB, WS_K = 120 * MiB, WS_V = 152 * MiB;
constexpr size_t WS_PRW = 184 * MiB;
constexpr size_t WS_GATES = 296 * MiB;
constexpr size_t WS_F = 424 * MiB;
constexpr size_t WS_END = 512 * MiB;
constexpr size_t WS_Y = WS_K;
constexpr size_t WS_H = WS_Q;
constexpr size_t WS_W13 = WS_PRW, WS_W2T = WS_PRW + 64 * MiB;
constexpr size_t WS_TMP = WS_PRW;
constexpr size_t WS_YM = 280 * MiB;
constexpr size_t WS_X1 = 424 * MiB;
static_assert(WS_YM + (size_t)MAXSLOT * 1024 * 2 <= WS_END, "ws map");
static_assert(WS_H + (size_t)MAXSLOT * 512 * 2 <= WS_PRW, "ws map");
constexpr int CW_TMO = 0, CW_CODE = 1;
constexpr int CW_BAR = 4096;
constexpr int CW_QKMAX = 8192;
constexpr int CW_QUEUE = 8448;
constexpr int CW_KTMAX = 12288;
constexpr int CW_DIAG = 8704;

constexpr int RING_OFF = 0, RING_BYTES = 131072;
constexpr int TAB_OFF = 83968;
constexpr int SEGP_OFF = TAB_OFF + 65536;
constexpr int TILE_OFF = 131072;
constexpr int LDSCTL_OFF = SEGP_OFF + 512, MISC_OFF = LDSCTL_OFF + 320;
constexpr int LDS_BYTES = LDSCTL_OFF + 512;
static_assert(attn_body::LDS_BYTES <= TAB_OFF, "attention LDS");


#define PHASE_IDS() int tid_ = threadIdx.x; asm volatile("" : "+v"(tid_)); const int lane_ = tid_ & 63; const int wave_ = __builtin_amdgcn_readfirstlane(tid_ >> 6); (void)lane_; (void)wave_
struct Frame {
    LAS unsigned char* lds;
    volatile LAS unsigned* MISC;
    gu32* ctl;
    int tid, lane, wave;
    int vcu, G;
    const float* const* in;
};
template <int CTRL> __device__ __forceinline__ float dpp_f(float v) { return __int_as_float(__builtin_amdgcn_mov_dpp(__float_as_int(v), CTRL, 0xf, 0xf, true)); }
__device__ __forceinline__ float row_sum16(float v) { v += dpp_f<0xB1>(v); v += dpp_f<0x4E>(v); v += dpp_f<0x141>(v); v += dpp_f<0x140>(v); return v; }
__device__ __forceinline__ float wave_sum(float v) { v = row_sum16(v); v += __shfl_xor(v, 16); v += __shfl_xor(v, 32); return v; }
__device__ __forceinline__ float bflo(unsigned w) { return __uint_as_float(w << 16); }
__device__ __forceinline__ float bfhi(unsigned w) { return __uint_as_float(w & 0xffff0000u); }
__device__ __forceinline__ float sigm(float x) { return 1.0f / (1.0f + __expf(-x)); }

__device__ __forceinline__ void transpose_item(const float* W, int ld, int col, int k0, int K, bf16* WT, size_t drow, LAS float* scr, int lane) {
#pragma unroll 8
    for (int i = 0; i < 32; ++i) { const int kk = 2 * i + (lane >> 5); scr[kk * 33 + (lane & 31)] = W[(size_t)(k0 + kk) * ld + col + (lane & 31)]; }
    LDS_WAIT(); asm volatile("" ::: "memory");
    const int c = lane & 7;
#pragma unroll
    for (int j = 0; j < 4; ++j) { const int n = (lane >> 3) + 8 * j; const LAS float* s = scr + (8 * c) * 33 + n;
        v4u o; o.x = pk2(s[0 * 33], s[1 * 33]); o.y = pk2(s[2 * 33], s[3 * 33]); o.z = pk2(s[4 * 33], s[5 * 33]); o.w = pk2(s[6 * 33], s[7 * 33]);
        *(GAS v4u*)(WT + (drow + n) * K + k0 + 8 * c) = o; }
    LDS_WAIT(); asm volatile("" ::: "memory");
}
__device__ __forceinline__ void conv_seg(Frame& F, const float* W, int ld, int col0, int K, int ncols, bf16* WT, size_t drow0) {
    PHASE_IDS();
    LAS float* scr = (LAS float*)(F.lds + RING_OFF + wave_ * 16384);
    const int gw = F.vcu * NWAVES + wave_, NGW = F.G * NWAVES, nkb = K / 64, nnb = ncols / 32;
    for (int it = gw; it < nkb * nnb; it += NGW) { const int kb = it / nnb, nb = it % nnb; transpose_item(W, ld, col0 + 32 * nb, 64 * kb, K, WT, drow0 + 32 * nb, scr, lane_); }
}

struct Args { const float* in[30]; float* out; unsigned char* ws; };

__device__ __forceinline__ void p0_prologue(Frame& F, const Args& A) {
    PHASE_IDS();
    unsigned char* ws = A.ws;
    if (blockIdx.x < 96) {
        const float* c = A.in[1]; const float* aw = A.in[2]; const float* ab = A.in[3];
        const int col = blockIdx.x * 64 + lane_; float a0 = 0.f, a1 = 0.f;
        const int kbeg = wave_ * 128;
#pragma unroll 8
        for (int k = kbeg; k < kbeg + 128; ++k) { const float wv = aw[(size_t)k * 6144 + col]; const float c0 = c[k], c1 = c[1024 + k];
            a0 += c0 * sigm(c0) * wv; a1 += c1 * sigm(c1) * wv; }
        LAS float* red = (LAS float*)(F.lds + 8 * 16384 - 4096);
        red[(wave_ * 2 + 0) * 64 + lane_] = a0; red[(wave_ * 2 + 1) * 64 + lane_] = a1;
        __syncthreads();
        if (wave_ < 2) { float s = 0.f;
#pragma unroll
            for (int w = 0; w < 8; ++w) s += red[(w * 2 + wave_) * 64 + lane_];
            ((float*)(ws + WS_MOD))[wave_ * 6144 + col] = s + ab[col]; }
        __syncthreads();
    }
}

__device__ __forceinline__ void p_convert_early(Frame& F, const Args& A) {
    unsigned char* ws = A.ws;
    const float* w_in = A.in[5];
    conv_seg(F, w_in, DIN, 0, 1024, 1536, (bf16*)(ws + WS_WIN), 0);
    conv_seg(F, w_in, DIN, 1544, 1024, 1792, (bf16*)(ws + WS_WIN), 1536);
    conv_seg(F, w_in, DIN, 3336, 1024, 2048, (bf16*)(ws + WS_WIN), 3328);
    conv_seg(F, A.in[18], 1024, 0, 512, 1024, (bf16*)(ws + WS_WOF), 0);
    conv_seg(F, A.in[19], 1024, 0, 512, 1024, (bf16*)(ws + WS_WOR), 0);
    conv_seg(F, A.in[20], 1024, 0, 1024, 1024, (bf16*)(ws + WS_WO), 0);
    conv_seg(F, A.in[9], 512, 0, 64, 512, (bf16*)(ws + WS_LW2), 0);
    conv_seg(F, A.in[11], 512, 0, 64, 512, (bf16*)(ws + WS_LA2), 0);
    conv_seg(F, A.in[12], 512, 0, 128, 512, (bf16*)(ws + WS_LG2), 0);
}

__device__ __forceinline__ void p1_norm(Frame& F, const Args& A) {
    PHASE_IDS();
    unsigned char* ws = A.ws;
    LAS float* wf = (LAS float*)(F.lds);
    LAS float* lfl = (LAS float*)(F.lds + 32768);
    LAS float* part = (LAS float*)(F.lds + 32768 + 4096);
    const float* x = A.in[0]; const float* g1 = A.in[4]; const float* w_in = A.in[5]; const float* fb = A.in[6];
    const float* mod = (const float*)(ws + WS_MOD);
    bf16* XN = (bf16*)(ws + WS_XN); float* cumT = (float*)(ws + WS_CUM); float* segtot = (float*)(ws + WS_SEGTOT);
    for (int i = tid_; i < 8192; i += NWAVES * 64) wf[(i & 7) * 1024 + (i >> 3)] = w_in[(size_t)(i >> 3) * DIN + 1536 + (i & 7)];
    __syncthreads();
    for (int blk = blockIdx.x; blk < M / 128; blk += F.G) {
        const int b = blk / (SEQ / 128);
        f32x4 gm[4], sh[4];
#pragma unroll
        for (int j = 0; j < 4; ++j) { const int col = 4 * lane_ + 256 * j; const f32x4 g = *(const f32x4*)(g1 + col), sc = *(const f32x4*)(mod + b * 6144 + 1024 + col);
            gm[j] = g * (sc + 1.0f); sh[j] = *(const f32x4*)(mod + b * 6144 + col); }
        float fbv = fb[((lane_ >> 5) & 1) * 4 + ((lane_ >> 4) & 1) * 2 + ((lane_ >> 3) & 1)];
        f32x4 nv[4];
        { const GAS f32x4* xr0 = (const GAS f32x4*)(x + ((size_t)blk * 128 + wave_ * 16) * D) + lane_;
#pragma unroll
          for (int j = 0; j < 4; ++j) nv[j] = xr0[64 * j]; }
        for (int i = 0; i < 16; ++i) {
            const int tl = wave_ * 16 + i; const size_t tok = (size_t)blk * 128 + tl;
            f32x4 v[4]; float s = 0.f;
#pragma unroll
            for (int j = 0; j < 4; ++j) { v[j] = nv[j]; s += (v[j].x * v[j].x + v[j].y * v[j].y) + (v[j].z * v[j].z + v[j].w * v[j].w); }
            { const GAS f32x4* xr = (const GAS f32x4*)(x + (tok + ((i + 1 < 16) ? 1 : 0)) * D) + lane_;
#pragma unroll
                for (int j = 0; j < 4; ++j) nv[j] = xr[64 * j]; }
            const float rstd = 1.0f / sqrtf(wave_sum(s) * (1.f / D) + 1e-6f);
            GAS unsigned long long* o8 = (GAS unsigned long long*)(XN + tok * D) + lane_;
            float f[8];
#pragma unroll
            for (int hh = 0; hh < 8; ++hh) f[hh] = 0.f;
#pragma unroll
            for (int j = 0; j < 4; ++j) { v[j] = v[j] * rstd * gm[j] + sh[j];
                o8[64 * j] = (unsigned long long)pk2(v[j].x, v[j].y) | ((unsigned long long)pk2(v[j].z, v[j].w) << 32);
#pragma unroll
                for (int hh = 0; hh < 8; ++hh) { const f32x4 w4 = *(const LAS f32x4*)(wf + hh * 1024 + 4 * lane_ + 256 * j); f[hh] += (v[j].x * w4.x + v[j].y * w4.y) + (v[j].z * w4.z + v[j].w * w4.w); } }
            float g4[4], g2v[2], z;
            { const bool up = (lane_ & 32) != 0;
#pragma unroll
              for (int i = 0; i < 4; ++i) { const float keep = up ? f[4 + i] : f[i], send = up ? f[i] : f[4 + i]; g4[i] = keep + __shfl_xor(send, 32); } }
            { const bool up = (lane_ & 16) != 0;
#pragma unroll
              for (int i = 0; i < 2; ++i) { const float keep = up ? g4[2 + i] : g4[i], send = up ? g4[i] : g4[2 + i]; g2v[i] = keep + __shfl_xor(send, 16); } }
            { const bool up = (lane_ & 8) != 0; const float keep = up ? g2v[1] : g2v[0], send = up ? g2v[0] : g2v[1]; z = keep + __shfl_xor(send, 8); }
            z += __shfl_xor(z, 1); z += __shfl_xor(z, 2); z += __shfl_xor(z, 4);
            const int myh = ((lane_ >> 5) & 1) * 4 + ((lane_ >> 4) & 1) * 2 + ((lane_ >> 3) & 1);
            z += fbv;
            const float lf = (z >= 0.f) ? -log1pf(__expf(-z)) : z - log1pf(__expf(z));
            if ((lane_ & 7) == 0) lfl[tl * 8 + myh] = lf;
        }
        __syncthreads();
        const int hh = tid_ & 7, p = tid_ >> 3;
        if (tid_ < 64) { float run = 0.f; for (int i = 0; i < 16; ++i) { run += lfl[(p * 16 + i) * 8 + hh]; lfl[(p * 16 + i) * 8 + hh] = run; } part[p * 8 + hh] = run; }
        __syncthreads();
        if (tid_ < 64) { float off = 0.f; for (int q = 0; q < p; ++q) off += part[q * 8 + hh];
            const int t0 = (blk % (SEQ / 128)) * 128 + p * 16; float* dst = cumT + ((size_t)(b * 8 + hh)) * SEQ + t0;
            for (int i = 0; i < 16; ++i) dst[i] = lfl[(p * 16 + i) * 8 + hh] + off;
            if (p == 7) segtot[blk * 8 + hh] = off + part[7 * 8 + hh]; }
        __syncthreads();
    }
}


__device__ __forceinline__ void p_cumfix(Frame& F, const Args& A) {
    PHASE_IDS();
    unsigned char* ws = A.ws; float* cumT = (float*)(ws + WS_CUM); const float* segtot = (const float*)(ws + WS_SEGTOT);
    LAS float* pre = (LAS float*)(F.lds);
    for (int blk = blockIdx.x; blk < M / 128; blk += F.G) {
        const int b = blk / (SEQ / 128), seg = blk % (SEQ / 128);
        __syncthreads();
        if (tid_ < 64) { const int hh = tid_ & 7, part = tid_ >> 3; float a = 0.f; for (int s = part; s < seg; s += 8) a += segtot[(b * 128 + s) * 8 + hh];
            a += __shfl_xor(a, 8); a += __shfl_xor(a, 16); a += __shfl_xor(a, 32); if (part == 0) pre[hh] = a; }
        __syncthreads();
        for (int i = tid_; i < 8 * 128; i += NWAVES * 64) { const int hh = i >> 7, t = i & 127; cumT[((size_t)(b * 8 + hh)) * SEQ + seg * 128 + t] += pre[hh]; }
    }
}
__device__ __forceinline__ void p_qknorm(Frame& F, const Args& A, unsigned* qkmax, unsigned* ktmax) {
    PHASE_IDS();
    unsigned char* ws = A.ws; const bf16* Q = (const bf16*)(ws + WS_Q); const bf16* K = (const bf16*)(ws + WS_K);
    const int gw = F.vcu * NWAVES + wave_, NGW = F.G * NWAVES, hd = lane_ >> 3;
    for (int g = gw; g < M / 16; g += NGW) { const int m0 = 16 * g, b = m0 / SEQ, tile = (m0 % SEQ) >> 6; float mq = 0.f, mk = 0.f;
#pragma unroll 4
        for (int i = 0; i < 16; ++i) { const size_t m = (size_t)(m0 + i);
            const v4u qw = *(const v4u*)(Q + m * 512 + 8 * lane_), kw = *(const v4u*)(K + m * 512 + 8 * lane_);
            float sq = 0.f, sk = 0.f;
#pragma unroll
            for (int e = 0; e < 4; ++e) { const float a = bflo(qw[e]), c = bfhi(qw[e]), d = bflo(kw[e]), f = bfhi(kw[e]); sq += a * a + c * c; sk += d * d + f * f; }
            sq += dpp_f<0xB1>(sq); sq += dpp_f<0x4E>(sq); sq += dpp_f<0x141>(sq);
            sk += dpp_f<0xB1>(sk); sk += dpp_f<0x4E>(sk); sk += dpp_f<0x141>(sk);
            mq = fmaxf(mq, sq); mk = fmaxf(mk, sk); }
        if ((lane_ & 7) == 0) { const int bh = b * 8 + hd;
            atomicMax(qkmax + bh * 2, __float_as_uint(mq)); atomicMax(qkmax + bh * 2 + 1, __float_as_uint(mk)); atomicMax(ktmax + bh * 256 + tile, __float_as_uint(mk)); } }
}

template <int WITH_MOE>
__device__ __forceinline__ void p_final(Frame& F, const Args& A, const float* src) {
    PHASE_IDS();
    unsigned char* ws = A.ws; const float* fg = A.in[29]; const float* mod = (const float*)(ws + WS_MOD);
    const int* route = (const int*)(ws + WS_ROUTE); const bf16* Y = (const bf16*)(ws + WS_YM);
    f32x4 fgv[4];
#pragma unroll
    for (int j = 0; j < 4; ++j) fgv[j] = *(const f32x4*)(fg + 4 * lane_ + 256 * j);
    const int gw = F.vcu * NWAVES + wave_, NGW = F.G * NWAVES;
    for (int m = gw; m < M; m += NGW) {
        f32x4 v[4]; float s = 0.f;
        if (WITH_MOE) { const GAS unsigned long long* xb = (const GAS unsigned long long*)((const bf16*)(ws + WS_X1) + (size_t)m * D) + lane_;
#pragma unroll
            for (int j = 0; j < 4; ++j) { const unsigned long long a = xb[64 * j]; const unsigned al = (unsigned)a, ah = (unsigned)(a >> 32); v[j] = (f32x4){bflo(al), bfhi(al), bflo(ah), bfhi(ah)}; } }
        else { const GAS f32x4* xr = (const GAS f32x4*)(src + (size_t)m * D) + lane_;
#pragma unroll
            for (int j = 0; j < 4; ++j) v[j] = xr[64 * j]; }
        if (WITH_MOE) {
            const int b = m / SEQ; const int* rt_ = route + (size_t)m * 8;
            const float w0 = __int_as_float(rt_[2]), w1 = __int_as_float(rt_[3]); const int s0 = rt_[6], s1 = rt_[7];
            const GAS unsigned* y0 = (const GAS unsigned*)((const unsigned char*)Y + (size_t)s0 * D) + lane_; const GAS unsigned* y1 = (const GAS unsigned*)((const unsigned char*)Y + (size_t)s1 * D) + lane_;
#pragma unroll
            for (int j = 0; j < 4; ++j) { const int a = (int)y0[64 * j], c = (int)y1[64 * j]; const f32x4 g2 = *(const f32x4*)(mod + b * 6144 + 5120 + 4 * lane_ + 256 * j);
                f32x4 y; y.x = w0 * __builtin_amdgcn_cvt_f32_fp8(a, 0) + w1 * __builtin_amdgcn_cvt_f32_fp8(c, 0); y.y = w0 * __builtin_amdgcn_cvt_f32_fp8(a, 1) + w1 * __builtin_amdgcn_cvt_f32_fp8(c, 1);
                y.z = w0 * __builtin_amdgcn_cvt_f32_fp8(a, 2) + w1 * __builtin_amdgcn_cvt_f32_fp8(c, 2); y.w = w0 * __builtin_amdgcn_cvt_f32_fp8(a, 3) + w1 * __builtin_amdgcn_cvt_f32_fp8(c, 3);
                v[j] = v[j] + g2 * y; }
        }
#pragma unroll
        for (int j = 0; j < 4; ++j) s += (v[j].x * v[j].x + v[j].y * v[j].y) + (v[j].z * v[j].z + v[j].w * v[j].w);
        float rstd = 1.0f / sqrtf(wave_sum(s) * (1.f / D) + 1e-6f);
        if (WITH_MOE == 2) { if (((const unsigned*)(ws + WS_CTL))[CW_DIAG]) rstd = 0.f; }
        GAS f32x4* o = (GAS f32x4*)(A.out + (size_t)m * D) + lane_;
#pragma unroll
        for (int j = 0; j < 4; ++j) o[64 * j] = v[j] * rstd * fgv[j];
    }
}

typedef float f32x16 __attribute__((ext_vector_type(16)));
typedef unsigned u32x2 __attribute__((ext_vector_type(2)));
__device__ __forceinline__ f32x4 shift4(const bf16* p, bool has_prev, const float* mu) {
    const u32x2 c = *(const u32x2*)p; u32x2 q = *(const u32x2*)(has_prev ? p - SHW : p); if (!has_prev) q = (u32x2){0u, 0u};
    const f32x4 m = *(const f32x4*)mu;
    f32x4 cv = {bflo(c.x), bfhi(c.x), bflo(c.y), bfhi(c.y)}, pv = {bflo(q.x), bfhi(q.x), bflo(q.y), bfhi(q.y)};
    return cv + (pv - cv) * m;
}
__device__ __forceinline__ u32x2 pack4(f32x4 v) { u32x2 r; r.x = pk2(v.x, v.y); r.y = pk2(v.z, v.w); return r; }

__device__ __forceinline__ float fsig(float x) { return __builtin_amdgcn_rcpf(1.0f + __builtin_amdgcn_exp2f(-1.4426950408889634f * x)); }
__device__ __forceinline__ float ftanh(float x) { const float xc = fminf(fmaxf(x, -15.f), 15.f); return 1.0f - 2.0f * __builtin_amdgcn_rcpf(1.0f + __builtin_amdgcn_exp2f(2.8853900817779268f * xc)); }
__device__ __forceinline__ float half_sum32(float v) { v = row_sum16(v); v += __shfl_xor(v, 16); return v; }
__device__ __forceinline__ void shift2(const bf16* p, bool has_prev, const float (&mu)[2], float (&o)[2]) {
    const unsigned c = *(const unsigned*)p; unsigned q = *(const unsigned*)(has_prev ? p - SHW : p); if (!has_prev) q = 0u;
    const float c0 = bflo(c), c1 = bfhi(c); o[0] = c0 + (bflo(q) - c0) * mu[0]; o[1] = c1 + (bfhi(q) - c1) * mu[1];
}
template <int VAR> __device__ __forceinline__ void rwkv_pre(Frame& F, const Args& A, int ci_lo, int ci_hi) {
    PHASE_IDS();
    unsigned char* ws = A.ws;
    const bf16* PRW = (const bf16*)(ws + WS_PRW);
    const float* mu = A.in[7]; const float* w0 = A.in[8]; const float* a0 = A.in[10]; const float* k_k = A.in[13]; const float* k_a = A.in[14]; const float* r_k = A.in[15];
    const bf16* LW2 = (const bf16*)(ws + WS_LW2); const bf16* LA2 = (const bf16*)(ws + WS_LA2); const bf16* LG2 = (const bf16*)(ws + WS_LG2);
    bf16* R = (bf16*)((unsigned char*)A.out + 64 * MiB); bf16* KP = (bf16*)((unsigned char*)A.out + 96 * MiB);
    bf16* VV = (bf16*)(ws + WS_XN); bf16* AV = (bf16*)(ws + WS_XN + 32 * MiB); bf16* BV = (bf16*)(ws + WS_F); bf16* GG = (bf16*)(ws + WS_F + 32 * MiB);
    float* BON = (float*)(ws + WS_BON);
    LAS bf16* Xw = (LAS bf16*)(F.lds); LAS bf16* Xa = (LAS bf16*)(F.lds + 9216); LAS bf16* Xg = (LAS bf16*)(F.lds + 18432);
    const int h = wave_;
    for (int ci = ci_lo; ci < ci_hi; ci += F.G) {
        __syncthreads();
        {
            int tl_ = threadIdx.x; asm volatile("" : "+v"(tl_));
            const int row = tl_ >> 3, cg = tl_ & 7; const size_t tok = (size_t)ci * 64 + row; const bool hp = (tok % SEQ) != 0;
            const bf16* src = PRW + tok * SHW + 1536 + 32 * cg; const float* mup = mu + 1536 + 32 * cg;
            LAS bf16* dst = (cg < 2) ? (Xw + row * 72 + 32 * cg) : (cg < 4) ? (Xa + row * 72 + 32 * (cg - 2)) : (Xg + row * 136 + 32 * (cg - 4));
#pragma unroll
            for (int q = 0; q < 8; ++q) { f32x4 v = shift4(src + 4 * q, hp, mup + 4 * q);
                if (cg < 2) { v.x = ftanh(v.x); v.y = ftanh(v.y); v.z = ftanh(v.z); v.w = ftanh(v.w); }
                else if (cg >= 4) { v.x = fsig(v.x); v.y = fsig(v.y); v.z = fsig(v.z); v.w = fsig(v.w); }
                *(LAS u32x2*)(dst + 4 * q) = pack4(v); }
        }
        __syncthreads();
        int ln_ = threadIdx.x & 63; asm volatile("" : "+v"(ln_));
        const int c = ln_ & 31, hh = ln_ >> 5, colb = 64 * h + 2 * c;
    float mur[2], muk[2], muv[2], kkc[2], kac[2], rkc[2], a0c[2], w0c[2];
#pragma unroll
    for (int e = 0; e < 2; ++e) { mur[e] = mu[colb + e]; muk[e] = mu[512 + colb + e]; muv[e] = mu[1024 + colb + e]; kkc[e] = k_k[colb + e]; kac[e] = k_a[colb + e]; rkc[e] = r_k[colb + e]; a0c[e] = a0[colb + e]; w0c[e] = w0[colb + e]; }
        float carry[2] = {0.f, 0.f};
#pragma unroll 1
        for (int tb = 0; tb < ((VAR == 3) ? 0 : 2); ++tb) {
            f32x16 aa[2], aw[2], ag[2];
            aa[0] = f32x16{}; aa[1] = f32x16{}; aw[0] = f32x16{}; aw[1] = f32x16{}; ag[0] = f32x16{}; ag[1] = f32x16{};
            if (VAR != 4) {
#pragma unroll
            for (int ks = 0; ks < 4; ++ks) { const bf16x8 afr = *(const LAS bf16x8*)(Xa + (32 * tb + c) * 72 + 16 * ks + 8 * hh), wfr = *(const LAS bf16x8*)(Xw + (32 * tb + c) * 72 + 16 * ks + 8 * hh);
#pragma unroll
                for (int jb = 0; jb < 2; ++jb) { const bf16x8 b1 = *(const bf16x8*)(LA2 + (size_t)(colb + jb) * 64 + 16 * ks + 8 * hh), b2 = *(const bf16x8*)(LW2 + (size_t)(colb + jb) * 64 + 16 * ks + 8 * hh);
                    aa[jb] = __builtin_amdgcn_mfma_f32_32x32x16_bf16(afr, b1, aa[jb], 0, 0, 0); aw[jb] = __builtin_amdgcn_mfma_f32_32x32x16_bf16(wfr, b2, aw[jb], 0, 0, 0); } }
#pragma unroll
            for (int ks = 0; ks < 8; ++ks) { const bf16x8 gfr = *(const LAS bf16x8*)(Xg + (32 * tb + c) * 136 + 16 * ks + 8 * hh);
#pragma unroll
                for (int jb = 0; jb < 2; ++jb) { const bf16x8 b3 = *(const bf16x8*)(LG2 + (size_t)(colb + jb) * 128 + 16 * ks + 8 * hh); ag[jb] = __builtin_amdgcn_mfma_f32_32x32x16_bf16(gfr, b3, ag[jb], 0, 0, 0); } }
            }
            unsigned gpk[16], apk[16];
#pragma unroll
            for (int reg = 0; reg < 16; ++reg) { gpk[reg] = pk2(ag[0][reg], ag[1][reg]); apk[reg] = pk2(fsig(a0c[0] + aa[0][reg]), fsig(a0c[1] + aa[1][reg])); }
            float G2[2][16], gb[2][4];
#pragma unroll
            for (int e = 0; e < 2; ++e) {
#pragma unroll
                for (int reg = 0; reg < 16; ++reg) { const float z = -(w0c[e] + aw[e][reg]);
                    const float sp = fmaxf(z, 0.f) + 0.6931471805599453f * __builtin_amdgcn_logf(1.0f + __builtin_amdgcn_exp2f(-1.4426950408889634f * fabsf(z)));
                    G2[e][reg] = -1.4426950408889634f * __builtin_amdgcn_exp2f(-1.4426950408889634f * (sp + 0.5f)); }
                float run = carry[e];
#pragma unroll
                for (int q = 0; q < 4; ++q) { G2[e][4 * q + 1] += G2[e][4 * q]; G2[e][4 * q + 2] += G2[e][4 * q + 1]; G2[e][4 * q + 3] += G2[e][4 * q + 2];
                    const float s_ = G2[e][4 * q + 3], sp_ = __shfl_xor(s_, 32); const float base = run + (hh ? sp_ : 0.f); gb[e][q] = base;
#pragma unroll
                    for (int x = 0; x < 4; ++x) G2[e][4 * q + x] += base;
                    run += s_ + sp_; }
                carry[e] = run; }
            float egp[2] = {0.f, 0.f};
            unsigned rawc[16][3], rawq[4][3];
#pragma unroll
            for (int reg = 0; reg < 16; ++reg) { const int t = 32 * tb + (reg & 3) + 8 * (reg >> 2) + 4 * hh; const size_t tok = (size_t)ci * 64 + t; const bool hp = (tok % SEQ) != 0;
                const bf16* prow = PRW + tok * SHW + colb; const bf16* pprev = hp ? prow - SHW : prow;
#pragma unroll
                for (int x = 0; x < 3; ++x) { if (VAR == 2) { rawc[reg][x] = 0x3f803f80u + reg; if ((reg & 3) == 0) rawq[reg >> 2][x] = 0x3f803f80u; } else { rawc[reg][x] = *(const unsigned*)(prow + 512 * x); if ((reg & 3) == 0) { const unsigned q = *(const unsigned*)(pprev + 512 * x); rawq[reg >> 2][x] = hp ? q : 0u; } } } }
#pragma unroll
            for (int reg = 0; reg < 16; ++reg) { const int t = 32 * tb + (reg & 3) + 8 * (reg >> 2) + 4 * hh; *(unsigned*)((unsigned char*)GG + ((unsigned)(ci * 64 + t) * 1024u + (unsigned)colb * 2u)) = gpk[reg]; }
#pragma unroll
            for (int reg = 0; reg < 16; ++reg) {
                const int t = 32 * tb + (reg & 3) + 8 * (reg >> 2) + 4 * hh; const size_t tok = (size_t)ci * 64 + t;
                unsigned rawp_[3];
#pragma unroll
                for (int x = 0; x < 3; ++x) rawp_[x] = ((reg & 3) == 0) ? rawq[reg >> 2][x] : rawc[(reg + 15) & 15][x];
                float kx[2], rx[2], vx[2];
                { const unsigned cc_ = rawc[reg][0], pp_ = rawp_[0]; const float c0 = bflo(cc_), c1 = bfhi(cc_); rx[0] = c0 + (bflo(pp_) - c0) * mur[0]; rx[1] = c1 + (bfhi(pp_) - c1) * mur[1]; }
                { const unsigned cc_ = rawc[reg][1], pp_ = rawp_[1]; const float c0 = bflo(cc_), c1 = bfhi(cc_); kx[0] = c0 + (bflo(pp_) - c0) * muk[0]; kx[1] = c1 + (bfhi(pp_) - c1) * muk[1]; }
                { const unsigned cc_ = rawc[reg][2], pp_ = rawp_[2]; const float c0 = bflo(cc_), c1 = bfhi(cc_); vx[0] = c0 + (bflo(pp_) - c0) * muv[0]; vx[1] = c1 + (bfhi(pp_) - c1) * muv[1]; }
                const float as0 = bflo(apk[reg]), as1 = bfhi(apk[reg]);
                const float kr0 = kx[0] * kkc[0], kr1 = kx[1] * kkc[1];
                const float ss = half_sum32(kr0 * kr0 + kr1 * kr1); const float inv = __builtin_amdgcn_rsqf(fmaxf(ss, 1e-24f));
                const float kk0 = kr0 * inv, kk1 = kr1 * inv, kp0 = kx[0] * (1.0f + (as0 - 1.0f) * kac[0]), kp1 = kx[1] * (1.0f + (as1 - 1.0f) * kac[1]);
                const float bon = half_sum32(rx[0] * kp0 * rkc[0] + rx[1] * kp1 * rkc[1]);
                float eg[2], en[2], ea[2];
#pragma unroll
                for (int e = 0; e < 2; ++e) { eg[e] = __builtin_amdgcn_exp2f(G2[e][reg]); en[e] = __builtin_amdgcn_rcpf(eg[e]); ea[e] = ((reg & 3) == 0) ? __builtin_amdgcn_exp2f(gb[e][reg >> 2]) : egp[e]; egp[e] = eg[e]; }
                const unsigned ob = (unsigned)tok * 1024u + (unsigned)colb * 2u;
                if (VAR == 0) {
                *(unsigned*)((unsigned char*)R + ob) = pk2(rx[0] * eg[0], rx[1] * eg[1]); *(unsigned*)((unsigned char*)KP + ob) = pk2(kp0 * en[0], kp1 * en[1]); *(unsigned*)((unsigned char*)VV + ob) = pk2(vx[0], vx[1]);
                *(unsigned*)((unsigned char*)AV + ob) = pk2(-kk0 * ea[0], -kk1 * ea[1]); *(unsigned*)((unsigned char*)BV + ob) = pk2(kk0 * as0 * en[0], kk1 * as1 * en[1]);
                if (c == 0) BON[tok * 8 + h] = bon;
                }
                if ((reg & 3) == 3) __builtin_amdgcn_sched_barrier(0);
            }
        }
        if (hh == 0) { const int item = (((ci >> 8) * 8 + h) << 8) + (ci & 255); *(float2*)((unsigned char*)A.out + 32 * MiB + (size_t)item * 256 + (size_t)c * 8) = make_float2(__builtin_amdgcn_exp2f(carry[0]), __builtin_amdgcn_exp2f(carry[1])); }
    }
}

__device__ __forceinline__ void rwkv_scan_seq(Frame& F, const Args& A) {
    PHASE_IDS();
    if (blockIdx.x >= BATCH * 8) return;
    unsigned char* ws = A.ws;
    const float* LW = (const float*)A.out; const bf16* R = (const bf16*)((unsigned char*)A.out + 64 * MiB); const bf16* KP = (const bf16*)((unsigned char*)A.out + 96 * MiB);
    const bf16* VV = (const bf16*)(ws + WS_XN); const bf16* AV = (const bf16*)(ws + WS_XN + 32 * MiB); const bf16* BV = (const bf16*)(ws + WS_F);
    float* Y = (float*)(ws + WS_Y);
    const int b = blockIdx.x >> 3, h = blockIdx.x & 7;
    constexpr int STEPB = 896, CH = 16, BUFB = STEPB * CH;
    LAS unsigned char* buf = F.lds;
    const size_t tok0 = (size_t)b * SEQ;
    const bool loader = wave_ >= 4; const int lt = tid_ - 256;
    auto load_chunk = [&](int cidx, int slot) {
        for (int p = lt; p < CH * 56; p += 256) { const int s = p / 56, q = p % 56; const size_t tok = tok0 + (size_t)cidx * CH + s; v4u val;
            if (q < 16) val = *(const v4u*)(LW + tok * 512 + 64 * h + 4 * q);
            else { const int a = (q - 16) >> 3, o8 = (q - 16) & 7; const bf16* src = (a == 0) ? AV : (a == 1) ? BV : (a == 2) ? KP : (a == 3) ? R : VV; val = *(const v4u*)(src + tok * 512 + 64 * h + 8 * o8); }
            *(LAS v4u*)(buf + slot * BUFB + s * STEPB + q * 16) = val; }
    };
    if (loader) load_chunk(0, 0);
    __syncthreads();
    float S[16];
#pragma unroll
    for (int j = 0; j < 16; ++j) S[j] = 0.f;
    const int il = lane_ & 15, jq = lane_ >> 4, irow = 16 * wave_ + il;
    for (int cidx = 0; cidx < SEQ / CH; ++cidx) {
        if (loader) { if (cidx + 1 < SEQ / CH) load_chunk(cidx + 1, (cidx + 1) & 1); }
        else {
            const LAS unsigned char* bb = buf + (cidx & 1) * BUFB;
#pragma unroll 4
            for (int s = 0; s < CH; ++s) { const LAS unsigned char* sp = bb + s * STEPB;
                float w[16], av[16], bv[16], kv[16], rv[16];
#pragma unroll
                for (int q = 0; q < 4; ++q) { const f32x4 l4 = *(const LAS f32x4*)(sp + 64 * jq + 16 * q); w[4 * q] = __expf(l4.x); w[4 * q + 1] = __expf(l4.y); w[4 * q + 2] = __expf(l4.z); w[4 * q + 3] = __expf(l4.w); }
#pragma unroll
                for (int q = 0; q < 2; ++q) { const v4u a4 = *(const LAS v4u*)(sp + 256 + 32 * jq + 16 * q), b4 = *(const LAS v4u*)(sp + 384 + 32 * jq + 16 * q), k4 = *(const LAS v4u*)(sp + 512 + 32 * jq + 16 * q), r4 = *(const LAS v4u*)(sp + 640 + 32 * jq + 16 * q);
#pragma unroll
                    for (int e = 0; e < 4; ++e) { av[8 * q + 2 * e] = bflo(a4[e]); av[8 * q + 2 * e + 1] = bfhi(a4[e]); bv[8 * q + 2 * e] = bflo(b4[e]); bv[8 * q + 2 * e + 1] = bfhi(b4[e]);
                        kv[8 * q + 2 * e] = bflo(k4[e]); kv[8 * q + 2 * e + 1] = bfhi(k4[e]); rv[8 * q + 2 * e] = bflo(r4[e]); rv[8 * q + 2 * e + 1] = bfhi(r4[e]); } }
                const unsigned short vraw = *(const LAS unsigned short*)(sp + 768 + 2 * irow); const float vi = __uint_as_float((unsigned)vraw << 16);
                float sa = 0.f;
#pragma unroll
                for (int j = 0; j < 16; ++j) sa += S[j] * av[j];
                sa += __shfl_xor(sa, 16); sa += __shfl_xor(sa, 32);
                float y = 0.f;
#pragma unroll
                for (int j = 0; j < 16; ++j) { S[j] = S[j] * w[j] + sa * bv[j] + vi * kv[j]; y += S[j] * rv[j]; }
                y += __shfl_xor(y, 16); y += __shfl_xor(y, 32);
                if (jq == 0) Y[(tok0 + (size_t)cidx * CH + s) * 512 + 64 * h + irow] = y;
            }
        }
        __syncthreads();
    }
}

__device__ __forceinline__ void rwkv_post(Frame& F, const Args& A) {
    PHASE_IDS();
    unsigned char* ws = A.ws;
    const float* Y = (const float*)(ws + WS_Y); const bf16* VV = (const bf16*)(ws + WS_XN); const bf16* GG = (const bf16*)(ws + WS_F + 32 * MiB); const float* BON = (const float*)(ws + WS_BON);
    bf16* O = (bf16*)(ws + WS_F);
    const float* lg = A.in[16]; const float* lb = A.in[17];
    const int gw = F.vcu * NWAVES + wave_, NGW = F.G * NWAVES, col = 8 * lane_, hd = lane_ >> 3;
    const f32x4 g0 = *(const f32x4*)(lg + col), g1 = *(const f32x4*)(lg + col + 4), b0 = *(const f32x4*)(lb + col), b1 = *(const f32x4*)(lb + col + 4);
    for (int m = gw; m < M; m += NGW) {
        const f32x4 y0 = *(const f32x4*)(Y + (size_t)m * 512 + col), y1 = *(const f32x4*)(Y + (size_t)m * 512 + col + 4);
        float s = (y0.x + y0.y) + (y0.z + y0.w) + (y1.x + y1.y) + (y1.z + y1.w);
        s += __shfl_xor(s, 1); s += __shfl_xor(s, 2); s += __shfl_xor(s, 4);
        const float mean = s * (1.f / 64.f); const f32x4 d0 = y0 - mean, d1 = y1 - mean;
        float q = (d0.x * d0.x + d0.y * d0.y) + (d0.z * d0.z + d0.w * d0.w) + (d1.x * d1.x + d1.y * d1.y) + (d1.z * d1.z + d1.w * d1.w);
        q += __shfl_xor(q, 1); q += __shfl_xor(q, 2); q += __shfl_xor(q, 4);
        const float rstd = 1.0f / sqrtf(q * (1.f / 64.f) + 64e-5f);
        const float bon = BON[(size_t)m * 8 + hd];
        const v4u vw = *(const v4u*)(VV + (size_t)m * 512 + col), gw4 = *(const v4u*)(GG + (size_t)m * 512 + col);
        f32x4 o0 = (d0 * rstd * g0 + b0), o1 = (d1 * rstd * g1 + b1);
        o0.x = (o0.x + bon * bflo(vw.x)) * bflo(gw4.x); o0.y = (o0.y + bon * bfhi(vw.x)) * bfhi(gw4.x); o0.z = (o0.z + bon * bflo(vw.y)) * bflo(gw4.y); o0.w = (o0.w + bon * bfhi(vw.y)) * bfhi(gw4.y);
        o1.x = (o1.x + bon * bflo(vw.z)) * bflo(gw4.z); o1.y = (o1.y + bon * bfhi(vw.z)) * bfhi(gw4.z); o1.z = (o1.z + bon * bflo(vw.w)) * bflo(gw4.w); o1.w = (o1.w + bon * bfhi(vw.w)) * bfhi(gw4.w);
        v4u ow; ow.x = pk2(o0.x, o0.y); ow.y = pk2(o0.z, o0.w); ow.z = pk2(o1.x, o1.y); ow.w = pk2(o1.z, o1.w);
        *(v4u*)(O + (size_t)m * 512 + col) = ow;
    }
}

__device__ __forceinline__ size_t pq_off(int it) { const int ch = it >> 8, cc = it & 255; return WS_PRW + ((size_t)(ch >> 3) * SEQ + (size_t)cc * 64) * (SHW * 2) + (size_t)(ch & 7) * 24576; }
__device__ __forceinline__ size_t y0_off(int it, int idx) { const int ch = it >> 8, cc = it & 255; return (((size_t)(ch >> 3) * SEQ + (size_t)cc * 64 + (idx >> 4)) * 512 + 64 * (ch & 7)) * 4 + (size_t)(idx & 15) * 16; }
constexpr size_t ST_OFF = 64 * MiB;
constexpr int CH_ITEMS = BATCH * 8 * (SEQ / 64);

__device__ __forceinline__ int sw16(int row, int chunk) { return row * 128 + ((chunk ^ (row & 7)) << 4); }
typedef float f32x4c __attribute__((ext_vector_type(4)));
__device__ __forceinline__ bf16x8 ld_frag(const LAS unsigned char* Mx, int row, int chunk) { return *(const LAS bf16x8*)(Mx + sw16(row, chunk)); }
template <bool SWAP>
__device__ __forceinline__ void mm_tile(const LAS unsigned char* Am, const LAS unsigned char* Bm, int r0, int c0, int l15, int kg, f32x4c (&acc)[2]) {
    bf16x8 a[2], b[2][2];
#pragma unroll
    for (int ks = 0; ks < 2; ++ks) { a[ks] = ld_frag(Am, r0 + l15, 4 * ks + kg);
#pragma unroll
        for (int n = 0; n < 2; ++n) b[ks][n] = ld_frag(Bm, c0 + 16 * n + l15, 4 * ks + kg); }
#pragma unroll
    for (int ks = 0; ks < 2; ++ks)
#pragma unroll
        for (int n = 0; n < 2; ++n)
            acc[n] = SWAP ? __builtin_amdgcn_mfma_f32_16x16x32_bf16(b[ks][n], a[ks], acc[n], 0, 0, 0) : __builtin_amdgcn_mfma_f32_16x16x32_bf16(a[ks], b[ks][n], acc[n], 0, 0, 0);
}
__device__ __forceinline__ unsigned long long pack4u(f32x4c v) { return (unsigned long long)pk2(v[0], v[1]) | ((unsigned long long)pk2(v[2], v[3]) << 32); }
__device__ __forceinline__ void st_nat(LAS unsigned char* O, int r0, int c0, int l15, int kg, const f32x4c (&acc)[2]) {
#pragma unroll
    for (int n = 0; n < 2; ++n) { const int row = r0 + l15, col = c0 + 16 * n + 4 * kg; *(LAS unsigned long long*)(O + sw16(row, col >> 3) + (col & 4) * 2) = pack4u(acc[n]); }
}
__device__ __forceinline__ void st_tr(LAS unsigned char* OT, int r0, int c0, int l15, int kg, const f32x4c (&acc)[2]) {
#pragma unroll
    for (int n = 0; n < 2; ++n)
#pragma unroll
        for (int e = 0; e < 4; ++e) { const int row = r0 + l15, col = c0 + 16 * n + 4 * kg + e; *(LAS unsigned short*)(OT + sw16(col, row >> 3) + (row & 7) * 2) = (unsigned short)f2bf(acc[n][e]); }
}
__device__ __forceinline__ f32x4c ld_nat4(const LAS unsigned char* O, int row, int col) { const unsigned long long w = *(const LAS unsigned long long*)(O + sw16(row, col >> 3) + (col & 4) * 2);
    const unsigned lo = (unsigned)w, hi = (unsigned)(w >> 32); return (f32x4c){bflo(lo), bfhi(lo), bflo(hi), bfhi(hi)}; }

struct Op2 { bf16x8 k[2]; };
#define R1_MF(a, b, c) __builtin_amdgcn_mfma_f32_32x32x16_bf16(a, b, c, 0, 0, 0)
__device__ __forceinline__ f32x16 mm2(f32x16 acc, const Op2& a, const Op2& b) { acc = R1_MF(a.k[0], b.k[0], acc); return R1_MF(a.k[1], b.k[1], acc); }
__device__ __forceinline__ Op2 packop(const f32x16& a) { Op2 o;
#pragma unroll
    for (int ks = 0; ks < 2; ++ks) { v4u p_; p_.x = pk2(a[8 * ks], a[8 * ks + 1]); p_.y = pk2(a[8 * ks + 2], a[8 * ks + 3]); p_.z = pk2(a[8 * ks + 4], a[8 * ks + 5]); p_.w = pk2(a[8 * ks + 6], a[8 * ks + 7]); o.k[ks] = __builtin_bit_cast(bf16x8, p_); }
    return o; }
__device__ __forceinline__ Op2 ldrow(const bf16* p) { Op2 o; o.k[0] = *(const bf16x8*)p; o.k[1] = *(const bf16x8*)(p + 16); return o; }
template <int MODE> __device__ __forceinline__ f32x16 tri_mask(f32x16 a, int dd) {
#pragma unroll
    for (int r = 0; r < 16; ++r) { const int cr = 8 * (r >> 2) + (r & 3); const bool keep = MODE == 0 ? (cr < dd) : MODE == 1 ? (cr <= dd) : (cr > dd); a[r] = keep ? a[r] : 0.f; }
    return a; }
__device__ __forceinline__ f32x16 add_diag(f32x16 a, int dd, float v) {
#pragma unroll
    for (int r = 0; r < 16; ++r) { const int cr = 8 * (r >> 2) + (r & 3); a[r] += (cr == dd) ? v : 0.f; }
    return a; }
__device__ __forceinline__ void st_tile(unsigned char* p, const f32x16& a) { const Op2 o = packop(a); *(bf16x8*)p = o.k[0]; *(bf16x8*)(p + 16) = o.k[1]; }
constexpr size_t Y0_OFF = 0, GC_OFF = 32 * MiB;
__device__ __forceinline__ Op2 r1_identity() {
    int l2 = threadIdx.x & 63; asm volatile("" : "+v"(l2)); Op2 o;
#pragma unroll
    for (int ks = 0; ks < 2; ++ks) { const int d = (l2 & 31) - 8 * (l2 >> 5) - 16 * ks; v4u p_;
#pragma unroll
        for (int q = 0; q < 4; ++q) p_[q] = (d == 2 * q) ? 0x00003f80u : (d == 2 * q + 1) ? 0x3f800000u : 0u;
        o.k[ks] = __builtin_bit_cast(bf16x8, p_); }
    return o; }
__device__ __forceinline__ void rwkv_r1w(Frame& F, const Args& A, int it) {
    int l_ = threadIdx.x & 63; asm volatile("" : "+v"(l_));
    const int ln = l_ & 31, hh = l_ >> 5, dd = ln - 4 * hh;
    unsigned char* ws = A.ws;
    const int ch = it >> 8, cc = it & 255, h = ch & 7; const unsigned tok0 = (unsigned)(ch >> 3) * SEQ + (unsigned)cc * 64;
    const unsigned ro = ((tok0 + ln) * 512 + 64 * h + 8 * hh) * 2;
    const unsigned char* bR = (const unsigned char*)A.out + 64 * MiB; const unsigned char* bK = (const unsigned char*)A.out + 96 * MiB;
    const unsigned char* bV = ws + WS_XN; const unsigned char* bA = ws + WS_XN + 32 * MiB; const unsigned char* bB = ws + WS_F;
#define LDROW(bp, T, J) ldrow((const bf16*)((bp) + ro + (T) * (32 * 1024) + (J) * 64))
#define R1_SB() __builtin_amdgcn_sched_barrier(0)
    const f32x16 Z16 = f32x16{};
    Op2 rAt[2][2], rBt[2][2];
#pragma unroll
    for (int T = 0; T < 2; ++T)
#pragma unroll
        for (int J = 0; J < 2; ++J) { rAt[T][J] = LDROW(bA, T, J); rBt[T][J] = LDROW(bB, T, J); }
    const Op2 LT01 = packop(mm2(mm2(Z16, rBt[0][0], rAt[1][0]), rBt[0][1], rAt[1][1]));
    Op2 TT[2];
#pragma unroll
    for (int b = 0; b < 2; ++b) {
        const f32x16 aLT = tri_mask<0>(mm2(mm2(Z16, rBt[b][0], rAt[b][0]), rBt[b][1], rAt[b][1]), dd);
        const f32x16 aL = tri_mask<2>(mm2(mm2(Z16, rAt[b][0], rBt[b][0]), rAt[b][1], rBt[b][1]), dd);
        f32x16 accM = add_diag(aLT, dd, 1.0f);
        Op2 cN = packop(aL), cNt = packop(aLT);
#pragma unroll
        for (int lev = 0; lev < 4; ++lev) {
            const Op2 cN2 = packop(mm2(Z16, cNt, cN));
            Op2 cN2t = cN2; if (lev < 3) cN2t = packop(mm2(Z16, cN, cNt));
            accM = mm2(accM, cN2, packop(accM));
            cN = cN2; cNt = cN2t; }
        TT[b] = packop(accM);
        R1_SB(); }
    Op2 AkT00, AkT11, AkT01;
    {   Op2 rKt[2][2];
#pragma unroll
        for (int T = 0; T < 2; ++T)
#pragma unroll
            for (int J = 0; J < 2; ++J) rKt[T][J] = LDROW(bK, T, J);
        AkT00 = packop(tri_mask<0>(mm2(mm2(Z16, rKt[0][0], rAt[0][0]), rKt[0][1], rAt[0][1]), dd));
        AkT11 = packop(tri_mask<0>(mm2(mm2(Z16, rKt[1][0], rAt[1][0]), rKt[1][1], rAt[1][1]), dd));
        AkT01 = packop(mm2(mm2(Z16, rKt[0][0], rAt[1][0]), rKt[0][1], rAt[1][1])); }
    Op2 RHS0[4];
    { const Op2 Iop = r1_identity(); RHS0[0] = packop(mm2(Z16, rAt[0][0], Iop)); RHS0[1] = packop(mm2(Z16, rAt[0][1], Iop)); }
    R1_SB();
    LAS unsigned char* park = F.lds + __builtin_amdgcn_readfirstlane((int)threadIdx.x >> 6) * 16384 + l_ * 16;
#define PARK_ST(mtx, a, b, op) do { *(LAS bf16x8*)(park + (((mtx) * 4 + (a) * 2 + (b)) * 2 + 0) * 1024) = (op).k[0]; *(LAS bf16x8*)(park + (((mtx) * 4 + (a) * 2 + (b)) * 2 + 1) * 1024) = (op).k[1]; } while (0)
#define PARK_LD(mtx, a, b, op) do { (op).k[0] = *(const LAS bf16x8*)(park + (((mtx) * 4 + (a) * 2 + (b)) * 2 + 0) * 1024); (op).k[1] = *(const LAS bf16x8*)(park + (((mtx) * 4 + (a) * 2 + (b)) * 2 + 1) * 1024); } while (0)
    f32x16 aAV1[2];
    {   Op2 cV[2][2];
        {   Op2 rV[2][2]; const Op2 Iop = r1_identity();
#pragma unroll
            for (int T = 0; T < 2; ++T)
#pragma unroll
                for (int J = 0; J < 2; ++J) rV[T][J] = LDROW(bV, T, J);
#pragma unroll
            for (int I = 0; I < 2; ++I)
#pragma unroll
                for (int U = 0; U < 2; ++U) { cV[I][U] = packop(mm2(Z16, rV[U][I], Iop)); PARK_ST(0, I, U, cV[I][U]); } }
        R1_SB();
#pragma unroll
        for (int I = 0; I < 2; ++I) { RHS0[2 + I] = packop(mm2(Z16, AkT00, cV[I][0])); aAV1[I] = mm2(mm2(Z16, AkT01, cV[I][0]), AkT11, cV[I][1]); } }
    R1_SB();
    Op2 cW[2][2];
#pragma unroll
    for (int cc_ = 0; cc_ < 4; ++cc_) { const int c = (cc_ + 2) & 3;
        const Op2 x0 = packop(mm2(Z16, TT[0], RHS0[c]));
        f32x16 init; if (c < 2) { const Op2 Iop = r1_identity(); init = mm2(Z16, rAt[1][c & 1], Iop); } else init = aAV1[c & 1];
        const Op2 y1 = packop(mm2(init, LT01, x0));
        const Op2 x1 = packop(mm2(Z16, TT[1], y1));
        if (c < 2) { cW[c][0] = x0; cW[c][1] = x1; } else { PARK_ST(1, c & 1, 0, x0); PARK_ST(1, c & 1, 1, x1); }
        R1_SB(); }
    unsigned char* og = ws + pq_off(it); unsigned char* oy = (unsigned char*)A.out + Y0_OFF + (size_t)it * 8192;
    const float* gc = (const float*)((const unsigned char*)A.out + GC_OFF + (size_t)it * 256);
    Op2 cBt[2][2];
    Op2 rB2[2][2];
#pragma unroll
    for (int T = 0; T < 2; ++T)
#pragma unroll
        for (int J = 0; J < 2; ++J) rB2[T][J] = LDROW(bB, T, J);
    {   const Op2 Iop = r1_identity();
#pragma unroll
        for (int T = 0; T < 2; ++T)
#pragma unroll
            for (int J = 0; J < 2; ++J) cBt[J][T] = packop(mm2(Z16, rB2[T][J], Iop)); }
#pragma unroll
    for (int Jp = 0; Jp < 2; ++Jp) { const float gl = gc[32 * Jp + ln];
#pragma unroll
        for (int J = 0; J < 2; ++J) {
            f32x16 pa = mm2(mm2(Z16, cW[J][0], cBt[Jp][0]), cW[J][1], cBt[Jp][1]);
            if (J == Jp) pa = add_diag(pa, dd, 1.0f);
#pragma unroll
            for (int r = 0; r < 16; ++r) pa[r] *= gl;
            const Op2 o = packop(pa);
            *(bf16x8*)(og + (((2 * Jp + J) * 2 + 0) * 64 + l_) * 16) = o.k[0]; *(bf16x8*)(og + (((2 * Jp + J) * 2 + 1) * 64 + l_) * 16) = o.k[1]; } }
    R1_SB();
    Op2 ArT00, ArT11, ArT01;
    Op2 rRt[2][2];
#pragma unroll
    for (int T = 0; T < 2; ++T)
#pragma unroll
        for (int J = 0; J < 2; ++J) rRt[T][J] = LDROW(bR, T, J);
    ArT00 = packop(tri_mask<1>(mm2(mm2(Z16, rB2[0][0], rRt[0][0]), rB2[0][1], rRt[0][1]), dd));
    ArT11 = packop(tri_mask<1>(mm2(mm2(Z16, rB2[1][0], rRt[1][0]), rB2[1][1], rRt[1][1]), dd));
    ArT01 = packop(mm2(mm2(Z16, rB2[0][0], rRt[1][0]), rB2[0][1], rRt[1][1]));
    R1_SB();
    {   const Op2 Iop = r1_identity();
#pragma unroll
        for (int J = 0; J < 2; ++J) {
            const f32x16 z0 = mm2(mm2(Z16, Iop, rRt[0][J]), cW[J][0], ArT00);
            const f32x16 z1 = mm2(mm2(mm2(Z16, Iop, rRt[1][J]), cW[J][0], ArT01), cW[J][1], ArT11);
            st_tile(og + 16384 + ((2 * J + 0) * 64 + l_) * 32, z0); st_tile(og + 16384 + ((2 * J + 1) * 64 + l_) * 32, z1); } }
    R1_SB();
    Op2 AkR00, AkR11, AkR01, cKt[2][2];
    {   Op2 rK2[2][2];
#pragma unroll
        for (int T = 0; T < 2; ++T)
#pragma unroll
            for (int J = 0; J < 2; ++J) rK2[T][J] = LDROW(bK, T, J);
        AkR00 = packop(tri_mask<1>(mm2(mm2(Z16, rK2[0][0], rRt[0][0]), rK2[0][1], rRt[0][1]), dd));
        AkR11 = packop(tri_mask<1>(mm2(mm2(Z16, rK2[1][0], rRt[1][0]), rK2[1][1], rRt[1][1]), dd));
        AkR01 = packop(mm2(mm2(Z16, rK2[0][0], rRt[1][0]), rK2[0][1], rRt[1][1]));
        R1_SB();
        const Op2 Iop = r1_identity();
#pragma unroll
        for (int T = 0; T < 2; ++T)
#pragma unroll
            for (int J = 0; J < 2; ++J) cKt[J][T] = packop(mm2(Z16, rK2[T][J], Iop)); }
    R1_SB();
#pragma unroll
    for (int I = 0; I < 2; ++I) {
        Op2 cU0, cU1, cV0, cV1; PARK_LD(1, I, 0, cU0); PARK_LD(1, I, 1, cU1); PARK_LD(0, I, 0, cV0); PARK_LD(0, I, 1, cV1);
        const f32x16 y0 = mm2(mm2(Z16, ArT00, cU0), AkR00, cV0);
        st_tile(oy + ((0 + I) * 64 + l_) * 32, y0);
        const f32x16 y1 = mm2(mm2(mm2(mm2(Z16, ArT01, cU0), AkR01, cV0), ArT11, cU1), AkR11, cV1);
        st_tile(oy + ((2 + I) * 64 + l_) * 32, y1);
#pragma unroll
        for (int Jp = 0; Jp < 2; ++Jp) {
            f32x16 qa = mm2(mm2(mm2(mm2(Z16, cBt[Jp][0], cU0), cKt[Jp][0], cV0), cBt[Jp][1], cU1), cKt[Jp][1], cV1);
#pragma unroll
            for (int q = 0; q < 4; ++q) { const f32x4 g4 = *(const f32x4*)(gc + 32 * Jp + 8 * q + 4 * hh);
#pragma unroll
                for (int e = 0; e < 4; ++e) qa[4 * q + e] *= g4[e]; }
            st_tile(og + 8192 + ((2 * I + Jp) * 64 + l_) * 32, qa); }
        R1_SB(); }
#undef PARK_ST
#undef PARK_LD
#undef LDROW
#undef R1_SB
}

template <int VAR> __device__ __forceinline__ void rwkv_r2(Frame& F, const Args& A, unsigned char* stbase) {
    PHASE_IDS();
    if (blockIdx.x >= BATCH * 8) return;
    unsigned char* ws = A.ws;
    LAS unsigned char* L = F.lds;
    const int ch = blockIdx.x, w = wave_, l15 = lane_ & 15, kg = lane_ >> 4, r0 = 16 * (w >> 1), c0 = 32 * (w & 1);
    const unsigned char* pq = ws + pq_off(ch * 256); unsigned char* st = stbase + (size_t)ch * 256 * 8192;
    for (int i = tid_; i < 2048; i += NWAVES * 64) { ((LAS unsigned*)L)[i] = 0u; }
    for (int i = tid_; i < 512; i += NWAVES * 64) ((v4u*)st)[i] = (v4u){0u, 0u, 0u, 0u};
    __syncthreads();
    constexpr int PF = 8;
    bf16x8 pa[PF][2]; v4u qf[PF];
#define R2_LOAD(slot, step) do { const unsigned char* p_ = pq + (size_t)(step) * (64 * SHW * 2); \
        pa[slot][0] = *(const bf16x8*)(p_ + (size_t)((r0 + l15) * 64 + 8 * kg) * 2); pa[slot][1] = *(const bf16x8*)(p_ + (size_t)((r0 + l15) * 64 + 32 + 8 * kg) * 2); \
        qf[slot] = *(const v4u*)(p_ + 8192 + (size_t)(w * 64 + lane_) * 16); } while (0)
#pragma unroll
    for (int s = 0; s < PF; ++s) R2_LOAD(s, s);
    for (int c = 0; c < 256; c += PF) {
#pragma unroll
        for (int s = 0; s < PF; ++s) {
            const int step = c + s; const LAS unsigned char* Sin = L + (step & 15) * 8192; LAS unsigned char* Sout = L + ((step + 1) & 15) * 8192;
            f32x4c acc[2];
            acc[0] = (f32x4c){bflo(qf[s].x), bfhi(qf[s].x), bflo(qf[s].y), bfhi(qf[s].y)}; acc[1] = (f32x4c){bflo(qf[s].z), bfhi(qf[s].z), bflo(qf[s].w), bfhi(qf[s].w)};
            bf16x8 sf[2][2];
#pragma unroll
            for (int ks = 0; ks < 2; ++ks)
#pragma unroll
                for (int n = 0; n < 2; ++n) sf[ks][n] = ld_frag(Sin, c0 + 16 * n + l15, 4 * ks + kg);
#pragma unroll
            for (int ks = 0; ks < 2; ++ks)
#pragma unroll
                for (int n = 0; n < 2; ++n) acc[n] = __builtin_amdgcn_mfma_f32_16x16x32_bf16(pa[s][ks], sf[ks][n], acc[n], 0, 0, 0);
#pragma unroll
            for (int n = 0; n < 2; ++n) { const int row = c0 + 16 * n + l15, col = r0 + 4 * kg; const unsigned long long pkd = pack4u(acc[n]);
                *(LAS unsigned long long*)(Sout + sw16(row, col >> 3) + (col & 4) * 2) = pkd;
                }
            if (VAR != 3) { if (step + PF < 256) R2_LOAD(s, step + PF); }
            if (VAR != 4) asm volatile("s_waitcnt lgkmcnt(0)\n\ts_barrier" ::: "memory");
        }
        if (VAR != 2) { const int nflush = (c + PF < 256) ? PF * 8192 : (PF - 1) * 8192; unsigned char* dst = st + (size_t)(c + 1) * 8192;
          for (int o = tid_ * 16; o < nflush; o += NWAVES * 64 * 16) { const int row_ = (o >> 7) & 63, chk_ = (o >> 4) & 7, slot_ = (c + 1 + (o >> 13)) & 15; *(v4u*)(dst + o) = *(const LAS v4u*)(L + slot_ * 8192 + sw16(row_, chk_)); } }
    }
#undef R2_LOAD
}

__device__ __forceinline__ void rwkv_r2w(Frame& F, const Args& A, unsigned char* stbase) {
    PHASE_IDS();
    if (blockIdx.x >= BATCH * 8) return;
    unsigned char* ws = A.ws;
    LAS unsigned char* RING = F.lds;
    LAS unsigned char* HB = F.lds + 98304;
    const int ch = blockIdx.x, it = wave_ & 1, cl = lane_ & 31, hh = lane_ >> 5; const bool chain = wave_ < 2;
    const unsigned char* pq = ws + pq_off(ch * 256); unsigned char* st = stbase + (size_t)ch * 256 * 8192;
    const int ft = tid_ - 128;
    f32x16 H[2]; H[0] = f32x16{}; H[1] = f32x16{};
    v4u hx[3][6];
#define HP_LOAD(set, grp) do { _Pragma("unroll") for (int j = 0; j < 6; ++j) { const int pc_ = ft + 384 * j; const int pcc_ = pc_ < 2048 ? pc_ : 2047; int stp_ = 2 * (grp) + (pcc_ >> 10); stp_ = stp_ < 255 ? stp_ : 254; \
        hx[set][j] = *(const v4u*)(pq + (size_t)stp_ * (64 * SHW * 2) + (size_t)(pcc_ & 1023) * 16); } } while (0)
#define HP_STORE(set, slot) do { LAS unsigned char* rg_ = RING + (slot) * 32768; _Pragma("unroll") for (int j = 0; j < 6; ++j) { const int pc_ = ft + 384 * j; const int pcc_ = pc_ < 2048 ? pc_ : 2047; *(LAS v4u*)(rg_ + pcc_ * 16) = hx[set][j]; } } while (0)
#define CH_READ(PF_, QF_, rs_) do { _Pragma("unroll") for (int f = 0; f < 8; ++f) PF_[f] = *(const LAS bf16x8*)((rs_) + (f * 64 + lane_) * 16); \
        _Pragma("unroll") for (int jt = 0; jt < 2; ++jt) { const LAS unsigned char* q_ = (rs_) + 8192 + ((it * 2 + jt) * 64 + lane_) * 32; QF_[2 * jt] = *(const LAS v4u*)q_; QF_[2 * jt + 1] = *(const LAS v4u*)(q_ + 16); } } while (0)
#define CH_STEP(PF_, QF_, hbs_) do { bf16x8 B[2][2]; \
        _Pragma("unroll") for (int jt2 = 0; jt2 < 2; ++jt2) _Pragma("unroll") for (int k = 0; k < 2; ++k) { v4u p_; p_.x = pk2(H[jt2][8 * k], H[jt2][8 * k + 1]); p_.y = pk2(H[jt2][8 * k + 2], H[jt2][8 * k + 3]); \
            p_.z = pk2(H[jt2][8 * k + 4], H[jt2][8 * k + 5]); p_.w = pk2(H[jt2][8 * k + 6], H[jt2][8 * k + 7]); B[jt2][k] = __builtin_bit_cast(bf16x8, p_); } \
        _Pragma("unroll") for (int jt = 0; jt < 2; ++jt) { f32x16 n_; \
            _Pragma("unroll") for (int e = 0; e < 4; ++e) { const unsigned a_ = QF_[2 * jt][e], b_ = QF_[2 * jt + 1][e]; n_[2 * e] = bflo(a_); n_[2 * e + 1] = bfhi(a_); n_[8 + 2 * e] = bflo(b_); n_[8 + 2 * e + 1] = bfhi(b_); } \
            _Pragma("unroll") for (int jt2 = 0; jt2 < 2; ++jt2) _Pragma("unroll") for (int k = 0; k < 2; ++k) n_ = __builtin_amdgcn_mfma_f32_32x32x16_bf16(PF_[(jt * 2 + jt2) * 2 + k], B[jt2][k], n_, 0, 0, 0); \
            H[jt] = n_; } \
          \
        _Pragma("unroll") for (int jt = 0; jt < 2; ++jt) _Pragma("unroll") for (int q = 0; q < 4; ++q) { const int row = 32 * it + cl, col = 32 * jt + 8 * q + 4 * hh; \
            *(LAS unsigned long long*)((hbs_) + sw16(row, col >> 3) + (col & 4) * 2) = (unsigned long long)pk2(H[jt][4 * q], H[jt][4 * q + 1]) | ((unsigned long long)pk2(H[jt][4 * q + 2], H[jt][4 * q + 3]) << 32); } } while (0)
    if (!chain) {
        for (int o = ft * 16; o < 8192; o += 384 * 16) *(LAS v4u*)(HB + 16384 + 8192 + o) = (v4u){0u, 0u, 0u, 0u};
        HP_LOAD(0, 0); HP_STORE(0, 0); HP_LOAD(1, 1); HP_LOAD(2, 2); HP_LOAD(0, 3);
    }
    __syncthreads();
    for (int g0 = 0; g0 < 129; g0 += 3) {
#pragma unroll
        for (int u = 0; u < 3; ++u) {
            const int g = g0 + u;
            if (chain) {
                const LAS unsigned char* rg = RING + u * 32768; LAS unsigned char* hb = HB + (g & 1) * 16384;
                bf16x8 pfa[8], pfb[8]; v4u qfa[4], qfb[4];
                CH_READ(pfa, qfa, rg); CH_READ(pfb, qfb, rg + 16384);
                if (2 * g < 255) CH_STEP(pfa, qfa, hb);
                if (2 * g + 1 < 255) CH_STEP(pfb, qfb, hb + 8192);
            } else {
                HP_STORE((u + 1) % 3, (u + 1) % 3);
                HP_LOAD((u + 1) % 3, g + 4);
                const LAS unsigned char* hbp = HB + ((g - 1) & 1) * 16384; unsigned char* dst = st + (long)(2 * g - 1) * 8192;
                const int lo_ = g == 0 ? 512 : 0, hi_ = g == 128 ? 511 : 1023;
#pragma unroll
                for (int j = 0; j < 3; ++j) { int pc_ = ft + 384 * j; pc_ = pc_ < lo_ ? pc_ + 512 : pc_; pc_ = pc_ > hi_ ? hi_ : pc_; const int o = pc_ * 16; const int row_ = (o >> 7) & 63, chk_ = (o >> 4) & 7;
                    *(v4u*)(dst + o) = *(const LAS v4u*)(hbp + (o & ~8191) + sw16(row_, chk_)); }
            }
            asm volatile("s_waitcnt lgkmcnt(0)\n\ts_barrier" ::: "memory");
        }
    }
    asm volatile("s_waitcnt vmcnt(0) lgkmcnt(0)\n\ts_barrier" ::: "memory");
#undef HP_LOAD
#undef HP_STORE
#undef CH_READ
#undef CH_STEP
}

__device__ __forceinline__ void rwkv_r3(Frame& F, const Args& A) {
    PHASE_IDS();
    unsigned char* ws = A.ws;
    const bf16* VV = (const bf16*)(ws + WS_XN); const bf16* GG = (const bf16*)(ws + WS_F + 32 * MiB); const float* BON = (const float*)(ws + WS_BON);
    bf16* O = (bf16*)(ws + WS_F); const float* lg = A.in[16]; const float* lb = A.in[17];
    LAS float* Yt = (LAS float*)F.lds;
    const int w = wave_, l15 = lane_ & 15, kg = lane_ >> 4, r0 = 16 * (w >> 1), c0 = 32 * (w & 1);
#define R3_BAR() asm volatile("s_waitcnt lgkmcnt(0)\n\ts_barrier" ::: "memory")
    v4u nq, nvw, ngw; bf16x8 na[2], nb[2][2]; float nbon;
    const int pt_ = tid_ >> 3, pi0_ = 8 * (tid_ & 7);
#define R3_LOAD(itx) do { const int ch_ = (itx) >> 8, cc_ = (itx) & 255; const unsigned char* og_ = ws + pq_off(itx); const unsigned char* sg_ = (const unsigned char*)A.out + ST_OFF + (size_t)(itx) * 8192; \
        { const unsigned char* y_ = (const unsigned char*)A.out + Y0_OFF + (size_t)(itx) * 8192 + ((2 * (w >> 2) + (w & 1)) * 64 + l15 + 32 * (kg & 1)) * 32 + 8 * (2 * ((w >> 1) & 1) + (kg >> 1)); \
          const u32x2 y0_ = *(const u32x2*)y_, y1_ = *(const u32x2*)(y_ + 16 * 32); nq.x = y0_.x; nq.y = y0_.y; nq.z = y1_.x; nq.w = y1_.y; } \
        _Pragma("unroll") for (int ks = 0; ks < 2; ++ks) { na[ks] = *(const bf16x8*)(og_ + 16384 + ((2 * ks + (w >> 2)) * 64 + (r0 & 31) + l15 + 32 * (kg & 1)) * 32 + 16 * (kg >> 1)); \
            _Pragma("unroll") for (int n = 0; n < 2; ++n) { const unsigned char* s_ = sg_ + (size_t)((c0 + 16 * n + l15) * 64 + 32 * ks + 16 * (kg >> 1) + 4 * (kg & 1)) * 2; \
                const u32x2 s0_ = *(const u32x2*)s_, s1_ = *(const u32x2*)(s_ + 16); v4u sb_; sb_.x = s0_.x; sb_.y = s0_.y; sb_.z = s1_.x; sb_.w = s1_.y; nb[ks][n] = __builtin_bit_cast(bf16x8, sb_); } } \
        const size_t m_ = (size_t)(ch_ >> 3) * SEQ + (size_t)cc_ * 64 + pt_; const int col_ = 64 * (ch_ & 7) + pi0_; \
        nvw = *(const v4u*)(VV + m_ * 512 + col_); ngw = *(const v4u*)(GG + m_ * 512 + col_); nbon = BON[m_ * 8 + (ch_ & 7)]; } while (0)
    if ((int)blockIdx.x < CH_ITEMS) R3_LOAD((int)blockIdx.x);
    for (int it = blockIdx.x; it < CH_ITEMS; it += F.G) {
        const int ch = it >> 8, cc = it & 255, b = ch >> 3, h = ch & 7;
        f32x4c acc[2];
        acc[0] = (f32x4c){bflo(nq.x), bfhi(nq.x), bflo(nq.y), bfhi(nq.y)}; acc[1] = (f32x4c){bflo(nq.z), bfhi(nq.z), bflo(nq.w), bfhi(nq.w)};
#pragma unroll
        for (int ks = 0; ks < 2; ++ks)
#pragma unroll
            for (int n = 0; n < 2; ++n) acc[n] = __builtin_amdgcn_mfma_f32_16x16x32_bf16(na[ks], nb[ks][n], acc[n], 0, 0, 0);
        const v4u vw = nvw, gw4 = ngw; const float bon = nbon;
        { const int itn_ = (it + (int)F.G < CH_ITEMS) ? it + (int)F.G : it; R3_LOAD(itn_); }
        R3_BAR();
#pragma unroll
        for (int n = 0; n < 2; ++n)
#pragma unroll
            for (int e = 0; e < 4; ++e) Yt[(r0 + 4 * kg + e) * 68 + c0 + 16 * n + l15] = acc[n][e];
        R3_BAR();
        {   const int t = pt_, i0 = pi0_; const size_t m = (size_t)b * SEQ + (size_t)cc * 64 + t; const int col = 64 * h + i0;
            const f32x4 y0 = *(const LAS f32x4*)(Yt + t * 68 + i0), y1 = *(const LAS f32x4*)(Yt + t * 68 + i0 + 4);
            float s = (y0.x + y0.y) + (y0.z + y0.w) + (y1.x + y1.y) + (y1.z + y1.w);
            s += __shfl_xor(s, 1); s += __shfl_xor(s, 2); s += __shfl_xor(s, 4);
            const float mean = s * (1.f / 64.f); const f32x4 d0 = y0 - mean, d1 = y1 - mean;
            float q = (d0.x * d0.x + d0.y * d0.y) + (d0.z * d0.z + d0.w * d0.w) + (d1.x * d1.x + d1.y * d1.y) + (d1.z * d1.z + d1.w * d1.w);
            q += __shfl_xor(q, 1); q += __shfl_xor(q, 2); q += __shfl_xor(q, 4);
            const float rstd = 1.0f / sqrtf(q * (1.f / 64.f) + 64e-5f);
            const f32x4 g0 = *(const f32x4*)(lg + col), g1 = *(const f32x4*)(lg + col + 4), b0 = *(const f32x4*)(lb + col), b1 = *(const f32x4*)(lb + col + 4);
            f32x4 o0 = (d0 * rstd * g0 + b0), o1 = (d1 * rstd * g1 + b1);
            o0.x = (o0.x + bon * bflo(vw.x)) * bflo(gw4.x); o0.y = (o0.y + bon * bfhi(vw.x)) * bfhi(gw4.x); o0.z = (o0.z + bon * bflo(vw.y)) * bflo(gw4.y); o0.w = (o0.w + bon * bfhi(vw.y)) * bfhi(gw4.y);
            o1.x = (o1.x + bon * bflo(vw.z)) * bflo(gw4.z); o1.y = (o1.y + bon * bfhi(vw.z)) * bfhi(gw4.z); o1.z = (o1.z + bon * bflo(vw.w)) * bflo(gw4.w); o1.w = (o1.w + bon * bfhi(vw.w)) * bfhi(gw4.w);
            v4u ow; ow.x = pk2(o0.x, o0.y); ow.y = pk2(o0.z, o0.w); ow.z = pk2(o1.x, o1.y); ow.w = pk2(o1.z, o1.w);
            *(v4u*)(O + m * 512 + col) = ow; }
    }
#undef R3_BAR
#undef R3_LOAD
}

__device__ __forceinline__ void p_norm2_route(Frame& F, const Args& A) {
    PHASE_IDS();
    unsigned char* ws = A.ws;
    constexpr int WROW = 2064;
    LAS unsigned char* WH = F.lds; LAS unsigned char* WL = F.lds + 36 * WROW;
    LAS float* LG = (LAS float*)F.lds;
    LAS int* eid = (LAS int*)(F.lds + 128 * 36 * 4);
    const bf16* x1 = (const bf16*)(ws + WS_X1); const float* g2 = A.in[21]; const float* mod = (const float*)(ws + WS_MOD);
    const float* rgw = A.in[22]; const float* rgb = A.in[23]; const float* rew = A.in[24]; const float* reb = A.in[25];
    bf16* XN2 = (bf16*)(ws + WS_XN); int* route = (int*)(ws + WS_ROUTE); int* blkcnt = (int*)(ws + WS_BLKCNT);
    const int l15 = lane_ & 15, kg = lane_ >> 4;
    for (int blk = blockIdx.x; blk < M / 128; blk += F.G) {
        __syncthreads();
        for (int i = tid_; i < 4096; i += NWAVES * 64) { const float w = rgw[i]; const unsigned hi = f2bf(w); const unsigned lo = f2bf(w - __uint_as_float(hi << 16)); const int off = (i & 3) * WROW + (i >> 2) * 2;
            *(LAS unsigned short*)(WH + off) = (unsigned short)hi; *(LAS unsigned short*)(WL + off) = (unsigned short)lo; }
        for (int i = tid_; i < 32768; i += NWAVES * 64) { const float w = rew[i]; const unsigned hi = f2bf(w); const unsigned lo = f2bf(w - __uint_as_float(hi << 16)); const int off = (4 + (i & 31)) * WROW + (i >> 5) * 2;
            *(LAS unsigned short*)(WH + off) = (unsigned short)hi; *(LAS unsigned short*)(WL + off) = (unsigned short)lo; }
        __syncthreads();
        const int b = blk / (SEQ / 128); const size_t tok = (size_t)blk * 128 + wave_ * 16 + l15;
        const bf16* xrow = x1 + tok * D + 8 * kg; const float* gmp = g2 + 8 * kg; const float* scp = mod + b * 6144 + 4096 + 8 * kg; const float* shp = mod + b * 6144 + 3072 + 8 * kg;
        float ss = 0.f;
#pragma unroll 8
        for (int ks = 0; ks < 32; ++ks) { const v4u xw = *(const v4u*)(xrow + 32 * ks);
#pragma unroll
            for (int e = 0; e < 4; ++e) { const float lo_ = bflo(xw[e]), hi_ = bfhi(xw[e]); ss += lo_ * lo_ + hi_ * hi_; } }
        ss += __shfl_xor(ss, 16); ss += __shfl_xor(ss, 32);
        const float rstd = 1.0f / sqrtf(ss * (1.f / D) + 1e-6f);
        f32x4 acc[3]; acc[0] = f32x4{0.f, 0.f, 0.f, 0.f}; acc[1] = acc[0]; acc[2] = acc[0];
        int wcol[3];
#pragma unroll
        for (int ct = 0; ct < 3; ++ct) { const int col = 16 * ct + l15; wcol[ct] = (col < 36 ? col : 35) * WROW + 16 * kg; }
#pragma unroll 2
        for (int ks = 0; ks < 32; ++ks) {
            float hv[8];
            { const v4u xw = *(const v4u*)(xrow + 32 * ks); const f32x4 a = {bflo(xw.x), bfhi(xw.x), bflo(xw.y), bfhi(xw.y)}, c = {bflo(xw.z), bfhi(xw.z), bflo(xw.w), bfhi(xw.w)};
              const f32x4 g0 = *(const f32x4*)(gmp + 32 * ks), g1 = *(const f32x4*)(gmp + 32 * ks + 4), s0 = *(const f32x4*)(scp + 32 * ks), s1 = *(const f32x4*)(scp + 32 * ks + 4), h0 = *(const f32x4*)(shp + 32 * ks), h1 = *(const f32x4*)(shp + 32 * ks + 4);
              const f32x4 u0 = a * rstd * (g0 * (s0 + 1.0f)) + h0, u1 = c * rstd * (g1 * (s1 + 1.0f)) + h1;
              hv[0] = u0.x; hv[1] = u0.y; hv[2] = u0.z; hv[3] = u0.w; hv[4] = u1.x; hv[5] = u1.y; hv[6] = u1.z; hv[7] = u1.w; }
            unsigned hiw[4], low[4];
#pragma unroll
            for (int e = 0; e < 4; ++e) { const unsigned h0 = f2bf(hv[2 * e]), h1 = f2bf(hv[2 * e + 1]); hiw[e] = h0 | (h1 << 16);
                low[e] = f2bf(hv[2 * e] - __uint_as_float(h0 << 16)) | (f2bf(hv[2 * e + 1] - __uint_as_float(h1 << 16)) << 16); }
            v4u hq; hq.x = hiw[0]; hq.y = hiw[1]; hq.z = hiw[2]; hq.w = hiw[3];
            *(v4u*)(XN2 + tok * D + 32 * ks + 8 * kg) = hq;
            v4u lq; lq.x = low[0]; lq.y = low[1]; lq.z = low[2]; lq.w = low[3];
            const bf16x8 ah = __builtin_bit_cast(bf16x8, hq), al = __builtin_bit_cast(bf16x8, lq);
#pragma unroll
            for (int ct = 0; ct < 3; ++ct) { const bf16x8 bh = *(const LAS bf16x8*)(WH + wcol[ct] + 64 * ks), bl = *(const LAS bf16x8*)(WL + wcol[ct] + 64 * ks);
                acc[ct] = __builtin_amdgcn_mfma_f32_16x16x32_bf16(ah, bh, acc[ct], 0, 0, 0); acc[ct] = __builtin_amdgcn_mfma_f32_16x16x32_bf16(ah, bl, acc[ct], 0, 0, 0); acc[ct] = __builtin_amdgcn_mfma_f32_16x16x32_bf16(al, bh, acc[ct], 0, 0, 0); }
        }
        __syncthreads();
#pragma unroll
        for (int ct = 0; ct < 3; ++ct) { const int col = 16 * ct + l15; if (col < 36) { const float bias = (col < 4) ? rgb[col] : reb[col - 4];
#pragma unroll
            for (int e = 0; e < 4; ++e) LG[(wave_ * 16 + 4 * kg + e) * 36 + col] = acc[ct][e] + bias; } }
        __syncthreads();
        if (tid_ < 128) { const LAS float* lg = LG + tid_ * 36;
            int gi = 0; float gmax = lg[0];
#pragma unroll
            for (int i = 1; i < 4; ++i) if (lg[i] > gmax) { gmax = lg[i]; gi = i; }
            float den = 0.f;
#pragma unroll
            for (int i = 0; i < 4; ++i) den += __expf(lg[i] - gmax);
            const float gp = 1.0f / den;
            float el[8];
#pragma unroll
            for (int i = 0; i < 8; ++i) el[i] = lg[4 + 8 * gi + i];
            int i0 = 0; float m0 = el[0];
#pragma unroll
            for (int i = 1; i < 8; ++i) if (el[i] > m0) { m0 = el[i]; i0 = i; }
            int i1 = -1; float m1 = -INFINITY;
#pragma unroll
            for (int i = 0; i < 8; ++i) if (i != i0 && el[i] > m1) { m1 = el[i]; i1 = i; }
            if (i1 < 0) { i1 = (i0 + 1) & 7; m1 = m0; }
            const float p1 = __expf(m1 - m0), w0 = gp / (1.0f + p1), w1 = gp * p1 / (1.0f + p1);
            int* rt_ = route + ((size_t)blk * 128 + tid_) * 8; rt_[0] = gi * 8 + i0; rt_[1] = gi * 8 + i1; rt_[2] = __float_as_int(w0); rt_[3] = __float_as_int(w1);
            eid[tid_ * 2] = gi * 8 + i0; eid[tid_ * 2 + 1] = gi * 8 + i1; }
        __syncthreads();
        if (tid_ < 256) { const int e = eid[tid_]; int rk = 0; for (int a = 0; a < tid_; ++a) rk += (eid[a] == e) ? 1 : 0; route[((size_t)blk * 128 + (tid_ >> 1)) * 8 + 4 + (tid_ & 1)] = rk; }
        else if (tid_ < 288) { const int e = tid_ - 256; int cn = 0; for (int a = 0; a < 256; ++a) cn += (eid[a] == e) ? 1 : 0; blkcnt[blk * 32 + e] = cn; }
    }
}

__device__ __forceinline__ void conv_experts(Frame& F, const Args& A) {
    PHASE_IDS();
    unsigned char* ws = A.ws; bf16* W13 = (bf16*)(ws + WS_W13); bf16* W2T = (bf16*)(ws + WS_W2T);
    LAS float* scr = (LAS float*)(F.lds + RING_OFF + wave_ * 16384);
    const int gw = F.vcu * NWAVES + wave_, NGW = F.G * NWAVES;
    for (int it = gw; it < 3 * 8192; it += NGW) {
        const int which = it >> 13, r = it & 8191;
        if (which < 2) { const int e = r >> 8, kb = (r >> 4) & 15, nb = r & 15, n0 = 32 * nb;
            transpose_item(A.in[26 + which] + (size_t)e * 1024 * 512, 512, n0, 64 * kb, 1024, W13, (size_t)e * 1024 + (n0 >> 7) * 256 + which * 128 + (n0 & 127), scr, lane_); }
        else { const int e = r >> 8, kb = (r >> 5) & 7, nb = r & 31;
            transpose_item(A.in[28] + (size_t)e * 512 * 1024, 1024, 32 * nb, 64 * kb, 512, W2T, (size_t)e * 1024 + 32 * nb, scr, lane_); }
    }
}

__device__ __forceinline__ void p_slots(Frame& F, const Args& A) {
    PHASE_IDS();
    unsigned char* ws = A.ws;
    LAS int* tile_e = (LAS int*)(F.lds + TILE_OFF); LAS int* base = tile_e + 288; LAS int* tot = base + 32; LAS int* pre = tot + 32; LAS int* ntl = pre + 32; LAS int* part = ntl + 4;
    const int* blkcnt = (const int*)(ws + WS_BLKCNT); int* route = (int*)(ws + WS_ROUTE); int* rowtok = (int*)(ws + WS_ROWTOK);
    { const int e = tid_ & 31, pt = tid_ >> 5; int s = 0; for (int bb = 16 * pt; bb < 16 * pt + 16; ++bb) s += blkcnt[bb * 32 + e]; part[pt * 32 + e] = s; }
    __syncthreads();
    if (tid_ < 32) { int t = 0; for (int p = 0; p < 16; ++p) t += part[p * 32 + tid_]; tot[tid_] = t; }
    __syncthreads();
    if (tid_ == 0) { int run = 0, nt = 0; for (int e = 0; e < 32; ++e) { base[e] = run; const int pad = (tot[e] + 255) >> 8; for (int i = 0; i < pad; ++i) tile_e[nt++] = e; run += pad * 256; } ntl[0] = nt; }
    __syncthreads();
    for (int blk = blockIdx.x; blk < M / 128; blk += F.G) {
        { const int e = tid_ & 31, pt = tid_ >> 5; int s = 0; for (int bb = pt; bb < blk; bb += 16) s += blkcnt[bb * 32 + e]; part[pt * 32 + e] = s; }
        __syncthreads();
        if (tid_ < 32) { int p = 0; for (int q = 0; q < 16; ++q) p += part[q * 32 + tid_]; pre[tid_] = p; }
        __syncthreads();
        if (tid_ < 256) { const size_t tok = (size_t)blk * 128 + (tid_ >> 1); const int k = tid_ & 1; const int e = route[tok * 8 + k], lr = route[tok * 8 + 4 + k];
            const int slot = base[e] + pre[e] + lr; route[tok * 8 + 6 + k] = slot; rowtok[slot] = (int)tok; }
        __syncthreads();
    }
    for (int e = blockIdx.x; e < 32; e += F.G) { const int lo = base[e] + tot[e], hi = base[e] + (((tot[e] + 255) >> 8) << 8); for (int s = lo + tid_; s < hi; s += NWAVES * 64) rowtok[s] = 0; }
}

#ifndef STAGE_UNUSED
#define STAGE 4
#endif
#ifndef PHASES
#define PHASES 0xffff
#endif
#ifndef RWKV_CHUNKED
#define RWKV_CHUNKED 1
#endif

__device__ __forceinline__ void ph_gemm1(Frame& F, const Args& args) { unsigned char* ws = args.ws;
    pg8::Gemm g{(const pg8::bf16_t*)(ws + WS_XN), (const pg8::bf16_t*)(ws + WS_WIN), nullptr, 1024, NIN};
    pg8::StaticOrder S; S.init(M, NIN, F.G, (int)blockIdx.x);
    pg8::EpiIn E{(pg8::bf16_t*)(ws + WS_Q), (pg8::bf16_t*)(ws + WS_K), (pg8::bf16_t*)(ws + WS_V), (pg8::bf16_t*)(ws + WS_PRW), (pg8::bf16_t*)(ws + WS_GATES), ATT_C2};
    pg8::gemm_phase<pg8::EpiIn, pg8::StaticOrder>(F.lds + RING_OFF, g, S, E); }
__device__ __forceinline__ void ph_attn_wrap(unsigned char* lds, Frame& F, const Args& args, size_t out_off, int qslot) { unsigned char* ws = args.ws;
    const attn_body::AttnTensors AT{(const attn_body::bf16*)(ws + WS_Q), (const attn_body::bf16*)(ws + WS_K), (const attn_body::bf16*)(ws + WS_V), (attn_body::bf16*)(ws + out_off), (const float*)(ws + WS_CUM), (const float*)(ws + WS_SEGTOT)};
    attn_body::attn_phase_dyn<8>((char*)lds + RING_OFF, AT, (unsigned*)(F.ctl + CW_QUEUE + 64 * qslot), (const unsigned*)(F.ctl + CW_QKMAX), (const unsigned*)(F.ctl + CW_KTMAX), TAB_OFF, SEGP_OFF); }
__device__ __forceinline__ void ph_gemm2a(Frame& F, const Args& args) { unsigned char* ws = args.ws;
    pg8::Gemm g{(const pg8::bf16_t*)(ws + WS_Q), (const pg8::bf16_t*)(ws + WS_WOF), nullptr, 512, 1024};
    pg8::StaticOrder S; S.init(M, 1024, F.G, (int)blockIdx.x);
    pg8::EpiGate<1> E{(pg8::bf16_t*)(ws + WS_TMP), 1024, (const pg8::bf16_t*)(ws + WS_GATES), 2048, 0};
    pg8::gemm_phase<pg8::EpiGate<1>, pg8::StaticOrder>(F.lds + RING_OFF, g, S, E); }
__device__ __forceinline__ void ph_gemm2b(Frame& F, const Args& args) { unsigned char* ws = args.ws;
    pg8::Gemm g{(const pg8::bf16_t*)(ws + WS_F), (const pg8::bf16_t*)(ws + WS_WOR), nullptr, 512, 1024};
    pg8::StaticOrder S; S.init(M, 1024, F.G, (int)blockIdx.x);
    pg8::EpiGate<2> E{(pg8::bf16_t*)(ws + WS_TMP), 1024, (const pg8::bf16_t*)(ws + WS_GATES), 2048, 1024};
    pg8::gemm_phase<pg8::EpiGate<2>, pg8::StaticOrder>(F.lds + RING_OFF, g, S, E); }
__device__ __forceinline__ void ph_gemm3(Frame& F, const Args& args) { unsigned char* ws = args.ws;
    pg8::Gemm g{(const pg8::bf16_t*)(ws + WS_TMP), (const pg8::bf16_t*)(ws + WS_WO), nullptr, 1024, 1024};
    pg8::StaticOrder S; S.init(M, 1024, F.G, (int)blockIdx.x);
    pg8::EpiRes E{args.in[0], (pg8::bf16_t*)(ws + WS_X1), (const float*)(ws + WS_MOD) + 2048, SEQ, 6144};
    pg8::gemm_phase<pg8::EpiRes, pg8::StaticOrder>(F.lds + RING_OFF, g, S, E); }
__device__ __forceinline__ void ph_moe_up(Frame& F, const Args& args) { unsigned char* ws = args.ws;
    const LAS int* tile_e = (const LAS int*)(F.lds + TILE_OFF); const int ntiles = tile_e[288 + 96];
    LAS int* rows = (LAS int*)(F.lds + TILE_OFF + 4096);
    { const int* rowtok = (const int*)(ws + WS_ROWTOK); int tid_ = threadIdx.x; asm volatile("" : "+v"(tid_));
      for (int i = 0; i < 8; ++i) { const int L = i * F.G + (int)blockIdx.x; if (L >= ntiles * 4) break; if (tid_ < 256) rows[i * 256 + tid_] = rowtok[(L >> 2) * 256 + tid_]; }
      __syncthreads(); }
    pg8::Gemm g{(const pg8::bf16_t*)(ws + WS_XN), (const pg8::bf16_t*)(ws + WS_W13), rows, 1024, 1024};
    pg8::MoeOrder S{ntiles * 4, F.G, (int)blockIdx.x, 2, tile_e};
    pg8::EpiSwiGLU E{(pg8::bf16_t*)(ws + WS_H)};
    pg8::gemm_phase<pg8::EpiSwiGLU, pg8::MoeOrder, true>(F.lds + RING_OFF, g, S, E); }
__device__ __forceinline__ void ph_moe_down(Frame& F, const Args& args) { unsigned char* ws = args.ws;
    const LAS int* tile_e = (const LAS int*)(F.lds + TILE_OFF); const int ntiles = tile_e[288 + 96];
    pg8::Gemm g{(const pg8::bf16_t*)(ws + WS_H), (const pg8::bf16_t*)(ws + WS_W2T), nullptr, 512, 1024};
    pg8::MoeOrder S{ntiles * 4, F.G, (int)blockIdx.x, 2, tile_e};
    pg8::EpiFp8 E{ws + WS_YM, 1024};
    pg8::gemm_phase<pg8::EpiFp8, pg8::MoeOrder>(F.lds + RING_OFF, g, S, E); }

__global__ void __launch_bounds__(NWAVES * 64, 2) fwd_kernel(Args args) {
    extern __shared__ __attribute__((aligned(16))) unsigned char lds[];
    Frame F;
    F.lds = (LAS unsigned char*)lds;
    F.MISC = (volatile LAS unsigned*)(F.lds + MISC_OFF);
    F.tid = threadIdx.x; F.lane = F.tid & 63; F.wave = __builtin_amdgcn_readfirstlane(F.tid >> 6);
    F.G = gridDim.x; { const int bx = blockIdx.x; F.vcu = (F.G % 8 == 0) ? (bx % 8) * (F.G / 8) + bx / 8 : bx; }
    unsigned char* ws = args.ws;
    F.ctl = (gu32*)(ws + WS_CTL);
    for (int u = F.tid; u < (LDS_BYTES - LDSCTL_OFF) / 4; u += NWAVES * 64) ((LAS unsigned*)(F.lds + LDSCTL_OFF))[u] = 0u;
    __syncthreads();
    XcdBarrier bar = xcd_barrier_post((unsigned*)(F.ctl + CW_BAR), F.MISC + 8);
#define GRID_BAR() xcd_barrier(bar)

    p0_prologue(F, args); GRID_BAR();
    p1_norm(F, args); __syncthreads(); p_convert_early(F, args); GRID_BAR();
    p_cumfix(F, args);
    ph_gemm1(F, args); GRID_BAR();
    p_qknorm(F, args, (unsigned*)(F.ctl + CW_QKMAX), (unsigned*)(F.ctl + CW_KTMAX));
    for (int cb = (int)blockIdx.x; cb < SEQ / 64; cb += F.G)
    for (int half = 0; half < 2; ++half) {
        rwkv_pre<0>(F, args, cb + 256 * half, cb + 256 * half + 1);
        __syncthreads();
        rwkv_r1w(F, args, cb + 2048 * half + 256 * __builtin_amdgcn_readfirstlane((int)threadIdx.x >> 6));
    }
    GRID_BAR();
    rwkv_r2w(F, args, (unsigned char*)args.out + ST_OFF);
    ph_attn_wrap(lds, F, args, WS_Q, 0); GRID_BAR();
    rwkv_r3(F, args); GRID_BAR();
    ph_gemm2a(F, args);
    ph_gemm2b(F, args); GRID_BAR();
    ph_gemm3(F, args); GRID_BAR();
    p_norm2_route(F, args); GRID_BAR();
    p_slots(F, args); conv_experts(F, args); GRID_BAR();
    ph_moe_up(F, args); GRID_BAR();
    ph_moe_down(F, args); GRID_BAR();
    p_final<1>(F, args, args.out);
}

extern "C" void kernel_launch(void* const* d_in, const int* in_sizes, int n_in, void* d_out, int out_size, void* d_ws, size_t ws_size, hipStream_t stream) {
    static int grid = 0;
    if (grid == 0) {
        if (n_in != 30 || in_sizes[0] != M * D || out_size != M * D || ws_size < WS_END) { fprintf(stderr, "kernel_launch: unexpected shapes (n_in %d, in0 %d, out %d, ws %zu)\n", n_in, n_in > 0 ? in_sizes[0] : -1, out_size, ws_size); grid = -1; return; }
        int dev = 0, cus = 0, per_cu = 0;
        if (hipGetDevice(&dev) != hipSuccess || hipDeviceGetAttribute(&cus, hipDeviceAttributeMultiprocessorCount, dev) != hipSuccess) { grid = -1; return; }
        if (hipFuncSetAttribute((const void*)fwd_kernel, hipFuncAttributeMaxDynamicSharedMemorySize, LDS_BYTES) != hipSuccess) { fprintf(stderr, "kernel_launch: hipFuncSetAttribute failed\n"); grid = -1; return; }
        if (hipOccupancyMaxActiveBlocksPerMultiprocessor(&per_cu, (const void*)fwd_kernel, NWAVES * 64, LDS_BYTES) != hipSuccess || per_cu < 1)
            fprintf(stderr, "kernel_launch: occupancy query reports %d\n", per_cu);
        (void)hipGetLastError();
        grid = cus;
        if (grid > 256) grid = 256;
    }
    if (grid < 0) return;
    if (hipMemsetAsync((char*)d_ws + WS_CTL, 0, CTL_ZERO_BYTES, stream) != hipSuccess) return;
    Args a{};
    for (int i = 0; i < 30; ++i) a.in[i] = (const float*)d_in[i];
    a.out = (float*)d_out; a.ws = (unsigned char*)d_ws;
    hipLaunchKernelGGL(fwd_kernel, dim3(grid), dim3(NWAVES * 64), LDS_BYTES, stream, a);
}
```
